# Optimizing an MI355X kernel written in HIP

```python
import math
import jax, jax.numpy as jnp
from jax import lax
import numpy as np

D_MODEL = 1024
BATCH = 16
SEQ = 2048
DEPTH = 1

D_MIX = D_MODEL
D_SSM = D_MIX // 2
D_DN = D_MIX - D_SSM
SSM_GROUP = 16
SSM_GROUPS = D_SSM // SSM_GROUP
SSM_STATE = 64
DN_HEAD_DIM = 128
DN_HEADS = D_DN // DN_HEAD_DIM
DN_CONV = 4
DN_CHUNK = 64
PLE_DIM = 256
NORM_EPS = 1e-6

SPLIT_1 = D_SSM
SPLIT_2 = SPLIT_1 + D_SSM
SPLIT_3 = SPLIT_2 + D_DN
SPLIT_4 = SPLIT_3 + D_DN
SPLIT_5 = SPLIT_4 + D_DN
SPLIT_6 = SPLIT_5 + D_DN
SPLIT_7 = SPLIT_6 + DN_HEADS
D_IN_PROJ = SPLIT_7 + DN_HEADS

kernel_name = "hymba_s5_gated_deltanet_block"


def rms_norm(x, g):
    xf = x.astype(jnp.float32)
    y = xf * lax.rsqrt(jnp.mean(xf * xf, axis=-1, keepdims=True) + NORM_EPS)
    return (y * g.astype(jnp.float32)).astype(x.dtype)


def l2_normalize(x):
    return x * lax.rsqrt(jnp.sum(x * x, axis=-1, keepdims=True) + NORM_EPS)


def _complex_linear_combine(earlier, later):
    a1r, a1i, b1r, b1i = earlier
    a2r, a2i, b2r, b2i = later
    ar = a2r * a1r - a2i * a1i
    ai = a2r * a1i + a2i * a1r
    br = a2r * b1r - a2i * b1i + b2r
    bi = a2r * b1i + a2i * b1r + b2i
    return (ar, ai, br, bi)


def s5_branch(u, A_re, A_im, B_re, B_im, C_re, C_im, D, log_dt, w_glu, b_glu):
    f32 = jnp.float32
    bsz, L, _ = u.shape
    uf = u.astype(f32)
    ug = uf.reshape(bsz, L, SSM_GROUPS, SSM_GROUP)
    dt = jnp.exp(log_dt.astype(f32))[:, None]
    lr = A_re.astype(f32)
    li = A_im.astype(f32)
    mag = jnp.exp(lr * dt)
    ang = li * dt
    ab_r = mag * jnp.cos(ang)
    ab_i = mag * jnp.sin(ang)
    den = lr * lr + li * li
    nr = ab_r - 1.0
    ni = ab_i
    cr = (nr * lr + ni * li) / den
    ci = (ni * lr - nr * li) / den
    Br = B_re.astype(f32)
    Bi = B_im.astype(f32)
    bb_r = cr[..., None] * Br - ci[..., None] * Bi
    bb_i = cr[..., None] * Bi + ci[..., None] * Br
    bu_r = jnp.einsum('gph,blgh->blgp', bb_r, ug)
    bu_i = jnp.einsum('gph,blgh->blgp', bb_i, ug)
    a_r = jnp.broadcast_to(ab_r, (1, L) + ab_r.shape)
    a_i = jnp.broadcast_to(ab_i, (1, L) + ab_i.shape)
    _, _, s_r, s_i = lax.associative_scan(_complex_linear_combine, (a_r, a_i, bu_r, bu_i), axis=1)
    y = (jnp.einsum('ghp,blgp->blgh', C_re.astype(f32), s_r)
         - jnp.einsum('ghp,blgp->blgh', C_im.astype(f32), s_i))
    y = y.reshape(bsz, L, D_SSM) + D.astype(f32) * uf
    y = jax.nn.gelu(y)
    y = y * jax.nn.sigmoid(y @ w_glu.astype(f32) + b_glu.astype(f32))
    return y


def causal_depthwise_conv(x, w):
    K, C = w.shape
    return lax.conv_general_dilated(x, w[:, None, :], window_strides=(1,), padding=((K - 1, 0),),
                                    dimension_numbers=('NWC', 'WIO', 'NWC'), feature_group_count=C)


def chunk_gated_delta_rule(q, k, v, g, beta):
    f32 = jnp.float32
    bsz, L, H, Dk = q.shape
    Dv = v.shape[-1]
    C = DN_CHUNK
    N = L // C

    def to_chunks(t):
        return t.reshape(bsz, N, C, H, -1).transpose(0, 1, 3, 2, 4)

    q, k, v = to_chunks(q), to_chunks(k), to_chunks(v)
    g = g.reshape(bsz, N, C, H).transpose(0, 1, 3, 2)
    beta = beta.reshape(bsz, N, C, H).transpose(0, 1, 3, 2)
    g = jnp.cumsum(g, axis=-1)
    causal = jnp.tril(jnp.ones((C, C), dtype=bool))
    strict = jnp.tril(jnp.ones((C, C), dtype=bool), k=-1)
    diff = g[..., :, None] - g[..., None, :]
    decay = jnp.where(causal, jnp.exp(jnp.where(causal, diff, 0.0)), 0.0)
    k_beta = k * beta[..., None]
    v_beta = v * beta[..., None]
    lower = jnp.where(strict, jnp.einsum('bnhid,bnhjd->bnhij', k_beta, k) * decay, 0.0)
    tri = lower + jnp.eye(C, dtype=f32)
    rhs = jnp.concatenate([v_beta, k_beta * jnp.exp(g)[..., None]], axis=-1)
    sol = lax.linalg.triangular_solve(tri, rhs, left_side=True, lower=True, unit_diagonal=True)
    u = sol[..., :Dv]
    w = sol[..., Dv:]
    attn_intra = jnp.where(causal, jnp.einsum('bnhid,bnhjd->bnhij', q, k) * decay, 0.0)

    def step(S, inp):
        q_c, k_c, u_c, w_c, g_c, a_c = inp
        v_new = u_c - jnp.einsum('bhck,bhkv->bhcv', w_c, S)
        o = (jnp.einsum('bhck,bhkv->bhcv', q_c * jnp.exp(g_c)[..., None], S)
             + jnp.einsum('bhij,bhjv->bhiv', a_c, v_new))
        g_last = g_c[..., -1]
        k_dec = k_c * jnp.exp(g_last[..., None] - g_c)[..., None]
        S = S * jnp.exp(g_last)[..., None, None] + jnp.einsum('bhck,bhcv->bhkv', k_dec, v_new)
        return S, o

    xs = tuple(jnp.moveaxis(t, 1, 0) for t in (q, k, u, w, g, attn_intra))
    S0 = jnp.zeros((bsz, H, Dk, Dv), dtype=f32)
    _, o = lax.scan(step, S0, xs)
    o = jnp.moveaxis(o, 0, 1).transpose(0, 1, 3, 2, 4).reshape(bsz, L, H, Dv)
    return o


def gated_deltanet_branch(q, k, v, z, b_raw, a_raw, conv_w, A_log, dt_bias, norm_g):
    f32 = jnp.float32
    bsz, L, _ = q.shape
    qkv = jnp.concatenate([q, k, v], axis=-1).astype(f32)
    qkv = jax.nn.silu(causal_depthwise_conv(qkv, conv_w.astype(f32)))
    q, k, v = jnp.split(qkv, [D_DN, 2 * D_DN], axis=-1)
    q = l2_normalize(q.reshape(bsz, L, DN_HEADS, DN_HEAD_DIM)) * (DN_HEAD_DIM ** -0.5)
    k = l2_normalize(k.reshape(bsz, L, DN_HEADS, DN_HEAD_DIM))
    v = v.reshape(bsz, L, DN_HEADS, DN_HEAD_DIM)
    beta = jax.nn.sigmoid(b_raw.astype(f32))
    g = -jnp.exp(A_log.astype(f32)) * jax.nn.softplus(a_raw.astype(f32) + dt_bias.astype(f32))
    o = chunk_gated_delta_rule(q, k, v, g, beta)
    zf = z.astype(f32).reshape(bsz, L, DN_HEADS, DN_HEAD_DIM)
    o = rms_norm(o, norm_g) * jax.nn.silu(zf)
    return o.reshape(bsz, L, D_DN)


def setup_inputs(seed: int = 0) -> dict:
    key = jax.random.key(seed)
    ks = jax.random.split(key, 24)
    f32 = jnp.float32
    nrm = lambda k, s, sc: jax.random.normal(k, s, f32) * sc
    x = jax.random.normal(ks[0], (BATCH, SEQ, D_MODEL), f32)
    p = jax.random.normal(ks[1], (DEPTH, BATCH, SEQ, PLE_DIM), f32)
    norm_mix_g = 1.0 + nrm(ks[2], (DEPTH, D_MODEL), 0.02)
    w_in = nrm(ks[3], (DEPTH, D_MODEL, D_IN_PROJ), D_MODEL ** -0.5)
    n_idx = jnp.arange(SSM_STATE, dtype=f32)
    ssm_A_re = -0.5 + nrm(ks[4], (DEPTH, SSM_GROUPS, SSM_STATE), 0.01)
    ssm_A_im = math.pi * n_idx + nrm(ks[5], (DEPTH, SSM_GROUPS, SSM_STATE), 0.01)
    ssm_B_re = nrm(ks[6], (DEPTH, SSM_GROUPS, SSM_STATE, SSM_GROUP), (2 * SSM_GROUP) ** -0.5)
    ssm_B_im = nrm(ks[7], (DEPTH, SSM_GROUPS, SSM_STATE, SSM_GROUP), (2 * SSM_GROUP) ** -0.5)
    ssm_C_re = nrm(ks[8], (DEPTH, SSM_GROUPS, SSM_GROUP, SSM_STATE), SSM_STATE ** -0.5)
    ssm_C_im = nrm(ks[9], (DEPTH, SSM_GROUPS, SSM_GROUP, SSM_STATE), SSM_STATE ** -0.5)
    ssm_D = nrm(ks[10], (DEPTH, D_SSM), 1.0)
    ssm_log_dt = jax.random.uniform(ks[11], (DEPTH, SSM_GROUPS), f32, math.log(1e-3), math.log(1e-1))
    ssm_w_glu = nrm(ks[12], (DEPTH, D_SSM, D_SSM), D_SSM ** -0.5)
    ssm_b_glu = nrm(ks[13], (DEPTH, D_SSM), 0.01)
    dn_conv_w = nrm(ks[14], (DEPTH, DN_CONV, 3 * D_DN), DN_CONV ** -0.5)
    dn_A_log = jnp.log(jax.random.uniform(ks[15], (DEPTH, DN_HEADS), f32, 1.0, 16.0))
    dt0 = jnp.exp(jax.random.uniform(ks[16], (DEPTH, DN_HEADS), f32, math.log(1e-3), math.log(1e-1)))
    dn_dt_bias = dt0 + jnp.log(-jnp.expm1(-dt0))
    dn_norm_g = 1.0 + nrm(ks[17], (DEPTH, DN_HEAD_DIM), 0.02)
    w_out = nrm(ks[18], (DEPTH, D_MIX, D_MODEL), D_MIX ** -0.5)
    w_ple_proj = nrm(ks[19], (DEPTH, PLE_DIM, D_MODEL), PLE_DIM ** -0.5)
    ple_norm_g = 1.0 + nrm(ks[20], (DEPTH, D_MODEL), 0.02)
    w_ple_gate = nrm(ks[21], (DEPTH, D_MODEL, D_MODEL), D_MODEL ** -0.5)
    final_norm_g = 1.0 + nrm(ks[22], (D_MODEL,), 0.02)
    return {"x": x, "p": p, "norm_mix_g": norm_mix_g, "w_in": w_in,
            "ssm_A_re": ssm_A_re, "ssm_A_im": ssm_A_im, "ssm_B_re": ssm_B_re, "ssm_B_im": ssm_B_im,
            "ssm_C_re": ssm_C_re, "ssm_C_im": ssm_C_im, "ssm_D": ssm_D, "ssm_log_dt": ssm_log_dt,
            "ssm_w_glu": ssm_w_glu, "ssm_b_glu": ssm_b_glu,
            "dn_conv_w": dn_conv_w, "dn_A_log": dn_A_log, "dn_dt_bias": dn_dt_bias, "dn_norm_g": dn_norm_g,
            "w_out": w_out, "w_ple_proj": w_ple_proj, "ple_norm_g": ple_norm_g, "w_ple_gate": w_ple_gate,
            "final_norm_g": final_norm_g}


def reference(x, p, norm_mix_g, w_in, ssm_A_re, ssm_A_im, ssm_B_re, ssm_B_im, ssm_C_re, ssm_C_im,
              ssm_D, ssm_log_dt, ssm_w_glu, ssm_b_glu, dn_conv_w, dn_A_log, dn_dt_bias, dn_norm_g,
              w_out, w_ple_proj, ple_norm_g, w_ple_gate, final_norm_g):
    h = x
    for i in range(DEPTH):
        a = rms_norm(h, norm_mix_g[i])
        proj = a @ w_in[i]
        u_s, z_s, q, k, v, z_d, b_raw, a_raw = jnp.split(
            proj, [SPLIT_1, SPLIT_2, SPLIT_3, SPLIT_4, SPLIT_5, SPLIT_6, SPLIT_7], axis=-1)
        y_s = s5_branch(u_s, ssm_A_re[i], ssm_A_im[i], ssm_B_re[i], ssm_B_im[i], ssm_C_re[i],
                        ssm_C_im[i], ssm_D[i], ssm_log_dt[i], ssm_w_glu[i], ssm_b_glu[i])
        y_s = y_s * jax.nn.silu(z_s.astype(jnp.float32))
        y_d = gated_deltanet_branch(q, k, v, z_d, b_raw, a_raw, dn_conv_w[i], dn_A_log[i],
                                    dn_dt_bias[i], dn_norm_g[i])
        mix = jnp.concatenate([y_s, y_d], axis=-1).astype(h.dtype) @ w_out[i]
        h = h + mix
        e = rms_norm(p[i] @ w_ple_proj[i], ple_norm_g[i])
        h = h + jax.nn.sigmoid(h @ w_ple_gate[i]) * e
    return rms_norm(h, final_norm_g)
```

```cpp
#include <hip/hip_runtime.h>
#include <hip/hip_cooperative_groups.h>
#include <cstdio>
namespace cg = cooperative_groups;

#ifndef MULTI_LAUNCH
#define MULTI_LAUNCH 1
#endif

typedef _Float16 h16;
typedef __attribute__((ext_vector_type(8))) _Float16 h16x8;
typedef __attribute__((ext_vector_type(4))) _Float16 h16x4;
typedef __attribute__((ext_vector_type(4))) float f32x4;

#define MFMA(a, b, c) __builtin_amdgcn_mfma_f32_16x16x32_f16((a), (b), (c), 0, 0, 0)

constexpr int T_TOK = 32768;
constexpr int SEQ = 2048;
constexpr int NPH = 7;
constexpr int LDP = 3072;
constexpr int SMEM_BYTES = 70400;

constexpr size_t SZ_WIN = (size_t)3200 * 1024 * 2;
constexpr size_t SZ_WGLU = (size_t)512 * 512 * 2;
constexpr size_t SZ_WOUT = (size_t)1024 * 1024 * 2;
constexpr size_t SZ_WPP = (size_t)1024 * 256 * 2;
constexpr size_t SZ_WGATE = (size_t)1024 * 1024 * 2;
constexpr size_t OFF_WIN = 0;
constexpr size_t OFF_WGLU = OFF_WIN + SZ_WIN;
constexpr size_t OFF_WOUT = OFF_WGLU + SZ_WGLU;
constexpr size_t OFF_WPP = OFF_WOUT + SZ_WOUT;
constexpr size_t OFF_WGATE = OFF_WPP + SZ_WPP;
constexpr size_t OFF_PB = OFF_WGATE + SZ_WGATE;
constexpr size_t OFF_PROJ = OFF_PB + (size_t)T_TOK * 256 * 2;
constexpr size_t OFF_AB = OFF_PROJ + (size_t)T_TOK * LDP * 2;
constexpr size_t OFF_KTAB = OFF_AB + (size_t)T_TOK * 8 * 4;
constexpr size_t OFF_ETAB = OFF_KTAB + (size_t)32 * 33 * 256 * 2;
constexpr size_t OFF_FTAB = OFF_ETAB + (size_t)32 * 128 * 512 * 2;
constexpr size_t OFF_ALPOW = OFF_FTAB + (size_t)32 * 512 * 128 * 2;
constexpr size_t OFF_DL = OFF_ALPOW + (size_t)32 * 64 * 2 * 4;
constexpr size_t OFF_EPART = OFF_DL + (size_t)2048 * 4;
constexpr size_t OFF_OPART = OFF_EPART + (size_t)T_TOK * 16 * 4;
constexpr size_t OFF_MIXIN = OFF_OPART + (size_t)T_TOK * 16 * 4;
constexpr size_t OFF_WP = OFF_MIXIN + (size_t)T_TOK * 1024 * 2;
constexpr size_t OFF_QGP = OFF_WP + (size_t)2048 * 64 * 128 * 2;
constexpr size_t OFF_KDT = OFF_QGP + (size_t)2048 * 64 * 128 * 2;
constexpr size_t OFF_UT = OFF_KDT + (size_t)2048 * 128 * 64 * 2;
constexpr size_t OFF_ATP = OFF_UT + (size_t)2048 * 128 * 64 * 2;
constexpr size_t OFF_EH = OFF_ATP + (size_t)2048 * 64 * 64 * 2;
constexpr size_t WS_END = OFF_EH + (size_t)T_TOK * 1024 * 2;
constexpr size_t OUT_OFF_A0 = 0;
constexpr size_t OUT_OFF_YPRE = (size_t)T_TOK * 1024 * 2;

struct Params {
  const float* in[23];
  float* out;
  unsigned char* ws;
  int ph_lo, ph_hi;
};

enum { I_X = 0, I_P, I_NMG, I_WIN, I_ARE, I_AIM, I_BRE, I_BIM, I_CRE, I_CIM, I_D, I_LOGDT, I_WGLU, I_BGLU,
       I_CONVW, I_ALOG, I_DTB, I_DNG, I_WOUT, I_WPP, I_PLEG, I_WGATE, I_FING };

__device__ __forceinline__ float wave_sum(float v) {
#pragma unroll
  for (int o = 32; o > 0; o >>= 1) v += __shfl_xor(v, o);
  return v;
}
__device__ __forceinline__ float sum16(float v) {
  v += __shfl_xor(v, 1); v += __shfl_xor(v, 2); v += __shfl_xor(v, 4); v += __shfl_xor(v, 8);
  return v;
}
__device__ __forceinline__ float sigmoidf_(float x) { return 1.f / (1.f + __expf(-x)); }
__device__ __forceinline__ float siluf_(float x) { return x / (1.f + __expf(-x)); }
__device__ __forceinline__ float gelu_tanh(float y) {
  float z = 0.7978845608028654f * (y + 0.044715f * y * y * y);
  return 0.5f * y * (1.f + tanhf(z));
}
__device__ __forceinline__ h16x8 pack8(f32x4 lo, f32x4 hi) {
  h16x8 r;
  r[0] = (h16)lo[0]; r[1] = (h16)lo[1]; r[2] = (h16)lo[2]; r[3] = (h16)lo[3];
  r[4] = (h16)hi[0]; r[5] = (h16)hi[1]; r[6] = (h16)hi[2]; r[7] = (h16)hi[3];
  return r;
}
__device__ __forceinline__ int perm_pos(int n) { return (n & ~31) + (((n & 15) >> 2) << 3) + (((n >> 4) & 1) << 2) + (n & 3); }
__device__ __forceinline__ int perm_inv(int pos) {
  int q5 = pos & 31, qq = q5 >> 3, jj = q5 & 7;
  return (pos & ~31) + (jj < 4 ? 4 * qq + jj : 16 + 4 * qq + (jj - 4));
}

__device__ void transpose_w(const float* __restrict__ W, int K, int N, int Npad, h16* __restrict__ WT, int t, float* tile) {
  const int ntn = Npad / 64;
  const int kt = t / ntn, nt = t % ntn, k0 = kt * 64, n0 = nt * 64;
  const int tx = threadIdx.x & 63, ty = threadIdx.x >> 6;
  for (int r = 0; r < 16; ++r) {
    int k = ty * 16 + r, n = n0 + tx;
    tile[k * 65 + tx] = (n < N) ? W[(size_t)(k0 + k) * N + n] : 0.f;
  }
  __syncthreads();
  for (int r = 0; r < 16; ++r) {
    int n = ty * 16 + r;
    WT[(size_t)(n0 + n) * K + k0 + tx] = (h16)tile[tx * 65 + n];
  }
  __syncthreads();
}

__device__ void ssm_table_item(const Params& p, int g, int d, float* lds) {
  float2* sAp = (float2*)lds;
  float2* sW = sAp + 64;
  const int tid = threadIdx.x;
  h16* KTAB = (h16*)(p.ws + OFF_KTAB);
  h16* ETAB = (h16*)(p.ws + OFF_ETAB);
  h16* FTAB = (h16*)(p.ws + OFF_FTAB);
  float* ALPOW = (float*)(p.ws + OFF_ALPOW);
  const float* B_re = p.in[I_BRE]; const float* B_im = p.in[I_BIM];
  const float* C_re = p.in[I_CRE]; const float* C_im = p.in[I_CIM];
  if (tid < 64) {
    const int pp = tid;
    float lr = p.in[I_ARE][g * 64 + pp], li = p.in[I_AIM][g * 64 + pp], dt = expf(p.in[I_LOGDT][g]);
    float mag = expf(lr * dt), ang = li * dt;
    float abr = mag * cosf(ang), abi = mag * sinf(ang);
    float nr = abr - 1.f, ni = abi, den = lr * lr + li * li;
    float cr = (nr * lr + ni * li) / den, ci = (ni * lr - nr * li) / den;
    float apr = 1.f, api = 0.f;
    for (int k = 0; k < d; ++k) { float t0 = apr * abr - api * abi; api = apr * abi + api * abr; apr = t0; }
    sAp[pp] = make_float2(apr, api);
    sW[pp] = make_float2(apr * cr - api * ci, apr * ci + api * cr);
    if (d == 32) { ALPOW[(g * 64 + pp) * 2] = apr; ALPOW[(g * 64 + pp) * 2 + 1] = api; }
  }
  __syncthreads();
  if (d < 32) {
    {
      const int h = tid >> 4, hp = tid & 15;
      float acc = 0.f;
      for (int pp = 0; pp < 64; ++pp) {
        float2 W = sW[pp];
        float br = B_re[(g * 64 + pp) * 16 + hp], bi = B_im[(g * 64 + pp) * 16 + hp];
        float wbr = W.x * br - W.y * bi, wbi = W.x * bi + W.y * br;
        float cr = C_re[(g * 16 + h) * 64 + pp], ci = C_im[(g * 16 + h) * 64 + pp];
        acc += cr * wbr - ci * wbi;
      }
      KTAB[(size_t)(g * 33 + d + 1) * 256 + h * 16 + hp] = (h16)acc;
      if (d == 0) KTAB[(size_t)(g * 33) * 256 + tid] = (h16)0.f;
    }
    {
      const int i = 31 - d;
      for (int r = 0; r < 4; ++r) {
        int idx = tid + 256 * r, pp = idx >> 4, hp = idx & 15;
        float2 W = sW[pp];
        float br = B_re[(g * 64 + pp) * 16 + hp], bi = B_im[(g * 64 + pp) * 16 + hp];
        float wbr = W.x * br - W.y * bi, wbi = W.x * bi + W.y * br;
        ETAB[((size_t)g * 128 + pp) * 512 + i * 16 + hp] = (h16)wbr;
        ETAB[((size_t)g * 128 + 64 + pp) * 512 + i * 16 + hp] = (h16)wbi;
      }
    }
  }
  if (d >= 1) {
    const int j = d - 1;
    for (int r = 0; r < 4; ++r) {
      int idx = tid + 256 * r, h = idx >> 6, pp = idx & 63;
      float2 Ap = sAp[pp];
      float cr = C_re[(g * 16 + h) * 64 + pp], ci = C_im[(g * 16 + h) * 64 + pp];
      float re = cr * Ap.x - ci * Ap.y, im = cr * Ap.y + ci * Ap.x;
      FTAB[((size_t)g * 512 + j * 16 + h) * 128 + pp] = (h16)re;
      FTAB[((size_t)g * 512 + j * 16 + h) * 128 + 64 + pp] = (h16)(-im);
    }
  }
  __syncthreads();
}

__device__ void phase0(const Params& p, unsigned char* smem) {
  const int bid = blockIdx.x, nb = gridDim.x, tid = threadIdx.x, wid = tid >> 6, lane = tid & 63;
  float* tile = (float*)smem;
  for (int t = bid; t < 1440; t += nb) {
    if (t < 800) transpose_w(p.in[I_WIN], 1024, 3080, 3200, (h16*)(p.ws + OFF_WIN), t, tile);
    else if (t < 864) transpose_w(p.in[I_WGLU], 512, 512, 512, (h16*)(p.ws + OFF_WGLU), t - 800, tile);
    else if (t < 1120) transpose_w(p.in[I_WOUT], 1024, 1024, 1024, (h16*)(p.ws + OFF_WOUT), t - 864, tile);
    else if (t < 1184) transpose_w(p.in[I_WPP], 256, 1024, 1024, (h16*)(p.ws + OFF_WPP), t - 1120, tile);
    else transpose_w(p.in[I_WGATE], 1024, 1024, 1024, (h16*)(p.ws + OFF_WGATE), t - 1184, tile);
  }
  for (int it = bid; it < 32 * 33; it += nb) ssm_table_item(p, it / 33, it % 33, (float*)smem);
  {
    h16* A0 = (h16*)((unsigned char*)p.out + OUT_OFF_A0);
    const float* x = p.in[I_X];
    const float4* g4 = (const float4*)p.in[I_NMG];
    for (int row = bid * 4 + wid; row < T_TOK; row += nb * 4) {
      const float4* xr = (const float4*)(x + (size_t)row * 1024);
      float4 v[4];
      float ss = 0.f;
#pragma unroll
      for (int i = 0; i < 4; ++i) {
        v[i] = xr[lane + i * 64];
        ss += v[i].x * v[i].x + v[i].y * v[i].y + v[i].z * v[i].z + v[i].w * v[i].w;
      }
      ss = wave_sum(ss);
      float rstd = rsqrtf(ss * (1.f / 1024.f) + 1e-6f);
#pragma unroll
      for (int i = 0; i < 4; ++i) {
        float4 g = g4[lane + i * 64];
        h16x4 o;
        o[0] = (h16)(v[i].x * rstd * g.x); o[1] = (h16)(v[i].y * rstd * g.y);
        o[2] = (h16)(v[i].z * rstd * g.z); o[3] = (h16)(v[i].w * rstd * g.w);
        *(h16x4*)(A0 + (size_t)row * 1024 + (lane + i * 64) * 4) = o;
      }
    }
  }
  {
    h16* PB = (h16*)(p.ws + OFF_PB);
    const float4* p4 = (const float4*)p.in[I_P];
    const size_t n4 = (size_t)T_TOK * 256 / 4;
    for (size_t i = (size_t)bid * 256 + tid; i < n4; i += (size_t)nb * 256) {
      float4 v = p4[i];
      h16x4 o;
      o[0] = (h16)v.x; o[1] = (h16)v.y; o[2] = (h16)v.z; o[3] = (h16)v.w;
      *(h16x4*)(PB + i * 4) = o;
    }
  }
}

enum { EPI_PROJ = 0, EPI_GLU, EPI_PLE, EPI_OUT, EPI_GATE };

template <int EPI>
__device__ __forceinline__ void gemm_tile(const Params& p, const h16* __restrict__ A, int lda, const h16* __restrict__ Bt, int ldb,
                                          int K, int brow, int bcol, unsigned char* smem) {
  const int tid = threadIdx.x, wid = tid >> 6, lane = tid & 63, wr = wid >> 1, wc = wid & 1, fr = lane & 15, fq = lane >> 4;
  unsigned char* SA = smem;
  unsigned char* SB = smem + 128 * 32 * 2;
  f32x4 acc[4][4];
#pragma unroll
  for (int m = 0; m < 4; ++m)
#pragma unroll
    for (int n = 0; n < 4; ++n) acc[m][n] = f32x4{0.f, 0.f, 0.f, 0.f};
  const int nk = K / 32;
  for (int t = 0; t < nk; ++t) {
#pragma unroll
    for (int i = 0; i < 2; ++i) {
      int b = tid * 16 + i * 4096, r = b >> 6, c = (b & 63) >> 1;
      __builtin_amdgcn_global_load_lds((const unsigned*)(A + (size_t)(brow + r) * lda + t * 32 + c), (unsigned*)(SA + b), 16, 0, 0);
      __builtin_amdgcn_global_load_lds((const unsigned*)(Bt + (size_t)(bcol + r) * ldb + t * 32 + c), (unsigned*)(SB + b), 16, 0, 0);
    }
    asm volatile("s_waitcnt vmcnt(0)" ::: "memory");
    __syncthreads();
    h16x8 af[4], bf[4];
#pragma unroll
    for (int m = 0; m < 4; ++m) {
      af[m] = *(const h16x8*)(SA + (wr * 64 + m * 16 + fr) * 64 + fq * 16);
      bf[m] = *(const h16x8*)(SB + (wc * 64 + m * 16 + fr) * 64 + fq * 16);
    }
#pragma unroll
    for (int m = 0; m < 4; ++m)
#pragma unroll
      for (int n = 0; n < 4; ++n) acc[m][n] = MFMA(af[m], bf[n], acc[m][n]);
    __syncthreads();
  }
  if constexpr (EPI == EPI_PROJ) {
    h16* PROJ = (h16*)(p.ws + OFF_PROJ);
    float* AB = (float*)(p.ws + OFF_AB);
#pragma unroll
    for (int m = 0; m < 4; ++m)
#pragma unroll
      for (int n = 0; n < 4; ++n) {
        const int col = bcol + wc * 64 + n * 16 + fr;
#pragma unroll
        for (int j = 0; j < 4; ++j) {
          const size_t row = brow + wr * 64 + m * 16 + fq * 4 + j;
          if (col < 3072) PROJ[row * LDP + col] = (h16)acc[m][n][j];
          else if (col < 3080) AB[row * 8 + (col - 3072)] = acc[m][n][j];
        }
      }
  } else if constexpr (EPI == EPI_GLU) {
    const h16* PROJ = (const h16*)(p.ws + OFF_PROJ);
    const h16* YPRE = (const h16*)((unsigned char*)p.out + OUT_OFF_YPRE);
    h16* MIXIN = (h16*)(p.ws + OFF_MIXIN);
    const float* bglu = p.in[I_BGLU];
#pragma unroll
    for (int m = 0; m < 4; ++m)
#pragma unroll
      for (int n = 0; n < 4; ++n) {
        const int col = bcol + wc * 64 + n * 16 + fr;
        const float bb = bglu[col];
#pragma unroll
        for (int j = 0; j < 4; ++j) {
          const size_t row = brow + wr * 64 + m * 16 + fq * 4 + j;
          float y = (float)YPRE[row * 512 + col];
          float z = (float)PROJ[row * LDP + 512 + col];
          float o = y * sigmoidf_(acc[m][n][j] + bb) * siluf_(z);
          MIXIN[row * 1024 + col] = (h16)o;
        }
      }
  } else if constexpr (EPI == EPI_PLE) {
    h16* EH = (h16*)(p.ws + OFF_EH);
    float* EPART = (float*)(p.ws + OFF_EPART);
#pragma unroll
    for (int m = 0; m < 4; ++m) {
#pragma unroll
      for (int j = 0; j < 4; ++j) {
        const size_t row = brow + wr * 64 + m * 16 + fq * 4 + j;
        float s = 0.f;
#pragma unroll
        for (int n = 0; n < 4; ++n) {
          const int col = bcol + wc * 64 + n * 16 + fr;
          float v = acc[m][n][j];
          s += v * v;
          EH[row * 1024 + col] = (h16)v;
        }
        s = sum16(s);
        if (fr == 0) EPART[row * 16 + (bcol >> 7) * 2 + wc] = s;
      }
    }
  } else if constexpr (EPI == EPI_OUT) {
    const float* x = p.in[I_X];
    h16* HB = (h16*)(p.ws + OFF_PROJ);
#pragma unroll
    for (int m = 0; m < 4; ++m)
#pragma unroll
      for (int n = 0; n < 4; ++n) {
        const int col = bcol + wc * 64 + n * 16 + fr;
#pragma unroll
        for (int j = 0; j < 4; ++j) {
          const size_t row = brow + wr * 64 + m * 16 + fq * 4 + j;
          float hv = x[row * 1024 + col] + acc[m][n][j];
          p.out[row * 1024 + col] = hv;
          HB[row * 1024 + col] = (h16)hv;
        }
      }
  } else if constexpr (EPI == EPI_GATE) {
    const h16* EH = (const h16*)(p.ws + OFF_EH);
    const float* EPART = (const float*)(p.ws + OFF_EPART);
    float* OPART = (float*)(p.ws + OFF_OPART);
    const float* pg = p.in[I_PLEG];
    float* sr = (float*)smem;
    if (tid < 128) {
      const float* ep = EPART + (size_t)(brow + tid) * 16;
      float s = 0.f;
#pragma unroll
      for (int i = 0; i < 16; ++i) s += ep[i];
      sr[tid] = rsqrtf(s * (1.f / 1024.f) + 1e-6f);
    }
    __syncthreads();
#pragma unroll
    for (int m = 0; m < 4; ++m) {
#pragma unroll
      for (int j = 0; j < 4; ++j) {
        const int rl = wr * 64 + m * 16 + fq * 4 + j;
        const size_t row = brow + rl;
        const float rs = sr[rl];
        float s = 0.f;
#pragma unroll
        for (int n = 0; n < 4; ++n) {
          const int col = bcol + wc * 64 + n * 16 + fr;
          float gate = sigmoidf_(acc[m][n][j]);
          float e = (float)EH[row * 1024 + col] * rs * pg[col];
          float h2 = p.out[row * 1024 + col] + gate * e;
          p.out[row * 1024 + col] = h2;
          s += h2 * h2;
        }
        s = sum16(s);
        if (fr == 0) OPART[row * 16 + (bcol >> 7) * 2 + wc] = s;
      }
    }
    __syncthreads();
  }
}

__device__ void ssm_item(const Params& p, int b, int g, unsigned char* smem) {
  float* LOCAL = (float*)smem;
  h16* SPREV = (h16*)(smem + 64 * 132 * 4);
  const int tid = threadIdx.x, w = tid >> 6, lane = tid & 63, fr = lane & 15, fq = lane >> 4;
  const h16* PROJ = (const h16*)(p.ws + OFF_PROJ);
  const h16* Eg = (const h16*)(p.ws + OFF_ETAB) + (size_t)g * 128 * 512;
  const h16* Kg = (const h16*)(p.ws + OFF_KTAB) + (size_t)g * 33 * 256;
  const h16* Fg = (const h16*)(p.ws + OFF_FTAB) + (size_t)g * 512 * 128;
  const float* ALPOW = (const float*)(p.ws + OFF_ALPOW);
  h16* YPRE = (h16*)((unsigned char*)p.out + OUT_OFF_YPRE);
  const int nchunk = w * 16 + fr;
  const size_t tok0 = (size_t)b * SEQ + (size_t)nchunk * 32;
  h16x8 uf[16];
#pragma unroll
  for (int ks = 0; ks < 16; ++ks) {
    const int i = 2 * ks + (fq >> 1);
    uf[ks] = *(const h16x8*)(PROJ + (tok0 + i) * LDP + g * 16 + (fq & 1) * 8);
  }
  for (int mt = 0; mt < 8; ++mt) {
    f32x4 acc = {0.f, 0.f, 0.f, 0.f};
#pragma unroll
    for (int ks = 0; ks < 16; ++ks) {
      h16x8 a = *(const h16x8*)(Eg + (size_t)(mt * 16 + fr) * 512 + ks * 32 + fq * 8);
      acc = MFMA(a, uf[ks], acc);
    }
    *(f32x4*)(LOCAL + nchunk * 132 + mt * 16 + fq * 4) = acc;
  }
  __syncthreads();
  if (tid < 64) {
    const int pp = tid;
    const float ar = ALPOW[(g * 64 + pp) * 2], ai = ALPOW[(g * 64 + pp) * 2 + 1];
    float sr = 0.f, si = 0.f;
    for (int c = 0; c < 64; ++c) {
      SPREV[c * 136 + pp] = (h16)sr;
      SPREV[c * 136 + 64 + pp] = (h16)si;
      float lr = LOCAL[c * 132 + pp], li = LOCAL[c * 132 + 64 + pp];
      float nr = ar * sr - ai * si + lr;
      float ni = ar * si + ai * sr + li;
      sr = nr; si = ni;
    }
  }
  __syncthreads();
  h16x8 sf[4];
#pragma unroll
  for (int ks = 0; ks < 4; ++ks) sf[ks] = *(const h16x8*)(SPREV + nchunk * 136 + ks * 32 + fq * 8);
  const float4 Dv = *(const float4*)(p.in[I_D] + g * 16 + fq * 4);
#pragma unroll 1
  for (int j = 0; j < 32; ++j) {
    f32x4 acc = {0.f, 0.f, 0.f, 0.f};
#pragma unroll
    for (int ks = 0; ks < 16; ++ks) {
      if (2 * ks <= j) {
        const int dd = j - 2 * ks - (fq >> 1) + 1;
        h16x8 a = *(const h16x8*)(Kg + dd * 256 + fr * 16 + (fq & 1) * 8);
        acc = MFMA(a, uf[ks], acc);
      }
    }
#pragma unroll
    for (int ks = 0; ks < 4; ++ks) {
      h16x8 a = *(const h16x8*)(Fg + (size_t)(j * 16 + fr) * 128 + ks * 32 + fq * 8);
      acc = MFMA(a, sf[ks], acc);
    }
    const size_t tok = tok0 + j;
    h16x4 u4 = *(const h16x4*)(PROJ + tok * LDP + g * 16 + fq * 4);
    h16x4 o;
    o[0] = (h16)gelu_tanh(acc[0] + Dv.x * (float)u4[0]);
    o[1] = (h16)gelu_tanh(acc[1] + Dv.y * (float)u4[1]);
    o[2] = (h16)gelu_tanh(acc[2] + Dv.z * (float)u4[2]);
    o[3] = (h16)gelu_tanh(acc[3] + Dv.w * (float)u4[3]);
    *(h16x4*)(YPRE + tok * 512 + g * 16 + fq * 4) = o;
  }
  __syncthreads();
}

__device__ void gdn_pre_item(const Params& p, int item, unsigned char* smem) {
  h16* QH = (h16*)smem;
  h16* KH = (h16*)(smem + 17408);
  h16* VH = (h16*)(smem + 34816);
  float* LT = (float*)(smem + 52224);
  float* sG = (float*)(smem + 69632);
  float* sBeta = (float*)(smem + 69888);
  const int tid = threadIdx.x, w = tid >> 6, lane = tid & 63, fr = lane & 15, fq = lane >> 4;
  const int c = item & 31, h = (item >> 5) & 3, b = item >> 7;
  const h16* PROJ = (const h16*)(p.ws + OFF_PROJ);
  const float* AB = (const float*)(p.ws + OFF_AB);
  const float* convw = p.in[I_CONVW];
  h16* WPi = (h16*)(p.ws + OFF_WP) + (size_t)item * 64 * 128;
  h16* QGPi = (h16*)(p.ws + OFF_QGP) + (size_t)item * 64 * 128;
  h16* KDTi = (h16*)(p.ws + OFF_KDT) + (size_t)item * 128 * 64;
  h16* UTi = (h16*)(p.ws + OFF_UT) + (size_t)item * 128 * 64;
  h16* ATPi = (h16*)(p.ws + OFF_ATP) + (size_t)item * 64 * 64;
  float* DL = (float*)(p.ws + OFF_DL);
  {
    const int ch0 = (tid & 15) * 8, trow = tid >> 4;
#pragma unroll 1
    for (int pass = 0; pass < 4; ++pass) {
      const int t = pass * 16 + trow, tl = c * 64 + t;
#pragma unroll
      for (int sec = 0; sec < 3; ++sec) {
        const int colbase = 1024 + sec * 512 + h * 128 + ch0;
        float a[8];
#pragma unroll
        for (int e = 0; e < 8; ++e) a[e] = 0.f;
#pragma unroll
        for (int jj = 0; jj < 4; ++jj) {
          const int ts = tl - 3 + jj;
          if (ts >= 0) {
            h16x8 xv = *(const h16x8*)(PROJ + ((size_t)b * SEQ + ts) * LDP + colbase);
            const float4 w0 = *(const float4*)(convw + jj * 1536 + sec * 512 + h * 128 + ch0);
            const float4 w1 = *(const float4*)(convw + jj * 1536 + sec * 512 + h * 128 + ch0 + 4);
            a[0] += w0.x * (float)xv[0]; a[1] += w0.y * (float)xv[1]; a[2] += w0.z * (float)xv[2]; a[3] += w0.w * (float)xv[3];
            a[4] += w1.x * (float)xv[4]; a[5] += w1.y * (float)xv[5]; a[6] += w1.z * (float)xv[6]; a[7] += w1.w * (float)xv[7];
          }
        }
        float ss = 0.f;
#pragma unroll
        for (int e = 0; e < 8; ++e) { a[e] = siluf_(a[e]); ss += a[e] * a[e]; }
        float scale = 1.f;
        if (sec < 2) {
          ss = sum16(ss);
          scale = rsqrtf(ss + 1e-6f) * (sec == 0 ? 0.08838834764831845f : 1.f);
        }
        h16x8 o;
#pragma unroll
        for (int e = 0; e < 8; ++e) o[e] = (h16)(a[e] * scale);
        h16* dst = (sec == 0 ? QH : (sec == 1 ? KH : VH));
        *(h16x8*)(dst + t * 136 + ch0) = o;
      }
    }
  }
  if (tid < 64) {
    const size_t tok = (size_t)b * SEQ + c * 64 + tid;
    float braw = AB[tok * 8 + h], araw = AB[tok * 8 + 4 + h];
    float beta = 1.f / (1.f + expf(-braw));
    float xx = araw + p.in[I_DTB][h];
    float sp = xx > 20.f ? xx : log1pf(expf(xx));
    float gg = -expf(p.in[I_ALOG][h]) * sp;
#pragma unroll
    for (int o = 1; o < 64; o <<= 1) {
      float v = __shfl_up(gg, o);
      if (lane >= o) gg += v;
    }
    sG[tid] = gg;
    sBeta[tid] = beta;
  }
  __syncthreads();
  {
    h16x8 ak[4], aq[4];
#pragma unroll
    for (int ks = 0; ks < 4; ++ks) {
      ak[ks] = *(const h16x8*)(KH + (w * 16 + fr) * 136 + ks * 32 + fq * 8);
      aq[ks] = *(const h16x8*)(QH + (w * 16 + fr) * 136 + ks * 32 + fq * 8);
    }
#pragma unroll
    for (int jt = 0; jt < 4; ++jt) {
      const int j = jt * 16 + fr;
      const int pj = perm_pos(j);
      if (jt <= w) {
        f32x4 kk = {0.f, 0.f, 0.f, 0.f}, qk = {0.f, 0.f, 0.f, 0.f};
#pragma unroll
        for (int ks = 0; ks < 4; ++ks) {
          h16x8 bk = *(const h16x8*)(KH + (jt * 16 + fr) * 136 + ks * 32 + fq * 8);
          kk = MFMA(ak[ks], bk, kk);
          qk = MFMA(aq[ks], bk, qk);
        }
        const float Gj = sG[j];
        f32x4 lt;
#pragma unroll
        for (int r = 0; r < 4; ++r) {
          const int i = w * 16 + 4 * fq + r;
          const float e = (i >= j) ? expf(sG[i] - Gj) : 0.f;
          lt[r] = (i > j) ? sBeta[i] * kk[r] * e : 0.f;
          ATPi[i * 64 + pj] = (h16)(qk[r] * e);
        }
        *(f32x4*)(LT + j * 68 + w * 16 + 4 * fq) = lt;
      } else {
#pragma unroll
        for (int r = 0; r < 4; ++r) {
          const int i = w * 16 + 4 * fq + r;
          ATPi[i * 64 + pj] = (h16)0.f;
        }
      }
    }
  }
  __syncthreads();
  float r[64];
  if (tid < 128) {
#pragma unroll
    for (int t = 0; t < 64; ++t) r[t] = (float)VH[t * 136 + tid] * sBeta[t];
  } else {
#pragma unroll
    for (int t = 0; t < 64; ++t) r[t] = (float)KH[t * 136 + (tid - 128)] * sBeta[t] * expf(sG[t]);
  }
#pragma unroll
  for (int j = 0; j < 63; ++j) {
    const float xj = r[j];
#pragma unroll
    for (int i4 = (j + 1) / 4; i4 < 16; ++i4) {
      const f32x4 l = *(const f32x4*)(LT + j * 68 + i4 * 4);
#pragma unroll
      for (int e = 0; e < 4; ++e) {
        if (i4 * 4 + e > j) r[i4 * 4 + e] -= l[e] * xj;
      }
    }
    __builtin_amdgcn_sched_barrier(0);
  }
  if (tid < 128) {
#pragma unroll
    for (int t8 = 0; t8 < 8; ++t8) {
      h16x8 v;
#pragma unroll
      for (int e = 0; e < 8; ++e) v[e] = (h16)r[t8 * 8 + e];
      *(h16x8*)(UTi + (size_t)tid * 64 + t8 * 8) = v;
    }
  }
  __syncthreads();
  if (tid >= 128) {
    const int pos = perm_pos(tid - 128);
#pragma unroll
    for (int t = 0; t < 64; ++t) VH[t * 136 + pos] = (h16)r[t];
  }
  __syncthreads();
  for (int rr = 0; rr < 4; ++rr) {
    const int idx = tid + 256 * rr, row = idx >> 4, seg = idx & 15;
    *(h16x8*)(WPi + row * 128 + seg * 8) = *(const h16x8*)(VH + row * 136 + seg * 8);
  }
#pragma unroll 2
  for (int rr = 0; rr < 32; ++rr) {
    const int idx = tid + 256 * rr, t = idx >> 7, pp = idx & 127;
    const int dk = perm_inv(pp);
    QGPi[t * 128 + pp] = (h16)((float)QH[t * 136 + dk] * expf(sG[t]));
  }
  const float Glast = sG[63];
#pragma unroll 2
  for (int rr = 0; rr < 32; ++rr) {
    const int idx = tid + 256 * rr, dk = idx >> 6, tp = idx & 63;
    const int t = perm_inv(tp);
    KDTi[dk * 64 + tp] = (h16)((float)KH[t * 136 + dk] * expf(Glast - sG[t]));
  }
  if (tid == 0) DL[item] = expf(Glast);
  __syncthreads();
}

__device__ void gdn_recurrence(const Params& p, int bh, unsigned char* smem) {
  float* red = (float*)smem;
  const int tid = threadIdx.x, w = tid >> 6, lane = tid & 63, fr = lane & 15, fq = lane >> 4;
  const int b = bh >> 2, h = bh & 3;
  const h16* PROJ = (const h16*)(p.ws + OFF_PROJ);
  h16* MIXIN = (h16*)(p.ws + OFF_MIXIN);
  const float* DL = (const float*)(p.ws + OFF_DL);
  const float* ng = p.in[I_DNG];
  const float ng0 = ng[w * 32 + fr], ng1 = ng[w * 32 + 16 + fr];
  f32x4 S[8][2];
#pragma unroll
  for (int i = 0; i < 8; ++i) { S[i][0] = f32x4{0.f, 0.f, 0.f, 0.f}; S[i][1] = f32x4{0.f, 0.f, 0.f, 0.f}; }
  for (int c = 0; c < 32; ++c) {
    const int item = bh * 32 + c;
    const h16* WPi = (const h16*)(p.ws + OFF_WP) + (size_t)item * 64 * 128;
    const h16* QGPi = (const h16*)(p.ws + OFF_QGP) + (size_t)item * 64 * 128;
    const h16* KDTi = (const h16*)(p.ws + OFF_KDT) + (size_t)item * 128 * 64;
    const h16* UTi = (const h16*)(p.ws + OFF_UT) + (size_t)item * 128 * 64;
    const h16* ATPi = (const h16*)(p.ws + OFF_ATP) + (size_t)item * 64 * 64;
    const float dl = DL[item];
    h16x8 sfr[4][2];
#pragma unroll
    for (int ks = 0; ks < 4; ++ks) { sfr[ks][0] = pack8(S[2 * ks][0], S[2 * ks + 1][0]); sfr[ks][1] = pack8(S[2 * ks][1], S[2 * ks + 1][1]); }
    f32x4 vn[4][2], o[4][2];
#pragma unroll
    for (int mt = 0; mt < 4; ++mt) {
      f32x4 a0 = {0.f, 0.f, 0.f, 0.f}, a1 = {0.f, 0.f, 0.f, 0.f}, o0 = {0.f, 0.f, 0.f, 0.f}, o1 = {0.f, 0.f, 0.f, 0.f};
#pragma unroll
      for (int ks = 0; ks < 4; ++ks) {
        h16x8 aw = *(const h16x8*)(WPi + (mt * 16 + fr) * 128 + ks * 32 + fq * 8);
        h16x8 aq = *(const h16x8*)(QGPi + (mt * 16 + fr) * 128 + ks * 32 + fq * 8);
        a0 = MFMA(aw, sfr[ks][0], a0);
        a1 = MFMA(aw, sfr[ks][1], a1);
        o0 = MFMA(aq, sfr[ks][0], o0);
        o1 = MFMA(aq, sfr[ks][1], o1);
      }
      h16x4 u0 = *(const h16x4*)(UTi + (size_t)(w * 32 + fr) * 64 + mt * 16 + fq * 4);
      h16x4 u1 = *(const h16x4*)(UTi + (size_t)(w * 32 + 16 + fr) * 64 + mt * 16 + fq * 4);
#pragma unroll
      for (int r = 0; r < 4; ++r) { a0[r] = (float)u0[r] - a0[r]; a1[r] = (float)u1[r] - a1[r]; }
      vn[mt][0] = a0; vn[mt][1] = a1; o[mt][0] = o0; o[mt][1] = o1;
    }
    h16x8 vfr[2][2];
#pragma unroll
    for (int k2 = 0; k2 < 2; ++k2) { vfr[k2][0] = pack8(vn[2 * k2][0], vn[2 * k2 + 1][0]); vfr[k2][1] = pack8(vn[2 * k2][1], vn[2 * k2 + 1][1]); }
#pragma unroll
    for (int mt = 0; mt < 4; ++mt) {
#pragma unroll
      for (int k2 = 0; k2 < 2; ++k2) {
        h16x8 aa = *(const h16x8*)(ATPi + (mt * 16 + fr) * 64 + k2 * 32 + fq * 8);
        o[mt][0] = MFMA(aa, vfr[k2][0], o[mt][0]);
        o[mt][1] = MFMA(aa, vfr[k2][1], o[mt][1]);
      }
    }
#pragma unroll
    for (int dkt = 0; dkt < 8; ++dkt) {
      f32x4 s0 = S[dkt][0], s1 = S[dkt][1];
#pragma unroll
      for (int r = 0; r < 4; ++r) { s0[r] *= dl; s1[r] *= dl; }
#pragma unroll
      for (int k2 = 0; k2 < 2; ++k2) {
        h16x8 ak = *(const h16x8*)(KDTi + (dkt * 16 + fr) * 64 + k2 * 32 + fq * 8);
        s0 = MFMA(ak, vfr[k2][0], s0);
        s1 = MFMA(ak, vfr[k2][1], s1);
      }
      S[dkt][0] = s0; S[dkt][1] = s1;
    }
#pragma unroll
    for (int mt = 0; mt < 4; ++mt)
#pragma unroll
      for (int r = 0; r < 4; ++r) {
        float s = o[mt][0][r] * o[mt][0][r] + o[mt][1][r] * o[mt][1][r];
        s = sum16(s);
        if (fr == 0) red[w * 64 + mt * 16 + 4 * fq + r] = s;
      }
    __syncthreads();
#pragma unroll
    for (int mt = 0; mt < 4; ++mt)
#pragma unroll
      for (int r = 0; r < 4; ++r) {
        const int tl = mt * 16 + 4 * fq + r;
        const float tot = red[tl] + red[64 + tl] + red[128 + tl] + red[192 + tl];
        const float rstd = rsqrtf(tot * (1.f / 128.f) + 1e-6f);
        const size_t tok = (size_t)b * SEQ + c * 64 + tl;
        const h16* zp = PROJ + tok * LDP + 2560 + h * 128 + w * 32 + fr;
        h16* yp = MIXIN + tok * 1024 + 512 + h * 128 + w * 32 + fr;
        yp[0] = (h16)(o[mt][0][r] * rstd * ng0 * siluf_((float)zp[0]));
        yp[16] = (h16)(o[mt][1][r] * rstd * ng1 * siluf_((float)zp[16]));
      }
    __syncthreads();
  }
}

#define RUNPH(n) (p.ph_lo <= (n) && (n) <= p.ph_hi)
#define SYNCPH(n) do { if (p.ph_lo <= (n) && (n) < p.ph_hi) grid.sync(); } while (0)
__global__ void __launch_bounds__(256, 2) hymba_mega(Params p) {
  __shared__ __attribute__((aligned(16))) unsigned char smem[SMEM_BYTES];
  cg::grid_group grid = cg::this_grid();
  const int bid = blockIdx.x, nb = gridDim.x;
  {
    if (RUNPH(0)) {
      phase0(p, smem);
    }
    SYNCPH(0);
    if (RUNPH(1)) {
      const h16* A0 = (const h16*)((unsigned char*)p.out + OUT_OFF_A0);
      const h16* W = (const h16*)(p.ws + OFF_WIN);
      for (int t = bid; t < 256 * 25; t += nb) gemm_tile<EPI_PROJ>(p, A0, 1024, W, 1024, 1024, (t / 25) * 128, (t % 25) * 128, smem);
    }
    SYNCPH(1);
    if (RUNPH(2)) {
      for (int it = bid; it < 512 + 2048; it += nb) {
        if (it < 2048) gdn_pre_item(p, it, smem);
        else ssm_item(p, (it - 2048) >> 5, (it - 2048) & 31, smem);
      }
    }
    SYNCPH(2);
    if (RUNPH(3)) {
      const int nrec = 64;
      if (bid < nrec) for (int it = bid; it < nrec; it += nb) gdn_recurrence(p, it, smem);
      if (nb <= nrec || bid >= nrec) {
        const int start = nb > nrec ? bid - nrec : bid, step = nb > nrec ? nb - nrec : nb;
        const h16* YPRE = (const h16*)((unsigned char*)p.out + OUT_OFF_YPRE);
        for (int t = start; t < 1024 + 2048; t += step) {
          if (t < 1024) gemm_tile<EPI_GLU>(p, YPRE, 512, (const h16*)(p.ws + OFF_WGLU), 512, 512, (t >> 2) * 128, (t & 3) * 128, smem);
          else gemm_tile<EPI_PLE>(p, (const h16*)(p.ws + OFF_PB), 256, (const h16*)(p.ws + OFF_WPP), 256, 256, ((t - 1024) >> 3) * 128, ((t - 1024) & 7) * 128, smem);
        }
      }
    }
    SYNCPH(3);
    if (RUNPH(4)) {
      for (int t = bid; t < 2048; t += nb)
        gemm_tile<EPI_OUT>(p, (const h16*)(p.ws + OFF_MIXIN), 1024, (const h16*)(p.ws + OFF_WOUT), 1024, 1024, (t >> 3) * 128, (t & 7) * 128, smem);
    }
    SYNCPH(4);
    if (RUNPH(5)) {
      for (int t = bid; t < 2048; t += nb)
        gemm_tile<EPI_GATE>(p, (const h16*)(p.ws + OFF_PROJ), 1024, (const h16*)(p.ws + OFF_WGATE), 1024, 1024, (t >> 3) * 128, (t & 7) * 128, smem);
    }
    SYNCPH(5);
    if (RUNPH(6)) {
      const int wid = threadIdx.x >> 6, lane = threadIdx.x & 63;
      const float* OPART = (const float*)(p.ws + OFF_OPART);
      const float4* g4 = (const float4*)p.in[I_FING];
      for (int row = bid * 4 + wid; row < T_TOK; row += nb * 4) {
        float s = (lane < 16) ? OPART[(size_t)row * 16 + lane] : 0.f;
        s = wave_sum(s);
        const float rstd = rsqrtf(s * (1.f / 1024.f) + 1e-6f);
        float4* orow = (float4*)(p.out + (size_t)row * 1024);
#pragma unroll
        for (int i = 0; i < 4; ++i) {
          float4 v = orow[lane + i * 64];
          float4 g = g4[lane + i * 64];
          v.x *= rstd * g.x; v.y *= rstd * g.y; v.z *= rstd * g.z; v.w *= rstd * g.w;
          orow[lane + i * 64] = v;
        }
      }
    }
  }
}

extern "C" void kernel_launch(void* const* d_in, const int* in_sizes, int n_in, void* d_out, int out_size, void* d_ws, size_t ws_size,
                              hipStream_t stream) {
  static int grid_blocks = 0;
  if (!grid_blocks) {
    int dev = 0, cus = 0, per_cu = 0;
    hipGetDevice(&dev);
    hipDeviceGetAttribute(&cus, hipDeviceAttributeMultiprocessorCount, dev);
    hipOccupancyMaxActiveBlocksPerMultiprocessor(&per_cu, hymba_mega, 256, 0);
    if (per_cu > 2) per_cu = 2;
    if (per_cu < 1) per_cu = 1;
    grid_blocks = cus * per_cu;
  }
  if (n_in != 23 || ws_size < WS_END || out_size != T_TOK * 1024) {
    fprintf(stderr, "kernel_launch: unexpected sizes n_in=%d ws=%zu (need %zu) out=%d\n", n_in, ws_size, (size_t)WS_END, out_size);
    return;
  }
  Params p{};
  for (int i = 0; i < 23; ++i) p.in[i] = (const float*)d_in[i];
  p.out = (float*)d_out;
  p.ws = (unsigned char*)d_ws;
#if MULTI_LAUNCH
  for (int ph = 0; ph < NPH; ++ph) {
    p.ph_lo = ph; p.ph_hi = ph;
    hipLaunchKernelGGL(hymba_mega, dim3(grid_blocks), dim3(256), 0, stream, p);
  }
#else
  p.ph_lo = 0; p.ph_hi = NPH - 1;
  void* args[] = {&p};
  hipError_t e = hipLaunchCooperativeKernel((void*)hymba_mega, dim3(grid_blocks), dim3(256), args, 0, stream);
  if (e != hipSuccess) fprintf(stderr, "cooperative launch failed: %s (grid %d)\n", hipGetErrorString(e), grid_blocks);
#endif
}
```

```cpp
#include <hip/hip_runtime.h>
#include <hip/hip_cooperative_groups.h>
#include <cstdio>
namespace cg = cooperative_groups;

#ifndef MULTI_LAUNCH
#define MULTI_LAUNCH 0
#endif

typedef _Float16 h16;
typedef __attribute__((ext_vector_type(8))) _Float16 h16x8;
typedef __attribute__((ext_vector_type(4))) _Float16 h16x4;
typedef __attribute__((ext_vector_type(4))) float f32x4;

#define MFMA(a, b, c) __builtin_amdgcn_mfma_f32_16x16x32_f16((a), (b), (c), 0, 0, 0)

constexpr int T_TOK = 32768;
constexpr int SEQ = 2048;
constexpr int NPH = 7;
constexpr int LDP = 3072;
constexpr int SMEM_BYTES = 70400;

constexpr size_t SZ_WIN = (size_t)3200 * 1024 * 2;
constexpr size_t SZ_WGLU = (size_t)512 * 512 * 2;
constexpr size_t SZ_WOUT = (size_t)1024 * 1024 * 2;
constexpr size_t SZ_WPP = (size_t)1024 * 256 * 2;
constexpr size_t SZ_WGATE = (size_t)1024 * 1024 * 2;
constexpr size_t OFF_WIN = 0;
constexpr size_t OFF_WGLU = OFF_WIN + SZ_WIN;
constexpr size_t OFF_WOUT = OFF_WGLU + SZ_WGLU;
constexpr size_t OFF_WPP = OFF_WOUT + SZ_WOUT;
constexpr size_t OFF_WGATE = OFF_WPP + SZ_WPP;
constexpr size_t OFF_PB = OFF_WGATE + SZ_WGATE;
constexpr size_t OFF_PROJ = OFF_PB + (size_t)T_TOK * 256 * 2;
constexpr size_t OFF_AB = OFF_PROJ + (size_t)T_TOK * LDP * 2;
constexpr size_t OFF_KTAB = OFF_AB + (size_t)T_TOK * 8 * 4;
constexpr size_t OFF_ETAB = OFF_KTAB + (size_t)32 * 33 * 256 * 2;
constexpr size_t OFF_FTAB = OFF_ETAB + (size_t)32 * 128 * 512 * 2;
constexpr size_t OFF_ALPOW = OFF_FTAB + (size_t)32 * 512 * 128 * 2;
constexpr size_t OFF_DL = OFF_ALPOW + (size_t)32 * 64 * 2 * 4;
constexpr size_t OFF_EPART = OFF_DL + (size_t)2048 * 4;
constexpr size_t OFF_OPART = OFF_EPART + (size_t)T_TOK * 16 * 4;
constexpr size_t OFF_MIXIN = OFF_OPART + (size_t)T_TOK * 16 * 4;
constexpr size_t OFF_WP = OFF_MIXIN + (size_t)T_TOK * 1024 * 2;
constexpr size_t OFF_QGP = OFF_WP + (size_t)2048 * 64 * 128 * 2;
constexpr size_t OFF_KDT = OFF_QGP + (size_t)2048 * 64 * 128 * 2;
constexpr size_t OFF_UT = OFF_KDT + (size_t)2048 * 128 * 64 * 2;
constexpr size_t OFF_ATP = OFF_UT + (size_t)2048 * 128 * 64 * 2;
constexpr size_t OFF_EH = OFF_ATP + (size_t)2048 * 64 * 64 * 2;
constexpr size_t WS_END = OFF_EH + (size_t)T_TOK * 1024 * 2;
constexpr size_t OUT_OFF_A0 = 0;
constexpr size_t OUT_OFF_YPRE = (size_t)T_TOK * 1024 * 2;

struct Params {
  const float* in[23];
  float* out;
  unsigned char* ws;
  int ph_lo, ph_hi;
};

enum { I_X = 0, I_P, I_NMG, I_WIN, I_ARE, I_AIM, I_BRE, I_BIM, I_CRE, I_CIM, I_D, I_LOGDT, I_WGLU, I_BGLU,
       I_CONVW, I_ALOG, I_DTB, I_DNG, I_WOUT, I_WPP, I_PLEG, I_WGATE, I_FING };

__device__ __forceinline__ float wave_sum(float v) {
#pragma unroll
  for (int o = 32; o > 0; o >>= 1) v += __shfl_xor(v, o);
  return v;
}
__device__ __forceinline__ float sum16(float v) {
  v += __shfl_xor(v, 1); v += __shfl_xor(v, 2); v += __shfl_xor(v, 4); v += __shfl_xor(v, 8);
  return v;
}
__device__ __forceinline__ float sigmoidf_(float x) { return 1.f / (1.f + __expf(-x)); }
__device__ __forceinline__ float siluf_(float x) { return x / (1.f + __expf(-x)); }
__device__ __forceinline__ float gelu_tanh(float y) {
  float z = 0.7978845608028654f * (y + 0.044715f * y * y * y);
  return 0.5f * y * (1.f + tanhf(z));
}
__device__ __forceinline__ h16x8 pack8(f32x4 lo, f32x4 hi) {
  h16x8 r;
  r[0] = (h16)lo[0]; r[1] = (h16)lo[1]; r[2] = (h16)lo[2]; r[3] = (h16)lo[3];
  r[4] = (h16)hi[0]; r[5] = (h16)hi[1]; r[6] = (h16)hi[2]; r[7] = (h16)hi[3];
  return r;
}
__device__ __forceinline__ int perm_pos(int n) { return (n & ~31) + (((n & 15) >> 2) << 3) + (((n >> 4) & 1) << 2) + (n & 3); }
__device__ __forceinline__ int perm_inv(int pos) {
  int q5 = pos & 31, qq = q5 >> 3, jj = q5 & 7;
  return (pos & ~31) + (jj < 4 ? 4 * qq + jj : 16 + 4 * qq + (jj - 4));
}

__device__ void transpose_w(const float* __restrict__ W, int K, int N, int Npad, h16* __restrict__ WT, int t, float* tile) {
  const int ntn = Npad / 64;
  const int kt = t / ntn, nt = t % ntn, k0 = kt * 64, n0 = nt * 64;
  const int tx = threadIdx.x & 63, ty = threadIdx.x >> 6;
  for (int r = 0; r < 16; ++r) {
    int k = ty * 16 + r, n = n0 + tx;
    tile[k * 65 + tx] = (n < N) ? W[(size_t)(k0 + k) * N + n] : 0.f;
  }
  __syncthreads();
  for (int r = 0; r < 16; ++r) {
    int n = ty * 16 + r;
    WT[(size_t)(n0 + n) * K + k0 + tx] = (h16)tile[tx * 65 + n];
  }
  __syncthreads();
}

__device__ void ssm_table_item(const Params& p, int g, int d, float* lds) {
  float2* sAp = (float2*)lds;
  float2* sW = sAp + 64;
  const int tid = threadIdx.x;
  h16* KTAB = (h16*)(p.ws + OFF_KTAB);
  h16* ETAB = (h16*)(p.ws + OFF_ETAB);
  h16* FTAB = (h16*)(p.ws + OFF_FTAB);
  float* ALPOW = (float*)(p.ws + OFF_ALPOW);
  const float* B_re = p.in[I_BRE]; const float* B_im = p.in[I_BIM];
  const float* C_re = p.in[I_CRE]; const float* C_im = p.in[I_CIM];
  if (tid < 64) {
    const int pp = tid;
    float lr = p.in[I_ARE][g * 64 + pp], li = p.in[I_AIM][g * 64 + pp], dt = expf(p.in[I_LOGDT][g]);
    float mag = expf(lr * dt), ang = li * dt;
    float abr = mag * cosf(ang), abi = mag * sinf(ang);
    float nr = abr - 1.f, ni = abi, den = lr * lr + li * li;
    float cr = (nr * lr + ni * li) / den, ci = (ni * lr - nr * li) / den;
    float apr = 1.f, api = 0.f;
    for (int k = 0; k < d; ++k) { float t0 = apr * abr - api * abi; api = apr * abi + api * abr; apr = t0; }
    sAp[pp] = make_float2(apr, api);
    sW[pp] = make_float2(apr * cr - api * ci, apr * ci + api * cr);
    if (d == 32) { ALPOW[(g * 64 + pp) * 2] = apr; ALPOW[(g * 64 + pp) * 2 + 1] = api; }
  }
  __syncthreads();
  if (d < 32) {
    {
      const int h = tid >> 4, hp = tid & 15;
      float acc = 0.f;
      for (int pp = 0; pp < 64; ++pp) {
        float2 W = sW[pp];
        float br = B_re[(g * 64 + pp) * 16 + hp], bi = B_im[(g * 64 + pp) * 16 + hp];
        float wbr = W.x * br - W.y * bi, wbi = W.x * bi + W.y * br;
        float cr = C_re[(g * 16 + h) * 64 + pp], ci = C_im[(g * 16 + h) * 64 + pp];
        acc += cr * wbr - ci * wbi;
      }
      KTAB[(size_t)(g * 33 + d + 1) * 256 + h * 16 + hp] = (h16)acc;
      if (d == 0) KTAB[(size_t)(g * 33) * 256 + tid] = (h16)0.f;
    }
    {
      const int i = 31 - d;
      for (int r = 0; r < 4; ++r) {
        int idx = tid + 256 * r, pp = idx >> 4, hp = idx & 15;
        float2 W = sW[pp];
        float br = B_re[(g * 64 + pp) * 16 + hp], bi = B_im[(g * 64 + pp) * 16 + hp];
        float wbr = W.x * br - W.y * bi, wbi = W.x * bi + W.y * br;
        ETAB[((size_t)g * 128 + pp) * 512 + i * 16 + hp] = (h16)wbr;
        ETAB[((size_t)g * 128 + 64 + pp) * 512 + i * 16 + hp] = (h16)wbi;
      }
    }
  }
  if (d >= 1) {
    const int j = d - 1;
    for (int r = 0; r < 4; ++r) {
      int idx = tid + 256 * r, h = idx >> 6, pp = idx & 63;
      float2 Ap = sAp[pp];
      float cr = C_re[(g * 16 + h) * 64 + pp], ci = C_im[(g * 16 + h) * 64 + pp];
      float re = cr * Ap.x - ci * Ap.y, im = cr * Ap.y + ci * Ap.x;
      FTAB[((size_t)g * 512 + j * 16 + h) * 128 + pp] = (h16)re;
      FTAB[((size_t)g * 512 + j * 16 + h) * 128 + 64 + pp] = (h16)(-im);
    }
  }
  __syncthreads();
}

__device__ void phase0(const Params& p, unsigned char* smem) {
  const int bid = blockIdx.x, nb = gridDim.x, tid = threadIdx.x, wid = tid >> 6, lane = tid & 63;
  float* tile = (float*)smem;
  for (int t = bid; t < 1440; t += nb) {
    if (t < 800) transpose_w(p.in[I_WIN], 1024, 3080, 3200, (h16*)(p.ws + OFF_WIN), t, tile);
    else if (t < 864) transpose_w(p.in[I_WGLU], 512, 512, 512, (h16*)(p.ws + OFF_WGLU), t - 800, tile);
    else if (t < 1120) transpose_w(p.in[I_WOUT], 1024, 1024, 1024, (h16*)(p.ws + OFF_WOUT), t - 864, tile);
    else if (t < 1184) transpose_w(p.in[I_WPP], 256, 1024, 1024, (h16*)(p.ws + OFF_WPP), t - 1120, tile);
    else transpose_w(p.in[I_WGATE], 1024, 1024, 1024, (h16*)(p.ws + OFF_WGATE), t - 1184, tile);
  }
  for (int it = bid; it < 32 * 33; it += nb) ssm_table_item(p, it / 33, it % 33, (float*)smem);
  {
    h16* A0 = (h16*)((unsigned char*)p.out + OUT_OFF_A0);
    const float* x = p.in[I_X];
    const float4* g4 = (const float4*)p.in[I_NMG];
    for (int row = bid * 4 + wid; row < T_TOK; row += nb * 4) {
      const float4* xr = (const float4*)(x + (size_t)row * 1024);
      float4 v[4];
      float ss = 0.f;
#pragma unroll
      for (int i = 0; i < 4; ++i) {
        v[i] = xr[lane + i * 64];
        ss += v[i].x * v[i].x + v[i].y * v[i].y + v[i].z * v[i].z + v[i].w * v[i].w;
      }
      ss = wave_sum(ss);
      float rstd = rsqrtf(ss * (1.f / 1024.f) + 1e-6f);
#pragma unroll
      for (int i = 0; i < 4; ++i) {
        float4 g = g4[lane + i * 64];
        h16x4 o;
        o[0] = (h16)(v[i].x * rstd * g.x); o[1] = (h16)(v[i].y * rstd * g.y);
        o[2] = (h16)(v[i].z * rstd * g.z); o[3] = (h16)(v[i].w * rstd * g.w);
        *(h16x4*)(A0 + (size_t)row * 1024 + (lane + i * 64) * 4) = o;
      }
    }
  }
  {
    h16* PB = (h16*)(p.ws + OFF_PB);
    const float4* p4 = (const float4*)p.in[I_P];
    const size_t n4 = (size_t)T_TOK * 256 / 4;
    for (size_t i = (size_t)bid * 256 + tid; i < n4; i += (size_t)nb * 256) {
      float4 v = p4[i];
      h16x4 o;
      o[0] = (h16)v.x; o[1] = (h16)v.y; o[2] = (h16)v.z; o[3] = (h16)v.w;
      *(h16x4*)(PB + i * 4) = o;
    }
  }
}

enum { EPI_PROJ = 0, EPI_GLU, EPI_PLE, EPI_OUT, EPI_GATE };

template <int EPI>
__device__ __forceinline__ void gemm_tile(const Params& p, const h16* __restrict__ A, int lda, const h16* __restrict__ Bt, int ldb,
                                          int K, int brow, int bcol, unsigned char* smem) {
  const int tid = threadIdx.x, wid = tid >> 6, lane = tid & 63, wr = wid >> 1, wc = wid & 1, fr = lane & 15, fq = lane >> 4;
  unsigned char* SA = smem;
  unsigned char* SB = smem + 128 * 32 * 2;
  f32x4 acc[4][4];
#pragma unroll
  for (int m = 0; m < 4; ++m)
#pragma unroll
    for (int n = 0; n < 4; ++n) acc[m][n] = f32x4{0.f, 0.f, 0.f, 0.f};
  const int nk = K / 32;
  for (int t = 0; t < nk; ++t) {
#pragma unroll
    for (int i = 0; i < 2; ++i) {
      int b = tid * 16 + i * 4096, r = b >> 6, c = (b & 63) >> 1;
      __builtin_amdgcn_global_load_lds((const unsigned*)(A + (size_t)(brow + r) * lda + t * 32 + c), (unsigned*)(SA + b), 16, 0, 0);
      __builtin_amdgcn_global_load_lds((const unsigned*)(Bt + (size_t)(bcol + r) * ldb + t * 32 + c), (unsigned*)(SB + b), 16, 0, 0);
    }
    asm volatile("s_waitcnt vmcnt(0)" ::: "memory");
    __syncthreads();
    h16x8 af[4], bf[4];
#pragma unroll
    for (int m = 0; m < 4; ++m) {
      af[m] = *(const h16x8*)(SA + (wr * 64 + m * 16 + fr) * 64 + fq * 16);
      bf[m] = *(const h16x8*)(SB + (wc * 64 + m * 16 + fr) * 64 + fq * 16);
    }
#pragma unroll
    for (int m = 0; m < 4; ++m)
#pragma unroll
      for (int n = 0; n < 4; ++n) acc[m][n] = MFMA(af[m], bf[n], acc[m][n]);
    __syncthreads();
  }
  if constexpr (EPI == EPI_PROJ) {
    h16* PROJ = (h16*)(p.ws + OFF_PROJ);
    float* AB = (float*)(p.ws + OFF_AB);
#pragma unroll
    for (int m = 0; m < 4; ++m)
#pragma unroll
      for (int n = 0; n < 4; ++n) {
        const int col = bcol + wc * 64 + n * 16 + fr;
#pragma unroll
        for (int j = 0; j < 4; ++j) {
          const size_t row = brow + wr * 64 + m * 16 + fq * 4 + j;
          if (col < 3072) PROJ[row * LDP + col] = (h16)acc[m][n][j];
          else if (col < 3080) AB[row * 8 + (col - 3072)] = acc[m][n][j];
        }
      }
  } else if constexpr (EPI == EPI_GLU) {
    const h16* PROJ = (const h16*)(p.ws + OFF_PROJ);
    const h16* YPRE = (const h16*)((unsigned char*)p.out + OUT_OFF_YPRE);
    h16* MIXIN = (h16*)(p.ws + OFF_MIXIN);
    const float* bglu = p.in[I_BGLU];
#pragma unroll
    for (int m = 0; m < 4; ++m)
#pragma unroll
      for (int n = 0; n < 4; ++n) {
        const int col = bcol + wc * 64 + n * 16 + fr;
        const float bb = bglu[col];
#pragma unroll
        for (int j = 0; j < 4; ++j) {
          const size_t row = brow + wr * 64 + m * 16 + fq * 4 + j;
          float y = (float)YPRE[row * 512 + col];
          float z = (float)PROJ[row * LDP + 512 + col];
          float o = y * sigmoidf_(acc[m][n][j] + bb) * siluf_(z);
          MIXIN[row * 1024 + col] = (h16)o;
        }
      }
  } else if constexpr (EPI == EPI_PLE) {
    h16* EH = (h16*)(p.ws + OFF_EH);
    float* EPART = (float*)(p.ws + OFF_EPART);
#pragma unroll
    for (int m = 0; m < 4; ++m) {
#pragma unroll
      for (int j = 0; j < 4; ++j) {
        const size_t row = brow + wr * 64 + m * 16 + fq * 4 + j;
        float s = 0.f;
#pragma unroll
        for (int n = 0; n < 4; ++n) {
          const int col = bcol + wc * 64 + n * 16 + fr;
          float v = acc[m][n][j];
          s += v * v;
          EH[row * 1024 + col] = (h16)v;
        }
        s = sum16(s);
        if (fr == 0) EPART[row * 16 + (bcol >> 7) * 2 + wc] = s;
      }
    }
  } else if constexpr (EPI == EPI_OUT) {
    const float* x = p.in[I_X];
    h16* HB = (h16*)(p.ws + OFF_PROJ);
#pragma unroll
    for (int m = 0; m < 4; ++m)
#pragma unroll
      for (int n = 0; n < 4; ++n) {
        const int col = bcol + wc * 64 + n * 16 + fr;
#pragma unroll
        for (int j = 0; j < 4; ++j) {
          const size_t row = brow + wr * 64 + m * 16 + fq * 4 + j;
          float hv = x[row * 1024 + col] + acc[m][n][j];
          p.out[row * 1024 + col] = hv;
          HB[row * 1024 + col] = (h16)hv;
        }
      }
  } else if constexpr (EPI == EPI_GATE) {
    const h16* EH = (const h16*)(p.ws + OFF_EH);
    const float* EPART = (const float*)(p.ws + OFF_EPART);
    float* OPART = (float*)(p.ws + OFF_OPART);
    const float* pg = p.in[I_PLEG];
    float* sr = (float*)smem;
    if (tid < 128) {
      const float* ep = EPART + (size_t)(brow + tid) * 16;
      float s = 0.f;
#pragma unroll
      for (int i = 0; i < 16; ++i) s += ep[i];
      sr[tid] = rsqrtf(s * (1.f / 1024.f) + 1e-6f);
    }
    __syncthreads();
#pragma unroll
    for (int m = 0; m < 4; ++m) {
#pragma unroll
      for (int j = 0; j < 4; ++j) {
        const int rl = wr * 64 + m * 16 + fq * 4 + j;
        const size_t row = brow + rl;
        const float rs = sr[rl];
        float s = 0.f;
#pragma unroll
        for (int n = 0; n < 4; ++n) {
          const int col = bcol + wc * 64 + n * 16 + fr;
          float gate = sigmoidf_(acc[m][n][j]);
          float e = (float)EH[row * 1024 + col] * rs * pg[col];
          float h2 = p.out[row * 1024 + col] + gate * e;
          p.out[row * 1024 + col] = h2;
          s += h2 * h2;
        }
        s = sum16(s);
        if (fr == 0) OPART[row * 16 + (bcol >> 7) * 2 + wc] = s;
      }
    }
    __syncthreads();
  }
}

__device__ void ssm_item(const Params& p, int b, int g, unsigned char* smem) {
  float* LOCAL = (float*)smem;
  h16* SPREV = (h16*)(smem + 64 * 132 * 4);
  const int tid = threadIdx.x, w = tid >> 6, lane = tid & 63, fr = lane & 15, fq = lane >> 4;
  const h16* PROJ = (const h16*)(p.ws + OFF_PROJ);
  const h16* Eg = (const h16*)(p.ws + OFF_ETAB) + (size_t)g * 128 * 512;
  const h16* Kg = (const h16*)(p.ws + OFF_KTAB) + (size_t)g * 33 * 256;
  const h16* Fg = (const h16*)(p.ws + OFF_FTAB) + (size_t)g * 512 * 128;
  const float* ALPOW = (const float*)(p.ws + OFF_ALPOW);
  h16* YPRE = (h16*)((unsigned char*)p.out + OUT_OFF_YPRE);
  const int nchunk = w * 16 + fr;
  const size_t tok0 = (size_t)b * SEQ + (size_t)nchunk * 32;
  h16x8 uf[16];
#pragma unroll
  for (int ks = 0; ks < 16; ++ks) {
    const int i = 2 * ks + (fq >> 1);
    uf[ks] = *(const h16x8*)(PROJ + (tok0 + i) * LDP + g * 16 + (fq & 1) * 8);
  }
  for (int mt = 0; mt < 8; ++mt) {
    f32x4 acc = {0.f, 0.f, 0.f, 0.f};
#pragma unroll
    for (int ks = 0; ks < 16; ++ks) {
      h16x8 a = *(const h16x8*)(Eg + (size_t)(mt * 16 + fr) * 512 + ks * 32 + fq * 8);
      acc = MFMA(a, uf[ks], acc);
    }
    *(f32x4*)(LOCAL + nchunk * 132 + mt * 16 + fq * 4) = acc;
  }
  __syncthreads();
  if (tid < 64) {
    const int pp = tid;
    const float ar = ALPOW[(g * 64 + pp) * 2], ai = ALPOW[(g * 64 + pp) * 2 + 1];
    float sr = 0.f, si = 0.f;
    for (int c = 0; c < 64; ++c) {
      SPREV[c * 136 + pp] = (h16)sr;
      SPREV[c * 136 + 64 + pp] = (h16)si;
      float lr = LOCAL[c * 132 + pp], li = LOCAL[c * 132 + 64 + pp];
      float nr = ar * sr - ai * si + lr;
      float ni = ar * si + ai * sr + li;
      sr = nr; si = ni;
    }
  }
  __syncthreads();
  h16x8 sf[4];
#pragma unroll
  for (int ks = 0; ks < 4; ++ks) sf[ks] = *(const h16x8*)(SPREV + nchunk * 136 + ks * 32 + fq * 8);
  const float4 Dv = *(const float4*)(p.in[I_D] + g * 16 + fq * 4);
#pragma unroll 1
  for (int j = 0; j < 32; ++j) {
    f32x4 acc = {0.f, 0.f, 0.f, 0.f};
#pragma unroll
    for (int ks = 0; ks < 16; ++ks) {
      if (2 * ks <= j) {
        const int dd = j - 2 * ks - (fq >> 1) + 1;
        h16x8 a = *(const h16x8*)(Kg + dd * 256 + fr * 16 + (fq & 1) * 8);
        acc = MFMA(a, uf[ks], acc);
      }
    }
#pragma unroll
    for (int ks = 0; ks < 4; ++ks) {
      h16x8 a = *(const h16x8*)(Fg + (size_t)(j * 16 + fr) * 128 + ks * 32 + fq * 8);
      acc = MFMA(a, sf[ks], acc);
    }
    const size_t tok = tok0 + j;
    h16x4 u4 = *(const h16x4*)(PROJ + tok * LDP + g * 16 + fq * 4);
    h16x4 o;
    o[0] = (h16)gelu_tanh(acc[0] + Dv.x * (float)u4[0]);
    o[1] = (h16)gelu_tanh(acc[1] + Dv.y * (float)u4[1]);
    o[2] = (h16)gelu_tanh(acc[2] + Dv.z * (float)u4[2]);
    o[3] = (h16)gelu_tanh(acc[3] + Dv.w * (float)u4[3]);
    *(h16x4*)(YPRE + tok * 512 + g * 16 + fq * 4) = o;
  }
  __syncthreads();
}

__device__ void gdn_pre_item(const Params& p, int item, unsigned char* smem) {
  h16* QH = (h16*)smem;
  h16* KH = (h16*)(smem + 17408);
  h16* VH = (h16*)(smem + 34816);
  float* LT = (float*)(smem + 52224);
  float* sG = (float*)(smem + 69632);
  float* sBeta = (float*)(smem + 69888);
  const int tid = threadIdx.x, w = tid >> 6, lane = tid & 63, fr = lane & 15, fq = lane >> 4;
  const int c = item & 31, h = (item >> 5) & 3, b = item >> 7;
  const h16* PROJ = (const h16*)(p.ws + OFF_PROJ);
  const float* AB = (const float*)(p.ws + OFF_AB);
  const float* convw = p.in[I_CONVW];
  h16* WPi = (h16*)(p.ws + OFF_WP) + (size_t)item * 64 * 128;
  h16* QGPi = (h16*)(p.ws + OFF_QGP) + (size_t)item * 64 * 128;
  h16* KDTi = (h16*)(p.ws + OFF_KDT) + (size_t)item * 128 * 64;
  h16* UTi = (h16*)(p.ws + OFF_UT) + (size_t)item * 128 * 64;
  h16* ATPi = (h16*)(p.ws + OFF_ATP) + (size_t)item * 64 * 64;
  float* DL = (float*)(p.ws + OFF_DL);
  {
    const int ch0 = (tid & 15) * 8, trow = tid >> 4;
#pragma unroll 1
    for (int pass = 0; pass < 4; ++pass) {
      const int t = pass * 16 + trow, tl = c * 64 + t;
#pragma unroll
      for (int sec = 0; sec < 3; ++sec) {
        const int colbase = 1024 + sec * 512 + h * 128 + ch0;
        float a[8];
#pragma unroll
        for (int e = 0; e < 8; ++e) a[e] = 0.f;
#pragma unroll
        for (int jj = 0; jj < 4; ++jj) {
          const int ts = tl - 3 + jj;
          if (ts >= 0) {
            h16x8 xv = *(const h16x8*)(PROJ + ((size_t)b * SEQ + ts) * LDP + colbase);
            const float4 w0 = *(const float4*)(convw + jj * 1536 + sec * 512 + h * 128 + ch0);
            const float4 w1 = *(const float4*)(convw + jj * 1536 + sec * 512 + h * 128 + ch0 + 4);
            a[0] += w0.x * (float)xv[0]; a[1] += w0.y * (float)xv[1]; a[2] += w0.z * (float)xv[2]; a[3] += w0.w * (float)xv[3];
            a[4] += w1.x * (float)xv[4]; a[5] += w1.y * (float)xv[5]; a[6] += w1.z * (float)xv[6]; a[7] += w1.w * (float)xv[7];
          }
        }
        float ss = 0.f;
#pragma unroll
        for (int e = 0; e < 8; ++e) { a[e] = siluf_(a[e]); ss += a[e] * a[e]; }
        float scale = 1.f;
        if (sec < 2) {
          ss = sum16(ss);
          scale = rsqrtf(ss + 1e-6f) * (sec == 0 ? 0.08838834764831845f : 1.f);
        }
        h16x8 o;
#pragma unroll
        for (int e = 0; e < 8; ++e) o[e] = (h16)(a[e] * scale);
        h16* dst = (sec == 0 ? QH : (sec == 1 ? KH : VH));
        *(h16x8*)(dst + t * 136 + ch0) = o;
      }
    }
  }
  if (tid < 64) {
    const size_t tok = (size_t)b * SEQ + c * 64 + tid;
    float braw = AB[tok * 8 + h], araw = AB[tok * 8 + 4 + h];
    float beta = 1.f / (1.f + expf(-braw));
    float xx = araw + p.in[I_DTB][h];
    float sp = xx > 20.f ? xx : log1pf(expf(xx));
    float gg = -expf(p.in[I_ALOG][h]) * sp;
#pragma unroll
    for (int o = 1; o < 64; o <<= 1) {
      float v = __shfl_up(gg, o);
      if (lane >= o) gg += v;
    }
    sG[tid] = gg;
    sBeta[tid] = beta;
  }
  __syncthreads();
  {
    h16x8 ak[4], aq[4];
#pragma unroll
    for (int ks = 0; ks < 4; ++ks) {
      ak[ks] = *(const h16x8*)(KH + (w * 16 + fr) * 136 + ks * 32 + fq * 8);
      aq[ks] = *(const h16x8*)(QH + (w * 16 + fr) * 136 + ks * 32 + fq * 8);
    }
#pragma unroll
    for (int jt = 0; jt < 4; ++jt) {
      const int j = jt * 16 + fr;
      const int pj = perm_pos(j);
      if (jt <= w) {
        f32x4 kk = {0.f, 0.f, 0.f, 0.f}, qk = {0.f, 0.f, 0.f, 0.f};
#pragma unroll
        for (int ks = 0; ks < 4; ++ks) {
          h16x8 bk = *(const h16x8*)(KH + (jt * 16 + fr) * 136 + ks * 32 + fq * 8);
          kk = MFMA(ak[ks], bk, kk);
          qk = MFMA(aq[ks], bk, qk);
        }
        const float Gj = sG[j];
        f32x4 lt;
#pragma unroll
        for (int r = 0; r < 4; ++r) {
          const int i = w * 16 + 4 * fq + r;
          const float e = (i >= j) ? expf(sG[i] - Gj) : 0.f;
          lt[r] = (i > j) ? sBeta[i] * kk[r] * e : 0.f;
          ATPi[i * 64 + pj] = (h16)(qk[r] * e);
        }
        *(f32x4*)(LT + j * 68 + w * 16 + 4 * fq) = lt;
      } else {
#pragma unroll
        for (int r = 0; r < 4; ++r) {
          const int i = w * 16 + 4 * fq + r;
          ATPi[i * 64 + pj] = (h16)0.f;
        }
      }
    }
  }
  __syncthreads();
  float r[64];
  if (tid < 128) {
#pragma unroll
    for (int t = 0; t < 64; ++t) r[t] = (float)VH[t * 136 + tid] * sBeta[t];
  } else {
#pragma unroll
    for (int t = 0; t < 64; ++t) r[t] = (float)KH[t * 136 + (tid - 128)] * sBeta[t] * expf(sG[t]);
  }
#pragma unroll
  for (int j = 0; j < 63; ++j) {
    const float xj = r[j];
#pragma unroll
    for (int i4 = (j + 1) / 4; i4 < 16; ++i4) {
      const f32x4 l = *(const f32x4*)(LT + j * 68 + i4 * 4);
#pragma unroll
      for (int e = 0; e < 4; ++e) {
        if (i4 * 4 + e > j) r[i4 * 4 + e] -= l[e] * xj;
      }
    }
    __builtin_amdgcn_sched_barrier(0);
  }
  if (tid < 128) {
#pragma unroll
    for (int t8 = 0; t8 < 8; ++t8) {
      h16x8 v;
#pragma unroll
      for (int e = 0; e < 8; ++e) v[e] = (h16)r[t8 * 8 + e];
      *(h16x8*)(UTi + (size_t)tid * 64 + t8 * 8) = v;
    }
  }
  __syncthreads();
  if (tid >= 128) {
    const int pos = perm_pos(tid - 128);
#pragma unroll
    for (int t = 0; t < 64; ++t) VH[t * 136 + pos] = (h16)r[t];
  }
  __syncthreads();
  for (int rr = 0; rr < 4; ++rr) {
    const int idx = tid + 256 * rr, row = idx >> 4, seg = idx & 15;
    *(h16x8*)(WPi + row * 128 + seg * 8) = *(const h16x8*)(VH + row * 136 + seg * 8);
  }
#pragma unroll 2
  for (int rr = 0; rr < 32; ++rr) {
    const int idx = tid + 256 * rr, t = idx >> 7, pp = idx & 127;
    const int dk = perm_inv(pp);
    QGPi[t * 128 + pp] = (h16)((float)QH[t * 136 + dk] * expf(sG[t]));
  }
  const float Glast = sG[63];
#pragma unroll 2
  for (int rr = 0; rr < 32; ++rr) {
    const int idx = tid + 256 * rr, dk = idx >> 6, tp = idx & 63;
    const int t = perm_inv(tp);
    KDTi[dk * 64 + tp] = (h16)((float)KH[t * 136 + dk] * expf(Glast - sG[t]));
  }
  if (tid == 0) DL[item] = expf(Glast);
  __syncthreads();
}

__device__ void gdn_recurrence(const Params& p, int bh, unsigned char* smem) {
  float* red = (float*)smem;
  const int tid = threadIdx.x, w = tid >> 6, lane = tid & 63, fr = lane & 15, fq = lane >> 4;
  const int b = bh >> 2, h = bh & 3;
  const h16* PROJ = (const h16*)(p.ws + OFF_PROJ);
  h16* MIXIN = (h16*)(p.ws + OFF_MIXIN);
  const float* DL = (const float*)(p.ws + OFF_DL);
  const float* ng = p.in[I_DNG];
  const float ng0 = ng[w * 32 + fr], ng1 = ng[w * 32 + 16 + fr];
  f32x4 S[8][2];
#pragma unroll
  for (int i = 0; i < 8; ++i) { S[i][0] = f32x4{0.f, 0.f, 0.f, 0.f}; S[i][1] = f32x4{0.f, 0.f, 0.f, 0.f}; }
  for (int c = 0; c < 32; ++c) {
    const int item = bh * 32 + c;
    const h16* WPi = (const h16*)(p.ws + OFF_WP) + (size_t)item * 64 * 128;
    const h16* QGPi = (const h16*)(p.ws + OFF_QGP) + (size_t)item * 64 * 128;
    const h16* KDTi = (const h16*)(p.ws + OFF_KDT) + (size_t)item * 128 * 64;
    const h16* UTi = (const h16*)(p.ws + OFF_UT) + (size_t)item * 128 * 64;
    const h16* ATPi = (const h16*)(p.ws + OFF_ATP) + (size_t)item * 64 * 64;
    const float dl = DL[item];
    h16x8 sfr[4][2];
#pragma unroll
    for (int ks = 0; ks < 4; ++ks) { sfr[ks][0] = pack8(S[2 * ks][0], S[2 * ks + 1][0]); sfr[ks][1] = pack8(S[2 * ks][1], S[2 * ks + 1][1]); }
    f32x4 vn[4][2], o[4][2];
#pragma unroll
    for (int mt = 0; mt < 4; ++mt) {
      f32x4 a0 = {0.f, 0.f, 0.f, 0.f}, a1 = {0.f, 0.f, 0.f, 0.f}, o0 = {0.f, 0.f, 0.f, 0.f}, o1 = {0.f, 0.f, 0.f, 0.f};
#pragma unroll
      for (int ks = 0; ks < 4; ++ks) {
        h16x8 aw = *(const h16x8*)(WPi + (mt * 16 + fr) * 128 + ks * 32 + fq * 8);
        h16x8 aq = *(const h16x8*)(QGPi + (mt * 16 + fr) * 128 + ks * 32 + fq * 8);
        a0 = MFMA(aw, sfr[ks][0], a0);
        a1 = MFMA(aw, sfr[ks][1], a1);
        o0 = MFMA(aq, sfr[ks][0], o0);
        o1 = MFMA(aq, sfr[ks][1], o1);
      }
      h16x4 u0 = *(const h16x4*)(UTi + (size_t)(w * 32 + fr) * 64 + mt * 16 + fq * 4);
      h16x4 u1 = *(const h16x4*)(UTi + (size_t)(w * 32 + 16 + fr) * 64 + mt * 16 + fq * 4);
#pragma unroll
      for (int r = 0; r < 4; ++r) { a0[r] = (float)u0[r] - a0[r]; a1[r] = (float)u1[r] - a1[r]; }
      vn[mt][0] = a0; vn[mt][1] = a1; o[mt][0] = o0; o[mt][1] = o1;
    }
    h16x8 vfr[2][2];
#pragma unroll
    for (int k2 = 0; k2 < 2; ++k2) { vfr[k2][0] = pack8(vn[2 * k2][0], vn[2 * k2 + 1][0]); vfr[k2][1] = pack8(vn[2 * k2][1], vn[2 * k2 + 1][1]); }
#pragma unroll
    for (int mt = 0; mt < 4; ++mt) {
#pragma unroll
      for (int k2 = 0; k2 < 2; ++k2) {
        h16x8 aa = *(const h16x8*)(ATPi + (mt * 16 + fr) * 64 + k2 * 32 + fq * 8);
        o[mt][0] = MFMA(aa, vfr[k2][0], o[mt][0]);
        o[mt][1] = MFMA(aa, vfr[k2][1], o[mt][1]);
      }
    }
#pragma unroll
    for (int dkt = 0; dkt < 8; ++dkt) {
      f32x4 s0 = S[dkt][0], s1 = S[dkt][1];
#pragma unroll
      for (int r = 0; r < 4; ++r) { s0[r] *= dl; s1[r] *= dl; }
#pragma unroll
      for (int k2 = 0; k2 < 2; ++k2) {
        h16x8 ak = *(const h16x8*)(KDTi + (dkt * 16 + fr) * 64 + k2 * 32 + fq * 8);
        s0 = MFMA(ak, vfr[k2][0], s0);
        s1 = MFMA(ak, vfr[k2][1], s1);
      }
      S[dkt][0] = s0; S[dkt][1] = s1;
    }
#pragma unroll
    for (int mt = 0; mt < 4; ++mt)
#pragma unroll
      for (int r = 0; r < 4; ++r) {
        float s = o[mt][0][r] * o[mt][0][r] + o[mt][1][r] * o[mt][1][r];
        s = sum16(s);
        if (fr == 0) red[w * 64 + mt * 16 + 4 * fq + r] = s;
      }
    __syncthreads();
#pragma unroll
    for (int mt = 0; mt < 4; ++mt)
#pragma unroll
      for (int r = 0; r < 4; ++r) {
        const int tl = mt * 16 + 4 * fq + r;
        const float tot = red[tl] + red[64 + tl] + red[128 + tl] + red[192 + tl];
        const float rstd = rsqrtf(tot * (1.f / 128.f) + 1e-6f);
        const size_t tok = (size_t)b * SEQ + c * 64 + tl;
        const h16* zp = PROJ + tok * LDP + 2560 + h * 128 + w * 32 + fr;
        h16* yp = MIXIN + tok * 1024 + 512 + h * 128 + w * 32 + fr;
        yp[0] = (h16)(o[mt][0][r] * rstd * ng0 * siluf_((float)zp[0]));
        yp[16] = (h16)(o[mt][1][r] * rstd * ng1 * siluf_((float)zp[16]));
      }
    __syncthreads();
  }
}

#define RUNPH(n) (p.ph_lo <= (n) && (n) <= p.ph_hi)
#define SYNCPH(n) do { if (p.ph_lo <= (n) && (n) < p.ph_hi) grid.sync(); } while (0)
__global__ void __launch_bounds__(256, 2) hymba_mega(Params p) {
  __shared__ __attribute__((aligned(16))) unsigned char smem[SMEM_BYTES];
  cg::grid_group grid = cg::this_grid();
  const int bid = blockIdx.x, nb = gridDim.x;
  {
    if (RUNPH(0)) {
      phase0(p, smem);
    }
    SYNCPH(0);
    if (RUNPH(1)) {
      const h16* A0 = (const h16*)((unsigned char*)p.out + OUT_OFF_A0);
      const h16* W = (const h16*)(p.ws + OFF_WIN);
      for (int t = bid; t < 256 * 25; t += nb) gemm_tile<EPI_PROJ>(p, A0, 1024, W, 1024, 1024, (t / 25) * 128, (t % 25) * 128, smem);
    }
    SYNCPH(1);
    if (RUNPH(2)) {
      for (int it = bid; it < 512 + 2048; it += nb) {
        if (it < 2048) gdn_pre_item(p, it, smem);
        else ssm_item(p, (it - 2048) >> 5, (it - 2048) & 31, smem);
      }
    }
    SYNCPH(2);
    if (RUNPH(3)) {
      const int nrec = 64;
      if (bid < nrec) for (int it = bid; it < nrec; it += nb) gdn_recurrence(p, it, smem);
      if (nb <= nrec || bid >= nrec) {
        const int start = nb > nrec ? bid - nrec : bid, step = nb > nrec ? nb - nrec : nb;
        const h16* YPRE = (const h16*)((unsigned char*)p.out + OUT_OFF_YPRE);
        for (int t = start; t < 1024 + 2048; t += step) {
          if (t < 1024) gemm_tile<EPI_GLU>(p, YPRE, 512, (const h16*)(p.ws + OFF_WGLU), 512, 512, (t >> 2) * 128, (t & 3) * 128, smem);
          else gemm_tile<EPI_PLE>(p, (const h16*)(p.ws + OFF_PB), 256, (const h16*)(p.ws + OFF_WPP), 256, 256, ((t - 1024) >> 3) * 128, ((t - 1024) & 7) * 128, smem);
        }
      }
    }
    SYNCPH(3);
    if (RUNPH(4)) {
      for (int t = bid; t < 2048; t += nb)
        gemm_tile<EPI_OUT>(p, (const h16*)(p.ws + OFF_MIXIN), 1024, (const h16*)(p.ws + OFF_WOUT), 1024, 1024, (t >> 3) * 128, (t & 7) * 128, smem);
    }
    SYNCPH(4);
    if (RUNPH(5)) {
      for (int t = bid; t < 2048; t += nb)
        gemm_tile<EPI_GATE>(p, (const h16*)(p.ws + OFF_PROJ), 1024, (const h16*)(p.ws + OFF_WGATE), 1024, 1024, (t >> 3) * 128, (t & 7) * 128, smem);
    }
    SYNCPH(5);
    if (RUNPH(6)) {
      const int wid = threadIdx.x >> 6, lane = threadIdx.x & 63;
      const float* OPART = (const float*)(p.ws + OFF_OPART);
      const float4* g4 = (const float4*)p.in[I_FING];
      for (int row = bid * 4 + wid; row < T_TOK; row += nb * 4) {
        float s = (lane < 16) ? OPART[(size_t)row * 16 + lane] : 0.f;
        s = wave_sum(s);
        const float rstd = rsqrtf(s * (1.f / 1024.f) + 1e-6f);
        float4* orow = (float4*)(p.out + (size_t)row * 1024);
#pragma unroll
        for (int i = 0; i < 4; ++i) {
          float4 v = orow[lane + i * 64];
          float4 g = g4[lane + i * 64];
          v.x *= rstd * g.x; v.y *= rstd * g.y; v.z *= rstd * g.z; v.w *= rstd * g.w;
          orow[lane + i * 64] = v;
        }
      }
    }
  }
}

extern "C" void kernel_launch(void* const* d_in, const int* in_sizes, int n_in, void* d_out, int out_size, void* d_ws, size_t ws_size,
                              hipStream_t stream) {
  static int grid_blocks = 0;
  if (!grid_blocks) {
    int dev = 0, cus = 0, per_cu = 0;
    hipGetDevice(&dev);
    hipDeviceGetAttribute(&cus, hipDeviceAttributeMultiprocessorCount, dev);
    hipOccupancyMaxActiveBlocksPerMultiprocessor(&per_cu, hymba_mega, 256, 0);
    if (per_cu > 2) per_cu = 2;
    if (per_cu < 1) per_cu = 1;
    grid_blocks = cus * per_cu;
  }
  if (n_in != 23 || ws_size < WS_END || out_size != T_TOK * 1024) {
    fprintf(stderr, "kernel_launch: unexpected sizes n_in=%d ws=%zu (need %zu) out=%d\n", n_in, ws_size, (size_t)WS_END, out_size);
    return;
  }
  Params p{};
  for (int i = 0; i < 23; ++i) p.in[i] = (const float*)d_in[i];
  p.out = (float*)d_out;
  p.ws = (unsigned char*)d_ws;
#if MULTI_LAUNCH
  for (int ph = 0; ph < NPH; ++ph) {
    p.ph_lo = ph; p.ph_hi = ph;
    hipLaunchKernelGGL(hymba_mega, dim3(grid_blocks), dim3(256), 0, stream, p);
  }
#else
  p.ph_lo = 0; p.ph_hi = NPH - 1;
  void* args[] = {&p};
  hipError_t e = hipLaunchCooperativeKernel((void*)hymba_mega, dim3(grid_blocks), dim3(256), args, 0, stream);
  if (e != hipSuccess) fprintf(stderr, "cooperative launch failed: %s (grid %d)\n", hipGetErrorString(e), grid_blocks);
#endif
}
```

```cpp
#include <hip/hip_runtime.h>
#include <hip/hip_cooperative_groups.h>
#include <cstdio>
namespace cg = cooperative_groups;

#ifndef REP0
#define REP0 1
#endif
#ifndef REP1
#define REP1 1
#endif
#ifndef REP2
#define REP2 1
#endif
#ifndef REP3
#define REP3 1
#endif
#ifndef REP4
#define REP4 1
#endif
#ifndef MULTI_LAUNCH
#define MULTI_LAUNCH 0
#endif

typedef _Float16 h16;
typedef __attribute__((ext_vector_type(8))) _Float16 h16x8;
typedef __attribute__((ext_vector_type(4))) _Float16 h16x4;
typedef __attribute__((ext_vector_type(4))) float f32x4;

#define MFMA(a, b, c) __builtin_amdgcn_mfma_f32_16x16x32_f16((a), (b), (c), 0, 0, 0)

constexpr int T_TOK = 32768;
constexpr int SEQ = 2048;
constexpr int NPH = 7;
constexpr int LDP = 3072;
constexpr int SMEM_BYTES = 70400;

constexpr size_t SZ_WIN = (size_t)3200 * 1024 * 2;
constexpr size_t SZ_WGLU = (size_t)512 * 512 * 2;
constexpr size_t SZ_WOUT = (size_t)1024 * 1024 * 2;
constexpr size_t SZ_WPP = (size_t)1024 * 256 * 2;
constexpr size_t SZ_WGATE = (size_t)1024 * 1024 * 2;
constexpr size_t OFF_WIN = 0;
constexpr size_t OFF_WGLU = OFF_WIN + SZ_WIN;
constexpr size_t OFF_WOUT = OFF_WGLU + SZ_WGLU;
constexpr size_t OFF_WPP = OFF_WOUT + SZ_WOUT;
constexpr size_t OFF_WGATE = OFF_WPP + SZ_WPP;
constexpr size_t OFF_PB = OFF_WGATE + SZ_WGATE;
constexpr size_t OFF_PROJ = OFF_PB + (size_t)T_TOK * 256 * 2;
constexpr size_t OFF_AB = OFF_PROJ + (size_t)T_TOK * LDP * 2;
constexpr size_t OFF_KTAB = OFF_AB + (size_t)T_TOK * 8 * 4;
constexpr size_t OFF_ETAB = OFF_KTAB + (size_t)32 * 33 * 256 * 2;
constexpr size_t OFF_FTAB = OFF_ETAB + (size_t)32 * 128 * 512 * 2;
constexpr size_t OFF_ALPOW = OFF_FTAB + (size_t)32 * 512 * 128 * 2;
constexpr size_t OFF_DL = OFF_ALPOW + (size_t)32 * 64 * 2 * 4;
constexpr size_t OFF_EPART = OFF_DL + (size_t)2048 * 4;
constexpr size_t OFF_OPART = OFF_EPART + (size_t)T_TOK * 16 * 4;
constexpr size_t OFF_MIXIN = OFF_OPART + (size_t)T_TOK * 16 * 4;
constexpr size_t OFF_WP = OFF_MIXIN + (size_t)T_TOK * 1024 * 2;
constexpr size_t OFF_QGP = OFF_WP + (size_t)2048 * 64 * 128 * 2;
constexpr size_t OFF_KDT = OFF_QGP + (size_t)2048 * 64 * 128 * 2;
constexpr size_t OFF_UT = OFF_KDT + (size_t)2048 * 128 * 64 * 2;
constexpr size_t OFF_ATP = OFF_UT + (size_t)2048 * 128 * 64 * 2;
constexpr size_t OFF_EH = OFF_ATP + (size_t)2048 * 64 * 64 * 2;
constexpr size_t WS_END = OFF_EH + (size_t)T_TOK * 1024 * 2;
constexpr size_t OUT_OFF_A0 = 0;
constexpr size_t OUT_OFF_YPRE = (size_t)T_TOK * 1024 * 2;
constexpr size_t OUT_OFF_ZT = OUT_OFF_YPRE + (size_t)T_TOK * 512 * 2;

struct Params {
  const float* in[23];
  float* out;
  unsigned char* ws;
  int ph_lo, ph_hi;
};

enum { I_X = 0, I_P, I_NMG, I_WIN, I_ARE, I_AIM, I_BRE, I_BIM, I_CRE, I_CIM, I_D, I_LOGDT, I_WGLU, I_BGLU,
       I_CONVW, I_ALOG, I_DTB, I_DNG, I_WOUT, I_WPP, I_PLEG, I_WGATE, I_FING };

__device__ __forceinline__ float wave_sum(float v) {
#pragma unroll
  for (int o = 32; o > 0; o >>= 1) v += __shfl_xor(v, o);
  return v;
}
__device__ __forceinline__ float sum16(float v) {
  v += __shfl_xor(v, 1); v += __shfl_xor(v, 2); v += __shfl_xor(v, 4); v += __shfl_xor(v, 8);
  return v;
}
__device__ __forceinline__ float sigmoidf_(float x) { return 1.f / (1.f + __expf(-x)); }
__device__ __forceinline__ float siluf_(float x) { return x / (1.f + __expf(-x)); }
__device__ __forceinline__ float gelu_tanh(float y) {
  float z = 0.7978845608028654f * (y + 0.044715f * y * y * y);
  return 0.5f * y * (1.f + tanhf(z));
}
__device__ __forceinline__ h16x8 pack8(f32x4 lo, f32x4 hi) {
  h16x8 r;
  r[0] = (h16)lo[0]; r[1] = (h16)lo[1]; r[2] = (h16)lo[2]; r[3] = (h16)lo[3];
  r[4] = (h16)hi[0]; r[5] = (h16)hi[1]; r[6] = (h16)hi[2]; r[7] = (h16)hi[3];
  return r;
}
__device__ __forceinline__ int perm_pos(int n) { return (n & ~31) + (((n & 15) >> 2) << 3) + (((n >> 4) & 1) << 2) + (n & 3); }
__device__ __forceinline__ int perm_inv(int pos) {
  int q5 = pos & 31, qq = q5 >> 3, jj = q5 & 7;
  return (pos & ~31) + (jj < 4 ? 4 * qq + jj : 16 + 4 * qq + (jj - 4));
}

__device__ void transpose_w(const float* __restrict__ W, int K, int N, int Npad, h16* __restrict__ WT, int t, float* tile) {
  const int ntn = Npad / 64;
  const int kt = t / ntn, nt = t % ntn, k0 = kt * 64, n0 = nt * 64;
  const int tx = threadIdx.x & 63, ty = threadIdx.x >> 6;
  for (int r = 0; r < 16; ++r) {
    int k = ty * 16 + r, n = n0 + tx;
    tile[k * 65 + tx] = (n < N) ? W[(size_t)(k0 + k) * N + n] : 0.f;
  }
  __syncthreads();
  for (int r = 0; r < 16; ++r) {
    int n = ty * 16 + r;
    WT[(size_t)(n0 + n) * K + k0 + tx] = (h16)tile[tx * 65 + n];
  }
  __syncthreads();
}

__device__ void ssm_table_item(const Params& p, int g, int d, float* lds) {
  float2* sAp = (float2*)lds;
  float2* sW = sAp + 64;
  const int tid = threadIdx.x;
  h16* KTAB = (h16*)(p.ws + OFF_KTAB);
  h16* ETAB = (h16*)(p.ws + OFF_ETAB);
  h16* FTAB = (h16*)(p.ws + OFF_FTAB);
  float* ALPOW = (float*)(p.ws + OFF_ALPOW);
  float* sBr = lds + 256; float* sBi = sBr + 1024; float* sCr = sBi + 1024; float* sCi = sCr + 16 * 65;
  {
    const float4 vbr = ((const float4*)(p.in[I_BRE] + g * 1024))[tid], vbi = ((const float4*)(p.in[I_BIM] + g * 1024))[tid];
    const float4 vcr = ((const float4*)(p.in[I_CRE] + g * 1024))[tid], vci = ((const float4*)(p.in[I_CIM] + g * 1024))[tid];
    *(float4*)(sBr + tid * 4) = vbr; *(float4*)(sBi + tid * 4) = vbi;
    const int ch = (tid * 4) >> 6, cp = (tid * 4) & 63;
    sCr[ch * 65 + cp] = vcr.x; sCr[ch * 65 + cp + 1] = vcr.y; sCr[ch * 65 + cp + 2] = vcr.z; sCr[ch * 65 + cp + 3] = vcr.w;
    sCi[ch * 65 + cp] = vci.x; sCi[ch * 65 + cp + 1] = vci.y; sCi[ch * 65 + cp + 2] = vci.z; sCi[ch * 65 + cp + 3] = vci.w;
  }
  if (tid < 64) {
    const int pp = tid;
    float lr = p.in[I_ARE][g * 64 + pp], li = p.in[I_AIM][g * 64 + pp], dt = expf(p.in[I_LOGDT][g]);
    float mag = expf(lr * dt), ang = li * dt;
    float abr = mag * cosf(ang), abi = mag * sinf(ang);
    float nr = abr - 1.f, ni = abi, den = lr * lr + li * li;
    float cr = (nr * lr + ni * li) / den, ci = (ni * lr - nr * li) / den;
    float apr = 1.f, api = 0.f;
    for (int k = 0; k < d; ++k) { float t0 = apr * abr - api * abi; api = apr * abi + api * abr; apr = t0; }
    sAp[pp] = make_float2(apr, api);
    sW[pp] = make_float2(apr * cr - api * ci, apr * ci + api * cr);
    if (d == 32) { ALPOW[(g * 64 + pp) * 2] = apr; ALPOW[(g * 64 + pp) * 2 + 1] = api; }
  }
  __syncthreads();
  if (d < 32) {
    {
      const int h = tid >> 4, hp = tid & 15;
      float acc = 0.f;
#pragma unroll 8
      for (int pp = 0; pp < 64; ++pp) {
        float2 W = sW[pp];
        float br = sBr[pp * 16 + hp], bi = sBi[pp * 16 + hp];
        float wbr = W.x * br - W.y * bi, wbi = W.x * bi + W.y * br;
        float cr = sCr[h * 65 + pp], ci = sCi[h * 65 + pp];
        acc += cr * wbr - ci * wbi;
      }
      KTAB[(size_t)(g * 33 + d + 1) * 256 + h * 16 + hp] = (h16)acc;
      if (d == 0) KTAB[(size_t)(g * 33) * 256 + tid] = (h16)0.f;
    }
    {
      const int i = 31 - d;
#pragma unroll
      for (int r = 0; r < 4; ++r) {
        int idx = tid + 256 * r, pp = idx >> 4, hp = idx & 15;
        float2 W = sW[pp];
        float br = sBr[pp * 16 + hp], bi = sBi[pp * 16 + hp];
        float wbr = W.x * br - W.y * bi, wbi = W.x * bi + W.y * br;
        ETAB[((size_t)g * 128 + pp) * 512 + i * 16 + hp] = (h16)wbr;
        ETAB[((size_t)g * 128 + 64 + pp) * 512 + i * 16 + hp] = (h16)wbi;
      }
    }
  }
  if (d >= 1) {
    const int j = d - 1;
#pragma unroll
    for (int r = 0; r < 4; ++r) {
      int idx = tid + 256 * r, h = idx >> 6, pp = idx & 63;
      float2 Ap = sAp[pp];
      float cr = sCr[h * 65 + pp], ci = sCi[h * 65 + pp];
      float re = cr * Ap.x - ci * Ap.y, im = cr * Ap.y + ci * Ap.x;
      FTAB[((size_t)g * 512 + j * 16 + h) * 128 + pp] = (h16)re;
      FTAB[((size_t)g * 512 + j * 16 + h) * 128 + 64 + pp] = (h16)(-im);
    }
  }
  __syncthreads();
}

__device__ void phase0(const Params& p, unsigned char* smem) {
  const int bid = blockIdx.x, nb = gridDim.x, tid = threadIdx.x, wid = tid >> 6, lane = tid & 63;
  float* tile = (float*)smem;
  for (int t = bid; t < 1440; t += nb) {
    if (t < 800) transpose_w(p.in[I_WIN], 1024, 3080, 3200, (h16*)(p.ws + OFF_WIN), t, tile);
    else if (t < 864) transpose_w(p.in[I_WGLU], 512, 512, 512, (h16*)(p.ws + OFF_WGLU), t - 800, tile);
    else if (t < 1120) transpose_w(p.in[I_WOUT], 1024, 1024, 1024, (h16*)(p.ws + OFF_WOUT), t - 864, tile);
    else if (t < 1184) transpose_w(p.in[I_WPP], 256, 1024, 1024, (h16*)(p.ws + OFF_WPP), t - 1120, tile);
    else transpose_w(p.in[I_WGATE], 1024, 1024, 1024, (h16*)(p.ws + OFF_WGATE), t - 1184, tile);
  }
  for (int it = bid; it < 32 * 33; it += nb) ssm_table_item(p, it / 33, it % 33, (float*)smem);
  {
    h16* A0 = (h16*)((unsigned char*)p.out + OUT_OFF_A0);
    const float* x = p.in[I_X];
    const float4* g4 = (const float4*)p.in[I_NMG];
    for (int row = bid * 4 + wid; row < T_TOK; row += nb * 4) {
      const float4* xr = (const float4*)(x + (size_t)row * 1024);
      float4 v[4];
      float ss = 0.f;
#pragma unroll
      for (int i = 0; i < 4; ++i) {
        v[i] = xr[lane + i * 64];
        ss += v[i].x * v[i].x + v[i].y * v[i].y + v[i].z * v[i].z + v[i].w * v[i].w;
      }
      ss = wave_sum(ss);
      float rstd = rsqrtf(ss * (1.f / 1024.f) + 1e-6f);
#pragma unroll
      for (int i = 0; i < 4; ++i) {
        float4 g = g4[lane + i * 64];
        h16x4 o;
        o[0] = (h16)(v[i].x * rstd * g.x); o[1] = (h16)(v[i].y * rstd * g.y);
        o[2] = (h16)(v[i].z * rstd * g.z); o[3] = (h16)(v[i].w * rstd * g.w);
        *(h16x4*)(A0 + (size_t)row * 1024 + (lane + i * 64) * 4) = o;
      }
    }
  }
  {
    h16* PB = (h16*)(p.ws + OFF_PB);
    const float4* p4 = (const float4*)p.in[I_P];
    const size_t n4 = (size_t)T_TOK * 256 / 4;
    for (size_t i = (size_t)bid * 256 + tid; i < n4; i += (size_t)nb * 256) {
      float4 v = p4[i];
      h16x4 o;
      o[0] = (h16)v.x; o[1] = (h16)v.y; o[2] = (h16)v.z; o[3] = (h16)v.w;
      *(h16x4*)(PB + i * 4) = o;
    }
  }
}

enum { EPI_PROJ = 0, EPI_GLU, EPI_PLE, EPI_OUT, EPI_GATE };

template <int EPI>
__device__ __forceinline__ void gemm_tile(const Params& p, const h16* __restrict__ A, int lda, const h16* __restrict__ Bt, int ldb,
                                          int K, int brow, int bcol, unsigned char* smem) {
  const int tid = threadIdx.x, wid = tid >> 6, lane = tid & 63, wr = wid >> 1, wc = wid & 1, fr = lane & 15, fq = lane >> 4;
  unsigned char* SA = smem;
  unsigned char* SB = smem + 128 * 32 * 2;
  f32x4 acc[4][4];
#pragma unroll
  for (int m = 0; m < 4; ++m)
#pragma unroll
    for (int n = 0; n < 4; ++n) acc[m][n] = f32x4{0.f, 0.f, 0.f, 0.f};
  const int nk = K / 32;
  for (int t = 0; t < nk; ++t) {
#pragma unroll
    for (int i = 0; i < 2; ++i) {
      int b = tid * 16 + i * 4096, r = b >> 6, c = (b & 63) >> 1;
      __builtin_amdgcn_global_load_lds((const unsigned*)(A + (size_t)(brow + r) * lda + t * 32 + c), (unsigned*)(SA + b), 16, 0, 0);
      __builtin_amdgcn_global_load_lds((const unsigned*)(Bt + (size_t)(bcol + r) * ldb + t * 32 + c), (unsigned*)(SB + b), 16, 0, 0);
    }
    asm volatile("s_waitcnt vmcnt(0)" ::: "memory");
    __syncthreads();
    h16x8 af[4], bf[4];
#pragma unroll
    for (int m = 0; m < 4; ++m) {
      af[m] = *(const h16x8*)(SA + (wr * 64 + m * 16 + fr) * 64 + fq * 16);
      bf[m] = *(const h16x8*)(SB + (wc * 64 + m * 16 + fr) * 64 + fq * 16);
    }
#pragma unroll
    for (int m = 0; m < 4; ++m)
#pragma unroll
      for (int n = 0; n < 4; ++n) acc[m][n] = MFMA(af[m], bf[n], acc[m][n]);
    __syncthreads();
  }
  if constexpr (EPI == EPI_PROJ) {
    h16* PROJ = (h16*)(p.ws + OFF_PROJ);
    float* AB = (float*)(p.ws + OFF_AB);
#pragma unroll
    for (int m = 0; m < 4; ++m)
#pragma unroll
      for (int n = 0; n < 4; ++n) {
        const int col = bcol + wc * 64 + n * 16 + fr;
#pragma unroll
        for (int j = 0; j < 4; ++j) {
          const size_t row = brow + wr * 64 + m * 16 + fq * 4 + j;
          if (col < 3072) PROJ[row * LDP + col] = (h16)acc[m][n][j];
          else if (col < 3080) AB[row * 8 + (col - 3072)] = acc[m][n][j];
        }
      }
  } else if constexpr (EPI == EPI_GLU) {
    const h16* PROJ = (const h16*)(p.ws + OFF_PROJ);
    const h16* YPRE = (const h16*)((unsigned char*)p.out + OUT_OFF_YPRE);
    h16* MIXIN = (h16*)(p.ws + OFF_MIXIN);
    const float* bglu = p.in[I_BGLU];
#pragma unroll
    for (int m = 0; m < 4; ++m)
#pragma unroll
      for (int n = 0; n < 4; ++n) {
        const int col = bcol + wc * 64 + n * 16 + fr;
        const float bb = bglu[col];
#pragma unroll
        for (int j = 0; j < 4; ++j) {
          const size_t row = brow + wr * 64 + m * 16 + fq * 4 + j;
          float y = (float)YPRE[row * 512 + col];
          float z = (float)PROJ[row * LDP + 512 + col];
          float o = y * sigmoidf_(acc[m][n][j] + bb) * siluf_(z);
          MIXIN[row * 1024 + col] = (h16)o;
        }
      }
  } else if constexpr (EPI == EPI_PLE) {
    h16* EH = (h16*)(p.ws + OFF_EH);
    float* EPART = (float*)(p.ws + OFF_EPART);
#pragma unroll
    for (int m = 0; m < 4; ++m) {
#pragma unroll
      for (int j = 0; j < 4; ++j) {
        const size_t row = brow + wr * 64 + m * 16 + fq * 4 + j;
        float s = 0.f;
#pragma unroll
        for (int n = 0; n < 4; ++n) {
          const int col = bcol + wc * 64 + n * 16 + fr;
          float v = acc[m][n][j];
          s += v * v;
          EH[row * 1024 + col] = (h16)v;
        }
        s = sum16(s);
        if (fr == 0) EPART[row * 16 + (bcol >> 7) * 2 + wc] = s;
      }
    }
  } else if constexpr (EPI == EPI_OUT) {
    const float* x = p.in[I_X];
    h16* HB = (h16*)(p.ws + OFF_PROJ);
#pragma unroll
    for (int m = 0; m < 4; ++m)
#pragma unroll
      for (int n = 0; n < 4; ++n) {
        const int col = bcol + wc * 64 + n * 16 + fr;
#pragma unroll
        for (int j = 0; j < 4; ++j) {
          const size_t row = brow + wr * 64 + m * 16 + fq * 4 + j;
          float hv = x[row * 1024 + col] + acc[m][n][j];
          p.out[row * 1024 + col] = hv;
          HB[row * 1024 + col] = (h16)hv;
        }
      }
  } else if constexpr (EPI == EPI_GATE) {
    const h16* EH = (const h16*)(p.ws + OFF_EH);
    const float* EPART = (const float*)(p.ws + OFF_EPART);
    float* OPART = (float*)(p.ws + OFF_OPART);
    const float* pg = p.in[I_PLEG];
    float* sr = (float*)smem;
    if (tid < 128) {
      const float* ep = EPART + (size_t)(brow + tid) * 16;
      float s = 0.f;
#pragma unroll
      for (int i = 0; i < 16; ++i) s += ep[i];
      sr[tid] = rsqrtf(s * (1.f / 1024.f) + 1e-6f);
    }
    __syncthreads();
#pragma unroll
    for (int m = 0; m < 4; ++m) {
#pragma unroll
      for (int j = 0; j < 4; ++j) {
        const int rl = wr * 64 + m * 16 + fq * 4 + j;
        const size_t row = brow + rl;
        const float rs = sr[rl];
        float s = 0.f;
#pragma unroll
        for (int n = 0; n < 4; ++n) {
          const int col = bcol + wc * 64 + n * 16 + fr;
          float gate = sigmoidf_(acc[m][n][j]);
          float e = (float)EH[row * 1024 + col] * rs * pg[col];
          float h2 = p.out[row * 1024 + col] + gate * e;
          p.out[row * 1024 + col] = h2;
          s += h2 * h2;
        }
        s = sum16(s);
        if (fr == 0) OPART[row * 16 + (bcol >> 7) * 2 + wc] = s;
      }
    }
    __syncthreads();
  }
}

__device__ void ssm_item(const Params& p, int b, int g, unsigned char* smem) {
  float* LOCAL = (float*)smem;
  h16* SPREV = (h16*)(smem + 33792);
  h16* KT = (h16*)(smem + 51200);
  int tid_ = threadIdx.x;
  asm volatile("" : "+v"(tid_));
  const int tid = tid_, w = tid >> 6, lane = tid & 63, fr = lane & 15, fq = lane >> 4;
  const h16* PROJ = (const h16*)(p.ws + OFF_PROJ);
  const h16* Eg = (const h16*)(p.ws + OFF_ETAB) + (size_t)g * 128 * 512;
  const h16* Kg = (const h16*)(p.ws + OFF_KTAB) + (size_t)g * 33 * 256;
  const h16* Fg = (const h16*)(p.ws + OFF_FTAB) + (size_t)g * 512 * 128;
  const float* ALPOW = (const float*)(p.ws + OFF_ALPOW);
  h16* YPRE = (h16*)((unsigned char*)p.out + OUT_OFF_YPRE);
  const int nchunk = w * 16 + fr;
  const size_t tok0 = (size_t)b * SEQ + (size_t)nchunk * 32;
  for (int idx = tid; idx < 33 * 256 / 8; idx += 256) *(h16x8*)(KT + idx * 8) = *(const h16x8*)(Kg + idx * 8);
  h16x8 uf[16];
#pragma unroll
  for (int ks = 0; ks < 16; ++ks) {
    const int i = 2 * ks + (fq >> 1);
    uf[ks] = *(const h16x8*)(PROJ + (tok0 + i) * LDP + g * 16 + (fq & 1) * 8);
  }
  {
    h16x8 ea[8];
#pragma unroll
    for (int ks = 0; ks < 8; ++ks) ea[ks] = *(const h16x8*)(Eg + (size_t)fr * 512 + ks * 32 + fq * 8);
    f32x4 acc = {0.f, 0.f, 0.f, 0.f};
#pragma unroll 1
    for (int it = 0; it < 16; ++it) {
      const int mt = it >> 1, hf = it & 1;
      const int itn = it < 15 ? it + 1 : 15;
      h16x8 en[8];
#pragma unroll
      for (int ks = 0; ks < 8; ++ks) en[ks] = *(const h16x8*)(Eg + (size_t)((itn >> 1) * 16 + fr) * 512 + ((itn & 1) * 8 + ks) * 32 + fq * 8);
      if (hf == 0) {
#pragma unroll
        for (int ks = 0; ks < 8; ++ks) acc = MFMA(ea[ks], uf[ks], acc);
      } else {
#pragma unroll
        for (int ks = 0; ks < 8; ++ks) acc = MFMA(ea[ks], uf[8 + ks], acc);
        *(f32x4*)(LOCAL + nchunk * 132 + mt * 16 + fq * 4) = acc;
        acc = f32x4{0.f, 0.f, 0.f, 0.f};
      }
#pragma unroll
      for (int ks = 0; ks < 8; ++ks) ea[ks] = en[ks];
    }
  }
  __syncthreads();
  if (tid < 64) {
    const int pp = tid;
    const float ar = ALPOW[(g * 64 + pp) * 2], ai = ALPOW[(g * 64 + pp) * 2 + 1];
    float sr = 0.f, si = 0.f;
#pragma unroll 4
    for (int c = 0; c < 64; ++c) {
      SPREV[c * 136 + pp] = (h16)sr;
      SPREV[c * 136 + 64 + pp] = (h16)si;
      float lr = LOCAL[c * 132 + pp], li = LOCAL[c * 132 + 64 + pp];
      float nr = ar * sr - ai * si + lr;
      float ni = ar * si + ai * sr + li;
      sr = nr; si = ni;
    }
  }
  __syncthreads();
  h16x8 sf[4];
#pragma unroll
  for (int ks = 0; ks < 4; ++ks) sf[ks] = *(const h16x8*)(SPREV + nchunk * 136 + ks * 32 + fq * 8);
  const float4 Dv = *(const float4*)(p.in[I_D] + g * 16 + fq * 4);
  h16x8 fa[4];
#pragma unroll
  for (int ks = 0; ks < 4; ++ks) fa[ks] = *(const h16x8*)(Fg + (size_t)fr * 128 + ks * 32 + fq * 8);
  h16x4 u4 = *(const h16x4*)(PROJ + tok0 * LDP + g * 16 + fq * 4);
#pragma unroll 1
  for (int j = 0; j < 32; ++j) {
    const int jn = j < 31 ? j + 1 : 31;
    h16x8 fn[4];
#pragma unroll
    for (int ks = 0; ks < 4; ++ks) fn[ks] = *(const h16x8*)(Fg + (size_t)(jn * 16 + fr) * 128 + ks * 32 + fq * 8);
    const h16x4 un = *(const h16x4*)(PROJ + (tok0 + jn) * LDP + g * 16 + fq * 4);
    f32x4 acc = {0.f, 0.f, 0.f, 0.f};
#pragma unroll
    for (int ks = 0; ks < 16; ++ks) {
      if (2 * ks <= j) {
        const int dd = j - 2 * ks - (fq >> 1) + 1;
        h16x8 a = *(const h16x8*)(KT + dd * 256 + fr * 16 + (fq & 1) * 8);
        acc = MFMA(a, uf[ks], acc);
      }
    }
#pragma unroll
    for (int ks = 0; ks < 4; ++ks) acc = MFMA(fa[ks], sf[ks], acc);
    const size_t tok = tok0 + j;
    h16x4 o;
    o[0] = (h16)gelu_tanh(acc[0] + Dv.x * (float)u4[0]);
    o[1] = (h16)gelu_tanh(acc[1] + Dv.y * (float)u4[1]);
    o[2] = (h16)gelu_tanh(acc[2] + Dv.z * (float)u4[2]);
    o[3] = (h16)gelu_tanh(acc[3] + Dv.w * (float)u4[3]);
    *(h16x4*)(YPRE + tok * 512 + g * 16 + fq * 4) = o;
#pragma unroll
    for (int ks = 0; ks < 4; ++ks) fa[ks] = fn[ks];
    u4 = un;
  }
  __syncthreads();
}

__device__ void gdn_pre_item(const Params& p, int item, unsigned char* smem) {
  h16* QH = (h16*)smem;
  h16* KH = (h16*)(smem + 17408);
  h16* VH = (h16*)(smem + 34816);
  float* LT = (float*)(smem + 52224);
  float* sG = (float*)(smem + 69632);
  float* sBeta = (float*)(smem + 69888);
  int tid_ = threadIdx.x;
  asm volatile("" : "+v"(tid_));
  const int tid = tid_, w = tid >> 6, lane = tid & 63, fr = lane & 15, fq = lane >> 4;
  const int c = item & 31, h = (item >> 5) & 3, b = item >> 7;
  const h16* PROJ = (const h16*)(p.ws + OFF_PROJ);
  const float* AB = (const float*)(p.ws + OFF_AB);
  const float* convw = p.in[I_CONVW];
  h16* WPi = (h16*)(p.ws + OFF_WP) + (size_t)item * 64 * 128;
  h16* QGPi = (h16*)(p.ws + OFF_QGP) + (size_t)item * 64 * 128;
  h16* KDTi = (h16*)(p.ws + OFF_KDT) + (size_t)item * 128 * 64;
  h16* UTi = (h16*)(p.ws + OFF_UT) + (size_t)item * 128 * 64;
  h16* ATPi = (h16*)(p.ws + OFF_ATP) + (size_t)item * 64 * 64;
  h16* ZTi = (h16*)((unsigned char*)p.out + OUT_OFF_ZT) + (size_t)item * 128 * 64;
  float* DL = (float*)(p.ws + OFF_DL);
  {
    const int ch0 = (tid & 15) * 8, trow = tid >> 4;
#pragma unroll 1
    for (int pass = 0; pass < 4; ++pass) {
      const int t = pass * 16 + trow, tl = c * 64 + t;
#pragma unroll
      for (int sec = 0; sec < 3; ++sec) {
        const int colbase = 1024 + sec * 512 + h * 128 + ch0;
        float a[8];
#pragma unroll
        for (int e = 0; e < 8; ++e) a[e] = 0.f;
#pragma unroll
        for (int jj = 0; jj < 4; ++jj) {
          const int ts = tl - 3 + jj;
          if (ts >= 0) {
            h16x8 xv = *(const h16x8*)(PROJ + ((size_t)b * SEQ + ts) * LDP + colbase);
            const float4 w0 = *(const float4*)(convw + jj * 1536 + sec * 512 + h * 128 + ch0);
            const float4 w1 = *(const float4*)(convw + jj * 1536 + sec * 512 + h * 128 + ch0 + 4);
            a[0] += w0.x * (float)xv[0]; a[1] += w0.y * (float)xv[1]; a[2] += w0.z * (float)xv[2]; a[3] += w0.w * (float)xv[3];
            a[4] += w1.x * (float)xv[4]; a[5] += w1.y * (float)xv[5]; a[6] += w1.z * (float)xv[6]; a[7] += w1.w * (float)xv[7];
          }
        }
        float ss = 0.f;
#pragma unroll
        for (int e = 0; e < 8; ++e) { a[e] = siluf_(a[e]); ss += a[e] * a[e]; }
        float scale = 1.f;
        if (sec < 2) {
          ss = sum16(ss);
          scale = rsqrtf(ss + 1e-6f) * (sec == 0 ? 0.08838834764831845f : 1.f);
        }
        h16x8 o;
#pragma unroll
        for (int e = 0; e < 8; ++e) o[e] = (h16)(a[e] * scale);
        h16* dst = (sec == 0 ? QH : (sec == 1 ? KH : VH));
        *(h16x8*)(dst + t * 136 + ch0) = o;
      }
    }
  }
  if (tid < 64) {
    const size_t tok = (size_t)b * SEQ + c * 64 + tid;
    float braw = AB[tok * 8 + h], araw = AB[tok * 8 + 4 + h];
    float beta = 1.f / (1.f + expf(-braw));
    float xx = araw + p.in[I_DTB][h];
    float sp = xx > 20.f ? xx : log1pf(expf(xx));
    float gg = -expf(p.in[I_ALOG][h]) * sp;
#pragma unroll
    for (int o = 1; o < 64; o <<= 1) {
      float v = __shfl_up(gg, o);
      if (lane >= o) gg += v;
    }
    sG[tid] = gg;
    sBeta[tid] = beta;
  }
  __syncthreads();
  {
    h16x8 ak[4], aq[4];
#pragma unroll
    for (int ks = 0; ks < 4; ++ks) {
      ak[ks] = *(const h16x8*)(KH + (w * 16 + fr) * 136 + ks * 32 + fq * 8);
      aq[ks] = *(const h16x8*)(QH + (w * 16 + fr) * 136 + ks * 32 + fq * 8);
    }
#pragma unroll
    for (int jt = 0; jt < 4; ++jt) {
      const int j = jt * 16 + fr;
      const int pj = perm_pos(j);
      if (jt <= w) {
        f32x4 kk = {0.f, 0.f, 0.f, 0.f}, qk = {0.f, 0.f, 0.f, 0.f};
#pragma unroll
        for (int ks = 0; ks < 4; ++ks) {
          h16x8 bk = *(const h16x8*)(KH + (jt * 16 + fr) * 136 + ks * 32 + fq * 8);
          kk = MFMA(ak[ks], bk, kk);
          qk = MFMA(aq[ks], bk, qk);
        }
        const float Gj = sG[j];
        f32x4 lt;
#pragma unroll
        for (int r = 0; r < 4; ++r) {
          const int i = w * 16 + 4 * fq + r;
          const float e = (i >= j) ? expf(sG[i] - Gj) : 0.f;
          lt[r] = (i > j) ? sBeta[i] * kk[r] * e : 0.f;
          ATPi[i * 64 + (((pj >> 3) ^ (i & 7)) << 3) + (pj & 7)] = (h16)(qk[r] * e);
        }
        *(f32x4*)(LT + j * 68 + w * 16 + 4 * fq) = lt;
      } else {
#pragma unroll
        for (int r = 0; r < 4; ++r) {
          const int i = w * 16 + 4 * fq + r;
          ATPi[i * 64 + (((pj >> 3) ^ (i & 7)) << 3) + (pj & 7)] = (h16)0.f;
        }
      }
    }
  }
  __syncthreads();
  float r[64];
  if (tid < 128) {
#pragma unroll
    for (int t = 0; t < 64; ++t) r[t] = (float)VH[t * 136 + tid] * sBeta[t];
  } else {
#pragma unroll
    for (int t = 0; t < 64; ++t) r[t] = (float)KH[t * 136 + (tid - 128)] * sBeta[t] * expf(sG[t]);
  }
#pragma unroll
  for (int j = 0; j < 63; ++j) {
    const float xj = r[j];
#pragma unroll
    for (int i4 = (j + 1) / 4; i4 < 16; ++i4) {
      const f32x4 l = *(const f32x4*)(LT + j * 68 + i4 * 4);
#pragma unroll
      for (int e = 0; e < 4; ++e) {
        if (i4 * 4 + e > j) r[i4 * 4 + e] -= l[e] * xj;
      }
    }
    __builtin_amdgcn_sched_barrier(0);
  }
  if (tid < 128) {
#pragma unroll
    for (int t8 = 0; t8 < 8; ++t8) {
      h16x8 v;
#pragma unroll
      for (int e = 0; e < 8; ++e) v[e] = (h16)r[t8 * 8 + e];
      *(h16x8*)(UTi + (size_t)tid * 64 + t8 * 8) = v;
    }
  }
  __syncthreads();
  if (tid >= 128) {
    const int pos = perm_pos(tid - 128);
#pragma unroll
    for (int t = 0; t < 64; ++t) VH[t * 136 + pos] = (h16)r[t];
  }
  __syncthreads();
  for (int rr = 0; rr < 4; ++rr) {
    const int idx = tid + 256 * rr, row = idx >> 4, seg = idx & 15;
    *(h16x8*)(WPi + row * 128 + ((seg ^ (row & 15)) << 3)) = *(const h16x8*)(VH + row * 136 + seg * 8);
  }
  {
    const int dv = tid & 127, th = tid >> 7;
    const float gdv = p.in[I_DNG][dv];
    const h16* zp = PROJ + ((size_t)b * SEQ + c * 64 + th * 32) * LDP + 2560 + h * 128 + dv;
    h16 zv[32];
#pragma unroll
    for (int t = 0; t < 32; ++t) zv[t] = zp[(size_t)t * LDP];
#pragma unroll
    for (int t8 = 0; t8 < 4; ++t8) {
      h16x8 v;
#pragma unroll
      for (int e = 0; e < 8; ++e) v[e] = (h16)(siluf_((float)zv[t8 * 8 + e]) * gdv);
      *(h16x8*)(ZTi + (size_t)dv * 64 + th * 32 + t8 * 8) = v;
    }
  }
#pragma unroll 2
  for (int rr = 0; rr < 32; ++rr) {
    const int idx = tid + 256 * rr, t = idx >> 7, pp = idx & 127;
    const int dk = perm_inv(pp);
    QGPi[t * 128 + (((pp >> 3) ^ (t & 15)) << 3) + (pp & 7)] = (h16)((float)QH[t * 136 + dk] * expf(sG[t]));
  }
  const float Glast = sG[63];
#pragma unroll 2
  for (int rr = 0; rr < 32; ++rr) {
    const int idx = tid + 256 * rr, dk = idx >> 6, tp = idx & 63;
    const int t = perm_inv(tp);
    KDTi[dk * 64 + (((tp >> 3) ^ (dk & 7)) << 3) + (tp & 7)] = (h16)((float)KH[t * 136 + dk] * expf(Glast - sG[t]));
  }
  if (tid == 0) DL[item] = expf(Glast);
  __syncthreads();
}

template <int NB>
__device__ __forceinline__ void glds_copy(const h16* __restrict__ g, unsigned char* l) {
#pragma unroll
  for (int i = 0; i < NB / 4096; ++i) {
    const int off = threadIdx.x * 16 + i * 4096;
    __builtin_amdgcn_global_load_lds((const unsigned*)((const unsigned char*)g + off), (unsigned*)(l + off), 16, 0, 0);
  }
}
#define RAW_BARRIER() do { asm volatile("s_waitcnt lgkmcnt(0)" ::: "memory"); __builtin_amdgcn_s_barrier(); asm volatile("" ::: "memory"); } while (0)

__device__ void gdn_recurrence(const Params& p, int bh, unsigned char* smem) {
  unsigned char* LW = smem;
  unsigned char* LQ = smem + 16384;
  unsigned char* LA = smem + 32768;
  unsigned char* LK = smem + 40960;
  float* red = (float*)(smem + 57344);
  const int tid = threadIdx.x, w = tid >> 6, lane = tid & 63, fr = lane & 15, fq = lane >> 4;
  const int b = bh >> 2, h = bh & 3;
  h16* MIXIN = (h16*)(p.ws + OFF_MIXIN);
  const float* DL = (const float*)(p.ws + OFF_DL);
  const h16* WPb = (const h16*)(p.ws + OFF_WP) + (size_t)bh * 32 * 64 * 128;
  const h16* QGPb = (const h16*)(p.ws + OFF_QGP) + (size_t)bh * 32 * 64 * 128;
  const h16* KDTb = (const h16*)(p.ws + OFF_KDT) + (size_t)bh * 32 * 128 * 64;
  const h16* UTb = (const h16*)(p.ws + OFF_UT) + (size_t)bh * 32 * 128 * 64;
  const h16* ATPb = (const h16*)(p.ws + OFF_ATP) + (size_t)bh * 32 * 64 * 64;
  const h16* ZTb = (const h16*)((unsigned char*)p.out + OUT_OFF_ZT) + (size_t)bh * 32 * 128 * 64;
  f32x4 S[8][2];
#pragma unroll
  for (int i = 0; i < 8; ++i) { S[i][0] = f32x4{0.f, 0.f, 0.f, 0.f}; S[i][1] = f32x4{0.f, 0.f, 0.f, 0.f}; }
  h16x4 uR[4][2];
  glds_copy<16384>(WPb, LW); glds_copy<16384>(QGPb, LQ); glds_copy<8192>(ATPb, LA); glds_copy<16384>(KDTb, LK);
#pragma unroll
  for (int mt = 0; mt < 4; ++mt)
#pragma unroll
    for (int nt = 0; nt < 2; ++nt) {
      uR[mt][nt] = *(const h16x4*)(UTb + (size_t)(w * 32 + nt * 16 + fr) * 64 + mt * 16 + fq * 4);
    }
  asm volatile("s_waitcnt vmcnt(0)" ::: "memory");
  RAW_BARRIER();
  for (int c = 0; c < 32; ++c) {
    const int item = bh * 32 + c;
    const float dl = DL[item];
    const bool more = (c + 1 < 32);
    h16x4 zR[4][2];
#pragma unroll
    for (int mt = 0; mt < 4; ++mt)
#pragma unroll
      for (int nt = 0; nt < 2; ++nt)
        zR[mt][nt] = *(const h16x4*)(ZTb + (size_t)c * 128 * 64 + (size_t)(w * 32 + nt * 16 + fr) * 64 + mt * 16 + fq * 4);
    f32x4 vn[4][2], o[4][2];
#pragma unroll
    for (int mt = 0; mt < 4; ++mt) { vn[mt][0] = f32x4{0.f, 0.f, 0.f, 0.f}; vn[mt][1] = vn[mt][0]; o[mt][0] = vn[mt][0]; o[mt][1] = vn[mt][0]; }
#pragma unroll
    for (int ks = 0; ks < 4; ++ks) {
      const h16x8 sf0 = pack8(S[2 * ks][0], S[2 * ks + 1][0]);
      const h16x8 sf1 = pack8(S[2 * ks][1], S[2 * ks + 1][1]);
#pragma unroll
      for (int mt = 0; mt < 4; ++mt) {
        const int off = (mt * 16 + fr) * 256 + (((ks * 4 + fq) ^ fr) << 4);
        h16x8 aw = *(const h16x8*)(LW + off);
        h16x8 aq = *(const h16x8*)(LQ + off);
        vn[mt][0] = MFMA(aw, sf0, vn[mt][0]);
        vn[mt][1] = MFMA(aw, sf1, vn[mt][1]);
        o[mt][0] = MFMA(aq, sf0, o[mt][0]);
        o[mt][1] = MFMA(aq, sf1, o[mt][1]);
      }
    }
#pragma unroll
    for (int mt = 0; mt < 4; ++mt)
#pragma unroll
      for (int r = 0; r < 4; ++r) { vn[mt][0][r] = (float)uR[mt][0][r] - vn[mt][0][r]; vn[mt][1][r] = (float)uR[mt][1][r] - vn[mt][1][r]; }
    RAW_BARRIER();
    const int cn = more ? c + 1 : c;
    glds_copy<16384>(WPb + (size_t)cn * 64 * 128, LW);
    glds_copy<16384>(QGPb + (size_t)cn * 64 * 128, LQ);
#pragma unroll
    for (int mt = 0; mt < 4; ++mt)
#pragma unroll
      for (int nt = 0; nt < 2; ++nt)
        uR[mt][nt] = *(const h16x4*)(UTb + (size_t)cn * 128 * 64 + (size_t)(w * 32 + nt * 16 + fr) * 64 + mt * 16 + fq * 4);
    h16x8 vfr[2][2];
#pragma unroll
    for (int k2 = 0; k2 < 2; ++k2) { vfr[k2][0] = pack8(vn[2 * k2][0], vn[2 * k2 + 1][0]); vfr[k2][1] = pack8(vn[2 * k2][1], vn[2 * k2 + 1][1]); }
#pragma unroll
    for (int mt = 0; mt < 4; ++mt) {
#pragma unroll
      for (int k2 = 0; k2 < 2; ++k2) {
        h16x8 aa = *(const h16x8*)(LA + (mt * 16 + fr) * 128 + (((k2 * 4 + fq) ^ (fr & 7)) << 4));
        o[mt][0] = MFMA(aa, vfr[k2][0], o[mt][0]);
        o[mt][1] = MFMA(aa, vfr[k2][1], o[mt][1]);
      }
    }
#pragma unroll
    for (int dkt = 0; dkt < 8; ++dkt) {
      f32x4 s0 = S[dkt][0], s1 = S[dkt][1];
#pragma unroll
      for (int r = 0; r < 4; ++r) { s0[r] *= dl; s1[r] *= dl; }
#pragma unroll
      for (int k2 = 0; k2 < 2; ++k2) {
        h16x8 ak = *(const h16x8*)(LK + (dkt * 16 + fr) * 128 + (((k2 * 4 + fq) ^ (fr & 7)) << 4));
        s0 = MFMA(ak, vfr[k2][0], s0);
        s1 = MFMA(ak, vfr[k2][1], s1);
      }
      S[dkt][0] = s0; S[dkt][1] = s1;
    }
#pragma unroll
    for (int mt = 0; mt < 4; ++mt)
#pragma unroll
      for (int r = 0; r < 4; ++r) {
        float s = o[mt][0][r] * o[mt][0][r] + o[mt][1][r] * o[mt][1][r];
        s = sum16(s);
        if (fr == 0) red[w * 64 + mt * 16 + 4 * fq + r] = s;
      }
    RAW_BARRIER();
    glds_copy<8192>(ATPb + (size_t)cn * 64 * 64, LA);
    glds_copy<16384>(KDTb + (size_t)cn * 128 * 64, LK);
    asm volatile("" ::: "memory");
#pragma unroll
    for (int mt = 0; mt < 4; ++mt)
#pragma unroll
      for (int r = 0; r < 4; ++r) {
        const int tl = mt * 16 + 4 * fq + r;
        const float tot = red[tl] + red[64 + tl] + red[128 + tl] + red[192 + tl];
        const float rstd = rsqrtf(tot * (1.f / 128.f) + 1e-6f);
        const size_t tok = (size_t)b * SEQ + c * 64 + tl;
        h16* yp = MIXIN + tok * 1024 + 512 + h * 128 + w * 32 + fr;
        yp[0] = (h16)(o[mt][0][r] * rstd * (float)zR[mt][0][r]);
        yp[16] = (h16)(o[mt][1][r] * rstd * (float)zR[mt][1][r]);
      }
    asm volatile("s_waitcnt vmcnt(32)" ::: "memory");
    RAW_BARRIER();
  }
  asm volatile("s_waitcnt vmcnt(0)" ::: "memory");
  __syncthreads();
}

#ifndef ONLY_PH
#define ONLY_PH -1
#endif
#define RUNPH(n) ((ONLY_PH < 0 || ONLY_PH == (n)) && p.ph_lo <= (n) && (n) <= p.ph_hi)
#define SYNCPH(n) do { if (p.ph_lo <= (n) && (n) < p.ph_hi) grid.sync(); } while (0)
__global__ void __launch_bounds__(256, 2) hymba_mega(Params p) {
  __shared__ __attribute__((aligned(16))) unsigned char smem[SMEM_BYTES];
  cg::grid_group grid = cg::this_grid();
  const int bid = blockIdx.x, nb = gridDim.x;
  {
    if (RUNPH(0)) for (int rep = 0; rep < REP0; ++rep) {
      if (rep) grid.sync();
      phase0(p, smem);
    }
    SYNCPH(0);
    if (RUNPH(1)) for (int rep = 0; rep < REP1; ++rep) {
      if (rep) grid.sync();
      const h16* A0 = (const h16*)((unsigned char*)p.out + OUT_OFF_A0);
      const h16* W = (const h16*)(p.ws + OFF_WIN);
      for (int t = bid; t < 256 * 25; t += nb) gemm_tile<EPI_PROJ>(p, A0, 1024, W, 1024, 1024, (t / 25) * 128, (t % 25) * 128, smem);
    }
    SYNCPH(1);
    if (RUNPH(2)) for (int rep = 0; rep < REP2; ++rep) {
      if (rep) grid.sync();
      for (int it = bid; it < 512 + 2048; it += nb) {
        if (it < 2048) gdn_pre_item(p, it, smem);
        else ssm_item(p, (it - 2048) >> 5, (it - 2048) & 31, smem);
      }
    }
    SYNCPH(2);
    if (RUNPH(3)) for (int rep = 0; rep < REP3; ++rep) {
      if (rep) grid.sync();
      const int nrec = 64;
      if (bid < nrec) for (int it = bid; it < nrec; it += nb) gdn_recurrence(p, it, smem);
      if (nb <= nrec || bid >= nrec) {
        const int start = nb > nrec ? bid - nrec : bid, step = nb > nrec ? nb - nrec : nb;
        const h16* YPRE = (const h16*)((unsigned char*)p.out + OUT_OFF_YPRE);
        for (int t = start; t < 1024 + 2048; t += step) {
          if (t < 1024) gemm_tile<EPI_GLU>(p, YPRE, 512, (const h16*)(p.ws + OFF_WGLU), 512, 512, (t >> 2) * 128, (t & 3) * 128, smem);
          else gemm_tile<EPI_PLE>(p, (const h16*)(p.ws + OFF_PB), 256, (const h16*)(p.ws + OFF_WPP), 256, 256, ((t - 1024) >> 3) * 128, ((t - 1024) & 7) * 128, smem);
        }
      }
    }
    SYNCPH(3);
    if (RUNPH(4)) for (int rep = 0; rep < REP4; ++rep) {
      if (rep) grid.sync();
      for (int t = bid; t < 2048; t += nb)
        gemm_tile<EPI_OUT>(p, (const h16*)(p.ws + OFF_MIXIN), 1024, (const h16*)(p.ws + OFF_WOUT), 1024, 1024, (t >> 3) * 128, (t & 7) * 128, smem);
    }
    SYNCPH(4);
    if (RUNPH(5)) {
      for (int t = bid; t < 2048; t += nb)
        gemm_tile<EPI_GATE>(p, (const h16*)(p.ws + OFF_PROJ), 1024, (const h16*)(p.ws + OFF_WGATE), 1024, 1024, (t >> 3) * 128, (t & 7) * 128, smem);
    }
    SYNCPH(5);
    if (RUNPH(6)) {
      const int wid = threadIdx.x >> 6, lane = threadIdx.x & 63;
      const float* OPART = (const float*)(p.ws + OFF_OPART);
      const float4* g4 = (const float4*)p.in[I_FING];
      for (int row = bid * 4 + wid; row < T_TOK; row += nb * 4) {
        float s = (lane < 16) ? OPART[(size_t)row * 16 + lane] : 0.f;
        s = wave_sum(s);
        const float rstd = rsqrtf(s * (1.f / 1024.f) + 1e-6f);
        float4* orow = (float4*)(p.out + (size_t)row * 1024);
#pragma unroll
        for (int i = 0; i < 4; ++i) {
          float4 v = orow[lane + i * 64];
          float4 g = g4[lane + i * 64];
          v.x *= rstd * g.x; v.y *= rstd * g.y; v.z *= rstd * g.z; v.w *= rstd * g.w;
          orow[lane + i * 64] = v;
        }
      }
    }
  }
}

extern "C" void kernel_launch(void* const* d_in, const int* in_sizes, int n_in, void* d_out, int out_size, void* d_ws, size_t ws_size,
                              hipStream_t stream) {
  static int grid_blocks = 0;
  if (!grid_blocks) {
    int dev = 0, cus = 0, per_cu = 0;
    hipGetDevice(&dev);
    hipDeviceGetAttribute(&cus, hipDeviceAttributeMultiprocessorCount, dev);
    hipOccupancyMaxActiveBlocksPerMultiprocessor(&per_cu, hymba_mega, 256, 0);
    if (per_cu > 2) per_cu = 2;
    if (per_cu < 1) per_cu = 1;
    grid_blocks = cus * per_cu;
  }
  if (n_in != 23 || ws_size < WS_END || out_size != T_TOK * 1024) {
    fprintf(stderr, "kernel_launch: unexpected sizes n_in=%d ws=%zu (need %zu) out=%d\n", n_in, ws_size, (size_t)WS_END, out_size);
    return;
  }
  Params p{};
  for (int i = 0; i < 23; ++i) p.in[i] = (const float*)d_in[i];
  p.out = (float*)d_out;
  p.ws = (unsigned char*)d_ws;
#if MULTI_LAUNCH
  for (int ph = 0; ph < NPH; ++ph) {
    p.ph_lo = ph; p.ph_hi = ph;
    hipLaunchKernelGGL(hymba_mega, dim3(grid_blocks), dim3(256), 0, stream, p);
  }
#else
  p.ph_lo = 0; p.ph_hi = NPH - 1;
  void* args[] = {&p};
  hipError_t e = hipLaunchCooperativeKernel((void*)hymba_mega, dim3(grid_blocks), dim3(256), args, 0, stream);
  if (e != hipSuccess) fprintf(stderr, "cooperative launch failed: %s (grid %d)\n", hipGetErrorString(e), grid_blocks);
#endif
}
```

```cpp
#include <hip/hip_runtime.h>
#include <hip/hip_cooperative_groups.h>
#include <cstdio>
namespace cg = cooperative_groups;

#ifndef REP0
#define REP0 1
#endif
#ifndef REP1
#define REP1 1
#endif
#ifndef REP2
#define REP2 1
#endif
#ifndef REP3
#define REP3 1
#endif
#ifndef REP4
#define REP4 1
#endif
#ifndef MULTI_LAUNCH
#define MULTI_LAUNCH 0
#endif

typedef _Float16 h16;
typedef __attribute__((ext_vector_type(8))) _Float16 h16x8;
typedef __attribute__((ext_vector_type(4))) _Float16 h16x4;
typedef __attribute__((ext_vector_type(4))) float f32x4;

#define MFMA(a, b, c) __builtin_amdgcn_mfma_f32_16x16x32_f16((a), (b), (c), 0, 0, 0)

constexpr int T_TOK = 32768;
constexpr int SEQ = 2048;
constexpr int NPH = 7;
constexpr int LDP = 3072;
constexpr int SMEM_BYTES = 70400;

constexpr size_t SZ_WIN = (size_t)3200 * 1024 * 2;
constexpr size_t SZ_WGLU = (size_t)512 * 512 * 2;
constexpr size_t SZ_WOUT = (size_t)1024 * 1024 * 2;
constexpr size_t SZ_WPP = (size_t)1024 * 256 * 2;
constexpr size_t SZ_WGATE = (size_t)1024 * 1024 * 2;
constexpr size_t OFF_WIN = 0;
constexpr size_t OFF_WGLU = OFF_WIN + SZ_WIN;
constexpr size_t OFF_WOUT = OFF_WGLU + SZ_WGLU;
constexpr size_t OFF_WPP = OFF_WOUT + SZ_WOUT;
constexpr size_t OFF_WGATE = OFF_WPP + SZ_WPP;
constexpr size_t OFF_PB = OFF_WGATE + SZ_WGATE;
constexpr size_t OFF_PROJ = OFF_PB + (size_t)T_TOK * 256 * 2;
constexpr size_t OFF_AB = OFF_PROJ + (size_t)T_TOK * LDP * 2;
constexpr size_t OFF_KTAB = OFF_AB + (size_t)T_TOK * 8 * 4;
constexpr size_t OFF_ETAB = OFF_KTAB + (size_t)32 * 33 * 256 * 2;
constexpr size_t OFF_FTAB = OFF_ETAB + (size_t)32 * 128 * 512 * 2;
constexpr size_t OFF_ALPOW = OFF_FTAB + (size_t)32 * 512 * 128 * 2;
constexpr size_t OFF_DL = OFF_ALPOW + (size_t)32 * 64 * 2 * 4;
constexpr size_t OFF_EPART = OFF_DL + (size_t)2048 * 4;
constexpr size_t OFF_OPART = OFF_EPART + (size_t)T_TOK * 16 * 4;
constexpr size_t OFF_MIXIN = OFF_OPART + (size_t)T_TOK * 16 * 4;
constexpr size_t OFF_WP = OFF_MIXIN + (size_t)T_TOK * 1024 * 2;
constexpr size_t OFF_QGP = OFF_WP + (size_t)2048 * 64 * 128 * 2;
constexpr size_t OFF_KDT = OFF_QGP + (size_t)2048 * 64 * 128 * 2;
constexpr size_t OFF_UT = OFF_KDT + (size_t)2048 * 128 * 64 * 2;
constexpr size_t OFF_ATP = OFF_UT + (size_t)2048 * 128 * 64 * 2;
constexpr size_t OFF_EH = OFF_ATP + (size_t)2048 * 64 * 64 * 2;
constexpr size_t OFF_BAR = OFF_EH + (size_t)T_TOK * 1024 * 2;
constexpr size_t WS_END = OFF_BAR + 16384;
constexpr size_t OUT_OFF_A0 = 0;
constexpr size_t OUT_OFF_YPRE = (size_t)T_TOK * 1024 * 2;
constexpr size_t OUT_OFF_ZT = OUT_OFF_YPRE + (size_t)T_TOK * 512 * 2;

struct Params {
  const float* in[23];
  float* out;
  unsigned char* ws;
  int ph_lo, ph_hi;
};

enum { I_X = 0, I_P, I_NMG, I_WIN, I_ARE, I_AIM, I_BRE, I_BIM, I_CRE, I_CIM, I_D, I_LOGDT, I_WGLU, I_BGLU,
       I_CONVW, I_ALOG, I_DTB, I_DNG, I_WOUT, I_WPP, I_PLEG, I_WGATE, I_FING };

__device__ __forceinline__ float wave_sum(float v) {
#pragma unroll
  for (int o = 32; o > 0; o >>= 1) v += __shfl_xor(v, o);
  return v;
}
__device__ __forceinline__ float sum16(float v) {
  v += __shfl_xor(v, 1); v += __shfl_xor(v, 2); v += __shfl_xor(v, 4); v += __shfl_xor(v, 8);
  return v;
}
__device__ __forceinline__ float sigmoidf_(float x) { return 1.f / (1.f + __expf(-x)); }
__device__ __forceinline__ float siluf_(float x) { return x / (1.f + __expf(-x)); }
__device__ __forceinline__ float gelu_tanh(float y) {
  float z = 0.7978845608028654f * (y + 0.044715f * y * y * y);
  return 0.5f * y * (1.f + tanhf(z));
}
__device__ __forceinline__ h16x8 pack8(f32x4 lo, f32x4 hi) {
  h16x8 r;
  r[0] = (h16)lo[0]; r[1] = (h16)lo[1]; r[2] = (h16)lo[2]; r[3] = (h16)lo[3];
  r[4] = (h16)hi[0]; r[5] = (h16)hi[1]; r[6] = (h16)hi[2]; r[7] = (h16)hi[3];
  return r;
}
__device__ __forceinline__ int perm_pos(int n) { return (n & ~31) + (((n & 15) >> 2) << 3) + (((n >> 4) & 1) << 2) + (n & 3); }
__device__ __forceinline__ int perm_inv(int pos) {
  int q5 = pos & 31, qq = q5 >> 3, jj = q5 & 7;
  return (pos & ~31) + (jj < 4 ? 4 * qq + jj : 16 + 4 * qq + (jj - 4));
}

__device__ void transpose_w(const float* __restrict__ W, int K, int N, int Npad, h16* __restrict__ WT, int t, float* tile) {
  const int ntn = Npad / 64;
  const int kt = t / ntn, nt = t % ntn, k0 = kt * 64, n0 = nt * 64;
  const int tx = threadIdx.x & 63, ty = threadIdx.x >> 6;
  for (int r = 0; r < 16; ++r) {
    int k = ty * 16 + r, n = n0 + tx;
    tile[k * 65 + tx] = (n < N) ? W[(size_t)(k0 + k) * N + n] : 0.f;
  }
  __syncthreads();
  for (int r = 0; r < 16; ++r) {
    int n = ty * 16 + r;
    WT[(size_t)(n0 + n) * K + k0 + tx] = (h16)tile[tx * 65 + n];
  }
  __syncthreads();
}

__device__ void ssm_table_item(const Params& p, int g, int d, float* lds) {
  float2* sAp = (float2*)lds;
  float2* sW = sAp + 64;
  const int tid = threadIdx.x;
  h16* KTAB = (h16*)(p.ws + OFF_KTAB);
  h16* ETAB = (h16*)(p.ws + OFF_ETAB);
  h16* FTAB = (h16*)(p.ws + OFF_FTAB);
  float* ALPOW = (float*)(p.ws + OFF_ALPOW);
  float* sBr = lds + 256; float* sBi = sBr + 1024; float* sCr = sBi + 1024; float* sCi = sCr + 16 * 65;
  {
    const float4 vbr = ((const float4*)(p.in[I_BRE] + g * 1024))[tid], vbi = ((const float4*)(p.in[I_BIM] + g * 1024))[tid];
    const float4 vcr = ((const float4*)(p.in[I_CRE] + g * 1024))[tid], vci = ((const float4*)(p.in[I_CIM] + g * 1024))[tid];
    *(float4*)(sBr + tid * 4) = vbr; *(float4*)(sBi + tid * 4) = vbi;
    const int ch = (tid * 4) >> 6, cp = (tid * 4) & 63;
    sCr[ch * 65 + cp] = vcr.x; sCr[ch * 65 + cp + 1] = vcr.y; sCr[ch * 65 + cp + 2] = vcr.z; sCr[ch * 65 + cp + 3] = vcr.w;
    sCi[ch * 65 + cp] = vci.x; sCi[ch * 65 + cp + 1] = vci.y; sCi[ch * 65 + cp + 2] = vci.z; sCi[ch * 65 + cp + 3] = vci.w;
  }
  if (tid < 64) {
    const int pp = tid;
    float lr = p.in[I_ARE][g * 64 + pp], li = p.in[I_AIM][g * 64 + pp], dt = expf(p.in[I_LOGDT][g]);
    float mag = expf(lr * dt), ang = li * dt;
    float abr = mag * cosf(ang), abi = mag * sinf(ang);
    float nr = abr - 1.f, ni = abi, den = lr * lr + li * li;
    float cr = (nr * lr + ni * li) / den, ci = (ni * lr - nr * li) / den;
    float apr = 1.f, api = 0.f;
    for (int k = 0; k < d; ++k) { float t0 = apr * abr - api * abi; api = apr * abi + api * abr; apr = t0; }
    sAp[pp] = make_float2(apr, api);
    sW[pp] = make_float2(apr * cr - api * ci, apr * ci + api * cr);
    if (d == 32) { ALPOW[(g * 64 + pp) * 2] = apr; ALPOW[(g * 64 + pp) * 2 + 1] = api; }
  }
  __syncthreads();
  if (d < 32) {
    {
      const int h = tid >> 4, hp = tid & 15;
      float acc = 0.f;
#pragma unroll 8
      for (int pp = 0; pp < 64; ++pp) {
        float2 W = sW[pp];
        float br = sBr[pp * 16 + hp], bi = sBi[pp * 16 + hp];
        float wbr = W.x * br - W.y * bi, wbi = W.x * bi + W.y * br;
        float cr = sCr[h * 65 + pp], ci = sCi[h * 65 + pp];
        acc += cr * wbr - ci * wbi;
      }
      KTAB[(size_t)(g * 33 + d + 1) * 256 + h * 16 + hp] = (h16)acc;
      if (d == 0) KTAB[(size_t)(g * 33) * 256 + tid] = (h16)0.f;
    }
    {
      const int i = 31 - d;
#pragma unroll
      for (int r = 0; r < 4; ++r) {
        int idx = tid + 256 * r, pp = idx >> 4, hp = idx & 15;
        float2 W = sW[pp];
        float br = sBr[pp * 16 + hp], bi = sBi[pp * 16 + hp];
        float wbr = W.x * br - W.y * bi, wbi = W.x * bi + W.y * br;
        ETAB[((size_t)g * 128 + pp) * 512 + i * 16 + hp] = (h16)wbr;
        ETAB[((size_t)g * 128 + 64 + pp) * 512 + i * 16 + hp] = (h16)wbi;
      }
    }
  }
  if (d >= 1) {
    const int j = d - 1;
#pragma unroll
    for (int r = 0; r < 4; ++r) {
      int idx = tid + 256 * r, h = idx >> 6, pp = idx & 63;
      float2 Ap = sAp[pp];
      float cr = sCr[h * 65 + pp], ci = sCi[h * 65 + pp];
      float re = cr * Ap.x - ci * Ap.y, im = cr * Ap.y + ci * Ap.x;
      FTAB[((size_t)g * 512 + j * 16 + h) * 128 + pp] = (h16)re;
      FTAB[((size_t)g * 512 + j * 16 + h) * 128 + 64 + pp] = (h16)(-im);
    }
  }
  __syncthreads();
}

__device__ void phase0(const Params& p, unsigned char* smem) {
  const int bid = blockIdx.x, nb = gridDim.x, tid = threadIdx.x, wid = tid >> 6, lane = tid & 63;
  float* tile = (float*)smem;
  for (int t = bid; t < 1440; t += nb) {
    if (t < 800) transpose_w(p.in[I_WIN], 1024, 3080, 3200, (h16*)(p.ws + OFF_WIN), t, tile);
    else if (t < 864) transpose_w(p.in[I_WGLU], 512, 512, 512, (h16*)(p.ws + OFF_WGLU), t - 800, tile);
    else if (t < 1120) transpose_w(p.in[I_WOUT], 1024, 1024, 1024, (h16*)(p.ws + OFF_WOUT), t - 864, tile);
    else if (t < 1184) transpose_w(p.in[I_WPP], 256, 1024, 1024, (h16*)(p.ws + OFF_WPP), t - 1120, tile);
    else transpose_w(p.in[I_WGATE], 1024, 1024, 1024, (h16*)(p.ws + OFF_WGATE), t - 1184, tile);
  }
  for (int it = bid; it < 32 * 33; it += nb) ssm_table_item(p, it / 33, it % 33, (float*)smem);
  {
    h16* A0 = (h16*)((unsigned char*)p.out + OUT_OFF_A0);
    const float* x = p.in[I_X];
    const float4* g4 = (const float4*)p.in[I_NMG];
    for (int row = bid * 4 + wid; row < T_TOK; row += nb * 4) {
      const float4* xr = (const float4*)(x + (size_t)row * 1024);
      float4 v[4];
      float ss = 0.f;
#pragma unroll
      for (int i = 0; i < 4; ++i) {
        v[i] = xr[lane + i * 64];
        ss += v[i].x * v[i].x + v[i].y * v[i].y + v[i].z * v[i].z + v[i].w * v[i].w;
      }
      ss = wave_sum(ss);
      float rstd = rsqrtf(ss * (1.f / 1024.f) + 1e-6f);
#pragma unroll
      for (int i = 0; i < 4; ++i) {
        float4 g = g4[lane + i * 64];
        h16x4 o;
        o[0] = (h16)(v[i].x * rstd * g.x); o[1] = (h16)(v[i].y * rstd * g.y);
        o[2] = (h16)(v[i].z * rstd * g.z); o[3] = (h16)(v[i].w * rstd * g.w);
        *(h16x4*)(A0 + (size_t)row * 1024 + (lane + i * 64) * 4) = o;
      }
    }
  }
  {
    h16* PB = (h16*)(p.ws + OFF_PB);
    const float4* p4 = (const float4*)p.in[I_P];
    const size_t n4 = (size_t)T_TOK * 256 / 4;
    for (size_t i = (size_t)bid * 256 + tid; i < n4; i += (size_t)nb * 256) {
      float4 v = p4[i];
      h16x4 o;
      o[0] = (h16)v.x; o[1] = (h16)v.y; o[2] = (h16)v.z; o[3] = (h16)v.w;
      *(h16x4*)(PB + i * 4) = o;
    }
  }
}

enum { EPI_PROJ = 0, EPI_GLU, EPI_PLE, EPI_OUT, EPI_GATE };

template <int EPI>
__device__ __forceinline__ void gemm_tile(const Params& p, const h16* __restrict__ A, int lda, const h16* __restrict__ Bt, int ldb,
                                          int K, int brow, int bcol, unsigned char* smem) {
  const int tid = threadIdx.x, wid = tid >> 6, lane = tid & 63, wr = wid >> 1, wc = wid & 1, fr = lane & 15, fq = lane >> 4;
  unsigned char* SA = smem;
  unsigned char* SB = smem + 128 * 32 * 2;
  f32x4 acc[4][4];
#pragma unroll
  for (int m = 0; m < 4; ++m)
#pragma unroll
    for (int n = 0; n < 4; ++n) acc[m][n] = f32x4{0.f, 0.f, 0.f, 0.f};
  const int nk = K / 32;
  for (int t = 0; t < nk; ++t) {
#pragma unroll
    for (int i = 0; i < 2; ++i) {
      int b = tid * 16 + i * 4096, r = b >> 6, c = (b & 63) >> 1;
      __builtin_amdgcn_global_load_lds((const unsigned*)(A + (size_t)(brow + r) * lda + t * 32 + c), (unsigned*)(SA + b), 16, 0, 0);
      __builtin_amdgcn_global_load_lds((const unsigned*)(Bt + (size_t)(bcol + r) * ldb + t * 32 + c), (unsigned*)(SB + b), 16, 0, 0);
    }
    asm volatile("s_waitcnt vmcnt(0)" ::: "memory");
    __syncthreads();
    h16x8 af[4], bf[4];
#pragma unroll
    for (int m = 0; m < 4; ++m) {
      af[m] = *(const h16x8*)(SA + (wr * 64 + m * 16 + fr) * 64 + fq * 16);
      bf[m] = *(const h16x8*)(SB + (wc * 64 + m * 16 + fr) * 64 + fq * 16);
    }
#pragma unroll
    for (int m = 0; m < 4; ++m)
#pragma unroll
      for (int n = 0; n < 4; ++n) acc[m][n] = MFMA(af[m], bf[n], acc[m][n]);
    __syncthreads();
  }
  if constexpr (EPI == EPI_PROJ) {
    h16* PROJ = (h16*)(p.ws + OFF_PROJ);
    float* AB = (float*)(p.ws + OFF_AB);
#pragma unroll
    for (int m = 0; m < 4; ++m)
#pragma unroll
      for (int n = 0; n < 4; ++n) {
        const int col = bcol + wc * 64 + n * 16 + fr;
#pragma unroll
        for (int j = 0; j < 4; ++j) {
          const size_t row = brow + wr * 64 + m * 16 + fq * 4 + j;
          if (col < 3072) PROJ[row * LDP + col] = (h16)acc[m][n][j];
          else if (col < 3080) AB[row * 8 + (col - 3072)] = acc[m][n][j];
        }
      }
  } else if constexpr (EPI == EPI_GLU) {
    const h16* PROJ = (const h16*)(p.ws + OFF_PROJ);
    const h16* YPRE = (const h16*)((unsigned char*)p.out + OUT_OFF_YPRE);
    h16* MIXIN = (h16*)(p.ws + OFF_MIXIN);
    const float* bglu = p.in[I_BGLU];
#pragma unroll
    for (int m = 0; m < 4; ++m)
#pragma unroll
      for (int n = 0; n < 4; ++n) {
        const int col = bcol + wc * 64 + n * 16 + fr;
        const float bb = bglu[col];
#pragma unroll
        for (int j = 0; j < 4; ++j) {
          const size_t row = brow + wr * 64 + m * 16 + fq * 4 + j;
          float y = (float)YPRE[row * 512 + col];
          float z = (float)PROJ[row * LDP + 512 + col];
          float o = y * sigmoidf_(acc[m][n][j] + bb) * siluf_(z);
          MIXIN[row * 1024 + col] = (h16)o;
        }
      }
  } else if constexpr (EPI == EPI_PLE) {
    h16* EH = (h16*)(p.ws + OFF_EH);
    float* EPART = (float*)(p.ws + OFF_EPART);
#pragma unroll
    for (int m = 0; m < 4; ++m) {
#pragma unroll
      for (int j = 0; j < 4; ++j) {
        const size_t row = brow + wr * 64 + m * 16 + fq * 4 + j;
        float s = 0.f;
#pragma unroll
        for (int n = 0; n < 4; ++n) {
          const int col = bcol + wc * 64 + n * 16 + fr;
          float v = acc[m][n][j];
          s += v * v;
          EH[row * 1024 + col] = (h16)v;
        }
        s = sum16(s);
        if (fr == 0) EPART[row * 16 + (bcol >> 7) * 2 + wc] = s;
      }
    }
  } else if constexpr (EPI == EPI_OUT) {
    const float* x = p.in[I_X];
    h16* HB = (h16*)(p.ws + OFF_PROJ);
#pragma unroll
    for (int m = 0; m < 4; ++m)
#pragma unroll
      for (int n = 0; n < 4; ++n) {
        const int col = bcol + wc * 64 + n * 16 + fr;
#pragma unroll
        for (int j = 0; j < 4; ++j) {
          const size_t row = brow + wr * 64 + m * 16 + fq * 4 + j;
          float hv = x[row * 1024 + col] + acc[m][n][j];
          p.out[row * 1024 + col] = hv;
          HB[row * 1024 + col] = (h16)hv;
        }
      }
  } else if constexpr (EPI == EPI_GATE) {
    const h16* EH = (const h16*)(p.ws + OFF_EH);
    const float* EPART = (const float*)(p.ws + OFF_EPART);
    float* OPART = (float*)(p.ws + OFF_OPART);
    const float* pg = p.in[I_PLEG];
    float* sr = (float*)smem;
    if (tid < 128) {
      const float* ep = EPART + (size_t)(brow + tid) * 16;
      float s = 0.f;
#pragma unroll
      for (int i = 0; i < 16; ++i) s += ep[i];
      sr[tid] = rsqrtf(s * (1.f / 1024.f) + 1e-6f);
    }
    __syncthreads();
#pragma unroll
    for (int m = 0; m < 4; ++m) {
#pragma unroll
      for (int j = 0; j < 4; ++j) {
        const int rl = wr * 64 + m * 16 + fq * 4 + j;
        const size_t row = brow + rl;
        const float rs = sr[rl];
        float s = 0.f;
#pragma unroll
        for (int n = 0; n < 4; ++n) {
          const int col = bcol + wc * 64 + n * 16 + fr;
          float gate = sigmoidf_(acc[m][n][j]);
          float e = (float)EH[row * 1024 + col] * rs * pg[col];
          float h2 = p.out[row * 1024 + col] + gate * e;
          p.out[row * 1024 + col] = h2;
          s += h2 * h2;
        }
        s = sum16(s);
        if (fr == 0) OPART[row * 16 + (bcol >> 7) * 2 + wc] = s;
      }
    }
    __syncthreads();
  }
}

__device__ void ssm_item(const Params& p, int b, int g, unsigned char* smem) {
  float* LOCAL = (float*)smem;
  h16* SPREV = (h16*)(smem + 33792);
  h16* KT = (h16*)(smem + 51200);
  int tid_ = threadIdx.x;
  asm volatile("" : "+v"(tid_));
  const int tid = tid_, w = tid >> 6, lane = tid & 63, fr = lane & 15, fq = lane >> 4;
  const h16* PROJ = (const h16*)(p.ws + OFF_PROJ);
  const h16* Eg = (const h16*)(p.ws + OFF_ETAB) + (size_t)g * 128 * 512;
  const h16* Kg = (const h16*)(p.ws + OFF_KTAB) + (size_t)g * 33 * 256;
  const h16* Fg = (const h16*)(p.ws + OFF_FTAB) + (size_t)g * 512 * 128;
  const float* ALPOW = (const float*)(p.ws + OFF_ALPOW);
  h16* YPRE = (h16*)((unsigned char*)p.out + OUT_OFF_YPRE);
  const int nchunk = w * 16 + fr;
  const size_t tok0 = (size_t)b * SEQ + (size_t)nchunk * 32;
  for (int idx = tid; idx < 33 * 256 / 8; idx += 256) *(h16x8*)(KT + idx * 8) = *(const h16x8*)(Kg + idx * 8);
  h16x8 uf[16];
#pragma unroll
  for (int ks = 0; ks < 16; ++ks) {
    const int i = 2 * ks + (fq >> 1);
    uf[ks] = *(const h16x8*)(PROJ + (tok0 + i) * LDP + g * 16 + (fq & 1) * 8);
  }
  {
    h16x8 ea[8];
#pragma unroll
    for (int ks = 0; ks < 8; ++ks) ea[ks] = *(const h16x8*)(Eg + (size_t)fr * 512 + ks * 32 + fq * 8);
    f32x4 acc = {0.f, 0.f, 0.f, 0.f};
#pragma unroll 1
    for (int it = 0; it < 16; ++it) {
      const int mt = it >> 1, hf = it & 1;
      const int itn = it < 15 ? it + 1 : 15;
      h16x8 en[8];
#pragma unroll
      for (int ks = 0; ks < 8; ++ks) en[ks] = *(const h16x8*)(Eg + (size_t)((itn >> 1) * 16 + fr) * 512 + ((itn & 1) * 8 + ks) * 32 + fq * 8);
      if (hf == 0) {
#pragma unroll
        for (int ks = 0; ks < 8; ++ks) acc = MFMA(ea[ks], uf[ks], acc);
      } else {
#pragma unroll
        for (int ks = 0; ks < 8; ++ks) acc = MFMA(ea[ks], uf[8 + ks], acc);
        *(f32x4*)(LOCAL + nchunk * 132 + mt * 16 + fq * 4) = acc;
        acc = f32x4{0.f, 0.f, 0.f, 0.f};
      }
#pragma unroll
      for (int ks = 0; ks < 8; ++ks) ea[ks] = en[ks];
    }
  }
  __syncthreads();
  if (tid < 64) {
    const int pp = tid;
    const float ar = ALPOW[(g * 64 + pp) * 2], ai = ALPOW[(g * 64 + pp) * 2 + 1];
    float sr = 0.f, si = 0.f;
#pragma unroll 4
    for (int c = 0; c < 64; ++c) {
      SPREV[c * 136 + pp] = (h16)sr;
      SPREV[c * 136 + 64 + pp] = (h16)si;
      float lr = LOCAL[c * 132 + pp], li = LOCAL[c * 132 + 64 + pp];
      float nr = ar * sr - ai * si + lr;
      float ni = ar * si + ai * sr + li;
      sr = nr; si = ni;
    }
  }
  __syncthreads();
  h16x8 sf[4];
#pragma unroll
  for (int ks = 0; ks < 4; ++ks) sf[ks] = *(const h16x8*)(SPREV + nchunk * 136 + ks * 32 + fq * 8);
  const float4 Dv = *(const float4*)(p.in[I_D] + g * 16 + fq * 4);
  h16x8 fa[4];
#pragma unroll
  for (int ks = 0; ks < 4; ++ks) fa[ks] = *(const h16x8*)(Fg + (size_t)fr * 128 + ks * 32 + fq * 8);
  h16x4 u4 = *(const h16x4*)(PROJ + tok0 * LDP + g * 16 + fq * 4);
#pragma unroll 1
  for (int j = 0; j < 32; ++j) {
    const int jn = j < 31 ? j + 1 : 31;
    h16x8 fn[4];
#pragma unroll
    for (int ks = 0; ks < 4; ++ks) fn[ks] = *(const h16x8*)(Fg + (size_t)(jn * 16 + fr) * 128 + ks * 32 + fq * 8);
    const h16x4 un = *(const h16x4*)(PROJ + (tok0 + jn) * LDP + g * 16 + fq * 4);
    f32x4 acc = {0.f, 0.f, 0.f, 0.f};
#pragma unroll
    for (int ks = 0; ks < 16; ++ks) {
      if (2 * ks <= j) {
        const int dd = j - 2 * ks - (fq >> 1) + 1;
        h16x8 a = *(const h16x8*)(KT + dd * 256 + fr * 16 + (fq & 1) * 8);
        acc = MFMA(a, uf[ks], acc);
      }
    }
#pragma unroll
    for (int ks = 0; ks < 4; ++ks) acc = MFMA(fa[ks], sf[ks], acc);
    const size_t tok = tok0 + j;
    h16x4 o;
    o[0] = (h16)gelu_tanh(acc[0] + Dv.x * (float)u4[0]);
    o[1] = (h16)gelu_tanh(acc[1] + Dv.y * (float)u4[1]);
    o[2] = (h16)gelu_tanh(acc[2] + Dv.z * (float)u4[2]);
    o[3] = (h16)gelu_tanh(acc[3] + Dv.w * (float)u4[3]);
    *(h16x4*)(YPRE + tok * 512 + g * 16 + fq * 4) = o;
#pragma unroll
    for (int ks = 0; ks < 4; ++ks) fa[ks] = fn[ks];
    u4 = un;
  }
  __syncthreads();
}

__device__ void gdn_pre_item(const Params& p, int item, unsigned char* smem) {
  h16* QH = (h16*)smem;
  h16* KH = (h16*)(smem + 17408);
  h16* VH = (h16*)(smem + 34816);
  float* LT = (float*)(smem + 52224);
  float* sG = (float*)(smem + 69632);
  float* sBeta = (float*)(smem + 69888);
  int tid_ = threadIdx.x;
  asm volatile("" : "+v"(tid_));
  const int tid = tid_, w = tid >> 6, lane = tid & 63, fr = lane & 15, fq = lane >> 4;
  const int c = item & 31, h = (item >> 5) & 3, b = item >> 7;
  const h16* PROJ = (const h16*)(p.ws + OFF_PROJ);
  const float* AB = (const float*)(p.ws + OFF_AB);
  const float* convw = p.in[I_CONVW];
  h16* WPi = (h16*)(p.ws + OFF_WP) + (size_t)item * 64 * 128;
  h16* QGPi = (h16*)(p.ws + OFF_QGP) + (size_t)item * 64 * 128;
  h16* KDTi = (h16*)(p.ws + OFF_KDT) + (size_t)item * 128 * 64;
  h16* UTi = (h16*)(p.ws + OFF_UT) + (size_t)item * 128 * 64;
  h16* ATPi = (h16*)(p.ws + OFF_ATP) + (size_t)item * 64 * 64;
  h16* ZTi = (h16*)((unsigned char*)p.out + OUT_OFF_ZT) + (size_t)item * 128 * 64;
  float* DL = (float*)(p.ws + OFF_DL);
  {
    const int ch0 = (tid & 15) * 8, trow = tid >> 4;
#pragma unroll 1
    for (int pass = 0; pass < 4; ++pass) {
      const int t = pass * 16 + trow, tl = c * 64 + t;
#pragma unroll
      for (int sec = 0; sec < 3; ++sec) {
        const int colbase = 1024 + sec * 512 + h * 128 + ch0;
        float a[8];
#pragma unroll
        for (int e = 0; e < 8; ++e) a[e] = 0.f;
#pragma unroll
        for (int jj = 0; jj < 4; ++jj) {
          const int ts = tl - 3 + jj;
          if (ts >= 0) {
            h16x8 xv = *(const h16x8*)(PROJ + ((size_t)b * SEQ + ts) * LDP + colbase);
            const float4 w0 = *(const float4*)(convw + jj * 1536 + sec * 512 + h * 128 + ch0);
            const float4 w1 = *(const float4*)(convw + jj * 1536 + sec * 512 + h * 128 + ch0 + 4);
            a[0] += w0.x * (float)xv[0]; a[1] += w0.y * (float)xv[1]; a[2] += w0.z * (float)xv[2]; a[3] += w0.w * (float)xv[3];
            a[4] += w1.x * (float)xv[4]; a[5] += w1.y * (float)xv[5]; a[6] += w1.z * (float)xv[6]; a[7] += w1.w * (float)xv[7];
          }
        }
        float ss = 0.f;
#pragma unroll
        for (int e = 0; e < 8; ++e) { a[e] = siluf_(a[e]); ss += a[e] * a[e]; }
        float scale = 1.f;
        if (sec < 2) {
          ss = sum16(ss);
          scale = rsqrtf(ss + 1e-6f) * (sec == 0 ? 0.08838834764831845f : 1.f);
        }
        h16x8 o;
#pragma unroll
        for (int e = 0; e < 8; ++e) o[e] = (h16)(a[e] * scale);
        h16* dst = (sec == 0 ? QH : (sec == 1 ? KH : VH));
        *(h16x8*)(dst + t * 136 + ch0) = o;
      }
    }
  }
  if (tid < 64) {
    const size_t tok = (size_t)b * SEQ + c * 64 + tid;
    float braw = AB[tok * 8 + h], araw = AB[tok * 8 + 4 + h];
    float beta = 1.f / (1.f + expf(-braw));
    float xx = araw + p.in[I_DTB][h];
    float sp = xx > 20.f ? xx : log1pf(expf(xx));
    float gg = -expf(p.in[I_ALOG][h]) * sp;
#pragma unroll
    for (int o = 1; o < 64; o <<= 1) {
      float v = __shfl_up(gg, o);
      if (lane >= o) gg += v;
    }
    sG[tid] = gg;
    sBeta[tid] = beta;
  }
  __syncthreads();
  {
    h16x8 ak[4], aq[4];
#pragma unroll
    for (int ks = 0; ks < 4; ++ks) {
      ak[ks] = *(const h16x8*)(KH + (w * 16 + fr) * 136 + ks * 32 + fq * 8);
      aq[ks] = *(const h16x8*)(QH + (w * 16 + fr) * 136 + ks * 32 + fq * 8);
    }
#pragma unroll
    for (int jt = 0; jt < 4; ++jt) {
      const int j = jt * 16 + fr;
      const int pj = perm_pos(j);
      if (jt <= w) {
        f32x4 kk = {0.f, 0.f, 0.f, 0.f}, qk = {0.f, 0.f, 0.f, 0.f};
#pragma unroll
        for (int ks = 0; ks < 4; ++ks) {
          h16x8 bk = *(const h16x8*)(KH + (jt * 16 + fr) * 136 + ks * 32 + fq * 8);
          kk = MFMA(ak[ks], bk, kk);
          qk = MFMA(aq[ks], bk, qk);
        }
        const float Gj = sG[j];
        f32x4 lt;
#pragma unroll
        for (int r = 0; r < 4; ++r) {
          const int i = w * 16 + 4 * fq + r;
          const float e = (i >= j) ? expf(sG[i] - Gj) : 0.f;
          lt[r] = (i > j) ? sBeta[i] * kk[r] * e : 0.f;
          ATPi[i * 64 + (((pj >> 3) ^ (i & 7)) << 3) + (pj & 7)] = (h16)(qk[r] * e);
        }
        *(f32x4*)(LT + j * 68 + w * 16 + 4 * fq) = lt;
      } else {
#pragma unroll
        for (int r = 0; r < 4; ++r) {
          const int i = w * 16 + 4 * fq + r;
          ATPi[i * 64 + (((pj >> 3) ^ (i & 7)) << 3) + (pj & 7)] = (h16)0.f;
        }
      }
    }
  }
  __syncthreads();
  float r[64];
  if (tid < 128) {
#pragma unroll
    for (int t = 0; t < 64; ++t) r[t] = (float)VH[t * 136 + tid] * sBeta[t];
  } else {
#pragma unroll
    for (int t = 0; t < 64; ++t) r[t] = (float)KH[t * 136 + (tid - 128)] * sBeta[t] * expf(sG[t]);
  }
#pragma unroll
  for (int j = 0; j < 63; ++j) {
    const float xj = r[j];
#pragma unroll
    for (int i4 = (j + 1) / 4; i4 < 16; ++i4) {
      const f32x4 l = *(const f32x4*)(LT + j * 68 + i4 * 4);
#pragma unroll
      for (int e = 0; e < 4; ++e) {
        if (i4 * 4 + e > j) r[i4 * 4 + e] -= l[e] * xj;
      }
    }
    __builtin_amdgcn_sched_barrier(0);
  }
  if (tid < 128) {
#pragma unroll
    for (int t8 = 0; t8 < 8; ++t8) {
      h16x8 v;
#pragma unroll
      for (int e = 0; e < 8; ++e) v[e] = (h16)r[t8 * 8 + e];
      *(h16x8*)(UTi + (size_t)tid * 64 + t8 * 8) = v;
    }
  }
  __syncthreads();
  if (tid >= 128) {
    const int pos = perm_pos(tid - 128);
#pragma unroll
    for (int t = 0; t < 64; ++t) VH[t * 136 + pos] = (h16)r[t];
  }
  __syncthreads();
  for (int rr = 0; rr < 4; ++rr) {
    const int idx = tid + 256 * rr, row = idx >> 4, seg = idx & 15;
    *(h16x8*)(WPi + row * 128 + ((seg ^ (row & 15)) << 3)) = *(const h16x8*)(VH + row * 136 + seg * 8);
  }
  {
    const int dv = tid & 127, th = tid >> 7;
    const float gdv = p.in[I_DNG][dv];
    const h16* zp = PROJ + ((size_t)b * SEQ + c * 64 + th * 32) * LDP + 2560 + h * 128 + dv;
    h16 zv[32];
#pragma unroll
    for (int t = 0; t < 32; ++t) zv[t] = zp[(size_t)t * LDP];
#pragma unroll
    for (int t8 = 0; t8 < 4; ++t8) {
      h16x8 v;
#pragma unroll
      for (int e = 0; e < 8; ++e) v[e] = (h16)(siluf_((float)zv[t8 * 8 + e]) * gdv);
      *(h16x8*)(ZTi + (size_t)dv * 64 + th * 32 + t8 * 8) = v;
    }
  }
#pragma unroll 2
  for (int rr = 0; rr < 32; ++rr) {
    const int idx = tid + 256 * rr, t = idx >> 7, pp = idx & 127;
    const int dk = perm_inv(pp);
    QGPi[t * 128 + (((pp >> 3) ^ (t & 15)) << 3) + (pp & 7)] = (h16)((float)QH[t * 136 + dk] * expf(sG[t]));
  }
  const float Glast = sG[63];
#pragma unroll 2
  for (int rr = 0; rr < 32; ++rr) {
    const int idx = tid + 256 * rr, dk = idx >> 6, tp = idx & 63;
    const int t = perm_inv(tp);
    KDTi[dk * 64 + (((tp >> 3) ^ (dk & 7)) << 3) + (tp & 7)] = (h16)((float)KH[t * 136 + dk] * expf(Glast - sG[t]));
  }
  if (tid == 0) DL[item] = expf(Glast);
  __syncthreads();
}

template <int NB>
__device__ __forceinline__ void glds_copy(const h16* __restrict__ g, unsigned char* l) {
#pragma unroll
  for (int i = 0; i < NB / 4096; ++i) {
    const int off = threadIdx.x * 16 + i * 4096;
    __builtin_amdgcn_global_load_lds((const unsigned*)((const unsigned char*)g + off), (unsigned*)(l + off), 16, 0, 0);
  }
}
#define RAW_BARRIER() do { asm volatile("s_waitcnt lgkmcnt(0)" ::: "memory"); __builtin_amdgcn_s_barrier(); asm volatile("" ::: "memory"); } while (0)

__device__ void gdn_recurrence(const Params& p, int bh, unsigned char* smem) {
  unsigned char* LW = smem;
  unsigned char* LQ = smem + 16384;
  unsigned char* LA = smem + 32768;
  unsigned char* LK = smem + 40960;
  float* red = (float*)(smem + 57344);
  const int tid = threadIdx.x, w = tid >> 6, lane = tid & 63, fr = lane & 15, fq = lane >> 4;
  const int b = bh >> 2, h = bh & 3;
  h16* MIXIN = (h16*)(p.ws + OFF_MIXIN);
  const float* DL = (const float*)(p.ws + OFF_DL);
  const h16* WPb = (const h16*)(p.ws + OFF_WP) + (size_t)bh * 32 * 64 * 128;
  const h16* QGPb = (const h16*)(p.ws + OFF_QGP) + (size_t)bh * 32 * 64 * 128;
  const h16* KDTb = (const h16*)(p.ws + OFF_KDT) + (size_t)bh * 32 * 128 * 64;
  const h16* UTb = (const h16*)(p.ws + OFF_UT) + (size_t)bh * 32 * 128 * 64;
  const h16* ATPb = (const h16*)(p.ws + OFF_ATP) + (size_t)bh * 32 * 64 * 64;
  const h16* ZTb = (const h16*)((unsigned char*)p.out + OUT_OFF_ZT) + (size_t)bh * 32 * 128 * 64;
  f32x4 S[8][2];
#pragma unroll
  for (int i = 0; i < 8; ++i) { S[i][0] = f32x4{0.f, 0.f, 0.f, 0.f}; S[i][1] = f32x4{0.f, 0.f, 0.f, 0.f}; }
  h16x4 uR[4][2];
  glds_copy<16384>(WPb, LW); glds_copy<16384>(QGPb, LQ); glds_copy<8192>(ATPb, LA); glds_copy<16384>(KDTb, LK);
#pragma unroll
  for (int mt = 0; mt < 4; ++mt)
#pragma unroll
    for (int nt = 0; nt < 2; ++nt) {
      uR[mt][nt] = *(const h16x4*)(UTb + (size_t)(w * 32 + nt * 16 + fr) * 64 + mt * 16 + fq * 4);
    }
  asm volatile("s_waitcnt vmcnt(0)" ::: "memory");
  RAW_BARRIER();
  for (int c = 0; c < 32; ++c) {
    const int item = bh * 32 + c;
    const float dl = DL[item];
    const bool more = (c + 1 < 32);
    h16x4 zR[4][2];
#pragma unroll
    for (int mt = 0; mt < 4; ++mt)
#pragma unroll
      for (int nt = 0; nt < 2; ++nt)
        zR[mt][nt] = *(const h16x4*)(ZTb + (size_t)c * 128 * 64 + (size_t)(w * 32 + nt * 16 + fr) * 64 + mt * 16 + fq * 4);
    f32x4 vn[4][2], o[4][2];
#pragma unroll
    for (int mt = 0; mt < 4; ++mt) { vn[mt][0] = f32x4{0.f, 0.f, 0.f, 0.f}; vn[mt][1] = vn[mt][0]; o[mt][0] = vn[mt][0]; o[mt][1] = vn[mt][0]; }
#pragma unroll
    for (int ks = 0; ks < 4; ++ks) {
      const h16x8 sf0 = pack8(S[2 * ks][0], S[2 * ks + 1][0]);
      const h16x8 sf1 = pack8(S[2 * ks][1], S[2 * ks + 1][1]);
#pragma unroll
      for (int mt = 0; mt < 4; ++mt) {
        const int off = (mt * 16 + fr) * 256 + (((ks * 4 + fq) ^ fr) << 4);
        h16x8 aw = *(const h16x8*)(LW + off);
        h16x8 aq = *(const h16x8*)(LQ + off);
        vn[mt][0] = MFMA(aw, sf0, vn[mt][0]);
        vn[mt][1] = MFMA(aw, sf1, vn[mt][1]);
        o[mt][0] = MFMA(aq, sf0, o[mt][0]);
        o[mt][1] = MFMA(aq, sf1, o[mt][1]);
      }
    }
#pragma unroll
    for (int mt = 0; mt < 4; ++mt)
#pragma unroll
      for (int r = 0; r < 4; ++r) { vn[mt][0][r] = (float)uR[mt][0][r] - vn[mt][0][r]; vn[mt][1][r] = (float)uR[mt][1][r] - vn[mt][1][r]; }
    RAW_BARRIER();
    const int cn = more ? c + 1 : c;
    glds_copy<16384>(WPb + (size_t)cn * 64 * 128, LW);
    glds_copy<16384>(QGPb + (size_t)cn * 64 * 128, LQ);
#pragma unroll
    for (int mt = 0; mt < 4; ++mt)
#pragma unroll
      for (int nt = 0; nt < 2; ++nt)
        uR[mt][nt] = *(const h16x4*)(UTb + (size_t)cn * 128 * 64 + (size_t)(w * 32 + nt * 16 + fr) * 64 + mt * 16 + fq * 4);
    h16x8 vfr[2][2];
#pragma unroll
    for (int k2 = 0; k2 < 2; ++k2) { vfr[k2][0] = pack8(vn[2 * k2][0], vn[2 * k2 + 1][0]); vfr[k2][1] = pack8(vn[2 * k2][1], vn[2 * k2 + 1][1]); }
#pragma unroll
    for (int mt = 0; mt < 4; ++mt) {
#pragma unroll
      for (int k2 = 0; k2 < 2; ++k2) {
        h16x8 aa = *(const h16x8*)(LA + (mt * 16 + fr) * 128 + (((k2 * 4 + fq) ^ (fr & 7)) << 4));
        o[mt][0] = MFMA(aa, vfr[k2][0], o[mt][0]);
        o[mt][1] = MFMA(aa, vfr[k2][1], o[mt][1]);
      }
    }
#pragma unroll
    for (int dkt = 0; dkt < 8; ++dkt) {
      f32x4 s0 = S[dkt][0], s1 = S[dkt][1];
#pragma unroll
      for (int r = 0; r < 4; ++r) { s0[r] *= dl; s1[r] *= dl; }
#pragma unroll
      for (int k2 = 0; k2 < 2; ++k2) {
        h16x8 ak = *(const h16x8*)(LK + (dkt * 16 + fr) * 128 + (((k2 * 4 + fq) ^ (fr & 7)) << 4));
        s0 = MFMA(ak, vfr[k2][0], s0);
        s1 = MFMA(ak, vfr[k2][1], s1);
      }
      S[dkt][0] = s0; S[dkt][1] = s1;
    }
#pragma unroll
    for (int mt = 0; mt < 4; ++mt)
#pragma unroll
      for (int r = 0; r < 4; ++r) {
        float s = o[mt][0][r] * o[mt][0][r] + o[mt][1][r] * o[mt][1][r];
        s = sum16(s);
        if (fr == 0) red[w * 64 + mt * 16 + 4 * fq + r] = s;
      }
    RAW_BARRIER();
    glds_copy<8192>(ATPb + (size_t)cn * 64 * 64, LA);
    glds_copy<16384>(KDTb + (size_t)cn * 128 * 64, LK);
    asm volatile("" ::: "memory");
#pragma unroll
    for (int mt = 0; mt < 4; ++mt)
#pragma unroll
      for (int r = 0; r < 4; ++r) {
        const int tl = mt * 16 + 4 * fq + r;
        const float tot = red[tl] + red[64 + tl] + red[128 + tl] + red[192 + tl];
        const float rstd = rsqrtf(tot * (1.f / 128.f) + 1e-6f);
        const size_t tok = (size_t)b * SEQ + c * 64 + tl;
        h16* yp = MIXIN + tok * 1024 + 512 + h * 128 + w * 32 + fr;
        yp[0] = (h16)(o[mt][0][r] * rstd * (float)zR[mt][0][r]);
        yp[16] = (h16)(o[mt][1][r] * rstd * (float)zR[mt][1][r]);
      }
    asm volatile("s_waitcnt vmcnt(32)" ::: "memory");
    RAW_BARRIER();
  }
  asm volatile("s_waitcnt vmcnt(0)" ::: "memory");
  __syncthreads();
}

#define XB_TMO      128
#define XB_XCNT(j)  (256  + 64 * (j))
#define XB_XSUB(j)  (1280 + 64 * (j))
#define XB_XGEN(j)  (2304 + 64 * (j))
#define XB_TOP      3328
#define XB_TOPGEN   3392
#define XCD_BAR_WORDS 3456
#define XB_SPIN_CAP (1u << 18)
#define LAS __attribute__((address_space(3)))

__device__ __forceinline__ unsigned xb_ld(unsigned* p)              { return __hip_atomic_load(p, __ATOMIC_RELAXED, __HIP_MEMORY_SCOPE_AGENT); }
__device__ __forceinline__ unsigned xb_add(unsigned* p, unsigned v) { return __hip_atomic_fetch_add(p, v, __ATOMIC_RELAXED, __HIP_MEMORY_SCOPE_AGENT); }
__device__ __forceinline__ unsigned xb_xcc_id() { return (unsigned)__builtin_amdgcn_s_getreg((3 << 11) | 20) & 0xFu; }
#define XB_SPIN(cond, bar) do { unsigned _sp = 0; while (cond) { __builtin_amdgcn_s_sleep(1); \
    if ((++_sp & 255u) == 0u) { if (xb_ld(&(bar)[XB_TMO])) break; if (_sp > XB_SPIN_CAP) { atomicAdd(&(bar)[XB_TMO], 1u); break; } } } } while (0)

struct XcdBarrier {
    unsigned* bar; unsigned x;
    volatile LAS unsigned* st;
};

__device__ __forceinline__ XcdBarrier xcd_barrier_post(unsigned* bar, volatile LAS unsigned* st) {
    XcdBarrier b; b.bar = bar; b.x = xb_xcc_id(); b.st = st;
    if (threadIdx.x == 0) (void)xb_add(&bar[XB_XCNT(b.x)], 1u);
    return b;
}
__device__ __forceinline__ void xcd_barrier_complete(unsigned* bar, unsigned x, unsigned& nloc, unsigned& nx) {
    const unsigned G = gridDim.x * gridDim.y * gridDim.z;
    unsigned sum, cnt, mine, sp = 0u;
    for (;;) {
        sum = 0u; cnt = 0u; mine = 0u;
#pragma unroll
        for (unsigned j = 0; j < 16; ++j) { const unsigned c = xb_ld(&bar[XB_XCNT(j)]); sum += c; cnt += (c > 0u) ? 1u : 0u; mine = (j == x) ? c : mine; }
        if (sum == G) break;
        __builtin_amdgcn_s_sleep(1);
        if ((++sp & 255u) == 0u) { if (xb_ld(&bar[XB_TMO])) break; if (sp > XB_SPIN_CAP) { atomicAdd(&bar[XB_TMO], 1u); break; } }
    }
    nloc = mine > 0u ? mine : 1u; nx = cnt > 0u ? cnt : 1u;
}

__device__ __forceinline__ void xcd_barrier(const XcdBarrier& b) {
    asm volatile("s_waitcnt vmcnt(0)" ::: "memory");
    __syncthreads();
    if (threadIdx.x == 0) {
        unsigned* bar = b.bar;
        __builtin_amdgcn_s_waitcnt(0);
        unsigned nloc = b.st[0], nx = b.st[1];
        if (nloc == 0u) { xcd_barrier_complete(bar, b.x, nloc, nx); b.st[0] = nloc; b.st[1] = nx; }
        const unsigned old = xb_add(&bar[XB_XSUB(b.x)], 1u);
        const unsigned gen = old / nloc;
        if (old + 1u == (gen + 1u) * nloc) {
            __builtin_amdgcn_fence(__ATOMIC_RELEASE, "agent");
            asm volatile("s_waitcnt vmcnt(0)" ::: "memory");
            const unsigned og = xb_add(&bar[XB_TOP], 1u);
            const unsigned tg = og / nx;
            if (og + 1u == (tg + 1u) * nx) xb_add(&bar[XB_TOPGEN], 1u);
            else XB_SPIN(xb_ld(&bar[XB_TOPGEN]) == tg, bar);
            __builtin_amdgcn_fence(__ATOMIC_ACQUIRE, "agent");
            xb_add(&bar[XB_XGEN(b.x)], 1u);
            asm volatile("s_waitcnt vmcnt(0)" ::: "memory");
        } else {
            XB_SPIN(xb_ld(&bar[XB_XGEN(b.x)]) == gen, bar);
            __builtin_amdgcn_fence(__ATOMIC_ACQUIRE, "agent");
            asm volatile("s_waitcnt vmcnt(0)" ::: "memory");
        }
    }
    __syncthreads();
}

#ifndef ONLY_PH
#define ONLY_PH -1
#endif
#define RUNPH(n) ((ONLY_PH < 0 || ONLY_PH == (n)) && p.ph_lo <= (n) && (n) <= p.ph_hi)
#define SYNCPH(n) do { if (p.ph_lo <= (n) && (n) < p.ph_hi) xcd_barrier(xb); } while (0)
__global__ void __launch_bounds__(256, 2) hymba_mega(Params p) {
  __shared__ __attribute__((aligned(16))) unsigned char smem[SMEM_BYTES];
  cg::grid_group grid = cg::this_grid();
  const int bid = blockIdx.x, nb = gridDim.x;
  if (p.ph_lo < 0) grid.sync();
  XcdBarrier xb;
  {
    volatile LAS unsigned* st = (volatile LAS unsigned*)(smem + SMEM_BYTES - 16);
    if (threadIdx.x == 0) { st[0] = 0u; st[1] = 0u; st[2] = 0u; st[3] = 0u; }
    __syncthreads();
    if (p.ph_lo < p.ph_hi) xb = xcd_barrier_post((unsigned*)(p.ws + OFF_BAR), st);
    else { xb.bar = (unsigned*)(p.ws + OFF_BAR); xb.x = 0; xb.st = st; }
  }
  {
    if (RUNPH(0)) for (int rep = 0; rep < REP0; ++rep) {
      if (rep) grid.sync();
      phase0(p, smem);
    }
    SYNCPH(0);
    if (RUNPH(1)) for (int rep = 0; rep < REP1; ++rep) {
      if (rep) grid.sync();
      const h16* A0 = (const h16*)((unsigned char*)p.out + OUT_OFF_A0);
      const h16* W = (const h16*)(p.ws + OFF_WIN);
      for (int t = bid; t < 256 * 25; t += nb) gemm_tile<EPI_PROJ>(p, A0, 1024, W, 1024, 1024, (t / 25) * 128, (t % 25) * 128, smem);
    }
    SYNCPH(1);
    if (RUNPH(2)) for (int rep = 0; rep < REP2; ++rep) {
      if (rep) grid.sync();
      for (int it = bid; it < 512 + 2048; it += nb) {
        if (it < 2048) gdn_pre_item(p, it, smem);
        else ssm_item(p, (it - 2048) >> 5, (it - 2048) & 31, smem);
      }
    }
    SYNCPH(2);
    if (RUNPH(3)) for (int rep = 0; rep < REP3; ++rep) {
      if (rep) grid.sync();
      const int nrec = 64;
      if (bid < nrec) for (int it = bid; it < nrec; it += nb) gdn_recurrence(p, it, smem);
      if (nb <= nrec || bid >= nrec) {
        const int start = nb > nrec ? bid - nrec : bid, step = nb > nrec ? nb - nrec : nb;
        const h16* YPRE = (const h16*)((unsigned char*)p.out + OUT_OFF_YPRE);
        for (int t = start; t < 1024 + 2048; t += step) {
          if (t < 1024) gemm_tile<EPI_GLU>(p, YPRE, 512, (const h16*)(p.ws + OFF_WGLU), 512, 512, (t >> 2) * 128, (t & 3) * 128, smem);
          else gemm_tile<EPI_PLE>(p, (const h16*)(p.ws + OFF_PB), 256, (const h16*)(p.ws + OFF_WPP), 256, 256, ((t - 1024) >> 3) * 128, ((t - 1024) & 7) * 128, smem);
        }
      }
    }
    SYNCPH(3);
    if (RUNPH(4)) for (int rep = 0; rep < REP4; ++rep) {
      if (rep) grid.sync();
      for (int t = bid; t < 2048; t += nb)
        gemm_tile<EPI_OUT>(p, (const h16*)(p.ws + OFF_MIXIN), 1024, (const h16*)(p.ws + OFF_WOUT), 1024, 1024, (t >> 3) * 128, (t & 7) * 128, smem);
    }
    SYNCPH(4);
    if (RUNPH(5)) {
      for (int t = bid; t < 2048; t += nb)
        gemm_tile<EPI_GATE>(p, (const h16*)(p.ws + OFF_PROJ), 1024, (const h16*)(p.ws + OFF_WGATE), 1024, 1024, (t >> 3) * 128, (t & 7) * 128, smem);
    }
    SYNCPH(5);
    if (RUNPH(6)) {
      const int wid = threadIdx.x >> 6, lane = threadIdx.x & 63;
      const float* OPART = (const float*)(p.ws + OFF_OPART);
      const float4* g4 = (const float4*)p.in[I_FING];
      for (int row = bid * 4 + wid; row < T_TOK; row += nb * 4) {
        float s = (lane < 16) ? OPART[(size_t)row * 16 + lane] : 0.f;
        s = wave_sum(s);
        const float rstd = rsqrtf(s * (1.f / 1024.f) + 1e-6f);
        float4* orow = (float4*)(p.out + (size_t)row * 1024);
#pragma unroll
        for (int i = 0; i < 4; ++i) {
          float4 v = orow[lane + i * 64];
          float4 g = g4[lane + i * 64];
          v.x *= rstd * g.x; v.y *= rstd * g.y; v.z *= rstd * g.z; v.w *= rstd * g.w;
          orow[lane + i * 64] = v;
        }
      }
    }
  }
}

extern "C" void kernel_launch(void* const* d_in, const int* in_sizes, int n_in, void* d_out, int out_size, void* d_ws, size_t ws_size,
                              hipStream_t stream) {
  static int grid_blocks = 0;
  if (!grid_blocks) {
    int dev = 0, cus = 0, per_cu = 0;
    hipGetDevice(&dev);
    hipDeviceGetAttribute(&cus, hipDeviceAttributeMultiprocessorCount, dev);
    hipOccupancyMaxActiveBlocksPerMultiprocessor(&per_cu, hymba_mega, 256, 0);
    if (per_cu > 2) per_cu = 2;
    if (per_cu < 1) per_cu = 1;
    grid_blocks = cus * per_cu;
  }
  if (n_in != 23 || ws_size < WS_END || out_size != T_TOK * 1024) {
    fprintf(stderr, "kernel_launch: unexpected sizes n_in=%d ws=%zu (need %zu) out=%d\n", n_in, ws_size, (size_t)WS_END, out_size);
    return;
  }
  Params p{};
  for (int i = 0; i < 23; ++i) p.in[i] = (const float*)d_in[i];
  p.out = (float*)d_out;
  p.ws = (unsigned char*)d_ws;
#if MULTI_LAUNCH
  for (int ph = 0; ph < NPH; ++ph) {
    p.ph_lo = ph; p.ph_hi = ph;
    hipLaunchKernelGGL(hymba_mega, dim3(grid_blocks), dim3(256), 0, stream, p);
  }
#else
  p.ph_lo = 0; p.ph_hi = NPH - 1;
  if (hipMemsetAsync((unsigned char*)d_ws + OFF_BAR, 0, 16384, stream) != hipSuccess) { fprintf(stderr, "kernel_launch: memset of barrier words failed\n"); return; }
  void* args[] = {&p};
  hipError_t e = hipLaunchCooperativeKernel((void*)hymba_mega, dim3(grid_blocks), dim3(256), args, 0, stream);
  if (e != hipSuccess) fprintf(stderr, "cooperative launch failed: %s (grid %d)\n", hipGetErrorString(e), grid_blocks);
#endif
}
```

```cpp
#include <hip/hip_runtime.h>
#include <hip/hip_cooperative_groups.h>
#include <cstdio>
namespace cg = cooperative_groups;

#ifndef REP0
#define REP0 1
#endif
#ifndef REP1
#define REP1 1
#endif
#ifndef REP2
#define REP2 1
#endif
#ifndef REP3
#define REP3 1
#endif
#ifndef REP4
#define REP4 1
#endif
#ifndef MULTI_LAUNCH
#define MULTI_LAUNCH 0
#endif

typedef _Float16 h16;
typedef __attribute__((ext_vector_type(8))) _Float16 h16x8;
typedef __attribute__((ext_vector_type(4))) _Float16 h16x4;
typedef __attribute__((ext_vector_type(4))) float f32x4;

#define MFMA(a, b, c) __builtin_amdgcn_mfma_f32_16x16x32_f16((a), (b), (c), 0, 0, 0)

constexpr int T_TOK = 32768;
constexpr int SEQ = 2048;
constexpr int NPH = 7;
constexpr int LDP = 3072;
constexpr int SMEM_BYTES = 70400;

constexpr size_t SZ_WIN = (size_t)3200 * 1024 * 2;
constexpr size_t SZ_WGLU = (size_t)512 * 512 * 2;
constexpr size_t SZ_WOUT = (size_t)1024 * 1024 * 2;
constexpr size_t SZ_WPP = (size_t)1024 * 256 * 2;
constexpr size_t SZ_WGATE = (size_t)1024 * 1024 * 2;
constexpr size_t OFF_WIN = 0;
constexpr size_t OFF_WGLU = OFF_WIN + SZ_WIN;
constexpr size_t OFF_WOUT = OFF_WGLU + SZ_WGLU;
constexpr size_t OFF_WPP = OFF_WOUT + SZ_WOUT;
constexpr size_t OFF_WGATE = OFF_WPP + SZ_WPP;
constexpr size_t OFF_PB = OFF_WGATE + SZ_WGATE;
constexpr size_t OFF_PROJ = OFF_PB + (size_t)T_TOK * 256 * 2;
constexpr size_t OFF_AB = OFF_PROJ + (size_t)T_TOK * LDP * 2;
constexpr size_t OFF_KTAB = OFF_AB + (size_t)T_TOK * 8 * 4;
constexpr size_t OFF_ETAB = OFF_KTAB + (size_t)32 * 33 * 256 * 2;
constexpr size_t OFF_FTAB = OFF_ETAB + (size_t)32 * 128 * 512 * 2;
constexpr size_t OFF_ALPOW = OFF_FTAB + (size_t)32 * 512 * 128 * 2;
constexpr size_t OFF_DL = OFF_ALPOW + (size_t)32 * 64 * 2 * 4;
constexpr size_t OFF_EPART = OFF_DL + (size_t)2048 * 4;
constexpr size_t OFF_OPART = OFF_EPART + (size_t)T_TOK * 16 * 4;
constexpr size_t OFF_MIXIN = OFF_OPART + (size_t)T_TOK * 16 * 4;
constexpr size_t OFF_WP = OFF_MIXIN + (size_t)T_TOK * 1024 * 2;
constexpr size_t OFF_QGP = OFF_WP + (size_t)2048 * 64 * 128 * 2;
constexpr size_t OFF_KDT = OFF_QGP + (size_t)2048 * 64 * 128 * 2;
constexpr size_t OFF_UT = OFF_KDT + (size_t)2048 * 128 * 64 * 2;
constexpr size_t OFF_ATP = OFF_UT + (size_t)2048 * 128 * 64 * 2;
constexpr size_t OFF_EH = OFF_ATP + (size_t)2048 * 64 * 64 * 2;
constexpr size_t OFF_BAR = OFF_EH + (size_t)T_TOK * 1024 * 2;
constexpr size_t WS_END = OFF_BAR + 16384;
constexpr size_t OUT_OFF_A0 = 0;
constexpr size_t OUT_OFF_YPRE = (size_t)T_TOK * 1024 * 2;
constexpr size_t OUT_OFF_ZT = OUT_OFF_YPRE + (size_t)T_TOK * 512 * 2;

struct Params {
  const float* in[23];
  float* out;
  unsigned char* ws;
  int ph_lo, ph_hi;
};

enum { I_X = 0, I_P, I_NMG, I_WIN, I_ARE, I_AIM, I_BRE, I_BIM, I_CRE, I_CIM, I_D, I_LOGDT, I_WGLU, I_BGLU,
       I_CONVW, I_ALOG, I_DTB, I_DNG, I_WOUT, I_WPP, I_PLEG, I_WGATE, I_FING };

__device__ __forceinline__ float wave_sum(float v) {
#pragma unroll
  for (int o = 32; o > 0; o >>= 1) v += __shfl_xor(v, o);
  return v;
}
__device__ __forceinline__ float sum16(float v) {
  v += __shfl_xor(v, 1); v += __shfl_xor(v, 2); v += __shfl_xor(v, 4); v += __shfl_xor(v, 8);
  return v;
}
__device__ __forceinline__ float sigmoidf_(float x) { return 1.f / (1.f + __expf(-x)); }
__device__ __forceinline__ float siluf_(float x) { return x / (1.f + __expf(-x)); }
__device__ __forceinline__ float gelu_tanh(float y) {
  float z = 0.7978845608028654f * (y + 0.044715f * y * y * y);
  return 0.5f * y * (1.f + tanhf(z));
}
__device__ __forceinline__ h16x8 pack8(f32x4 lo, f32x4 hi) {
  h16x8 r;
  r[0] = (h16)lo[0]; r[1] = (h16)lo[1]; r[2] = (h16)lo[2]; r[3] = (h16)lo[3];
  r[4] = (h16)hi[0]; r[5] = (h16)hi[1]; r[6] = (h16)hi[2]; r[7] = (h16)hi[3];
  return r;
}
__device__ __forceinline__ int perm_pos(int n) { return (n & ~31) + (((n & 15) >> 2) << 3) + (((n >> 4) & 1) << 2) + (n & 3); }
__device__ __forceinline__ int perm_inv(int pos) {
  int q5 = pos & 31, qq = q5 >> 3, jj = q5 & 7;
  return (pos & ~31) + (jj < 4 ? 4 * qq + jj : 16 + 4 * qq + (jj - 4));
}

__device__ void transpose_w(const float* __restrict__ W, int K, int N, int Npad, h16* __restrict__ WT, int t, float* tile) {
  const int ntn = Npad / 64;
  const int kt = t / ntn, nt = t % ntn, k0 = kt * 64, n0 = nt * 64;
  const int tx = threadIdx.x & 63, ty = threadIdx.x >> 6;
  for (int r = 0; r < 16; ++r) {
    int k = ty * 16 + r, n = n0 + tx;
    tile[k * 65 + tx] = (n < N) ? W[(size_t)(k0 + k) * N + n] : 0.f;
  }
  __syncthreads();
  for (int r = 0; r < 16; ++r) {
    int n = ty * 16 + r;
    WT[(size_t)(n0 + n) * K + k0 + tx] = (h16)tile[tx * 65 + n];
  }
  __syncthreads();
}

__device__ void ssm_table_item(const Params& p, int g, int d, float* lds) {
  float2* sAp = (float2*)lds;
  float2* sW = sAp + 64;
  const int tid = threadIdx.x;
  h16* KTAB = (h16*)(p.ws + OFF_KTAB);
  h16* ETAB = (h16*)(p.ws + OFF_ETAB);
  h16* FTAB = (h16*)(p.ws + OFF_FTAB);
  float* ALPOW = (float*)(p.ws + OFF_ALPOW);
  float* sBr = lds + 256; float* sBi = sBr + 1024; float* sCr = sBi + 1024; float* sCi = sCr + 16 * 65;
  {
    const float4 vbr = ((const float4*)(p.in[I_BRE] + g * 1024))[tid], vbi = ((const float4*)(p.in[I_BIM] + g * 1024))[tid];
    const float4 vcr = ((const float4*)(p.in[I_CRE] + g * 1024))[tid], vci = ((const float4*)(p.in[I_CIM] + g * 1024))[tid];
    *(float4*)(sBr + tid * 4) = vbr; *(float4*)(sBi + tid * 4) = vbi;
    const int ch = (tid * 4) >> 6, cp = (tid * 4) & 63;
    sCr[ch * 65 + cp] = vcr.x; sCr[ch * 65 + cp + 1] = vcr.y; sCr[ch * 65 + cp + 2] = vcr.z; sCr[ch * 65 + cp + 3] = vcr.w;
    sCi[ch * 65 + cp] = vci.x; sCi[ch * 65 + cp + 1] = vci.y; sCi[ch * 65 + cp + 2] = vci.z; sCi[ch * 65 + cp + 3] = vci.w;
  }
  if (tid < 64) {
    const int pp = tid;
    float lr = p.in[I_ARE][g * 64 + pp], li = p.in[I_AIM][g * 64 + pp], dt = expf(p.in[I_LOGDT][g]);
    float mag = expf(lr * dt), ang = li * dt;
    float abr = mag * cosf(ang), abi = mag * sinf(ang);
    float nr = abr - 1.f, ni = abi, den = lr * lr + li * li;
    float cr = (nr * lr + ni * li) / den, ci = (ni * lr - nr * li) / den;
    float apr = 1.f, api = 0.f;
    for (int k = 0; k < d; ++k) { float t0 = apr * abr - api * abi; api = apr * abi + api * abr; apr = t0; }
    sAp[pp] = make_float2(apr, api);
    sW[pp] = make_float2(apr * cr - api * ci, apr * ci + api * cr);
    if (d == 32) { ALPOW[(g * 64 + pp) * 2] = apr; ALPOW[(g * 64 + pp) * 2 + 1] = api; }
  }
  __syncthreads();
  if (d < 32) {
    {
      const int h = tid >> 4, hp = tid & 15;
      float acc = 0.f;
#pragma unroll 8
      for (int pp = 0; pp < 64; ++pp) {
        float2 W = sW[pp];
        float br = sBr[pp * 16 + hp], bi = sBi[pp * 16 + hp];
        float wbr = W.x * br - W.y * bi, wbi = W.x * bi + W.y * br;
        float cr = sCr[h * 65 + pp], ci = sCi[h * 65 + pp];
        acc += cr * wbr - ci * wbi;
      }
      KTAB[(size_t)(g * 33 + d + 1) * 256 + h * 16 + hp] = (h16)acc;
      if (d == 0) KTAB[(size_t)(g * 33) * 256 + tid] = (h16)0.f;
    }
    {
      const int i = 31 - d;
#pragma unroll
      for (int r = 0; r < 4; ++r) {
        int idx = tid + 256 * r, pp = idx >> 4, hp = idx & 15;
        float2 W = sW[pp];
        float br = sBr[pp * 16 + hp], bi = sBi[pp * 16 + hp];
        float wbr = W.x * br - W.y * bi, wbi = W.x * bi + W.y * br;
        ETAB[((size_t)g * 128 + pp) * 512 + i * 16 + hp] = (h16)wbr;
        ETAB[((size_t)g * 128 + 64 + pp) * 512 + i * 16 + hp] = (h16)wbi;
      }
    }
  }
  if (d >= 1) {
    const int j = d - 1;
#pragma unroll
    for (int r = 0; r < 4; ++r) {
      int idx = tid + 256 * r, h = idx >> 6, pp = idx & 63;
      float2 Ap = sAp[pp];
      float cr = sCr[h * 65 + pp], ci = sCi[h * 65 + pp];
      float re = cr * Ap.x - ci * Ap.y, im = cr * Ap.y + ci * Ap.x;
      FTAB[((size_t)g * 512 + j * 16 + h) * 128 + pp] = (h16)re;
      FTAB[((size_t)g * 512 + j * 16 + h) * 128 + 64 + pp] = (h16)(-im);
    }
  }
  __syncthreads();
}

__device__ void phase0(const Params& p, unsigned char* smem) {
  const int bid = blockIdx.x, nb = gridDim.x, tid = threadIdx.x, wid = tid >> 6, lane = tid & 63;
  float* tile = (float*)smem;
  for (int t = bid; t < 1440; t += nb) {
    if (t < 800) transpose_w(p.in[I_WIN], 1024, 3080, 3200, (h16*)(p.ws + OFF_WIN), t, tile);
    else if (t < 864) transpose_w(p.in[I_WGLU], 512, 512, 512, (h16*)(p.ws + OFF_WGLU), t - 800, tile);
    else if (t < 1120) transpose_w(p.in[I_WOUT], 1024, 1024, 1024, (h16*)(p.ws + OFF_WOUT), t - 864, tile);
    else if (t < 1184) transpose_w(p.in[I_WPP], 256, 1024, 1024, (h16*)(p.ws + OFF_WPP), t - 1120, tile);
    else transpose_w(p.in[I_WGATE], 1024, 1024, 1024, (h16*)(p.ws + OFF_WGATE), t - 1184, tile);
  }
  for (int it = bid; it < 32 * 33; it += nb) ssm_table_item(p, it / 33, it % 33, (float*)smem);
  {
    h16* A0 = (h16*)((unsigned char*)p.out + OUT_OFF_A0);
    const float* x = p.in[I_X];
    const float4* g4 = (const float4*)p.in[I_NMG];
    for (int row = bid * 4 + wid; row < T_TOK; row += nb * 4) {
      const float4* xr = (const float4*)(x + (size_t)row * 1024);
      float4 v[4];
      float ss = 0.f;
#pragma unroll
      for (int i = 0; i < 4; ++i) {
        v[i] = xr[lane + i * 64];
        ss += v[i].x * v[i].x + v[i].y * v[i].y + v[i].z * v[i].z + v[i].w * v[i].w;
      }
      ss = wave_sum(ss);
      float rstd = rsqrtf(ss * (1.f / 1024.f) + 1e-6f);
#pragma unroll
      for (int i = 0; i < 4; ++i) {
        float4 g = g4[lane + i * 64];
        h16x4 o;
        o[0] = (h16)(v[i].x * rstd * g.x); o[1] = (h16)(v[i].y * rstd * g.y);
        o[2] = (h16)(v[i].z * rstd * g.z); o[3] = (h16)(v[i].w * rstd * g.w);
        *(h16x4*)(A0 + (size_t)row * 1024 + (lane + i * 64) * 4) = o;
      }
    }
  }
  {
    h16* PB = (h16*)(p.ws + OFF_PB);
    const float4* p4 = (const float4*)p.in[I_P];
    const size_t n4 = (size_t)T_TOK * 256 / 4;
    for (size_t i = (size_t)bid * 256 + tid; i < n4; i += (size_t)nb * 256) {
      float4 v = p4[i];
      h16x4 o;
      o[0] = (h16)v.x; o[1] = (h16)v.y; o[2] = (h16)v.z; o[3] = (h16)v.w;
      *(h16x4*)(PB + i * 4) = o;
    }
  }
}

enum { EPI_PROJ = 0, EPI_GLU, EPI_PLE, EPI_OUT, EPI_GATE };

template <int EPI>
__device__ __forceinline__ void gemm_tile(const Params& p, const h16* __restrict__ A, int lda, const h16* __restrict__ Bt, int ldb,
                                          int K, int brow, int bcol, unsigned char* smem) {
  const int tid = threadIdx.x, wid = tid >> 6, lane = tid & 63, wr = wid >> 1, wc = wid & 1, fr = lane & 15, fq = lane >> 4;
  f32x4 acc[4][4];
#pragma unroll
  for (int m = 0; m < 4; ++m)
#pragma unroll
    for (int n = 0; n < 4; ++n) acc[m][n] = f32x4{0.f, 0.f, 0.f, 0.f};
  const int nk = K / 32;
  const int sb0 = tid * 16, sr0 = sb0 >> 6, sc0 = (sb0 & 63) >> 1;
  const h16* ga = A + (size_t)(brow + sr0) * lda + sc0;
  const h16* gb = Bt + (size_t)(bcol + sr0) * ldb + sc0;
#define GEMM_STAGE(t_, buf_) do { \
    unsigned char* sa_ = smem + (buf_) * 16384; \
    __builtin_amdgcn_global_load_lds((const unsigned*)(ga + (t_) * 32), (unsigned*)(sa_ + sb0), 16, 0, 0); \
    __builtin_amdgcn_global_load_lds((const unsigned*)(ga + (size_t)64 * lda + (t_) * 32), (unsigned*)(sa_ + sb0 + 4096), 16, 0, 0); \
    __builtin_amdgcn_global_load_lds((const unsigned*)(gb + (t_) * 32), (unsigned*)(sa_ + 8192 + sb0), 16, 0, 0); \
    __builtin_amdgcn_global_load_lds((const unsigned*)(gb + (size_t)64 * ldb + (t_) * 32), (unsigned*)(sa_ + 8192 + sb0 + 4096), 16, 0, 0); \
  } while (0)
  GEMM_STAGE(0, 0);
  for (int t = 0; t < nk; ++t) {
    asm volatile("s_waitcnt vmcnt(0)" ::: "memory");
    __syncthreads();
    if (t + 1 < nk) GEMM_STAGE(t + 1, (t + 1) & 1);
    const unsigned char* SA = smem + (t & 1) * 16384;
    const unsigned char* SB = SA + 8192;
    h16x8 af[4], bf[4];
#pragma unroll
    for (int m = 0; m < 4; ++m) {
      af[m] = *(const h16x8*)(SA + (wr * 64 + m * 16 + fr) * 64 + fq * 16);
      bf[m] = *(const h16x8*)(SB + (wc * 64 + m * 16 + fr) * 64 + fq * 16);
    }
#pragma unroll
    for (int m = 0; m < 4; ++m)
#pragma unroll
      for (int n = 0; n < 4; ++n) acc[m][n] = MFMA(af[m], bf[n], acc[m][n]);
  }
#undef GEMM_STAGE
  __syncthreads();
  float* CT = (float*)smem;
#pragma unroll
  for (int m = 0; m < 4; ++m)
#pragma unroll
    for (int n = 0; n < 4; ++n)
#pragma unroll
      for (int j = 0; j < 4; ++j) CT[(wr * 64 + m * 16 + fq * 4 + j) * 132 + wc * 64 + n * 16 + fr] = acc[m][n][j];
  __syncthreads();
  const int c4 = tid & 31;
#pragma unroll 2
  for (int it = 0; it < 16; ++it) {
    const int rl = it * 8 + (tid >> 5);
    const size_t row = (size_t)brow + rl;
    const int col = bcol + c4 * 4;
    const float4 v = *(const float4*)(CT + rl * 132 + c4 * 4);
    if constexpr (EPI == EPI_PROJ) {
      if (bcol < 3072) {
        h16x4 o; o[0] = (h16)v.x; o[1] = (h16)v.y; o[2] = (h16)v.z; o[3] = (h16)v.w;
        *(h16x4*)((h16*)(p.ws + OFF_PROJ) + row * LDP + col) = o;
      } else if (c4 < 2) {
        *(float4*)((float*)(p.ws + OFF_AB) + row * 8 + c4 * 4) = v;
      }
    } else if constexpr (EPI == EPI_GLU) {
      const h16x4 y = *(const h16x4*)((const h16*)((unsigned char*)p.out + OUT_OFF_YPRE) + row * 512 + col);
      const h16x4 z = *(const h16x4*)((const h16*)(p.ws + OFF_PROJ) + row * LDP + 512 + col);
      const float4 bb = *(const float4*)(p.in[I_BGLU] + col);
      h16x4 o;
      o[0] = (h16)((float)y[0] * sigmoidf_(v.x + bb.x) * siluf_((float)z[0]));
      o[1] = (h16)((float)y[1] * sigmoidf_(v.y + bb.y) * siluf_((float)z[1]));
      o[2] = (h16)((float)y[2] * sigmoidf_(v.z + bb.z) * siluf_((float)z[2]));
      o[3] = (h16)((float)y[3] * sigmoidf_(v.w + bb.w) * siluf_((float)z[3]));
      *(h16x4*)((h16*)(p.ws + OFF_MIXIN) + row * 1024 + col) = o;
    } else if constexpr (EPI == EPI_PLE) {
      h16x4 o; o[0] = (h16)v.x; o[1] = (h16)v.y; o[2] = (h16)v.z; o[3] = (h16)v.w;
      *(h16x4*)((h16*)(p.ws + OFF_EH) + row * 1024 + col) = o;
      float s = v.x * v.x + v.y * v.y + v.z * v.z + v.w * v.w;
      s = sum16(s); s += __shfl_xor(s, 16);
      if (c4 == 0) ((float*)(p.ws + OFF_EPART))[row * 8 + (bcol >> 7)] = s;
    } else if constexpr (EPI == EPI_OUT) {
      const float4 xv = *(const float4*)(p.in[I_X] + row * 1024 + col);
      float4 hv; hv.x = xv.x + v.x; hv.y = xv.y + v.y; hv.z = xv.z + v.z; hv.w = xv.w + v.w;
      *(float4*)(p.out + row * 1024 + col) = hv;
      h16x4 o; o[0] = (h16)hv.x; o[1] = (h16)hv.y; o[2] = (h16)hv.z; o[3] = (h16)hv.w;
      *(h16x4*)((h16*)(p.ws + OFF_PROJ) + row * 1024 + col) = o;
    } else if constexpr (EPI == EPI_GATE) {
      const float4 e0 = *(const float4*)((const float*)(p.ws + OFF_EPART) + row * 8);
      const float4 e1 = *(const float4*)((const float*)(p.ws + OFF_EPART) + row * 8 + 4);
      const float rs = rsqrtf((e0.x + e0.y + e0.z + e0.w + e1.x + e1.y + e1.z + e1.w) * (1.f / 1024.f) + 1e-6f);
      const h16x4 eh = *(const h16x4*)((const h16*)(p.ws + OFF_EH) + row * 1024 + col);
      const float4 pg = *(const float4*)(p.in[I_PLEG] + col);
      float4 hv = *(const float4*)(p.out + row * 1024 + col);
      hv.x += sigmoidf_(v.x) * ((float)eh[0] * rs * pg.x);
      hv.y += sigmoidf_(v.y) * ((float)eh[1] * rs * pg.y);
      hv.z += sigmoidf_(v.z) * ((float)eh[2] * rs * pg.z);
      hv.w += sigmoidf_(v.w) * ((float)eh[3] * rs * pg.w);
      *(float4*)(p.out + row * 1024 + col) = hv;
      float s = hv.x * hv.x + hv.y * hv.y + hv.z * hv.z + hv.w * hv.w;
      s = sum16(s); s += __shfl_xor(s, 16);
      if (c4 == 0) ((float*)(p.ws + OFF_OPART))[row * 8 + (bcol >> 7)] = s;
    }
  }
  __syncthreads();
}

__device__ void ssm_item(const Params& p, int b, int g, unsigned char* smem) {
  float* LOCAL = (float*)smem;
  h16* SPREV = (h16*)(smem + 33792);
  h16* KT = (h16*)(smem + 51200);
  int tid_ = threadIdx.x;
  asm volatile("" : "+v"(tid_));
  const int tid = tid_, w = tid >> 6, lane = tid & 63, fr = lane & 15, fq = lane >> 4;
  const h16* PROJ = (const h16*)(p.ws + OFF_PROJ);
  const h16* Eg = (const h16*)(p.ws + OFF_ETAB) + (size_t)g * 128 * 512;
  const h16* Kg = (const h16*)(p.ws + OFF_KTAB) + (size_t)g * 33 * 256;
  const h16* Fg = (const h16*)(p.ws + OFF_FTAB) + (size_t)g * 512 * 128;
  const float* ALPOW = (const float*)(p.ws + OFF_ALPOW);
  h16* YPRE = (h16*)((unsigned char*)p.out + OUT_OFF_YPRE);
  const int nchunk = w * 16 + fr;
  const size_t tok0 = (size_t)b * SEQ + (size_t)nchunk * 32;
  for (int idx = tid; idx < 33 * 256 / 8; idx += 256) *(h16x8*)(KT + idx * 8) = *(const h16x8*)(Kg + idx * 8);
  h16x8 uf[16];
#pragma unroll
  for (int ks = 0; ks < 16; ++ks) {
    const int i = 2 * ks + (fq >> 1);
    uf[ks] = *(const h16x8*)(PROJ + (tok0 + i) * LDP + g * 16 + (fq & 1) * 8);
  }
  {
    h16x8 ea[8];
#pragma unroll
    for (int ks = 0; ks < 8; ++ks) ea[ks] = *(const h16x8*)(Eg + (size_t)fr * 512 + ks * 32 + fq * 8);
    f32x4 acc = {0.f, 0.f, 0.f, 0.f};
#pragma unroll 1
    for (int it = 0; it < 16; ++it) {
      const int mt = it >> 1, hf = it & 1;
      const int itn = it < 15 ? it + 1 : 15;
      h16x8 en[8];
#pragma unroll
      for (int ks = 0; ks < 8; ++ks) en[ks] = *(const h16x8*)(Eg + (size_t)((itn >> 1) * 16 + fr) * 512 + ((itn & 1) * 8 + ks) * 32 + fq * 8);
      if (hf == 0) {
#pragma unroll
        for (int ks = 0; ks < 8; ++ks) acc = MFMA(ea[ks], uf[ks], acc);
      } else {
#pragma unroll
        for (int ks = 0; ks < 8; ++ks) acc = MFMA(ea[ks], uf[8 + ks], acc);
        *(f32x4*)(LOCAL + nchunk * 132 + mt * 16 + fq * 4) = acc;
        acc = f32x4{0.f, 0.f, 0.f, 0.f};
      }
#pragma unroll
      for (int ks = 0; ks < 8; ++ks) ea[ks] = en[ks];
    }
  }
  __syncthreads();
  if (tid < 64) {
    const int pp = tid;
    const float ar = ALPOW[(g * 64 + pp) * 2], ai = ALPOW[(g * 64 + pp) * 2 + 1];
    float sr = 0.f, si = 0.f;
#pragma unroll 4
    for (int c = 0; c < 64; ++c) {
      SPREV[c * 136 + pp] = (h16)sr;
      SPREV[c * 136 + 64 + pp] = (h16)si;
      float lr = LOCAL[c * 132 + pp], li = LOCAL[c * 132 + 64 + pp];
      float nr = ar * sr - ai * si + lr;
      float ni = ar * si + ai * sr + li;
      sr = nr; si = ni;
    }
  }
  __syncthreads();
  h16x8 sf[4];
#pragma unroll
  for (int ks = 0; ks < 4; ++ks) sf[ks] = *(const h16x8*)(SPREV + nchunk * 136 + ks * 32 + fq * 8);
  const float4 Dv = *(const float4*)(p.in[I_D] + g * 16 + fq * 4);
  h16x8 fa[4];
#pragma unroll
  for (int ks = 0; ks < 4; ++ks) fa[ks] = *(const h16x8*)(Fg + (size_t)fr * 128 + ks * 32 + fq * 8);
  h16x4 u4 = *(const h16x4*)(PROJ + tok0 * LDP + g * 16 + fq * 4);
#pragma unroll 1
  for (int j = 0; j < 32; ++j) {
    const int jn = j < 31 ? j + 1 : 31;
    h16x8 fn[4];
#pragma unroll
    for (int ks = 0; ks < 4; ++ks) fn[ks] = *(const h16x8*)(Fg + (size_t)(jn * 16 + fr) * 128 + ks * 32 + fq * 8);
    const h16x4 un = *(const h16x4*)(PROJ + (tok0 + jn) * LDP + g * 16 + fq * 4);
    f32x4 acc = {0.f, 0.f, 0.f, 0.f};
#pragma unroll
    for (int ks = 0; ks < 16; ++ks) {
      if (2 * ks <= j) {
        const int dd = j - 2 * ks - (fq >> 1) + 1;
        h16x8 a = *(const h16x8*)(KT + dd * 256 + fr * 16 + (fq & 1) * 8);
        acc = MFMA(a, uf[ks], acc);
      }
    }
#pragma unroll
    for (int ks = 0; ks < 4; ++ks) acc = MFMA(fa[ks], sf[ks], acc);
    const size_t tok = tok0 + j;
    h16x4 o;
    o[0] = (h16)gelu_tanh(acc[0] + Dv.x * (float)u4[0]);
    o[1] = (h16)gelu_tanh(acc[1] + Dv.y * (float)u4[1]);
    o[2] = (h16)gelu_tanh(acc[2] + Dv.z * (float)u4[2]);
    o[3] = (h16)gelu_tanh(acc[3] + Dv.w * (float)u4[3]);
    *(h16x4*)(YPRE + tok * 512 + g * 16 + fq * 4) = o;
#pragma unroll
    for (int ks = 0; ks < 4; ++ks) fa[ks] = fn[ks];
    u4 = un;
  }
  __syncthreads();
}

__device__ void gdn_pre_item(const Params& p, int item, unsigned char* smem) {
  h16* QH = (h16*)smem;
  h16* KH = (h16*)(smem + 17408);
  h16* VH = (h16*)(smem + 34816);
  float* LT = (float*)(smem + 52224);
  float* sG = (float*)(smem + 69632);
  float* sBeta = (float*)(smem + 69888);
  int tid_ = threadIdx.x;
  asm volatile("" : "+v"(tid_));
  const int tid = tid_, w = tid >> 6, lane = tid & 63, fr = lane & 15, fq = lane >> 4;
  const int c = item & 31, h = (item >> 5) & 3, b = item >> 7;
  const h16* PROJ = (const h16*)(p.ws + OFF_PROJ);
  const float* AB = (const float*)(p.ws + OFF_AB);
  const float* convw = p.in[I_CONVW];
  h16* WPi = (h16*)(p.ws + OFF_WP) + (size_t)item * 64 * 128;
  h16* QGPi = (h16*)(p.ws + OFF_QGP) + (size_t)item * 64 * 128;
  h16* KDTi = (h16*)(p.ws + OFF_KDT) + (size_t)item * 128 * 64;
  h16* UTi = (h16*)(p.ws + OFF_UT) + (size_t)item * 128 * 64;
  h16* ATPi = (h16*)(p.ws + OFF_ATP) + (size_t)item * 64 * 64;
  h16* ZTi = (h16*)((unsigned char*)p.out + OUT_OFF_ZT) + (size_t)item * 128 * 64;
  float* DL = (float*)(p.ws + OFF_DL);
  {
    const int ch0 = (tid & 15) * 8, trow = tid >> 4;
#pragma unroll 1
    for (int pass = 0; pass < 4; ++pass) {
      const int t = pass * 16 + trow, tl = c * 64 + t;
#pragma unroll
      for (int sec = 0; sec < 3; ++sec) {
        const int colbase = 1024 + sec * 512 + h * 128 + ch0;
        float a[8];
#pragma unroll
        for (int e = 0; e < 8; ++e) a[e] = 0.f;
#pragma unroll
        for (int jj = 0; jj < 4; ++jj) {
          const int ts = tl - 3 + jj;
          if (ts >= 0) {
            h16x8 xv = *(const h16x8*)(PROJ + ((size_t)b * SEQ + ts) * LDP + colbase);
            const float4 w0 = *(const float4*)(convw + jj * 1536 + sec * 512 + h * 128 + ch0);
            const float4 w1 = *(const float4*)(convw + jj * 1536 + sec * 512 + h * 128 + ch0 + 4);
            a[0] += w0.x * (float)xv[0]; a[1] += w0.y * (float)xv[1]; a[2] += w0.z * (float)xv[2]; a[3] += w0.w * (float)xv[3];
            a[4] += w1.x * (float)xv[4]; a[5] += w1.y * (float)xv[5]; a[6] += w1.z * (float)xv[6]; a[7] += w1.w * (float)xv[7];
          }
        }
        float ss = 0.f;
#pragma unroll
        for (int e = 0; e < 8; ++e) { a[e] = siluf_(a[e]); ss += a[e] * a[e]; }
        float scale = 1.f;
        if (sec < 2) {
          ss = sum16(ss);
          scale = rsqrtf(ss + 1e-6f) * (sec == 0 ? 0.08838834764831845f : 1.f);
        }
        h16x8 o;
#pragma unroll
        for (int e = 0; e < 8; ++e) o[e] = (h16)(a[e] * scale);
        h16* dst = (sec == 0 ? QH : (sec == 1 ? KH : VH));
        *(h16x8*)(dst + t * 136 + ch0) = o;
      }
    }
  }
  if (tid < 64) {
    const size_t tok = (size_t)b * SEQ + c * 64 + tid;
    float braw = AB[tok * 8 + h], araw = AB[tok * 8 + 4 + h];
    float beta = 1.f / (1.f + expf(-braw));
    float xx = araw + p.in[I_DTB][h];
    float sp = xx > 20.f ? xx : log1pf(expf(xx));
    float gg = -expf(p.in[I_ALOG][h]) * sp;
#pragma unroll
    for (int o = 1; o < 64; o <<= 1) {
      float v = __shfl_up(gg, o);
      if (lane >= o) gg += v;
    }
    sG[tid] = gg;
    sBeta[tid] = beta;
  }
  __syncthreads();
  {
    h16x8 ak[4], aq[4];
#pragma unroll
    for (int ks = 0; ks < 4; ++ks) {
      ak[ks] = *(const h16x8*)(KH + (w * 16 + fr) * 136 + ks * 32 + fq * 8);
      aq[ks] = *(const h16x8*)(QH + (w * 16 + fr) * 136 + ks * 32 + fq * 8);
    }
#pragma unroll
    for (int jt = 0; jt < 4; ++jt) {
      const int j = jt * 16 + fr;
      const int pj = perm_pos(j);
      if (jt <= w) {
        f32x4 kk = {0.f, 0.f, 0.f, 0.f}, qk = {0.f, 0.f, 0.f, 0.f};
#pragma unroll
        for (int ks = 0; ks < 4; ++ks) {
          h16x8 bk = *(const h16x8*)(KH + (jt * 16 + fr) * 136 + ks * 32 + fq * 8);
          kk = MFMA(ak[ks], bk, kk);
          qk = MFMA(aq[ks], bk, qk);
        }
        const float Gj = sG[j];
        f32x4 lt;
#pragma unroll
        for (int r = 0; r < 4; ++r) {
          const int i = w * 16 + 4 * fq + r;
          const float e = (i >= j) ? expf(sG[i] - Gj) : 0.f;
          lt[r] = (i > j) ? sBeta[i] * kk[r] * e : 0.f;
          ATPi[i * 64 + (((pj >> 3) ^ (i & 7)) << 3) + (pj & 7)] = (h16)(qk[r] * e);
        }
        *(f32x4*)(LT + j * 68 + w * 16 + 4 * fq) = lt;
      } else {
#pragma unroll
        for (int r = 0; r < 4; ++r) {
          const int i = w * 16 + 4 * fq + r;
          ATPi[i * 64 + (((pj >> 3) ^ (i & 7)) << 3) + (pj & 7)] = (h16)0.f;
        }
      }
    }
  }
  __syncthreads();
  float r[64];
  if (tid < 128) {
#pragma unroll
    for (int t = 0; t < 64; ++t) r[t] = (float)VH[t * 136 + tid] * sBeta[t];
  } else {
#pragma unroll
    for (int t = 0; t < 64; ++t) r[t] = (float)KH[t * 136 + (tid - 128)] * sBeta[t] * expf(sG[t]);
  }
#pragma unroll
  for (int j = 0; j < 63; ++j) {
    const float xj = r[j];
#pragma unroll
    for (int i4 = (j + 1) / 4; i4 < 16; ++i4) {
      const f32x4 l = *(const f32x4*)(LT + j * 68 + i4 * 4);
#pragma unroll
      for (int e = 0; e < 4; ++e) {
        if (i4 * 4 + e > j) r[i4 * 4 + e] -= l[e] * xj;
      }
    }
    __builtin_amdgcn_sched_barrier(0);
  }
  if (tid < 128) {
#pragma unroll
    for (int t8 = 0; t8 < 8; ++t8) {
      h16x8 v;
#pragma unroll
      for (int e = 0; e < 8; ++e) v[e] = (h16)r[t8 * 8 + e];
      *(h16x8*)(UTi + (size_t)tid * 64 + t8 * 8) = v;
    }
  }
  __syncthreads();
  if (tid >= 128) {
    const int pos = perm_pos(tid - 128);
#pragma unroll
    for (int t = 0; t < 64; ++t) VH[t * 136 + pos] = (h16)r[t];
  }
  __syncthreads();
  for (int rr = 0; rr < 4; ++rr) {
    const int idx = tid + 256 * rr, row = idx >> 4, seg = idx & 15;
    *(h16x8*)(WPi + row * 128 + ((seg ^ (row & 15)) << 3)) = *(const h16x8*)(VH + row * 136 + seg * 8);
  }
  {
    const int dv = tid & 127, th = tid >> 7;
    const float gdv = p.in[I_DNG][dv];
    const h16* zp = PROJ + ((size_t)b * SEQ + c * 64 + th * 32) * LDP + 2560 + h * 128 + dv;
    h16 zv[32];
#pragma unroll
    for (int t = 0; t < 32; ++t) zv[t] = zp[(size_t)t * LDP];
#pragma unroll
    for (int t8 = 0; t8 < 4; ++t8) {
      h16x8 v;
#pragma unroll
      for (int e = 0; e < 8; ++e) v[e] = (h16)(siluf_((float)zv[t8 * 8 + e]) * gdv);
      *(h16x8*)(ZTi + (size_t)dv * 64 + th * 32 + t8 * 8) = v;
    }
  }
#pragma unroll 2
  for (int rr = 0; rr < 32; ++rr) {
    const int idx = tid + 256 * rr, t = idx >> 7, pp = idx & 127;
    const int dk = perm_inv(pp);
    QGPi[t * 128 + (((pp >> 3) ^ (t & 15)) << 3) + (pp & 7)] = (h16)((float)QH[t * 136 + dk] * expf(sG[t]));
  }
  const float Glast = sG[63];
#pragma unroll 2
  for (int rr = 0; rr < 32; ++rr) {
    const int idx = tid + 256 * rr, dk = idx >> 6, tp = idx & 63;
    const int t = perm_inv(tp);
    KDTi[dk * 64 + (((tp >> 3) ^ (dk & 7)) << 3) + (tp & 7)] = (h16)((float)KH[t * 136 + dk] * expf(Glast - sG[t]));
  }
  if (tid == 0) DL[item] = expf(Glast);
  __syncthreads();
}

template <int NB>
__device__ __forceinline__ void glds_copy(const h16* __restrict__ g, unsigned char* l) {
#pragma unroll
  for (int i = 0; i < NB / 4096; ++i) {
    const int off = threadIdx.x * 16 + i * 4096;
    __builtin_amdgcn_global_load_lds((const unsigned*)((const unsigned char*)g + off), (unsigned*)(l + off), 16, 0, 0);
  }
}
#define RAW_BARRIER() do { asm volatile("s_waitcnt lgkmcnt(0)" ::: "memory"); __builtin_amdgcn_s_barrier(); asm volatile("" ::: "memory"); } while (0)

__device__ void gdn_recurrence(const Params& p, int bh, unsigned char* smem) {
  unsigned char* LW = smem;
  unsigned char* LQ = smem + 16384;
  unsigned char* LA = smem + 32768;
  unsigned char* LK = smem + 40960;
  float* red = (float*)(smem + 57344);
  const int tid = threadIdx.x, w = tid >> 6, lane = tid & 63, fr = lane & 15, fq = lane >> 4;
  const int b = bh >> 2, h = bh & 3;
  h16* MIXIN = (h16*)(p.ws + OFF_MIXIN);
  const float* DL = (const float*)(p.ws + OFF_DL);
  const h16* WPb = (const h16*)(p.ws + OFF_WP) + (size_t)bh * 32 * 64 * 128;
  const h16* QGPb = (const h16*)(p.ws + OFF_QGP) + (size_t)bh * 32 * 64 * 128;
  const h16* KDTb = (const h16*)(p.ws + OFF_KDT) + (size_t)bh * 32 * 128 * 64;
  const h16* UTb = (const h16*)(p.ws + OFF_UT) + (size_t)bh * 32 * 128 * 64;
  const h16* ATPb = (const h16*)(p.ws + OFF_ATP) + (size_t)bh * 32 * 64 * 64;
  const h16* ZTb = (const h16*)((unsigned char*)p.out + OUT_OFF_ZT) + (size_t)bh * 32 * 128 * 64;
  f32x4 S[8][2];
#pragma unroll
  for (int i = 0; i < 8; ++i) { S[i][0] = f32x4{0.f, 0.f, 0.f, 0.f}; S[i][1] = f32x4{0.f, 0.f, 0.f, 0.f}; }
  h16x4 uR[4][2];
  glds_copy<16384>(WPb, LW); glds_copy<16384>(QGPb, LQ); glds_copy<8192>(ATPb, LA); glds_copy<16384>(KDTb, LK);
#pragma unroll
  for (int mt = 0; mt < 4; ++mt)
#pragma unroll
    for (int nt = 0; nt < 2; ++nt) {
      uR[mt][nt] = *(const h16x4*)(UTb + (size_t)(w * 32 + nt * 16 + fr) * 64 + mt * 16 + fq * 4);
    }
  asm volatile("s_waitcnt vmcnt(0)" ::: "memory");
  RAW_BARRIER();
  for (int c = 0; c < 32; ++c) {
    const int item = bh * 32 + c;
    const float dl = DL[item];
    const bool more = (c + 1 < 32);
    h16x4 zR[4][2];
#pragma unroll
    for (int mt = 0; mt < 4; ++mt)
#pragma unroll
      for (int nt = 0; nt < 2; ++nt)
        zR[mt][nt] = *(const h16x4*)(ZTb + (size_t)c * 128 * 64 + (size_t)(w * 32 + nt * 16 + fr) * 64 + mt * 16 + fq * 4);
    f32x4 vn[4][2], o[4][2];
#pragma unroll
    for (int mt = 0; mt < 4; ++mt) { vn[mt][0] = f32x4{0.f, 0.f, 0.f, 0.f}; vn[mt][1] = vn[mt][0]; o[mt][0] = vn[mt][0]; o[mt][1] = vn[mt][0]; }
#pragma unroll
    for (int ks = 0; ks < 4; ++ks) {
      const h16x8 sf0 = pack8(S[2 * ks][0], S[2 * ks + 1][0]);
      const h16x8 sf1 = pack8(S[2 * ks][1], S[2 * ks + 1][1]);
#pragma unroll
      for (int mt = 0; mt < 4; ++mt) {
        const int off = (mt * 16 + fr) * 256 + (((ks * 4 + fq) ^ fr) << 4);
        h16x8 aw = *(const h16x8*)(LW + off);
        h16x8 aq = *(const h16x8*)(LQ + off);
        vn[mt][0] = MFMA(aw, sf0, vn[mt][0]);
        vn[mt][1] = MFMA(aw, sf1, vn[mt][1]);
        o[mt][0] = MFMA(aq, sf0, o[mt][0]);
        o[mt][1] = MFMA(aq, sf1, o[mt][1]);
      }
    }
#pragma unroll
    for (int mt = 0; mt < 4; ++mt)
#pragma unroll
      for (int r = 0; r < 4; ++r) { vn[mt][0][r] = (float)uR[mt][0][r] - vn[mt][0][r]; vn[mt][1][r] = (float)uR[mt][1][r] - vn[mt][1][r]; }
    RAW_BARRIER();
    const int cn = more ? c + 1 : c;
    glds_copy<16384>(WPb + (size_t)cn * 64 * 128, LW);
    glds_copy<16384>(QGPb + (size_t)cn * 64 * 128, LQ);
#pragma unroll
    for (int mt = 0; mt < 4; ++mt)
#pragma unroll
      for (int nt = 0; nt < 2; ++nt)
        uR[mt][nt] = *(const h16x4*)(UTb + (size_t)cn * 128 * 64 + (size_t)(w * 32 + nt * 16 + fr) * 64 + mt * 16 + fq * 4);
    h16x8 vfr[2][2];
#pragma unroll
    for (int k2 = 0; k2 < 2; ++k2) { vfr[k2][0] = pack8(vn[2 * k2][0], vn[2 * k2 + 1][0]); vfr[k2][1] = pack8(vn[2 * k2][1], vn[2 * k2 + 1][1]); }
#pragma unroll
    for (int mt = 0; mt < 4; ++mt) {
#pragma unroll
      for (int k2 = 0; k2 < 2; ++k2) {
        h16x8 aa = *(const h16x8*)(LA + (mt * 16 + fr) * 128 + (((k2 * 4 + fq) ^ (fr & 7)) << 4));
        o[mt][0] = MFMA(aa, vfr[k2][0], o[mt][0]);
        o[mt][1] = MFMA(aa, vfr[k2][1], o[mt][1]);
      }
    }
#pragma unroll
    for (int dkt = 0; dkt < 8; ++dkt) {
      f32x4 s0 = S[dkt][0], s1 = S[dkt][1];
#pragma unroll
      for (int r = 0; r < 4; ++r) { s0[r] *= dl; s1[r] *= dl; }
#pragma unroll
      for (int k2 = 0; k2 < 2; ++k2) {
        h16x8 ak = *(const h16x8*)(LK + (dkt * 16 + fr) * 128 + (((k2 * 4 + fq) ^ (fr & 7)) << 4));
        s0 = MFMA(ak, vfr[k2][0], s0);
        s1 = MFMA(ak, vfr[k2][1], s1);
      }
      S[dkt][0] = s0; S[dkt][1] = s1;
    }
#pragma unroll
    for (int mt = 0; mt < 4; ++mt)
#pragma unroll
      for (int r = 0; r < 4; ++r) {
        float s = o[mt][0][r] * o[mt][0][r] + o[mt][1][r] * o[mt][1][r];
        s = sum16(s);
        if (fr == 0) red[w * 64 + mt * 16 + 4 * fq + r] = s;
      }
    RAW_BARRIER();
    glds_copy<8192>(ATPb + (size_t)cn * 64 * 64, LA);
    glds_copy<16384>(KDTb + (size_t)cn * 128 * 64, LK);
    asm volatile("" ::: "memory");
#pragma unroll
    for (int mt = 0; mt < 4; ++mt)
#pragma unroll
      for (int r = 0; r < 4; ++r) {
        const int tl = mt * 16 + 4 * fq + r;
        const float tot = red[tl] + red[64 + tl] + red[128 + tl] + red[192 + tl];
        const float rstd = rsqrtf(tot * (1.f / 128.f) + 1e-6f);
        const size_t tok = (size_t)b * SEQ + c * 64 + tl;
        h16* yp = MIXIN + tok * 1024 + 512 + h * 128 + w * 32 + fr;
        yp[0] = (h16)(o[mt][0][r] * rstd * (float)zR[mt][0][r]);
        yp[16] = (h16)(o[mt][1][r] * rstd * (float)zR[mt][1][r]);
      }
    asm volatile("s_waitcnt vmcnt(32)" ::: "memory");
    RAW_BARRIER();
  }
  asm volatile("s_waitcnt vmcnt(0)" ::: "memory");
  __syncthreads();
}

#define XB_TMO      128
#define XB_XCNT(j)  (256  + 64 * (j))
#define XB_XSUB(j)  (1280 + 64 * (j))
#define XB_XGEN(j)  (2304 + 64 * (j))
#define XB_TOP      3328
#define XB_TOPGEN   3392
#define XCD_BAR_WORDS 3456
#define XB_SPIN_CAP (1u << 18)
#define LAS __attribute__((address_space(3)))

__device__ __forceinline__ unsigned xb_ld(unsigned* p)              { return __hip_atomic_load(p, __ATOMIC_RELAXED, __HIP_MEMORY_SCOPE_AGENT); }
__device__ __forceinline__ unsigned xb_add(unsigned* p, unsigned v) { return __hip_atomic_fetch_add(p, v, __ATOMIC_RELAXED, __HIP_MEMORY_SCOPE_AGENT); }
__device__ __forceinline__ unsigned xb_xcc_id() { return (unsigned)__builtin_amdgcn_s_getreg((3 << 11) | 20) & 0xFu; }
#define XB_SPIN(cond, bar) do { unsigned _sp = 0; while (cond) { __builtin_amdgcn_s_sleep(1); \
    if ((++_sp & 255u) == 0u) { if (xb_ld(&(bar)[XB_TMO])) break; if (_sp > XB_SPIN_CAP) { atomicAdd(&(bar)[XB_TMO], 1u); break; } } } } while (0)

struct XcdBarrier {
    unsigned* bar; unsigned x;
    volatile LAS unsigned* st;
};

__device__ __forceinline__ XcdBarrier xcd_barrier_post(unsigned* bar, volatile LAS unsigned* st) {
    XcdBarrier b; b.bar = bar; b.x = xb_xcc_id(); b.st = st;
    if (threadIdx.x == 0) (void)xb_add(&bar[XB_XCNT(b.x)], 1u);
    return b;
}
__device__ __forceinline__ void xcd_barrier_complete(unsigned* bar, unsigned x, unsigned& nloc, unsigned& nx) {
    const unsigned G = gridDim.x * gridDim.y * gridDim.z;
    unsigned sum, cnt, mine, sp = 0u;
    for (;;) {
        sum = 0u; cnt = 0u; mine = 0u;
#pragma unroll
        for (unsigned j = 0; j < 16; ++j) { const unsigned c = xb_ld(&bar[XB_XCNT(j)]); sum += c; cnt += (c > 0u) ? 1u : 0u; mine = (j == x) ? c : mine; }
        if (sum == G) break;
        __builtin_amdgcn_s_sleep(1);
        if ((++sp & 255u) == 0u) { if (xb_ld(&bar[XB_TMO])) break; if (sp > XB_SPIN_CAP) { atomicAdd(&bar[XB_TMO], 1u); break; } }
    }
    nloc = mine > 0u ? mine : 1u; nx = cnt > 0u ? cnt : 1u;
}

__device__ __forceinline__ void xcd_barrier(const XcdBarrier& b) {
    asm volatile("s_waitcnt vmcnt(0)" ::: "memory");
    __syncthreads();
    if (threadIdx.x == 0) {
        unsigned* bar = b.bar;
        __builtin_amdgcn_s_waitcnt(0);
        unsigned nloc = b.st[0], nx = b.st[1];
        if (nloc == 0u) { xcd_barrier_complete(bar, b.x, nloc, nx); b.st[0] = nloc; b.st[1] = nx; }
        const unsigned old = xb_add(&bar[XB_XSUB(b.x)], 1u);
        const unsigned gen = old / nloc;
        if (old + 1u == (gen + 1u) * nloc) {
            __builtin_amdgcn_fence(__ATOMIC_RELEASE, "agent");
            asm volatile("s_waitcnt vmcnt(0)" ::: "memory");
            const unsigned og = xb_add(&bar[XB_TOP], 1u);
            const unsigned tg = og / nx;
            if (og + 1u == (tg + 1u) * nx) xb_add(&bar[XB_TOPGEN], 1u);
            else XB_SPIN(xb_ld(&bar[XB_TOPGEN]) == tg, bar);
            __builtin_amdgcn_fence(__ATOMIC_ACQUIRE, "agent");
            xb_add(&bar[XB_XGEN(b.x)], 1u);
            asm volatile("s_waitcnt vmcnt(0)" ::: "memory");
        } else {
            XB_SPIN(xb_ld(&bar[XB_XGEN(b.x)]) == gen, bar);
            __builtin_amdgcn_fence(__ATOMIC_ACQUIRE, "agent");
            asm volatile("s_waitcnt vmcnt(0)" ::: "memory");
        }
    }
    __syncthreads();
}

#ifndef ONLY_PH
#define ONLY_PH -1
#endif
#define RUNPH(n) ((ONLY_PH < 0 || ONLY_PH == (n)) && p.ph_lo <= (n) && (n) <= p.ph_hi)
#define SYNCPH(n) do { if (p.ph_lo <= (n) && (n) < p.ph_hi) xcd_barrier(xb); } while (0)
__global__ void __launch_bounds__(256, 2) hymba_mega(Params p) {
  __shared__ __attribute__((aligned(16))) unsigned char smem[SMEM_BYTES];
  cg::grid_group grid = cg::this_grid();
  const int bid = blockIdx.x, nb = gridDim.x;
  if (p.ph_lo < 0) grid.sync();
  XcdBarrier xb;
  {
    volatile LAS unsigned* st = (volatile LAS unsigned*)(smem + SMEM_BYTES - 16);
    if (threadIdx.x == 0) { st[0] = 0u; st[1] = 0u; st[2] = 0u; st[3] = 0u; }
    __syncthreads();
    if (p.ph_lo < p.ph_hi) xb = xcd_barrier_post((unsigned*)(p.ws + OFF_BAR), st);
    else { xb.bar = (unsigned*)(p.ws + OFF_BAR); xb.x = 0; xb.st = st; }
  }
  {
    if (RUNPH(0)) for (int rep = 0; rep < REP0; ++rep) {
      if (rep) grid.sync();
      phase0(p, smem);
    }
    SYNCPH(0);
    if (RUNPH(1)) for (int rep = 0; rep < REP1; ++rep) {
      if (rep) grid.sync();
      const h16* A0 = (const h16*)((unsigned char*)p.out + OUT_OFF_A0);
      const h16* W = (const h16*)(p.ws + OFF_WIN);
      for (int t = bid; t < 256 * 25; t += nb) gemm_tile<EPI_PROJ>(p, A0, 1024, W, 1024, 1024, (t / 25) * 128, (t % 25) * 128, smem);
    }
    SYNCPH(1);
    if (RUNPH(2)) for (int rep = 0; rep < REP2; ++rep) {
      if (rep) grid.sync();
      for (int it = bid; it < 512 + 2048; it += nb) {
        if (it < 2048) gdn_pre_item(p, it, smem);
        else ssm_item(p, (it - 2048) >> 5, (it - 2048) & 31, smem);
      }
    }
    SYNCPH(2);
    if (RUNPH(3)) for (int rep = 0; rep < REP3; ++rep) {
      if (rep) grid.sync();
      const int nrec = 64;
      if (bid < nrec) for (int it = bid; it < nrec; it += nb) gdn_recurrence(p, it, smem);
      if (nb <= nrec || bid >= nrec) {
        const int start = nb > nrec ? bid - nrec : bid, step = nb > nrec ? nb - nrec : nb;
        const h16* YPRE = (const h16*)((unsigned char*)p.out + OUT_OFF_YPRE);
        for (int t = start; t < 1024 + 2048; t += step) {
          if (t < 1024) gemm_tile<EPI_GLU>(p, YPRE, 512, (const h16*)(p.ws + OFF_WGLU), 512, 512, (t >> 2) * 128, (t & 3) * 128, smem);
          else gemm_tile<EPI_PLE>(p, (const h16*)(p.ws + OFF_PB), 256, (const h16*)(p.ws + OFF_WPP), 256, 256, ((t - 1024) >> 3) * 128, ((t - 1024) & 7) * 128, smem);
        }
      }
    }
    SYNCPH(3);
    if (RUNPH(4)) for (int rep = 0; rep < REP4; ++rep) {
      if (rep) grid.sync();
      for (int t = bid; t < 2048; t += nb)
        gemm_tile<EPI_OUT>(p, (const h16*)(p.ws + OFF_MIXIN), 1024, (const h16*)(p.ws + OFF_WOUT), 1024, 1024, (t >> 3) * 128, (t & 7) * 128, smem);
    }
    SYNCPH(4);
    if (RUNPH(5)) {
      for (int t = bid; t < 2048; t += nb)
        gemm_tile<EPI_GATE>(p, (const h16*)(p.ws + OFF_PROJ), 1024, (const h16*)(p.ws + OFF_WGATE), 1024, 1024, (t >> 3) * 128, (t & 7) * 128, smem);
    }
    SYNCPH(5);
    if (RUNPH(6)) {
      const int wid = threadIdx.x >> 6, lane = threadIdx.x & 63;
      const float* OPART = (const float*)(p.ws + OFF_OPART);
      const float4* g4 = (const float4*)p.in[I_FING];
      for (int row = bid * 4 + wid; row < T_TOK; row += nb * 4) {
        float s = (lane < 8) ? OPART[(size_t)row * 8 + lane] : 0.f;
        s = wave_sum(s);
        const float rstd = rsqrtf(s * (1.f / 1024.f) + 1e-6f);
        float4* orow = (float4*)(p.out + (size_t)row * 1024);
#pragma unroll
        for (int i = 0; i < 4; ++i) {
          float4 v = orow[lane + i * 64];
          float4 g = g4[lane + i * 64];
          v.x *= rstd * g.x; v.y *= rstd * g.y; v.z *= rstd * g.z; v.w *= rstd * g.w;
          orow[lane + i * 64] = v;
        }
      }
    }
  }
}

extern "C" void kernel_launch(void* const* d_in, const int* in_sizes, int n_in, void* d_out, int out_size, void* d_ws, size_t ws_size,
                              hipStream_t stream) {
  static int grid_blocks = 0;
  if (!grid_blocks) {
    int dev = 0, cus = 0, per_cu = 0;
    hipGetDevice(&dev);
    hipDeviceGetAttribute(&cus, hipDeviceAttributeMultiprocessorCount, dev);
    hipOccupancyMaxActiveBlocksPerMultiprocessor(&per_cu, hymba_mega, 256, 0);
    if (per_cu > 2) per_cu = 2;
    if (per_cu < 1) per_cu = 1;
    grid_blocks = cus * per_cu;
  }
  if (n_in != 23 || ws_size < WS_END || out_size != T_TOK * 1024) {
    fprintf(stderr, "kernel_launch: unexpected sizes n_in=%d ws=%zu (need %zu) out=%d\n", n_in, ws_size, (size_t)WS_END, out_size);
    return;
  }
  Params p{};
  for (int i = 0; i < 23; ++i) p.in[i] = (const float*)d_in[i];
  p.out = (float*)d_out;
  p.ws = (unsigned char*)d_ws;
#if MULTI_LAUNCH
  for (int ph = 0; ph < NPH; ++ph) {
    p.ph_lo = ph; p.ph_hi = ph;
    hipLaunchKernelGGL(hymba_mega, dim3(grid_blocks), dim3(256), 0, stream, p);
  }
#else
  p.ph_lo = 0; p.ph_hi = NPH - 1;
  if (hipMemsetAsync((unsigned char*)d_ws + OFF_BAR, 0, 16384, stream) != hipSuccess) { fprintf(stderr, "kernel_launch: memset of barrier words failed\n"); return; }
  void* args[] = {&p};
  hipError_t e = hipLaunchCooperativeKernel((void*)hymba_mega, dim3(grid_blocks), dim3(256), args, 0, stream);
  if (e != hipSuccess) fprintf(stderr, "cooperative launch failed: %s (grid %d)\n", hipGetErrorString(e), grid_blocks);
#endif
}
```

```cpp
#include <hip/hip_runtime.h>
#include <hip/hip_cooperative_groups.h>
#include <cstdio>
namespace cg = cooperative_groups;

#ifndef REP0
#define REP0 1
#endif
#ifndef REP1
#define REP1 1
#endif
#ifndef REP2
#define REP2 1
#endif
#ifndef REP3
#define REP3 1
#endif
#ifndef REP4
#define REP4 1
#endif
#ifndef MULTI_LAUNCH
#define MULTI_LAUNCH 0
#endif

typedef _Float16 h16;
typedef __attribute__((ext_vector_type(8))) _Float16 h16x8;
typedef __attribute__((ext_vector_type(4))) _Float16 h16x4;
typedef __attribute__((ext_vector_type(4))) float f32x4;

#define MFMA(a, b, c) __builtin_amdgcn_mfma_f32_16x16x32_f16((a), (b), (c), 0, 0, 0)

constexpr int T_TOK = 32768;
constexpr int SEQ = 2048;
constexpr int NPH = 8;
constexpr int LDP = 3072;
constexpr int SMEM_BYTES = 70400;

constexpr size_t SZ_WIN = (size_t)3200 * 1024 * 2;
constexpr size_t SZ_WGLU = (size_t)512 * 512 * 2;
constexpr size_t SZ_WOUT = (size_t)1024 * 1024 * 2;
constexpr size_t SZ_WPP = (size_t)1024 * 256 * 2;
constexpr size_t SZ_WGATE = (size_t)1024 * 1024 * 2;
constexpr size_t OFF_WIN = 0;
constexpr size_t OFF_WGLU = OFF_WIN + SZ_WIN;
constexpr size_t OFF_WOUT = OFF_WGLU + SZ_WGLU;
constexpr size_t OFF_WPP = OFF_WOUT + SZ_WOUT;
constexpr size_t OFF_WGATE = OFF_WPP + SZ_WPP;
constexpr size_t OFF_PB = OFF_WGATE + SZ_WGATE;
constexpr size_t OFF_PROJ = OFF_PB + (size_t)T_TOK * 256 * 2;
constexpr size_t OFF_AB = OFF_PROJ + (size_t)T_TOK * LDP * 2;
constexpr size_t OFF_KTAB = OFF_AB + (size_t)T_TOK * 8 * 4;
constexpr size_t OFF_ETAB = OFF_KTAB + (size_t)32 * 33 * 256 * 2;
constexpr size_t OFF_FTAB = OFF_ETAB + (size_t)32 * 128 * 512 * 2;
constexpr size_t OFF_ALPOW = OFF_FTAB + (size_t)32 * 512 * 128 * 2;
constexpr size_t OFF_DL = OFF_ALPOW + (size_t)32 * 64 * 2 * 4;
constexpr size_t OFF_EPART = OFF_DL + (size_t)2048 * 4;
constexpr size_t OFF_OPART = OFF_EPART + (size_t)T_TOK * 16 * 4;
constexpr size_t OFF_MIXIN = OFF_OPART + (size_t)T_TOK * 16 * 4;
constexpr size_t OFF_WP = OFF_MIXIN + (size_t)T_TOK * 1024 * 2;
constexpr size_t OFF_QGP = OFF_WP + (size_t)2048 * 64 * 128 * 2;
constexpr size_t OFF_KDT = OFF_QGP + (size_t)2048 * 64 * 128 * 2;
constexpr size_t OFF_UT = OFF_KDT + (size_t)2048 * 128 * 64 * 2;
constexpr size_t OFF_ATP = OFF_UT + (size_t)2048 * 128 * 64 * 2;
constexpr size_t OFF_EH = OFF_ATP + (size_t)2048 * 64 * 64 * 2;
constexpr size_t OFF_BAR = OFF_EH + (size_t)T_TOK * 1024 * 2;
constexpr size_t WS_END = OFF_BAR + 16384;
constexpr size_t OFF_CTR = OFF_BAR + 15360;
constexpr size_t OUT_OFF_A0 = 0;
constexpr size_t OUT_OFF_SF = 0;
constexpr size_t OUT_OFF_YPRE = (size_t)T_TOK * 1024 * 2;
constexpr size_t OUT_OFF_ZT = OUT_OFF_YPRE + (size_t)T_TOK * 512 * 2;

struct Params {
  const float* in[23];
  float* out;
  unsigned char* ws;
  int ph_lo, ph_hi;
};

enum { I_X = 0, I_P, I_NMG, I_WIN, I_ARE, I_AIM, I_BRE, I_BIM, I_CRE, I_CIM, I_D, I_LOGDT, I_WGLU, I_BGLU,
       I_CONVW, I_ALOG, I_DTB, I_DNG, I_WOUT, I_WPP, I_PLEG, I_WGATE, I_FING };

__device__ __forceinline__ float wave_sum(float v) {
#pragma unroll
  for (int o = 32; o > 0; o >>= 1) v += __shfl_xor(v, o);
  return v;
}
__device__ __forceinline__ float sum16(float v) {
  v += __shfl_xor(v, 1); v += __shfl_xor(v, 2); v += __shfl_xor(v, 4); v += __shfl_xor(v, 8);
  return v;
}
__device__ __forceinline__ float sigmoidf_(float x) { return 1.f / (1.f + __expf(-x)); }
__device__ __forceinline__ float siluf_(float x) { return x / (1.f + __expf(-x)); }
__device__ __forceinline__ float gelu_tanh(float y) {
  float z = 0.7978845608028654f * (y + 0.044715f * y * y * y);
  return 0.5f * y * (1.f + tanhf(z));
}
__device__ __forceinline__ h16x8 pack8(f32x4 lo, f32x4 hi) {
  h16x8 r;
  r[0] = (h16)lo[0]; r[1] = (h16)lo[1]; r[2] = (h16)lo[2]; r[3] = (h16)lo[3];
  r[4] = (h16)hi[0]; r[5] = (h16)hi[1]; r[6] = (h16)hi[2]; r[7] = (h16)hi[3];
  return r;
}
__device__ __forceinline__ int perm_pos(int n) { return (n & ~31) + (((n & 15) >> 2) << 3) + (((n >> 4) & 1) << 2) + (n & 3); }
__device__ __forceinline__ int perm_inv(int pos) {
  int q5 = pos & 31, qq = q5 >> 3, jj = q5 & 7;
  return (pos & ~31) + (jj < 4 ? 4 * qq + jj : 16 + 4 * qq + (jj - 4));
}

__device__ void transpose_w(const float* __restrict__ W, int K, int N, int Npad, h16* __restrict__ WT, int t, float* tile) {
  const int ntn = Npad / 64;
  const int kt = t / ntn, nt = t % ntn, k0 = kt * 64, n0 = nt * 64;
  const int tx = threadIdx.x & 63, ty = threadIdx.x >> 6;
  for (int r = 0; r < 16; ++r) {
    int k = ty * 16 + r, n = n0 + tx;
    tile[k * 65 + tx] = (n < N) ? W[(size_t)(k0 + k) * N + n] : 0.f;
  }
  __syncthreads();
  for (int r = 0; r < 16; ++r) {
    int n = ty * 16 + r;
    WT[(size_t)(n0 + n) * K + k0 + tx] = (h16)tile[tx * 65 + n];
  }
  __syncthreads();
}

__device__ void ssm_table_item(const Params& p, int g, int d, float* lds) {
  float2* sAp = (float2*)lds;
  float2* sW = sAp + 64;
  const int tid = threadIdx.x;
  h16* KTAB = (h16*)(p.ws + OFF_KTAB);
  h16* ETAB = (h16*)(p.ws + OFF_ETAB);
  h16* FTAB = (h16*)(p.ws + OFF_FTAB);
  float* ALPOW = (float*)(p.ws + OFF_ALPOW);
  float* sBr = lds + 256; float* sBi = sBr + 1024; float* sCr = sBi + 1024; float* sCi = sCr + 16 * 65;
  {
    const float4 vbr = ((const float4*)(p.in[I_BRE] + g * 1024))[tid], vbi = ((const float4*)(p.in[I_BIM] + g * 1024))[tid];
    const float4 vcr = ((const float4*)(p.in[I_CRE] + g * 1024))[tid], vci = ((const float4*)(p.in[I_CIM] + g * 1024))[tid];
    *(float4*)(sBr + tid * 4) = vbr; *(float4*)(sBi + tid * 4) = vbi;
    const int ch = (tid * 4) >> 6, cp = (tid * 4) & 63;
    sCr[ch * 65 + cp] = vcr.x; sCr[ch * 65 + cp + 1] = vcr.y; sCr[ch * 65 + cp + 2] = vcr.z; sCr[ch * 65 + cp + 3] = vcr.w;
    sCi[ch * 65 + cp] = vci.x; sCi[ch * 65 + cp + 1] = vci.y; sCi[ch * 65 + cp + 2] = vci.z; sCi[ch * 65 + cp + 3] = vci.w;
  }
  if (tid < 64) {
    const int pp = tid;
    float lr = p.in[I_ARE][g * 64 + pp], li = p.in[I_AIM][g * 64 + pp], dt = expf(p.in[I_LOGDT][g]);
    float mag = expf(lr * dt), ang = li * dt;
    float abr = mag * cosf(ang), abi = mag * sinf(ang);
    float nr = abr - 1.f, ni = abi, den = lr * lr + li * li;
    float cr = (nr * lr + ni * li) / den, ci = (ni * lr - nr * li) / den;
    float apr = 1.f, api = 0.f;
    for (int k = 0; k < d; ++k) { float t0 = apr * abr - api * abi; api = apr * abi + api * abr; apr = t0; }
    sAp[pp] = make_float2(apr, api);
    sW[pp] = make_float2(apr * cr - api * ci, apr * ci + api * cr);
    if (d == 32) { ALPOW[(g * 64 + pp) * 2] = apr; ALPOW[(g * 64 + pp) * 2 + 1] = api; }
  }
  __syncthreads();
  if (d < 32) {
    {
      const int h = tid >> 4, hp = tid & 15;
      float acc = 0.f;
#pragma unroll 8
      for (int pp = 0; pp < 64; ++pp) {
        float2 W = sW[pp];
        float br = sBr[pp * 16 + hp], bi = sBi[pp * 16 + hp];
        float wbr = W.x * br - W.y * bi, wbi = W.x * bi + W.y * br;
        float cr = sCr[h * 65 + pp], ci = sCi[h * 65 + pp];
        acc += cr * wbr - ci * wbi;
      }
      KTAB[(size_t)(g * 33 + d + 1) * 256 + h * 16 + hp] = (h16)acc;
      if (d == 0) KTAB[(size_t)(g * 33) * 256 + tid] = (h16)0.f;
    }
    {
      const int i = 31 - d;
#pragma unroll
      for (int r = 0; r < 4; ++r) {
        int idx = tid + 256 * r, pp = idx >> 4, hp = idx & 15;
        float2 W = sW[pp];
        float br = sBr[pp * 16 + hp], bi = sBi[pp * 16 + hp];
        float wbr = W.x * br - W.y * bi, wbi = W.x * bi + W.y * br;
        ETAB[((size_t)g * 128 + pp) * 512 + i * 16 + hp] = (h16)wbr;
        ETAB[((size_t)g * 128 + 64 + pp) * 512 + i * 16 + hp] = (h16)wbi;
      }
    }
  }
  if (d >= 1) {
    const int j = d - 1;
#pragma unroll
    for (int r = 0; r < 4; ++r) {
      int idx = tid + 256 * r, h = idx >> 6, pp = idx & 63;
      float2 Ap = sAp[pp];
      float cr = sCr[h * 65 + pp], ci = sCi[h * 65 + pp];
      float re = cr * Ap.x - ci * Ap.y, im = cr * Ap.y + ci * Ap.x;
      FTAB[((size_t)g * 512 + j * 16 + h) * 128 + pp] = (h16)re;
      FTAB[((size_t)g * 512 + j * 16 + h) * 128 + 64 + pp] = (h16)(-im);
    }
  }
  __syncthreads();
}

__device__ void phase0(const Params& p, unsigned char* smem) {
  const int bid = blockIdx.x, nb = gridDim.x, tid = threadIdx.x, wid = tid >> 6, lane = tid & 63;
  float* tile = (float*)smem;
  for (int t = bid; t < 1440; t += nb) {
    if (t < 800) transpose_w(p.in[I_WIN], 1024, 3080, 3200, (h16*)(p.ws + OFF_WIN), t, tile);
    else if (t < 864) transpose_w(p.in[I_WGLU], 512, 512, 512, (h16*)(p.ws + OFF_WGLU), t - 800, tile);
    else if (t < 1120) transpose_w(p.in[I_WOUT], 1024, 1024, 1024, (h16*)(p.ws + OFF_WOUT), t - 864, tile);
    else if (t < 1184) transpose_w(p.in[I_WPP], 256, 1024, 1024, (h16*)(p.ws + OFF_WPP), t - 1120, tile);
    else transpose_w(p.in[I_WGATE], 1024, 1024, 1024, (h16*)(p.ws + OFF_WGATE), t - 1184, tile);
  }
  for (int it = bid; it < 32 * 33; it += nb) ssm_table_item(p, it / 33, it % 33, (float*)smem);
  {
    h16* A0 = (h16*)((unsigned char*)p.out + OUT_OFF_A0);
    const float* x = p.in[I_X];
    const float4* g4 = (const float4*)p.in[I_NMG];
    for (int row = bid * 4 + wid; row < T_TOK; row += nb * 4) {
      const float4* xr = (const float4*)(x + (size_t)row * 1024);
      float4 v[4];
      float ss = 0.f;
#pragma unroll
      for (int i = 0; i < 4; ++i) {
        v[i] = xr[lane + i * 64];
        ss += v[i].x * v[i].x + v[i].y * v[i].y + v[i].z * v[i].z + v[i].w * v[i].w;
      }
      ss = wave_sum(ss);
      float rstd = rsqrtf(ss * (1.f / 1024.f) + 1e-6f);
#pragma unroll
      for (int i = 0; i < 4; ++i) {
        float4 g = g4[lane + i * 64];
        h16x4 o;
        o[0] = (h16)(v[i].x * rstd * g.x); o[1] = (h16)(v[i].y * rstd * g.y);
        o[2] = (h16)(v[i].z * rstd * g.z); o[3] = (h16)(v[i].w * rstd * g.w);
        *(h16x4*)(A0 + (size_t)row * 1024 + (lane + i * 64) * 4) = o;
      }
    }
  }
  {
    h16* PB = (h16*)(p.ws + OFF_PB);
    const float4* p4 = (const float4*)p.in[I_P];
    const size_t n4 = (size_t)T_TOK * 256 / 4;
    for (size_t i = (size_t)bid * 256 + tid; i < n4; i += (size_t)nb * 256) {
      float4 v = p4[i];
      h16x4 o;
      o[0] = (h16)v.x; o[1] = (h16)v.y; o[2] = (h16)v.z; o[3] = (h16)v.w;
      *(h16x4*)(PB + i * 4) = o;
    }
  }
}

enum { EPI_PROJ = 0, EPI_GLU, EPI_PLE, EPI_OUT, EPI_GATE };

template <int EPI>
__device__ __forceinline__ void gemm_tile(const Params& p, const h16* __restrict__ A, int lda, const h16* __restrict__ Bt, int ldb,
                                          int K, int brow, int bcol, unsigned char* smem) {
  const int tid = threadIdx.x, wid = tid >> 6, lane = tid & 63, wr = wid >> 1, wc = wid & 1, fr = lane & 15, fq = lane >> 4;
  f32x4 acc[4][4];
#pragma unroll
  for (int m = 0; m < 4; ++m)
#pragma unroll
    for (int n = 0; n < 4; ++n) acc[m][n] = f32x4{0.f, 0.f, 0.f, 0.f};
  const int nk = K / 32;
  const int sb0 = tid * 16, sr0 = sb0 >> 6, sc0 = (sb0 & 63) >> 1;
  const h16* ga = A + (size_t)(brow + sr0) * lda + sc0;
  const h16* gb = Bt + (size_t)(bcol + sr0) * ldb + sc0;
#define GEMM_STAGE(t_, buf_) do { \
    unsigned char* sa_ = smem + (buf_) * 16384; \
    __builtin_amdgcn_global_load_lds((const unsigned*)(ga + (t_) * 32), (unsigned*)(sa_ + sb0), 16, 0, 0); \
    __builtin_amdgcn_global_load_lds((const unsigned*)(ga + (size_t)64 * lda + (t_) * 32), (unsigned*)(sa_ + sb0 + 4096), 16, 0, 0); \
    __builtin_amdgcn_global_load_lds((const unsigned*)(gb + (t_) * 32), (unsigned*)(sa_ + 8192 + sb0), 16, 0, 0); \
    __builtin_amdgcn_global_load_lds((const unsigned*)(gb + (size_t)64 * ldb + (t_) * 32), (unsigned*)(sa_ + 8192 + sb0 + 4096), 16, 0, 0); \
  } while (0)
  GEMM_STAGE(0, 0);
  for (int t = 0; t < nk; ++t) {
    asm volatile("s_waitcnt vmcnt(0)" ::: "memory");
    __syncthreads();
    if (t + 1 < nk) GEMM_STAGE(t + 1, (t + 1) & 1);
    const unsigned char* SA = smem + (t & 1) * 16384;
    const unsigned char* SB = SA + 8192;
    h16x8 af[4], bf[4];
#pragma unroll
    for (int m = 0; m < 4; ++m) {
      af[m] = *(const h16x8*)(SA + (wr * 64 + m * 16 + fr) * 64 + fq * 16);
      bf[m] = *(const h16x8*)(SB + (wc * 64 + m * 16 + fr) * 64 + fq * 16);
    }
#pragma unroll
    for (int m = 0; m < 4; ++m)
#pragma unroll
      for (int n = 0; n < 4; ++n) acc[m][n] = MFMA(af[m], bf[n], acc[m][n]);
  }
#undef GEMM_STAGE
  __syncthreads();
  float* CT = (float*)smem;
#pragma unroll
  for (int m = 0; m < 4; ++m)
#pragma unroll
    for (int n = 0; n < 4; ++n)
#pragma unroll
      for (int j = 0; j < 4; ++j) CT[(wr * 64 + m * 16 + fq * 4 + j) * 132 + wc * 64 + n * 16 + fr] = acc[m][n][j];
  __syncthreads();
  const int c4 = tid & 31;
#pragma unroll 2
  for (int it = 0; it < 16; ++it) {
    const int rl = it * 8 + (tid >> 5);
    const size_t row = (size_t)brow + rl;
    const int col = bcol + c4 * 4;
    const float4 v = *(const float4*)(CT + rl * 132 + c4 * 4);
    if constexpr (EPI == EPI_PROJ) {
      if (bcol < 3072) {
        h16x4 o; o[0] = (h16)v.x; o[1] = (h16)v.y; o[2] = (h16)v.z; o[3] = (h16)v.w;
        *(h16x4*)((h16*)(p.ws + OFF_PROJ) + row * LDP + col) = o;
      } else if (c4 < 2) {
        *(float4*)((float*)(p.ws + OFF_AB) + row * 8 + c4 * 4) = v;
      }
    } else if constexpr (EPI == EPI_GLU) {
      const h16x4 y = *(const h16x4*)((const h16*)((unsigned char*)p.out + OUT_OFF_YPRE) + row * 512 + col);
      const h16x4 z = *(const h16x4*)((const h16*)(p.ws + OFF_PROJ) + row * LDP + 512 + col);
      const float4 bb = *(const float4*)(p.in[I_BGLU] + col);
      h16x4 o;
      o[0] = (h16)((float)y[0] * sigmoidf_(v.x + bb.x) * siluf_((float)z[0]));
      o[1] = (h16)((float)y[1] * sigmoidf_(v.y + bb.y) * siluf_((float)z[1]));
      o[2] = (h16)((float)y[2] * sigmoidf_(v.z + bb.z) * siluf_((float)z[2]));
      o[3] = (h16)((float)y[3] * sigmoidf_(v.w + bb.w) * siluf_((float)z[3]));
      *(h16x4*)((h16*)(p.ws + OFF_MIXIN) + row * 1024 + col) = o;
    } else if constexpr (EPI == EPI_PLE) {
      h16x4 o; o[0] = (h16)v.x; o[1] = (h16)v.y; o[2] = (h16)v.z; o[3] = (h16)v.w;
      *(h16x4*)((h16*)(p.ws + OFF_EH) + row * 1024 + col) = o;
      float s = v.x * v.x + v.y * v.y + v.z * v.z + v.w * v.w;
      s = sum16(s); s += __shfl_xor(s, 16);
      if (c4 == 0) ((float*)(p.ws + OFF_EPART))[row * 8 + (bcol >> 7)] = s;
    } else if constexpr (EPI == EPI_OUT) {
      const float4 xv = *(const float4*)(p.in[I_X] + row * 1024 + col);
      float4 hv; hv.x = xv.x + v.x; hv.y = xv.y + v.y; hv.z = xv.z + v.z; hv.w = xv.w + v.w;
      *(float4*)(p.out + row * 1024 + col) = hv;
      h16x4 o; o[0] = (h16)hv.x; o[1] = (h16)hv.y; o[2] = (h16)hv.z; o[3] = (h16)hv.w;
      *(h16x4*)((h16*)(p.ws + OFF_PROJ) + row * 1024 + col) = o;
    } else if constexpr (EPI == EPI_GATE) {
      const float4 e0 = *(const float4*)((const float*)(p.ws + OFF_EPART) + row * 8);
      const float4 e1 = *(const float4*)((const float*)(p.ws + OFF_EPART) + row * 8 + 4);
      const float rs = rsqrtf((e0.x + e0.y + e0.z + e0.w + e1.x + e1.y + e1.z + e1.w) * (1.f / 1024.f) + 1e-6f);
      const h16x4 eh = *(const h16x4*)((const h16*)(p.ws + OFF_EH) + row * 1024 + col);
      const float4 pg = *(const float4*)(p.in[I_PLEG] + col);
      float4 hv = *(const float4*)(p.out + row * 1024 + col);
      hv.x += sigmoidf_(v.x) * ((float)eh[0] * rs * pg.x);
      hv.y += sigmoidf_(v.y) * ((float)eh[1] * rs * pg.y);
      hv.z += sigmoidf_(v.z) * ((float)eh[2] * rs * pg.z);
      hv.w += sigmoidf_(v.w) * ((float)eh[3] * rs * pg.w);
      *(float4*)(p.out + row * 1024 + col) = hv;
      float s = hv.x * hv.x + hv.y * hv.y + hv.z * hv.z + hv.w * hv.w;
      s = sum16(s); s += __shfl_xor(s, 16);
      if (c4 == 0) ((float*)(p.ws + OFF_OPART))[row * 8 + (bcol >> 7)] = s;
    }
  }
  __syncthreads();
}

__device__ void ssm_item(const Params& p, int b, int g, unsigned char* smem) {
  float* LOCAL = (float*)smem;
  h16* SPREV = (h16*)(smem + 33792);
  h16* KT = (h16*)(smem + 51200);
  int tid_ = threadIdx.x;
  asm volatile("" : "+v"(tid_));
  const int tid = tid_, w = tid >> 6, lane = tid & 63, fr = lane & 15, fq = lane >> 4;
  const h16* PROJ = (const h16*)(p.ws + OFF_PROJ);
  const h16* Eg = (const h16*)(p.ws + OFF_ETAB) + (size_t)g * 128 * 512;
  const h16* Kg = (const h16*)(p.ws + OFF_KTAB) + (size_t)g * 33 * 256;
  const h16* Fg = (const h16*)(p.ws + OFF_FTAB) + (size_t)g * 512 * 128;
  const float* ALPOW = (const float*)(p.ws + OFF_ALPOW);
  h16* YPRE = (h16*)((unsigned char*)p.out + OUT_OFF_YPRE);
  const int nchunk = w * 16 + fr;
  const size_t tok0 = (size_t)b * SEQ + (size_t)nchunk * 32;
  for (int idx = tid; idx < 33 * 256 / 8; idx += 256) *(h16x8*)(KT + idx * 8) = *(const h16x8*)(Kg + idx * 8);
  h16x8 uf[16];
#pragma unroll
  for (int ks = 0; ks < 16; ++ks) {
    const int i = 2 * ks + (fq >> 1);
    uf[ks] = *(const h16x8*)(PROJ + (tok0 + i) * LDP + g * 16 + (fq & 1) * 8);
  }
  {
    h16x8 ea[8];
#pragma unroll
    for (int ks = 0; ks < 8; ++ks) ea[ks] = *(const h16x8*)(Eg + (size_t)fr * 512 + ks * 32 + fq * 8);
    f32x4 acc = {0.f, 0.f, 0.f, 0.f};
#pragma unroll 1
    for (int it = 0; it < 16; ++it) {
      const int mt = it >> 1, hf = it & 1;
      const int itn = it < 15 ? it + 1 : 15;
      h16x8 en[8];
#pragma unroll
      for (int ks = 0; ks < 8; ++ks) en[ks] = *(const h16x8*)(Eg + (size_t)((itn >> 1) * 16 + fr) * 512 + ((itn & 1) * 8 + ks) * 32 + fq * 8);
      if (hf == 0) {
#pragma unroll
        for (int ks = 0; ks < 8; ++ks) acc = MFMA(ea[ks], uf[ks], acc);
      } else {
#pragma unroll
        for (int ks = 0; ks < 8; ++ks) acc = MFMA(ea[ks], uf[8 + ks], acc);
        *(f32x4*)(LOCAL + nchunk * 132 + mt * 16 + fq * 4) = acc;
        acc = f32x4{0.f, 0.f, 0.f, 0.f};
      }
#pragma unroll
      for (int ks = 0; ks < 8; ++ks) ea[ks] = en[ks];
    }
  }
  __syncthreads();
  if (tid < 64) {
    const int pp = tid;
    const float ar = ALPOW[(g * 64 + pp) * 2], ai = ALPOW[(g * 64 + pp) * 2 + 1];
    float sr = 0.f, si = 0.f;
#pragma unroll 4
    for (int c = 0; c < 64; ++c) {
      SPREV[c * 136 + pp] = (h16)sr;
      SPREV[c * 136 + 64 + pp] = (h16)si;
      float lr = LOCAL[c * 132 + pp], li = LOCAL[c * 132 + 64 + pp];
      float nr = ar * sr - ai * si + lr;
      float ni = ar * si + ai * sr + li;
      sr = nr; si = ni;
    }
  }
  __syncthreads();
  h16x8 sf[4];
#pragma unroll
  for (int ks = 0; ks < 4; ++ks) sf[ks] = *(const h16x8*)(SPREV + nchunk * 136 + ks * 32 + fq * 8);
  const float4 Dv = *(const float4*)(p.in[I_D] + g * 16 + fq * 4);
  h16x8 fa[4];
#pragma unroll
  for (int ks = 0; ks < 4; ++ks) fa[ks] = *(const h16x8*)(Fg + (size_t)fr * 128 + ks * 32 + fq * 8);
  h16x4 u4 = *(const h16x4*)(PROJ + tok0 * LDP + g * 16 + fq * 4);
#pragma unroll 1
  for (int j = 0; j < 32; ++j) {
    const int jn = j < 31 ? j + 1 : 31;
    h16x8 fn[4];
#pragma unroll
    for (int ks = 0; ks < 4; ++ks) fn[ks] = *(const h16x8*)(Fg + (size_t)(jn * 16 + fr) * 128 + ks * 32 + fq * 8);
    const h16x4 un = *(const h16x4*)(PROJ + (tok0 + jn) * LDP + g * 16 + fq * 4);
    f32x4 acc = {0.f, 0.f, 0.f, 0.f};
#pragma unroll
    for (int ks = 0; ks < 16; ++ks) {
      if (2 * ks <= j) {
        const int dd = j - 2 * ks - (fq >> 1) + 1;
        h16x8 a = *(const h16x8*)(KT + dd * 256 + fr * 16 + (fq & 1) * 8);
        acc = MFMA(a, uf[ks], acc);
      }
    }
#pragma unroll
    for (int ks = 0; ks < 4; ++ks) acc = MFMA(fa[ks], sf[ks], acc);
    const size_t tok = tok0 + j;
    h16x4 o;
    o[0] = (h16)gelu_tanh(acc[0] + Dv.x * (float)u4[0]);
    o[1] = (h16)gelu_tanh(acc[1] + Dv.y * (float)u4[1]);
    o[2] = (h16)gelu_tanh(acc[2] + Dv.z * (float)u4[2]);
    o[3] = (h16)gelu_tanh(acc[3] + Dv.w * (float)u4[3]);
    *(h16x4*)(YPRE + tok * 512 + g * 16 + fq * 4) = o;
#pragma unroll
    for (int ks = 0; ks < 4; ++ks) fa[ks] = fn[ks];
    u4 = un;
  }
  __syncthreads();
}

__device__ void gdn_pre_item(const Params& p, int item, unsigned char* smem) {
  h16* QH = (h16*)smem;
  h16* KH = (h16*)(smem + 17408);
  h16* VH = (h16*)(smem + 34816);
  float* LT = (float*)(smem + 52224);
  float* sG = (float*)(smem + 69632);
  float* sBeta = (float*)(smem + 69888);
  int tid_ = threadIdx.x;
  asm volatile("" : "+v"(tid_));
  const int tid = tid_, w = tid >> 6, lane = tid & 63, fr = lane & 15, fq = lane >> 4;
  const int c = item & 31, h = (item >> 5) & 3, b = item >> 7;
  const h16* PROJ = (const h16*)(p.ws + OFF_PROJ);
  const float* AB = (const float*)(p.ws + OFF_AB);
  const float* convw = p.in[I_CONVW];
  h16* WPi = (h16*)(p.ws + OFF_WP) + (size_t)item * 64 * 128;
  h16* QGPi = (h16*)(p.ws + OFF_QGP) + (size_t)item * 64 * 128;
  h16* KDTi = (h16*)(p.ws + OFF_KDT) + (size_t)item * 128 * 64;
  h16* UTi = (h16*)(p.ws + OFF_UT) + (size_t)item * 128 * 64;
  h16* ATPi = (h16*)(p.ws + OFF_ATP) + (size_t)item * 64 * 64;
  h16* ZTi = (h16*)((unsigned char*)p.out + OUT_OFF_ZT) + (size_t)item * 128 * 64;
  float* DL = (float*)(p.ws + OFF_DL);
  {
    const int ch0 = (tid & 15) * 8, trow = tid >> 4;
#pragma unroll 1
    for (int pass = 0; pass < 4; ++pass) {
      const int t = pass * 16 + trow, tl = c * 64 + t;
#pragma unroll
      for (int sec = 0; sec < 3; ++sec) {
        const int colbase = 1024 + sec * 512 + h * 128 + ch0;
        float a[8];
#pragma unroll
        for (int e = 0; e < 8; ++e) a[e] = 0.f;
#pragma unroll
        for (int jj = 0; jj < 4; ++jj) {
          const int ts = tl - 3 + jj;
          if (ts >= 0) {
            h16x8 xv = *(const h16x8*)(PROJ + ((size_t)b * SEQ + ts) * LDP + colbase);
            const float4 w0 = *(const float4*)(convw + jj * 1536 + sec * 512 + h * 128 + ch0);
            const float4 w1 = *(const float4*)(convw + jj * 1536 + sec * 512 + h * 128 + ch0 + 4);
            a[0] += w0.x * (float)xv[0]; a[1] += w0.y * (float)xv[1]; a[2] += w0.z * (float)xv[2]; a[3] += w0.w * (float)xv[3];
            a[4] += w1.x * (float)xv[4]; a[5] += w1.y * (float)xv[5]; a[6] += w1.z * (float)xv[6]; a[7] += w1.w * (float)xv[7];
          }
        }
        float ss = 0.f;
#pragma unroll
        for (int e = 0; e < 8; ++e) { a[e] = siluf_(a[e]); ss += a[e] * a[e]; }
        float scale = 1.f;
        if (sec < 2) {
          ss = sum16(ss);
          scale = rsqrtf(ss + 1e-6f) * (sec == 0 ? 0.08838834764831845f : 1.f);
        }
        h16x8 o;
#pragma unroll
        for (int e = 0; e < 8; ++e) o[e] = (h16)(a[e] * scale);
        h16* dst = (sec == 0 ? QH : (sec == 1 ? KH : VH));
        *(h16x8*)(dst + t * 136 + ch0) = o;
      }
    }
  }
  if (tid < 64) {
    const size_t tok = (size_t)b * SEQ + c * 64 + tid;
    float braw = AB[tok * 8 + h], araw = AB[tok * 8 + 4 + h];
    float beta = 1.f / (1.f + expf(-braw));
    float xx = araw + p.in[I_DTB][h];
    float sp = xx > 20.f ? xx : log1pf(expf(xx));
    float gg = -expf(p.in[I_ALOG][h]) * sp;
#pragma unroll
    for (int o = 1; o < 64; o <<= 1) {
      float v = __shfl_up(gg, o);
      if (lane >= o) gg += v;
    }
    sG[tid] = gg;
    sBeta[tid] = beta;
  }
  __syncthreads();
  {
    h16x8 ak[4], aq[4];
#pragma unroll
    for (int ks = 0; ks < 4; ++ks) {
      ak[ks] = *(const h16x8*)(KH + (w * 16 + fr) * 136 + ks * 32 + fq * 8);
      aq[ks] = *(const h16x8*)(QH + (w * 16 + fr) * 136 + ks * 32 + fq * 8);
    }
#pragma unroll
    for (int jt = 0; jt < 4; ++jt) {
      const int j = jt * 16 + fr;
      const int pj = perm_pos(j);
      if (jt <= w) {
        f32x4 kk = {0.f, 0.f, 0.f, 0.f}, qk = {0.f, 0.f, 0.f, 0.f};
#pragma unroll
        for (int ks = 0; ks < 4; ++ks) {
          h16x8 bk = *(const h16x8*)(KH + (jt * 16 + fr) * 136 + ks * 32 + fq * 8);
          kk = MFMA(ak[ks], bk, kk);
          qk = MFMA(aq[ks], bk, qk);
        }
        const float Gj = sG[j];
        f32x4 lt;
#pragma unroll
        for (int r = 0; r < 4; ++r) {
          const int i = w * 16 + 4 * fq + r;
          const float e = (i >= j) ? expf(sG[i] - Gj) : 0.f;
          lt[r] = (i > j) ? sBeta[i] * kk[r] * e : 0.f;
          ATPi[i * 64 + (((pj >> 3) ^ (i & 7)) << 3) + (pj & 7)] = (h16)(qk[r] * e);
        }
        *(f32x4*)(LT + j * 68 + w * 16 + 4 * fq) = lt;
      } else {
#pragma unroll
        for (int r = 0; r < 4; ++r) {
          const int i = w * 16 + 4 * fq + r;
          ATPi[i * 64 + (((pj >> 3) ^ (i & 7)) << 3) + (pj & 7)] = (h16)0.f;
        }
      }
    }
  }
  __syncthreads();
  float r[64];
  if (tid < 128) {
#pragma unroll
    for (int t = 0; t < 64; ++t) r[t] = (float)VH[t * 136 + tid] * sBeta[t];
  } else {
#pragma unroll
    for (int t = 0; t < 64; ++t) r[t] = (float)KH[t * 136 + (tid - 128)] * sBeta[t] * expf(sG[t]);
  }
#pragma unroll
  for (int j = 0; j < 63; ++j) {
    const float xj = r[j];
#pragma unroll
    for (int i4 = (j + 1) / 4; i4 < 16; ++i4) {
      const f32x4 l = *(const f32x4*)(LT + j * 68 + i4 * 4);
#pragma unroll
      for (int e = 0; e < 4; ++e) {
        if (i4 * 4 + e > j) r[i4 * 4 + e] -= l[e] * xj;
      }
    }
    __builtin_amdgcn_sched_barrier(0);
  }
  if (tid < 128) {
#pragma unroll
    for (int t8 = 0; t8 < 8; ++t8) {
      h16x8 v;
#pragma unroll
      for (int e = 0; e < 8; ++e) v[e] = (h16)r[t8 * 8 + e];
      *(h16x8*)(UTi + (size_t)tid * 64 + t8 * 8) = v;
    }
  }
  __syncthreads();
  if (tid >= 128) {
    const int pos = perm_pos(tid - 128);
#pragma unroll
    for (int t = 0; t < 64; ++t) VH[t * 136 + pos] = (h16)r[t];
  }
  __syncthreads();
  for (int rr = 0; rr < 4; ++rr) {
    const int idx = tid + 256 * rr, row = idx >> 4, seg = idx & 15;
    *(h16x8*)(WPi + row * 128 + ((seg ^ (row & 15)) << 3)) = *(const h16x8*)(VH + row * 136 + seg * 8);
  }
  {
    const int dv = tid & 127, th = tid >> 7;
    const float gdv = p.in[I_DNG][dv];
    const h16* zp = PROJ + ((size_t)b * SEQ + c * 64 + th * 32) * LDP + 2560 + h * 128 + dv;
    h16 zv[32];
#pragma unroll
    for (int t = 0; t < 32; ++t) zv[t] = zp[(size_t)t * LDP];
#pragma unroll
    for (int t8 = 0; t8 < 4; ++t8) {
      h16x8 v;
#pragma unroll
      for (int e = 0; e < 8; ++e) v[e] = (h16)(siluf_((float)zv[t8 * 8 + e]) * gdv);
      *(h16x8*)(ZTi + (size_t)dv * 64 + th * 32 + t8 * 8) = v;
    }
  }
#pragma unroll 2
  for (int rr = 0; rr < 32; ++rr) {
    const int idx = tid + 256 * rr, t = idx >> 7, pp = idx & 127;
    const int dk = perm_inv(pp);
    QGPi[t * 128 + (((pp >> 3) ^ (t & 15)) << 3) + (pp & 7)] = (h16)((float)QH[t * 136 + dk] * expf(sG[t]));
  }
  const float Glast = sG[63];
#pragma unroll 2
  for (int rr = 0; rr < 32; ++rr) {
    const int idx = tid + 256 * rr, dk = idx >> 6, tp = idx & 63;
    const int t = perm_inv(tp);
    KDTi[dk * 64 + (((tp >> 3) ^ (dk & 7)) << 3) + (tp & 7)] = (h16)((float)KH[t * 136 + dk] * expf(Glast - sG[t]));
  }
  if (tid == 0) DL[item] = expf(Glast);
  __syncthreads();
}

template <int NB>
__device__ __forceinline__ void glds_copy(const h16* __restrict__ g, unsigned char* l) {
#pragma unroll
  for (int i = 0; i < NB / 4096; ++i) {
    const int off = threadIdx.x * 16 + i * 4096;
    __builtin_amdgcn_global_load_lds((const unsigned*)((const unsigned char*)g + off), (unsigned*)(l + off), 16, 0, 0);
  }
}
#define RAW_BARRIER() do { asm volatile("s_waitcnt lgkmcnt(0)" ::: "memory"); __builtin_amdgcn_s_barrier(); asm volatile("" ::: "memory"); } while (0)

__device__ void gdn_chain(const Params& p, int bh, unsigned char* smem) {
  const int tid = threadIdx.x, w = tid >> 6, lane = tid & 63, fr = lane & 15, fq = lane >> 4;
  const float* DL = (const float*)(p.ws + OFF_DL);
  const h16* WPb = (const h16*)(p.ws + OFF_WP) + (size_t)bh * 32 * 64 * 128;
  const h16* KDTb = (const h16*)(p.ws + OFF_KDT) + (size_t)bh * 32 * 128 * 64;
  h16* UTb = (h16*)(p.ws + OFF_UT) + (size_t)bh * 32 * 128 * 64;
  h16* SFb = (h16*)((unsigned char*)p.out + OUT_OFF_SF) + (size_t)bh * 32 * 128 * 128;
  f32x4 S[8][2];
#pragma unroll
  for (int i = 0; i < 8; ++i) { S[i][0] = f32x4{0.f, 0.f, 0.f, 0.f}; S[i][1] = f32x4{0.f, 0.f, 0.f, 0.f}; }
  h16x4 uR[4][2];
  glds_copy<16384>(WPb, smem); glds_copy<16384>(KDTb, smem + 16384);
#pragma unroll
  for (int mt = 0; mt < 4; ++mt)
#pragma unroll
    for (int nt = 0; nt < 2; ++nt)
      uR[mt][nt] = *(const h16x4*)(UTb + (size_t)(w * 32 + nt * 16 + fr) * 64 + mt * 16 + fq * 4);
  asm volatile("s_waitcnt vmcnt(0)" ::: "memory");
  RAW_BARRIER();
  for (int c = 0; c < 32; ++c) {
    const int item = bh * 32 + c;
    const float dl = DL[item];
    const int cn = (c + 1 < 32) ? c + 1 : c;
    const unsigned char* LW = smem + (c & 1) * 32768;
    const unsigned char* LK = LW + 16384;
    unsigned char* LWn = smem + ((c + 1) & 1) * 32768;
    h16x8 sfr[4][2];
#pragma unroll
    for (int ks = 0; ks < 4; ++ks) { sfr[ks][0] = pack8(S[2 * ks][0], S[2 * ks + 1][0]); sfr[ks][1] = pack8(S[2 * ks][1], S[2 * ks + 1][1]); }
#pragma unroll
    for (int ks = 0; ks < 4; ++ks)
#pragma unroll
      for (int nt = 0; nt < 2; ++nt)
        *(h16x8*)(SFb + ((size_t)(c * 4 + ks) * 8 + w * 2 + nt) * 512 + lane * 8) = sfr[ks][nt];
    asm volatile("" ::: "memory");
    glds_copy<16384>(WPb + (size_t)cn * 64 * 128, LWn);
    glds_copy<16384>(KDTb + (size_t)cn * 128 * 64, LWn + 16384);
    asm volatile("" ::: "memory");
    f32x4 vn[4][2];
#pragma unroll
    for (int mt = 0; mt < 4; ++mt) { vn[mt][0] = f32x4{0.f, 0.f, 0.f, 0.f}; vn[mt][1] = vn[mt][0]; }
#pragma unroll
    for (int ks = 0; ks < 4; ++ks)
#pragma unroll
      for (int mt = 0; mt < 4; ++mt) {
        h16x8 aw = *(const h16x8*)(LW + (mt * 16 + fr) * 256 + (((ks * 4 + fq) ^ fr) << 4));
        vn[mt][0] = MFMA(aw, sfr[ks][0], vn[mt][0]);
        vn[mt][1] = MFMA(aw, sfr[ks][1], vn[mt][1]);
      }
#pragma unroll
    for (int mt = 0; mt < 4; ++mt)
#pragma unroll
      for (int r = 0; r < 4; ++r) { vn[mt][0][r] = (float)uR[mt][0][r] - vn[mt][0][r]; vn[mt][1][r] = (float)uR[mt][1][r] - vn[mt][1][r]; }
#pragma unroll
    for (int mt = 0; mt < 4; ++mt)
#pragma unroll
      for (int nt = 0; nt < 2; ++nt)
        uR[mt][nt] = *(const h16x4*)(UTb + (size_t)cn * 128 * 64 + (size_t)(w * 32 + nt * 16 + fr) * 64 + mt * 16 + fq * 4);
    asm volatile("" ::: "memory");
    h16x8 vfr[2][2];
#pragma unroll
    for (int k2 = 0; k2 < 2; ++k2) { vfr[k2][0] = pack8(vn[2 * k2][0], vn[2 * k2 + 1][0]); vfr[k2][1] = pack8(vn[2 * k2][1], vn[2 * k2 + 1][1]); }
    if (c + 1 < 32) {
#pragma unroll
      for (int k2 = 0; k2 < 2; ++k2)
#pragma unroll
        for (int nt = 0; nt < 2; ++nt)
          *(h16x8*)(UTb + (size_t)c * 128 * 64 + ((size_t)k2 * 8 + w * 2 + nt) * 512 + lane * 8) = vfr[k2][nt];
    }
#pragma unroll
    for (int dkt = 0; dkt < 8; ++dkt) {
      f32x4 s0 = S[dkt][0], s1 = S[dkt][1];
#pragma unroll
      for (int r = 0; r < 4; ++r) { s0[r] *= dl; s1[r] *= dl; }
#pragma unroll
      for (int k2 = 0; k2 < 2; ++k2) {
        h16x8 ak = *(const h16x8*)(LK + (dkt * 16 + fr) * 128 + (((k2 * 4 + fq) ^ (fr & 7)) << 4));
        s0 = MFMA(ak, vfr[k2][0], s0);
        s1 = MFMA(ak, vfr[k2][1], s1);
      }
      S[dkt][0] = s0; S[dkt][1] = s1;
    }
    asm volatile("s_waitcnt vmcnt(0)" ::: "memory");
    RAW_BARRIER();
    if (c + 1 == 32) {
#pragma unroll
      for (int k2 = 0; k2 < 2; ++k2)
#pragma unroll
        for (int nt = 0; nt < 2; ++nt)
          *(h16x8*)(UTb + (size_t)c * 128 * 64 + ((size_t)k2 * 8 + w * 2 + nt) * 512 + lane * 8) = vfr[k2][nt];
    }
  }
  asm volatile("s_waitcnt vmcnt(0)" ::: "memory");
  __syncthreads();
}

__device__ void gdn_out_item(const Params& p, int item, unsigned char* smem) {
  unsigned char* LQ = smem;
  unsigned char* LA = smem + 16384;
  float* red = (float*)(smem + 24576);
  const int tid = threadIdx.x, w = tid >> 6, lane = tid & 63, fr = lane & 15, fq = lane >> 4;
  const int c = item & 31, h = (item >> 5) & 3, b = item >> 7;
  h16* MIXIN = (h16*)(p.ws + OFF_MIXIN);
  const h16* QGPi = (const h16*)(p.ws + OFF_QGP) + (size_t)item * 64 * 128;
  const h16* ATPi = (const h16*)(p.ws + OFF_ATP) + (size_t)item * 64 * 64;
  const h16* VFi = (const h16*)(p.ws + OFF_UT) + (size_t)item * 128 * 64;
  const h16* SFi = (const h16*)((unsigned char*)p.out + OUT_OFF_SF) + (size_t)item * 128 * 128;
  const h16* ZTi = (const h16*)((unsigned char*)p.out + OUT_OFF_ZT) + (size_t)item * 128 * 64;
  glds_copy<16384>(QGPi, LQ); glds_copy<8192>(ATPi, LA);
  h16x8 sfr[4][2], vfr[2][2];
#pragma unroll
  for (int ks = 0; ks < 4; ++ks)
#pragma unroll
    for (int nt = 0; nt < 2; ++nt) sfr[ks][nt] = *(const h16x8*)(SFi + ((size_t)ks * 8 + w * 2 + nt) * 512 + lane * 8);
#pragma unroll
  for (int k2 = 0; k2 < 2; ++k2)
#pragma unroll
    for (int nt = 0; nt < 2; ++nt) vfr[k2][nt] = *(const h16x8*)(VFi + ((size_t)k2 * 8 + w * 2 + nt) * 512 + lane * 8);
  h16x4 zR[4][2];
#pragma unroll
  for (int mt = 0; mt < 4; ++mt)
#pragma unroll
    for (int nt = 0; nt < 2; ++nt) zR[mt][nt] = *(const h16x4*)(ZTi + (size_t)(w * 32 + nt * 16 + fr) * 64 + mt * 16 + fq * 4);
  asm volatile("s_waitcnt vmcnt(0)" ::: "memory");
  __syncthreads();
  f32x4 o[4][2];
#pragma unroll
  for (int mt = 0; mt < 4; ++mt) {
    f32x4 o0 = {0.f, 0.f, 0.f, 0.f}, o1 = {0.f, 0.f, 0.f, 0.f};
#pragma unroll
    for (int ks = 0; ks < 4; ++ks) {
      h16x8 aq = *(const h16x8*)(LQ + (mt * 16 + fr) * 256 + (((ks * 4 + fq) ^ fr) << 4));
      o0 = MFMA(aq, sfr[ks][0], o0);
      o1 = MFMA(aq, sfr[ks][1], o1);
    }
#pragma unroll
    for (int k2 = 0; k2 < 2; ++k2) {
      h16x8 aa = *(const h16x8*)(LA + (mt * 16 + fr) * 128 + (((k2 * 4 + fq) ^ (fr & 7)) << 4));
      o0 = MFMA(aa, vfr[k2][0], o0);
      o1 = MFMA(aa, vfr[k2][1], o1);
    }
    o[mt][0] = o0; o[mt][1] = o1;
  }
#pragma unroll
  for (int mt = 0; mt < 4; ++mt)
#pragma unroll
    for (int r = 0; r < 4; ++r) {
      float s = o[mt][0][r] * o[mt][0][r] + o[mt][1][r] * o[mt][1][r];
      s = sum16(s);
      if (fr == 0) red[w * 64 + mt * 16 + 4 * fq + r] = s;
    }
  __syncthreads();
#pragma unroll
  for (int mt = 0; mt < 4; ++mt)
#pragma unroll
    for (int r = 0; r < 4; ++r) {
      const int tl = mt * 16 + 4 * fq + r;
      const float tot = red[tl] + red[64 + tl] + red[128 + tl] + red[192 + tl];
      const float rstd = rsqrtf(tot * (1.f / 128.f) + 1e-6f);
      const size_t tok = (size_t)b * SEQ + c * 64 + tl;
      h16* yp = MIXIN + tok * 1024 + 512 + h * 128 + w * 32 + fr;
      yp[0] = (h16)(o[mt][0][r] * rstd * (float)zR[mt][0][r]);
      yp[16] = (h16)(o[mt][1][r] * rstd * (float)zR[mt][1][r]);
    }
  __syncthreads();
}

#define XB_TMO      128
#define XB_XCNT(j)  (256  + 64 * (j))
#define XB_XSUB(j)  (1280 + 64 * (j))
#define XB_XGEN(j)  (2304 + 64 * (j))
#define XB_TOP      3328
#define XB_TOPGEN   3392
#define XCD_BAR_WORDS 3456
#define XB_SPIN_CAP (1u << 18)
#define LAS __attribute__((address_space(3)))

__device__ __forceinline__ unsigned xb_ld(unsigned* p)              { return __hip_atomic_load(p, __ATOMIC_RELAXED, __HIP_MEMORY_SCOPE_AGENT); }
__device__ __forceinline__ unsigned xb_add(unsigned* p, unsigned v) { return __hip_atomic_fetch_add(p, v, __ATOMIC_RELAXED, __HIP_MEMORY_SCOPE_AGENT); }
__device__ __forceinline__ unsigned xb_xcc_id() { return (unsigned)__builtin_amdgcn_s_getreg((3 << 11) | 20) & 0xFu; }
#define XB_SPIN(cond, bar) do { unsigned _sp = 0; while (cond) { __builtin_amdgcn_s_sleep(1); \
    if ((++_sp & 255u) == 0u) { if (xb_ld(&(bar)[XB_TMO])) break; if (_sp > XB_SPIN_CAP) { atomicAdd(&(bar)[XB_TMO], 1u); break; } } } } while (0)

struct XcdBarrier {
    unsigned* bar; unsigned x;
    volatile LAS unsigned* st;
};

__device__ __forceinline__ XcdBarrier xcd_barrier_post(unsigned* bar, volatile LAS unsigned* st) {
    XcdBarrier b; b.bar = bar; b.x = xb_xcc_id(); b.st = st;
    if (threadIdx.x == 0) (void)xb_add(&bar[XB_XCNT(b.x)], 1u);
    return b;
}
__device__ __forceinline__ void xcd_barrier_complete(unsigned* bar, unsigned x, unsigned& nloc, unsigned& nx) {
    const unsigned G = gridDim.x * gridDim.y * gridDim.z;
    unsigned sum, cnt, mine, sp = 0u;
    for (;;) {
        sum = 0u; cnt = 0u; mine = 0u;
#pragma unroll
        for (unsigned j = 0; j < 16; ++j) { const unsigned c = xb_ld(&bar[XB_XCNT(j)]); sum += c; cnt += (c > 0u) ? 1u : 0u; mine = (j == x) ? c : mine; }
        if (sum == G) break;
        __builtin_amdgcn_s_sleep(1);
        if ((++sp & 255u) == 0u) { if (xb_ld(&bar[XB_TMO])) break; if (sp > XB_SPIN_CAP) { atomicAdd(&bar[XB_TMO], 1u); break; } }
    }
    nloc = mine > 0u ? mine : 1u; nx = cnt > 0u ? cnt : 1u;
}

__device__ __forceinline__ void xcd_barrier(const XcdBarrier& b) {
    asm volatile("s_waitcnt vmcnt(0)" ::: "memory");
    __syncthreads();
    if (threadIdx.x == 0) {
        unsigned* bar = b.bar;
        __builtin_amdgcn_s_waitcnt(0);
        unsigned nloc = b.st[0], nx = b.st[1];
        if (nloc == 0u) { xcd_barrier_complete(bar, b.x, nloc, nx); b.st[0] = nloc; b.st[1] = nx; }
        const unsigned old = xb_add(&bar[XB_XSUB(b.x)], 1u);
        const unsigned gen = old / nloc;
        if (old + 1u == (gen + 1u) * nloc) {
            __builtin_amdgcn_fence(__ATOMIC_RELEASE, "agent");
            asm volatile("s_waitcnt vmcnt(0)" ::: "memory");
            const unsigned og = xb_add(&bar[XB_TOP], 1u);
            const unsigned tg = og / nx;
            if (og + 1u == (tg + 1u) * nx) xb_add(&bar[XB_TOPGEN], 1u);
            else XB_SPIN(xb_ld(&bar[XB_TOPGEN]) == tg, bar);
            __builtin_amdgcn_fence(__ATOMIC_ACQUIRE, "agent");
            xb_add(&bar[XB_XGEN(b.x)], 1u);
            asm volatile("s_waitcnt vmcnt(0)" ::: "memory");
        } else {
            XB_SPIN(xb_ld(&bar[XB_XGEN(b.x)]) == gen, bar);
            __builtin_amdgcn_fence(__ATOMIC_ACQUIRE, "agent");
            asm volatile("s_waitcnt vmcnt(0)" ::: "memory");
        }
    }
    __syncthreads();
}

#ifndef ONLY_PH
#define ONLY_PH -1
#endif
#define RUNPH(n) ((ONLY_PH < 0 || ONLY_PH == (n)) && p.ph_lo <= (n) && (n) <= p.ph_hi)
#define SYNCPH(n) do { if (p.ph_lo <= (n) && (n) < p.ph_hi) xcd_barrier(xb); } while (0)
__global__ void __launch_bounds__(256, 2) hymba_mega(Params p) {
  __shared__ __attribute__((aligned(16))) unsigned char smem[SMEM_BYTES];
  cg::grid_group grid = cg::this_grid();
  const int bid = blockIdx.x, nb = gridDim.x;
  if (p.ph_lo < 0) grid.sync();
  XcdBarrier xb;
  {
    volatile LAS unsigned* st = (volatile LAS unsigned*)(smem + SMEM_BYTES - 16);
    if (threadIdx.x == 0) { st[0] = 0u; st[1] = 0u; st[2] = 0u; st[3] = 0u; }
    __syncthreads();
    if (p.ph_lo < p.ph_hi) xb = xcd_barrier_post((unsigned*)(p.ws + OFF_BAR), st);
    else { xb.bar = (unsigned*)(p.ws + OFF_BAR); xb.x = 0; xb.st = st; }
  }
  {
    if (RUNPH(0)) for (int rep = 0; rep < REP0; ++rep) {
      if (rep) grid.sync();
      phase0(p, smem);
    }
    SYNCPH(0);
    if (RUNPH(1)) for (int rep = 0; rep < REP1; ++rep) {
      if (rep) grid.sync();
      const h16* A0 = (const h16*)((unsigned char*)p.out + OUT_OFF_A0);
      const h16* W = (const h16*)(p.ws + OFF_WIN);
      for (int t = bid; t < 256 * 25; t += nb) gemm_tile<EPI_PROJ>(p, A0, 1024, W, 1024, 1024, (t / 25) * 128, (t % 25) * 128, smem);
    }
    SYNCPH(1);
    if (RUNPH(2)) for (int rep = 0; rep < REP2; ++rep) {
      if (rep) grid.sync();
      for (int it = bid; it < 512 + 2048; it += nb) {
        if (it < 2048) gdn_pre_item(p, it, smem);
        else ssm_item(p, (it - 2048) >> 5, (it - 2048) & 31, smem);
      }
    }
    SYNCPH(2);
    if (RUNPH(3)) {
      if (bid < 64) gdn_chain(p, bid, smem);
      unsigned* ctr = (unsigned*)(p.ws + OFF_CTR);
      volatile int* bc = (volatile int*)(smem + SMEM_BYTES - 4);
      const h16* YPRE = (const h16*)((unsigned char*)p.out + OUT_OFF_YPRE);
      for (;;) {
        __syncthreads();
        if (threadIdx.x == 0) *bc = (int)atomicAdd(ctr, 1u);
        __syncthreads();
        const int t = *bc;
        if (t >= 1024 + 2048) break;
        if (t < 1024) gemm_tile<EPI_GLU>(p, YPRE, 512, (const h16*)(p.ws + OFF_WGLU), 512, 512, (t >> 2) * 128, (t & 3) * 128, smem);
        else gemm_tile<EPI_PLE>(p, (const h16*)(p.ws + OFF_PB), 256, (const h16*)(p.ws + OFF_WPP), 256, 256, ((t - 1024) >> 3) * 128, ((t - 1024) & 7) * 128, smem);
      }
    }
    SYNCPH(3);
    if (RUNPH(4)) {
      for (int it = bid; it < 2048; it += nb) gdn_out_item(p, it, smem);
    }
    SYNCPH(4);
    if (RUNPH(5)) {
      for (int t = bid; t < 2048; t += nb)
        gemm_tile<EPI_OUT>(p, (const h16*)(p.ws + OFF_MIXIN), 1024, (const h16*)(p.ws + OFF_WOUT), 1024, 1024, (t >> 3) * 128, (t & 7) * 128, smem);
    }
    SYNCPH(5);
    if (RUNPH(6)) {
      for (int t = bid; t < 2048; t += nb)
        gemm_tile<EPI_GATE>(p, (const h16*)(p.ws + OFF_PROJ), 1024, (const h16*)(p.ws + OFF_WGATE), 1024, 1024, (t >> 3) * 128, (t & 7) * 128, smem);
    }
    SYNCPH(6);
    if (RUNPH(7)) {
      const int wid = threadIdx.x >> 6, lane = threadIdx.x & 63;
      const float* OPART = (const float*)(p.ws + OFF_OPART);
      const float4* g4 = (const float4*)p.in[I_FING];
      for (int row = bid * 4 + wid; row < T_TOK; row += nb * 4) {
        float s = (lane < 8) ? OPART[(size_t)row * 8 + lane] : 0.f;
        s = wave_sum(s);
        const float rstd = rsqrtf(s * (1.f / 1024.f) + 1e-6f);
        float4* orow = (float4*)(p.out + (size_t)row * 1024);
#pragma unroll
        for (int i = 0; i < 4; ++i) {
          float4 v = orow[lane + i * 64];
          float4 g = g4[lane + i * 64];
          v.x *= rstd * g.x; v.y *= rstd * g.y; v.z *= rstd * g.z; v.w *= rstd * g.w;
          orow[lane + i * 64] = v;
        }
      }
    }
  }
}

extern "C" void kernel_launch(void* const* d_in, const int* in_sizes, int n_in, void* d_out, int out_size, void* d_ws, size_t ws_size,
                              hipStream_t stream) {
  static int grid_blocks = 0;
  if (!grid_blocks) {
    int dev = 0, cus = 0, per_cu = 0;
    hipGetDevice(&dev);
    hipDeviceGetAttribute(&cus, hipDeviceAttributeMultiprocessorCount, dev);
    hipOccupancyMaxActiveBlocksPerMultiprocessor(&per_cu, hymba_mega, 256, 0);
    if (per_cu > 2) per_cu = 2;
    if (per_cu < 1) per_cu = 1;
    grid_blocks = cus * per_cu;
  }
  if (n_in != 23 || ws_size < WS_END || out_size != T_TOK * 1024) {
    fprintf(stderr, "kernel_launch: unexpected sizes n_in=%d ws=%zu (need %zu) out=%d\n", n_in, ws_size, (size_t)WS_END, out_size);
    return;
  }
  Params p{};
  for (int i = 0; i < 23; ++i) p.in[i] = (const float*)d_in[i];
  p.out = (float*)d_out;
  p.ws = (unsigned char*)d_ws;
  if (hipMemsetAsync((unsigned char*)d_ws + OFF_BAR, 0, 16384, stream) != hipSuccess) { fprintf(stderr, "kernel_launch: memset of control words failed\n"); return; }
#if MULTI_LAUNCH
  for (int ph = 0; ph < NPH; ++ph) {
    p.ph_lo = ph; p.ph_hi = ph;
    hipLaunchKernelGGL(hymba_mega, dim3(grid_blocks), dim3(256), 0, stream, p);
  }
#else
  p.ph_lo = 0; p.ph_hi = NPH - 1;
  void* args[] = {&p};
  hipError_t e = hipLaunchCooperativeKernel((void*)hymba_mega, dim3(grid_blocks), dim3(256), args, 0, stream);
  if (e != hipSuccess) fprintf(stderr, "cooperative launch failed: %s (grid %d)\n", hipGetErrorString(e), grid_blocks);
#endif
}
```

```cpp
#include <hip/hip_runtime.h>
#include <hip/hip_cooperative_groups.h>
#include <cstdio>
namespace cg = cooperative_groups;

#ifndef REP0
#define REP0 1
#endif
#ifndef REP1
#define REP1 1
#endif
#ifndef REP2
#define REP2 1
#endif
#ifndef REP3
#define REP3 1
#endif
#ifndef REP4
#define REP4 1
#endif
#ifndef MULTI_LAUNCH
#define MULTI_LAUNCH 0
#endif

typedef _Float16 h16;
typedef __attribute__((ext_vector_type(8))) _Float16 h16x8;
typedef __attribute__((ext_vector_type(4))) _Float16 h16x4;
typedef __attribute__((ext_vector_type(4))) float f32x4;

#define MFMA(a, b, c) __builtin_amdgcn_mfma_f32_16x16x32_f16((a), (b), (c), 0, 0, 0)

constexpr int T_TOK = 32768;
constexpr int SEQ = 2048;
constexpr int NPH = 8;
constexpr int LDP = 3072;
constexpr int SMEM_BYTES = 70400;

constexpr size_t SZ_WIN = (size_t)3200 * 1024 * 2;
constexpr size_t SZ_WGLU = (size_t)512 * 512 * 2;
constexpr size_t SZ_WOUT = (size_t)1024 * 1024 * 2;
constexpr size_t SZ_WPP = (size_t)1024 * 256 * 2;
constexpr size_t SZ_WGATE = (size_t)1024 * 1024 * 2;
constexpr size_t OFF_WIN = 0;
constexpr size_t OFF_WGLU = OFF_WIN + SZ_WIN;
constexpr size_t OFF_WOUT = OFF_WGLU + SZ_WGLU;
constexpr size_t OFF_WPP = OFF_WOUT + SZ_WOUT;
constexpr size_t OFF_WGATE = OFF_WPP + SZ_WPP;
constexpr size_t OFF_PB = OFF_WGATE + SZ_WGATE;
constexpr size_t OFF_PROJ = OFF_PB + (size_t)T_TOK * 256 * 2;
constexpr size_t OFF_AB = OFF_PROJ + (size_t)T_TOK * LDP * 2;
constexpr size_t OFF_KTAB = OFF_AB + (size_t)T_TOK * 8 * 4;
constexpr size_t OFF_ETAB = OFF_KTAB + (size_t)32 * 33 * 256 * 2;
constexpr size_t OFF_FTAB = OFF_ETAB + (size_t)32 * 128 * 512 * 2;
constexpr size_t OFF_ALPOW = OFF_FTAB + (size_t)32 * 512 * 128 * 2;
constexpr size_t OFF_DL = OFF_ALPOW + (size_t)32 * 64 * 2 * 4;
constexpr size_t OFF_EPART = OFF_DL + (size_t)2048 * 4;
constexpr size_t OFF_OPART = OFF_EPART + (size_t)T_TOK * 16 * 4;
constexpr size_t OFF_MIXIN = OFF_OPART + (size_t)T_TOK * 16 * 4;
constexpr size_t OFF_WP = OFF_MIXIN + (size_t)T_TOK * 1024 * 2;
constexpr size_t OFF_QGP = OFF_WP + (size_t)2048 * 64 * 128 * 2;
constexpr size_t OFF_KDT = OFF_QGP + (size_t)2048 * 64 * 128 * 2;
constexpr size_t OFF_UT = OFF_KDT + (size_t)2048 * 128 * 64 * 2;
constexpr size_t OFF_ATP = OFF_UT + (size_t)2048 * 128 * 64 * 2;
constexpr size_t OFF_EH = OFF_ATP + (size_t)2048 * 64 * 64 * 2;
constexpr size_t OFF_BAR = OFF_EH + (size_t)T_TOK * 1024 * 2;
constexpr size_t WS_END = OFF_BAR + 16384;
constexpr size_t OFF_CTR = OFF_BAR + 15360;
constexpr size_t OUT_OFF_A0 = 0;
constexpr size_t OUT_OFF_SF = 0;
constexpr size_t OUT_OFF_YPRE = (size_t)T_TOK * 1024 * 2;
constexpr size_t OUT_OFF_ZT = OUT_OFF_YPRE + (size_t)T_TOK * 512 * 2;

struct Params {
  const float* in[23];
  float* out;
  unsigned char* ws;
  int ph_lo, ph_hi;
};

enum { I_X = 0, I_P, I_NMG, I_WIN, I_ARE, I_AIM, I_BRE, I_BIM, I_CRE, I_CIM, I_D, I_LOGDT, I_WGLU, I_BGLU,
       I_CONVW, I_ALOG, I_DTB, I_DNG, I_WOUT, I_WPP, I_PLEG, I_WGATE, I_FING };

__device__ __forceinline__ float wave_sum(float v) {
#pragma unroll
  for (int o = 32; o > 0; o >>= 1) v += __shfl_xor(v, o);
  return v;
}
__device__ __forceinline__ float sum16(float v) {
  v += __shfl_xor(v, 1); v += __shfl_xor(v, 2); v += __shfl_xor(v, 4); v += __shfl_xor(v, 8);
  return v;
}
__device__ __forceinline__ float sigmoidf_(float x) { return 1.f / (1.f + __expf(-x)); }
__device__ __forceinline__ float siluf_(float x) { return x / (1.f + __expf(-x)); }
__device__ __forceinline__ float gelu_tanh(float y) {
  float z = 0.7978845608028654f * (y + 0.044715f * y * y * y);
  return 0.5f * y * (1.f + tanhf(z));
}
__device__ __forceinline__ h16x8 pack8(f32x4 lo, f32x4 hi) {
  h16x8 r;
  r[0] = (h16)lo[0]; r[1] = (h16)lo[1]; r[2] = (h16)lo[2]; r[3] = (h16)lo[3];
  r[4] = (h16)hi[0]; r[5] = (h16)hi[1]; r[6] = (h16)hi[2]; r[7] = (h16)hi[3];
  return r;
}
__device__ __forceinline__ int perm_pos(int n) { return (n & ~31) + (((n & 15) >> 2) << 3) + (((n >> 4) & 1) << 2) + (n & 3); }
__device__ __forceinline__ int perm_inv(int pos) {
  int q5 = pos & 31, qq = q5 >> 3, jj = q5 & 7;
  return (pos & ~31) + (jj < 4 ? 4 * qq + jj : 16 + 4 * qq + (jj - 4));
}

__device__ void transpose_w(const float* __restrict__ W, int K, int N, int Npad, h16* __restrict__ WT, int t, float* tile) {
  const int ntn = Npad / 64;
  const int kt = t / ntn, nt = t % ntn, k0 = kt * 64, n0 = nt * 64;
  const int tx = threadIdx.x & 63, ty = threadIdx.x >> 6;
  for (int r = 0; r < 16; ++r) {
    int k = ty * 16 + r, n = n0 + tx;
    tile[k * 65 + tx] = (n < N) ? W[(size_t)(k0 + k) * N + n] : 0.f;
  }
  __syncthreads();
  for (int r = 0; r < 16; ++r) {
    int n = ty * 16 + r;
    WT[(size_t)(n0 + n) * K + k0 + tx] = (h16)tile[tx * 65 + n];
  }
  __syncthreads();
}

__device__ void ssm_table_item(const Params& p, int g, int d, float* lds) {
  float2* sAp = (float2*)lds;
  float2* sW = sAp + 64;
  const int tid = threadIdx.x;
  h16* KTAB = (h16*)(p.ws + OFF_KTAB);
  h16* ETAB = (h16*)(p.ws + OFF_ETAB);
  h16* FTAB = (h16*)(p.ws + OFF_FTAB);
  float* ALPOW = (float*)(p.ws + OFF_ALPOW);
  float* sBr = lds + 256; float* sBi = sBr + 1024; float* sCr = sBi + 1024; float* sCi = sCr + 16 * 65;
  {
    const float4 vbr = ((const float4*)(p.in[I_BRE] + g * 1024))[tid], vbi = ((const float4*)(p.in[I_BIM] + g * 1024))[tid];
    const float4 vcr = ((const float4*)(p.in[I_CRE] + g * 1024))[tid], vci = ((const float4*)(p.in[I_CIM] + g * 1024))[tid];
    *(float4*)(sBr + tid * 4) = vbr; *(float4*)(sBi + tid * 4) = vbi;
    const int ch = (tid * 4) >> 6, cp = (tid * 4) & 63;
    sCr[ch * 65 + cp] = vcr.x; sCr[ch * 65 + cp + 1] = vcr.y; sCr[ch * 65 + cp + 2] = vcr.z; sCr[ch * 65 + cp + 3] = vcr.w;
    sCi[ch * 65 + cp] = vci.x; sCi[ch * 65 + cp + 1] = vci.y; sCi[ch * 65 + cp + 2] = vci.z; sCi[ch * 65 + cp + 3] = vci.w;
  }
  if (tid < 64) {
    const int pp = tid;
    float lr = p.in[I_ARE][g * 64 + pp], li = p.in[I_AIM][g * 64 + pp], dt = expf(p.in[I_LOGDT][g]);
    float mag = expf(lr * dt), ang = li * dt;
    float abr = mag * cosf(ang), abi = mag * sinf(ang);
    float nr = abr - 1.f, ni = abi, den = lr * lr + li * li;
    float cr = (nr * lr + ni * li) / den, ci = (ni * lr - nr * li) / den;
    float apr = 1.f, api = 0.f;
    for (int k = 0; k < d; ++k) { float t0 = apr * abr - api * abi; api = apr * abi + api * abr; apr = t0; }
    sAp[pp] = make_float2(apr, api);
    sW[pp] = make_float2(apr * cr - api * ci, apr * ci + api * cr);
    if (d == 32) { ALPOW[(g * 64 + pp) * 2] = apr; ALPOW[(g * 64 + pp) * 2 + 1] = api; }
  }
  __syncthreads();
  if (d < 32) {
    {
      const int h = tid >> 4, hp = tid & 15;
      float acc = 0.f;
#pragma unroll 8
      for (int pp = 0; pp < 64; ++pp) {
        float2 W = sW[pp];
        float br = sBr[pp * 16 + hp], bi = sBi[pp * 16 + hp];
        float wbr = W.x * br - W.y * bi, wbi = W.x * bi + W.y * br;
        float cr = sCr[h * 65 + pp], ci = sCi[h * 65 + pp];
        acc += cr * wbr - ci * wbi;
      }
      KTAB[(size_t)(g * 33 + d + 1) * 256 + h * 16 + hp] = (h16)acc;
      if (d == 0) KTAB[(size_t)(g * 33) * 256 + tid] = (h16)0.f;
    }
    {
      const int i = 31 - d;
#pragma unroll
      for (int r = 0; r < 4; ++r) {
        int idx = tid + 256 * r, pp = idx >> 4, hp = idx & 15;
        float2 W = sW[pp];
        float br = sBr[pp * 16 + hp], bi = sBi[pp * 16 + hp];
        float wbr = W.x * br - W.y * bi, wbi = W.x * bi + W.y * br;
        ETAB[((size_t)g * 128 + pp) * 512 + i * 16 + hp] = (h16)wbr;
        ETAB[((size_t)g * 128 + 64 + pp) * 512 + i * 16 + hp] = (h16)wbi;
      }
    }
  }
  if (d >= 1) {
    const int j = d - 1;
#pragma unroll
    for (int r = 0; r < 4; ++r) {
      int idx = tid + 256 * r, h = idx >> 6, pp = idx & 63;
      float2 Ap = sAp[pp];
      float cr = sCr[h * 65 + pp], ci = sCi[h * 65 + pp];
      float re = cr * Ap.x - ci * Ap.y, im = cr * Ap.y + ci * Ap.x;
      FTAB[((size_t)g * 512 + j * 16 + h) * 128 + pp] = (h16)re;
      FTAB[((size_t)g * 512 + j * 16 + h) * 128 + 64 + pp] = (h16)(-im);
    }
  }
  __syncthreads();
}

__device__ void phase0(const Params& p, unsigned char* smem) {
  const int bid = blockIdx.x, nb = gridDim.x, tid = threadIdx.x, wid = tid >> 6, lane = tid & 63;
  float* tile = (float*)smem;
  for (int t = bid; t < 1440; t += nb) {
    if (t < 800) transpose_w(p.in[I_WIN], 1024, 3080, 3200, (h16*)(p.ws + OFF_WIN), t, tile);
    else if (t < 864) transpose_w(p.in[I_WGLU], 512, 512, 512, (h16*)(p.ws + OFF_WGLU), t - 800, tile);
    else if (t < 1120) transpose_w(p.in[I_WOUT], 1024, 1024, 1024, (h16*)(p.ws + OFF_WOUT), t - 864, tile);
    else if (t < 1184) transpose_w(p.in[I_WPP], 256, 1024, 1024, (h16*)(p.ws + OFF_WPP), t - 1120, tile);
    else transpose_w(p.in[I_WGATE], 1024, 1024, 1024, (h16*)(p.ws + OFF_WGATE), t - 1184, tile);
  }
  for (int it = bid; it < 32 * 33; it += nb) ssm_table_item(p, it / 33, it % 33, (float*)smem);
  {
    h16* A0 = (h16*)((unsigned char*)p.out + OUT_OFF_A0);
    const float* x = p.in[I_X];
    const float4* g4 = (const float4*)p.in[I_NMG];
    for (int row = bid * 4 + wid; row < T_TOK; row += nb * 4) {
      const float4* xr = (const float4*)(x + (size_t)row * 1024);
      float4 v[4];
      float ss = 0.f;
#pragma unroll
      for (int i = 0; i < 4; ++i) {
        v[i] = xr[lane + i * 64];
        ss += v[i].x * v[i].x + v[i].y * v[i].y + v[i].z * v[i].z + v[i].w * v[i].w;
      }
      ss = wave_sum(ss);
      float rstd = rsqrtf(ss * (1.f / 1024.f) + 1e-6f);
#pragma unroll
      for (int i = 0; i < 4; ++i) {
        float4 g = g4[lane + i * 64];
        h16x4 o;
        o[0] = (h16)(v[i].x * rstd * g.x); o[1] = (h16)(v[i].y * rstd * g.y);
        o[2] = (h16)(v[i].z * rstd * g.z); o[3] = (h16)(v[i].w * rstd * g.w);
        *(h16x4*)(A0 + (size_t)row * 1024 + (lane + i * 64) * 4) = o;
      }
    }
  }
  {
    h16* PB = (h16*)(p.ws + OFF_PB);
    const float4* p4 = (const float4*)p.in[I_P];
    const size_t n4 = (size_t)T_TOK * 256 / 4;
    for (size_t i = (size_t)bid * 256 + tid; i < n4; i += (size_t)nb * 256) {
      float4 v = p4[i];
      h16x4 o;
      o[0] = (h16)v.x; o[1] = (h16)v.y; o[2] = (h16)v.z; o[3] = (h16)v.w;
      *(h16x4*)(PB + i * 4) = o;
    }
  }
}

enum { EPI_PROJ = 0, EPI_GLU, EPI_PLE, EPI_OUT, EPI_GATE };

template <int EPI>
__device__ __forceinline__ void gemm_tile(const Params& p, const h16* __restrict__ A, int lda, const h16* __restrict__ Bt, int ldb,
                                          int K, int brow, int bcol, unsigned char* smem) {
  const int tid = threadIdx.x, wid = tid >> 6, lane = tid & 63, wr = wid >> 1, wc = wid & 1, fr = lane & 15, fq = lane >> 4;
  f32x4 acc[4][4];
#pragma unroll
  for (int m = 0; m < 4; ++m)
#pragma unroll
    for (int n = 0; n < 4; ++n) acc[m][n] = f32x4{0.f, 0.f, 0.f, 0.f};
  const int nk = K / 64;
  const h16* ga[4]; const h16* gb[4];
#pragma unroll
  for (int i = 0; i < 4; ++i) {
    const int L = tid + 256 * i, row = L >> 3, cs = (L & 7) ^ (row & 7);
    ga[i] = A + (size_t)(brow + row) * lda + cs * 8;
    gb[i] = Bt + (size_t)(bcol + row) * ldb + cs * 8;
  }
#define GEMM_STAGE(t_, buf_) do { \
    unsigned char* sa_ = smem + (buf_) * 32768 + tid * 16; \
    _Pragma("unroll") for (int i_ = 0; i_ < 4; ++i_) { \
      __builtin_amdgcn_global_load_lds((const unsigned*)(ga[i_] + (t_) * 64), (unsigned*)(sa_ + i_ * 4096), 16, 0, 0); \
      __builtin_amdgcn_global_load_lds((const unsigned*)(gb[i_] + (t_) * 64), (unsigned*)(sa_ + 16384 + i_ * 4096), 16, 0, 0); \
    } \
  } while (0)
  GEMM_STAGE(0, 0);
  for (int t = 0; t < nk; ++t) {
    asm volatile("s_waitcnt vmcnt(0)" ::: "memory");
    __syncthreads();
    if (t + 1 < nk) GEMM_STAGE(t + 1, (t + 1) & 1);
    const unsigned char* SA = smem + (t & 1) * 32768;
    const unsigned char* SB = SA + 16384;
#pragma unroll
    for (int kk = 0; kk < 2; ++kk) {
      h16x8 af[4], bf[4];
      const int pos = ((kk * 4 + fq) ^ (fr & 7)) << 4;
#pragma unroll
      for (int m = 0; m < 4; ++m) {
        af[m] = *(const h16x8*)(SA + (wr * 64 + m * 16 + fr) * 128 + pos);
        bf[m] = *(const h16x8*)(SB + (wc * 64 + m * 16 + fr) * 128 + pos);
      }
#pragma unroll
      for (int m = 0; m < 4; ++m)
#pragma unroll
        for (int n = 0; n < 4; ++n) acc[m][n] = MFMA(af[m], bf[n], acc[m][n]);
    }
  }
#undef GEMM_STAGE
  __syncthreads();
  float* CT = (float*)smem;
#pragma unroll
  for (int m = 0; m < 4; ++m)
#pragma unroll
    for (int n = 0; n < 4; ++n)
#pragma unroll
      for (int j = 0; j < 4; ++j) CT[(wr * 64 + m * 16 + fq * 4 + j) * 132 + wc * 64 + n * 16 + fr] = acc[m][n][j];
  __syncthreads();
  const int c4 = tid & 31;
#pragma unroll 2
  for (int it = 0; it < 16; ++it) {
    const int rl = it * 8 + (tid >> 5);
    const size_t row = (size_t)brow + rl;
    const int col = bcol + c4 * 4;
    const float4 v = *(const float4*)(CT + rl * 132 + c4 * 4);
    if constexpr (EPI == EPI_PROJ) {
      if (bcol < 3072) {
        h16x4 o; o[0] = (h16)v.x; o[1] = (h16)v.y; o[2] = (h16)v.z; o[3] = (h16)v.w;
        *(h16x4*)((h16*)(p.ws + OFF_PROJ) + row * LDP + col) = o;
      } else if (c4 < 2) {
        *(float4*)((float*)(p.ws + OFF_AB) + row * 8 + c4 * 4) = v;
      }
    } else if constexpr (EPI == EPI_GLU) {
      const h16x4 y = *(const h16x4*)((const h16*)((unsigned char*)p.out + OUT_OFF_YPRE) + row * 512 + col);
      const h16x4 z = *(const h16x4*)((const h16*)(p.ws + OFF_PROJ) + row * LDP + 512 + col);
      const float4 bb = *(const float4*)(p.in[I_BGLU] + col);
      h16x4 o;
      o[0] = (h16)((float)y[0] * sigmoidf_(v.x + bb.x) * siluf_((float)z[0]));
      o[1] = (h16)((float)y[1] * sigmoidf_(v.y + bb.y) * siluf_((float)z[1]));
      o[2] = (h16)((float)y[2] * sigmoidf_(v.z + bb.z) * siluf_((float)z[2]));
      o[3] = (h16)((float)y[3] * sigmoidf_(v.w + bb.w) * siluf_((float)z[3]));
      *(h16x4*)((h16*)(p.ws + OFF_MIXIN) + row * 1024 + col) = o;
    } else if constexpr (EPI == EPI_PLE) {
      h16x4 o; o[0] = (h16)v.x; o[1] = (h16)v.y; o[2] = (h16)v.z; o[3] = (h16)v.w;
      *(h16x4*)((h16*)(p.ws + OFF_EH) + row * 1024 + col) = o;
      float s = v.x * v.x + v.y * v.y + v.z * v.z + v.w * v.w;
      s = sum16(s); s += __shfl_xor(s, 16);
      if (c4 == 0) ((float*)(p.ws + OFF_EPART))[row * 8 + (bcol >> 7)] = s;
    } else if constexpr (EPI == EPI_OUT) {
      const float4 xv = *(const float4*)(p.in[I_X] + row * 1024 + col);
      float4 hv; hv.x = xv.x + v.x; hv.y = xv.y + v.y; hv.z = xv.z + v.z; hv.w = xv.w + v.w;
      *(float4*)(p.out + row * 1024 + col) = hv;
      h16x4 o; o[0] = (h16)hv.x; o[1] = (h16)hv.y; o[2] = (h16)hv.z; o[3] = (h16)hv.w;
      *(h16x4*)((h16*)(p.ws + OFF_PROJ) + row * 1024 + col) = o;
    } else if constexpr (EPI == EPI_GATE) {
      const float4 e0 = *(const float4*)((const float*)(p.ws + OFF_EPART) + row * 8);
      const float4 e1 = *(const float4*)((const float*)(p.ws + OFF_EPART) + row * 8 + 4);
      const float rs = rsqrtf((e0.x + e0.y + e0.z + e0.w + e1.x + e1.y + e1.z + e1.w) * (1.f / 1024.f) + 1e-6f);
      const h16x4 eh = *(const h16x4*)((const h16*)(p.ws + OFF_EH) + row * 1024 + col);
      const float4 pg = *(const float4*)(p.in[I_PLEG] + col);
      float4 hv = *(const float4*)(p.out + row * 1024 + col);
      hv.x += sigmoidf_(v.x) * ((float)eh[0] * rs * pg.x);
      hv.y += sigmoidf_(v.y) * ((float)eh[1] * rs * pg.y);
      hv.z += sigmoidf_(v.z) * ((float)eh[2] * rs * pg.z);
      hv.w += sigmoidf_(v.w) * ((float)eh[3] * rs * pg.w);
      *(float4*)(p.out + row * 1024 + col) = hv;
      float s = hv.x * hv.x + hv.y * hv.y + hv.z * hv.z + hv.w * hv.w;
      s = sum16(s); s += __shfl_xor(s, 16);
      if (c4 == 0) ((float*)(p.ws + OFF_OPART))[row * 8 + (bcol >> 7)] = s;
    }
  }
  __syncthreads();
}

__device__ void ssm_item(const Params& p, int b, int g, unsigned char* smem) {
  float* LOCAL = (float*)smem;
  h16* SPREV = (h16*)(smem + 33792);
  h16* KT = (h16*)(smem + 51200);
  int tid_ = threadIdx.x;
  asm volatile("" : "+v"(tid_));
  const int tid = tid_, w = tid >> 6, lane = tid & 63, fr = lane & 15, fq = lane >> 4;
  const h16* PROJ = (const h16*)(p.ws + OFF_PROJ);
  const h16* Eg = (const h16*)(p.ws + OFF_ETAB) + (size_t)g * 128 * 512;
  const h16* Kg = (const h16*)(p.ws + OFF_KTAB) + (size_t)g * 33 * 256;
  const h16* Fg = (const h16*)(p.ws + OFF_FTAB) + (size_t)g * 512 * 128;
  const float* ALPOW = (const float*)(p.ws + OFF_ALPOW);
  h16* YPRE = (h16*)((unsigned char*)p.out + OUT_OFF_YPRE);
  const int nchunk = w * 16 + fr;
  const size_t tok0 = (size_t)b * SEQ + (size_t)nchunk * 32;
  for (int idx = tid; idx < 33 * 256 / 8; idx += 256) *(h16x8*)(KT + idx * 8) = *(const h16x8*)(Kg + idx * 8);
  h16x8 uf[16];
#pragma unroll
  for (int ks = 0; ks < 16; ++ks) {
    const int i = 2 * ks + (fq >> 1);
    uf[ks] = *(const h16x8*)(PROJ + (tok0 + i) * LDP + g * 16 + (fq & 1) * 8);
  }
  {
    h16x8 ea[8];
#pragma unroll
    for (int ks = 0; ks < 8; ++ks) ea[ks] = *(const h16x8*)(Eg + (size_t)fr * 512 + ks * 32 + fq * 8);
    f32x4 acc = {0.f, 0.f, 0.f, 0.f};
#pragma unroll 1
    for (int it = 0; it < 16; ++it) {
      const int mt = it >> 1, hf = it & 1;
      const int itn = it < 15 ? it + 1 : 15;
      h16x8 en[8];
#pragma unroll
      for (int ks = 0; ks < 8; ++ks) en[ks] = *(const h16x8*)(Eg + (size_t)((itn >> 1) * 16 + fr) * 512 + ((itn & 1) * 8 + ks) * 32 + fq * 8);
      if (hf == 0) {
#pragma unroll
        for (int ks = 0; ks < 8; ++ks) acc = MFMA(ea[ks], uf[ks], acc);
      } else {
#pragma unroll
        for (int ks = 0; ks < 8; ++ks) acc = MFMA(ea[ks], uf[8 + ks], acc);
        *(f32x4*)(LOCAL + nchunk * 132 + mt * 16 + fq * 4) = acc;
        acc = f32x4{0.f, 0.f, 0.f, 0.f};
      }
#pragma unroll
      for (int ks = 0; ks < 8; ++ks) ea[ks] = en[ks];
    }
  }
  __syncthreads();
  if (tid < 64) {
    const int pp = tid;
    const float ar = ALPOW[(g * 64 + pp) * 2], ai = ALPOW[(g * 64 + pp) * 2 + 1];
    float sr = 0.f, si = 0.f;
#pragma unroll 4
    for (int c = 0; c < 64; ++c) {
      SPREV[c * 136 + pp] = (h16)sr;
      SPREV[c * 136 + 64 + pp] = (h16)si;
      float lr = LOCAL[c * 132 + pp], li = LOCAL[c * 132 + 64 + pp];
      float nr = ar * sr - ai * si + lr;
      float ni = ar * si + ai * sr + li;
      sr = nr; si = ni;
    }
  }
  __syncthreads();
  h16x8 sf[4];
#pragma unroll
  for (int ks = 0; ks < 4; ++ks) sf[ks] = *(const h16x8*)(SPREV + nchunk * 136 + ks * 32 + fq * 8);
  const float4 Dv = *(const float4*)(p.in[I_D] + g * 16 + fq * 4);
  h16x8 fa[4];
#pragma unroll
  for (int ks = 0; ks < 4; ++ks) fa[ks] = *(const h16x8*)(Fg + (size_t)fr * 128 + ks * 32 + fq * 8);
  h16x4 u4 = *(const h16x4*)(PROJ + tok0 * LDP + g * 16 + fq * 4);
#pragma unroll 1
  for (int j = 0; j < 32; ++j) {
    const int jn = j < 31 ? j + 1 : 31;
    h16x8 fn[4];
#pragma unroll
    for (int ks = 0; ks < 4; ++ks) fn[ks] = *(const h16x8*)(Fg + (size_t)(jn * 16 + fr) * 128 + ks * 32 + fq * 8);
    const h16x4 un = *(const h16x4*)(PROJ + (tok0 + jn) * LDP + g * 16 + fq * 4);
    f32x4 acc = {0.f, 0.f, 0.f, 0.f};
#pragma unroll
    for (int ks = 0; ks < 16; ++ks) {
      if (2 * ks <= j) {
        const int dd = j - 2 * ks - (fq >> 1) + 1;
        h16x8 a = *(const h16x8*)(KT + dd * 256 + fr * 16 + (fq & 1) * 8);
        acc = MFMA(a, uf[ks], acc);
      }
    }
#pragma unroll
    for (int ks = 0; ks < 4; ++ks) acc = MFMA(fa[ks], sf[ks], acc);
    const size_t tok = tok0 + j;
    h16x4 o;
    o[0] = (h16)gelu_tanh(acc[0] + Dv.x * (float)u4[0]);
    o[1] = (h16)gelu_tanh(acc[1] + Dv.y * (float)u4[1]);
    o[2] = (h16)gelu_tanh(acc[2] + Dv.z * (float)u4[2]);
    o[3] = (h16)gelu_tanh(acc[3] + Dv.w * (float)u4[3]);
    *(h16x4*)(YPRE + tok * 512 + g * 16 + fq * 4) = o;
#pragma unroll
    for (int ks = 0; ks < 4; ++ks) fa[ks] = fn[ks];
    u4 = un;
  }
  __syncthreads();
}

__device__ void gdn_pre_item(const Params& p, int item, unsigned char* smem) {
  h16* QH = (h16*)smem;
  h16* KH = (h16*)(smem + 17408);
  h16* VH = (h16*)(smem + 34816);
  float* LT = (float*)(smem + 52224);
  float* sG = (float*)(smem + 69632);
  float* sBeta = (float*)(smem + 69888);
  int tid_ = threadIdx.x;
  asm volatile("" : "+v"(tid_));
  const int tid = tid_, w = tid >> 6, lane = tid & 63, fr = lane & 15, fq = lane >> 4;
  const int c = item & 31, h = (item >> 5) & 3, b = item >> 7;
  const h16* PROJ = (const h16*)(p.ws + OFF_PROJ);
  const float* AB = (const float*)(p.ws + OFF_AB);
  const float* convw = p.in[I_CONVW];
  h16* WPi = (h16*)(p.ws + OFF_WP) + (size_t)item * 64 * 128;
  h16* QGPi = (h16*)(p.ws + OFF_QGP) + (size_t)item * 64 * 128;
  h16* KDTi = (h16*)(p.ws + OFF_KDT) + (size_t)item * 128 * 64;
  h16* UTi = (h16*)(p.ws + OFF_UT) + (size_t)item * 128 * 64;
  h16* ATPi = (h16*)(p.ws + OFF_ATP) + (size_t)item * 64 * 64;
  h16* ZTi = (h16*)((unsigned char*)p.out + OUT_OFF_ZT) + (size_t)item * 128 * 64;
  float* DL = (float*)(p.ws + OFF_DL);
  {
    const int ch0 = (tid & 15) * 8, trow = tid >> 4;
#pragma unroll 1
    for (int pass = 0; pass < 4; ++pass) {
      const int t = pass * 16 + trow, tl = c * 64 + t;
#pragma unroll
      for (int sec = 0; sec < 3; ++sec) {
        const int colbase = 1024 + sec * 512 + h * 128 + ch0;
        float a[8];
#pragma unroll
        for (int e = 0; e < 8; ++e) a[e] = 0.f;
#pragma unroll
        for (int jj = 0; jj < 4; ++jj) {
          const int ts = tl - 3 + jj;
          if (ts >= 0) {
            h16x8 xv = *(const h16x8*)(PROJ + ((size_t)b * SEQ + ts) * LDP + colbase);
            const float4 w0 = *(const float4*)(convw + jj * 1536 + sec * 512 + h * 128 + ch0);
            const float4 w1 = *(const float4*)(convw + jj * 1536 + sec * 512 + h * 128 + ch0 + 4);
            a[0] += w0.x * (float)xv[0]; a[1] += w0.y * (float)xv[1]; a[2] += w0.z * (float)xv[2]; a[3] += w0.w * (float)xv[3];
            a[4] += w1.x * (float)xv[4]; a[5] += w1.y * (float)xv[5]; a[6] += w1.z * (float)xv[6]; a[7] += w1.w * (float)xv[7];
          }
        }
        float ss = 0.f;
#pragma unroll
        for (int e = 0; e < 8; ++e) { a[e] = siluf_(a[e]); ss += a[e] * a[e]; }
        float scale = 1.f;
        if (sec < 2) {
          ss = sum16(ss);
          scale = rsqrtf(ss + 1e-6f) * (sec == 0 ? 0.08838834764831845f : 1.f);
        }
        h16x8 o;
#pragma unroll
        for (int e = 0; e < 8; ++e) o[e] = (h16)(a[e] * scale);
        h16* dst = (sec == 0 ? QH : (sec == 1 ? KH : VH));
        *(h16x8*)(dst + t * 136 + ch0) = o;
      }
    }
  }
  if (tid < 64) {
    const size_t tok = (size_t)b * SEQ + c * 64 + tid;
    float braw = AB[tok * 8 + h], araw = AB[tok * 8 + 4 + h];
    float beta = 1.f / (1.f + expf(-braw));
    float xx = araw + p.in[I_DTB][h];
    float sp = xx > 20.f ? xx : log1pf(expf(xx));
    float gg = -expf(p.in[I_ALOG][h]) * sp;
#pragma unroll
    for (int o = 1; o < 64; o <<= 1) {
      float v = __shfl_up(gg, o);
      if (lane >= o) gg += v;
    }
    sG[tid] = gg;
    sBeta[tid] = beta;
  }
  __syncthreads();
  {
    h16x8 ak[4], aq[4];
#pragma unroll
    for (int ks = 0; ks < 4; ++ks) {
      ak[ks] = *(const h16x8*)(KH + (w * 16 + fr) * 136 + ks * 32 + fq * 8);
      aq[ks] = *(const h16x8*)(QH + (w * 16 + fr) * 136 + ks * 32 + fq * 8);
    }
#pragma unroll
    for (int jt = 0; jt < 4; ++jt) {
      const int j = jt * 16 + fr;
      const int pj = perm_pos(j);
      if (jt <= w) {
        f32x4 kk = {0.f, 0.f, 0.f, 0.f}, qk = {0.f, 0.f, 0.f, 0.f};
#pragma unroll
        for (int ks = 0; ks < 4; ++ks) {
          h16x8 bk = *(const h16x8*)(KH + (jt * 16 + fr) * 136 + ks * 32 + fq * 8);
          kk = MFMA(ak[ks], bk, kk);
          qk = MFMA(aq[ks], bk, qk);
        }
        const float Gj = sG[j];
        f32x4 lt;
#pragma unroll
        for (int r = 0; r < 4; ++r) {
          const int i = w * 16 + 4 * fq + r;
          const float e = (i >= j) ? expf(sG[i] - Gj) : 0.f;
          lt[r] = (i > j) ? sBeta[i] * kk[r] * e : 0.f;
          ATPi[i * 64 + (((pj >> 3) ^ (i & 7)) << 3) + (pj & 7)] = (h16)(qk[r] * e);
        }
        *(f32x4*)(LT + j * 68 + w * 16 + 4 * fq) = lt;
      } else {
#pragma unroll
        for (int r = 0; r < 4; ++r) {
          const int i = w * 16 + 4 * fq + r;
          ATPi[i * 64 + (((pj >> 3) ^ (i & 7)) << 3) + (pj & 7)] = (h16)0.f;
        }
      }
    }
  }
  __syncthreads();
  float r[64];
  if (tid < 128) {
#pragma unroll
    for (int t = 0; t < 64; ++t) r[t] = (float)VH[t * 136 + tid] * sBeta[t];
  } else {
#pragma unroll
    for (int t = 0; t < 64; ++t) r[t] = (float)KH[t * 136 + (tid - 128)] * sBeta[t] * expf(sG[t]);
  }
#pragma unroll
  for (int j = 0; j < 63; ++j) {
    const float xj = r[j];
#pragma unroll
    for (int i4 = (j + 1) / 4; i4 < 16; ++i4) {
      const f32x4 l = *(const f32x4*)(LT + j * 68 + i4 * 4);
#pragma unroll
      for (int e = 0; e < 4; ++e) {
        if (i4 * 4 + e > j) r[i4 * 4 + e] -= l[e] * xj;
      }
    }
    __builtin_amdgcn_sched_barrier(0);
  }
  if (tid < 128) {
#pragma unroll
    for (int t8 = 0; t8 < 8; ++t8) {
      h16x8 v;
#pragma unroll
      for (int e = 0; e < 8; ++e) v[e] = (h16)r[t8 * 8 + e];
      *(h16x8*)(UTi + (size_t)tid * 64 + t8 * 8) = v;
    }
  }
  __syncthreads();
  if (tid >= 128) {
    const int pos = perm_pos(tid - 128);
#pragma unroll
    for (int t = 0; t < 64; ++t) VH[t * 136 + pos] = (h16)r[t];
  }
  __syncthreads();
  for (int rr = 0; rr < 4; ++rr) {
    const int idx = tid + 256 * rr, row = idx >> 4, seg = idx & 15;
    *(h16x8*)(WPi + row * 128 + ((seg ^ (row & 15)) << 3)) = *(const h16x8*)(VH + row * 136 + seg * 8);
  }
  {
    const int dv = tid & 127, th = tid >> 7;
    const float gdv = p.in[I_DNG][dv];
    const h16* zp = PROJ + ((size_t)b * SEQ + c * 64 + th * 32) * LDP + 2560 + h * 128 + dv;
    h16 zv[32];
#pragma unroll
    for (int t = 0; t < 32; ++t) zv[t] = zp[(size_t)t * LDP];
#pragma unroll
    for (int t8 = 0; t8 < 4; ++t8) {
      h16x8 v;
#pragma unroll
      for (int e = 0; e < 8; ++e) v[e] = (h16)(siluf_((float)zv[t8 * 8 + e]) * gdv);
      *(h16x8*)(ZTi + (size_t)dv * 64 + th * 32 + t8 * 8) = v;
    }
  }
#pragma unroll 2
  for (int rr = 0; rr < 32; ++rr) {
    const int idx = tid + 256 * rr, t = idx >> 7, pp = idx & 127;
    const int dk = perm_inv(pp);
    QGPi[t * 128 + (((pp >> 3) ^ (t & 15)) << 3) + (pp & 7)] = (h16)((float)QH[t * 136 + dk] * expf(sG[t]));
  }
  const float Glast = sG[63];
#pragma unroll 2
  for (int rr = 0; rr < 32; ++rr) {
    const int idx = tid + 256 * rr, dk = idx >> 6, tp = idx & 63;
    const int t = perm_inv(tp);
    KDTi[dk * 64 + (((tp >> 3) ^ (dk & 7)) << 3) + (tp & 7)] = (h16)((float)KH[t * 136 + dk] * expf(Glast - sG[t]));
  }
  if (tid == 0) DL[item] = expf(Glast);
  __syncthreads();
}

template <int NB>
__device__ __forceinline__ void glds_copy(const h16* __restrict__ g, unsigned char* l) {
#pragma unroll
  for (int i = 0; i < NB / 4096; ++i) {
    const int off = threadIdx.x * 16 + i * 4096;
    __builtin_amdgcn_global_load_lds((const unsigned*)((const unsigned char*)g + off), (unsigned*)(l + off), 16, 0, 0);
  }
}
#define RAW_BARRIER() do { asm volatile("s_waitcnt lgkmcnt(0)" ::: "memory"); __builtin_amdgcn_s_barrier(); asm volatile("" ::: "memory"); } while (0)

__device__ void gdn_chain(const Params& p, int bh, unsigned char* smem) {
  const int tid = threadIdx.x, w = tid >> 6, lane = tid & 63, fr = lane & 15, fq = lane >> 4;
  const float* DL = (const float*)(p.ws + OFF_DL);
  const h16* WPb = (const h16*)(p.ws + OFF_WP) + (size_t)bh * 32 * 64 * 128;
  const h16* KDTb = (const h16*)(p.ws + OFF_KDT) + (size_t)bh * 32 * 128 * 64;
  h16* UTb = (h16*)(p.ws + OFF_UT) + (size_t)bh * 32 * 128 * 64;
  h16* SFb = (h16*)((unsigned char*)p.out + OUT_OFF_SF) + (size_t)bh * 32 * 128 * 128;
  f32x4 S[8][2];
#pragma unroll
  for (int i = 0; i < 8; ++i) { S[i][0] = f32x4{0.f, 0.f, 0.f, 0.f}; S[i][1] = f32x4{0.f, 0.f, 0.f, 0.f}; }
  h16x4 uR[4][2];
  glds_copy<16384>(WPb, smem); glds_copy<16384>(KDTb, smem + 16384);
#pragma unroll
  for (int mt = 0; mt < 4; ++mt)
#pragma unroll
    for (int nt = 0; nt < 2; ++nt)
      uR[mt][nt] = *(const h16x4*)(UTb + (size_t)(w * 32 + nt * 16 + fr) * 64 + mt * 16 + fq * 4);
  asm volatile("s_waitcnt vmcnt(0)" ::: "memory");
  RAW_BARRIER();
  for (int c = 0; c < 32; ++c) {
    const int item = bh * 32 + c;
    const float dl = DL[item];
    const int cn = (c + 1 < 32) ? c + 1 : c;
    const unsigned char* LW = smem + (c & 1) * 32768;
    const unsigned char* LK = LW + 16384;
    unsigned char* LWn = smem + ((c + 1) & 1) * 32768;
    h16x8 sfr[4][2];
#pragma unroll
    for (int ks = 0; ks < 4; ++ks) { sfr[ks][0] = pack8(S[2 * ks][0], S[2 * ks + 1][0]); sfr[ks][1] = pack8(S[2 * ks][1], S[2 * ks + 1][1]); }
#pragma unroll
    for (int ks = 0; ks < 4; ++ks)
#pragma unroll
      for (int nt = 0; nt < 2; ++nt)
        *(h16x8*)(SFb + ((size_t)(c * 4 + ks) * 8 + w * 2 + nt) * 512 + lane * 8) = sfr[ks][nt];
    asm volatile("" ::: "memory");
    glds_copy<16384>(WPb + (size_t)cn * 64 * 128, LWn);
    glds_copy<16384>(KDTb + (size_t)cn * 128 * 64, LWn + 16384);
    asm volatile("" ::: "memory");
    f32x4 vn[4][2];
#pragma unroll
    for (int mt = 0; mt < 4; ++mt) { vn[mt][0] = f32x4{0.f, 0.f, 0.f, 0.f}; vn[mt][1] = vn[mt][0]; }
#pragma unroll
    for (int ks = 0; ks < 4; ++ks)
#pragma unroll
      for (int mt = 0; mt < 4; ++mt) {
        h16x8 aw = *(const h16x8*)(LW + (mt * 16 + fr) * 256 + (((ks * 4 + fq) ^ fr) << 4));
        vn[mt][0] = MFMA(aw, sfr[ks][0], vn[mt][0]);
        vn[mt][1] = MFMA(aw, sfr[ks][1], vn[mt][1]);
      }
#pragma unroll
    for (int mt = 0; mt < 4; ++mt)
#pragma unroll
      for (int r = 0; r < 4; ++r) { vn[mt][0][r] = (float)uR[mt][0][r] - vn[mt][0][r]; vn[mt][1][r] = (float)uR[mt][1][r] - vn[mt][1][r]; }
#pragma unroll
    for (int mt = 0; mt < 4; ++mt)
#pragma unroll
      for (int nt = 0; nt < 2; ++nt)
        uR[mt][nt] = *(const h16x4*)(UTb + (size_t)cn * 128 * 64 + (size_t)(w * 32 + nt * 16 + fr) * 64 + mt * 16 + fq * 4);
    asm volatile("" ::: "memory");
    h16x8 vfr[2][2];
#pragma unroll
    for (int k2 = 0; k2 < 2; ++k2) { vfr[k2][0] = pack8(vn[2 * k2][0], vn[2 * k2 + 1][0]); vfr[k2][1] = pack8(vn[2 * k2][1], vn[2 * k2 + 1][1]); }
    if (c + 1 < 32) {
#pragma unroll
      for (int k2 = 0; k2 < 2; ++k2)
#pragma unroll
        for (int nt = 0; nt < 2; ++nt)
          *(h16x8*)(UTb + (size_t)c * 128 * 64 + ((size_t)k2 * 8 + w * 2 + nt) * 512 + lane * 8) = vfr[k2][nt];
    }
#pragma unroll
    for (int dkt = 0; dkt < 8; ++dkt) {
      f32x4 s0 = S[dkt][0], s1 = S[dkt][1];
#pragma unroll
      for (int r = 0; r < 4; ++r) { s0[r] *= dl; s1[r] *= dl; }
#pragma unroll
      for (int k2 = 0; k2 < 2; ++k2) {
        h16x8 ak = *(const h16x8*)(LK + (dkt * 16 + fr) * 128 + (((k2 * 4 + fq) ^ (fr & 7)) << 4));
        s0 = MFMA(ak, vfr[k2][0], s0);
        s1 = MFMA(ak, vfr[k2][1], s1);
      }
      S[dkt][0] = s0; S[dkt][1] = s1;
    }
    asm volatile("s_waitcnt vmcnt(0)" ::: "memory");
    RAW_BARRIER();
    if (c + 1 == 32) {
#pragma unroll
      for (int k2 = 0; k2 < 2; ++k2)
#pragma unroll
        for (int nt = 0; nt < 2; ++nt)
          *(h16x8*)(UTb + (size_t)c * 128 * 64 + ((size_t)k2 * 8 + w * 2 + nt) * 512 + lane * 8) = vfr[k2][nt];
    }
  }
  asm volatile("s_waitcnt vmcnt(0)" ::: "memory");
  __syncthreads();
}

__device__ void gdn_out_item(const Params& p, int item, unsigned char* smem) {
  unsigned char* LQ = smem;
  unsigned char* LA = smem + 16384;
  float* red = (float*)(smem + 24576);
  const int tid = threadIdx.x, w = tid >> 6, lane = tid & 63, fr = lane & 15, fq = lane >> 4;
  const int c = item & 31, h = (item >> 5) & 3, b = item >> 7;
  h16* MIXIN = (h16*)(p.ws + OFF_MIXIN);
  const h16* QGPi = (const h16*)(p.ws + OFF_QGP) + (size_t)item * 64 * 128;
  const h16* ATPi = (const h16*)(p.ws + OFF_ATP) + (size_t)item * 64 * 64;
  const h16* VFi = (const h16*)(p.ws + OFF_UT) + (size_t)item * 128 * 64;
  const h16* SFi = (const h16*)((unsigned char*)p.out + OUT_OFF_SF) + (size_t)item * 128 * 128;
  const h16* ZTi = (const h16*)((unsigned char*)p.out + OUT_OFF_ZT) + (size_t)item * 128 * 64;
  glds_copy<16384>(QGPi, LQ); glds_copy<8192>(ATPi, LA);
  h16x8 sfr[4][2], vfr[2][2];
#pragma unroll
  for (int ks = 0; ks < 4; ++ks)
#pragma unroll
    for (int nt = 0; nt < 2; ++nt) sfr[ks][nt] = *(const h16x8*)(SFi + ((size_t)ks * 8 + w * 2 + nt) * 512 + lane * 8);
#pragma unroll
  for (int k2 = 0; k2 < 2; ++k2)
#pragma unroll
    for (int nt = 0; nt < 2; ++nt) vfr[k2][nt] = *(const h16x8*)(VFi + ((size_t)k2 * 8 + w * 2 + nt) * 512 + lane * 8);
  h16x4 zR[4][2];
#pragma unroll
  for (int mt = 0; mt < 4; ++mt)
#pragma unroll
    for (int nt = 0; nt < 2; ++nt) zR[mt][nt] = *(const h16x4*)(ZTi + (size_t)(w * 32 + nt * 16 + fr) * 64 + mt * 16 + fq * 4);
  asm volatile("s_waitcnt vmcnt(0)" ::: "memory");
  __syncthreads();
  f32x4 o[4][2];
#pragma unroll
  for (int mt = 0; mt < 4; ++mt) {
    f32x4 o0 = {0.f, 0.f, 0.f, 0.f}, o1 = {0.f, 0.f, 0.f, 0.f};
#pragma unroll
    for (int ks = 0; ks < 4; ++ks) {
      h16x8 aq = *(const h16x8*)(LQ + (mt * 16 + fr) * 256 + (((ks * 4 + fq) ^ fr) << 4));
      o0 = MFMA(aq, sfr[ks][0], o0);
      o1 = MFMA(aq, sfr[ks][1], o1);
    }
#pragma unroll
    for (int k2 = 0; k2 < 2; ++k2) {
      h16x8 aa = *(const h16x8*)(LA + (mt * 16 + fr) * 128 + (((k2 * 4 + fq) ^ (fr & 7)) << 4));
      o0 = MFMA(aa, vfr[k2][0], o0);
      o1 = MFMA(aa, vfr[k2][1], o1);
    }
    o[mt][0] = o0; o[mt][1] = o1;
  }
#pragma unroll
  for (int mt = 0; mt < 4; ++mt)
#pragma unroll
    for (int r = 0; r < 4; ++r) {
      float s = o[mt][0][r] * o[mt][0][r] + o[mt][1][r] * o[mt][1][r];
      s = sum16(s);
      if (fr == 0) red[w * 64 + mt * 16 + 4 * fq + r] = s;
    }
  __syncthreads();
#pragma unroll
  for (int mt = 0; mt < 4; ++mt)
#pragma unroll
    for (int r = 0; r < 4; ++r) {
      const int tl = mt * 16 + 4 * fq + r;
      const float tot = red[tl] + red[64 + tl] + red[128 + tl] + red[192 + tl];
      const float rstd = rsqrtf(tot * (1.f / 128.f) + 1e-6f);
      const size_t tok = (size_t)b * SEQ + c * 64 + tl;
      h16* yp = MIXIN + tok * 1024 + 512 + h * 128 + w * 32 + fr;
      yp[0] = (h16)(o[mt][0][r] * rstd * (float)zR[mt][0][r]);
      yp[16] = (h16)(o[mt][1][r] * rstd * (float)zR[mt][1][r]);
    }
  __syncthreads();
}

#define XB_TMO      128
#define XB_XCNT(j)  (256  + 64 * (j))
#define XB_XSUB(j)  (1280 + 64 * (j))
#define XB_XGEN(j)  (2304 + 64 * (j))
#define XB_TOP      3328
#define XB_TOPGEN   3392
#define XCD_BAR_WORDS 3456
#define XB_SPIN_CAP (1u << 18)
#define LAS __attribute__((address_space(3)))

__device__ __forceinline__ unsigned xb_ld(unsigned* p)              { return __hip_atomic_load(p, __ATOMIC_RELAXED, __HIP_MEMORY_SCOPE_AGENT); }
__device__ __forceinline__ unsigned xb_add(unsigned* p, unsigned v) { return __hip_atomic_fetch_add(p, v, __ATOMIC_RELAXED, __HIP_MEMORY_SCOPE_AGENT); }
__device__ __forceinline__ unsigned xb_xcc_id() { return (unsigned)__builtin_amdgcn_s_getreg((3 << 11) | 20) & 0xFu; }
#define XB_SPIN(cond, bar) do { unsigned _sp = 0; while (cond) { __builtin_amdgcn_s_sleep(1); \
    if ((++_sp & 255u) == 0u) { if (xb_ld(&(bar)[XB_TMO])) break; if (_sp > XB_SPIN_CAP) { atomicAdd(&(bar)[XB_TMO], 1u); break; } } } } while (0)

struct XcdBarrier {
    unsigned* bar; unsigned x;
    volatile LAS unsigned* st;
};

__device__ __forceinline__ XcdBarrier xcd_barrier_post(unsigned* bar, volatile LAS unsigned* st) {
    XcdBarrier b; b.bar = bar; b.x = xb_xcc_id(); b.st = st;
    if (threadIdx.x == 0) (void)xb_add(&bar[XB_XCNT(b.x)], 1u);
    return b;
}
__device__ __forceinline__ void xcd_barrier_complete(unsigned* bar, unsigned x, unsigned& nloc, unsigned& nx) {
    const unsigned G = gridDim.x * gridDim.y * gridDim.z;
    unsigned sum, cnt, mine, sp = 0u;
    for (;;) {
        sum = 0u; cnt = 0u; mine = 0u;
#pragma unroll
        for (unsigned j = 0; j < 16; ++j) { const unsigned c = xb_ld(&bar[XB_XCNT(j)]); sum += c; cnt += (c > 0u) ? 1u : 0u; mine = (j == x) ? c : mine; }
        if (sum == G) break;
        __builtin_amdgcn_s_sleep(1);
        if ((++sp & 255u) == 0u) { if (xb_ld(&bar[XB_TMO])) break; if (sp > XB_SPIN_CAP) { atomicAdd(&bar[XB_TMO], 1u); break; } }
    }
    nloc = mine > 0u ? mine : 1u; nx = cnt > 0u ? cnt : 1u;
}

__device__ __forceinline__ void xcd_barrier(const XcdBarrier& b) {
    asm volatile("s_waitcnt vmcnt(0)" ::: "memory");
    __syncthreads();
    if (threadIdx.x == 0) {
        unsigned* bar = b.bar;
        __builtin_amdgcn_s_waitcnt(0);
        unsigned nloc = b.st[0], nx = b.st[1];
        if (nloc == 0u) { xcd_barrier_complete(bar, b.x, nloc, nx); b.st[0] = nloc; b.st[1] = nx; }
        const unsigned old = xb_add(&bar[XB_XSUB(b.x)], 1u);
        const unsigned gen = old / nloc;
        if (old + 1u == (gen + 1u) * nloc) {
            __builtin_amdgcn_fence(__ATOMIC_RELEASE, "agent");
            asm volatile("s_waitcnt vmcnt(0)" ::: "memory");
            const unsigned og = xb_add(&bar[XB_TOP], 1u);
            const unsigned tg = og / nx;
            if (og + 1u == (tg + 1u) * nx) xb_add(&bar[XB_TOPGEN], 1u);
            else XB_SPIN(xb_ld(&bar[XB_TOPGEN]) == tg, bar);
            __builtin_amdgcn_fence(__ATOMIC_ACQUIRE, "agent");
            xb_add(&bar[XB_XGEN(b.x)], 1u);
            asm volatile("s_waitcnt vmcnt(0)" ::: "memory");
        } else {
            XB_SPIN(xb_ld(&bar[XB_XGEN(b.x)]) == gen, bar);
            __builtin_amdgcn_fence(__ATOMIC_ACQUIRE, "agent");
            asm volatile("s_waitcnt vmcnt(0)" ::: "memory");
        }
    }
    __syncthreads();
}

#ifndef ONLY_PH
#define ONLY_PH -1
#endif
#define RUNPH(n) ((ONLY_PH < 0 || ONLY_PH == (n)) && p.ph_lo <= (n) && (n) <= p.ph_hi)
#define SYNCPH(n) do { if (p.ph_lo <= (n) && (n) < p.ph_hi) xcd_barrier(xb); } while (0)
__global__ void __launch_bounds__(256, 2) hymba_mega(Params p) {
  __shared__ __attribute__((aligned(16))) unsigned char smem[SMEM_BYTES];
  cg::grid_group grid = cg::this_grid();
  const int bid = blockIdx.x, nb = gridDim.x;
  if (p.ph_lo < 0) grid.sync();
  XcdBarrier xb;
  {
    volatile LAS unsigned* st = (volatile LAS unsigned*)(smem + SMEM_BYTES - 16);
    if (threadIdx.x == 0) { st[0] = 0u; st[1] = 0u; st[2] = 0u; st[3] = 0u; }
    __syncthreads();
    if (p.ph_lo < p.ph_hi) xb = xcd_barrier_post((unsigned*)(p.ws + OFF_BAR), st);
    else { xb.bar = (unsigned*)(p.ws + OFF_BAR); xb.x = 0; xb.st = st; }
  }
  {
    if (RUNPH(0)) for (int rep = 0; rep < REP0; ++rep) {
      if (rep) grid.sync();
      phase0(p, smem);
    }
    SYNCPH(0);
    if (RUNPH(1)) for (int rep = 0; rep < REP1; ++rep) {
      if (rep) grid.sync();
      const h16* A0 = (const h16*)((unsigned char*)p.out + OUT_OFF_A0);
      const h16* W = (const h16*)(p.ws + OFF_WIN);
      for (int t = bid; t < 256 * 25; t += nb) gemm_tile<EPI_PROJ>(p, A0, 1024, W, 1024, 1024, (t / 25) * 128, (t % 25) * 128, smem);
    }
    SYNCPH(1);
    if (RUNPH(2)) for (int rep = 0; rep < REP2; ++rep) {
      if (rep) grid.sync();
      for (int it = bid; it < 512 + 2048; it += nb) {
        if (it < 2048) gdn_pre_item(p, it, smem);
        else ssm_item(p, (it - 2048) >> 5, (it - 2048) & 31, smem);
      }
    }
    SYNCPH(2);
    if (RUNPH(3)) {
      if (bid < 64) gdn_chain(p, bid, smem);
      unsigned* ctr = (unsigned*)(p.ws + OFF_CTR);
      volatile int* bc = (volatile int*)(smem + SMEM_BYTES - 4);
      const h16* YPRE = (const h16*)((unsigned char*)p.out + OUT_OFF_YPRE);
      for (;;) {
        __syncthreads();
        if (threadIdx.x == 0) *bc = (int)atomicAdd(ctr, 1u);
        __syncthreads();
        const int t = *bc;
        if (t >= 1024 + 2048) break;
        if (t < 1024) gemm_tile<EPI_GLU>(p, YPRE, 512, (const h16*)(p.ws + OFF_WGLU), 512, 512, (t >> 2) * 128, (t & 3) * 128, smem);
        else gemm_tile<EPI_PLE>(p, (const h16*)(p.ws + OFF_PB), 256, (const h16*)(p.ws + OFF_WPP), 256, 256, ((t - 1024) >> 3) * 128, ((t - 1024) & 7) * 128, smem);
      }
    }
    SYNCPH(3);
    if (RUNPH(4)) {
      for (int it = bid; it < 2048; it += nb) gdn_out_item(p, it, smem);
    }
    SYNCPH(4);
    if (RUNPH(5)) {
      for (int t = bid; t < 2048; t += nb)
        gemm_tile<EPI_OUT>(p, (const h16*)(p.ws + OFF_MIXIN), 1024, (const h16*)(p.ws + OFF_WOUT), 1024, 1024, (t >> 3) * 128, (t & 7) * 128, smem);
    }
    SYNCPH(5);
    if (RUNPH(6)) {
      for (int t = bid; t < 2048; t += nb)
        gemm_tile<EPI_GATE>(p, (const h16*)(p.ws + OFF_PROJ), 1024, (const h16*)(p.ws + OFF_WGATE), 1024, 1024, (t >> 3) * 128, (t & 7) * 128, smem);
    }
    SYNCPH(6);
    if (RUNPH(7)) {
      const int wid = threadIdx.x >> 6, lane = threadIdx.x & 63;
      const float* OPART = (const float*)(p.ws + OFF_OPART);
      const float4* g4 = (const float4*)p.in[I_FING];
      for (int row = bid * 4 + wid; row < T_TOK; row += nb * 4) {
        float s = (lane < 8) ? OPART[(size_t)row * 8 + lane] : 0.f;
        s = wave_sum(s);
        const float rstd = rsqrtf(s * (1.f / 1024.f) + 1e-6f);
        float4* orow = (float4*)(p.out + (size_t)row * 1024);
#pragma unroll
        for (int i = 0; i < 4; ++i) {
          float4 v = orow[lane + i * 64];
          float4 g = g4[lane + i * 64];
          v.x *= rstd * g.x; v.y *= rstd * g.y; v.z *= rstd * g.z; v.w *= rstd * g.w;
          orow[lane + i * 64] = v;
        }
      }
    }
  }
}

extern "C" void kernel_launch(void* const* d_in, const int* in_sizes, int n_in, void* d_out, int out_size, void* d_ws, size_t ws_size,
                              hipStream_t stream) {
  static int grid_blocks = 0;
  if (!grid_blocks) {
    int dev = 0, cus = 0, per_cu = 0;
    hipGetDevice(&dev);
    hipDeviceGetAttribute(&cus, hipDeviceAttributeMultiprocessorCount, dev);
    hipOccupancyMaxActiveBlocksPerMultiprocessor(&per_cu, hymba_mega, 256, 0);
    if (per_cu > 2) per_cu = 2;
    if (per_cu < 1) per_cu = 1;
    grid_blocks = cus * per_cu;
  }
  if (n_in != 23 || ws_size < WS_END || out_size != T_TOK * 1024) {
    fprintf(stderr, "kernel_launch: unexpected sizes n_in=%d ws=%zu (need %zu) out=%d\n", n_in, ws_size, (size_t)WS_END, out_size);
    return;
  }
  Params p{};
  for (int i = 0; i < 23; ++i) p.in[i] = (const float*)d_in[i];
  p.out = (float*)d_out;
  p.ws = (unsigned char*)d_ws;
  if (hipMemsetAsync((unsigned char*)d_ws + OFF_BAR, 0, 16384, stream) != hipSuccess) { fprintf(stderr, "kernel_launch: memset of control words failed\n"); return; }
#if MULTI_LAUNCH
  for (int ph = 0; ph < NPH; ++ph) {
    p.ph_lo = ph; p.ph_hi = ph;
    hipLaunchKernelGGL(hymba_mega, dim3(grid_blocks), dim3(256), 0, stream, p);
  }
#else
  p.ph_lo = 0; p.ph_hi = NPH - 1;
  void* args[] = {&p};
  hipError_t e = hipLaunchCooperativeKernel((void*)hymba_mega, dim3(grid_blocks), dim3(256), args, 0, stream);
  if (e != hipSuccess) fprintf(stderr, "cooperative launch failed: %s (grid %d)\n", hipGetErrorString(e), grid_blocks);
#endif
}
```

```cpp
#include <hip/hip_runtime.h>
#include <hip/hip_cooperative_groups.h>
#include <cstdio>
namespace cg = cooperative_groups;

#ifndef REP0
#define REP0 1
#endif
#ifndef REP1
#define REP1 1
#endif
#ifndef REP2
#define REP2 1
#endif
#ifndef REP3
#define REP3 1
#endif
#ifndef REP4
#define REP4 1
#endif
#ifndef MULTI_LAUNCH
#define MULTI_LAUNCH 0
#endif

typedef _Float16 h16;
typedef __attribute__((ext_vector_type(8))) _Float16 h16x8;
typedef __attribute__((ext_vector_type(4))) _Float16 h16x4;
typedef __attribute__((ext_vector_type(4))) float f32x4;
typedef __attribute__((ext_vector_type(2))) float v2f;

#define MFMA(a, b, c) __builtin_amdgcn_mfma_f32_16x16x32_f16((a), (b), (c), 0, 0, 0)

constexpr int T_TOK = 32768;
constexpr int SEQ = 2048;
constexpr int NPH = 8;
constexpr int LDP = 3072;
constexpr int SMEM_BYTES = 72704;

constexpr size_t SZ_WIN = (size_t)3200 * 1024 * 2;
constexpr size_t SZ_WGLU = (size_t)512 * 512 * 2;
constexpr size_t SZ_WOUT = (size_t)1024 * 1024 * 2;
constexpr size_t SZ_WPP = (size_t)1024 * 256 * 2;
constexpr size_t SZ_WGATE = (size_t)1024 * 1024 * 2;
constexpr size_t OFF_WIN = 0;
constexpr size_t OFF_WGLU = OFF_WIN + SZ_WIN;
constexpr size_t OFF_WOUT = OFF_WGLU + SZ_WGLU;
constexpr size_t OFF_WPP = OFF_WOUT + SZ_WOUT;
constexpr size_t OFF_WGATE = OFF_WPP + SZ_WPP;
constexpr size_t OFF_PB = OFF_WGATE + SZ_WGATE;
constexpr size_t OFF_PROJ = OFF_PB + (size_t)T_TOK * 256 * 2;
constexpr size_t OFF_AB = OFF_PROJ + (size_t)T_TOK * LDP * 2;
constexpr size_t OFF_KTAB = OFF_AB + (size_t)T_TOK * 8 * 4;
constexpr size_t OFF_ETAB = OFF_KTAB + (size_t)32 * 33 * 256 * 2;
constexpr size_t OFF_FTAB = OFF_ETAB + (size_t)32 * 128 * 512 * 2;
constexpr size_t OFF_ALPOW = OFF_FTAB + (size_t)32 * 512 * 128 * 2;
constexpr size_t OFF_DL = OFF_ALPOW + (size_t)32 * 64 * 2 * 4;
constexpr size_t OFF_EPART = OFF_DL + (size_t)2048 * 4;
constexpr size_t OFF_OPART = OFF_EPART + (size_t)T_TOK * 16 * 4;
constexpr size_t OFF_MIXIN = OFF_OPART + (size_t)T_TOK * 16 * 4;
constexpr size_t OFF_WP = OFF_MIXIN + (size_t)T_TOK * 1024 * 2;
constexpr size_t OFF_QGP = OFF_WP + (size_t)2048 * 64 * 128 * 2;
constexpr size_t OFF_KDT = OFF_QGP + (size_t)2048 * 64 * 128 * 2;
constexpr size_t OFF_UT = OFF_KDT + (size_t)2048 * 128 * 64 * 2;
constexpr size_t OFF_ATP = OFF_UT + (size_t)2048 * 128 * 64 * 2;
constexpr size_t OFF_EH = OFF_ATP + (size_t)2048 * 64 * 64 * 2;
constexpr size_t OFF_BAR = OFF_EH + (size_t)T_TOK * 1024 * 2;
constexpr size_t WS_END = OFF_BAR + 16384;
constexpr size_t OFF_CTR = OFF_BAR + 15360;
constexpr size_t OUT_OFF_A0 = 0;
constexpr size_t OUT_OFF_SF = 0;
constexpr size_t OUT_OFF_YPRE = (size_t)T_TOK * 1024 * 2;
constexpr size_t OUT_OFF_ZT = OUT_OFF_YPRE + (size_t)T_TOK * 512 * 2;

struct Params {
  const float* in[23];
  float* out;
  unsigned char* ws;
  int ph_lo, ph_hi;
};

enum { I_X = 0, I_P, I_NMG, I_WIN, I_ARE, I_AIM, I_BRE, I_BIM, I_CRE, I_CIM, I_D, I_LOGDT, I_WGLU, I_BGLU,
       I_CONVW, I_ALOG, I_DTB, I_DNG, I_WOUT, I_WPP, I_PLEG, I_WGATE, I_FING };

__device__ __forceinline__ float wave_sum(float v) {
#pragma unroll
  for (int o = 32; o > 0; o >>= 1) v += __shfl_xor(v, o);
  return v;
}
__device__ __forceinline__ float sum16(float v) {
  v += __shfl_xor(v, 1); v += __shfl_xor(v, 2); v += __shfl_xor(v, 4); v += __shfl_xor(v, 8);
  return v;
}
__device__ __forceinline__ float sigmoidf_(float x) { return 1.f / (1.f + __expf(-x)); }
__device__ __forceinline__ float siluf_(float x) { return x / (1.f + __expf(-x)); }
__device__ __forceinline__ float gelu_tanh(float y) {
  float z = 0.7978845608028654f * (y + 0.044715f * y * y * y);
  return 0.5f * y * (1.f + tanhf(z));
}
__device__ __forceinline__ h16x8 pack8(f32x4 lo, f32x4 hi) {
  h16x8 r;
  r[0] = (h16)lo[0]; r[1] = (h16)lo[1]; r[2] = (h16)lo[2]; r[3] = (h16)lo[3];
  r[4] = (h16)hi[0]; r[5] = (h16)hi[1]; r[6] = (h16)hi[2]; r[7] = (h16)hi[3];
  return r;
}
__device__ __forceinline__ int perm_pos(int n) { return (n & ~31) + (((n & 15) >> 2) << 3) + (((n >> 4) & 1) << 2) + (n & 3); }
__device__ __forceinline__ int perm_inv(int pos) {
  int q5 = pos & 31, qq = q5 >> 3, jj = q5 & 7;
  return (pos & ~31) + (jj < 4 ? 4 * qq + jj : 16 + 4 * qq + (jj - 4));
}

__device__ void transpose_w(const float* __restrict__ W, int K, int N, int Npad, h16* __restrict__ WT, int t, float* tile) {
  const int ntn = Npad / 64;
  const int kt = t / ntn, nt = t % ntn, k0 = kt * 64, n0 = nt * 64;
  const int tx = threadIdx.x & 63, ty = threadIdx.x >> 6;
  for (int r = 0; r < 16; ++r) {
    int k = ty * 16 + r, n = n0 + tx;
    tile[k * 65 + tx] = (n < N) ? W[(size_t)(k0 + k) * N + n] : 0.f;
  }
  __syncthreads();
  for (int r = 0; r < 16; ++r) {
    int n = ty * 16 + r;
    WT[(size_t)(n0 + n) * K + k0 + tx] = (h16)tile[tx * 65 + n];
  }
  __syncthreads();
}

__device__ void ssm_table_item(const Params& p, int g, int d, float* lds) {
  float2* sAp = (float2*)lds;
  float2* sW = sAp + 64;
  const int tid = threadIdx.x;
  h16* KTAB = (h16*)(p.ws + OFF_KTAB);
  h16* ETAB = (h16*)(p.ws + OFF_ETAB);
  h16* FTAB = (h16*)(p.ws + OFF_FTAB);
  float* ALPOW = (float*)(p.ws + OFF_ALPOW);
  float* sBr = lds + 256; float* sBi = sBr + 1024; float* sCr = sBi + 1024; float* sCi = sCr + 16 * 65;
  {
    const float4 vbr = ((const float4*)(p.in[I_BRE] + g * 1024))[tid], vbi = ((const float4*)(p.in[I_BIM] + g * 1024))[tid];
    const float4 vcr = ((const float4*)(p.in[I_CRE] + g * 1024))[tid], vci = ((const float4*)(p.in[I_CIM] + g * 1024))[tid];
    *(float4*)(sBr + tid * 4) = vbr; *(float4*)(sBi + tid * 4) = vbi;
    const int ch = (tid * 4) >> 6, cp = (tid * 4) & 63;
    sCr[ch * 65 + cp] = vcr.x; sCr[ch * 65 + cp + 1] = vcr.y; sCr[ch * 65 + cp + 2] = vcr.z; sCr[ch * 65 + cp + 3] = vcr.w;
    sCi[ch * 65 + cp] = vci.x; sCi[ch * 65 + cp + 1] = vci.y; sCi[ch * 65 + cp + 2] = vci.z; sCi[ch * 65 + cp + 3] = vci.w;
  }
  if (tid < 64) {
    const int pp = tid;
    float lr = p.in[I_ARE][g * 64 + pp], li = p.in[I_AIM][g * 64 + pp], dt = expf(p.in[I_LOGDT][g]);
    float mag = expf(lr * dt), ang = li * dt;
    float abr = mag * cosf(ang), abi = mag * sinf(ang);
    float nr = abr - 1.f, ni = abi, den = lr * lr + li * li;
    float cr = (nr * lr + ni * li) / den, ci = (ni * lr - nr * li) / den;
    float apr = 1.f, api = 0.f;
    for (int k = 0; k < d; ++k) { float t0 = apr * abr - api * abi; api = apr * abi + api * abr; apr = t0; }
    sAp[pp] = make_float2(apr, api);
    sW[pp] = make_float2(apr * cr - api * ci, apr * ci + api * cr);
    if (d == 32) { ALPOW[(g * 64 + pp) * 2] = apr; ALPOW[(g * 64 + pp) * 2 + 1] = api; }
  }
  __syncthreads();
  if (d < 32) {
    {
      const int h = tid >> 4, hp = tid & 15;
      float acc = 0.f;
#pragma unroll 8
      for (int pp = 0; pp < 64; ++pp) {
        float2 W = sW[pp];
        float br = sBr[pp * 16 + hp], bi = sBi[pp * 16 + hp];
        float wbr = W.x * br - W.y * bi, wbi = W.x * bi + W.y * br;
        float cr = sCr[h * 65 + pp], ci = sCi[h * 65 + pp];
        acc += cr * wbr - ci * wbi;
      }
      KTAB[(size_t)(g * 33 + d + 1) * 256 + h * 16 + hp] = (h16)acc;
      if (d == 0) KTAB[(size_t)(g * 33) * 256 + tid] = (h16)0.f;
    }
    {
      const int i = 31 - d;
#pragma unroll
      for (int r = 0; r < 4; ++r) {
        int idx = tid + 256 * r, pp = idx >> 4, hp = idx & 15;
        float2 W = sW[pp];
        float br = sBr[pp * 16 + hp], bi = sBi[pp * 16 + hp];
        float wbr = W.x * br - W.y * bi, wbi = W.x * bi + W.y * br;
        ETAB[((size_t)g * 128 + pp) * 512 + i * 16 + hp] = (h16)wbr;
        ETAB[((size_t)g * 128 + 64 + pp) * 512 + i * 16 + hp] = (h16)wbi;
      }
    }
  }
  if (d >= 1) {
    const int j = d - 1;
#pragma unroll
    for (int r = 0; r < 4; ++r) {
      int idx = tid + 256 * r, h = idx >> 6, pp = idx & 63;
      float2 Ap = sAp[pp];
      float cr = sCr[h * 65 + pp], ci = sCi[h * 65 + pp];
      float re = cr * Ap.x - ci * Ap.y, im = cr * Ap.y + ci * Ap.x;
      FTAB[((size_t)g * 512 + j * 16 + h) * 128 + pp] = (h16)re;
      FTAB[((size_t)g * 512 + j * 16 + h) * 128 + 64 + pp] = (h16)(-im);
    }
  }
  __syncthreads();
}

__device__ void phase0(const Params& p, unsigned char* smem) {
  const int bid = blockIdx.x, nb = gridDim.x, tid = threadIdx.x, wid = tid >> 6, lane = tid & 63;
  float* tile = (float*)smem;
  for (int t = bid; t < 1440; t += nb) {
    if (t < 800) transpose_w(p.in[I_WIN], 1024, 3080, 3200, (h16*)(p.ws + OFF_WIN), t, tile);
    else if (t < 864) transpose_w(p.in[I_WGLU], 512, 512, 512, (h16*)(p.ws + OFF_WGLU), t - 800, tile);
    else if (t < 1120) transpose_w(p.in[I_WOUT], 1024, 1024, 1024, (h16*)(p.ws + OFF_WOUT), t - 864, tile);
    else if (t < 1184) transpose_w(p.in[I_WPP], 256, 1024, 1024, (h16*)(p.ws + OFF_WPP), t - 1120, tile);
    else transpose_w(p.in[I_WGATE], 1024, 1024, 1024, (h16*)(p.ws + OFF_WGATE), t - 1184, tile);
  }
  for (int it = bid; it < 32 * 33; it += nb) ssm_table_item(p, it / 33, it % 33, (float*)smem);
  {
    h16* A0 = (h16*)((unsigned char*)p.out + OUT_OFF_A0);
    const float* x = p.in[I_X];
    const float4* g4 = (const float4*)p.in[I_NMG];
    for (int row = bid * 4 + wid; row < T_TOK; row += nb * 4) {
      const float4* xr = (const float4*)(x + (size_t)row * 1024);
      float4 v[4];
      float ss = 0.f;
#pragma unroll
      for (int i = 0; i < 4; ++i) {
        v[i] = xr[lane + i * 64];
        ss += v[i].x * v[i].x + v[i].y * v[i].y + v[i].z * v[i].z + v[i].w * v[i].w;
      }
      ss = wave_sum(ss);
      float rstd = rsqrtf(ss * (1.f / 1024.f) + 1e-6f);
#pragma unroll
      for (int i = 0; i < 4; ++i) {
        float4 g = g4[lane + i * 64];
        h16x4 o;
        o[0] = (h16)(v[i].x * rstd * g.x); o[1] = (h16)(v[i].y * rstd * g.y);
        o[2] = (h16)(v[i].z * rstd * g.z); o[3] = (h16)(v[i].w * rstd * g.w);
        *(h16x4*)(A0 + (size_t)row * 1024 + (lane + i * 64) * 4) = o;
      }
    }
  }
  {
    h16* PB = (h16*)(p.ws + OFF_PB);
    const float4* p4 = (const float4*)p.in[I_P];
    const size_t n4 = (size_t)T_TOK * 256 / 4;
    for (size_t i = (size_t)bid * 256 + tid; i < n4; i += (size_t)nb * 256) {
      float4 v = p4[i];
      h16x4 o;
      o[0] = (h16)v.x; o[1] = (h16)v.y; o[2] = (h16)v.z; o[3] = (h16)v.w;
      *(h16x4*)(PB + i * 4) = o;
    }
  }
}

enum { EPI_PROJ = 0, EPI_GLU, EPI_PLE, EPI_OUT, EPI_GATE };

template <int EPI>
__device__ __forceinline__ void gemm_tile(const Params& p, const h16* __restrict__ A, int lda, const h16* __restrict__ Bt, int ldb,
                                          int K, int brow, int bcol, unsigned char* smem) {
  const int tid = threadIdx.x, wid = tid >> 6, lane = tid & 63, wr = wid >> 1, wc = wid & 1, fr = lane & 15, fq = lane >> 4;
  f32x4 acc[4][4];
#pragma unroll
  for (int m = 0; m < 4; ++m)
#pragma unroll
    for (int n = 0; n < 4; ++n) acc[m][n] = f32x4{0.f, 0.f, 0.f, 0.f};
  const int nk = K / 64;
  const h16* ga[4]; const h16* gb[4];
#pragma unroll
  for (int i = 0; i < 4; ++i) {
    const int L = tid + 256 * i, row = L >> 3, cs = (L & 7) ^ (row & 7);
    ga[i] = A + (size_t)(brow + row) * lda + cs * 8;
    gb[i] = Bt + (size_t)(bcol + row) * ldb + cs * 8;
  }
#define GEMM_STAGE(t_, buf_) do { \
    unsigned char* sa_ = smem + (buf_) * 32768 + tid * 16; \
    _Pragma("unroll") for (int i_ = 0; i_ < 4; ++i_) { \
      __builtin_amdgcn_global_load_lds((const unsigned*)(ga[i_] + (t_) * 64), (unsigned*)(sa_ + i_ * 4096), 16, 0, 0); \
      __builtin_amdgcn_global_load_lds((const unsigned*)(gb[i_] + (t_) * 64), (unsigned*)(sa_ + 16384 + i_ * 4096), 16, 0, 0); \
    } \
  } while (0)
  GEMM_STAGE(0, 0);
  for (int t = 0; t < nk; ++t) {
    asm volatile("s_waitcnt vmcnt(0)" ::: "memory");
    __syncthreads();
    if (t + 1 < nk) GEMM_STAGE(t + 1, (t + 1) & 1);
    const unsigned char* SA = smem + (t & 1) * 32768;
    const unsigned char* SB = SA + 16384;
#pragma unroll
    for (int kk = 0; kk < 2; ++kk) {
      h16x8 af[4], bf[4];
      const int pos = ((kk * 4 + fq) ^ (fr & 7)) << 4;
#pragma unroll
      for (int m = 0; m < 4; ++m) {
        af[m] = *(const h16x8*)(SA + (wr * 64 + m * 16 + fr) * 128 + pos);
        bf[m] = *(const h16x8*)(SB + (wc * 64 + m * 16 + fr) * 128 + pos);
      }
#pragma unroll
      for (int m = 0; m < 4; ++m)
#pragma unroll
        for (int n = 0; n < 4; ++n) acc[m][n] = MFMA(af[m], bf[n], acc[m][n]);
    }
  }
#undef GEMM_STAGE
  __syncthreads();
  float* CT = (float*)smem;
#pragma unroll
  for (int m = 0; m < 4; ++m)
#pragma unroll
    for (int n = 0; n < 4; ++n)
#pragma unroll
      for (int j = 0; j < 4; ++j) CT[(wr * 64 + m * 16 + fq * 4 + j) * 132 + wc * 64 + n * 16 + fr] = acc[m][n][j];
  __syncthreads();
  const int c4 = tid & 31;
#pragma unroll 2
  for (int it = 0; it < 16; ++it) {
    const int rl = it * 8 + (tid >> 5);
    const size_t row = (size_t)brow + rl;
    const int col = bcol + c4 * 4;
    const float4 v = *(const float4*)(CT + rl * 132 + c4 * 4);
    if constexpr (EPI == EPI_PROJ) {
      if (bcol < 3072) {
        h16x4 o; o[0] = (h16)v.x; o[1] = (h16)v.y; o[2] = (h16)v.z; o[3] = (h16)v.w;
        *(h16x4*)((h16*)(p.ws + OFF_PROJ) + row * LDP + col) = o;
      } else if (c4 < 2) {
        *(float4*)((float*)(p.ws + OFF_AB) + row * 8 + c4 * 4) = v;
      }
    } else if constexpr (EPI == EPI_GLU) {
      const h16x4 y = *(const h16x4*)((const h16*)((unsigned char*)p.out + OUT_OFF_YPRE) + row * 512 + col);
      const h16x4 z = *(const h16x4*)((const h16*)(p.ws + OFF_PROJ) + row * LDP + 512 + col);
      const float4 bb = *(const float4*)(p.in[I_BGLU] + col);
      h16x4 o;
      o[0] = (h16)((float)y[0] * sigmoidf_(v.x + bb.x) * siluf_((float)z[0]));
      o[1] = (h16)((float)y[1] * sigmoidf_(v.y + bb.y) * siluf_((float)z[1]));
      o[2] = (h16)((float)y[2] * sigmoidf_(v.z + bb.z) * siluf_((float)z[2]));
      o[3] = (h16)((float)y[3] * sigmoidf_(v.w + bb.w) * siluf_((float)z[3]));
      *(h16x4*)((h16*)(p.ws + OFF_MIXIN) + row * 1024 + col) = o;
    } else if constexpr (EPI == EPI_PLE) {
      h16x4 o; o[0] = (h16)v.x; o[1] = (h16)v.y; o[2] = (h16)v.z; o[3] = (h16)v.w;
      *(h16x4*)((h16*)(p.ws + OFF_EH) + row * 1024 + col) = o;
      float s = v.x * v.x + v.y * v.y + v.z * v.z + v.w * v.w;
      s = sum16(s); s += __shfl_xor(s, 16);
      if (c4 == 0) ((float*)(p.ws + OFF_EPART))[row * 8 + (bcol >> 7)] = s;
    } else if constexpr (EPI == EPI_OUT) {
      const float4 xv = *(const float4*)(p.in[I_X] + row * 1024 + col);
      float4 hv; hv.x = xv.x + v.x; hv.y = xv.y + v.y; hv.z = xv.z + v.z; hv.w = xv.w + v.w;
      *(float4*)(p.out + row * 1024 + col) = hv;
      h16x4 o; o[0] = (h16)hv.x; o[1] = (h16)hv.y; o[2] = (h16)hv.z; o[3] = (h16)hv.w;
      *(h16x4*)((h16*)(p.ws + OFF_PROJ) + row * 1024 + col) = o;
    } else if constexpr (EPI == EPI_GATE) {
      const float4 e0 = *(const float4*)((const float*)(p.ws + OFF_EPART) + row * 8);
      const float4 e1 = *(const float4*)((const float*)(p.ws + OFF_EPART) + row * 8 + 4);
      const float rs = rsqrtf((e0.x + e0.y + e0.z + e0.w + e1.x + e1.y + e1.z + e1.w) * (1.f / 1024.f) + 1e-6f);
      const h16x4 eh = *(const h16x4*)((const h16*)(p.ws + OFF_EH) + row * 1024 + col);
      const float4 pg = *(const float4*)(p.in[I_PLEG] + col);
      float4 hv = *(const float4*)(p.out + row * 1024 + col);
      hv.x += sigmoidf_(v.x) * ((float)eh[0] * rs * pg.x);
      hv.y += sigmoidf_(v.y) * ((float)eh[1] * rs * pg.y);
      hv.z += sigmoidf_(v.z) * ((float)eh[2] * rs * pg.z);
      hv.w += sigmoidf_(v.w) * ((float)eh[3] * rs * pg.w);
      *(float4*)(p.out + row * 1024 + col) = hv;
      float s = hv.x * hv.x + hv.y * hv.y + hv.z * hv.z + hv.w * hv.w;
      s = sum16(s); s += __shfl_xor(s, 16);
      if (c4 == 0) ((float*)(p.ws + OFF_OPART))[row * 8 + (bcol >> 7)] = s;
    }
  }
  __syncthreads();
}

__device__ void ssm_item(const Params& p, int b, int g, unsigned char* smem) {
  float* LOCAL = (float*)smem;
  h16* SPREV = (h16*)(smem + 33792);
  h16* KT = (h16*)(smem + 51200);
  int tid_ = threadIdx.x;
  asm volatile("" : "+v"(tid_));
  const int tid = tid_, w = tid >> 6, lane = tid & 63, fr = lane & 15, fq = lane >> 4;
  const h16* PROJ = (const h16*)(p.ws + OFF_PROJ);
  const h16* Eg = (const h16*)(p.ws + OFF_ETAB) + (size_t)g * 128 * 512;
  const h16* Kg = (const h16*)(p.ws + OFF_KTAB) + (size_t)g * 33 * 256;
  const h16* Fg = (const h16*)(p.ws + OFF_FTAB) + (size_t)g * 512 * 128;
  const float* ALPOW = (const float*)(p.ws + OFF_ALPOW);
  h16* YPRE = (h16*)((unsigned char*)p.out + OUT_OFF_YPRE);
  const int nchunk = w * 16 + fr;
  const size_t tok0 = (size_t)b * SEQ + (size_t)nchunk * 32;
  for (int idx = tid; idx < 33 * 256 / 8; idx += 256) *(h16x8*)(KT + idx * 8) = *(const h16x8*)(Kg + idx * 8);
  h16x8 uf[16];
#pragma unroll
  for (int ks = 0; ks < 16; ++ks) {
    const int i = 2 * ks + (fq >> 1);
    uf[ks] = *(const h16x8*)(PROJ + (tok0 + i) * LDP + g * 16 + (fq & 1) * 8);
  }
  {
    h16x8 ea[8];
#pragma unroll
    for (int ks = 0; ks < 8; ++ks) ea[ks] = *(const h16x8*)(Eg + (size_t)fr * 512 + ks * 32 + fq * 8);
    f32x4 acc = {0.f, 0.f, 0.f, 0.f};
#pragma unroll 1
    for (int it = 0; it < 16; ++it) {
      const int mt = it >> 1, hf = it & 1;
      const int itn = it < 15 ? it + 1 : 15;
      h16x8 en[8];
#pragma unroll
      for (int ks = 0; ks < 8; ++ks) en[ks] = *(const h16x8*)(Eg + (size_t)((itn >> 1) * 16 + fr) * 512 + ((itn & 1) * 8 + ks) * 32 + fq * 8);
      if (hf == 0) {
#pragma unroll
        for (int ks = 0; ks < 8; ++ks) acc = MFMA(ea[ks], uf[ks], acc);
      } else {
#pragma unroll
        for (int ks = 0; ks < 8; ++ks) acc = MFMA(ea[ks], uf[8 + ks], acc);
        *(f32x4*)(LOCAL + nchunk * 132 + mt * 16 + fq * 4) = acc;
        acc = f32x4{0.f, 0.f, 0.f, 0.f};
      }
#pragma unroll
      for (int ks = 0; ks < 8; ++ks) ea[ks] = en[ks];
    }
  }
  __syncthreads();
  if (tid < 64) {
    const int pp = tid;
    const float ar = ALPOW[(g * 64 + pp) * 2], ai = ALPOW[(g * 64 + pp) * 2 + 1];
    float sr = 0.f, si = 0.f;
#pragma unroll 4
    for (int c = 0; c < 64; ++c) {
      SPREV[c * 136 + pp] = (h16)sr;
      SPREV[c * 136 + 64 + pp] = (h16)si;
      float lr = LOCAL[c * 132 + pp], li = LOCAL[c * 132 + 64 + pp];
      float nr = ar * sr - ai * si + lr;
      float ni = ar * si + ai * sr + li;
      sr = nr; si = ni;
    }
  }
  __syncthreads();
  h16x8 sf[4];
#pragma unroll
  for (int ks = 0; ks < 4; ++ks) sf[ks] = *(const h16x8*)(SPREV + nchunk * 136 + ks * 32 + fq * 8);
  const float4 Dv = *(const float4*)(p.in[I_D] + g * 16 + fq * 4);
  h16x8 fa[4];
#pragma unroll
  for (int ks = 0; ks < 4; ++ks) fa[ks] = *(const h16x8*)(Fg + (size_t)fr * 128 + ks * 32 + fq * 8);
  h16x4 u4 = *(const h16x4*)(PROJ + tok0 * LDP + g * 16 + fq * 4);
#pragma unroll 1
  for (int j = 0; j < 32; ++j) {
    const int jn = j < 31 ? j + 1 : 31;
    h16x8 fn[4];
#pragma unroll
    for (int ks = 0; ks < 4; ++ks) fn[ks] = *(const h16x8*)(Fg + (size_t)(jn * 16 + fr) * 128 + ks * 32 + fq * 8);
    const h16x4 un = *(const h16x4*)(PROJ + (tok0 + jn) * LDP + g * 16 + fq * 4);
    f32x4 acc = {0.f, 0.f, 0.f, 0.f};
#pragma unroll
    for (int ks = 0; ks < 16; ++ks) {
      if (2 * ks <= j) {
        const int dd = j - 2 * ks - (fq >> 1) + 1;
        h16x8 a = *(const h16x8*)(KT + dd * 256 + fr * 16 + (fq & 1) * 8);
        acc = MFMA(a, uf[ks], acc);
      }
    }
#pragma unroll
    for (int ks = 0; ks < 4; ++ks) acc = MFMA(fa[ks], sf[ks], acc);
    const size_t tok = tok0 + j;
    h16x4 o;
    o[0] = (h16)gelu_tanh(acc[0] + Dv.x * (float)u4[0]);
    o[1] = (h16)gelu_tanh(acc[1] + Dv.y * (float)u4[1]);
    o[2] = (h16)gelu_tanh(acc[2] + Dv.z * (float)u4[2]);
    o[3] = (h16)gelu_tanh(acc[3] + Dv.w * (float)u4[3]);
    *(h16x4*)(YPRE + tok * 512 + g * 16 + fq * 4) = o;
#pragma unroll
    for (int ks = 0; ks < 4; ++ks) fa[ks] = fn[ks];
    u4 = un;
  }
  __syncthreads();
}

__device__ void gdn_pre_item(const Params& p, int item, unsigned char* smem) {
  h16* QH = (h16*)smem;
  h16* KH = (h16*)(smem + 17408);
  h16* VH = (h16*)(smem + 34816);
  float* LT = (float*)(smem + 52224);
  float* sG = (float*)(smem + 69632);
  float* sBeta = (float*)(smem + 69888);
  float* sEG = (float*)(smem + 70144);
  float* sBG = (float*)(smem + 70400);
  float* sEL = (float*)(smem + 70656);
  int tid_ = threadIdx.x;
  asm volatile("" : "+v"(tid_));
  const int tid = tid_, w = tid >> 6, lane = tid & 63, fr = lane & 15, fq = lane >> 4;
  const int c = item & 31, h = (item >> 5) & 3, b = item >> 7;
  const h16* PROJ = (const h16*)(p.ws + OFF_PROJ);
  const float* AB = (const float*)(p.ws + OFF_AB);
  const float* convw = p.in[I_CONVW];
  h16* WPi = (h16*)(p.ws + OFF_WP) + (size_t)item * 64 * 128;
  h16* QGPi = (h16*)(p.ws + OFF_QGP) + (size_t)item * 64 * 128;
  h16* KDTi = (h16*)(p.ws + OFF_KDT) + (size_t)item * 128 * 64;
  h16* UTi = (h16*)(p.ws + OFF_UT) + (size_t)item * 128 * 64;
  h16* ATPi = (h16*)(p.ws + OFF_ATP) + (size_t)item * 64 * 64;
  h16* ZTi = (h16*)((unsigned char*)p.out + OUT_OFF_ZT) + (size_t)item * 128 * 64;
  float* DL = (float*)(p.ws + OFF_DL);
  {
    const int ch0 = (tid & 15) * 8, t0 = (tid >> 4) * 4;
#pragma unroll 1
    for (int sec = 0; sec < 3; ++sec) {
      const int colbase = 1024 + sec * 512 + h * 128 + ch0;
      h16x8 xr[7];
#pragma unroll
      for (int i = 0; i < 7; ++i) {
        const int ts = c * 64 + t0 - 3 + i;
        h16x8 z8 = {(h16)0.f, (h16)0.f, (h16)0.f, (h16)0.f, (h16)0.f, (h16)0.f, (h16)0.f, (h16)0.f};
        xr[i] = (ts >= 0) ? *(const h16x8*)(PROJ + ((size_t)b * SEQ + ts) * LDP + colbase) : z8;
      }
      float4 wv[4][2];
#pragma unroll
      for (int jj = 0; jj < 4; ++jj) {
        wv[jj][0] = *(const float4*)(convw + jj * 1536 + sec * 512 + h * 128 + ch0);
        wv[jj][1] = *(const float4*)(convw + jj * 1536 + sec * 512 + h * 128 + ch0 + 4);
      }
      h16* dst = (sec == 0 ? QH : (sec == 1 ? KH : VH));
#pragma unroll
      for (int tt = 0; tt < 4; ++tt) {
        float a[8];
#pragma unroll
        for (int e = 0; e < 8; ++e) a[e] = 0.f;
#pragma unroll
        for (int jj = 0; jj < 4; ++jj) {
          const h16x8 xv = xr[tt + jj];
          a[0] += wv[jj][0].x * (float)xv[0]; a[1] += wv[jj][0].y * (float)xv[1]; a[2] += wv[jj][0].z * (float)xv[2]; a[3] += wv[jj][0].w * (float)xv[3];
          a[4] += wv[jj][1].x * (float)xv[4]; a[5] += wv[jj][1].y * (float)xv[5]; a[6] += wv[jj][1].z * (float)xv[6]; a[7] += wv[jj][1].w * (float)xv[7];
        }
        float ss = 0.f;
#pragma unroll
        for (int e = 0; e < 8; ++e) { a[e] = siluf_(a[e]); ss += a[e] * a[e]; }
        float scale = 1.f;
        if (sec < 2) {
          ss = sum16(ss);
          scale = rsqrtf(ss + 1e-6f) * (sec == 0 ? 0.08838834764831845f : 1.f);
        }
        h16x8 o;
#pragma unroll
        for (int e = 0; e < 8; ++e) o[e] = (h16)(a[e] * scale);
        *(h16x8*)(dst + (t0 + tt) * 136 + ch0) = o;
      }
    }
  }
  if (tid < 64) {
    const size_t tok = (size_t)b * SEQ + c * 64 + tid;
    float braw = AB[tok * 8 + h], araw = AB[tok * 8 + 4 + h];
    float beta = 1.f / (1.f + expf(-braw));
    float xx = araw + p.in[I_DTB][h];
    float sp = xx > 20.f ? xx : log1pf(expf(xx));
    float gg = -expf(p.in[I_ALOG][h]) * sp;
#pragma unroll
    for (int o = 1; o < 64; o <<= 1) {
      float v = __shfl_up(gg, o);
      if (lane >= o) gg += v;
    }
    sG[tid] = gg;
    sBeta[tid] = beta;
    const float eg = expf(gg);
    sEG[tid] = eg;
    sBG[tid] = beta * eg;
    sEL[tid] = expf(__shfl(gg, 63) - gg);
  }
  __syncthreads();
  {
    h16x8 ak[4], aq[4];
#pragma unroll
    for (int ks = 0; ks < 4; ++ks) {
      ak[ks] = *(const h16x8*)(KH + (w * 16 + fr) * 136 + ks * 32 + fq * 8);
      aq[ks] = *(const h16x8*)(QH + (w * 16 + fr) * 136 + ks * 32 + fq * 8);
    }
#pragma unroll
    for (int jt = 0; jt < 4; ++jt) {
      const int j = jt * 16 + fr;
      const int pj = perm_pos(j);
      if (jt <= w) {
        f32x4 kk = {0.f, 0.f, 0.f, 0.f}, qk = {0.f, 0.f, 0.f, 0.f};
#pragma unroll
        for (int ks = 0; ks < 4; ++ks) {
          h16x8 bk = *(const h16x8*)(KH + (jt * 16 + fr) * 136 + ks * 32 + fq * 8);
          kk = MFMA(ak[ks], bk, kk);
          qk = MFMA(aq[ks], bk, qk);
        }
        const float Gj = sG[j];
        f32x4 lt;
#pragma unroll
        for (int r = 0; r < 4; ++r) {
          const int i = w * 16 + 4 * fq + r;
          const float e = (i >= j) ? expf(sG[i] - Gj) : 0.f;
          lt[r] = (i > j) ? sBeta[i] * kk[r] * e : 0.f;
          ATPi[i * 64 + (((pj >> 3) ^ (i & 7)) << 3) + (pj & 7)] = (h16)(qk[r] * e);
        }
        *(f32x4*)(LT + j * 68 + w * 16 + 4 * fq) = lt;
      } else {
#pragma unroll
        for (int r = 0; r < 4; ++r) {
          const int i = w * 16 + 4 * fq + r;
          ATPi[i * 64 + (((pj >> 3) ^ (i & 7)) << 3) + (pj & 7)] = (h16)0.f;
        }
      }
    }
  }
  __syncthreads();
  v2f r2[32];
  if (tid < 128) {
#pragma unroll
    for (int t = 0; t < 32; ++t) {
      r2[t][0] = (float)VH[(2 * t) * 136 + tid] * sBeta[2 * t];
      r2[t][1] = (float)VH[(2 * t + 1) * 136 + tid] * sBeta[2 * t + 1];
    }
  } else {
#pragma unroll
    for (int t = 0; t < 32; ++t) {
      r2[t][0] = (float)KH[(2 * t) * 136 + (tid - 128)] * sBG[2 * t];
      r2[t][1] = (float)KH[(2 * t + 1) * 136 + (tid - 128)] * sBG[2 * t + 1];
    }
  }
#pragma unroll
  for (int j = 0; j < 63; ++j) {
    const float xj = r2[j >> 1][j & 1];
    const v2f xx = {xj, xj};
#pragma unroll
    for (int i4 = (j + 1) / 4; i4 < 16; ++i4) {
      const f32x4 l = *(const f32x4*)(LT + j * 68 + i4 * 4);
      const v2f l0 = {l[0], l[1]}, l1 = {l[2], l[3]};
      if (i4 * 4 > j) r2[2 * i4] -= l0 * xx;
      else { if (i4 * 4 + 0 > j) r2[2 * i4][0] -= l[0] * xj; if (i4 * 4 + 1 > j) r2[2 * i4][1] -= l[1] * xj; }
      if (i4 * 4 + 2 > j) r2[2 * i4 + 1] -= l1 * xx;
      else { if (i4 * 4 + 3 > j) r2[2 * i4 + 1][1] -= l[3] * xj; }
    }
    __builtin_amdgcn_sched_barrier(0);
  }
  if (tid < 128) {
#pragma unroll
    for (int t8 = 0; t8 < 8; ++t8) {
      h16x8 v;
#pragma unroll
      for (int e = 0; e < 8; ++e) v[e] = (h16)r2[(t8 * 8 + e) >> 1][e & 1];
      *(h16x8*)(UTi + (size_t)tid * 64 + t8 * 8) = v;
    }
  }
  __syncthreads();
  if (tid >= 128) {
    const int pos = perm_pos(tid - 128);
#pragma unroll
    for (int t = 0; t < 64; ++t) VH[t * 136 + pos] = (h16)r2[t >> 1][t & 1];
  }
  __syncthreads();
  for (int rr = 0; rr < 4; ++rr) {
    const int idx = tid + 256 * rr, row = idx >> 4, seg = idx & 15;
    *(h16x8*)(WPi + row * 128 + ((seg ^ (row & 15)) << 3)) = *(const h16x8*)(VH + row * 136 + seg * 8);
  }
  {
    const int dv = tid & 127, th = tid >> 7;
    const float gdv = p.in[I_DNG][dv];
    const h16* zp = PROJ + ((size_t)b * SEQ + c * 64 + th * 32) * LDP + 2560 + h * 128 + dv;
    h16 zv[32];
#pragma unroll
    for (int t = 0; t < 32; ++t) zv[t] = zp[(size_t)t * LDP];
#pragma unroll
    for (int t8 = 0; t8 < 4; ++t8) {
      h16x8 v;
#pragma unroll
      for (int e = 0; e < 8; ++e) v[e] = (h16)(siluf_((float)zv[t8 * 8 + e]) * gdv);
      *(h16x8*)(ZTi + (size_t)dv * 64 + th * 32 + t8 * 8) = v;
    }
  }
#pragma unroll 2
  for (int rr = 0; rr < 4; ++rr) {
    const int idx = tid + 256 * rr, t = idx >> 4, cpos = idx & 15, ks = cpos >> 2, q = cpos & 3;
    const h16x4 lo = *(const h16x4*)(QH + t * 136 + ks * 32 + 4 * q);
    const h16x4 hi = *(const h16x4*)(QH + t * 136 + ks * 32 + 16 + 4 * q);
    const float sc = sEG[t];
    h16x8 o;
#pragma unroll
    for (int e = 0; e < 4; ++e) { o[e] = (h16)((float)lo[e] * sc); o[4 + e] = (h16)((float)hi[e] * sc); }
    *(h16x8*)(QGPi + t * 128 + ((cpos ^ (t & 15)) << 3)) = o;
  }
#pragma unroll 2
  for (int rr = 0; rr < 4; ++rr) {
    const int idx = tid + 256 * rr, dk = idx >> 3, cpos = idx & 7, k2 = cpos >> 2, q = cpos & 3;
    h16x8 o;
#pragma unroll
    for (int e = 0; e < 8; ++e) {
      const int t = k2 * 32 + (e < 4 ? 4 * q + e : 16 + 4 * q + (e - 4));
      o[e] = (h16)((float)KH[t * 136 + dk] * sEL[t]);
    }
    *(h16x8*)(KDTi + dk * 64 + ((cpos ^ (dk & 7)) << 3)) = o;
  }
  const float Glast = sG[63];
  if (tid == 0) DL[item] = expf(Glast);
  __syncthreads();
}

template <int NB>
__device__ __forceinline__ void glds_copy(const h16* __restrict__ g, unsigned char* l) {
#pragma unroll
  for (int i = 0; i < NB / 4096; ++i) {
    const int off = threadIdx.x * 16 + i * 4096;
    __builtin_amdgcn_global_load_lds((const unsigned*)((const unsigned char*)g + off), (unsigned*)(l + off), 16, 0, 0);
  }
}
#define RAW_BARRIER() do { asm volatile("s_waitcnt lgkmcnt(0)" ::: "memory"); __builtin_amdgcn_s_barrier(); asm volatile("" ::: "memory"); } while (0)

__device__ void gdn_chain(const Params& p, int bh, unsigned char* smem) {
  const int tid = threadIdx.x, w = tid >> 6, lane = tid & 63, fr = lane & 15, fq = lane >> 4;
  const float* DL = (const float*)(p.ws + OFF_DL);
  const h16* WPb = (const h16*)(p.ws + OFF_WP) + (size_t)bh * 32 * 64 * 128;
  const h16* KDTb = (const h16*)(p.ws + OFF_KDT) + (size_t)bh * 32 * 128 * 64;
  h16* UTb = (h16*)(p.ws + OFF_UT) + (size_t)bh * 32 * 128 * 64;
  h16* SFb = (h16*)((unsigned char*)p.out + OUT_OFF_SF) + (size_t)bh * 32 * 128 * 128;
  f32x4 S[8][2];
#pragma unroll
  for (int i = 0; i < 8; ++i) { S[i][0] = f32x4{0.f, 0.f, 0.f, 0.f}; S[i][1] = f32x4{0.f, 0.f, 0.f, 0.f}; }
  h16x4 uR[4][2];
  glds_copy<16384>(WPb, smem); glds_copy<16384>(KDTb, smem + 16384);
#pragma unroll
  for (int mt = 0; mt < 4; ++mt)
#pragma unroll
    for (int nt = 0; nt < 2; ++nt)
      uR[mt][nt] = *(const h16x4*)(UTb + (size_t)(w * 32 + nt * 16 + fr) * 64 + mt * 16 + fq * 4);
  asm volatile("s_waitcnt vmcnt(0)" ::: "memory");
  RAW_BARRIER();
  for (int c = 0; c < 32; ++c) {
    const int item = bh * 32 + c;
    const float dl = DL[item];
    const int cn = (c + 1 < 32) ? c + 1 : c;
    const unsigned char* LW = smem + (c & 1) * 32768;
    const unsigned char* LK = LW + 16384;
    unsigned char* LWn = smem + ((c + 1) & 1) * 32768;
    h16x8 sfr[4][2];
#pragma unroll
    for (int ks = 0; ks < 4; ++ks) { sfr[ks][0] = pack8(S[2 * ks][0], S[2 * ks + 1][0]); sfr[ks][1] = pack8(S[2 * ks][1], S[2 * ks + 1][1]); }
#pragma unroll
    for (int ks = 0; ks < 4; ++ks)
#pragma unroll
      for (int nt = 0; nt < 2; ++nt)
        *(h16x8*)(SFb + ((size_t)(c * 4 + ks) * 8 + w * 2 + nt) * 512 + lane * 8) = sfr[ks][nt];
    asm volatile("" ::: "memory");
    glds_copy<16384>(WPb + (size_t)cn * 64 * 128, LWn);
    glds_copy<16384>(KDTb + (size_t)cn * 128 * 64, LWn + 16384);
    asm volatile("" ::: "memory");
    f32x4 vn[4][2];
#pragma unroll
    for (int mt = 0; mt < 4; ++mt) { vn[mt][0] = f32x4{0.f, 0.f, 0.f, 0.f}; vn[mt][1] = vn[mt][0]; }
#pragma unroll
    for (int ks = 0; ks < 4; ++ks)
#pragma unroll
      for (int mt = 0; mt < 4; ++mt) {
        h16x8 aw = *(const h16x8*)(LW + (mt * 16 + fr) * 256 + (((ks * 4 + fq) ^ fr) << 4));
        vn[mt][0] = MFMA(aw, sfr[ks][0], vn[mt][0]);
        vn[mt][1] = MFMA(aw, sfr[ks][1], vn[mt][1]);
      }
#pragma unroll
    for (int mt = 0; mt < 4; ++mt)
#pragma unroll
      for (int r = 0; r < 4; ++r) { vn[mt][0][r] = (float)uR[mt][0][r] - vn[mt][0][r]; vn[mt][1][r] = (float)uR[mt][1][r] - vn[mt][1][r]; }
#pragma unroll
    for (int mt = 0; mt < 4; ++mt)
#pragma unroll
      for (int nt = 0; nt < 2; ++nt)
        uR[mt][nt] = *(const h16x4*)(UTb + (size_t)cn * 128 * 64 + (size_t)(w * 32 + nt * 16 + fr) * 64 + mt * 16 + fq * 4);
    asm volatile("" ::: "memory");
    h16x8 vfr[2][2];
#pragma unroll
    for (int k2 = 0; k2 < 2; ++k2) { vfr[k2][0] = pack8(vn[2 * k2][0], vn[2 * k2 + 1][0]); vfr[k2][1] = pack8(vn[2 * k2][1], vn[2 * k2 + 1][1]); }
    if (c + 1 < 32) {
#pragma unroll
      for (int k2 = 0; k2 < 2; ++k2)
#pragma unroll
        for (int nt = 0; nt < 2; ++nt)
          *(h16x8*)(UTb + (size_t)c * 128 * 64 + ((size_t)k2 * 8 + w * 2 + nt) * 512 + lane * 8) = vfr[k2][nt];
    }
#pragma unroll
    for (int dkt = 0; dkt < 8; ++dkt) {
      f32x4 s0 = S[dkt][0], s1 = S[dkt][1];
#pragma unroll
      for (int r = 0; r < 4; ++r) { s0[r] *= dl; s1[r] *= dl; }
#pragma unroll
      for (int k2 = 0; k2 < 2; ++k2) {
        h16x8 ak = *(const h16x8*)(LK + (dkt * 16 + fr) * 128 + (((k2 * 4 + fq) ^ (fr & 7)) << 4));
        s0 = MFMA(ak, vfr[k2][0], s0);
        s1 = MFMA(ak, vfr[k2][1], s1);
      }
      S[dkt][0] = s0; S[dkt][1] = s1;
    }
    asm volatile("s_waitcnt vmcnt(0)" ::: "memory");
    RAW_BARRIER();
    if (c + 1 == 32) {
#pragma unroll
      for (int k2 = 0; k2 < 2; ++k2)
#pragma unroll
        for (int nt = 0; nt < 2; ++nt)
          *(h16x8*)(UTb + (size_t)c * 128 * 64 + ((size_t)k2 * 8 + w * 2 + nt) * 512 + lane * 8) = vfr[k2][nt];
    }
  }
  asm volatile("s_waitcnt vmcnt(0)" ::: "memory");
  __syncthreads();
}

__device__ void gdn_out_item(const Params& p, int item, unsigned char* smem) {
  unsigned char* LQ = smem;
  unsigned char* LA = smem + 16384;
  float* red = (float*)(smem + 24576);
  const int tid = threadIdx.x, w = tid >> 6, lane = tid & 63, fr = lane & 15, fq = lane >> 4;
  const int c = item & 31, h = (item >> 5) & 3, b = item >> 7;
  h16* MIXIN = (h16*)(p.ws + OFF_MIXIN);
  const h16* QGPi = (const h16*)(p.ws + OFF_QGP) + (size_t)item * 64 * 128;
  const h16* ATPi = (const h16*)(p.ws + OFF_ATP) + (size_t)item * 64 * 64;
  const h16* VFi = (const h16*)(p.ws + OFF_UT) + (size_t)item * 128 * 64;
  const h16* SFi = (const h16*)((unsigned char*)p.out + OUT_OFF_SF) + (size_t)item * 128 * 128;
  const h16* ZTi = (const h16*)((unsigned char*)p.out + OUT_OFF_ZT) + (size_t)item * 128 * 64;
  glds_copy<16384>(QGPi, LQ); glds_copy<8192>(ATPi, LA);
  h16x8 sfr[4][2], vfr[2][2];
#pragma unroll
  for (int ks = 0; ks < 4; ++ks)
#pragma unroll
    for (int nt = 0; nt < 2; ++nt) sfr[ks][nt] = *(const h16x8*)(SFi + ((size_t)ks * 8 + w * 2 + nt) * 512 + lane * 8);
#pragma unroll
  for (int k2 = 0; k2 < 2; ++k2)
#pragma unroll
    for (int nt = 0; nt < 2; ++nt) vfr[k2][nt] = *(const h16x8*)(VFi + ((size_t)k2 * 8 + w * 2 + nt) * 512 + lane * 8);
  h16x4 zR[4][2];
#pragma unroll
  for (int mt = 0; mt < 4; ++mt)
#pragma unroll
    for (int nt = 0; nt < 2; ++nt) zR[mt][nt] = *(const h16x4*)(ZTi + (size_t)(w * 32 + nt * 16 + fr) * 64 + mt * 16 + fq * 4);
  asm volatile("s_waitcnt vmcnt(0)" ::: "memory");
  __syncthreads();
  f32x4 o[4][2];
#pragma unroll
  for (int mt = 0; mt < 4; ++mt) {
    f32x4 o0 = {0.f, 0.f, 0.f, 0.f}, o1 = {0.f, 0.f, 0.f, 0.f};
#pragma unroll
    for (int ks = 0; ks < 4; ++ks) {
      h16x8 aq = *(const h16x8*)(LQ + (mt * 16 + fr) * 256 + (((ks * 4 + fq) ^ fr) << 4));
      o0 = MFMA(aq, sfr[ks][0], o0);
      o1 = MFMA(aq, sfr[ks][1], o1);
    }
#pragma unroll
    for (int k2 = 0; k2 < 2; ++k2) {
      h16x8 aa = *(const h16x8*)(LA + (mt * 16 + fr) * 128 + (((k2 * 4 + fq) ^ (fr & 7)) << 4));
      o0 = MFMA(aa, vfr[k2][0], o0);
      o1 = MFMA(aa, vfr[k2][1], o1);
    }
    o[mt][0] = o0; o[mt][1] = o1;
  }
#pragma unroll
  for (int mt = 0; mt < 4; ++mt)
#pragma unroll
    for (int r = 0; r < 4; ++r) {
      float s = o[mt][0][r] * o[mt][0][r] + o[mt][1][r] * o[mt][1][r];
      s = sum16(s);
      if (fr == 0) red[w * 64 + mt * 16 + 4 * fq + r] = s;
    }
  __syncthreads();
#pragma unroll
  for (int mt = 0; mt < 4; ++mt)
#pragma unroll
    for (int r = 0; r < 4; ++r) {
      const int tl = mt * 16 + 4 * fq + r;
      const float tot = red[tl] + red[64 + tl] + red[128 + tl] + red[192 + tl];
      const float rstd = rsqrtf(tot * (1.f / 128.f) + 1e-6f);
      const size_t tok = (size_t)b * SEQ + c * 64 + tl;
      h16* yp = MIXIN + tok * 1024 + 512 + h * 128 + w * 32 + fr;
      yp[0] = (h16)(o[mt][0][r] * rstd * (float)zR[mt][0][r]);
      yp[16] = (h16)(o[mt][1][r] * rstd * (float)zR[mt][1][r]);
    }
  __syncthreads();
}

#define XB_TMO      128
#define XB_XCNT(j)  (256  + 64 * (j))
#define XB_XSUB(j)  (1280 + 64 * (j))
#define XB_XGEN(j)  (2304 + 64 * (j))
#define XB_TOP      3328
#define XB_TOPGEN   3392
#define XCD_BAR_WORDS 3456
#define XB_SPIN_CAP (1u << 18)
#define LAS __attribute__((address_space(3)))

__device__ __forceinline__ unsigned xb_ld(unsigned* p)              { return __hip_atomic_load(p, __ATOMIC_RELAXED, __HIP_MEMORY_SCOPE_AGENT); }
__device__ __forceinline__ unsigned xb_add(unsigned* p, unsigned v) { return __hip_atomic_fetch_add(p, v, __ATOMIC_RELAXED, __HIP_MEMORY_SCOPE_AGENT); }
__device__ __forceinline__ unsigned xb_xcc_id() { return (unsigned)__builtin_amdgcn_s_getreg((3 << 11) | 20) & 0xFu; }
#define XB_SPIN(cond, bar) do { unsigned _sp = 0; while (cond) { __builtin_amdgcn_s_sleep(1); \
    if ((++_sp & 255u) == 0u) { if (xb_ld(&(bar)[XB_TMO])) break; if (_sp > XB_SPIN_CAP) { atomicAdd(&(bar)[XB_TMO], 1u); break; } } } } while (0)

struct XcdBarrier {
    unsigned* bar; unsigned x;
    volatile LAS unsigned* st;
};

__device__ __forceinline__ XcdBarrier xcd_barrier_post(unsigned* bar, volatile LAS unsigned* st) {
    XcdBarrier b; b.bar = bar; b.x = xb_xcc_id(); b.st = st;
    if (threadIdx.x == 0) (void)xb_add(&bar[XB_XCNT(b.x)], 1u);
    return b;
}
__device__ __forceinline__ void xcd_barrier_complete(unsigned* bar, unsigned x, unsigned& nloc, unsigned& nx) {
    const unsigned G = gridDim.x * gridDim.y * gridDim.z;
    unsigned sum, cnt, mine, sp = 0u;
    for (;;) {
        sum = 0u; cnt = 0u; mine = 0u;
#pragma unroll
        for (unsigned j = 0; j < 16; ++j) { const unsigned c = xb_ld(&bar[XB_XCNT(j)]); sum += c; cnt += (c > 0u) ? 1u : 0u; mine = (j == x) ? c : mine; }
        if (sum == G) break;
        __builtin_amdgcn_s_sleep(1);
        if ((++sp & 255u) == 0u) { if (xb_ld(&bar[XB_TMO])) break; if (sp > XB_SPIN_CAP) { atomicAdd(&bar[XB_TMO], 1u); break; } }
    }
    nloc = mine > 0u ? mine : 1u; nx = cnt > 0u ? cnt : 1u;
}

__device__ __forceinline__ void xcd_barrier(const XcdBarrier& b) {
    asm volatile("s_waitcnt vmcnt(0)" ::: "memory");
    __syncthreads();
    if (threadIdx.x == 0) {
        unsigned* bar = b.bar;
        __builtin_amdgcn_s_waitcnt(0);
        unsigned nloc = b.st[0], nx = b.st[1];
        if (nloc == 0u) { xcd_barrier_complete(bar, b.x, nloc, nx); b.st[0] = nloc; b.st[1] = nx; }
        const unsigned old = xb_add(&bar[XB_XSUB(b.x)], 1u);
        const unsigned gen = old / nloc;
        if (old + 1u == (gen + 1u) * nloc) {
            __builtin_amdgcn_fence(__ATOMIC_RELEASE, "agent");
            asm volatile("s_waitcnt vmcnt(0)" ::: "memory");
            const unsigned og = xb_add(&bar[XB_TOP], 1u);
            const unsigned tg = og / nx;
            if (og + 1u == (tg + 1u) * nx) xb_add(&bar[XB_TOPGEN], 1u);
            else XB_SPIN(xb_ld(&bar[XB_TOPGEN]) == tg, bar);
            __builtin_amdgcn_fence(__ATOMIC_ACQUIRE, "agent");
            xb_add(&bar[XB_XGEN(b.x)], 1u);
            asm volatile("s_waitcnt vmcnt(0)" ::: "memory");
        } else {
            XB_SPIN(xb_ld(&bar[XB_XGEN(b.x)]) == gen, bar);
            __builtin_amdgcn_fence(__ATOMIC_ACQUIRE, "agent");
            asm volatile("s_waitcnt vmcnt(0)" ::: "memory");
        }
    }
    __syncthreads();
}

#ifndef ONLY_PH
#define ONLY_PH -1
#endif
#define RUNPH(n) ((ONLY_PH < 0 || ONLY_PH == (n)) && p.ph_lo <= (n) && (n) <= p.ph_hi)
#define SYNCPH(n) do { if (p.ph_lo <= (n) && (n) < p.ph_hi) xcd_barrier(xb); } while (0)
__global__ void __launch_bounds__(256, 2) hymba_mega(Params p) {
  __shared__ __attribute__((aligned(16))) unsigned char smem[SMEM_BYTES];
  cg::grid_group grid = cg::this_grid();
  const int bid = blockIdx.x, nb = gridDim.x;
  if (p.ph_lo < 0) grid.sync();
  XcdBarrier xb;
  {
    volatile LAS unsigned* st = (volatile LAS unsigned*)(smem + SMEM_BYTES - 16);
    if (threadIdx.x == 0) { st[0] = 0u; st[1] = 0u; st[2] = 0u; st[3] = 0u; }
    __syncthreads();
    if (p.ph_lo < p.ph_hi) xb = xcd_barrier_post((unsigned*)(p.ws + OFF_BAR), st);
    else { xb.bar = (unsigned*)(p.ws + OFF_BAR); xb.x = 0; xb.st = st; }
  }
  {
    if (RUNPH(0)) for (int rep = 0; rep < REP0; ++rep) {
      if (rep) grid.sync();
      phase0(p, smem);
    }
    SYNCPH(0);
    if (RUNPH(1)) for (int rep = 0; rep < REP1; ++rep) {
      if (rep) grid.sync();
      const h16* A0 = (const h16*)((unsigned char*)p.out + OUT_OFF_A0);
      const h16* W = (const h16*)(p.ws + OFF_WIN);
      for (int t = bid; t < 256 * 25; t += nb) gemm_tile<EPI_PROJ>(p, A0, 1024, W, 1024, 1024, (t / 25) * 128, (t % 25) * 128, smem);
    }
    SYNCPH(1);
    if (RUNPH(2)) for (int rep = 0; rep < REP2; ++rep) {
      if (rep) grid.sync();
      for (int it = bid; it < 512 + 2048; it += nb) {
        if (it < 2048) gdn_pre_item(p, it, smem);
        else ssm_item(p, (it - 2048) >> 5, (it - 2048) & 31, smem);
      }
    }
    SYNCPH(2);
    if (RUNPH(3)) {
      if (bid < 64) gdn_chain(p, bid, smem);
      unsigned* ctr = (unsigned*)(p.ws + OFF_CTR);
      volatile int* bc = (volatile int*)(smem + SMEM_BYTES - 4);
      const h16* YPRE = (const h16*)((unsigned char*)p.out + OUT_OFF_YPRE);
      for (;;) {
        __syncthreads();
        if (threadIdx.x == 0) *bc = (int)atomicAdd(ctr, 1u);
        __syncthreads();
        const int t = *bc;
        if (t >= 1024 + 2048) break;
        if (t < 1024) gemm_tile<EPI_GLU>(p, YPRE, 512, (const h16*)(p.ws + OFF_WGLU), 512, 512, (t >> 2) * 128, (t & 3) * 128, smem);
        else gemm_tile<EPI_PLE>(p, (const h16*)(p.ws + OFF_PB), 256, (const h16*)(p.ws + OFF_WPP), 256, 256, ((t - 1024) >> 3) * 128, ((t - 1024) & 7) * 128, smem);
      }
    }
    SYNCPH(3);
    if (RUNPH(4)) {
      for (int it = bid; it < 2048; it += nb) gdn_out_item(p, it, smem);
    }
    SYNCPH(4);
    if (RUNPH(5)) {
      for (int t = bid; t < 2048; t += nb)
        gemm_tile<EPI_OUT>(p, (const h16*)(p.ws + OFF_MIXIN), 1024, (const h16*)(p.ws + OFF_WOUT), 1024, 1024, (t >> 3) * 128, (t & 7) * 128, smem);
    }
    SYNCPH(5);
    if (RUNPH(6)) {
      for (int t = bid; t < 2048; t += nb)
        gemm_tile<EPI_GATE>(p, (const h16*)(p.ws + OFF_PROJ), 1024, (const h16*)(p.ws + OFF_WGATE), 1024, 1024, (t >> 3) * 128, (t & 7) * 128, smem);
    }
    SYNCPH(6);
    if (RUNPH(7)) {
      const int wid = threadIdx.x >> 6, lane = threadIdx.x & 63;
      const float* OPART = (const float*)(p.ws + OFF_OPART);
      const float4* g4 = (const float4*)p.in[I_FING];
      for (int row = bid * 4 + wid; row < T_TOK; row += nb * 4) {
        float s = (lane < 8) ? OPART[(size_t)row * 8 + lane] : 0.f;
        s = wave_sum(s);
        const float rstd = rsqrtf(s * (1.f / 1024.f) + 1e-6f);
        float4* orow = (float4*)(p.out + (size_t)row * 1024);
#pragma unroll
        for (int i = 0; i < 4; ++i) {
          float4 v = orow[lane + i * 64];
          float4 g = g4[lane + i * 64];
          v.x *= rstd * g.x; v.y *= rstd * g.y; v.z *= rstd * g.z; v.w *= rstd * g.w;
          orow[lane + i * 64] = v;
        }
      }
    }
  }
}

extern "C" void kernel_launch(void* const* d_in, const int* in_sizes, int n_in, void* d_out, int out_size, void* d_ws, size_t ws_size,
                              hipStream_t stream) {
  static int grid_blocks = 0;
  if (!grid_blocks) {
    int dev = 0, cus = 0, per_cu = 0;
    hipGetDevice(&dev);
    hipDeviceGetAttribute(&cus, hipDeviceAttributeMultiprocessorCount, dev);
    hipOccupancyMaxActiveBlocksPerMultiprocessor(&per_cu, hymba_mega, 256, 0);
    if (per_cu > 2) per_cu = 2;
    if (per_cu < 1) per_cu = 1;
    grid_blocks = cus * per_cu;
  }
  if (n_in != 23 || ws_size < WS_END || out_size != T_TOK * 1024) {
    fprintf(stderr, "kernel_launch: unexpected sizes n_in=%d ws=%zu (need %zu) out=%d\n", n_in, ws_size, (size_t)WS_END, out_size);
    return;
  }
  Params p{};
  for (int i = 0; i < 23; ++i) p.in[i] = (const float*)d_in[i];
  p.out = (float*)d_out;
  p.ws = (unsigned char*)d_ws;
  if (hipMemsetAsync((unsigned char*)d_ws + OFF_BAR, 0, 16384, stream) != hipSuccess) { fprintf(stderr, "kernel_launch: memset of control words failed\n"); return; }
#if MULTI_LAUNCH
  for (int ph = 0; ph < NPH; ++ph) {
    p.ph_lo = ph; p.ph_hi = ph;
    hipLaunchKernelGGL(hymba_mega, dim3(grid_blocks), dim3(256), 0, stream, p);
  }
#else
  p.ph_lo = 0; p.ph_hi = NPH - 1;
  void* args[] = {&p};
  hipError_t e = hipLaunchCooperativeKernel((void*)hymba_mega, dim3(grid_blocks), dim3(256), args, 0, stream);
  if (e != hipSuccess) fprintf(stderr, "cooperative launch failed: %s (grid %d)\n", hipGetErrorString(e), grid_blocks);
#endif
}
```

```cpp
#include <hip/hip_runtime.h>
#include <hip/hip_cooperative_groups.h>
#include <cstdio>
namespace cg = cooperative_groups;

#ifndef REP0
#define REP0 1
#endif
#ifndef REP1
#define REP1 1
#endif
#ifndef REP2
#define REP2 1
#endif
#ifndef REP3
#define REP3 1
#endif
#ifndef REP4
#define REP4 1
#endif
#ifndef MULTI_LAUNCH
#define MULTI_LAUNCH 0
#endif

typedef _Float16 h16;
typedef __attribute__((ext_vector_type(8))) _Float16 h16x8;
typedef __attribute__((ext_vector_type(4))) _Float16 h16x4;
typedef __attribute__((ext_vector_type(4))) float f32x4;
typedef __attribute__((ext_vector_type(2))) float v2f;

#define MFMA(a, b, c) __builtin_amdgcn_mfma_f32_16x16x32_f16((a), (b), (c), 0, 0, 0)

constexpr int T_TOK = 32768;
constexpr int SEQ = 2048;
constexpr int NPH = 8;
constexpr int LDP = 3072;
constexpr int SMEM_BYTES = 72704;

constexpr size_t SZ_WIN = (size_t)3200 * 1024 * 2;
constexpr size_t SZ_WGLU = (size_t)512 * 512 * 2;
constexpr size_t SZ_WOUT = (size_t)1024 * 1024 * 2;
constexpr size_t SZ_WPP = (size_t)1024 * 256 * 2;
constexpr size_t SZ_WGATE = (size_t)1024 * 1024 * 2;
constexpr size_t OFF_WIN = 0;
constexpr size_t OFF_WGLU = OFF_WIN + SZ_WIN;
constexpr size_t OFF_WOUT = OFF_WGLU + SZ_WGLU;
constexpr size_t OFF_WPP = OFF_WOUT + SZ_WOUT;
constexpr size_t OFF_WGATE = OFF_WPP + SZ_WPP;
constexpr size_t OFF_PB = OFF_WGATE + SZ_WGATE;
constexpr size_t OFF_PROJ = OFF_PB + (size_t)T_TOK * 256 * 2;
constexpr size_t OFF_AB = OFF_PROJ + (size_t)T_TOK * LDP * 2;
constexpr size_t OFF_KTAB = OFF_AB + (size_t)T_TOK * 8 * 4;
constexpr size_t OFF_ETAB = OFF_KTAB + (size_t)32 * 33 * 256 * 2;
constexpr size_t OFF_FTAB = OFF_ETAB + (size_t)32 * 128 * 512 * 2;
constexpr size_t OFF_ALPOW = OFF_FTAB + (size_t)32 * 512 * 128 * 2;
constexpr size_t OFF_DL = OFF_ALPOW + (size_t)32 * 64 * 2 * 4;
constexpr size_t OFF_EPART = OFF_DL + (size_t)2048 * 4;
constexpr size_t OFF_OPART = OFF_EPART + (size_t)T_TOK * 16 * 4;
constexpr size_t OFF_MIXIN = OFF_OPART + (size_t)T_TOK * 16 * 4;
constexpr size_t OFF_WP = OFF_MIXIN + (size_t)T_TOK * 1024 * 2;
constexpr size_t OFF_QGP = OFF_WP + (size_t)2048 * 64 * 128 * 2;
constexpr size_t OFF_KDT = OFF_QGP + (size_t)2048 * 64 * 128 * 2;
constexpr size_t OFF_UT = OFF_KDT + (size_t)2048 * 128 * 64 * 2;
constexpr size_t OFF_ATP = OFF_UT + (size_t)2048 * 128 * 64 * 2;
constexpr size_t OFF_EH = OFF_ATP + (size_t)2048 * 64 * 64 * 2;
constexpr size_t OFF_BAR = OFF_EH + (size_t)T_TOK * 1024 * 2;
constexpr size_t WS_END = OFF_BAR + 16384;
constexpr size_t OFF_CTR = OFF_BAR + 15360;
constexpr size_t OUT_OFF_A0 = 0;
constexpr size_t OUT_OFF_SF = 0;
constexpr size_t OUT_OFF_YPRE = (size_t)T_TOK * 1024 * 2;
constexpr size_t OUT_OFF_ZT = OUT_OFF_YPRE + (size_t)T_TOK * 512 * 2;

struct Params {
  const float* in[23];
  float* out;
  unsigned char* ws;
  int ph_lo, ph_hi;
};

enum { I_X = 0, I_P, I_NMG, I_WIN, I_ARE, I_AIM, I_BRE, I_BIM, I_CRE, I_CIM, I_D, I_LOGDT, I_WGLU, I_BGLU,
       I_CONVW, I_ALOG, I_DTB, I_DNG, I_WOUT, I_WPP, I_PLEG, I_WGATE, I_FING };

__device__ __forceinline__ float wave_sum(float v) {
#pragma unroll
  for (int o = 32; o > 0; o >>= 1) v += __shfl_xor(v, o);
  return v;
}
__device__ __forceinline__ float sum16(float v) {
  v += __shfl_xor(v, 1); v += __shfl_xor(v, 2); v += __shfl_xor(v, 4); v += __shfl_xor(v, 8);
  return v;
}
__device__ __forceinline__ float sigmoidf_(float x) { return 1.f / (1.f + __expf(-x)); }
__device__ __forceinline__ float siluf_(float x) { return x / (1.f + __expf(-x)); }
__device__ __forceinline__ float gelu_tanh(float y) {
  float z = 0.7978845608028654f * (y + 0.044715f * y * y * y);
  return 0.5f * y * (1.f + tanhf(z));
}
__device__ __forceinline__ h16x8 pack8(f32x4 lo, f32x4 hi) {
  h16x8 r;
  r[0] = (h16)lo[0]; r[1] = (h16)lo[1]; r[2] = (h16)lo[2]; r[3] = (h16)lo[3];
  r[4] = (h16)hi[0]; r[5] = (h16)hi[1]; r[6] = (h16)hi[2]; r[7] = (h16)hi[3];
  return r;
}
__device__ __forceinline__ int perm_pos(int n) { return (n & ~31) + (((n & 15) >> 2) << 3) + (((n >> 4) & 1) << 2) + (n & 3); }
__device__ __forceinline__ int perm_inv(int pos) {
  int q5 = pos & 31, qq = q5 >> 3, jj = q5 & 7;
  return (pos & ~31) + (jj < 4 ? 4 * qq + jj : 16 + 4 * qq + (jj - 4));
}

__device__ void transpose_w(const float* __restrict__ W, int K, int N, int Npad, h16* __restrict__ WT, int t, float* tile) {
  const int ntn = Npad / 64;
  const int kt = t / ntn, nt = t % ntn, k0 = kt * 64, n0 = nt * 64;
  const int tx = threadIdx.x & 63, ty = threadIdx.x >> 6;
  for (int r = 0; r < 16; ++r) {
    int k = ty * 16 + r, n = n0 + tx;
    tile[k * 65 + tx] = (n < N) ? W[(size_t)(k0 + k) * N + n] : 0.f;
  }
  __syncthreads();
  for (int r = 0; r < 16; ++r) {
    int n = ty * 16 + r;
    WT[(size_t)(n0 + n) * K + k0 + tx] = (h16)tile[tx * 65 + n];
  }
  __syncthreads();
}

__device__ void ssm_table_item(const Params& p, int g, int d, float* lds) {
  float2* sAp = (float2*)lds;
  float2* sW = sAp + 64;
  const int tid = threadIdx.x;
  h16* KTAB = (h16*)(p.ws + OFF_KTAB);
  h16* ETAB = (h16*)(p.ws + OFF_ETAB);
  h16* FTAB = (h16*)(p.ws + OFF_FTAB);
  float* ALPOW = (float*)(p.ws + OFF_ALPOW);
  float* sBr = lds + 256; float* sBi = sBr + 1024; float* sCr = sBi + 1024; float* sCi = sCr + 16 * 65;
  {
    const float4 vbr = ((const float4*)(p.in[I_BRE] + g * 1024))[tid], vbi = ((const float4*)(p.in[I_BIM] + g * 1024))[tid];
    const float4 vcr = ((const float4*)(p.in[I_CRE] + g * 1024))[tid], vci = ((const float4*)(p.in[I_CIM] + g * 1024))[tid];
    *(float4*)(sBr + tid * 4) = vbr; *(float4*)(sBi + tid * 4) = vbi;
    const int ch = (tid * 4) >> 6, cp = (tid * 4) & 63;
    sCr[ch * 65 + cp] = vcr.x; sCr[ch * 65 + cp + 1] = vcr.y; sCr[ch * 65 + cp + 2] = vcr.z; sCr[ch * 65 + cp + 3] = vcr.w;
    sCi[ch * 65 + cp] = vci.x; sCi[ch * 65 + cp + 1] = vci.y; sCi[ch * 65 + cp + 2] = vci.z; sCi[ch * 65 + cp + 3] = vci.w;
  }
  if (tid < 64) {
    const int pp = tid;
    float lr = p.in[I_ARE][g * 64 + pp], li = p.in[I_AIM][g * 64 + pp], dt = expf(p.in[I_LOGDT][g]);
    float mag = expf(lr * dt), ang = li * dt;
    float abr = mag * cosf(ang), abi = mag * sinf(ang);
    float nr = abr - 1.f, ni = abi, den = lr * lr + li * li;
    float cr = (nr * lr + ni * li) / den, ci = (ni * lr - nr * li) / den;
    float apr = 1.f, api = 0.f;
    for (int k = 0; k < d; ++k) { float t0 = apr * abr - api * abi; api = apr * abi + api * abr; apr = t0; }
    sAp[pp] = make_float2(apr, api);
    sW[pp] = make_float2(apr * cr - api * ci, apr * ci + api * cr);
    if (d == 32) { ALPOW[(g * 64 + pp) * 2] = apr; ALPOW[(g * 64 + pp) * 2 + 1] = api; }
  }
  __syncthreads();
  if (d < 32) {
    {
      const int h = tid >> 4, hp = tid & 15;
      float acc = 0.f;
#pragma unroll 8
      for (int pp = 0; pp < 64; ++pp) {
        float2 W = sW[pp];
        float br = sBr[pp * 16 + hp], bi = sBi[pp * 16 + hp];
        float wbr = W.x * br - W.y * bi, wbi = W.x * bi + W.y * br;
        float cr = sCr[h * 65 + pp], ci = sCi[h * 65 + pp];
        acc += cr * wbr - ci * wbi;
      }
      KTAB[(size_t)(g * 33 + d + 1) * 256 + h * 16 + hp] = (h16)acc;
      if (d == 0) KTAB[(size_t)(g * 33) * 256 + tid] = (h16)0.f;
    }
    {
      const int i = 31 - d;
#pragma unroll
      for (int r = 0; r < 4; ++r) {
        int idx = tid + 256 * r, pp = idx >> 4, hp = idx & 15;
        float2 W = sW[pp];
        float br = sBr[pp * 16 + hp], bi = sBi[pp * 16 + hp];
        float wbr = W.x * br - W.y * bi, wbi = W.x * bi + W.y * br;
        ETAB[((size_t)g * 128 + pp) * 512 + i * 16 + hp] = (h16)wbr;
        ETAB[((size_t)g * 128 + 64 + pp) * 512 + i * 16 + hp] = (h16)wbi;
      }
    }
  }
  if (d >= 1) {
    const int j = d - 1;
#pragma unroll
    for (int r = 0; r < 4; ++r) {
      int idx = tid + 256 * r, h = idx >> 6, pp = idx & 63;
      float2 Ap = sAp[pp];
      float cr = sCr[h * 65 + pp], ci = sCi[h * 65 + pp];
      float re = cr * Ap.x - ci * Ap.y, im = cr * Ap.y + ci * Ap.x;
      FTAB[((size_t)g * 512 + j * 16 + h) * 128 + pp] = (h16)re;
      FTAB[((size_t)g * 512 + j * 16 + h) * 128 + 64 + pp] = (h16)(-im);
    }
  }
  __syncthreads();
}

__device__ void phase0(const Params& p, unsigned char* smem) {
  const int bid = blockIdx.x, nb = gridDim.x, tid = threadIdx.x, wid = tid >> 6, lane = tid & 63;
  float* tile = (float*)smem;
  for (int t = bid; t < 1440; t += nb) {
    if (t < 800) transpose_w(p.in[I_WIN], 1024, 3080, 3200, (h16*)(p.ws + OFF_WIN), t, tile);
    else if (t < 864) transpose_w(p.in[I_WGLU], 512, 512, 512, (h16*)(p.ws + OFF_WGLU), t - 800, tile);
    else if (t < 1120) transpose_w(p.in[I_WOUT], 1024, 1024, 1024, (h16*)(p.ws + OFF_WOUT), t - 864, tile);
    else if (t < 1184) transpose_w(p.in[I_WPP], 256, 1024, 1024, (h16*)(p.ws + OFF_WPP), t - 1120, tile);
    else transpose_w(p.in[I_WGATE], 1024, 1024, 1024, (h16*)(p.ws + OFF_WGATE), t - 1184, tile);
  }
  for (int it = bid; it < 32 * 33; it += nb) ssm_table_item(p, it / 33, it % 33, (float*)smem);
  {
    h16* A0 = (h16*)((unsigned char*)p.out + OUT_OFF_A0);
    const float* x = p.in[I_X];
    const float4* g4 = (const float4*)p.in[I_NMG];
    for (int row = bid * 4 + wid; row < T_TOK; row += nb * 4) {
      const float4* xr = (const float4*)(x + (size_t)row * 1024);
      float4 v[4];
      float ss = 0.f;
#pragma unroll
      for (int i = 0; i < 4; ++i) {
        v[i] = xr[lane + i * 64];
        ss += v[i].x * v[i].x + v[i].y * v[i].y + v[i].z * v[i].z + v[i].w * v[i].w;
      }
      ss = wave_sum(ss);
      float rstd = rsqrtf(ss * (1.f / 1024.f) + 1e-6f);
#pragma unroll
      for (int i = 0; i < 4; ++i) {
        float4 g = g4[lane + i * 64];
        h16x4 o;
        o[0] = (h16)(v[i].x * rstd * g.x); o[1] = (h16)(v[i].y * rstd * g.y);
        o[2] = (h16)(v[i].z * rstd * g.z); o[3] = (h16)(v[i].w * rstd * g.w);
        *(h16x4*)(A0 + (size_t)row * 1024 + (lane + i * 64) * 4) = o;
      }
    }
  }
  {
    h16* PB = (h16*)(p.ws + OFF_PB);
    const float4* p4 = (const float4*)p.in[I_P];
    const size_t n4 = (size_t)T_TOK * 256 / 4;
    for (size_t i = (size_t)bid * 256 + tid; i < n4; i += (size_t)nb * 256) {
      float4 v = p4[i];
      h16x4 o;
      o[0] = (h16)v.x; o[1] = (h16)v.y; o[2] = (h16)v.z; o[3] = (h16)v.w;
      *(h16x4*)(PB + i * 4) = o;
    }
  }
}

enum { EPI_PROJ = 0, EPI_GLU, EPI_PLE, EPI_OUT, EPI_GATE };

template <int EPI>
__device__ __forceinline__ void gemm_tile(const Params& p, const h16* __restrict__ A, int lda, const h16* __restrict__ Bt, int ldb,
                                          int K, int brow, int bcol, unsigned char* smem) {
  const int tid = threadIdx.x, wid = tid >> 6, lane = tid & 63, wr = wid >> 1, wc = wid & 1, fr = lane & 15, fq = lane >> 4;
  f32x4 acc[4][4];
#pragma unroll
  for (int m = 0; m < 4; ++m)
#pragma unroll
    for (int n = 0; n < 4; ++n) acc[m][n] = f32x4{0.f, 0.f, 0.f, 0.f};
  const int nk = K / 64;
  const h16* ga[4]; const h16* gb[4];
#pragma unroll
  for (int i = 0; i < 4; ++i) {
    const int L = tid + 256 * i, row = L >> 3, cs = (L & 7) ^ (row & 7);
    ga[i] = A + (size_t)(brow + row) * lda + cs * 8;
    gb[i] = Bt + (size_t)(bcol + row) * ldb + cs * 8;
  }
#define GEMM_STAGE(t_, buf_) do { \
    unsigned char* sa_ = smem + (buf_) * 32768 + tid * 16; \
    _Pragma("unroll") for (int i_ = 0; i_ < 4; ++i_) { \
      __builtin_amdgcn_global_load_lds((const unsigned*)(ga[i_] + (t_) * 64), (unsigned*)(sa_ + i_ * 4096), 16, 0, 0); \
      __builtin_amdgcn_global_load_lds((const unsigned*)(gb[i_] + (t_) * 64), (unsigned*)(sa_ + 16384 + i_ * 4096), 16, 0, 0); \
    } \
  } while (0)
  GEMM_STAGE(0, 0);
  for (int t = 0; t < nk; ++t) {
    asm volatile("s_waitcnt vmcnt(0)" ::: "memory");
    __syncthreads();
    if (t + 1 < nk) GEMM_STAGE(t + 1, (t + 1) & 1);
    const unsigned char* SA = smem + (t & 1) * 32768;
    const unsigned char* SB = SA + 16384;
#pragma unroll
    for (int kk = 0; kk < 2; ++kk) {
      h16x8 af[4], bf[4];
      const int pos = ((kk * 4 + fq) ^ (fr & 7)) << 4;
#pragma unroll
      for (int m = 0; m < 4; ++m) {
        af[m] = *(const h16x8*)(SA + (wr * 64 + m * 16 + fr) * 128 + pos);
        bf[m] = *(const h16x8*)(SB + (wc * 64 + m * 16 + fr) * 128 + pos);
      }
#pragma unroll
      for (int m = 0; m < 4; ++m)
#pragma unroll
        for (int n = 0; n < 4; ++n) acc[m][n] = MFMA(af[m], bf[n], acc[m][n]);
    }
  }
#undef GEMM_STAGE
  __syncthreads();
  float* CT = (float*)smem;
#pragma unroll
  for (int m = 0; m < 4; ++m)
#pragma unroll
    for (int n = 0; n < 4; ++n)
#pragma unroll
      for (int j = 0; j < 4; ++j) CT[(wr * 64 + m * 16 + fq * 4 + j) * 132 + wc * 64 + n * 16 + fr] = acc[m][n][j];
  __syncthreads();
  const int c4 = tid & 31;
#pragma unroll 2
  for (int it = 0; it < 16; ++it) {
    const int rl = it * 8 + (tid >> 5);
    const size_t row = (size_t)brow + rl;
    const int col = bcol + c4 * 4;
    const float4 v = *(const float4*)(CT + rl * 132 + c4 * 4);
    if constexpr (EPI == EPI_PROJ) {
      if (bcol < 3072) {
        h16x4 o; o[0] = (h16)v.x; o[1] = (h16)v.y; o[2] = (h16)v.z; o[3] = (h16)v.w;
        *(h16x4*)((h16*)(p.ws + OFF_PROJ) + row * LDP + col) = o;
      } else if (c4 < 2) {
        *(float4*)((float*)(p.ws + OFF_AB) + row * 8 + c4 * 4) = v;
      }
    } else if constexpr (EPI == EPI_GLU) {
      const h16x4 y = *(const h16x4*)((const h16*)((unsigned char*)p.out + OUT_OFF_YPRE) + row * 512 + col);
      const h16x4 z = *(const h16x4*)((const h16*)(p.ws + OFF_PROJ) + row * LDP + 512 + col);
      const float4 bb = *(const float4*)(p.in[I_BGLU] + col);
      h16x4 o;
      o[0] = (h16)((float)y[0] * sigmoidf_(v.x + bb.x) * siluf_((float)z[0]));
      o[1] = (h16)((float)y[1] * sigmoidf_(v.y + bb.y) * siluf_((float)z[1]));
      o[2] = (h16)((float)y[2] * sigmoidf_(v.z + bb.z) * siluf_((float)z[2]));
      o[3] = (h16)((float)y[3] * sigmoidf_(v.w + bb.w) * siluf_((float)z[3]));
      *(h16x4*)((h16*)(p.ws + OFF_MIXIN) + row * 1024 + col) = o;
    } else if constexpr (EPI == EPI_PLE) {
      h16x4 o; o[0] = (h16)v.x; o[1] = (h16)v.y; o[2] = (h16)v.z; o[3] = (h16)v.w;
      *(h16x4*)((h16*)(p.ws + OFF_EH) + row * 1024 + col) = o;
      float s = v.x * v.x + v.y * v.y + v.z * v.z + v.w * v.w;
      s = sum16(s); s += __shfl_xor(s, 16);
      if (c4 == 0) ((float*)(p.ws + OFF_EPART))[row * 8 + (bcol >> 7)] = s;
    } else if constexpr (EPI == EPI_OUT) {
      const float4 xv = *(const float4*)(p.in[I_X] + row * 1024 + col);
      float4 hv; hv.x = xv.x + v.x; hv.y = xv.y + v.y; hv.z = xv.z + v.z; hv.w = xv.w + v.w;
      h16x4 o; o[0] = (h16)hv.x; o[1] = (h16)hv.y; o[2] = (h16)hv.z; o[3] = (h16)hv.w;
      *(h16x4*)((h16*)(p.ws + OFF_PROJ) + row * 1024 + col) = o;
    } else if constexpr (EPI == EPI_GATE) {
      const float4 e0 = *(const float4*)((const float*)(p.ws + OFF_EPART) + row * 8);
      const float4 e1 = *(const float4*)((const float*)(p.ws + OFF_EPART) + row * 8 + 4);
      const float rs = rsqrtf((e0.x + e0.y + e0.z + e0.w + e1.x + e1.y + e1.z + e1.w) * (1.f / 1024.f) + 1e-6f);
      const h16x4 eh = *(const h16x4*)((const h16*)(p.ws + OFF_EH) + row * 1024 + col);
      const float4 pg = *(const float4*)(p.in[I_PLEG] + col);
      const h16x4 hb = *(const h16x4*)((const h16*)(p.ws + OFF_PROJ) + row * 1024 + col);
      float4 hv;
      hv.x = (float)hb[0] + sigmoidf_(v.x) * ((float)eh[0] * rs * pg.x);
      hv.y = (float)hb[1] + sigmoidf_(v.y) * ((float)eh[1] * rs * pg.y);
      hv.z = (float)hb[2] + sigmoidf_(v.z) * ((float)eh[2] * rs * pg.z);
      hv.w = (float)hb[3] + sigmoidf_(v.w) * ((float)eh[3] * rs * pg.w);
      {
        h16x4 o; o[0] = (h16)hv.x; o[1] = (h16)hv.y; o[2] = (h16)hv.z; o[3] = (h16)hv.w;
        *(h16x4*)((h16*)(p.ws + OFF_MIXIN) + row * 1024 + col) = o;
      }
      float s = hv.x * hv.x + hv.y * hv.y + hv.z * hv.z + hv.w * hv.w;
      s = sum16(s); s += __shfl_xor(s, 16);
      if (c4 == 0) ((float*)(p.ws + OFF_OPART))[row * 8 + (bcol >> 7)] = s;
    }
  }
  __syncthreads();
}

__device__ void ssm_item(const Params& p, int b, int g, unsigned char* smem) {
  float* LOCAL = (float*)smem;
  h16* SPREV = (h16*)(smem + 33792);
  h16* KT = (h16*)(smem + 51200);
  int tid_ = threadIdx.x;
  asm volatile("" : "+v"(tid_));
  const int tid = tid_, w = tid >> 6, lane = tid & 63, fr = lane & 15, fq = lane >> 4;
  const h16* PROJ = (const h16*)(p.ws + OFF_PROJ);
  const h16* Eg = (const h16*)(p.ws + OFF_ETAB) + (size_t)g * 128 * 512;
  const h16* Kg = (const h16*)(p.ws + OFF_KTAB) + (size_t)g * 33 * 256;
  const h16* Fg = (const h16*)(p.ws + OFF_FTAB) + (size_t)g * 512 * 128;
  const float* ALPOW = (const float*)(p.ws + OFF_ALPOW);
  h16* YPRE = (h16*)((unsigned char*)p.out + OUT_OFF_YPRE);
  const int nchunk = w * 16 + fr;
  const size_t tok0 = (size_t)b * SEQ + (size_t)nchunk * 32;
  for (int idx = tid; idx < 33 * 256 / 8; idx += 256) *(h16x8*)(KT + idx * 8) = *(const h16x8*)(Kg + idx * 8);
  h16x8 uf[16];
#pragma unroll
  for (int ks = 0; ks < 16; ++ks) {
    const int i = 2 * ks + (fq >> 1);
    uf[ks] = *(const h16x8*)(PROJ + (tok0 + i) * LDP + g * 16 + (fq & 1) * 8);
  }
  {
    h16x8 ea[8];
#pragma unroll
    for (int ks = 0; ks < 8; ++ks) ea[ks] = *(const h16x8*)(Eg + (size_t)fr * 512 + ks * 32 + fq * 8);
    f32x4 acc = {0.f, 0.f, 0.f, 0.f};
#pragma unroll 1
    for (int it = 0; it < 16; ++it) {
      const int mt = it >> 1, hf = it & 1;
      const int itn = it < 15 ? it + 1 : 15;
      h16x8 en[8];
#pragma unroll
      for (int ks = 0; ks < 8; ++ks) en[ks] = *(const h16x8*)(Eg + (size_t)((itn >> 1) * 16 + fr) * 512 + ((itn & 1) * 8 + ks) * 32 + fq * 8);
      if (hf == 0) {
#pragma unroll
        for (int ks = 0; ks < 8; ++ks) acc = MFMA(ea[ks], uf[ks], acc);
      } else {
#pragma unroll
        for (int ks = 0; ks < 8; ++ks) acc = MFMA(ea[ks], uf[8 + ks], acc);
        *(f32x4*)(LOCAL + nchunk * 132 + mt * 16 + fq * 4) = acc;
        acc = f32x4{0.f, 0.f, 0.f, 0.f};
      }
#pragma unroll
      for (int ks = 0; ks < 8; ++ks) ea[ks] = en[ks];
    }
  }
  __syncthreads();
  if (tid < 64) {
    const int pp = tid;
    const float ar = ALPOW[(g * 64 + pp) * 2], ai = ALPOW[(g * 64 + pp) * 2 + 1];
    float sr = 0.f, si = 0.f;
#pragma unroll 4
    for (int c = 0; c < 64; ++c) {
      SPREV[c * 136 + pp] = (h16)sr;
      SPREV[c * 136 + 64 + pp] = (h16)si;
      float lr = LOCAL[c * 132 + pp], li = LOCAL[c * 132 + 64 + pp];
      float nr = ar * sr - ai * si + lr;
      float ni = ar * si + ai * sr + li;
      sr = nr; si = ni;
    }
  }
  __syncthreads();
  h16x8 sf[4];
#pragma unroll
  for (int ks = 0; ks < 4; ++ks) sf[ks] = *(const h16x8*)(SPREV + nchunk * 136 + ks * 32 + fq * 8);
  const float4 Dv = *(const float4*)(p.in[I_D] + g * 16 + fq * 4);
  h16x8 fa[4];
#pragma unroll
  for (int ks = 0; ks < 4; ++ks) fa[ks] = *(const h16x8*)(Fg + (size_t)fr * 128 + ks * 32 + fq * 8);
  h16x4 u4 = *(const h16x4*)(PROJ + tok0 * LDP + g * 16 + fq * 4);
#pragma unroll 1
  for (int j = 0; j < 32; ++j) {
    const int jn = j < 31 ? j + 1 : 31;
    h16x8 fn[4];
#pragma unroll
    for (int ks = 0; ks < 4; ++ks) fn[ks] = *(const h16x8*)(Fg + (size_t)(jn * 16 + fr) * 128 + ks * 32 + fq * 8);
    const h16x4 un = *(const h16x4*)(PROJ + (tok0 + jn) * LDP + g * 16 + fq * 4);
    f32x4 acc = {0.f, 0.f, 0.f, 0.f};
#pragma unroll
    for (int ks = 0; ks < 16; ++ks) {
      if (2 * ks <= j) {
        const int dd = j - 2 * ks - (fq >> 1) + 1;
        h16x8 a = *(const h16x8*)(KT + dd * 256 + fr * 16 + (fq & 1) * 8);
        acc = MFMA(a, uf[ks], acc);
      }
    }
#pragma unroll
    for (int ks = 0; ks < 4; ++ks) acc = MFMA(fa[ks], sf[ks], acc);
    const size_t tok = tok0 + j;
    h16x4 o;
    o[0] = (h16)gelu_tanh(acc[0] + Dv.x * (float)u4[0]);
    o[1] = (h16)gelu_tanh(acc[1] + Dv.y * (float)u4[1]);
    o[2] = (h16)gelu_tanh(acc[2] + Dv.z * (float)u4[2]);
    o[3] = (h16)gelu_tanh(acc[3] + Dv.w * (float)u4[3]);
    *(h16x4*)(YPRE + tok * 512 + g * 16 + fq * 4) = o;
#pragma unroll
    for (int ks = 0; ks < 4; ++ks) fa[ks] = fn[ks];
    u4 = un;
  }
  __syncthreads();
}

__device__ void gdn_pre_item(const Params& p, int item, unsigned char* smem) {
  h16* QH = (h16*)smem;
  h16* KH = (h16*)(smem + 17408);
  h16* VH = (h16*)(smem + 34816);
  float* LT = (float*)(smem + 52224);
  float* sG = (float*)(smem + 69632);
  float* sBeta = (float*)(smem + 69888);
  float* sEG = (float*)(smem + 70144);
  float* sBG = (float*)(smem + 70400);
  float* sEL = (float*)(smem + 70656);
  int tid_ = threadIdx.x;
  asm volatile("" : "+v"(tid_));
  const int tid = tid_, w = tid >> 6, lane = tid & 63, fr = lane & 15, fq = lane >> 4;
  const int c = item & 31, h = (item >> 5) & 3, b = item >> 7;
  const h16* PROJ = (const h16*)(p.ws + OFF_PROJ);
  const float* AB = (const float*)(p.ws + OFF_AB);
  const float* convw = p.in[I_CONVW];
  h16* WPi = (h16*)(p.ws + OFF_WP) + (size_t)item * 64 * 128;
  h16* QGPi = (h16*)(p.ws + OFF_QGP) + (size_t)item * 64 * 128;
  h16* KDTi = (h16*)(p.ws + OFF_KDT) + (size_t)item * 128 * 64;
  h16* UTi = (h16*)(p.ws + OFF_UT) + (size_t)item * 128 * 64;
  h16* ATPi = (h16*)(p.ws + OFF_ATP) + (size_t)item * 64 * 64;
  h16* ZTi = (h16*)((unsigned char*)p.out + OUT_OFF_ZT) + (size_t)item * 128 * 64;
  float* DL = (float*)(p.ws + OFF_DL);
  {
    const int ch0 = (tid & 15) * 8, t0 = (tid >> 4) * 4;
#pragma unroll 1
    for (int sec = 0; sec < 3; ++sec) {
      const int colbase = 1024 + sec * 512 + h * 128 + ch0;
      h16x8 xr[7];
#pragma unroll
      for (int i = 0; i < 7; ++i) {
        const int ts = c * 64 + t0 - 3 + i;
        h16x8 z8 = {(h16)0.f, (h16)0.f, (h16)0.f, (h16)0.f, (h16)0.f, (h16)0.f, (h16)0.f, (h16)0.f};
        xr[i] = (ts >= 0) ? *(const h16x8*)(PROJ + ((size_t)b * SEQ + ts) * LDP + colbase) : z8;
      }
      float4 wv[4][2];
#pragma unroll
      for (int jj = 0; jj < 4; ++jj) {
        wv[jj][0] = *(const float4*)(convw + jj * 1536 + sec * 512 + h * 128 + ch0);
        wv[jj][1] = *(const float4*)(convw + jj * 1536 + sec * 512 + h * 128 + ch0 + 4);
      }
      h16* dst = (sec == 0 ? QH : (sec == 1 ? KH : VH));
#pragma unroll
      for (int tt = 0; tt < 4; ++tt) {
        float a[8];
#pragma unroll
        for (int e = 0; e < 8; ++e) a[e] = 0.f;
#pragma unroll
        for (int jj = 0; jj < 4; ++jj) {
          const h16x8 xv = xr[tt + jj];
          a[0] += wv[jj][0].x * (float)xv[0]; a[1] += wv[jj][0].y * (float)xv[1]; a[2] += wv[jj][0].z * (float)xv[2]; a[3] += wv[jj][0].w * (float)xv[3];
          a[4] += wv[jj][1].x * (float)xv[4]; a[5] += wv[jj][1].y * (float)xv[5]; a[6] += wv[jj][1].z * (float)xv[6]; a[7] += wv[jj][1].w * (float)xv[7];
        }
        float ss = 0.f;
#pragma unroll
        for (int e = 0; e < 8; ++e) { a[e] = siluf_(a[e]); ss += a[e] * a[e]; }
        float scale = 1.f;
        if (sec < 2) {
          ss = sum16(ss);
          scale = rsqrtf(ss + 1e-6f) * (sec == 0 ? 0.08838834764831845f : 1.f);
        }
        h16x8 o;
#pragma unroll
        for (int e = 0; e < 8; ++e) o[e] = (h16)(a[e] * scale);
        *(h16x8*)(dst + (t0 + tt) * 136 + ch0) = o;
      }
    }
  }
  if (tid < 64) {
    const size_t tok = (size_t)b * SEQ + c * 64 + tid;
    float braw = AB[tok * 8 + h], araw = AB[tok * 8 + 4 + h];
    float beta = 1.f / (1.f + expf(-braw));
    float xx = araw + p.in[I_DTB][h];
    float sp = xx > 20.f ? xx : log1pf(expf(xx));
    float gg = -expf(p.in[I_ALOG][h]) * sp;
#pragma unroll
    for (int o = 1; o < 64; o <<= 1) {
      float v = __shfl_up(gg, o);
      if (lane >= o) gg += v;
    }
    sG[tid] = gg;
    sBeta[tid] = beta;
    const float eg = expf(gg);
    sEG[tid] = eg;
    sBG[tid] = beta * eg;
    sEL[tid] = expf(__shfl(gg, 63) - gg);
  }
  __syncthreads();
  {
    h16x8 ak[4], aq[4];
#pragma unroll
    for (int ks = 0; ks < 4; ++ks) {
      ak[ks] = *(const h16x8*)(KH + (w * 16 + fr) * 136 + ks * 32 + fq * 8);
      aq[ks] = *(const h16x8*)(QH + (w * 16 + fr) * 136 + ks * 32 + fq * 8);
    }
#pragma unroll
    for (int jt = 0; jt < 4; ++jt) {
      const int j = jt * 16 + fr;
      const int pj = perm_pos(j);
      if (jt <= w) {
        f32x4 kk = {0.f, 0.f, 0.f, 0.f}, qk = {0.f, 0.f, 0.f, 0.f};
#pragma unroll
        for (int ks = 0; ks < 4; ++ks) {
          h16x8 bk = *(const h16x8*)(KH + (jt * 16 + fr) * 136 + ks * 32 + fq * 8);
          kk = MFMA(ak[ks], bk, kk);
          qk = MFMA(aq[ks], bk, qk);
        }
        const float Gj = sG[j];
        f32x4 lt;
#pragma unroll
        for (int r = 0; r < 4; ++r) {
          const int i = w * 16 + 4 * fq + r;
          const float e = (i >= j) ? expf(sG[i] - Gj) : 0.f;
          lt[r] = (i > j) ? sBeta[i] * kk[r] * e : 0.f;
          ATPi[i * 64 + (((pj >> 3) ^ (i & 7)) << 3) + (pj & 7)] = (h16)(qk[r] * e);
        }
        *(f32x4*)(LT + j * 68 + w * 16 + 4 * fq) = lt;
      } else {
#pragma unroll
        for (int r = 0; r < 4; ++r) {
          const int i = w * 16 + 4 * fq + r;
          ATPi[i * 64 + (((pj >> 3) ^ (i & 7)) << 3) + (pj & 7)] = (h16)0.f;
        }
      }
    }
  }
  __syncthreads();
  v2f r2[32];
  if (tid < 128) {
#pragma unroll
    for (int t = 0; t < 32; ++t) {
      r2[t][0] = (float)VH[(2 * t) * 136 + tid] * sBeta[2 * t];
      r2[t][1] = (float)VH[(2 * t + 1) * 136 + tid] * sBeta[2 * t + 1];
    }
  } else {
#pragma unroll
    for (int t = 0; t < 32; ++t) {
      r2[t][0] = (float)KH[(2 * t) * 136 + (tid - 128)] * sBG[2 * t];
      r2[t][1] = (float)KH[(2 * t + 1) * 136 + (tid - 128)] * sBG[2 * t + 1];
    }
  }
#pragma unroll
  for (int j = 0; j < 63; ++j) {
    const float xj = r2[j >> 1][j & 1];
    const v2f xx = {xj, xj};
#pragma unroll
    for (int i4 = (j + 1) / 4; i4 < 16; ++i4) {
      const f32x4 l = *(const f32x4*)(LT + j * 68 + i4 * 4);
      const v2f l0 = {l[0], l[1]}, l1 = {l[2], l[3]};
      if (i4 * 4 > j) r2[2 * i4] -= l0 * xx;
      else { if (i4 * 4 + 0 > j) r2[2 * i4][0] -= l[0] * xj; if (i4 * 4 + 1 > j) r2[2 * i4][1] -= l[1] * xj; }
      if (i4 * 4 + 2 > j) r2[2 * i4 + 1] -= l1 * xx;
      else { if (i4 * 4 + 3 > j) r2[2 * i4 + 1][1] -= l[3] * xj; }
    }
    __builtin_amdgcn_sched_barrier(0);
  }
  if (tid < 128) {
#pragma unroll
    for (int t8 = 0; t8 < 8; ++t8) {
      h16x8 v;
#pragma unroll
      for (int e = 0; e < 8; ++e) v[e] = (h16)r2[(t8 * 8 + e) >> 1][e & 1];
      *(h16x8*)(UTi + (size_t)tid * 64 + t8 * 8) = v;
    }
  }
  __syncthreads();
  if (tid >= 128) {
    const int pos = perm_pos(tid - 128);
#pragma unroll
    for (int t = 0; t < 64; ++t) VH[t * 136 + pos] = (h16)r2[t >> 1][t & 1];
  }
  __syncthreads();
  for (int rr = 0; rr < 4; ++rr) {
    const int idx = tid + 256 * rr, row = idx >> 4, seg = idx & 15;
    *(h16x8*)(WPi + row * 128 + ((seg ^ (row & 15)) << 3)) = *(const h16x8*)(VH + row * 136 + seg * 8);
  }
  {
    const int dv = tid & 127, th = tid >> 7;
    const float gdv = p.in[I_DNG][dv];
    const h16* zp = PROJ + ((size_t)b * SEQ + c * 64 + th * 32) * LDP + 2560 + h * 128 + dv;
    h16 zv[32];
#pragma unroll
    for (int t = 0; t < 32; ++t) zv[t] = zp[(size_t)t * LDP];
#pragma unroll
    for (int t8 = 0; t8 < 4; ++t8) {
      h16x8 v;
#pragma unroll
      for (int e = 0; e < 8; ++e) v[e] = (h16)(siluf_((float)zv[t8 * 8 + e]) * gdv);
      *(h16x8*)(ZTi + (size_t)dv * 64 + th * 32 + t8 * 8) = v;
    }
  }
#pragma unroll 2
  for (int rr = 0; rr < 4; ++rr) {
    const int idx = tid + 256 * rr, t = idx >> 4, cpos = idx & 15, ks = cpos >> 2, q = cpos & 3;
    const h16x4 lo = *(const h16x4*)(QH + t * 136 + ks * 32 + 4 * q);
    const h16x4 hi = *(const h16x4*)(QH + t * 136 + ks * 32 + 16 + 4 * q);
    const float sc = sEG[t];
    h16x8 o;
#pragma unroll
    for (int e = 0; e < 4; ++e) { o[e] = (h16)((float)lo[e] * sc); o[4 + e] = (h16)((float)hi[e] * sc); }
    *(h16x8*)(QGPi + t * 128 + ((cpos ^ (t & 15)) << 3)) = o;
  }
#pragma unroll 2
  for (int rr = 0; rr < 4; ++rr) {
    const int idx = tid + 256 * rr, dk = idx >> 3, cpos = idx & 7, k2 = cpos >> 2, q = cpos & 3;
    h16x8 o;
#pragma unroll
    for (int e = 0; e < 8; ++e) {
      const int t = k2 * 32 + (e < 4 ? 4 * q + e : 16 + 4 * q + (e - 4));
      o[e] = (h16)((float)KH[t * 136 + dk] * sEL[t]);
    }
    *(h16x8*)(KDTi + dk * 64 + ((cpos ^ (dk & 7)) << 3)) = o;
  }
  const float Glast = sG[63];
  if (tid == 0) DL[item] = expf(Glast);
  __syncthreads();
}

template <int NB>
__device__ __forceinline__ void glds_copy(const h16* __restrict__ g, unsigned char* l) {
#pragma unroll
  for (int i = 0; i < NB / 4096; ++i) {
    const int off = threadIdx.x * 16 + i * 4096;
    __builtin_amdgcn_global_load_lds((const unsigned*)((const unsigned char*)g + off), (unsigned*)(l + off), 16, 0, 0);
  }
}
#define RAW_BARRIER() do { asm volatile("s_waitcnt lgkmcnt(0)" ::: "memory"); __builtin_amdgcn_s_barrier(); asm volatile("" ::: "memory"); } while (0)

__device__ void gdn_chain(const Params& p, int bh, unsigned char* smem) {
  const int tid = threadIdx.x, w = tid >> 6, lane = tid & 63, fr = lane & 15, fq = lane >> 4;
  const float* DL = (const float*)(p.ws + OFF_DL);
  const h16* WPb = (const h16*)(p.ws + OFF_WP) + (size_t)bh * 32 * 64 * 128;
  const h16* KDTb = (const h16*)(p.ws + OFF_KDT) + (size_t)bh * 32 * 128 * 64;
  h16* UTb = (h16*)(p.ws + OFF_UT) + (size_t)bh * 32 * 128 * 64;
  h16* SFb = (h16*)((unsigned char*)p.out + OUT_OFF_SF) + (size_t)bh * 32 * 128 * 128;
  f32x4 S[8][2];
#pragma unroll
  for (int i = 0; i < 8; ++i) { S[i][0] = f32x4{0.f, 0.f, 0.f, 0.f}; S[i][1] = f32x4{0.f, 0.f, 0.f, 0.f}; }
  h16x4 uR[4][2];
  const int uoff = (w * 32 + fr) * 64 + fq * 4;
  glds_copy<16384>(WPb, smem); glds_copy<16384>(KDTb, smem + 16384);
#pragma unroll
  for (int mt = 0; mt < 4; ++mt)
#pragma unroll
    for (int nt = 0; nt < 2; ++nt) uR[mt][nt] = *(const h16x4*)(UTb + uoff + nt * 1024 + mt * 16);
  float dl = DL[bh * 32];
  asm volatile("s_waitcnt vmcnt(0)" ::: "memory");
  RAW_BARRIER();
  for (int c = 0; c < 32; ++c) {
    const int cn = (c + 1 < 32) ? c + 1 : 31;
    const unsigned char* LW = smem + (c & 1) * 32768;
    const unsigned char* LK = LW + 16384;
    unsigned char* LWn = smem + ((c + 1) & 1) * 32768;
    f32x4 uf[4][2];
#pragma unroll
    for (int mt = 0; mt < 4; ++mt)
#pragma unroll
      for (int nt = 0; nt < 2; ++nt)
#pragma unroll
        for (int r = 0; r < 4; ++r) uf[mt][nt][r] = (float)uR[mt][nt][r];
    const float dlc = dl;
    asm volatile("" ::: "memory");
    h16x8 sfr[4][2];
#pragma unroll
    for (int ks = 0; ks < 4; ++ks) { sfr[ks][0] = pack8(S[2 * ks][0], S[2 * ks + 1][0]); sfr[ks][1] = pack8(S[2 * ks][1], S[2 * ks + 1][1]); }
#pragma unroll
    for (int ks = 0; ks < 4; ++ks)
#pragma unroll
      for (int nt = 0; nt < 2; ++nt)
        *(h16x8*)(SFb + ((size_t)(c * 4 + ks) * 8 + w * 2 + nt) * 512 + lane * 8) = sfr[ks][nt];
    glds_copy<16384>(WPb + (size_t)cn * 64 * 128, LWn);
    glds_copy<16384>(KDTb + (size_t)cn * 128 * 64, LWn + 16384);
#pragma unroll
    for (int mt = 0; mt < 4; ++mt)
#pragma unroll
      for (int nt = 0; nt < 2; ++nt)
        uR[mt][nt] = *(const h16x4*)(UTb + (size_t)cn * 128 * 64 + uoff + nt * 1024 + mt * 16);
    dl = DL[bh * 32 + cn];
    asm volatile("" ::: "memory");
    f32x4 vn[4][2];
#pragma unroll
    for (int mt = 0; mt < 4; ++mt) { vn[mt][0] = f32x4{0.f, 0.f, 0.f, 0.f}; vn[mt][1] = vn[mt][0]; }
#pragma unroll
    for (int ks = 0; ks < 4; ++ks)
#pragma unroll
      for (int mt = 0; mt < 4; ++mt) {
        h16x8 aw = *(const h16x8*)(LW + (mt * 16 + fr) * 256 + (((ks * 4 + fq) ^ fr) << 4));
        vn[mt][0] = MFMA(aw, sfr[ks][0], vn[mt][0]);
        vn[mt][1] = MFMA(aw, sfr[ks][1], vn[mt][1]);
      }
#pragma unroll
    for (int mt = 0; mt < 4; ++mt)
#pragma unroll
      for (int r = 0; r < 4; ++r) { vn[mt][0][r] = uf[mt][0][r] - vn[mt][0][r]; vn[mt][1][r] = uf[mt][1][r] - vn[mt][1][r]; }
    h16x8 vfr[2][2];
#pragma unroll
    for (int k2 = 0; k2 < 2; ++k2) { vfr[k2][0] = pack8(vn[2 * k2][0], vn[2 * k2 + 1][0]); vfr[k2][1] = pack8(vn[2 * k2][1], vn[2 * k2 + 1][1]); }
    if (c + 1 < 32) {
#pragma unroll
      for (int k2 = 0; k2 < 2; ++k2)
#pragma unroll
        for (int nt = 0; nt < 2; ++nt)
          *(h16x8*)(UTb + (size_t)c * 128 * 64 + ((size_t)k2 * 8 + w * 2 + nt) * 512 + lane * 8) = vfr[k2][nt];
    }
#pragma unroll
    for (int dkt = 0; dkt < 8; ++dkt) {
      f32x4 s0 = S[dkt][0], s1 = S[dkt][1];
#pragma unroll
      for (int r = 0; r < 4; ++r) { s0[r] *= dlc; s1[r] *= dlc; }
#pragma unroll
      for (int k2 = 0; k2 < 2; ++k2) {
        h16x8 ak = *(const h16x8*)(LK + (dkt * 16 + fr) * 128 + (((k2 * 4 + fq) ^ (fr & 7)) << 4));
        s0 = MFMA(ak, vfr[k2][0], s0);
        s1 = MFMA(ak, vfr[k2][1], s1);
      }
      S[dkt][0] = s0; S[dkt][1] = s1;
    }
    asm volatile("s_waitcnt vmcnt(0)" ::: "memory");
    RAW_BARRIER();
    if (c + 1 == 32) {
#pragma unroll
      for (int k2 = 0; k2 < 2; ++k2)
#pragma unroll
        for (int nt = 0; nt < 2; ++nt)
          *(h16x8*)(UTb + (size_t)c * 128 * 64 + ((size_t)k2 * 8 + w * 2 + nt) * 512 + lane * 8) = vfr[k2][nt];
    }
  }
  asm volatile("s_waitcnt vmcnt(0)" ::: "memory");
  __syncthreads();
}

__device__ void gdn_out_item(const Params& p, int item, unsigned char* smem) {
  unsigned char* LQ = smem;
  unsigned char* LA = smem + 16384;
  float* red = (float*)(smem + 24576);
  const int tid = threadIdx.x, w = tid >> 6, lane = tid & 63, fr = lane & 15, fq = lane >> 4;
  const int c = item & 31, h = (item >> 5) & 3, b = item >> 7;
  h16* MIXIN = (h16*)(p.ws + OFF_MIXIN);
  const h16* QGPi = (const h16*)(p.ws + OFF_QGP) + (size_t)item * 64 * 128;
  const h16* ATPi = (const h16*)(p.ws + OFF_ATP) + (size_t)item * 64 * 64;
  const h16* VFi = (const h16*)(p.ws + OFF_UT) + (size_t)item * 128 * 64;
  const h16* SFi = (const h16*)((unsigned char*)p.out + OUT_OFF_SF) + (size_t)item * 128 * 128;
  const h16* ZTi = (const h16*)((unsigned char*)p.out + OUT_OFF_ZT) + (size_t)item * 128 * 64;
  glds_copy<16384>(QGPi, LQ); glds_copy<8192>(ATPi, LA);
  h16x8 sfr[4][2], vfr[2][2];
#pragma unroll
  for (int ks = 0; ks < 4; ++ks)
#pragma unroll
    for (int nt = 0; nt < 2; ++nt) sfr[ks][nt] = *(const h16x8*)(SFi + ((size_t)ks * 8 + w * 2 + nt) * 512 + lane * 8);
#pragma unroll
  for (int k2 = 0; k2 < 2; ++k2)
#pragma unroll
    for (int nt = 0; nt < 2; ++nt) vfr[k2][nt] = *(const h16x8*)(VFi + ((size_t)k2 * 8 + w * 2 + nt) * 512 + lane * 8);
  h16x4 zR[4][2];
#pragma unroll
  for (int mt = 0; mt < 4; ++mt)
#pragma unroll
    for (int nt = 0; nt < 2; ++nt) zR[mt][nt] = *(const h16x4*)(ZTi + (size_t)(w * 32 + nt * 16 + fr) * 64 + mt * 16 + fq * 4);
  asm volatile("s_waitcnt vmcnt(0)" ::: "memory");
  __syncthreads();
  f32x4 o[4][2];
#pragma unroll
  for (int mt = 0; mt < 4; ++mt) {
    f32x4 o0 = {0.f, 0.f, 0.f, 0.f}, o1 = {0.f, 0.f, 0.f, 0.f};
#pragma unroll
    for (int ks = 0; ks < 4; ++ks) {
      h16x8 aq = *(const h16x8*)(LQ + (mt * 16 + fr) * 256 + (((ks * 4 + fq) ^ fr) << 4));
      o0 = MFMA(aq, sfr[ks][0], o0);
      o1 = MFMA(aq, sfr[ks][1], o1);
    }
#pragma unroll
    for (int k2 = 0; k2 < 2; ++k2) {
      h16x8 aa = *(const h16x8*)(LA + (mt * 16 + fr) * 128 + (((k2 * 4 + fq) ^ (fr & 7)) << 4));
      o0 = MFMA(aa, vfr[k2][0], o0);
      o1 = MFMA(aa, vfr[k2][1], o1);
    }
    o[mt][0] = o0; o[mt][1] = o1;
  }
#pragma unroll
  for (int mt = 0; mt < 4; ++mt)
#pragma unroll
    for (int r = 0; r < 4; ++r) {
      float s = o[mt][0][r] * o[mt][0][r] + o[mt][1][r] * o[mt][1][r];
      s = sum16(s);
      if (fr == 0) red[w * 64 + mt * 16 + 4 * fq + r] = s;
    }
  __syncthreads();
#pragma unroll
  for (int mt = 0; mt < 4; ++mt)
#pragma unroll
    for (int r = 0; r < 4; ++r) {
      const int tl = mt * 16 + 4 * fq + r;
      const float tot = red[tl] + red[64 + tl] + red[128 + tl] + red[192 + tl];
      const float rstd = rsqrtf(tot * (1.f / 128.f) + 1e-6f);
      const size_t tok = (size_t)b * SEQ + c * 64 + tl;
      h16* yp = MIXIN + tok * 1024 + 512 + h * 128 + w * 32 + fr;
      yp[0] = (h16)(o[mt][0][r] * rstd * (float)zR[mt][0][r]);
      yp[16] = (h16)(o[mt][1][r] * rstd * (float)zR[mt][1][r]);
    }
  __syncthreads();
}

#define XB_TMO      128
#define XB_XCNT(j)  (256  + 64 * (j))
#define XB_XSUB(j)  (1280 + 64 * (j))
#define XB_XGEN(j)  (2304 + 64 * (j))
#define XB_TOP      3328
#define XB_TOPGEN   3392
#define XCD_BAR_WORDS 3456
#define XB_SPIN_CAP (1u << 18)
#define LAS __attribute__((address_space(3)))

__device__ __forceinline__ unsigned xb_ld(unsigned* p)              { return __hip_atomic_load(p, __ATOMIC_RELAXED, __HIP_MEMORY_SCOPE_AGENT); }
__device__ __forceinline__ unsigned xb_add(unsigned* p, unsigned v) { return __hip_atomic_fetch_add(p, v, __ATOMIC_RELAXED, __HIP_MEMORY_SCOPE_AGENT); }
__device__ __forceinline__ unsigned xb_xcc_id() { return (unsigned)__builtin_amdgcn_s_getreg((3 << 11) | 20) & 0xFu; }
#define XB_SPIN(cond, bar) do { unsigned _sp = 0; while (cond) { __builtin_amdgcn_s_sleep(1); \
    if ((++_sp & 255u) == 0u) { if (xb_ld(&(bar)[XB_TMO])) break; if (_sp > XB_SPIN_CAP) { atomicAdd(&(bar)[XB_TMO], 1u); break; } } } } while (0)

struct XcdBarrier {
    unsigned* bar; unsigned x;
    volatile LAS unsigned* st;
};

__device__ __forceinline__ XcdBarrier xcd_barrier_post(unsigned* bar, volatile LAS unsigned* st) {
    XcdBarrier b; b.bar = bar; b.x = xb_xcc_id(); b.st = st;
    if (threadIdx.x == 0) (void)xb_add(&bar[XB_XCNT(b.x)], 1u);
    return b;
}
__device__ __forceinline__ void xcd_barrier_complete(unsigned* bar, unsigned x, unsigned& nloc, unsigned& nx) {
    const unsigned G = gridDim.x * gridDim.y * gridDim.z;
    unsigned sum, cnt, mine, sp = 0u;
    for (;;) {
        sum = 0u; cnt = 0u; mine = 0u;
#pragma unroll
        for (unsigned j = 0; j < 16; ++j) { const unsigned c = xb_ld(&bar[XB_XCNT(j)]); sum += c; cnt += (c > 0u) ? 1u : 0u; mine = (j == x) ? c : mine; }
        if (sum == G) break;
        __builtin_amdgcn_s_sleep(1);
        if ((++sp & 255u) == 0u) { if (xb_ld(&bar[XB_TMO])) break; if (sp > XB_SPIN_CAP) { atomicAdd(&bar[XB_TMO], 1u); break; } }
    }
    nloc = mine > 0u ? mine : 1u; nx = cnt > 0u ? cnt : 1u;
}

__device__ __forceinline__ void xcd_barrier(const XcdBarrier& b) {
    asm volatile("s_waitcnt vmcnt(0)" ::: "memory");
    __syncthreads();
    if (threadIdx.x == 0) {
        unsigned* bar = b.bar;
        __builtin_amdgcn_s_waitcnt(0);
        unsigned nloc = b.st[0], nx = b.st[1];
        if (nloc == 0u) { xcd_barrier_complete(bar, b.x, nloc, nx); b.st[0] = nloc; b.st[1] = nx; }
        const unsigned old = xb_add(&bar[XB_XSUB(b.x)], 1u);
        const unsigned gen = old / nloc;
        if (old + 1u == (gen + 1u) * nloc) {
            __builtin_amdgcn_fence(__ATOMIC_RELEASE, "agent");
            asm volatile("s_waitcnt vmcnt(0)" ::: "memory");
            const unsigned og = xb_add(&bar[XB_TOP], 1u);
            const unsigned tg = og / nx;
            if (og + 1u == (tg + 1u) * nx) xb_add(&bar[XB_TOPGEN], 1u);
            else XB_SPIN(xb_ld(&bar[XB_TOPGEN]) == tg, bar);
            __builtin_amdgcn_fence(__ATOMIC_ACQUIRE, "agent");
            xb_add(&bar[XB_XGEN(b.x)], 1u);
            asm volatile("s_waitcnt vmcnt(0)" ::: "memory");
        } else {
            XB_SPIN(xb_ld(&bar[XB_XGEN(b.x)]) == gen, bar);
            __builtin_amdgcn_fence(__ATOMIC_ACQUIRE, "agent");
            asm volatile("s_waitcnt vmcnt(0)" ::: "memory");
        }
    }
    __syncthreads();
}

#ifndef ONLY_PH
#define ONLY_PH -1
#endif
#define RUNPH(n) ((ONLY_PH < 0 || ONLY_PH == (n)) && p.ph_lo <= (n) && (n) <= p.ph_hi)
#define SYNCPH(n) do { if (p.ph_lo <= (n) && (n) < p.ph_hi) xcd_barrier(xb); } while (0)
__global__ void __launch_bounds__(256, 2) hymba_mega(Params p) {
  __shared__ __attribute__((aligned(16))) unsigned char smem[SMEM_BYTES];
  cg::grid_group grid = cg::this_grid();
  const int bid = blockIdx.x, nb = gridDim.x;
  if (p.ph_lo < 0) grid.sync();
  XcdBarrier xb;
  {
    volatile LAS unsigned* st = (volatile LAS unsigned*)(smem + SMEM_BYTES - 16);
    if (threadIdx.x == 0) { st[0] = 0u; st[1] = 0u; st[2] = 0u; st[3] = 0u; }
    __syncthreads();
    if (p.ph_lo < p.ph_hi) xb = xcd_barrier_post((unsigned*)(p.ws + OFF_BAR), st);
    else { xb.bar = (unsigned*)(p.ws + OFF_BAR); xb.x = 0; xb.st = st; }
  }
  {
    if (RUNPH(0)) for (int rep = 0; rep < REP0; ++rep) {
      if (rep) grid.sync();
      phase0(p, smem);
    }
    SYNCPH(0);
    if (RUNPH(1)) for (int rep = 0; rep < REP1; ++rep) {
      if (rep) grid.sync();
      const h16* A0 = (const h16*)((unsigned char*)p.out + OUT_OFF_A0);
      const h16* W = (const h16*)(p.ws + OFF_WIN);
      for (int t = bid; t < 256 * 25; t += nb) gemm_tile<EPI_PROJ>(p, A0, 1024, W, 1024, 1024, (t / 25) * 128, (t % 25) * 128, smem);
    }
    SYNCPH(1);
    if (RUNPH(2)) for (int rep = 0; rep < REP2; ++rep) {
      if (rep) grid.sync();
      for (int it = bid; it < 512 + 2048; it += nb) {
        if (it < 2048) gdn_pre_item(p, it, smem);
        else ssm_item(p, (it - 2048) >> 5, (it - 2048) & 31, smem);
      }
    }
    SYNCPH(2);
    if (RUNPH(3)) {
      if (bid < 64) gdn_chain(p, bid, smem);
      unsigned* ctr = (unsigned*)(p.ws + OFF_CTR);
      volatile int* bc = (volatile int*)(smem + SMEM_BYTES - 4);
      const h16* YPRE = (const h16*)((unsigned char*)p.out + OUT_OFF_YPRE);
      for (;;) {
        __syncthreads();
        if (threadIdx.x == 0) *bc = (int)atomicAdd(ctr, 1u);
        __syncthreads();
        const int t = *bc;
        if (t >= 1024 + 2048) break;
        if (t < 1024) gemm_tile<EPI_GLU>(p, YPRE, 512, (const h16*)(p.ws + OFF_WGLU), 512, 512, (t >> 2) * 128, (t & 3) * 128, smem);
        else gemm_tile<EPI_PLE>(p, (const h16*)(p.ws + OFF_PB), 256, (const h16*)(p.ws + OFF_WPP), 256, 256, ((t - 1024) >> 3) * 128, ((t - 1024) & 7) * 128, smem);
      }
    }
    SYNCPH(3);
    if (RUNPH(4)) {
      for (int it = bid; it < 2048; it += nb) gdn_out_item(p, it, smem);
    }
    SYNCPH(4);
    if (RUNPH(5)) {
      for (int t = bid; t < 2048; t += nb)
        gemm_tile<EPI_OUT>(p, (const h16*)(p.ws + OFF_MIXIN), 1024, (const h16*)(p.ws + OFF_WOUT), 1024, 1024, (t >> 3) * 128, (t & 7) * 128, smem);
    }
    SYNCPH(5);
    if (RUNPH(6)) {
      for (int t = bid; t < 2048; t += nb)
        gemm_tile<EPI_GATE>(p, (const h16*)(p.ws + OFF_PROJ), 1024, (const h16*)(p.ws + OFF_WGATE), 1024, 1024, (t >> 3) * 128, (t & 7) * 128, smem);
    }
    SYNCPH(6);
    if (RUNPH(7)) {
      const int wid = threadIdx.x >> 6, lane = threadIdx.x & 63;
      const float* OPART = (const float*)(p.ws + OFF_OPART);
      const float4* g4 = (const float4*)p.in[I_FING];
      const h16* H2B = (const h16*)(p.ws + OFF_MIXIN);
      for (int row = bid * 4 + wid; row < T_TOK; row += nb * 4) {
        float s = (lane < 8) ? OPART[(size_t)row * 8 + lane] : 0.f;
        const h16x8 a = *(const h16x8*)(H2B + (size_t)row * 1024 + lane * 8);
        const h16x8 b = *(const h16x8*)(H2B + (size_t)row * 1024 + 512 + lane * 8);
        s = wave_sum(s);
        const float rstd = rsqrtf(s * (1.f / 1024.f) + 1e-6f);
        float4* orow = (float4*)(p.out + (size_t)row * 1024);
        const float4 g0 = g4[lane * 2], g1 = g4[lane * 2 + 1], g2 = g4[128 + lane * 2], g3 = g4[128 + lane * 2 + 1];
        float4 o0, o1, o2, o3;
        o0.x = (float)a[0] * rstd * g0.x; o0.y = (float)a[1] * rstd * g0.y; o0.z = (float)a[2] * rstd * g0.z; o0.w = (float)a[3] * rstd * g0.w;
        o1.x = (float)a[4] * rstd * g1.x; o1.y = (float)a[5] * rstd * g1.y; o1.z = (float)a[6] * rstd * g1.z; o1.w = (float)a[7] * rstd * g1.w;
        o2.x = (float)b[0] * rstd * g2.x; o2.y = (float)b[1] * rstd * g2.y; o2.z = (float)b[2] * rstd * g2.z; o2.w = (float)b[3] * rstd * g2.w;
        o3.x = (float)b[4] * rstd * g3.x; o3.y = (float)b[5] * rstd * g3.y; o3.z = (float)b[6] * rstd * g3.z; o3.w = (float)b[7] * rstd * g3.w;
        orow[lane * 2] = o0; orow[lane * 2 + 1] = o1; orow[128 + lane * 2] = o2; orow[128 + lane * 2 + 1] = o3;
      }
    }
  }
}

extern "C" void kernel_launch(void* const* d_in, const int* in_sizes, int n_in, void* d_out, int out_size, void* d_ws, size_t ws_size,
                              hipStream_t stream) {
  static int grid_blocks = 0;
  if (!grid_blocks) {
    int dev = 0, cus = 0, per_cu = 0;
    hipGetDevice(&dev);
    hipDeviceGetAttribute(&cus, hipDeviceAttributeMultiprocessorCount, dev);
    hipOccupancyMaxActiveBlocksPerMultiprocessor(&per_cu, hymba_mega, 256, 0);
    if (per_cu > 2) per_cu = 2;
    if (per_cu < 1) per_cu = 1;
    grid_blocks = cus * per_cu;
  }
  if (n_in != 23 || ws_size < WS_END || out_size != T_TOK * 1024) {
    fprintf(stderr, "kernel_launch: unexpected sizes n_in=%d ws=%zu (need %zu) out=%d\n", n_in, ws_size, (size_t)WS_END, out_size);
    return;
  }
  Params p{};
  for (int i = 0; i < 23; ++i) p.in[i] = (const float*)d_in[i];
  p.out = (float*)d_out;
  p.ws = (unsigned char*)d_ws;
  if (hipMemsetAsync((unsigned char*)d_ws + OFF_BAR, 0, 16384, stream) != hipSuccess) { fprintf(stderr, "kernel_launch: memset of control words failed\n"); return; }
#if MULTI_LAUNCH
  for (int ph = 0; ph < NPH; ++ph) {
    p.ph_lo = ph; p.ph_hi = ph;
    hipLaunchKernelGGL(hymba_mega, dim3(grid_blocks), dim3(256), 0, stream, p);
  }
#else
  p.ph_lo = 0; p.ph_hi = NPH - 1;
  void* args[] = {&p};
  hipError_t e = hipLaunchCooperativeKernel((void*)hymba_mega, dim3(grid_blocks), dim3(256), args, 0, stream);
  if (e != hipSuccess) fprintf(stderr, "cooperative launch failed: %s (grid %d)\n", hipGetErrorString(e), grid_blocks);
#endif
}
```

```cpp
#include <hip/hip_runtime.h>
#include <hip/hip_cooperative_groups.h>
#include <cstdio>
namespace cg = cooperative_groups;

#ifndef REP0
#define REP0 1
#endif
#ifndef REP1
#define REP1 1
#endif
#ifndef REP2
#define REP2 1
#endif
#ifndef REP3
#define REP3 1
#endif
#ifndef REP4
#define REP4 1
#endif
#ifndef MULTI_LAUNCH
#define MULTI_LAUNCH 0
#endif

typedef _Float16 h16;
typedef __attribute__((ext_vector_type(8))) _Float16 h16x8;
typedef __attribute__((ext_vector_type(4))) _Float16 h16x4;
typedef __attribute__((ext_vector_type(4))) float f32x4;
typedef __attribute__((ext_vector_type(2))) float v2f;

#define MFMA(a, b, c) __builtin_amdgcn_mfma_f32_16x16x32_f16((a), (b), (c), 0, 0, 0)

constexpr int T_TOK = 32768;
constexpr int SEQ = 2048;
constexpr int NPH = 8;
constexpr int LDP = 3072;
constexpr int SMEM_BYTES = 72704;

constexpr size_t SZ_WIN = (size_t)3200 * 1024 * 2;
constexpr size_t SZ_WGLU = (size_t)512 * 512 * 2;
constexpr size_t SZ_WOUT = (size_t)1024 * 1024 * 2;
constexpr size_t SZ_WPP = (size_t)1024 * 256 * 2;
constexpr size_t SZ_WGATE = (size_t)1024 * 1024 * 2;
constexpr size_t OFF_WIN = 0;
constexpr size_t OFF_WGLU = OFF_WIN + SZ_WIN;
constexpr size_t OFF_WOUT = OFF_WGLU + SZ_WGLU;
constexpr size_t OFF_WPP = OFF_WOUT + SZ_WOUT;
constexpr size_t OFF_WGATE = OFF_WPP + SZ_WPP;
constexpr size_t OFF_PB = OFF_WGATE + SZ_WGATE;
constexpr size_t OFF_PROJ = OFF_PB + (size_t)T_TOK * 256 * 2;
constexpr size_t OFF_AB = OFF_PROJ + (size_t)T_TOK * LDP * 2;
constexpr size_t OFF_KTAB = OFF_AB + (size_t)T_TOK * 8 * 4;
constexpr size_t OFF_ETAB = OFF_KTAB + (size_t)32 * 33 * 256 * 2;
constexpr size_t OFF_FTAB = OFF_ETAB + (size_t)32 * 128 * 512 * 2;
constexpr size_t OFF_ALPOW = OFF_FTAB + (size_t)32 * 512 * 128 * 2;
constexpr size_t OFF_DL = OFF_ALPOW + (size_t)32 * 64 * 2 * 4;
constexpr size_t OFF_EPART = OFF_DL + (size_t)2048 * 4;
constexpr size_t OFF_OPART = OFF_EPART + (size_t)T_TOK * 16 * 4;
constexpr size_t OFF_MIXIN = OFF_OPART + (size_t)T_TOK * 16 * 4;
constexpr size_t OFF_WP = OFF_MIXIN + (size_t)T_TOK * 1024 * 2;
constexpr size_t OFF_QGP = OFF_WP + (size_t)2048 * 64 * 128 * 2;
constexpr size_t OFF_KDT = OFF_QGP + (size_t)2048 * 64 * 128 * 2;
constexpr size_t OFF_UT = OFF_KDT + (size_t)2048 * 128 * 64 * 2;
constexpr size_t OFF_ATP = OFF_UT + (size_t)2048 * 128 * 64 * 2;
constexpr size_t OFF_EH = OFF_ATP + (size_t)2048 * 64 * 64 * 2;
constexpr size_t OFF_BAR = OFF_EH + (size_t)T_TOK * 1024 * 2;
constexpr size_t WS_END = OFF_BAR + 16384;
constexpr size_t OFF_CTR = OFF_BAR + 15360;
constexpr size_t OUT_OFF_A0 = 0;
constexpr size_t OUT_OFF_SF = 0;
constexpr size_t OUT_OFF_YPRE = (size_t)T_TOK * 1024 * 2;
constexpr size_t OUT_OFF_ZT = OUT_OFF_YPRE + (size_t)T_TOK * 512 * 2;

struct Params {
  const float* in[23];
  float* out;
  unsigned char* ws;
  int ph_lo, ph_hi;
};

enum { I_X = 0, I_P, I_NMG, I_WIN, I_ARE, I_AIM, I_BRE, I_BIM, I_CRE, I_CIM, I_D, I_LOGDT, I_WGLU, I_BGLU,
       I_CONVW, I_ALOG, I_DTB, I_DNG, I_WOUT, I_WPP, I_PLEG, I_WGATE, I_FING };

__device__ __forceinline__ float wave_sum(float v) {
#pragma unroll
  for (int o = 32; o > 0; o >>= 1) v += __shfl_xor(v, o);
  return v;
}
__device__ __forceinline__ float sum16(float v) {
  v += __shfl_xor(v, 1); v += __shfl_xor(v, 2); v += __shfl_xor(v, 4); v += __shfl_xor(v, 8);
  return v;
}
__device__ __forceinline__ float sigmoidf_(float x) { return 1.f / (1.f + __expf(-x)); }
__device__ __forceinline__ float siluf_(float x) { return x / (1.f + __expf(-x)); }
__device__ __forceinline__ float gelu_tanh(float y) {
  float z = 0.7978845608028654f * (y + 0.044715f * y * y * y);
  return 0.5f * y * (1.f + tanhf(z));
}
__device__ __forceinline__ h16x8 pack8(f32x4 lo, f32x4 hi) {
  h16x8 r;
  r[0] = (h16)lo[0]; r[1] = (h16)lo[1]; r[2] = (h16)lo[2]; r[3] = (h16)lo[3];
  r[4] = (h16)hi[0]; r[5] = (h16)hi[1]; r[6] = (h16)hi[2]; r[7] = (h16)hi[3];
  return r;
}
__device__ __forceinline__ int perm_pos(int n) { return (n & ~31) + (((n & 15) >> 2) << 3) + (((n >> 4) & 1) << 2) + (n & 3); }
__device__ __forceinline__ int perm_inv(int pos) {
  int q5 = pos & 31, qq = q5 >> 3, jj = q5 & 7;
  return (pos & ~31) + (jj < 4 ? 4 * qq + jj : 16 + 4 * qq + (jj - 4));
}

__device__ void transpose_w(const float* __restrict__ W, int K, int N, int Npad, h16* __restrict__ WT, int t, float* tile) {
  const int ntn = Npad / 64;
  const int kt = t / ntn, nt = t % ntn, k0 = kt * 64, n0 = nt * 64;
  const int tx = threadIdx.x & 63, ty = threadIdx.x >> 6;
  for (int r = 0; r < 16; ++r) {
    int k = ty * 16 + r, n = n0 + tx;
    tile[k * 65 + tx] = (n < N) ? W[(size_t)(k0 + k) * N + n] : 0.f;
  }
  __syncthreads();
  for (int r = 0; r < 16; ++r) {
    int n = ty * 16 + r;
    WT[(size_t)(n0 + n) * K + k0 + tx] = (h16)tile[tx * 65 + n];
  }
  __syncthreads();
}

__device__ void ssm_table_item(const Params& p, int g, int d, float* lds) {
  float2* sAp = (float2*)lds;
  float2* sW = sAp + 64;
  const int tid = threadIdx.x;
  h16* KTAB = (h16*)(p.ws + OFF_KTAB);
  h16* ETAB = (h16*)(p.ws + OFF_ETAB);
  h16* FTAB = (h16*)(p.ws + OFF_FTAB);
  float* ALPOW = (float*)(p.ws + OFF_ALPOW);
  float* sBr = lds + 256; float* sBi = sBr + 1024; float* sCr = sBi + 1024; float* sCi = sCr + 16 * 65;
  {
    const float4 vbr = ((const float4*)(p.in[I_BRE] + g * 1024))[tid], vbi = ((const float4*)(p.in[I_BIM] + g * 1024))[tid];
    const float4 vcr = ((const float4*)(p.in[I_CRE] + g * 1024))[tid], vci = ((const float4*)(p.in[I_CIM] + g * 1024))[tid];
    *(float4*)(sBr + tid * 4) = vbr; *(float4*)(sBi + tid * 4) = vbi;
    const int ch = (tid * 4) >> 6, cp = (tid * 4) & 63;
    sCr[ch * 65 + cp] = vcr.x; sCr[ch * 65 + cp + 1] = vcr.y; sCr[ch * 65 + cp + 2] = vcr.z; sCr[ch * 65 + cp + 3] = vcr.w;
    sCi[ch * 65 + cp] = vci.x; sCi[ch * 65 + cp + 1] = vci.y; sCi[ch * 65 + cp + 2] = vci.z; sCi[ch * 65 + cp + 3] = vci.w;
  }
  if (tid < 64) {
    const int pp = tid;
    float lr = p.in[I_ARE][g * 64 + pp], li = p.in[I_AIM][g * 64 + pp], dt = expf(p.in[I_LOGDT][g]);
    float mag = expf(lr * dt), ang = li * dt;
    float abr = mag * cosf(ang), abi = mag * sinf(ang);
    float nr = abr - 1.f, ni = abi, den = lr * lr + li * li;
    float cr = (nr * lr + ni * li) / den, ci = (ni * lr - nr * li) / den;
    float apr = 1.f, api = 0.f;
    for (int k = 0; k < d; ++k) { float t0 = apr * abr - api * abi; api = apr * abi + api * abr; apr = t0; }
    sAp[pp] = make_float2(apr, api);
    sW[pp] = make_float2(apr * cr - api * ci, apr * ci + api * cr);
    if (d == 32) { ALPOW[(g * 64 + pp) * 2] = apr; ALPOW[(g * 64 + pp) * 2 + 1] = api; }
  }
  __syncthreads();
  if (d < 32) {
    {
      const int h = tid >> 4, hp = tid & 15;
      float acc = 0.f;
#pragma unroll 8
      for (int pp = 0; pp < 64; ++pp) {
        float2 W = sW[pp];
        float br = sBr[pp * 16 + hp], bi = sBi[pp * 16 + hp];
        float wbr = W.x * br - W.y * bi, wbi = W.x * bi + W.y * br;
        float cr = sCr[h * 65 + pp], ci = sCi[h * 65 + pp];
        acc += cr * wbr - ci * wbi;
      }
      KTAB[(size_t)(g * 33 + d + 1) * 256 + h * 16 + hp] = (h16)acc;
      if (d == 0) KTAB[(size_t)(g * 33) * 256 + tid] = (h16)0.f;
    }
    {
      const int i = 31 - d;
#pragma unroll
      for (int r = 0; r < 4; ++r) {
        int idx = tid + 256 * r, pp = idx >> 4, hp = idx & 15;
        float2 W = sW[pp];
        float br = sBr[pp * 16 + hp], bi = sBi[pp * 16 + hp];
        float wbr = W.x * br - W.y * bi, wbi = W.x * bi + W.y * br;
        ETAB[((size_t)g * 128 + pp) * 512 + i * 16 + hp] = (h16)wbr;
        ETAB[((size_t)g * 128 + 64 + pp) * 512 + i * 16 + hp] = (h16)wbi;
      }
    }
  }
  if (d >= 1) {
    const int j = d - 1;
#pragma unroll
    for (int r = 0; r < 4; ++r) {
      int idx = tid + 256 * r, h = idx >> 6, pp = idx & 63;
      float2 Ap = sAp[pp];
      float cr = sCr[h * 65 + pp], ci = sCi[h * 65 + pp];
      float re = cr * Ap.x - ci * Ap.y, im = cr * Ap.y + ci * Ap.x;
      FTAB[((size_t)g * 512 + j * 16 + h) * 128 + pp] = (h16)re;
      FTAB[((size_t)g * 512 + j * 16 + h) * 128 + 64 + pp] = (h16)(-im);
    }
  }
  __syncthreads();
}

__device__ void phase0(const Params& p, unsigned char* smem) {
  const int bid = blockIdx.x, nb = gridDim.x, tid = threadIdx.x, wid = tid >> 6, lane = tid & 63;
  float* tile = (float*)smem;
  for (int t = bid; t < 1440; t += nb) {
    if (t < 800) transpose_w(p.in[I_WIN], 1024, 3080, 3200, (h16*)(p.ws + OFF_WIN), t, tile);
    else if (t < 864) transpose_w(p.in[I_WGLU], 512, 512, 512, (h16*)(p.ws + OFF_WGLU), t - 800, tile);
    else if (t < 1120) transpose_w(p.in[I_WOUT], 1024, 1024, 1024, (h16*)(p.ws + OFF_WOUT), t - 864, tile);
    else if (t < 1184) transpose_w(p.in[I_WPP], 256, 1024, 1024, (h16*)(p.ws + OFF_WPP), t - 1120, tile);
    else transpose_w(p.in[I_WGATE], 1024, 1024, 1024, (h16*)(p.ws + OFF_WGATE), t - 1184, tile);
  }
  for (int it = bid; it < 32 * 33; it += nb) ssm_table_item(p, it / 33, it % 33, (float*)smem);
  {
    h16* A0 = (h16*)((unsigned char*)p.out + OUT_OFF_A0);
    const float* x = p.in[I_X];
    const float4* g4 = (const float4*)p.in[I_NMG];
    for (int row = bid * 4 + wid; row < T_TOK; row += nb * 4) {
      const float4* xr = (const float4*)(x + (size_t)row * 1024);
      float4 v[4];
      float ss = 0.f;
#pragma unroll
      for (int i = 0; i < 4; ++i) {
        v[i] = xr[lane + i * 64];
        ss += v[i].x * v[i].x + v[i].y * v[i].y + v[i].z * v[i].z + v[i].w * v[i].w;
      }
      ss = wave_sum(ss);
      float rstd = rsqrtf(ss * (1.f / 1024.f) + 1e-6f);
#pragma unroll
      for (int i = 0; i < 4; ++i) {
        float4 g = g4[lane + i * 64];
        h16x4 o;
        o[0] = (h16)(v[i].x * rstd * g.x); o[1] = (h16)(v[i].y * rstd * g.y);
        o[2] = (h16)(v[i].z * rstd * g.z); o[3] = (h16)(v[i].w * rstd * g.w);
        *(h16x4*)(A0 + (size_t)row * 1024 + (lane + i * 64) * 4) = o;
      }
    }
  }
  {
    h16* PB = (h16*)(p.ws + OFF_PB);
    const float4* p4 = (const float4*)p.in[I_P];
    const size_t n4 = (size_t)T_TOK * 256 / 4;
    for (size_t i = (size_t)bid * 256 + tid; i < n4; i += (size_t)nb * 256) {
      float4 v = p4[i];
      h16x4 o;
      o[0] = (h16)v.x; o[1] = (h16)v.y; o[2] = (h16)v.z; o[3] = (h16)v.w;
      *(h16x4*)(PB + i * 4) = o;
    }
  }
}

enum { EPI_PROJ = 0, EPI_GLU, EPI_PLE, EPI_OUT, EPI_GATE };

template <int EPI>
__device__ __forceinline__ void gemm_tile(const Params& p, const h16* __restrict__ A, int lda, const h16* __restrict__ Bt, int ldb,
                                          int K, int brow, int bcol, unsigned char* smem) {
  const int tid = threadIdx.x, wid = tid >> 6, lane = tid & 63, wr = wid >> 1, wc = wid & 1, fr = lane & 15, fq = lane >> 4;
  f32x4 acc[4][4];
#pragma unroll
  for (int m = 0; m < 4; ++m)
#pragma unroll
    for (int n = 0; n < 4; ++n) acc[m][n] = f32x4{0.f, 0.f, 0.f, 0.f};
  const int nk = K / 64;
  const h16* ga[4]; const h16* gb[4];
#pragma unroll
  for (int i = 0; i < 4; ++i) {
    const int L = tid + 256 * i, row = L >> 3, cs = (L & 7) ^ (row & 7);
    ga[i] = A + (size_t)(brow + row) * lda + cs * 8;
    gb[i] = Bt + (size_t)(bcol + row) * ldb + cs * 8;
  }
#define GEMM_STAGE(t_, buf_) do { \
    unsigned char* sa_ = smem + (buf_) * 32768 + tid * 16; \
    _Pragma("unroll") for (int i_ = 0; i_ < 4; ++i_) { \
      __builtin_amdgcn_global_load_lds((const unsigned*)(ga[i_] + (t_) * 64), (unsigned*)(sa_ + i_ * 4096), 16, 0, 0); \
      __builtin_amdgcn_global_load_lds((const unsigned*)(gb[i_] + (t_) * 64), (unsigned*)(sa_ + 16384 + i_ * 4096), 16, 0, 0); \
    } \
  } while (0)
  GEMM_STAGE(0, 0);
  for (int t = 0; t < nk; ++t) {
    asm volatile("s_waitcnt vmcnt(0)" ::: "memory");
    __syncthreads();
    if (t + 1 < nk) GEMM_STAGE(t + 1, (t + 1) & 1);
    const unsigned char* SA = smem + (t & 1) * 32768;
    const unsigned char* SB = SA + 16384;
#pragma unroll
    for (int kk = 0; kk < 2; ++kk) {
      h16x8 af[4], bf[4];
      const int pos = ((kk * 4 + fq) ^ (fr & 7)) << 4;
#pragma unroll
      for (int m = 0; m < 4; ++m) {
        af[m] = *(const h16x8*)(SA + (wr * 64 + m * 16 + fr) * 128 + pos);
        bf[m] = *(const h16x8*)(SB + (wc * 64 + m * 16 + fr) * 128 + pos);
      }
#pragma unroll
      for (int m = 0; m < 4; ++m)
#pragma unroll
        for (int n = 0; n < 4; ++n) acc[m][n] = MFMA(af[m], bf[n], acc[m][n]);
    }
  }
#undef GEMM_STAGE
  __syncthreads();
  float* CT = (float*)smem;
#pragma unroll
  for (int m = 0; m < 4; ++m)
#pragma unroll
    for (int n = 0; n < 4; ++n)
#pragma unroll
      for (int j = 0; j < 4; ++j) CT[(wr * 64 + m * 16 + fq * 4 + j) * 132 + wc * 64 + n * 16 + fr] = acc[m][n][j];
  __syncthreads();
  const int c4 = tid & 31;
#pragma unroll 2
  for (int it = 0; it < 16; ++it) {
    const int rl = it * 8 + (tid >> 5);
    const size_t row = (size_t)brow + rl;
    const int col = bcol + c4 * 4;
    const float4 v = *(const float4*)(CT + rl * 132 + c4 * 4);
    if constexpr (EPI == EPI_PROJ) {
      if (bcol < 3072) {
        h16x4 o; o[0] = (h16)v.x; o[1] = (h16)v.y; o[2] = (h16)v.z; o[3] = (h16)v.w;
        *(h16x4*)((h16*)(p.ws + OFF_PROJ) + row * LDP + col) = o;
      } else if (c4 < 2) {
        *(float4*)((float*)(p.ws + OFF_AB) + row * 8 + c4 * 4) = v;
      }
    } else if constexpr (EPI == EPI_GLU) {
      const h16x4 y = *(const h16x4*)((const h16*)((unsigned char*)p.out + OUT_OFF_YPRE) + row * 512 + col);
      const h16x4 z = *(const h16x4*)((const h16*)(p.ws + OFF_PROJ) + row * LDP + 512 + col);
      const float4 bb = *(const float4*)(p.in[I_BGLU] + col);
      h16x4 o;
      o[0] = (h16)((float)y[0] * sigmoidf_(v.x + bb.x) * siluf_((float)z[0]));
      o[1] = (h16)((float)y[1] * sigmoidf_(v.y + bb.y) * siluf_((float)z[1]));
      o[2] = (h16)((float)y[2] * sigmoidf_(v.z + bb.z) * siluf_((float)z[2]));
      o[3] = (h16)((float)y[3] * sigmoidf_(v.w + bb.w) * siluf_((float)z[3]));
      *(h16x4*)((h16*)(p.ws + OFF_MIXIN) + row * 1024 + col) = o;
    } else if constexpr (EPI == EPI_PLE) {
      h16x4 o; o[0] = (h16)v.x; o[1] = (h16)v.y; o[2] = (h16)v.z; o[3] = (h16)v.w;
      *(h16x4*)((h16*)(p.ws + OFF_EH) + row * 1024 + col) = o;
      float s = v.x * v.x + v.y * v.y + v.z * v.z + v.w * v.w;
      s = sum16(s); s += __shfl_xor(s, 16);
      if (c4 == 0) ((float*)(p.ws + OFF_EPART))[row * 8 + (bcol >> 7)] = s;
    } else if constexpr (EPI == EPI_OUT) {
      const float4 xv = *(const float4*)(p.in[I_X] + row * 1024 + col);
      float4 hv; hv.x = xv.x + v.x; hv.y = xv.y + v.y; hv.z = xv.z + v.z; hv.w = xv.w + v.w;
      h16x4 o; o[0] = (h16)hv.x; o[1] = (h16)hv.y; o[2] = (h16)hv.z; o[3] = (h16)hv.w;
      *(h16x4*)((h16*)(p.ws + OFF_PROJ) + row * 1024 + col) = o;
    } else if constexpr (EPI == EPI_GATE) {
      const float4 e0 = *(const float4*)((const float*)(p.ws + OFF_EPART) + row * 8);
      const float4 e1 = *(const float4*)((const float*)(p.ws + OFF_EPART) + row * 8 + 4);
      const float rs = rsqrtf((e0.x + e0.y + e0.z + e0.w + e1.x + e1.y + e1.z + e1.w) * (1.f / 1024.f) + 1e-6f);
      const h16x4 eh = *(const h16x4*)((const h16*)(p.ws + OFF_EH) + row * 1024 + col);
      const float4 pg = *(const float4*)(p.in[I_PLEG] + col);
      const h16x4 hb = *(const h16x4*)((const h16*)(p.ws + OFF_PROJ) + row * 1024 + col);
      float4 hv;
      hv.x = (float)hb[0] + sigmoidf_(v.x) * ((float)eh[0] * rs * pg.x);
      hv.y = (float)hb[1] + sigmoidf_(v.y) * ((float)eh[1] * rs * pg.y);
      hv.z = (float)hb[2] + sigmoidf_(v.z) * ((float)eh[2] * rs * pg.z);
      hv.w = (float)hb[3] + sigmoidf_(v.w) * ((float)eh[3] * rs * pg.w);
      {
        h16x4 o; o[0] = (h16)hv.x; o[1] = (h16)hv.y; o[2] = (h16)hv.z; o[3] = (h16)hv.w;
        *(h16x4*)((h16*)(p.ws + OFF_MIXIN) + row * 1024 + col) = o;
      }
      float s = hv.x * hv.x + hv.y * hv.y + hv.z * hv.z + hv.w * hv.w;
      s = sum16(s); s += __shfl_xor(s, 16);
      if (c4 == 0) ((float*)(p.ws + OFF_OPART))[row * 8 + (bcol >> 7)] = s;
    }
  }
  __syncthreads();
}

__device__ void ssm_item(const Params& p, int b, int g, unsigned char* smem) {
  float* LOCAL = (float*)smem;
  h16* SPREV = (h16*)(smem + 33792);
  h16* KT = (h16*)(smem + 51200);
  int tid_ = threadIdx.x;
  asm volatile("" : "+v"(tid_));
  const int tid = tid_, w = tid >> 6, lane = tid & 63, fr = lane & 15, fq = lane >> 4;
  const h16* PROJ = (const h16*)(p.ws + OFF_PROJ);
  const h16* Eg = (const h16*)(p.ws + OFF_ETAB) + (size_t)g * 128 * 512;
  const h16* Kg = (const h16*)(p.ws + OFF_KTAB) + (size_t)g * 33 * 256;
  const h16* Fg = (const h16*)(p.ws + OFF_FTAB) + (size_t)g * 512 * 128;
  const float* ALPOW = (const float*)(p.ws + OFF_ALPOW);
  h16* YPRE = (h16*)((unsigned char*)p.out + OUT_OFF_YPRE);
  const int nchunk = w * 16 + fr;
  const size_t tok0 = (size_t)b * SEQ + (size_t)nchunk * 32;
  for (int idx = tid; idx < 33 * 256 / 8; idx += 256) *(h16x8*)(KT + idx * 8) = *(const h16x8*)(Kg + idx * 8);
  h16x8 uf[16];
#pragma unroll
  for (int ks = 0; ks < 16; ++ks) {
    const int i = 2 * ks + (fq >> 1);
    uf[ks] = *(const h16x8*)(PROJ + (tok0 + i) * LDP + g * 16 + (fq & 1) * 8);
  }
  {
    h16x8 ea[8];
#pragma unroll
    for (int ks = 0; ks < 8; ++ks) ea[ks] = *(const h16x8*)(Eg + (size_t)fr * 512 + ks * 32 + fq * 8);
    f32x4 acc = {0.f, 0.f, 0.f, 0.f};
#pragma unroll 1
    for (int it = 0; it < 16; ++it) {
      const int mt = it >> 1, hf = it & 1;
      const int itn = it < 15 ? it + 1 : 15;
      h16x8 en[8];
#pragma unroll
      for (int ks = 0; ks < 8; ++ks) en[ks] = *(const h16x8*)(Eg + (size_t)((itn >> 1) * 16 + fr) * 512 + ((itn & 1) * 8 + ks) * 32 + fq * 8);
      if (hf == 0) {
#pragma unroll
        for (int ks = 0; ks < 8; ++ks) acc = MFMA(ea[ks], uf[ks], acc);
      } else {
#pragma unroll
        for (int ks = 0; ks < 8; ++ks) acc = MFMA(ea[ks], uf[8 + ks], acc);
        *(f32x4*)(LOCAL + nchunk * 132 + mt * 16 + fq * 4) = acc;
        acc = f32x4{0.f, 0.f, 0.f, 0.f};
      }
#pragma unroll
      for (int ks = 0; ks < 8; ++ks) ea[ks] = en[ks];
    }
  }
  __syncthreads();
  if (tid < 64) {
    const int pp = tid;
    const float ar = ALPOW[(g * 64 + pp) * 2], ai = ALPOW[(g * 64 + pp) * 2 + 1];
    float sr = 0.f, si = 0.f;
#pragma unroll 4
    for (int c = 0; c < 64; ++c) {
      SPREV[c * 136 + pp] = (h16)sr;
      SPREV[c * 136 + 64 + pp] = (h16)si;
      float lr = LOCAL[c * 132 + pp], li = LOCAL[c * 132 + 64 + pp];
      float nr = ar * sr - ai * si + lr;
      float ni = ar * si + ai * sr + li;
      sr = nr; si = ni;
    }
  }
  __syncthreads();
  h16x8 sf[4];
#pragma unroll
  for (int ks = 0; ks < 4; ++ks) sf[ks] = *(const h16x8*)(SPREV + nchunk * 136 + ks * 32 + fq * 8);
  const float4 Dv = *(const float4*)(p.in[I_D] + g * 16 + fq * 4);
  h16x8 fa[4];
#pragma unroll
  for (int ks = 0; ks < 4; ++ks) fa[ks] = *(const h16x8*)(Fg + (size_t)fr * 128 + ks * 32 + fq * 8);
  h16x4 u4 = *(const h16x4*)(PROJ + tok0 * LDP + g * 16 + fq * 4);
#pragma unroll 1
  for (int j = 0; j < 32; ++j) {
    const int jn = j < 31 ? j + 1 : 31;
    h16x8 fn[4];
#pragma unroll
    for (int ks = 0; ks < 4; ++ks) fn[ks] = *(const h16x8*)(Fg + (size_t)(jn * 16 + fr) * 128 + ks * 32 + fq * 8);
    const h16x4 un = *(const h16x4*)(PROJ + (tok0 + jn) * LDP + g * 16 + fq * 4);
    f32x4 acc = {0.f, 0.f, 0.f, 0.f};
#pragma unroll
    for (int ks = 0; ks < 16; ++ks) {
      if (2 * ks <= j) {
        const int dd = j - 2 * ks - (fq >> 1) + 1;
        h16x8 a = *(const h16x8*)(KT + dd * 256 + fr * 16 + (fq & 1) * 8);
        acc = MFMA(a, uf[ks], acc);
      }
    }
#pragma unroll
    for (int ks = 0; ks < 4; ++ks) acc = MFMA(fa[ks], sf[ks], acc);
    const size_t tok = tok0 + j;
    h16x4 o;
    o[0] = (h16)gelu_tanh(acc[0] + Dv.x * (float)u4[0]);
    o[1] = (h16)gelu_tanh(acc[1] + Dv.y * (float)u4[1]);
    o[2] = (h16)gelu_tanh(acc[2] + Dv.z * (float)u4[2]);
    o[3] = (h16)gelu_tanh(acc[3] + Dv.w * (float)u4[3]);
    *(h16x4*)(YPRE + tok * 512 + g * 16 + fq * 4) = o;
#pragma unroll
    for (int ks = 0; ks < 4; ++ks) fa[ks] = fn[ks];
    u4 = un;
  }
  __syncthreads();
}

__device__ void gdn_pre_item(const Params& p, int item, unsigned char* smem) {
  h16* QH = (h16*)smem;
  h16* KH = (h16*)(smem + 17408);
  h16* VH = (h16*)(smem + 34816);
  float* LT = (float*)(smem + 52224);
  float* sG = (float*)(smem + 69632);
  float* sBeta = (float*)(smem + 69888);
  float* sEG = (float*)(smem + 70144);
  float* sBG = (float*)(smem + 70400);
  float* sEL = (float*)(smem + 70656);
  int tid_ = threadIdx.x;
  asm volatile("" : "+v"(tid_));
  const int tid = tid_, w = tid >> 6, lane = tid & 63, fr = lane & 15, fq = lane >> 4;
  const int c = item & 31, h = (item >> 5) & 3, b = item >> 7;
  const h16* PROJ = (const h16*)(p.ws + OFF_PROJ);
  const float* AB = (const float*)(p.ws + OFF_AB);
  const float* convw = p.in[I_CONVW];
  h16* WPi = (h16*)(p.ws + OFF_WP) + (size_t)item * 64 * 128;
  h16* QGPi = (h16*)(p.ws + OFF_QGP) + (size_t)item * 64 * 128;
  h16* KDTi = (h16*)(p.ws + OFF_KDT) + (size_t)item * 128 * 64;
  h16* UTi = (h16*)(p.ws + OFF_UT) + (size_t)item * 128 * 64;
  h16* ATPi = (h16*)(p.ws + OFF_ATP) + (size_t)item * 64 * 64;
  h16* ZTi = (h16*)((unsigned char*)p.out + OUT_OFF_ZT) + (size_t)item * 128 * 64;
  float* DL = (float*)(p.ws + OFF_DL);
  {
    const int ch0 = (tid & 15) * 8, t0 = (tid >> 4) * 4;
#pragma unroll 1
    for (int sec = 0; sec < 3; ++sec) {
      const int colbase = 1024 + sec * 512 + h * 128 + ch0;
      h16x8 xr[7];
#pragma unroll
      for (int i = 0; i < 7; ++i) {
        const int ts = c * 64 + t0 - 3 + i;
        h16x8 z8 = {(h16)0.f, (h16)0.f, (h16)0.f, (h16)0.f, (h16)0.f, (h16)0.f, (h16)0.f, (h16)0.f};
        xr[i] = (ts >= 0) ? *(const h16x8*)(PROJ + ((size_t)b * SEQ + ts) * LDP + colbase) : z8;
      }
      float4 wv[4][2];
#pragma unroll
      for (int jj = 0; jj < 4; ++jj) {
        wv[jj][0] = *(const float4*)(convw + jj * 1536 + sec * 512 + h * 128 + ch0);
        wv[jj][1] = *(const float4*)(convw + jj * 1536 + sec * 512 + h * 128 + ch0 + 4);
      }
      h16* dst = (sec == 0 ? QH : (sec == 1 ? KH : VH));
#pragma unroll
      for (int tt = 0; tt < 4; ++tt) {
        float a[8];
#pragma unroll
        for (int e = 0; e < 8; ++e) a[e] = 0.f;
#pragma unroll
        for (int jj = 0; jj < 4; ++jj) {
          const h16x8 xv = xr[tt + jj];
          a[0] += wv[jj][0].x * (float)xv[0]; a[1] += wv[jj][0].y * (float)xv[1]; a[2] += wv[jj][0].z * (float)xv[2]; a[3] += wv[jj][0].w * (float)xv[3];
          a[4] += wv[jj][1].x * (float)xv[4]; a[5] += wv[jj][1].y * (float)xv[5]; a[6] += wv[jj][1].z * (float)xv[6]; a[7] += wv[jj][1].w * (float)xv[7];
        }
        float ss = 0.f;
#pragma unroll
        for (int e = 0; e < 8; ++e) { a[e] = siluf_(a[e]); ss += a[e] * a[e]; }
        float scale = 1.f;
        if (sec < 2) {
          ss = sum16(ss);
          scale = rsqrtf(ss + 1e-6f) * (sec == 0 ? 0.08838834764831845f : 1.f);
        }
        h16x8 o;
#pragma unroll
        for (int e = 0; e < 8; ++e) o[e] = (h16)(a[e] * scale);
        *(h16x8*)(dst + (t0 + tt) * 136 + ch0) = o;
      }
    }
  }
  if (tid < 64) {
    const size_t tok = (size_t)b * SEQ + c * 64 + tid;
    float braw = AB[tok * 8 + h], araw = AB[tok * 8 + 4 + h];
    float beta = 1.f / (1.f + expf(-braw));
    float xx = araw + p.in[I_DTB][h];
    float sp = xx > 20.f ? xx : log1pf(expf(xx));
    float gg = -expf(p.in[I_ALOG][h]) * sp;
#pragma unroll
    for (int o = 1; o < 64; o <<= 1) {
      float v = __shfl_up(gg, o);
      if (lane >= o) gg += v;
    }
    sG[tid] = gg;
    sBeta[tid] = beta;
    const float eg = expf(gg);
    sEG[tid] = eg;
    sBG[tid] = beta * eg;
    sEL[tid] = expf(__shfl(gg, 63) - gg);
  }
  __syncthreads();
  {
    h16x8 ak[4], aq[4];
#pragma unroll
    for (int ks = 0; ks < 4; ++ks) {
      ak[ks] = *(const h16x8*)(KH + (w * 16 + fr) * 136 + ks * 32 + fq * 8);
      aq[ks] = *(const h16x8*)(QH + (w * 16 + fr) * 136 + ks * 32 + fq * 8);
    }
#pragma unroll
    for (int jt = 0; jt < 4; ++jt) {
      const int j = jt * 16 + fr;
      const int pj = perm_pos(j);
      if (jt <= w) {
        f32x4 kk = {0.f, 0.f, 0.f, 0.f}, qk = {0.f, 0.f, 0.f, 0.f};
#pragma unroll
        for (int ks = 0; ks < 4; ++ks) {
          h16x8 bk = *(const h16x8*)(KH + (jt * 16 + fr) * 136 + ks * 32 + fq * 8);
          kk = MFMA(ak[ks], bk, kk);
          qk = MFMA(aq[ks], bk, qk);
        }
        const float Gj = sG[j];
        f32x4 lt;
#pragma unroll
        for (int r = 0; r < 4; ++r) {
          const int i = w * 16 + 4 * fq + r;
          const float e = (i >= j) ? expf(sG[i] - Gj) : 0.f;
          lt[r] = (i > j) ? sBeta[i] * kk[r] * e : 0.f;
          ATPi[i * 64 + (((pj >> 3) ^ (i & 7)) << 3) + (pj & 7)] = (h16)(qk[r] * e);
        }
        *(f32x4*)(LT + j * 68 + w * 16 + 4 * fq) = lt;
      } else {
#pragma unroll
        for (int r = 0; r < 4; ++r) {
          const int i = w * 16 + 4 * fq + r;
          ATPi[i * 64 + (((pj >> 3) ^ (i & 7)) << 3) + (pj & 7)] = (h16)0.f;
        }
      }
    }
  }
  __syncthreads();
  v2f r2[32];
  if (tid < 128) {
#pragma unroll
    for (int t = 0; t < 32; ++t) {
      r2[t][0] = (float)VH[(2 * t) * 136 + tid] * sBeta[2 * t];
      r2[t][1] = (float)VH[(2 * t + 1) * 136 + tid] * sBeta[2 * t + 1];
    }
  } else {
#pragma unroll
    for (int t = 0; t < 32; ++t) {
      r2[t][0] = (float)KH[(2 * t) * 136 + (tid - 128)] * sBG[2 * t];
      r2[t][1] = (float)KH[(2 * t + 1) * 136 + (tid - 128)] * sBG[2 * t + 1];
    }
  }
#pragma unroll
  for (int j = 0; j < 63; ++j) {
    const float xj = r2[j >> 1][j & 1];
    const v2f xx = {xj, xj};
#pragma unroll
    for (int i4 = (j + 1) / 4; i4 < 16; ++i4) {
      const f32x4 l = *(const f32x4*)(LT + j * 68 + i4 * 4);
      const v2f l0 = {l[0], l[1]}, l1 = {l[2], l[3]};
      if (i4 * 4 > j) r2[2 * i4] -= l0 * xx;
      else { if (i4 * 4 + 0 > j) r2[2 * i4][0] -= l[0] * xj; if (i4 * 4 + 1 > j) r2[2 * i4][1] -= l[1] * xj; }
      if (i4 * 4 + 2 > j) r2[2 * i4 + 1] -= l1 * xx;
      else { if (i4 * 4 + 3 > j) r2[2 * i4 + 1][1] -= l[3] * xj; }
    }
    __builtin_amdgcn_sched_barrier(0);
  }
  if (tid < 128) {
#pragma unroll
    for (int t8 = 0; t8 < 8; ++t8) {
      h16x8 v;
#pragma unroll
      for (int e = 0; e < 8; ++e) v[e] = (h16)r2[(t8 * 8 + e) >> 1][e & 1];
      *(h16x8*)(UTi + (size_t)tid * 64 + t8 * 8) = v;
    }
  }
  __syncthreads();
  if (tid >= 128) {
    const int pos = perm_pos(tid - 128);
#pragma unroll
    for (int t = 0; t < 64; ++t) VH[t * 136 + pos] = (h16)r2[t >> 1][t & 1];
  }
  __syncthreads();
  for (int rr = 0; rr < 4; ++rr) {
    const int idx = tid + 256 * rr, row = idx >> 4, seg = idx & 15;
    *(h16x8*)(WPi + row * 128 + ((seg ^ (row & 15)) << 3)) = *(const h16x8*)(VH + row * 136 + seg * 8);
  }
  {
    const int dv = tid & 127, th = tid >> 7;
    const float gdv = p.in[I_DNG][dv];
    const h16* zp = PROJ + ((size_t)b * SEQ + c * 64 + th * 32) * LDP + 2560 + h * 128 + dv;
    h16 zv[32];
#pragma unroll
    for (int t = 0; t < 32; ++t) zv[t] = zp[(size_t)t * LDP];
#pragma unroll
    for (int t8 = 0; t8 < 4; ++t8) {
      h16x8 v;
#pragma unroll
      for (int e = 0; e < 8; ++e) v[e] = (h16)(siluf_((float)zv[t8 * 8 + e]) * gdv);
      *(h16x8*)(ZTi + (size_t)dv * 64 + th * 32 + t8 * 8) = v;
    }
  }
#pragma unroll 2
  for (int rr = 0; rr < 4; ++rr) {
    const int idx = tid + 256 * rr, t = idx >> 4, cpos = idx & 15, ks = cpos >> 2, q = cpos & 3;
    const h16x4 lo = *(const h16x4*)(QH + t * 136 + ks * 32 + 4 * q);
    const h16x4 hi = *(const h16x4*)(QH + t * 136 + ks * 32 + 16 + 4 * q);
    const float sc = sEG[t];
    h16x8 o;
#pragma unroll
    for (int e = 0; e < 4; ++e) { o[e] = (h16)((float)lo[e] * sc); o[4 + e] = (h16)((float)hi[e] * sc); }
    *(h16x8*)(QGPi + t * 128 + ((cpos ^ (t & 15)) << 3)) = o;
  }
#pragma unroll 2
  for (int rr = 0; rr < 4; ++rr) {
    const int idx = tid + 256 * rr, dk = idx >> 3, cpos = idx & 7, k2 = cpos >> 2, q = cpos & 3;
    h16x8 o;
#pragma unroll
    for (int e = 0; e < 8; ++e) {
      const int t = k2 * 32 + (e < 4 ? 4 * q + e : 16 + 4 * q + (e - 4));
      o[e] = (h16)((float)KH[t * 136 + dk] * sEL[t]);
    }
    *(h16x8*)(KDTi + dk * 64 + ((cpos ^ (dk & 7)) << 3)) = o;
  }
  const float Glast = sG[63];
  if (tid == 0) DL[item] = expf(Glast);
  __syncthreads();
}

template <int NB>
__device__ __forceinline__ void glds_copy(const h16* __restrict__ g, unsigned char* l) {
#pragma unroll
  for (int i = 0; i < NB / 4096; ++i) {
    const int off = threadIdx.x * 16 + i * 4096;
    __builtin_amdgcn_global_load_lds((const unsigned*)((const unsigned char*)g + off), (unsigned*)(l + off), 16, 0, 0);
  }
}
#define RAW_BARRIER() do { asm volatile("s_waitcnt lgkmcnt(0)" ::: "memory"); __builtin_amdgcn_s_barrier(); asm volatile("" ::: "memory"); } while (0)

__device__ void gdn_chain(const Params& p, int bh, unsigned char* smem) {
  const int tid = threadIdx.x, w = tid >> 6, lane = tid & 63, fr = lane & 15, fq = lane >> 4;
  const float* DL = (const float*)(p.ws + OFF_DL);
  const h16* WPb = (const h16*)(p.ws + OFF_WP) + (size_t)bh * 32 * 64 * 128;
  const h16* KDTb = (const h16*)(p.ws + OFF_KDT) + (size_t)bh * 32 * 128 * 64;
  h16* UTb = (h16*)(p.ws + OFF_UT) + (size_t)bh * 32 * 128 * 64;
  h16* SFb = (h16*)((unsigned char*)p.out + OUT_OFF_SF) + (size_t)bh * 32 * 128 * 128;
  f32x4 S[8][2];
#pragma unroll
  for (int i = 0; i < 8; ++i) { S[i][0] = f32x4{0.f, 0.f, 0.f, 0.f}; S[i][1] = f32x4{0.f, 0.f, 0.f, 0.f}; }
  h16x4 uR[4][2];
  const int uoff = (w * 32 + fr) * 64 + fq * 4;
  glds_copy<16384>(WPb, smem); glds_copy<16384>(KDTb, smem + 16384);
#pragma unroll
  for (int mt = 0; mt < 4; ++mt)
#pragma unroll
    for (int nt = 0; nt < 2; ++nt) uR[mt][nt] = *(const h16x4*)(UTb + uoff + nt * 1024 + mt * 16);
  float dl = DL[bh * 32];
  asm volatile("s_waitcnt vmcnt(0)" ::: "memory");
  RAW_BARRIER();
  for (int c = 0; c < 32; ++c) {
    const int cn = (c + 1 < 32) ? c + 1 : 31;
    const unsigned char* LW = smem + (c & 1) * 32768;
    const unsigned char* LK = LW + 16384;
    unsigned char* LWn = smem + ((c + 1) & 1) * 32768;
    f32x4 uf[4][2];
#pragma unroll
    for (int mt = 0; mt < 4; ++mt)
#pragma unroll
      for (int nt = 0; nt < 2; ++nt)
#pragma unroll
        for (int r = 0; r < 4; ++r) uf[mt][nt][r] = (float)uR[mt][nt][r];
    const float dlc = dl;
    asm volatile("" ::: "memory");
    h16x8 sfr[4][2];
#pragma unroll
    for (int ks = 0; ks < 4; ++ks) { sfr[ks][0] = pack8(S[2 * ks][0], S[2 * ks + 1][0]); sfr[ks][1] = pack8(S[2 * ks][1], S[2 * ks + 1][1]); }
#pragma unroll
    for (int ks = 0; ks < 4; ++ks)
#pragma unroll
      for (int nt = 0; nt < 2; ++nt)
        *(h16x8*)(SFb + ((size_t)(c * 4 + ks) * 8 + w * 2 + nt) * 512 + lane * 8) = sfr[ks][nt];
    glds_copy<16384>(WPb + (size_t)cn * 64 * 128, LWn);
    glds_copy<16384>(KDTb + (size_t)cn * 128 * 64, LWn + 16384);
#pragma unroll
    for (int mt = 0; mt < 4; ++mt)
#pragma unroll
      for (int nt = 0; nt < 2; ++nt)
        uR[mt][nt] = *(const h16x4*)(UTb + (size_t)cn * 128 * 64 + uoff + nt * 1024 + mt * 16);
    dl = DL[bh * 32 + cn];
    asm volatile("" ::: "memory");
    f32x4 vn[4][2];
#pragma unroll
    for (int mt = 0; mt < 4; ++mt) { vn[mt][0] = f32x4{0.f, 0.f, 0.f, 0.f}; vn[mt][1] = vn[mt][0]; }
#pragma unroll
    for (int ks = 0; ks < 4; ++ks)
#pragma unroll
      for (int mt = 0; mt < 4; ++mt) {
        h16x8 aw = *(const h16x8*)(LW + (mt * 16 + fr) * 256 + (((ks * 4 + fq) ^ fr) << 4));
        vn[mt][0] = MFMA(aw, sfr[ks][0], vn[mt][0]);
        vn[mt][1] = MFMA(aw, sfr[ks][1], vn[mt][1]);
      }
#pragma unroll
    for (int mt = 0; mt < 4; ++mt)
#pragma unroll
      for (int r = 0; r < 4; ++r) { vn[mt][0][r] = uf[mt][0][r] - vn[mt][0][r]; vn[mt][1][r] = uf[mt][1][r] - vn[mt][1][r]; }
    h16x8 vfr[2][2];
#pragma unroll
    for (int k2 = 0; k2 < 2; ++k2) { vfr[k2][0] = pack8(vn[2 * k2][0], vn[2 * k2 + 1][0]); vfr[k2][1] = pack8(vn[2 * k2][1], vn[2 * k2 + 1][1]); }
    if (c + 1 < 32) {
#pragma unroll
      for (int k2 = 0; k2 < 2; ++k2)
#pragma unroll
        for (int nt = 0; nt < 2; ++nt)
          *(h16x8*)(UTb + (size_t)c * 128 * 64 + ((size_t)k2 * 8 + w * 2 + nt) * 512 + lane * 8) = vfr[k2][nt];
    }
#pragma unroll
    for (int dkt = 0; dkt < 8; ++dkt) {
      f32x4 s0 = S[dkt][0], s1 = S[dkt][1];
#pragma unroll
      for (int r = 0; r < 4; ++r) { s0[r] *= dlc; s1[r] *= dlc; }
#pragma unroll
      for (int k2 = 0; k2 < 2; ++k2) {
        h16x8 ak = *(const h16x8*)(LK + (dkt * 16 + fr) * 128 + (((k2 * 4 + fq) ^ (fr & 7)) << 4));
        s0 = MFMA(ak, vfr[k2][0], s0);
        s1 = MFMA(ak, vfr[k2][1], s1);
      }
      S[dkt][0] = s0; S[dkt][1] = s1;
    }
    asm volatile("s_waitcnt vmcnt(0)" ::: "memory");
    RAW_BARRIER();
    if (c + 1 == 32) {
#pragma unroll
      for (int k2 = 0; k2 < 2; ++k2)
#pragma unroll
        for (int nt = 0; nt < 2; ++nt)
          *(h16x8*)(UTb + (size_t)c * 128 * 64 + ((size_t)k2 * 8 + w * 2 + nt) * 512 + lane * 8) = vfr[k2][nt];
    }
  }
  asm volatile("s_waitcnt vmcnt(0)" ::: "memory");
  __syncthreads();
}

__device__ void gdn_out_item(const Params& p, int item, unsigned char* smem) {
  unsigned char* LQ = smem;
  unsigned char* LA = smem + 16384;
  float* red = (float*)(smem + 24576);
  const int tid = threadIdx.x, w = tid >> 6, lane = tid & 63, fr = lane & 15, fq = lane >> 4;
  const int c = item & 31, h = (item >> 5) & 3, b = item >> 7;
  h16* MIXIN = (h16*)(p.ws + OFF_MIXIN);
  const h16* QGPi = (const h16*)(p.ws + OFF_QGP) + (size_t)item * 64 * 128;
  const h16* ATPi = (const h16*)(p.ws + OFF_ATP) + (size_t)item * 64 * 64;
  const h16* VFi = (const h16*)(p.ws + OFF_UT) + (size_t)item * 128 * 64;
  const h16* SFi = (const h16*)((unsigned char*)p.out + OUT_OFF_SF) + (size_t)item * 128 * 128;
  const h16* ZTi = (const h16*)((unsigned char*)p.out + OUT_OFF_ZT) + (size_t)item * 128 * 64;
  glds_copy<16384>(QGPi, LQ); glds_copy<8192>(ATPi, LA);
  h16x8 sfr[4][2], vfr[2][2];
#pragma unroll
  for (int ks = 0; ks < 4; ++ks)
#pragma unroll
    for (int nt = 0; nt < 2; ++nt) sfr[ks][nt] = *(const h16x8*)(SFi + ((size_t)ks * 8 + w * 2 + nt) * 512 + lane * 8);
#pragma unroll
  for (int k2 = 0; k2 < 2; ++k2)
#pragma unroll
    for (int nt = 0; nt < 2; ++nt) vfr[k2][nt] = *(const h16x8*)(VFi + ((size_t)k2 * 8 + w * 2 + nt) * 512 + lane * 8);
  h16x4 zR[4][2];
#pragma unroll
  for (int mt = 0; mt < 4; ++mt)
#pragma unroll
    for (int nt = 0; nt < 2; ++nt) zR[mt][nt] = *(const h16x4*)(ZTi + (size_t)(w * 32 + nt * 16 + fr) * 64 + mt * 16 + fq * 4);
  asm volatile("s_waitcnt vmcnt(0)" ::: "memory");
  __syncthreads();
  f32x4 o[4][2];
#pragma unroll
  for (int mt = 0; mt < 4; ++mt) {
    f32x4 o0 = {0.f, 0.f, 0.f, 0.f}, o1 = {0.f, 0.f, 0.f, 0.f};
#pragma unroll
    for (int ks = 0; ks < 4; ++ks) {
      h16x8 aq = *(const h16x8*)(LQ + (mt * 16 + fr) * 256 + (((ks * 4 + fq) ^ fr) << 4));
      o0 = MFMA(aq, sfr[ks][0], o0);
      o1 = MFMA(aq, sfr[ks][1], o1);
    }
#pragma unroll
    for (int k2 = 0; k2 < 2; ++k2) {
      h16x8 aa = *(const h16x8*)(LA + (mt * 16 + fr) * 128 + (((k2 * 4 + fq) ^ (fr & 7)) << 4));
      o0 = MFMA(aa, vfr[k2][0], o0);
      o1 = MFMA(aa, vfr[k2][1], o1);
    }
    o[mt][0] = o0; o[mt][1] = o1;
  }
#pragma unroll
  for (int mt = 0; mt < 4; ++mt)
#pragma unroll
    for (int r = 0; r < 4; ++r) {
      float s = o[mt][0][r] * o[mt][0][r] + o[mt][1][r] * o[mt][1][r];
      s = sum16(s);
      if (fr == 0) red[w * 64 + mt * 16 + 4 * fq + r] = s;
    }
  __syncthreads();
#pragma unroll
  for (int mt = 0; mt < 4; ++mt)
#pragma unroll
    for (int r = 0; r < 4; ++r) {
      const int tl = mt * 16 + 4 * fq + r;
      const float tot = red[tl] + red[64 + tl] + red[128 + tl] + red[192 + tl];
      const float rstd = rsqrtf(tot * (1.f / 128.f) + 1e-6f);
      const size_t tok = (size_t)b * SEQ + c * 64 + tl;
      h16* yp = MIXIN + tok * 1024 + 512 + h * 128 + w * 32 + fr;
      yp[0] = (h16)(o[mt][0][r] * rstd * (float)zR[mt][0][r]);
      yp[16] = (h16)(o[mt][1][r] * rstd * (float)zR[mt][1][r]);
    }
  __syncthreads();
}

#define XB_TMO      128
#define XB_XCNT(j)  (256  + 64 * (j))
#define XB_XSUB(j)  (1280 + 64 * (j))
#define XB_XGEN(j)  (2304 + 64 * (j))
#define XB_TOP      3328
#define XB_TOPGEN   3392
#define XCD_BAR_WORDS 3456
#define XB_SPIN_CAP (1u << 18)
#define LAS __attribute__((address_space(3)))

__device__ __forceinline__ unsigned xb_ld(unsigned* p)              { return __hip_atomic_load(p, __ATOMIC_RELAXED, __HIP_MEMORY_SCOPE_AGENT); }
__device__ __forceinline__ unsigned xb_add(unsigned* p, unsigned v) { return __hip_atomic_fetch_add(p, v, __ATOMIC_RELAXED, __HIP_MEMORY_SCOPE_AGENT); }
__device__ __forceinline__ unsigned xb_xcc_id() { return (unsigned)__builtin_amdgcn_s_getreg((3 << 11) | 20) & 0xFu; }
#define XB_SPIN(cond, bar) do { unsigned _sp = 0; while (cond) { __builtin_amdgcn_s_sleep(1); \
    if ((++_sp & 255u) == 0u) { if (xb_ld(&(bar)[XB_TMO])) break; if (_sp > XB_SPIN_CAP) { atomicAdd(&(bar)[XB_TMO], 1u); break; } } } } while (0)

struct XcdBarrier {
    unsigned* bar; unsigned x;
    volatile LAS unsigned* st;
};

__device__ __forceinline__ XcdBarrier xcd_barrier_post(unsigned* bar, volatile LAS unsigned* st) {
    XcdBarrier b; b.bar = bar; b.x = xb_xcc_id(); b.st = st;
    if (threadIdx.x == 0) (void)xb_add(&bar[XB_XCNT(b.x)], 1u);
    return b;
}
__device__ __forceinline__ void xcd_barrier_complete(unsigned* bar, unsigned x, unsigned& nloc, unsigned& nx) {
    const unsigned G = gridDim.x * gridDim.y * gridDim.z;
    unsigned sum, cnt, mine, sp = 0u;
    for (;;) {
        sum = 0u; cnt = 0u; mine = 0u;
#pragma unroll
        for (unsigned j = 0; j < 16; ++j) { const unsigned c = xb_ld(&bar[XB_XCNT(j)]); sum += c; cnt += (c > 0u) ? 1u : 0u; mine = (j == x) ? c : mine; }
        if (sum == G) break;
        __builtin_amdgcn_s_sleep(1);
        if ((++sp & 255u) == 0u) { if (xb_ld(&bar[XB_TMO])) break; if (sp > XB_SPIN_CAP) { atomicAdd(&bar[XB_TMO], 1u); break; } }
    }
    nloc = mine > 0u ? mine : 1u; nx = cnt > 0u ? cnt : 1u;
}

__device__ __forceinline__ void xcd_barrier(const XcdBarrier& b) {
    asm volatile("s_waitcnt vmcnt(0)" ::: "memory");
    __syncthreads();
    if (threadIdx.x == 0) {
        unsigned* bar = b.bar;
        __builtin_amdgcn_s_waitcnt(0);
        unsigned nloc = b.st[0], nx = b.st[1];
        if (nloc == 0u) { xcd_barrier_complete(bar, b.x, nloc, nx); b.st[0] = nloc; b.st[1] = nx; }
        const unsigned old = xb_add(&bar[XB_XSUB(b.x)], 1u);
        const unsigned gen = old / nloc;
        if (old + 1u == (gen + 1u) * nloc) {
            __builtin_amdgcn_fence(__ATOMIC_RELEASE, "agent");
            asm volatile("s_waitcnt vmcnt(0)" ::: "memory");
            const unsigned og = xb_add(&bar[XB_TOP], 1u);
            const unsigned tg = og / nx;
            if (og + 1u == (tg + 1u) * nx) xb_add(&bar[XB_TOPGEN], 1u);
            else XB_SPIN(xb_ld(&bar[XB_TOPGEN]) == tg, bar);
            __builtin_amdgcn_fence(__ATOMIC_ACQUIRE, "agent");
            xb_add(&bar[XB_XGEN(b.x)], 1u);
            asm volatile("s_waitcnt vmcnt(0)" ::: "memory");
        } else {
            XB_SPIN(xb_ld(&bar[XB_XGEN(b.x)]) == gen, bar);
            __builtin_amdgcn_fence(__ATOMIC_ACQUIRE, "agent");
            asm volatile("s_waitcnt vmcnt(0)" ::: "memory");
        }
    }
    __syncthreads();
}

#ifndef ONLY_PH
#define ONLY_PH -1
#endif
#define RUNPH(n) ((ONLY_PH < 0 || ONLY_PH == (n)) && p.ph_lo <= (n) && (n) <= p.ph_hi)
#define SYNCPH(n) do { if (p.ph_lo <= (n) && (n) < p.ph_hi) xcd_barrier(xb); } while (0)
__global__ void __launch_bounds__(256, 2) hymba_mega(Params p) {
  __shared__ __attribute__((aligned(16))) unsigned char smem[SMEM_BYTES];
  cg::grid_group grid = cg::this_grid();
  const int bid = blockIdx.x, nb = gridDim.x;
  if (p.ph_lo < 0) grid.sync();
  XcdBarrier xb;
  {
    volatile LAS unsigned* st = (volatile LAS unsigned*)(smem + SMEM_BYTES - 16);
    if (threadIdx.x == 0) { st[0] = 0u; st[1] = 0u; st[2] = 0u; st[3] = 0u; }
    __syncthreads();
    if (p.ph_lo < p.ph_hi) xb = xcd_barrier_post((unsigned*)(p.ws + OFF_BAR), st);
    else { xb.bar = (unsigned*)(p.ws + OFF_BAR); xb.x = 0; xb.st = st; }
  }
  {
    if (RUNPH(0)) for (int rep = 0; rep < REP0; ++rep) {
      if (rep) grid.sync();
      phase0(p, smem);
    }
    SYNCPH(0);
    if (RUNPH(1)) for (int rep = 0; rep < REP1; ++rep) {
      if (rep) grid.sync();
      const h16* A0 = (const h16*)((unsigned char*)p.out + OUT_OFF_A0);
      const h16* W = (const h16*)(p.ws + OFF_WIN);
      const int xl = bid & 7, nxb = nb >> 3;
      if (nb & 7) { for (int t = bid; t < 256 * 25; t += nb) gemm_tile<EPI_PROJ>(p, A0, 1024, W, 1024, 1024, (t / 25) * 128, (t % 25) * 128, smem); }
      else for (int u = bid >> 3; u < 800; u += nxb) {
        const int mb = u / 200, v = u % 200;
        gemm_tile<EPI_PROJ>(p, A0, 1024, W, 1024, 1024, (xl * 32 + mb * 8 + (v & 7)) * 128, (v >> 3) * 128, smem);
      }
    }
    SYNCPH(1);
    if (RUNPH(2)) for (int rep = 0; rep < REP2; ++rep) {
      if (rep) grid.sync();
      for (int it = bid; it < 512 + 2048; it += nb) {
        if (it < 2048) gdn_pre_item(p, it, smem);
        else ssm_item(p, (it - 2048) >> 5, (it - 2048) & 31, smem);
      }
    }
    SYNCPH(2);
    if (RUNPH(3)) {
      if (bid < 64) gdn_chain(p, bid, smem);
      const int xl = bid & 7;
      unsigned* ctr = (unsigned*)(p.ws + OFF_CTR) + xl * 16;
      volatile int* bc = (volatile int*)(smem + SMEM_BYTES - 4);
      const h16* YPRE = (const h16*)((unsigned char*)p.out + OUT_OFF_YPRE);
      for (;;) {
        __syncthreads();
        if (threadIdx.x == 0) *bc = (int)atomicAdd(ctr, 1u);
        __syncthreads();
        const int u = *bc;
        if (u >= 128 + 256) break;
        if (u < 128) gemm_tile<EPI_GLU>(p, YPRE, 512, (const h16*)(p.ws + OFF_WGLU), 512, 512, (xl * 32 + (u >> 2)) * 128, (u & 3) * 128, smem);
        else gemm_tile<EPI_PLE>(p, (const h16*)(p.ws + OFF_PB), 256, (const h16*)(p.ws + OFF_WPP), 256, 256, (xl * 32 + ((u - 128) >> 3)) * 128, ((u - 128) & 7) * 128, smem);
      }
    }
    SYNCPH(3);
    if (RUNPH(4)) {
      for (int it = bid; it < 2048; it += nb) gdn_out_item(p, it, smem);
    }
    SYNCPH(4);
    if (RUNPH(5)) {
      const int xl = bid & 7, nxb = nb >> 3;
      if (nb & 7) { for (int t = bid; t < 2048; t += nb) gemm_tile<EPI_OUT>(p, (const h16*)(p.ws + OFF_MIXIN), 1024, (const h16*)(p.ws + OFF_WOUT), 1024, 1024, (t >> 3) * 128, (t & 7) * 128, smem); }
      else for (int u = bid >> 3; u < 256; u += nxb)
        gemm_tile<EPI_OUT>(p, (const h16*)(p.ws + OFF_MIXIN), 1024, (const h16*)(p.ws + OFF_WOUT), 1024, 1024, (xl * 32 + (u >> 6) * 8 + (u & 7)) * 128, ((u >> 3) & 7) * 128, smem);
    }
    SYNCPH(5);
    if (RUNPH(6)) {
      const int xl = bid & 7, nxb = nb >> 3;
      if (nb & 7) { for (int t = bid; t < 2048; t += nb) gemm_tile<EPI_GATE>(p, (const h16*)(p.ws + OFF_PROJ), 1024, (const h16*)(p.ws + OFF_WGATE), 1024, 1024, (t >> 3) * 128, (t & 7) * 128, smem); }
      else for (int u = bid >> 3; u < 256; u += nxb)
        gemm_tile<EPI_GATE>(p, (const h16*)(p.ws + OFF_PROJ), 1024, (const h16*)(p.ws + OFF_WGATE), 1024, 1024, (xl * 32 + (u >> 6) * 8 + (u & 7)) * 128, ((u >> 3) & 7) * 128, smem);
    }
    SYNCPH(6);
    if (RUNPH(7)) {
      const int wid = threadIdx.x >> 6, lane = threadIdx.x & 63;
      const float* OPART = (const float*)(p.ws + OFF_OPART);
      const float4* g4 = (const float4*)p.in[I_FING];
      const h16* H2B = (const h16*)(p.ws + OFF_MIXIN);
      for (int row = bid * 4 + wid; row < T_TOK; row += nb * 4) {
        float s = (lane < 8) ? OPART[(size_t)row * 8 + lane] : 0.f;
        const h16x8 a = *(const h16x8*)(H2B + (size_t)row * 1024 + lane * 8);
        const h16x8 b = *(const h16x8*)(H2B + (size_t)row * 1024 + 512 + lane * 8);
        s = wave_sum(s);
        const float rstd = rsqrtf(s * (1.f / 1024.f) + 1e-6f);
        float4* orow = (float4*)(p.out + (size_t)row * 1024);
        const float4 g0 = g4[lane * 2], g1 = g4[lane * 2 + 1], g2 = g4[128 + lane * 2], g3 = g4[128 + lane * 2 + 1];
        float4 o0, o1, o2, o3;
        o0.x = (float)a[0] * rstd * g0.x; o0.y = (float)a[1] * rstd * g0.y; o0.z = (float)a[2] * rstd * g0.z; o0.w = (float)a[3] * rstd * g0.w;
        o1.x = (float)a[4] * rstd * g1.x; o1.y = (float)a[5] * rstd * g1.y; o1.z = (float)a[6] * rstd * g1.z; o1.w = (float)a[7] * rstd * g1.w;
        o2.x = (float)b[0] * rstd * g2.x; o2.y = (float)b[1] * rstd * g2.y; o2.z = (float)b[2] * rstd * g2.z; o2.w = (float)b[3] * rstd * g2.w;
        o3.x = (float)b[4] * rstd * g3.x; o3.y = (float)b[5] * rstd * g3.y; o3.z = (float)b[6] * rstd * g3.z; o3.w = (float)b[7] * rstd * g3.w;
        orow[lane * 2] = o0; orow[lane * 2 + 1] = o1; orow[128 + lane * 2] = o2; orow[128 + lane * 2 + 1] = o3;
      }
    }
  }
}

extern "C" void kernel_launch(void* const* d_in, const int* in_sizes, int n_in, void* d_out, int out_size, void* d_ws, size_t ws_size,
                              hipStream_t stream) {
  static int grid_blocks = 0;
  if (!grid_blocks) {
    int dev = 0, cus = 0, per_cu = 0;
    hipGetDevice(&dev);
    hipDeviceGetAttribute(&cus, hipDeviceAttributeMultiprocessorCount, dev);
    hipOccupancyMaxActiveBlocksPerMultiprocessor(&per_cu, hymba_mega, 256, 0);
    if (per_cu > 2) per_cu = 2;
    if (per_cu < 1) per_cu = 1;
    grid_blocks = cus * per_cu;
  }
  if (n_in != 23 || ws_size < WS_END || out_size != T_TOK * 1024) {
    fprintf(stderr, "kernel_launch: unexpected sizes n_in=%d ws=%zu (need %zu) out=%d\n", n_in, ws_size, (size_t)WS_END, out_size);
    return;
  }
  Params p{};
  for (int i = 0; i < 23; ++i) p.in[i] = (const float*)d_in[i];
  p.out = (float*)d_out;
  p.ws = (unsigned char*)d_ws;
  if (hipMemsetAsync((unsigned char*)d_ws + OFF_BAR, 0, 16384, stream) != hipSuccess) { fprintf(stderr, "kernel_launch: memset of control words failed\n"); return; }
#if MULTI_LAUNCH
  for (int ph = 0; ph < NPH; ++ph) {
    p.ph_lo = ph; p.ph_hi = ph;
    hipLaunchKernelGGL(hymba_mega, dim3(grid_blocks), dim3(256), 0, stream, p);
  }
#else
  p.ph_lo = 0; p.ph_hi = NPH - 1;
  void* args[] = {&p};
  hipError_t e = hipLaunchCooperativeKernel((void*)hymba_mega, dim3(grid_blocks), dim3(256), args, 0, stream);
  if (e != hipSuccess) fprintf(stderr, "cooperative launch failed: %s (grid %d)\n", hipGetErrorString(e), grid_blocks);
#endif
}
```

```cpp
#include <hip/hip_runtime.h>
#include <hip/hip_cooperative_groups.h>
#include <cstdio>
namespace cg = cooperative_groups;

#ifndef REP0
#define REP0 1
#endif
#ifndef REP1
#define REP1 1
#endif
#ifndef REP2
#define REP2 1
#endif
#ifndef REP3
#define REP3 1
#endif
#ifndef REP4
#define REP4 1
#endif
#ifndef MULTI_LAUNCH
#define MULTI_LAUNCH 0
#endif

typedef _Float16 h16;
typedef __attribute__((ext_vector_type(8))) _Float16 h16x8;
typedef __attribute__((ext_vector_type(4))) _Float16 h16x4;
typedef __attribute__((ext_vector_type(4))) float f32x4;
typedef __attribute__((ext_vector_type(2))) float v2f;

#define MFMA(a, b, c) __builtin_amdgcn_mfma_f32_16x16x32_f16((a), (b), (c), 0, 0, 0)

constexpr int T_TOK = 32768;
constexpr int SEQ = 2048;
constexpr int NPH = 8;
constexpr int LDP = 3072;
constexpr int SMEM_BYTES = 72704;

constexpr size_t SZ_WIN = (size_t)3200 * 1024 * 2;
constexpr size_t SZ_WGLU = (size_t)512 * 512 * 2;
constexpr size_t SZ_WOUT = (size_t)1024 * 1024 * 2;
constexpr size_t SZ_WPP = (size_t)1024 * 256 * 2;
constexpr size_t SZ_WGATE = (size_t)1024 * 1024 * 2;
constexpr size_t OFF_WIN = 0;
constexpr size_t OFF_WGLU = OFF_WIN + SZ_WIN;
constexpr size_t OFF_WOUT = OFF_WGLU + SZ_WGLU;
constexpr size_t OFF_WPP = OFF_WOUT + SZ_WOUT;
constexpr size_t OFF_WGATE = OFF_WPP + SZ_WPP;
constexpr size_t OFF_PB = OFF_WGATE + SZ_WGATE;
constexpr size_t OFF_PROJ = OFF_PB + (size_t)T_TOK * 256 * 2;
constexpr size_t OFF_AB = OFF_PROJ + (size_t)T_TOK * LDP * 2;
constexpr size_t OFF_KTAB = OFF_AB + (size_t)T_TOK * 8 * 4;
constexpr size_t OFF_ETAB = OFF_KTAB + (size_t)32 * 33 * 256 * 2;
constexpr size_t OFF_FTAB = OFF_ETAB + (size_t)32 * 128 * 512 * 2;
constexpr size_t OFF_ALPOW = OFF_FTAB + (size_t)32 * 512 * 128 * 2;
constexpr size_t OFF_DL = OFF_ALPOW + (size_t)32 * 64 * 2 * 4;
constexpr size_t OFF_EPART = OFF_DL + (size_t)2048 * 4;
constexpr size_t OFF_OPART = OFF_EPART + (size_t)T_TOK * 16 * 4;
constexpr size_t OFF_MIXIN = OFF_OPART + (size_t)T_TOK * 16 * 4;
constexpr size_t OFF_WP = OFF_MIXIN + (size_t)T_TOK * 1024 * 2;
constexpr size_t OFF_QGP = OFF_WP + (size_t)2048 * 64 * 128 * 2;
constexpr size_t OFF_KDT = OFF_QGP + (size_t)2048 * 64 * 128 * 2;
constexpr size_t OFF_UT = OFF_KDT + (size_t)2048 * 128 * 64 * 2;
constexpr size_t OFF_ATP = OFF_UT + (size_t)2048 * 128 * 64 * 2;
constexpr size_t OFF_EH = OFF_ATP + (size_t)2048 * 64 * 64 * 2;
constexpr size_t OFF_BAR = OFF_EH + (size_t)T_TOK * 1024 * 2;
constexpr size_t WS_END = OFF_BAR + 16384;
constexpr size_t OFF_CTR = OFF_BAR + 15360;
constexpr size_t OUT_OFF_A0 = 0;
constexpr size_t OUT_OFF_SF = 0;
constexpr size_t OUT_OFF_YPRE = (size_t)T_TOK * 1024 * 2;
constexpr size_t OUT_OFF_ZT = OUT_OFF_YPRE + (size_t)T_TOK * 512 * 2;

struct Params {
  const float* in[23];
  float* out;
  unsigned char* ws;
  int ph_lo, ph_hi;
};

enum { I_X = 0, I_P, I_NMG, I_WIN, I_ARE, I_AIM, I_BRE, I_BIM, I_CRE, I_CIM, I_D, I_LOGDT, I_WGLU, I_BGLU,
       I_CONVW, I_ALOG, I_DTB, I_DNG, I_WOUT, I_WPP, I_PLEG, I_WGATE, I_FING };

__device__ __forceinline__ float wave_sum(float v) {
#pragma unroll
  for (int o = 32; o > 0; o >>= 1) v += __shfl_xor(v, o);
  return v;
}
__device__ __forceinline__ float sum16(float v) {
  v += __shfl_xor(v, 1); v += __shfl_xor(v, 2); v += __shfl_xor(v, 4); v += __shfl_xor(v, 8);
  return v;
}
__device__ __forceinline__ float sigmoidf_(float x) { return __builtin_amdgcn_rcpf(1.f + __expf(-x)); }
__device__ __forceinline__ float siluf_(float x) { return x * __builtin_amdgcn_rcpf(1.f + __expf(-x)); }
__device__ __forceinline__ float gelu_tanh(float y) {
  float z = 0.7978845608028654f * (y + 0.044715f * y * y * y);
  return y * __builtin_amdgcn_rcpf(1.f + __expf(-2.f * z));
}
__device__ __forceinline__ h16x8 pack8(f32x4 lo, f32x4 hi) {
  h16x8 r;
  r[0] = (h16)lo[0]; r[1] = (h16)lo[1]; r[2] = (h16)lo[2]; r[3] = (h16)lo[3];
  r[4] = (h16)hi[0]; r[5] = (h16)hi[1]; r[6] = (h16)hi[2]; r[7] = (h16)hi[3];
  return r;
}
__device__ __forceinline__ int perm_pos(int n) { return (n & ~31) + (((n & 15) >> 2) << 3) + (((n >> 4) & 1) << 2) + (n & 3); }
__device__ __forceinline__ int perm_inv(int pos) {
  int q5 = pos & 31, qq = q5 >> 3, jj = q5 & 7;
  return (pos & ~31) + (jj < 4 ? 4 * qq + jj : 16 + 4 * qq + (jj - 4));
}

__device__ void transpose_w(const float* __restrict__ W, int K, int N, int Npad, h16* __restrict__ WT, int t, float* tile) {
  const int ntn = Npad / 64;
  const int kt = t / ntn, nt = t % ntn, k0 = kt * 64, n0 = nt * 64;
  const int tx = threadIdx.x & 63, ty = threadIdx.x >> 6;
  for (int r = 0; r < 16; ++r) {
    int k = ty * 16 + r, n = n0 + tx;
    tile[k * 65 + tx] = (n < N) ? W[(size_t)(k0 + k) * N + n] : 0.f;
  }
  __syncthreads();
  for (int r = 0; r < 16; ++r) {
    int n = ty * 16 + r;
    WT[(size_t)(n0 + n) * K + k0 + tx] = (h16)tile[tx * 65 + n];
  }
  __syncthreads();
}

__device__ void ssm_table_item(const Params& p, int g, int d, float* lds) {
  float2* sAp = (float2*)lds;
  float2* sW = sAp + 64;
  const int tid = threadIdx.x;
  h16* KTAB = (h16*)(p.ws + OFF_KTAB);
  h16* ETAB = (h16*)(p.ws + OFF_ETAB);
  h16* FTAB = (h16*)(p.ws + OFF_FTAB);
  float* ALPOW = (float*)(p.ws + OFF_ALPOW);
  float* sBr = lds + 256; float* sBi = sBr + 1024; float* sCr = sBi + 1024; float* sCi = sCr + 16 * 65;
  {
    const float4 vbr = ((const float4*)(p.in[I_BRE] + g * 1024))[tid], vbi = ((const float4*)(p.in[I_BIM] + g * 1024))[tid];
    const float4 vcr = ((const float4*)(p.in[I_CRE] + g * 1024))[tid], vci = ((const float4*)(p.in[I_CIM] + g * 1024))[tid];
    *(float4*)(sBr + tid * 4) = vbr; *(float4*)(sBi + tid * 4) = vbi;
    const int ch = (tid * 4) >> 6, cp = (tid * 4) & 63;
    sCr[ch * 65 + cp] = vcr.x; sCr[ch * 65 + cp + 1] = vcr.y; sCr[ch * 65 + cp + 2] = vcr.z; sCr[ch * 65 + cp + 3] = vcr.w;
    sCi[ch * 65 + cp] = vci.x; sCi[ch * 65 + cp + 1] = vci.y; sCi[ch * 65 + cp + 2] = vci.z; sCi[ch * 65 + cp + 3] = vci.w;
  }
  if (tid < 64) {
    const int pp = tid;
    float lr = p.in[I_ARE][g * 64 + pp], li = p.in[I_AIM][g * 64 + pp], dt = expf(p.in[I_LOGDT][g]);
    float mag = expf(lr * dt), ang = li * dt;
    float abr = mag * cosf(ang), abi = mag * sinf(ang);
    float nr = abr - 1.f, ni = abi, den = lr * lr + li * li;
    float cr = (nr * lr + ni * li) / den, ci = (ni * lr - nr * li) / den;
    float apr = 1.f, api = 0.f;
    for (int k = 0; k < d; ++k) { float t0 = apr * abr - api * abi; api = apr * abi + api * abr; apr = t0; }
    sAp[pp] = make_float2(apr, api);
    sW[pp] = make_float2(apr * cr - api * ci, apr * ci + api * cr);
    if (d == 32) { ALPOW[(g * 64 + pp) * 2] = apr; ALPOW[(g * 64 + pp) * 2 + 1] = api; }
  }
  __syncthreads();
  if (d < 32) {
    {
      const int h = tid >> 4, hp = tid & 15;
      float acc = 0.f;
#pragma unroll 8
      for (int pp = 0; pp < 64; ++pp) {
        float2 W = sW[pp];
        float br = sBr[pp * 16 + hp], bi = sBi[pp * 16 + hp];
        float wbr = W.x * br - W.y * bi, wbi = W.x * bi + W.y * br;
        float cr = sCr[h * 65 + pp], ci = sCi[h * 65 + pp];
        acc += cr * wbr - ci * wbi;
      }
      KTAB[(size_t)(g * 33 + d + 1) * 256 + h * 16 + hp] = (h16)acc;
      if (d == 0) KTAB[(size_t)(g * 33) * 256 + tid] = (h16)0.f;
    }
    {
      const int i = 31 - d;
#pragma unroll
      for (int r = 0; r < 4; ++r) {
        int idx = tid + 256 * r, pp = idx >> 4, hp = idx & 15;
        float2 W = sW[pp];
        float br = sBr[pp * 16 + hp], bi = sBi[pp * 16 + hp];
        float wbr = W.x * br - W.y * bi, wbi = W.x * bi + W.y * br;
        ETAB[((size_t)g * 128 + pp) * 512 + i * 16 + hp] = (h16)wbr;
        ETAB[((size_t)g * 128 + 64 + pp) * 512 + i * 16 + hp] = (h16)wbi;
      }
    }
  }
  if (d >= 1) {
    const int j = d - 1;
#pragma unroll
    for (int r = 0; r < 4; ++r) {
      int idx = tid + 256 * r, h = idx >> 6, pp = idx & 63;
      float2 Ap = sAp[pp];
      float cr = sCr[h * 65 + pp], ci = sCi[h * 65 + pp];
      float re = cr * Ap.x - ci * Ap.y, im = cr * Ap.y + ci * Ap.x;
      FTAB[((size_t)g * 512 + j * 16 + h) * 128 + pp] = (h16)re;
      FTAB[((size_t)g * 512 + j * 16 + h) * 128 + 64 + pp] = (h16)(-im);
    }
  }
  __syncthreads();
}

__device__ void phase0(const Params& p, unsigned char* smem) {
  const int bid = blockIdx.x, nb = gridDim.x, tid = threadIdx.x, wid = tid >> 6, lane = tid & 63;
  float* tile = (float*)smem;
  for (int t = bid; t < 1440; t += nb) {
    if (t < 800) transpose_w(p.in[I_WIN], 1024, 3080, 3200, (h16*)(p.ws + OFF_WIN), t, tile);
    else if (t < 864) transpose_w(p.in[I_WGLU], 512, 512, 512, (h16*)(p.ws + OFF_WGLU), t - 800, tile);
    else if (t < 1120) transpose_w(p.in[I_WOUT], 1024, 1024, 1024, (h16*)(p.ws + OFF_WOUT), t - 864, tile);
    else if (t < 1184) transpose_w(p.in[I_WPP], 256, 1024, 1024, (h16*)(p.ws + OFF_WPP), t - 1120, tile);
    else transpose_w(p.in[I_WGATE], 1024, 1024, 1024, (h16*)(p.ws + OFF_WGATE), t - 1184, tile);
  }
  for (int it = bid; it < 32 * 33; it += nb) ssm_table_item(p, it / 33, it % 33, (float*)smem);
  {
    h16* A0 = (h16*)((unsigned char*)p.out + OUT_OFF_A0);
    const float* x = p.in[I_X];
    const float4* g4 = (const float4*)p.in[I_NMG];
    for (int row = bid * 4 + wid; row < T_TOK; row += nb * 4) {
      const float4* xr = (const float4*)(x + (size_t)row * 1024);
      float4 v[4];
      float ss = 0.f;
#pragma unroll
      for (int i = 0; i < 4; ++i) {
        v[i] = xr[lane + i * 64];
        ss += v[i].x * v[i].x + v[i].y * v[i].y + v[i].z * v[i].z + v[i].w * v[i].w;
      }
      ss = wave_sum(ss);
      float rstd = rsqrtf(ss * (1.f / 1024.f) + 1e-6f);
#pragma unroll
      for (int i = 0; i < 4; ++i) {
        float4 g = g4[lane + i * 64];
        h16x4 o;
        o[0] = (h16)(v[i].x * rstd * g.x); o[1] = (h16)(v[i].y * rstd * g.y);
        o[2] = (h16)(v[i].z * rstd * g.z); o[3] = (h16)(v[i].w * rstd * g.w);
        *(h16x4*)(A0 + (size_t)row * 1024 + (lane + i * 64) * 4) = o;
      }
    }
  }
  {
    h16* PB = (h16*)(p.ws + OFF_PB);
    const float4* p4 = (const float4*)p.in[I_P];
    const size_t n4 = (size_t)T_TOK * 256 / 4;
    for (size_t i = (size_t)bid * 256 + tid; i < n4; i += (size_t)nb * 256) {
      float4 v = p4[i];
      h16x4 o;
      o[0] = (h16)v.x; o[1] = (h16)v.y; o[2] = (h16)v.z; o[3] = (h16)v.w;
      *(h16x4*)(PB + i * 4) = o;
    }
  }
}

enum { EPI_PROJ = 0, EPI_GLU, EPI_PLE, EPI_OUT, EPI_GATE };

template <int EPI>
__device__ __forceinline__ void gemm_tile(const Params& p, const h16* __restrict__ A, int lda, const h16* __restrict__ Bt, int ldb,
                                          int K, int brow, int bcol, unsigned char* smem) {
  const int tid = threadIdx.x, wid = tid >> 6, lane = tid & 63, wr = wid >> 1, wc = wid & 1, fr = lane & 15, fq = lane >> 4;
  f32x4 acc[4][4];
#pragma unroll
  for (int m = 0; m < 4; ++m)
#pragma unroll
    for (int n = 0; n < 4; ++n) acc[m][n] = f32x4{0.f, 0.f, 0.f, 0.f};
  const int nk = K / 64;
  const h16* ga[4]; const h16* gb[4];
#pragma unroll
  for (int i = 0; i < 4; ++i) {
    const int L = tid + 256 * i, row = L >> 3, cs = (L & 7) ^ (row & 7);
    ga[i] = A + (size_t)(brow + row) * lda + cs * 8;
    gb[i] = Bt + (size_t)(bcol + row) * ldb + cs * 8;
  }
#define GEMM_STAGE(t_, buf_) do { \
    unsigned char* sa_ = smem + (buf_) * 32768 + tid * 16; \
    _Pragma("unroll") for (int i_ = 0; i_ < 4; ++i_) { \
      __builtin_amdgcn_global_load_lds((const unsigned*)(ga[i_] + (t_) * 64), (unsigned*)(sa_ + i_ * 4096), 16, 0, 0); \
      __builtin_amdgcn_global_load_lds((const unsigned*)(gb[i_] + (t_) * 64), (unsigned*)(sa_ + 16384 + i_ * 4096), 16, 0, 0); \
    } \
  } while (0)
  GEMM_STAGE(0, 0);
  for (int t = 0; t < nk; ++t) {
    asm volatile("s_waitcnt vmcnt(0)" ::: "memory");
    __syncthreads();
    if (t + 1 < nk) GEMM_STAGE(t + 1, (t + 1) & 1);
    const unsigned char* SA = smem + (t & 1) * 32768;
    const unsigned char* SB = SA + 16384;
#pragma unroll
    for (int kk = 0; kk < 2; ++kk) {
      h16x8 af[4], bf[4];
      const int pos = ((kk * 4 + fq) ^ (fr & 7)) << 4;
#pragma unroll
      for (int m = 0; m < 4; ++m) {
        af[m] = *(const h16x8*)(SA + (wr * 64 + m * 16 + fr) * 128 + pos);
        bf[m] = *(const h16x8*)(SB + (wc * 64 + m * 16 + fr) * 128 + pos);
      }
#pragma unroll
      for (int m = 0; m < 4; ++m)
#pragma unroll
        for (int n = 0; n < 4; ++n) acc[m][n] = MFMA(af[m], bf[n], acc[m][n]);
    }
  }
#undef GEMM_STAGE
  __syncthreads();
  float* CT = (float*)smem;
#pragma unroll
  for (int m = 0; m < 4; ++m)
#pragma unroll
    for (int n = 0; n < 4; ++n)
#pragma unroll
      for (int j = 0; j < 4; ++j) CT[(wr * 64 + m * 16 + fq * 4 + j) * 132 + wc * 64 + n * 16 + fr] = acc[m][n][j];
  __syncthreads();
  const int c4 = tid & 31;
#pragma unroll 2
  for (int it = 0; it < 16; ++it) {
    const int rl = it * 8 + (tid >> 5);
    const size_t row = (size_t)brow + rl;
    const int col = bcol + c4 * 4;
    const float4 v = *(const float4*)(CT + rl * 132 + c4 * 4);
    if constexpr (EPI == EPI_PROJ) {
      if (bcol < 3072) {
        h16x4 o; o[0] = (h16)v.x; o[1] = (h16)v.y; o[2] = (h16)v.z; o[3] = (h16)v.w;
        *(h16x4*)((h16*)(p.ws + OFF_PROJ) + row * LDP + col) = o;
      } else if (c4 < 2) {
        *(float4*)((float*)(p.ws + OFF_AB) + row * 8 + c4 * 4) = v;
      }
    } else if constexpr (EPI == EPI_GLU) {
      const h16x4 y = *(const h16x4*)((const h16*)((unsigned char*)p.out + OUT_OFF_YPRE) + row * 512 + col);
      const h16x4 z = *(const h16x4*)((const h16*)(p.ws + OFF_PROJ) + row * LDP + 512 + col);
      const float4 bb = *(const float4*)(p.in[I_BGLU] + col);
      h16x4 o;
      o[0] = (h16)((float)y[0] * sigmoidf_(v.x + bb.x) * siluf_((float)z[0]));
      o[1] = (h16)((float)y[1] * sigmoidf_(v.y + bb.y) * siluf_((float)z[1]));
      o[2] = (h16)((float)y[2] * sigmoidf_(v.z + bb.z) * siluf_((float)z[2]));
      o[3] = (h16)((float)y[3] * sigmoidf_(v.w + bb.w) * siluf_((float)z[3]));
      *(h16x4*)((h16*)(p.ws + OFF_MIXIN) + row * 1024 + col) = o;
    } else if constexpr (EPI == EPI_PLE) {
      h16x4 o; o[0] = (h16)v.x; o[1] = (h16)v.y; o[2] = (h16)v.z; o[3] = (h16)v.w;
      *(h16x4*)((h16*)(p.ws + OFF_EH) + row * 1024 + col) = o;
      float s = v.x * v.x + v.y * v.y + v.z * v.z + v.w * v.w;
      s = sum16(s); s += __shfl_xor(s, 16);
      if (c4 == 0) ((float*)(p.ws + OFF_EPART))[row * 8 + (bcol >> 7)] = s;
    } else if constexpr (EPI == EPI_OUT) {
      const float4 xv = *(const float4*)(p.in[I_X] + row * 1024 + col);
      float4 hv; hv.x = xv.x + v.x; hv.y = xv.y + v.y; hv.z = xv.z + v.z; hv.w = xv.w + v.w;
      h16x4 o; o[0] = (h16)hv.x; o[1] = (h16)hv.y; o[2] = (h16)hv.z; o[3] = (h16)hv.w;
      *(h16x4*)((h16*)(p.ws + OFF_PROJ) + row * 1024 + col) = o;
    } else if constexpr (EPI == EPI_GATE) {
      const float4 e0 = *(const float4*)((const float*)(p.ws + OFF_EPART) + row * 8);
      const float4 e1 = *(const float4*)((const float*)(p.ws + OFF_EPART) + row * 8 + 4);
      const float rs = rsqrtf((e0.x + e0.y + e0.z + e0.w + e1.x + e1.y + e1.z + e1.w) * (1.f / 1024.f) + 1e-6f);
      const h16x4 eh = *(const h16x4*)((const h16*)(p.ws + OFF_EH) + row * 1024 + col);
      const float4 pg = *(const float4*)(p.in[I_PLEG] + col);
      const h16x4 hb = *(const h16x4*)((const h16*)(p.ws + OFF_PROJ) + row * 1024 + col);
      float4 hv;
      hv.x = (float)hb[0] + sigmoidf_(v.x) * ((float)eh[0] * rs * pg.x);
      hv.y = (float)hb[1] + sigmoidf_(v.y) * ((float)eh[1] * rs * pg.y);
      hv.z = (float)hb[2] + sigmoidf_(v.z) * ((float)eh[2] * rs * pg.z);
      hv.w = (float)hb[3] + sigmoidf_(v.w) * ((float)eh[3] * rs * pg.w);
      {
        h16x4 o; o[0] = (h16)hv.x; o[1] = (h16)hv.y; o[2] = (h16)hv.z; o[3] = (h16)hv.w;
        *(h16x4*)((h16*)(p.ws + OFF_MIXIN) + row * 1024 + col) = o;
      }
      float s = hv.x * hv.x + hv.y * hv.y + hv.z * hv.z + hv.w * hv.w;
      s = sum16(s); s += __shfl_xor(s, 16);
      if (c4 == 0) ((float*)(p.ws + OFF_OPART))[row * 8 + (bcol >> 7)] = s;
    }
  }
  __syncthreads();
}

__device__ void ssm_item(const Params& p, int b, int g, unsigned char* smem) {
  float* LOCAL = (float*)smem;
  h16* SPREV = (h16*)(smem + 33792);
  h16* KT = (h16*)(smem + 51200);
  int tid_ = threadIdx.x;
  asm volatile("" : "+v"(tid_));
  const int tid = tid_, w = tid >> 6, lane = tid & 63, fr = lane & 15, fq = lane >> 4;
  const h16* PROJ = (const h16*)(p.ws + OFF_PROJ);
  const h16* Eg = (const h16*)(p.ws + OFF_ETAB) + (size_t)g * 128 * 512;
  const h16* Kg = (const h16*)(p.ws + OFF_KTAB) + (size_t)g * 33 * 256;
  const h16* Fg = (const h16*)(p.ws + OFF_FTAB) + (size_t)g * 512 * 128;
  const float* ALPOW = (const float*)(p.ws + OFF_ALPOW);
  h16* YPRE = (h16*)((unsigned char*)p.out + OUT_OFF_YPRE);
  const int nchunk = w * 16 + fr;
  const size_t tok0 = (size_t)b * SEQ + (size_t)nchunk * 32;
  for (int idx = tid; idx < 33 * 256 / 8; idx += 256) *(h16x8*)(KT + idx * 8) = *(const h16x8*)(Kg + idx * 8);
  h16x8 uf[16];
#pragma unroll
  for (int ks = 0; ks < 16; ++ks) {
    const int i = 2 * ks + (fq >> 1);
    uf[ks] = *(const h16x8*)(PROJ + (tok0 + i) * LDP + g * 16 + (fq & 1) * 8);
  }
  {
    h16x8 ea[8];
#pragma unroll
    for (int ks = 0; ks < 8; ++ks) ea[ks] = *(const h16x8*)(Eg + (size_t)fr * 512 + ks * 32 + fq * 8);
    f32x4 acc = {0.f, 0.f, 0.f, 0.f};
#pragma unroll 1
    for (int it = 0; it < 16; ++it) {
      const int mt = it >> 1, hf = it & 1;
      const int itn = it < 15 ? it + 1 : 15;
      h16x8 en[8];
#pragma unroll
      for (int ks = 0; ks < 8; ++ks) en[ks] = *(const h16x8*)(Eg + (size_t)((itn >> 1) * 16 + fr) * 512 + ((itn & 1) * 8 + ks) * 32 + fq * 8);
      if (hf == 0) {
#pragma unroll
        for (int ks = 0; ks < 8; ++ks) acc = MFMA(ea[ks], uf[ks], acc);
      } else {
#pragma unroll
        for (int ks = 0; ks < 8; ++ks) acc = MFMA(ea[ks], uf[8 + ks], acc);
        *(f32x4*)(LOCAL + nchunk * 132 + mt * 16 + fq * 4) = acc;
        acc = f32x4{0.f, 0.f, 0.f, 0.f};
      }
#pragma unroll
      for (int ks = 0; ks < 8; ++ks) ea[ks] = en[ks];
    }
  }
  __syncthreads();
  if (tid < 64) {
    const int pp = tid;
    const float ar = ALPOW[(g * 64 + pp) * 2], ai = ALPOW[(g * 64 + pp) * 2 + 1];
    float sr = 0.f, si = 0.f;
#pragma unroll 4
    for (int c = 0; c < 64; ++c) {
      SPREV[c * 136 + pp] = (h16)sr;
      SPREV[c * 136 + 64 + pp] = (h16)si;
      float lr = LOCAL[c * 132 + pp], li = LOCAL[c * 132 + 64 + pp];
      float nr = ar * sr - ai * si + lr;
      float ni = ar * si + ai * sr + li;
      sr = nr; si = ni;
    }
  }
  __syncthreads();
  h16x8 sf[4];
#pragma unroll
  for (int ks = 0; ks < 4; ++ks) sf[ks] = *(const h16x8*)(SPREV + nchunk * 136 + ks * 32 + fq * 8);
  const float4 Dv = *(const float4*)(p.in[I_D] + g * 16 + fq * 4);
  h16x8 fa[4];
#pragma unroll
  for (int ks = 0; ks < 4; ++ks) fa[ks] = *(const h16x8*)(Fg + (size_t)fr * 128 + ks * 32 + fq * 8);
  h16x4 u4 = *(const h16x4*)(PROJ + tok0 * LDP + g * 16 + fq * 4);
#pragma unroll 1
  for (int j = 0; j < 32; ++j) {
    const int jn = j < 31 ? j + 1 : 31;
    h16x8 fn[4];
#pragma unroll
    for (int ks = 0; ks < 4; ++ks) fn[ks] = *(const h16x8*)(Fg + (size_t)(jn * 16 + fr) * 128 + ks * 32 + fq * 8);
    const h16x4 un = *(const h16x4*)(PROJ + (tok0 + jn) * LDP + g * 16 + fq * 4);
    f32x4 acc = {0.f, 0.f, 0.f, 0.f};
#pragma unroll
    for (int ks = 0; ks < 16; ++ks) {
      if (2 * ks <= j) {
        const int dd = j - 2 * ks - (fq >> 1) + 1;
        h16x8 a = *(const h16x8*)(KT + dd * 256 + fr * 16 + (fq & 1) * 8);
        acc = MFMA(a, uf[ks], acc);
      }
    }
#pragma unroll
    for (int ks = 0; ks < 4; ++ks) acc = MFMA(fa[ks], sf[ks], acc);
    const size_t tok = tok0 + j;
    h16x4 o;
    o[0] = (h16)gelu_tanh(acc[0] + Dv.x * (float)u4[0]);
    o[1] = (h16)gelu_tanh(acc[1] + Dv.y * (float)u4[1]);
    o[2] = (h16)gelu_tanh(acc[2] + Dv.z * (float)u4[2]);
    o[3] = (h16)gelu_tanh(acc[3] + Dv.w * (float)u4[3]);
    *(h16x4*)(YPRE + tok * 512 + g * 16 + fq * 4) = o;
#pragma unroll
    for (int ks = 0; ks < 4; ++ks) fa[ks] = fn[ks];
    u4 = un;
  }
  __syncthreads();
}

__device__ void gdn_pre_item(const Params& p, int item, unsigned char* smem) {
  h16* QH = (h16*)smem;
  h16* KH = (h16*)(smem + 17408);
  h16* VH = (h16*)(smem + 34816);
  float* LT = (float*)(smem + 52224);
  float* sG = (float*)(smem + 69632);
  float* sBeta = (float*)(smem + 69888);
  float* sEG = (float*)(smem + 70144);
  float* sBG = (float*)(smem + 70400);
  float* sEL = (float*)(smem + 70656);
  int tid_ = threadIdx.x;
  asm volatile("" : "+v"(tid_));
  const int tid = tid_, w = tid >> 6, lane = tid & 63, fr = lane & 15, fq = lane >> 4;
  const int c = item & 31, h = (item >> 5) & 3, b = item >> 7;
  const h16* PROJ = (const h16*)(p.ws + OFF_PROJ);
  const float* AB = (const float*)(p.ws + OFF_AB);
  const float* convw = p.in[I_CONVW];
  h16* WPi = (h16*)(p.ws + OFF_WP) + (size_t)item * 64 * 128;
  h16* QGPi = (h16*)(p.ws + OFF_QGP) + (size_t)item * 64 * 128;
  h16* KDTi = (h16*)(p.ws + OFF_KDT) + (size_t)item * 128 * 64;
  h16* UTi = (h16*)(p.ws + OFF_UT) + (size_t)item * 128 * 64;
  h16* ATPi = (h16*)(p.ws + OFF_ATP) + (size_t)item * 64 * 64;
  h16* ZTi = (h16*)((unsigned char*)p.out + OUT_OFF_ZT) + (size_t)item * 128 * 64;
  float* DL = (float*)(p.ws + OFF_DL);
  {
    const int ch0 = (tid & 15) * 8, t0 = (tid >> 4) * 4;
#pragma unroll 1
    for (int sec = 0; sec < 3; ++sec) {
      const int colbase = 1024 + sec * 512 + h * 128 + ch0;
      h16x8 xr[7];
#pragma unroll
      for (int i = 0; i < 7; ++i) {
        const int ts = c * 64 + t0 - 3 + i;
        h16x8 z8 = {(h16)0.f, (h16)0.f, (h16)0.f, (h16)0.f, (h16)0.f, (h16)0.f, (h16)0.f, (h16)0.f};
        xr[i] = (ts >= 0) ? *(const h16x8*)(PROJ + ((size_t)b * SEQ + ts) * LDP + colbase) : z8;
      }
      float4 wv[4][2];
#pragma unroll
      for (int jj = 0; jj < 4; ++jj) {
        wv[jj][0] = *(const float4*)(convw + jj * 1536 + sec * 512 + h * 128 + ch0);
        wv[jj][1] = *(const float4*)(convw + jj * 1536 + sec * 512 + h * 128 + ch0 + 4);
      }
      h16* dst = (sec == 0 ? QH : (sec == 1 ? KH : VH));
#pragma unroll
      for (int tt = 0; tt < 4; ++tt) {
        float a[8];
#pragma unroll
        for (int e = 0; e < 8; ++e) a[e] = 0.f;
#pragma unroll
        for (int jj = 0; jj < 4; ++jj) {
          const h16x8 xv = xr[tt + jj];
          a[0] += wv[jj][0].x * (float)xv[0]; a[1] += wv[jj][0].y * (float)xv[1]; a[2] += wv[jj][0].z * (float)xv[2]; a[3] += wv[jj][0].w * (float)xv[3];
          a[4] += wv[jj][1].x * (float)xv[4]; a[5] += wv[jj][1].y * (float)xv[5]; a[6] += wv[jj][1].z * (float)xv[6]; a[7] += wv[jj][1].w * (float)xv[7];
        }
        float ss = 0.f;
#pragma unroll
        for (int e = 0; e < 8; ++e) { a[e] = siluf_(a[e]); ss += a[e] * a[e]; }
        float scale = 1.f;
        if (sec < 2) {
          ss = sum16(ss);
          scale = rsqrtf(ss + 1e-6f) * (sec == 0 ? 0.08838834764831845f : 1.f);
        }
        h16x8 o;
#pragma unroll
        for (int e = 0; e < 8; ++e) o[e] = (h16)(a[e] * scale);
        *(h16x8*)(dst + (t0 + tt) * 136 + ch0) = o;
      }
    }
  }
  if (tid < 64) {
    const size_t tok = (size_t)b * SEQ + c * 64 + tid;
    float braw = AB[tok * 8 + h], araw = AB[tok * 8 + 4 + h];
    float beta = 1.f / (1.f + expf(-braw));
    float xx = araw + p.in[I_DTB][h];
    float sp = xx > 20.f ? xx : log1pf(expf(xx));
    float gg = -expf(p.in[I_ALOG][h]) * sp;
#pragma unroll
    for (int o = 1; o < 64; o <<= 1) {
      float v = __shfl_up(gg, o);
      if (lane >= o) gg += v;
    }
    sG[tid] = gg;
    sBeta[tid] = beta;
    const float eg = expf(gg);
    sEG[tid] = eg;
    sBG[tid] = beta * eg;
    sEL[tid] = expf(__shfl(gg, 63) - gg);
  }
  __syncthreads();
  {
    h16x8 ak[4], aq[4];
#pragma unroll
    for (int ks = 0; ks < 4; ++ks) {
      ak[ks] = *(const h16x8*)(KH + (w * 16 + fr) * 136 + ks * 32 + fq * 8);
      aq[ks] = *(const h16x8*)(QH + (w * 16 + fr) * 136 + ks * 32 + fq * 8);
    }
#pragma unroll
    for (int jt = 0; jt < 4; ++jt) {
      const int j = jt * 16 + fr;
      const int pj = perm_pos(j);
      if (jt <= w) {
        f32x4 kk = {0.f, 0.f, 0.f, 0.f}, qk = {0.f, 0.f, 0.f, 0.f};
#pragma unroll
        for (int ks = 0; ks < 4; ++ks) {
          h16x8 bk = *(const h16x8*)(KH + (jt * 16 + fr) * 136 + ks * 32 + fq * 8);
          kk = MFMA(ak[ks], bk, kk);
          qk = MFMA(aq[ks], bk, qk);
        }
        const float Gj = sG[j];
        f32x4 lt;
#pragma unroll
        for (int r = 0; r < 4; ++r) {
          const int i = w * 16 + 4 * fq + r;
          const float e = (i >= j) ? __expf(sG[i] - Gj) : 0.f;
          lt[r] = (i > j) ? sBeta[i] * kk[r] * e : 0.f;
          ATPi[i * 64 + (((pj >> 3) ^ (i & 7)) << 3) + (pj & 7)] = (h16)(qk[r] * e);
        }
        *(f32x4*)(LT + j * 68 + w * 16 + 4 * fq) = lt;
      } else {
#pragma unroll
        for (int r = 0; r < 4; ++r) {
          const int i = w * 16 + 4 * fq + r;
          ATPi[i * 64 + (((pj >> 3) ^ (i & 7)) << 3) + (pj & 7)] = (h16)0.f;
        }
      }
    }
  }
  __syncthreads();
  v2f r2[32];
  if (tid < 128) {
#pragma unroll
    for (int t = 0; t < 32; ++t) {
      r2[t][0] = (float)VH[(2 * t) * 136 + tid] * sBeta[2 * t];
      r2[t][1] = (float)VH[(2 * t + 1) * 136 + tid] * sBeta[2 * t + 1];
    }
  } else {
#pragma unroll
    for (int t = 0; t < 32; ++t) {
      r2[t][0] = (float)KH[(2 * t) * 136 + (tid - 128)] * sBG[2 * t];
      r2[t][1] = (float)KH[(2 * t + 1) * 136 + (tid - 128)] * sBG[2 * t + 1];
    }
  }
#pragma unroll
  for (int j = 0; j < 63; ++j) {
    const float xj = r2[j >> 1][j & 1];
    const v2f xx = {xj, xj};
#pragma unroll
    for (int i4 = (j + 1) / 4; i4 < 16; ++i4) {
      const f32x4 l = *(const f32x4*)(LT + j * 68 + i4 * 4);
      const v2f l0 = {l[0], l[1]}, l1 = {l[2], l[3]};
      if (i4 * 4 > j) r2[2 * i4] -= l0 * xx;
      else { if (i4 * 4 + 0 > j) r2[2 * i4][0] -= l[0] * xj; if (i4 * 4 + 1 > j) r2[2 * i4][1] -= l[1] * xj; }
      if (i4 * 4 + 2 > j) r2[2 * i4 + 1] -= l1 * xx;
      else { if (i4 * 4 + 3 > j) r2[2 * i4 + 1][1] -= l[3] * xj; }
    }
    __builtin_amdgcn_sched_barrier(0);
  }
  if (tid < 128) {
#pragma unroll
    for (int t8 = 0; t8 < 8; ++t8) {
      h16x8 v;
#pragma unroll
      for (int e = 0; e < 8; ++e) v[e] = (h16)r2[(t8 * 8 + e) >> 1][e & 1];
      *(h16x8*)(UTi + (size_t)tid * 64 + t8 * 8) = v;
    }
  }
  __syncthreads();
  if (tid >= 128) {
    const int pos = perm_pos(tid - 128);
#pragma unroll
    for (int t = 0; t < 64; ++t) VH[t * 136 + pos] = (h16)r2[t >> 1][t & 1];
  }
  __syncthreads();
  for (int rr = 0; rr < 4; ++rr) {
    const int idx = tid + 256 * rr, row = idx >> 4, seg = idx & 15;
    *(h16x8*)(WPi + row * 128 + ((seg ^ (row & 15)) << 3)) = *(const h16x8*)(VH + row * 136 + seg * 8);
  }
  {
    const int dv = tid & 127, th = tid >> 7;
    const float gdv = p.in[I_DNG][dv];
    const h16* zp = PROJ + ((size_t)b * SEQ + c * 64 + th * 32) * LDP + 2560 + h * 128 + dv;
    h16 zv[32];
#pragma unroll
    for (int t = 0; t < 32; ++t) zv[t] = zp[(size_t)t * LDP];
#pragma unroll
    for (int t8 = 0; t8 < 4; ++t8) {
      h16x8 v;
#pragma unroll
      for (int e = 0; e < 8; ++e) v[e] = (h16)(siluf_((float)zv[t8 * 8 + e]) * gdv);
      *(h16x8*)(ZTi + (size_t)dv * 64 + th * 32 + t8 * 8) = v;
    }
  }
#pragma unroll 2
  for (int rr = 0; rr < 4; ++rr) {
    const int idx = tid + 256 * rr, t = idx >> 4, cpos = idx & 15, ks = cpos >> 2, q = cpos & 3;
    const h16x4 lo = *(const h16x4*)(QH + t * 136 + ks * 32 + 4 * q);
    const h16x4 hi = *(const h16x4*)(QH + t * 136 + ks * 32 + 16 + 4 * q);
    const float sc = sEG[t];
    h16x8 o;
#pragma unroll
    for (int e = 0; e < 4; ++e) { o[e] = (h16)((float)lo[e] * sc); o[4 + e] = (h16)((float)hi[e] * sc); }
    *(h16x8*)(QGPi + t * 128 + ((cpos ^ (t & 15)) << 3)) = o;
  }
#pragma unroll 2
  for (int rr = 0; rr < 4; ++rr) {
    const int idx = tid + 256 * rr, dk = idx >> 3, cpos = idx & 7, k2 = cpos >> 2, q = cpos & 3;
    h16x8 o;
#pragma unroll
    for (int e = 0; e < 8; ++e) {
      const int t = k2 * 32 + (e < 4 ? 4 * q + e : 16 + 4 * q + (e - 4));
      o[e] = (h16)((float)KH[t * 136 + dk] * sEL[t]);
    }
    *(h16x8*)(KDTi + dk * 64 + ((cpos ^ (dk & 7)) << 3)) = o;
  }
  const float Glast = sG[63];
  if (tid == 0) DL[item] = expf(Glast);
  __syncthreads();
}

template <int NB>
__device__ __forceinline__ void glds_copy(const h16* __restrict__ g, unsigned char* l) {
#pragma unroll
  for (int i = 0; i < NB / 4096; ++i) {
    const int off = threadIdx.x * 16 + i * 4096;
    __builtin_amdgcn_global_load_lds((const unsigned*)((const unsigned char*)g + off), (unsigned*)(l + off), 16, 0, 0);
  }
}
#define RAW_BARRIER() do { asm volatile("s_waitcnt lgkmcnt(0)" ::: "memory"); __builtin_amdgcn_s_barrier(); asm volatile("" ::: "memory"); } while (0)

__device__ void gdn_chain(const Params& p, int bh, unsigned char* smem) {
  const int tid = threadIdx.x, w = tid >> 6, lane = tid & 63, fr = lane & 15, fq = lane >> 4;
  const float* DL = (const float*)(p.ws + OFF_DL);
  const h16* WPb = (const h16*)(p.ws + OFF_WP) + (size_t)bh * 32 * 64 * 128;
  const h16* KDTb = (const h16*)(p.ws + OFF_KDT) + (size_t)bh * 32 * 128 * 64;
  h16* UTb = (h16*)(p.ws + OFF_UT) + (size_t)bh * 32 * 128 * 64;
  h16* SFb = (h16*)((unsigned char*)p.out + OUT_OFF_SF) + (size_t)bh * 32 * 128 * 128;
  f32x4 S[8][2];
#pragma unroll
  for (int i = 0; i < 8; ++i) { S[i][0] = f32x4{0.f, 0.f, 0.f, 0.f}; S[i][1] = f32x4{0.f, 0.f, 0.f, 0.f}; }
  h16x4 uR[4][2];
  const int uoff = (w * 32 + fr) * 64 + fq * 4;
  glds_copy<16384>(WPb, smem); glds_copy<16384>(KDTb, smem + 16384);
#pragma unroll
  for (int mt = 0; mt < 4; ++mt)
#pragma unroll
    for (int nt = 0; nt < 2; ++nt) uR[mt][nt] = *(const h16x4*)(UTb + uoff + nt * 1024 + mt * 16);
  float dl = DL[bh * 32];
  asm volatile("s_waitcnt vmcnt(0)" ::: "memory");
  RAW_BARRIER();
  for (int c = 0; c < 32; ++c) {
    const int cn = (c + 1 < 32) ? c + 1 : 31;
    const unsigned char* LW = smem + (c & 1) * 32768;
    const unsigned char* LK = LW + 16384;
    unsigned char* LWn = smem + ((c + 1) & 1) * 32768;
    f32x4 uf[4][2];
#pragma unroll
    for (int mt = 0; mt < 4; ++mt)
#pragma unroll
      for (int nt = 0; nt < 2; ++nt)
#pragma unroll
        for (int r = 0; r < 4; ++r) uf[mt][nt][r] = (float)uR[mt][nt][r];
    const float dlc = dl;
    asm volatile("" ::: "memory");
    h16x8 sfr[4][2];
#pragma unroll
    for (int ks = 0; ks < 4; ++ks) { sfr[ks][0] = pack8(S[2 * ks][0], S[2 * ks + 1][0]); sfr[ks][1] = pack8(S[2 * ks][1], S[2 * ks + 1][1]); }
#pragma unroll
    for (int ks = 0; ks < 4; ++ks)
#pragma unroll
      for (int nt = 0; nt < 2; ++nt)
        *(h16x8*)(SFb + ((size_t)(c * 4 + ks) * 8 + w * 2 + nt) * 512 + lane * 8) = sfr[ks][nt];
    glds_copy<16384>(WPb + (size_t)cn * 64 * 128, LWn);
    glds_copy<16384>(KDTb + (size_t)cn * 128 * 64, LWn + 16384);
#pragma unroll
    for (int mt = 0; mt < 4; ++mt)
#pragma unroll
      for (int nt = 0; nt < 2; ++nt)
        uR[mt][nt] = *(const h16x4*)(UTb + (size_t)cn * 128 * 64 + uoff + nt * 1024 + mt * 16);
    dl = DL[bh * 32 + cn];
    asm volatile("" ::: "memory");
    f32x4 vn[4][2];
#pragma unroll
    for (int mt = 0; mt < 4; ++mt) { vn[mt][0] = f32x4{0.f, 0.f, 0.f, 0.f}; vn[mt][1] = vn[mt][0]; }
#pragma unroll
    for (int ks = 0; ks < 4; ++ks)
#pragma unroll
      for (int mt = 0; mt < 4; ++mt) {
        h16x8 aw = *(const h16x8*)(LW + (mt * 16 + fr) * 256 + (((ks * 4 + fq) ^ fr) << 4));
        vn[mt][0] = MFMA(aw, sfr[ks][0], vn[mt][0]);
        vn[mt][1] = MFMA(aw, sfr[ks][1], vn[mt][1]);
      }
#pragma unroll
    for (int mt = 0; mt < 4; ++mt)
#pragma unroll
      for (int r = 0; r < 4; ++r) { vn[mt][0][r] = uf[mt][0][r] - vn[mt][0][r]; vn[mt][1][r] = uf[mt][1][r] - vn[mt][1][r]; }
    h16x8 vfr[2][2];
#pragma unroll
    for (int k2 = 0; k2 < 2; ++k2) { vfr[k2][0] = pack8(vn[2 * k2][0], vn[2 * k2 + 1][0]); vfr[k2][1] = pack8(vn[2 * k2][1], vn[2 * k2 + 1][1]); }
    if (c + 1 < 32) {
#pragma unroll
      for (int k2 = 0; k2 < 2; ++k2)
#pragma unroll
        for (int nt = 0; nt < 2; ++nt)
          *(h16x8*)(UTb + (size_t)c * 128 * 64 + ((size_t)k2 * 8 + w * 2 + nt) * 512 + lane * 8) = vfr[k2][nt];
    }
#pragma unroll
    for (int dkt = 0; dkt < 8; ++dkt) {
      f32x4 s0 = S[dkt][0], s1 = S[dkt][1];
#pragma unroll
      for (int r = 0; r < 4; ++r) { s0[r] *= dlc; s1[r] *= dlc; }
#pragma unroll
      for (int k2 = 0; k2 < 2; ++k2) {
        h16x8 ak = *(const h16x8*)(LK + (dkt * 16 + fr) * 128 + (((k2 * 4 + fq) ^ (fr & 7)) << 4));
        s0 = MFMA(ak, vfr[k2][0], s0);
        s1 = MFMA(ak, vfr[k2][1], s1);
      }
      S[dkt][0] = s0; S[dkt][1] = s1;
    }
    asm volatile("s_waitcnt vmcnt(0)" ::: "memory");
    RAW_BARRIER();
    if (c + 1 == 32) {
#pragma unroll
      for (int k2 = 0; k2 < 2; ++k2)
#pragma unroll
        for (int nt = 0; nt < 2; ++nt)
          *(h16x8*)(UTb + (size_t)c * 128 * 64 + ((size_t)k2 * 8 + w * 2 + nt) * 512 + lane * 8) = vfr[k2][nt];
    }
  }
  asm volatile("s_waitcnt vmcnt(0)" ::: "memory");
  __syncthreads();
}

__device__ void gdn_out_item(const Params& p, int item, unsigned char* smem) {
  unsigned char* LQ = smem;
  unsigned char* LA = smem + 16384;
  float* red = (float*)(smem + 24576);
  const int tid = threadIdx.x, w = tid >> 6, lane = tid & 63, fr = lane & 15, fq = lane >> 4;
  const int c = item & 31, h = (item >> 5) & 3, b = item >> 7;
  h16* MIXIN = (h16*)(p.ws + OFF_MIXIN);
  const h16* QGPi = (const h16*)(p.ws + OFF_QGP) + (size_t)item * 64 * 128;
  const h16* ATPi = (const h16*)(p.ws + OFF_ATP) + (size_t)item * 64 * 64;
  const h16* VFi = (const h16*)(p.ws + OFF_UT) + (size_t)item * 128 * 64;
  const h16* SFi = (const h16*)((unsigned char*)p.out + OUT_OFF_SF) + (size_t)item * 128 * 128;
  const h16* ZTi = (const h16*)((unsigned char*)p.out + OUT_OFF_ZT) + (size_t)item * 128 * 64;
  glds_copy<16384>(QGPi, LQ); glds_copy<8192>(ATPi, LA);
  h16x8 sfr[4][2], vfr[2][2];
#pragma unroll
  for (int ks = 0; ks < 4; ++ks)
#pragma unroll
    for (int nt = 0; nt < 2; ++nt) sfr[ks][nt] = *(const h16x8*)(SFi + ((size_t)ks * 8 + w * 2 + nt) * 512 + lane * 8);
#pragma unroll
  for (int k2 = 0; k2 < 2; ++k2)
#pragma unroll
    for (int nt = 0; nt < 2; ++nt) vfr[k2][nt] = *(const h16x8*)(VFi + ((size_t)k2 * 8 + w * 2 + nt) * 512 + lane * 8);
  h16x4 zR[4][2];
#pragma unroll
  for (int mt = 0; mt < 4; ++mt)
#pragma unroll
    for (int nt = 0; nt < 2; ++nt) zR[mt][nt] = *(const h16x4*)(ZTi + (size_t)(w * 32 + nt * 16 + fr) * 64 + mt * 16 + fq * 4);
  asm volatile("s_waitcnt vmcnt(0)" ::: "memory");
  __syncthreads();
  f32x4 o[4][2];
#pragma unroll
  for (int mt = 0; mt < 4; ++mt) {
    f32x4 o0 = {0.f, 0.f, 0.f, 0.f}, o1 = {0.f, 0.f, 0.f, 0.f};
#pragma unroll
    for (int ks = 0; ks < 4; ++ks) {
      h16x8 aq = *(const h16x8*)(LQ + (mt * 16 + fr) * 256 + (((ks * 4 + fq) ^ fr) << 4));
      o0 = MFMA(aq, sfr[ks][0], o0);
      o1 = MFMA(aq, sfr[ks][1], o1);
    }
#pragma unroll
    for (int k2 = 0; k2 < 2; ++k2) {
      h16x8 aa = *(const h16x8*)(LA + (mt * 16 + fr) * 128 + (((k2 * 4 + fq) ^ (fr & 7)) << 4));
      o0 = MFMA(aa, vfr[k2][0], o0);
      o1 = MFMA(aa, vfr[k2][1], o1);
    }
    o[mt][0] = o0; o[mt][1] = o1;
  }
#pragma unroll
  for (int mt = 0; mt < 4; ++mt)
#pragma unroll
    for (int r = 0; r < 4; ++r) {
      float s = o[mt][0][r] * o[mt][0][r] + o[mt][1][r] * o[mt][1][r];
      s = sum16(s);
      if (fr == 0) red[w * 64 + mt * 16 + 4 * fq + r] = s;
    }
  __syncthreads();
#pragma unroll
  for (int mt = 0; mt < 4; ++mt)
#pragma unroll
    for (int r = 0; r < 4; ++r) {
      const int tl = mt * 16 + 4 * fq + r;
      const float tot = red[tl] + red[64 + tl] + red[128 + tl] + red[192 + tl];
      const float rstd = rsqrtf(tot * (1.f / 128.f) + 1e-6f);
      const size_t tok = (size_t)b * SEQ + c * 64 + tl;
      h16* yp = MIXIN + tok * 1024 + 512 + h * 128 + w * 32 + fr;
      yp[0] = (h16)(o[mt][0][r] * rstd * (float)zR[mt][0][r]);
      yp[16] = (h16)(o[mt][1][r] * rstd * (float)zR[mt][1][r]);
    }
  __syncthreads();
}

#define XB_TMO      128
#define XB_XCNT(j)  (256  + 64 * (j))
#define XB_XSUB(j)  (1280 + 64 * (j))
#define XB_XGEN(j)  (2304 + 64 * (j))
#define XB_TOP      3328
#define XB_TOPGEN   3392
#define XCD_BAR_WORDS 3456
#define XB_SPIN_CAP (1u << 18)
#define LAS __attribute__((address_space(3)))

__device__ __forceinline__ unsigned xb_ld(unsigned* p)              { return __hip_atomic_load(p, __ATOMIC_RELAXED, __HIP_MEMORY_SCOPE_AGENT); }
__device__ __forceinline__ unsigned xb_add(unsigned* p, unsigned v) { return __hip_atomic_fetch_add(p, v, __ATOMIC_RELAXED, __HIP_MEMORY_SCOPE_AGENT); }
__device__ __forceinline__ unsigned xb_xcc_id() { return (unsigned)__builtin_amdgcn_s_getreg((3 << 11) | 20) & 0xFu; }
#define XB_SPIN(cond, bar) do { unsigned _sp = 0; while (cond) { __builtin_amdgcn_s_sleep(1); \
    if ((++_sp & 255u) == 0u) { if (xb_ld(&(bar)[XB_TMO])) break; if (_sp > XB_SPIN_CAP) { atomicAdd(&(bar)[XB_TMO], 1u); break; } } } } while (0)

struct XcdBarrier {
    unsigned* bar; unsigned x;
    volatile LAS unsigned* st;
};

__device__ __forceinline__ XcdBarrier xcd_barrier_post(unsigned* bar, volatile LAS unsigned* st) {
    XcdBarrier b; b.bar = bar; b.x = xb_xcc_id(); b.st = st;
    if (threadIdx.x == 0) (void)xb_add(&bar[XB_XCNT(b.x)], 1u);
    return b;
}
__device__ __forceinline__ void xcd_barrier_complete(unsigned* bar, unsigned x, unsigned& nloc, unsigned& nx) {
    const unsigned G = gridDim.x * gridDim.y * gridDim.z;
    unsigned sum, cnt, mine, sp = 0u;
    for (;;) {
        sum = 0u; cnt = 0u; mine = 0u;
#pragma unroll
        for (unsigned j = 0; j < 16; ++j) { const unsigned c = xb_ld(&bar[XB_XCNT(j)]); sum += c; cnt += (c > 0u) ? 1u : 0u; mine = (j == x) ? c : mine; }
        if (sum == G) break;
        __builtin_amdgcn_s_sleep(1);
        if ((++sp & 255u) == 0u) { if (xb_ld(&bar[XB_TMO])) break; if (sp > XB_SPIN_CAP) { atomicAdd(&bar[XB_TMO], 1u); break; } }
    }
    nloc = mine > 0u ? mine : 1u; nx = cnt > 0u ? cnt : 1u;
}

__device__ __forceinline__ void xcd_barrier(const XcdBarrier& b) {
    asm volatile("s_waitcnt vmcnt(0)" ::: "memory");
    __syncthreads();
    if (threadIdx.x == 0) {
        unsigned* bar = b.bar;
        __builtin_amdgcn_s_waitcnt(0);
        unsigned nloc = b.st[0], nx = b.st[1];
        if (nloc == 0u) { xcd_barrier_complete(bar, b.x, nloc, nx); b.st[0] = nloc; b.st[1] = nx; }
        const unsigned old = xb_add(&bar[XB_XSUB(b.x)], 1u);
        const unsigned gen = old / nloc;
        if (old + 1u == (gen + 1u) * nloc) {
            __builtin_amdgcn_fence(__ATOMIC_RELEASE, "agent");
            asm volatile("s_waitcnt vmcnt(0)" ::: "memory");
            const unsigned og = xb_add(&bar[XB_TOP], 1u);
            const unsigned tg = og / nx;
            if (og + 1u == (tg + 1u) * nx) xb_add(&bar[XB_TOPGEN], 1u);
            else XB_SPIN(xb_ld(&bar[XB_TOPGEN]) == tg, bar);
            __builtin_amdgcn_fence(__ATOMIC_ACQUIRE, "agent");
            xb_add(&bar[XB_XGEN(b.x)], 1u);
            asm volatile("s_waitcnt vmcnt(0)" ::: "memory");
        } else {
            XB_SPIN(xb_ld(&bar[XB_XGEN(b.x)]) == gen, bar);
            __builtin_amdgcn_fence(__ATOMIC_ACQUIRE, "agent");
            asm volatile("s_waitcnt vmcnt(0)" ::: "memory");
        }
    }
    __syncthreads();
}

#ifndef ONLY_PH
#define ONLY_PH -1
#endif
#define RUNPH(n) ((ONLY_PH < 0 || ONLY_PH == (n)) && p.ph_lo <= (n) && (n) <= p.ph_hi)
#define SYNCPH(n) do { if (p.ph_lo <= (n) && (n) < p.ph_hi) xcd_barrier(xb); } while (0)
__global__ void __launch_bounds__(256, 2) hymba_mega(Params p) {
  __shared__ __attribute__((aligned(16))) unsigned char smem[SMEM_BYTES];
  cg::grid_group grid = cg::this_grid();
  const int bid = blockIdx.x, nb = gridDim.x;
  if (p.ph_lo < 0) grid.sync();
  XcdBarrier xb;
  {
    volatile LAS unsigned* st = (volatile LAS unsigned*)(smem + SMEM_BYTES - 16);
    if (threadIdx.x == 0) { st[0] = 0u; st[1] = 0u; st[2] = 0u; st[3] = 0u; }
    __syncthreads();
    if (p.ph_lo < p.ph_hi) xb = xcd_barrier_post((unsigned*)(p.ws + OFF_BAR), st);
    else { xb.bar = (unsigned*)(p.ws + OFF_BAR); xb.x = 0; xb.st = st; }
  }
  {
    if (RUNPH(0)) for (int rep = 0; rep < REP0; ++rep) {
      if (rep) grid.sync();
      phase0(p, smem);
    }
    SYNCPH(0);
    if (RUNPH(1)) for (int rep = 0; rep < REP1; ++rep) {
      if (rep) grid.sync();
      const h16* A0 = (const h16*)((unsigned char*)p.out + OUT_OFF_A0);
      const h16* W = (const h16*)(p.ws + OFF_WIN);
      const int xl = bid & 7, nxb = nb >> 3;
      if (nb & 7) { for (int t = bid; t < 256 * 25; t += nb) gemm_tile<EPI_PROJ>(p, A0, 1024, W, 1024, 1024, (t / 25) * 128, (t % 25) * 128, smem); }
      else for (int u = bid >> 3; u < 800; u += nxb) {
        const int mb = u / 200, v = u % 200;
        gemm_tile<EPI_PROJ>(p, A0, 1024, W, 1024, 1024, (xl * 32 + mb * 8 + (v & 7)) * 128, (v >> 3) * 128, smem);
      }
    }
    SYNCPH(1);
    if (RUNPH(2)) for (int rep = 0; rep < REP2; ++rep) {
      if (rep) grid.sync();
      for (int it = bid; it < 512 + 2048; it += nb) {
        if (it < 2048) gdn_pre_item(p, it, smem);
        else ssm_item(p, (it - 2048) >> 5, (it - 2048) & 31, smem);
      }
    }
    SYNCPH(2);
    if (RUNPH(3)) {
      if (bid < 64) gdn_chain(p, bid, smem);
      const int xl = bid & 7;
      unsigned* ctr = (unsigned*)(p.ws + OFF_CTR) + xl * 16;
      volatile int* bc = (volatile int*)(smem + SMEM_BYTES - 4);
      const h16* YPRE = (const h16*)((unsigned char*)p.out + OUT_OFF_YPRE);
      for (;;) {
        __syncthreads();
        if (threadIdx.x == 0) *bc = (int)atomicAdd(ctr, 1u);
        __syncthreads();
        const int u = *bc;
        if (u >= 128 + 256) break;
        if (u < 128) gemm_tile<EPI_GLU>(p, YPRE, 512, (const h16*)(p.ws + OFF_WGLU), 512, 512, (xl * 32 + (u >> 2)) * 128, (u & 3) * 128, smem);
        else gemm_tile<EPI_PLE>(p, (const h16*)(p.ws + OFF_PB), 256, (const h16*)(p.ws + OFF_WPP), 256, 256, (xl * 32 + ((u - 128) >> 3)) * 128, ((u - 128) & 7) * 128, smem);
      }
    }
    SYNCPH(3);
    if (RUNPH(4)) {
      for (int it = bid; it < 2048; it += nb) gdn_out_item(p, it, smem);
    }
    SYNCPH(4);
    if (RUNPH(5)) {
      const int xl = bid & 7, nxb = nb >> 3;
      if (nb & 7) { for (int t = bid; t < 2048; t += nb) gemm_tile<EPI_OUT>(p, (const h16*)(p.ws + OFF_MIXIN), 1024, (const h16*)(p.ws + OFF_WOUT), 1024, 1024, (t >> 3) * 128, (t & 7) * 128, smem); }
      else for (int u = bid >> 3; u < 256; u += nxb)
        gemm_tile<EPI_OUT>(p, (const h16*)(p.ws + OFF_MIXIN), 1024, (const h16*)(p.ws + OFF_WOUT), 1024, 1024, (xl * 32 + (u >> 6) * 8 + (u & 7)) * 128, ((u >> 3) & 7) * 128, smem);
    }
    SYNCPH(5);
    if (RUNPH(6)) {
      const int xl = bid & 7, nxb = nb >> 3;
      if (nb & 7) { for (int t = bid; t < 2048; t += nb) gemm_tile<EPI_GATE>(p, (const h16*)(p.ws + OFF_PROJ), 1024, (const h16*)(p.ws + OFF_WGATE), 1024, 1024, (t >> 3) * 128, (t & 7) * 128, smem); }
      else for (int u = bid >> 3; u < 256; u += nxb)
        gemm_tile<EPI_GATE>(p, (const h16*)(p.ws + OFF_PROJ), 1024, (const h16*)(p.ws + OFF_WGATE), 1024, 1024, (xl * 32 + (u >> 6) * 8 + (u & 7)) * 128, ((u >> 3) & 7) * 128, smem);
    }
    SYNCPH(6);
    if (RUNPH(7)) {
      const int wid = threadIdx.x >> 6, lane = threadIdx.x & 63;
      const float* OPART = (const float*)(p.ws + OFF_OPART);
      const float4* g4 = (const float4*)p.in[I_FING];
      const h16* H2B = (const h16*)(p.ws + OFF_MIXIN);
      for (int row = bid * 4 + wid; row < T_TOK; row += nb * 4) {
        float s = (lane < 8) ? OPART[(size_t)row * 8 + lane] : 0.f;
        const h16x8 a = *(const h16x8*)(H2B + (size_t)row * 1024 + lane * 8);
        const h16x8 b = *(const h16x8*)(H2B + (size_t)row * 1024 + 512 + lane * 8);
        s = wave_sum(s);
        const float rstd = rsqrtf(s * (1.f / 1024.f) + 1e-6f);
        float4* orow = (float4*)(p.out + (size_t)row * 1024);
        const float4 g0 = g4[lane * 2], g1 = g4[lane * 2 + 1], g2 = g4[128 + lane * 2], g3 = g4[128 + lane * 2 + 1];
        float4 o0, o1, o2, o3;
        o0.x = (float)a[0] * rstd * g0.x; o0.y = (float)a[1] * rstd * g0.y; o0.z = (float)a[2] * rstd * g0.z; o0.w = (float)a[3] * rstd * g0.w;
        o1.x = (float)a[4] * rstd * g1.x; o1.y = (float)a[5] * rstd * g1.y; o1.z = (float)a[6] * rstd * g1.z; o1.w = (float)a[7] * rstd * g1.w;
        o2.x = (float)b[0] * rstd * g2.x; o2.y = (float)b[1] * rstd * g2.y; o2.z = (float)b[2] * rstd * g2.z; o2.w = (float)b[3] * rstd * g2.w;
        o3.x = (float)b[4] * rstd * g3.x; o3.y = (float)b[5] * rstd * g3.y; o3.z = (float)b[6] * rstd * g3.z; o3.w = (float)b[7] * rstd * g3.w;
        orow[lane * 2] = o0; orow[lane * 2 + 1] = o1; orow[128 + lane * 2] = o2; orow[128 + lane * 2 + 1] = o3;
      }
    }
  }
}

extern "C" void kernel_launch(void* const* d_in, const int* in_sizes, int n_in, void* d_out, int out_size, void* d_ws, size_t ws_size,
                              hipStream_t stream) {
  static int grid_blocks = 0;
  if (!grid_blocks) {
    int dev = 0, cus = 0, per_cu = 0;
    hipGetDevice(&dev);
    hipDeviceGetAttribute(&cus, hipDeviceAttributeMultiprocessorCount, dev);
    hipOccupancyMaxActiveBlocksPerMultiprocessor(&per_cu, hymba_mega, 256, 0);
    if (per_cu > 2) per_cu = 2;
    if (per_cu < 1) per_cu = 1;
    grid_blocks = cus * per_cu;
  }
  if (n_in != 23 || ws_size < WS_END || out_size != T_TOK * 1024) {
    fprintf(stderr, "kernel_launch: unexpected sizes n_in=%d ws=%zu (need %zu) out=%d\n", n_in, ws_size, (size_t)WS_END, out_size);
    return;
  }
  Params p{};
  for (int i = 0; i < 23; ++i) p.in[i] = (const float*)d_in[i];
  p.out = (float*)d_out;
  p.ws = (unsigned char*)d_ws;
  if (hipMemsetAsync((unsigned char*)d_ws + OFF_BAR, 0, 16384, stream) != hipSuccess) { fprintf(stderr, "kernel_launch: memset of control words failed\n"); return; }
#if MULTI_LAUNCH
  for (int ph = 0; ph < NPH; ++ph) {
    p.ph_lo = ph; p.ph_hi = ph;
    hipLaunchKernelGGL(hymba_mega, dim3(grid_blocks), dim3(256), 0, stream, p);
  }
#else
  p.ph_lo = 0; p.ph_hi = NPH - 1;
  void* args[] = {&p};
  hipError_t e = hipLaunchCooperativeKernel((void*)hymba_mega, dim3(grid_blocks), dim3(256), args, 0, stream);
  if (e != hipSuccess) fprintf(stderr, "cooperative launch failed: %s (grid %d)\n", hipGetErrorString(e), grid_blocks);
#endif
}
```

```cpp
#include <hip/hip_runtime.h>
#include <hip/hip_cooperative_groups.h>
#include <cstdio>
namespace cg = cooperative_groups;

#ifndef REP0
#define REP0 1
#endif
#ifndef REP1
#define REP1 1
#endif
#ifndef REP2
#define REP2 1
#endif
#ifndef REP3
#define REP3 1
#endif
#ifndef REP4
#define REP4 1
#endif
#ifndef MULTI_LAUNCH
#define MULTI_LAUNCH 0
#endif

typedef _Float16 h16;
typedef __attribute__((ext_vector_type(8))) _Float16 h16x8;
typedef __attribute__((ext_vector_type(4))) _Float16 h16x4;
typedef __attribute__((ext_vector_type(4))) float f32x4;
typedef __attribute__((ext_vector_type(2))) float v2f;

#define MFMA(a, b, c) __builtin_amdgcn_mfma_f32_16x16x32_f16((a), (b), (c), 0, 0, 0)

constexpr int T_TOK = 32768;
constexpr int SEQ = 2048;
constexpr int NPH = 8;
constexpr int LDP = 3072;
constexpr int SMEM_BYTES = 72704;

constexpr size_t SZ_WIN = (size_t)3200 * 1024 * 2;
constexpr size_t SZ_WGLU = (size_t)512 * 512 * 2;
constexpr size_t SZ_WOUT = (size_t)1024 * 1024 * 2;
constexpr size_t SZ_WPP = (size_t)1024 * 256 * 2;
constexpr size_t SZ_WGATE = (size_t)1024 * 1024 * 2;
constexpr size_t OFF_WIN = 0;
constexpr size_t OFF_WGLU = OFF_WIN + SZ_WIN;
constexpr size_t OFF_WOUT = OFF_WGLU + SZ_WGLU;
constexpr size_t OFF_WPP = OFF_WOUT + SZ_WOUT;
constexpr size_t OFF_WGATE = OFF_WPP + SZ_WPP;
constexpr size_t OFF_PB = OFF_WGATE + SZ_WGATE;
constexpr size_t OFF_PROJ = OFF_PB + (size_t)T_TOK * 256 * 2;
constexpr size_t OFF_AB = OFF_PROJ + (size_t)T_TOK * LDP * 2;
constexpr size_t OFF_KTAB = OFF_AB + (size_t)T_TOK * 8 * 4;
constexpr size_t OFF_ETAB = OFF_KTAB + (size_t)32 * 33 * 256 * 2;
constexpr size_t OFF_FTAB = OFF_ETAB + (size_t)32 * 128 * 512 * 2;
constexpr size_t OFF_ALPOW = OFF_FTAB + (size_t)32 * 512 * 128 * 2;
constexpr size_t OFF_DL = OFF_ALPOW + (size_t)32 * 64 * 2 * 4;
constexpr size_t OFF_EPART = OFF_DL + (size_t)2048 * 4;
constexpr size_t OFF_OPART = OFF_EPART + (size_t)T_TOK * 16 * 4;
constexpr size_t OFF_MIXIN = OFF_OPART + (size_t)T_TOK * 16 * 4;
constexpr size_t OFF_WP = OFF_MIXIN + (size_t)T_TOK * 1024 * 2;
constexpr size_t OFF_QGP = OFF_WP + (size_t)2048 * 64 * 128 * 2;
constexpr size_t OFF_KDT = OFF_QGP + (size_t)2048 * 64 * 128 * 2;
constexpr size_t OFF_UT = OFF_KDT + (size_t)2048 * 128 * 64 * 2;
constexpr size_t OFF_ATP = OFF_UT + (size_t)2048 * 128 * 64 * 2;
constexpr size_t OFF_EH = OFF_ATP + (size_t)2048 * 64 * 64 * 2;
constexpr size_t OFF_BAR = OFF_EH + (size_t)T_TOK * 1024 * 2;
constexpr size_t WS_END = OFF_BAR + 16384;
constexpr size_t OFF_CTR = OFF_BAR + 15360;
constexpr size_t OUT_OFF_A0 = 0;
constexpr size_t OUT_OFF_SF = 0;
constexpr size_t OUT_OFF_YPRE = (size_t)T_TOK * 1024 * 2;
constexpr size_t OUT_OFF_ZT = OUT_OFF_YPRE + (size_t)T_TOK * 512 * 2;

struct Params {
  const float* in[23];
  float* out;
  unsigned char* ws;
  int ph_lo, ph_hi;
};

enum { I_X = 0, I_P, I_NMG, I_WIN, I_ARE, I_AIM, I_BRE, I_BIM, I_CRE, I_CIM, I_D, I_LOGDT, I_WGLU, I_BGLU,
       I_CONVW, I_ALOG, I_DTB, I_DNG, I_WOUT, I_WPP, I_PLEG, I_WGATE, I_FING };

__device__ __forceinline__ float wave_sum(float v) {
#pragma unroll
  for (int o = 32; o > 0; o >>= 1) v += __shfl_xor(v, o);
  return v;
}
__device__ __forceinline__ float sum16(float v) {
  v += __shfl_xor(v, 1); v += __shfl_xor(v, 2); v += __shfl_xor(v, 4); v += __shfl_xor(v, 8);
  return v;
}
__device__ __forceinline__ float sigmoidf_(float x) { return __builtin_amdgcn_rcpf(1.f + __expf(-x)); }
__device__ __forceinline__ float siluf_(float x) { return x * __builtin_amdgcn_rcpf(1.f + __expf(-x)); }
__device__ __forceinline__ float gelu_tanh(float y) {
  float z = 0.7978845608028654f * (y + 0.044715f * y * y * y);
  return y * __builtin_amdgcn_rcpf(1.f + __expf(-2.f * z));
}
__device__ __forceinline__ h16x8 pack8(f32x4 lo, f32x4 hi) {
  h16x8 r;
  r[0] = (h16)lo[0]; r[1] = (h16)lo[1]; r[2] = (h16)lo[2]; r[3] = (h16)lo[3];
  r[4] = (h16)hi[0]; r[5] = (h16)hi[1]; r[6] = (h16)hi[2]; r[7] = (h16)hi[3];
  return r;
}
__device__ __forceinline__ int perm_pos(int n) { return (n & ~31) + (((n & 15) >> 2) << 3) + (((n >> 4) & 1) << 2) + (n & 3); }
__device__ __forceinline__ int perm_inv(int pos) {
  int q5 = pos & 31, qq = q5 >> 3, jj = q5 & 7;
  return (pos & ~31) + (jj < 4 ? 4 * qq + jj : 16 + 4 * qq + (jj - 4));
}

__device__ void transpose_w(const float* __restrict__ W, int K, int N, int Npad, h16* __restrict__ WT, int t, float* tile) {
  const int ntn = Npad / 64;
  const int kt = t / ntn, nt = t % ntn, k0 = kt * 64, n0 = nt * 64;
  const int tx = threadIdx.x & 63, ty = threadIdx.x >> 6;
  for (int r = 0; r < 16; ++r) {
    int k = ty * 16 + r, n = n0 + tx;
    tile[k * 65 + tx] = (n < N) ? W[(size_t)(k0 + k) * N + n] : 0.f;
  }
  __syncthreads();
  for (int r = 0; r < 16; ++r) {
    int n = ty * 16 + r;
    WT[(size_t)(n0 + n) * K + k0 + tx] = (h16)tile[tx * 65 + n];
  }
  __syncthreads();
}

__device__ void ssm_table_item(const Params& p, int g, int d, float* lds) {
  float2* sAp = (float2*)lds;
  float2* sW = sAp + 64;
  const int tid = threadIdx.x;
  h16* KTAB = (h16*)(p.ws + OFF_KTAB);
  h16* ETAB = (h16*)(p.ws + OFF_ETAB);
  h16* FTAB = (h16*)(p.ws + OFF_FTAB);
  float* ALPOW = (float*)(p.ws + OFF_ALPOW);
  float* sBr = lds + 256; float* sBi = sBr + 1024; float* sCr = sBi + 1024; float* sCi = sCr + 16 * 65;
  {
    const float4 vbr = ((const float4*)(p.in[I_BRE] + g * 1024))[tid], vbi = ((const float4*)(p.in[I_BIM] + g * 1024))[tid];
    const float4 vcr = ((const float4*)(p.in[I_CRE] + g * 1024))[tid], vci = ((const float4*)(p.in[I_CIM] + g * 1024))[tid];
    *(float4*)(sBr + tid * 4) = vbr; *(float4*)(sBi + tid * 4) = vbi;
    const int ch = (tid * 4) >> 6, cp = (tid * 4) & 63;
    sCr[ch * 65 + cp] = vcr.x; sCr[ch * 65 + cp + 1] = vcr.y; sCr[ch * 65 + cp + 2] = vcr.z; sCr[ch * 65 + cp + 3] = vcr.w;
    sCi[ch * 65 + cp] = vci.x; sCi[ch * 65 + cp + 1] = vci.y; sCi[ch * 65 + cp + 2] = vci.z; sCi[ch * 65 + cp + 3] = vci.w;
  }
  if (tid < 64) {
    const int pp = tid;
    float lr = p.in[I_ARE][g * 64 + pp], li = p.in[I_AIM][g * 64 + pp], dt = expf(p.in[I_LOGDT][g]);
    float mag = expf(lr * dt), ang = li * dt;
    float abr = mag * cosf(ang), abi = mag * sinf(ang);
    float nr = abr - 1.f, ni = abi, den = lr * lr + li * li;
    float cr = (nr * lr + ni * li) / den, ci = (ni * lr - nr * li) / den;
    float apr = 1.f, api = 0.f;
    for (int k = 0; k < d; ++k) { float t0 = apr * abr - api * abi; api = apr * abi + api * abr; apr = t0; }
    sAp[pp] = make_float2(apr, api);
    sW[pp] = make_float2(apr * cr - api * ci, apr * ci + api * cr);
    if (d == 32) { ALPOW[(g * 64 + pp) * 2] = apr; ALPOW[(g * 64 + pp) * 2 + 1] = api; }
  }
  __syncthreads();
  if (d < 32) {
    {
      const int h = tid >> 4, hp = tid & 15;
      float acc = 0.f;
#pragma unroll 8
      for (int pp = 0; pp < 64; ++pp) {
        float2 W = sW[pp];
        float br = sBr[pp * 16 + hp], bi = sBi[pp * 16 + hp];
        float wbr = W.x * br - W.y * bi, wbi = W.x * bi + W.y * br;
        float cr = sCr[h * 65 + pp], ci = sCi[h * 65 + pp];
        acc += cr * wbr - ci * wbi;
      }
      KTAB[(size_t)(g * 33 + d + 1) * 256 + h * 16 + hp] = (h16)acc;
      if (d == 0) KTAB[(size_t)(g * 33) * 256 + tid] = (h16)0.f;
    }
    {
      const int i = 31 - d;
#pragma unroll
      for (int r = 0; r < 4; ++r) {
        int idx = tid + 256 * r, pp = idx >> 4, hp = idx & 15;
        float2 W = sW[pp];
        float br = sBr[pp * 16 + hp], bi = sBi[pp * 16 + hp];
        float wbr = W.x * br - W.y * bi, wbi = W.x * bi + W.y * br;
        ETAB[((size_t)g * 128 + pp) * 512 + i * 16 + hp] = (h16)wbr;
        ETAB[((size_t)g * 128 + 64 + pp) * 512 + i * 16 + hp] = (h16)wbi;
      }
    }
  }
  if (d >= 1) {
    const int j = d - 1;
#pragma unroll
    for (int r = 0; r < 4; ++r) {
      int idx = tid + 256 * r, h = idx >> 6, pp = idx & 63;
      float2 Ap = sAp[pp];
      float cr = sCr[h * 65 + pp], ci = sCi[h * 65 + pp];
      float re = cr * Ap.x - ci * Ap.y, im = cr * Ap.y + ci * Ap.x;
      FTAB[((size_t)g * 512 + j * 16 + h) * 128 + pp] = (h16)re;
      FTAB[((size_t)g * 512 + j * 16 + h) * 128 + 64 + pp] = (h16)(-im);
    }
  }
  __syncthreads();
}

__device__ void phase0(const Params& p, unsigned char* smem) {
  const int bid = blockIdx.x, nb = gridDim.x, tid = threadIdx.x, wid = tid >> 6, lane = tid & 63;
  float* tile = (float*)smem;
  for (int t = bid; t < 1440; t += nb) {
    if (t < 800) transpose_w(p.in[I_WIN], 1024, 3080, 3200, (h16*)(p.ws + OFF_WIN), t, tile);
    else if (t < 864) transpose_w(p.in[I_WGLU], 512, 512, 512, (h16*)(p.ws + OFF_WGLU), t - 800, tile);
    else if (t < 1120) transpose_w(p.in[I_WOUT], 1024, 1024, 1024, (h16*)(p.ws + OFF_WOUT), t - 864, tile);
    else if (t < 1184) transpose_w(p.in[I_WPP], 256, 1024, 1024, (h16*)(p.ws + OFF_WPP), t - 1120, tile);
    else transpose_w(p.in[I_WGATE], 1024, 1024, 1024, (h16*)(p.ws + OFF_WGATE), t - 1184, tile);
  }
  for (int it = bid; it < 32 * 33; it += nb) ssm_table_item(p, it / 33, it % 33, (float*)smem);
  {
    h16* A0 = (h16*)((unsigned char*)p.out + OUT_OFF_A0);
    const float* x = p.in[I_X];
    const float4* g4 = (const float4*)p.in[I_NMG];
    for (int row = bid * 4 + wid; row < T_TOK; row += nb * 4) {
      const float4* xr = (const float4*)(x + (size_t)row * 1024);
      float4 v[4];
      float ss = 0.f;
#pragma unroll
      for (int i = 0; i < 4; ++i) {
        v[i] = xr[lane + i * 64];
        ss += v[i].x * v[i].x + v[i].y * v[i].y + v[i].z * v[i].z + v[i].w * v[i].w;
      }
      ss = wave_sum(ss);
      float rstd = rsqrtf(ss * (1.f / 1024.f) + 1e-6f);
#pragma unroll
      for (int i = 0; i < 4; ++i) {
        float4 g = g4[lane + i * 64];
        h16x4 o;
        o[0] = (h16)(v[i].x * rstd * g.x); o[1] = (h16)(v[i].y * rstd * g.y);
        o[2] = (h16)(v[i].z * rstd * g.z); o[3] = (h16)(v[i].w * rstd * g.w);
        *(h16x4*)(A0 + (size_t)row * 1024 + (lane + i * 64) * 4) = o;
      }
    }
  }
  {
    h16* PB = (h16*)(p.ws + OFF_PB);
    const float4* p4 = (const float4*)p.in[I_P];
    const size_t n4 = (size_t)T_TOK * 256 / 4;
    for (size_t i = (size_t)bid * 256 + tid; i < n4; i += (size_t)nb * 256) {
      float4 v = p4[i];
      h16x4 o;
      o[0] = (h16)v.x; o[1] = (h16)v.y; o[2] = (h16)v.z; o[3] = (h16)v.w;
      *(h16x4*)(PB + i * 4) = o;
    }
  }
}

enum { EPI_PROJ = 0, EPI_GLU, EPI_PLE, EPI_OUT, EPI_GATE };

template <int EPI>
__device__ __forceinline__ void gemm_tile(const Params& p, const h16* __restrict__ A, int lda, const h16* __restrict__ Bt, int ldb,
                                          int K, int brow, int bcol, unsigned char* smem) {
  const int tid = threadIdx.x, wid = tid >> 6, lane = tid & 63, wr = wid >> 1, wc = wid & 1, fr = lane & 15, fq = lane >> 4;
  f32x4 acc[4][4];
#pragma unroll
  for (int m = 0; m < 4; ++m)
#pragma unroll
    for (int n = 0; n < 4; ++n) acc[m][n] = f32x4{0.f, 0.f, 0.f, 0.f};
  const int nk = K / 64;
  const h16* ga[4]; const h16* gb[4];
#pragma unroll
  for (int i = 0; i < 4; ++i) {
    const int L = tid + 256 * i, row = L >> 3, cs = (L & 7) ^ (row & 7);
    ga[i] = A + (size_t)(brow + row) * lda + cs * 8;
    gb[i] = Bt + (size_t)(bcol + row) * ldb + cs * 8;
  }
#define GEMM_STAGE(t_, buf_) do { \
    unsigned char* sa_ = smem + (buf_) * 32768 + tid * 16; \
    _Pragma("unroll") for (int i_ = 0; i_ < 4; ++i_) { \
      __builtin_amdgcn_global_load_lds((const unsigned*)(ga[i_] + (t_) * 64), (unsigned*)(sa_ + i_ * 4096), 16, 0, 0); \
      __builtin_amdgcn_global_load_lds((const unsigned*)(gb[i_] + (t_) * 64), (unsigned*)(sa_ + 16384 + i_ * 4096), 16, 0, 0); \
    } \
  } while (0)
  GEMM_STAGE(0, 0);
  for (int t = 0; t < nk; ++t) {
    asm volatile("s_waitcnt vmcnt(0)" ::: "memory");
    __syncthreads();
    if (t + 1 < nk) GEMM_STAGE(t + 1, (t + 1) & 1);
    const unsigned char* SA = smem + (t & 1) * 32768;
    const unsigned char* SB = SA + 16384;
#pragma unroll
    for (int kk = 0; kk < 2; ++kk) {
      h16x8 af[4], bf[4];
      const int pos = ((kk * 4 + fq) ^ (fr & 7)) << 4;
#pragma unroll
      for (int m = 0; m < 4; ++m) {
        af[m] = *(const h16x8*)(SA + (wr * 64 + m * 16 + fr) * 128 + pos);
        bf[m] = *(const h16x8*)(SB + (wc * 64 + m * 16 + fr) * 128 + pos);
      }
#pragma unroll
      for (int m = 0; m < 4; ++m)
#pragma unroll
        for (int n = 0; n < 4; ++n) acc[m][n] = MFMA(af[m], bf[n], acc[m][n]);
    }
  }
#undef GEMM_STAGE
  __syncthreads();
  float* CT = (float*)smem;
#pragma unroll
  for (int m = 0; m < 4; ++m)
#pragma unroll
    for (int n = 0; n < 4; ++n)
#pragma unroll
      for (int j = 0; j < 4; ++j) CT[(wr * 64 + m * 16 + fq * 4 + j) * 132 + wc * 64 + n * 16 + fr] = acc[m][n][j];
  __syncthreads();
  const int c4 = tid & 31;
#pragma unroll 2
  for (int it = 0; it < 16; ++it) {
    const int rl = it * 8 + (tid >> 5);
    const size_t row = (size_t)brow + rl;
    const int col = bcol + c4 * 4;
    const float4 v = *(const float4*)(CT + rl * 132 + c4 * 4);
    if constexpr (EPI == EPI_PROJ) {
      if (bcol < 3072) {
        h16x4 o; o[0] = (h16)v.x; o[1] = (h16)v.y; o[2] = (h16)v.z; o[3] = (h16)v.w;
        *(h16x4*)((h16*)(p.ws + OFF_PROJ) + row * LDP + col) = o;
      } else if (c4 < 2) {
        *(float4*)((float*)(p.ws + OFF_AB) + row * 8 + c4 * 4) = v;
      }
    } else if constexpr (EPI == EPI_GLU) {
      const h16x4 y = *(const h16x4*)((const h16*)((unsigned char*)p.out + OUT_OFF_YPRE) + row * 512 + col);
      const h16x4 z = *(const h16x4*)((const h16*)(p.ws + OFF_PROJ) + row * LDP + 512 + col);
      const float4 bb = *(const float4*)(p.in[I_BGLU] + col);
      h16x4 o;
      o[0] = (h16)((float)y[0] * sigmoidf_(v.x + bb.x) * siluf_((float)z[0]));
      o[1] = (h16)((float)y[1] * sigmoidf_(v.y + bb.y) * siluf_((float)z[1]));
      o[2] = (h16)((float)y[2] * sigmoidf_(v.z + bb.z) * siluf_((float)z[2]));
      o[3] = (h16)((float)y[3] * sigmoidf_(v.w + bb.w) * siluf_((float)z[3]));
      *(h16x4*)((h16*)(p.ws + OFF_MIXIN) + row * 1024 + col) = o;
    } else if constexpr (EPI == EPI_PLE) {
      h16x4 o; o[0] = (h16)v.x; o[1] = (h16)v.y; o[2] = (h16)v.z; o[3] = (h16)v.w;
      *(h16x4*)((h16*)(p.ws + OFF_EH) + row * 1024 + col) = o;
      float s = v.x * v.x + v.y * v.y + v.z * v.z + v.w * v.w;
      s = sum16(s); s += __shfl_xor(s, 16);
      if (c4 == 0) ((float*)(p.ws + OFF_EPART))[row * 8 + (bcol >> 7)] = s;
    } else if constexpr (EPI == EPI_OUT) {
      const float4 xv = *(const float4*)(p.in[I_X] + row * 1024 + col);
      float4 hv; hv.x = xv.x + v.x; hv.y = xv.y + v.y; hv.z = xv.z + v.z; hv.w = xv.w + v.w;
      h16x4 o; o[0] = (h16)hv.x; o[1] = (h16)hv.y; o[2] = (h16)hv.z; o[3] = (h16)hv.w;
      *(h16x4*)((h16*)(p.ws + OFF_PROJ) + row * 1024 + col) = o;
    } else if constexpr (EPI == EPI_GATE) {
      const float4 e0 = *(const float4*)((const float*)(p.ws + OFF_EPART) + row * 8);
      const float4 e1 = *(const float4*)((const float*)(p.ws + OFF_EPART) + row * 8 + 4);
      const float rs = rsqrtf((e0.x + e0.y + e0.z + e0.w + e1.x + e1.y + e1.z + e1.w) * (1.f / 1024.f) + 1e-6f);
      const h16x4 eh = *(const h16x4*)((const h16*)(p.ws + OFF_EH) + row * 1024 + col);
      const float4 pg = *(const float4*)(p.in[I_PLEG] + col);
      const h16x4 hb = *(const h16x4*)((const h16*)(p.ws + OFF_PROJ) + row * 1024 + col);
      float4 hv;
      hv.x = (float)hb[0] + sigmoidf_(v.x) * ((float)eh[0] * rs * pg.x);
      hv.y = (float)hb[1] + sigmoidf_(v.y) * ((float)eh[1] * rs * pg.y);
      hv.z = (float)hb[2] + sigmoidf_(v.z) * ((float)eh[2] * rs * pg.z);
      hv.w = (float)hb[3] + sigmoidf_(v.w) * ((float)eh[3] * rs * pg.w);
      {
        h16x4 o; o[0] = (h16)hv.x; o[1] = (h16)hv.y; o[2] = (h16)hv.z; o[3] = (h16)hv.w;
        *(h16x4*)((h16*)(p.ws + OFF_MIXIN) + row * 1024 + col) = o;
      }
      float s = hv.x * hv.x + hv.y * hv.y + hv.z * hv.z + hv.w * hv.w;
      s = sum16(s); s += __shfl_xor(s, 16);
      if (c4 == 0) ((float*)(p.ws + OFF_OPART))[row * 8 + (bcol >> 7)] = s;
    }
  }
  __syncthreads();
}

__device__ void ssm_item(const Params& p, int b, int g, unsigned char* smem) {
  float* LOCAL = (float*)smem;
  h16* SPREV = (h16*)(smem + 33792);
  h16* KT = (h16*)(smem + 51200);
  int tid_ = threadIdx.x;
  asm volatile("" : "+v"(tid_));
  const int tid = tid_, w = tid >> 6, lane = tid & 63, fr = lane & 15, fq = lane >> 4;
  const h16* PROJ = (const h16*)(p.ws + OFF_PROJ);
  const h16* Eg = (const h16*)(p.ws + OFF_ETAB) + (size_t)g * 128 * 512;
  const h16* Kg = (const h16*)(p.ws + OFF_KTAB) + (size_t)g * 33 * 256;
  const h16* Fg = (const h16*)(p.ws + OFF_FTAB) + (size_t)g * 512 * 128;
  const float* ALPOW = (const float*)(p.ws + OFF_ALPOW);
  h16* YPRE = (h16*)((unsigned char*)p.out + OUT_OFF_YPRE);
  const int nchunk = w * 16 + fr;
  const size_t tok0 = (size_t)b * SEQ + (size_t)nchunk * 32;
  for (int idx = tid; idx < 33 * 256 / 8; idx += 256) *(h16x8*)(KT + idx * 8) = *(const h16x8*)(Kg + idx * 8);
  h16x8 uf[16];
#pragma unroll
  for (int ks = 0; ks < 16; ++ks) {
    const int i = 2 * ks + (fq >> 1);
    uf[ks] = *(const h16x8*)(PROJ + (tok0 + i) * LDP + g * 16 + (fq & 1) * 8);
  }
  {
    h16x8 ea[8];
#pragma unroll
    for (int ks = 0; ks < 8; ++ks) ea[ks] = *(const h16x8*)(Eg + (size_t)fr * 512 + ks * 32 + fq * 8);
    f32x4 acc = {0.f, 0.f, 0.f, 0.f};
#pragma unroll 1
    for (int it = 0; it < 16; ++it) {
      const int mt = it >> 1, hf = it & 1;
      const int itn = it < 15 ? it + 1 : 15;
      h16x8 en[8];
#pragma unroll
      for (int ks = 0; ks < 8; ++ks) en[ks] = *(const h16x8*)(Eg + (size_t)((itn >> 1) * 16 + fr) * 512 + ((itn & 1) * 8 + ks) * 32 + fq * 8);
      if (hf == 0) {
#pragma unroll
        for (int ks = 0; ks < 8; ++ks) acc = MFMA(ea[ks], uf[ks], acc);
      } else {
#pragma unroll
        for (int ks = 0; ks < 8; ++ks) acc = MFMA(ea[ks], uf[8 + ks], acc);
        *(f32x4*)(LOCAL + nchunk * 132 + mt * 16 + fq * 4) = acc;
        acc = f32x4{0.f, 0.f, 0.f, 0.f};
      }
#pragma unroll
      for (int ks = 0; ks < 8; ++ks) ea[ks] = en[ks];
    }
  }
  __syncthreads();
  if (tid < 64) {
    const int pp = tid;
    const float ar = ALPOW[(g * 64 + pp) * 2], ai = ALPOW[(g * 64 + pp) * 2 + 1];
    float sr = 0.f, si = 0.f;
#pragma unroll 4
    for (int c = 0; c < 64; ++c) {
      SPREV[c * 136 + pp] = (h16)sr;
      SPREV[c * 136 + 64 + pp] = (h16)si;
      float lr = LOCAL[c * 132 + pp], li = LOCAL[c * 132 + 64 + pp];
      float nr = ar * sr - ai * si + lr;
      float ni = ar * si + ai * sr + li;
      sr = nr; si = ni;
    }
  }
  __syncthreads();
  h16x8 sf[4];
#pragma unroll
  for (int ks = 0; ks < 4; ++ks) sf[ks] = *(const h16x8*)(SPREV + nchunk * 136 + ks * 32 + fq * 8);
  const float4 Dv = *(const float4*)(p.in[I_D] + g * 16 + fq * 4);
  h16x8 fa[4];
#pragma unroll
  for (int ks = 0; ks < 4; ++ks) fa[ks] = *(const h16x8*)(Fg + (size_t)fr * 128 + ks * 32 + fq * 8);
  h16x4 u4 = *(const h16x4*)(PROJ + tok0 * LDP + g * 16 + fq * 4);
#pragma unroll 1
  for (int j = 0; j < 32; ++j) {
    const int jn = j < 31 ? j + 1 : 31;
    h16x8 fn[4];
#pragma unroll
    for (int ks = 0; ks < 4; ++ks) fn[ks] = *(const h16x8*)(Fg + (size_t)(jn * 16 + fr) * 128 + ks * 32 + fq * 8);
    const h16x4 un = *(const h16x4*)(PROJ + (tok0 + jn) * LDP + g * 16 + fq * 4);
    f32x4 acc = {0.f, 0.f, 0.f, 0.f};
#pragma unroll
    for (int ks = 0; ks < 16; ++ks) {
      if (2 * ks <= j) {
        const int dd = j - 2 * ks - (fq >> 1) + 1;
        h16x8 a = *(const h16x8*)(KT + dd * 256 + fr * 16 + (fq & 1) * 8);
        acc = MFMA(a, uf[ks], acc);
      }
    }
#pragma unroll
    for (int ks = 0; ks < 4; ++ks) acc = MFMA(fa[ks], sf[ks], acc);
    const size_t tok = tok0 + j;
    h16x4 o;
    o[0] = (h16)gelu_tanh(acc[0] + Dv.x * (float)u4[0]);
    o[1] = (h16)gelu_tanh(acc[1] + Dv.y * (float)u4[1]);
    o[2] = (h16)gelu_tanh(acc[2] + Dv.z * (float)u4[2]);
    o[3] = (h16)gelu_tanh(acc[3] + Dv.w * (float)u4[3]);
    *(h16x4*)(YPRE + tok * 512 + g * 16 + fq * 4) = o;
#pragma unroll
    for (int ks = 0; ks < 4; ++ks) fa[ks] = fn[ks];
    u4 = un;
  }
  __syncthreads();
}

__device__ void gdn_pre_item(const Params& p, int item, unsigned char* smem) {
  h16* QH = (h16*)smem;
  h16* KH = (h16*)(smem + 17408);
  h16* VH = (h16*)(smem + 34816);
  float* Ld = (float*)(smem + 52224);
  h16* Limg = (h16*)(smem + 56576);
  h16* Dimg = (h16*)(smem + 60672);
  float* sG = (float*)(smem + 69632);
  float* sBeta = (float*)(smem + 69888);
  float* sEG = (float*)(smem + 70144);
  float* sBG = (float*)(smem + 70400);
  float* sEL = (float*)(smem + 70656);
  int tid_ = threadIdx.x;
  asm volatile("" : "+v"(tid_));
  const int tid = tid_, w = tid >> 6, lane = tid & 63, fr = lane & 15, fq = lane >> 4;
  const int c = item & 31, h = (item >> 5) & 3, b = item >> 7;
  const h16* PROJ = (const h16*)(p.ws + OFF_PROJ);
  const float* AB = (const float*)(p.ws + OFF_AB);
  const float* convw = p.in[I_CONVW];
  h16* WPi = (h16*)(p.ws + OFF_WP) + (size_t)item * 64 * 128;
  h16* QGPi = (h16*)(p.ws + OFF_QGP) + (size_t)item * 64 * 128;
  h16* KDTi = (h16*)(p.ws + OFF_KDT) + (size_t)item * 128 * 64;
  h16* UTi = (h16*)(p.ws + OFF_UT) + (size_t)item * 128 * 64;
  h16* ATPi = (h16*)(p.ws + OFF_ATP) + (size_t)item * 64 * 64;
  h16* ZTi = (h16*)((unsigned char*)p.out + OUT_OFF_ZT) + (size_t)item * 128 * 64;
  float* DL = (float*)(p.ws + OFF_DL);
  {
    const h16x8 z8 = {(h16)0.f, (h16)0.f, (h16)0.f, (h16)0.f, (h16)0.f, (h16)0.f, (h16)0.f, (h16)0.f};
    *(h16x8*)(Limg + tid * 8) = z8; *(h16x8*)(Limg + 2048 + tid * 8) = z8;
  }
  {
    const int ch0 = (tid & 15) * 8, t0 = (tid >> 4) * 4;
#pragma unroll 1
    for (int sec = 0; sec < 3; ++sec) {
      const int colbase = 1024 + sec * 512 + h * 128 + ch0;
      h16x8 xr[7];
#pragma unroll
      for (int i = 0; i < 7; ++i) {
        const int ts = c * 64 + t0 - 3 + i;
        h16x8 z8 = {(h16)0.f, (h16)0.f, (h16)0.f, (h16)0.f, (h16)0.f, (h16)0.f, (h16)0.f, (h16)0.f};
        xr[i] = (ts >= 0) ? *(const h16x8*)(PROJ + ((size_t)b * SEQ + ts) * LDP + colbase) : z8;
      }
      float4 wv[4][2];
#pragma unroll
      for (int jj = 0; jj < 4; ++jj) {
        wv[jj][0] = *(const float4*)(convw + jj * 1536 + sec * 512 + h * 128 + ch0);
        wv[jj][1] = *(const float4*)(convw + jj * 1536 + sec * 512 + h * 128 + ch0 + 4);
      }
      h16* dst = (sec == 0 ? QH : (sec == 1 ? KH : VH));
#pragma unroll
      for (int tt = 0; tt < 4; ++tt) {
        float a[8];
#pragma unroll
        for (int e = 0; e < 8; ++e) a[e] = 0.f;
#pragma unroll
        for (int jj = 0; jj < 4; ++jj) {
          const h16x8 xv = xr[tt + jj];
          a[0] += wv[jj][0].x * (float)xv[0]; a[1] += wv[jj][0].y * (float)xv[1]; a[2] += wv[jj][0].z * (float)xv[2]; a[3] += wv[jj][0].w * (float)xv[3];
          a[4] += wv[jj][1].x * (float)xv[4]; a[5] += wv[jj][1].y * (float)xv[5]; a[6] += wv[jj][1].z * (float)xv[6]; a[7] += wv[jj][1].w * (float)xv[7];
        }
        float ss = 0.f;
#pragma unroll
        for (int e = 0; e < 8; ++e) { a[e] = siluf_(a[e]); ss += a[e] * a[e]; }
        float scale = 1.f;
        if (sec < 2) {
          ss = sum16(ss);
          scale = rsqrtf(ss + 1e-6f) * (sec == 0 ? 0.08838834764831845f : 1.f);
        }
        h16x8 o;
#pragma unroll
        for (int e = 0; e < 8; ++e) o[e] = (h16)(a[e] * scale);
        *(h16x8*)(dst + (t0 + tt) * 136 + ch0) = o;
      }
    }
  }
  if (tid < 64) {
    const size_t tok = (size_t)b * SEQ + c * 64 + tid;
    float braw = AB[tok * 8 + h], araw = AB[tok * 8 + 4 + h];
    float beta = 1.f / (1.f + expf(-braw));
    float xx = araw + p.in[I_DTB][h];
    float sp = xx > 20.f ? xx : log1pf(expf(xx));
    float gg = -expf(p.in[I_ALOG][h]) * sp;
#pragma unroll
    for (int o = 1; o < 64; o <<= 1) {
      float v = __shfl_up(gg, o);
      if (lane >= o) gg += v;
    }
    sG[tid] = gg;
    sBeta[tid] = beta;
    const float eg = expf(gg);
    sEG[tid] = eg;
    sBG[tid] = beta * eg;
    sEL[tid] = expf(__shfl(gg, 63) - gg);
  }
  __syncthreads();
  {
    h16x8 ak[4], aq[4];
#pragma unroll
    for (int ks = 0; ks < 4; ++ks) {
      ak[ks] = *(const h16x8*)(KH + (w * 16 + fr) * 136 + ks * 32 + fq * 8);
      aq[ks] = *(const h16x8*)(QH + (w * 16 + fr) * 136 + ks * 32 + fq * 8);
    }
#pragma unroll
    for (int jt = 0; jt < 4; ++jt) {
      const int j = jt * 16 + fr;
      const int pj = perm_pos(j);
      if (jt <= w) {
        f32x4 kk = {0.f, 0.f, 0.f, 0.f}, qk = {0.f, 0.f, 0.f, 0.f};
#pragma unroll
        for (int ks = 0; ks < 4; ++ks) {
          h16x8 bk = *(const h16x8*)(KH + (jt * 16 + fr) * 136 + ks * 32 + fq * 8);
          kk = MFMA(ak[ks], bk, kk);
          qk = MFMA(aq[ks], bk, qk);
        }
        const float Gj = sG[j];
        f32x4 lt;
#pragma unroll
        for (int r = 0; r < 4; ++r) {
          const int i = w * 16 + 4 * fq + r;
          const float e = (i >= j) ? __expf(sG[i] - Gj) : 0.f;
          lt[r] = (i > j) ? sBeta[i] * kk[r] * e : 0.f;
          ATPi[i * 64 + (((pj >> 3) ^ (i & 7)) << 3) + (pj & 7)] = (h16)(qk[r] * e);
        }
        if (jt == w) {
#pragma unroll
          for (int r = 0; r < 4; ++r) Ld[(w * 16 + 4 * fq + r) * 17 + fr] = lt[r];
        } else {
          const int img = (w == 1) ? 0 : (w == 2 ? 1 : (jt < 2 ? 2 : 3));
#pragma unroll
          for (int r = 0; r < 4; ++r) Limg[img * 512 + (4 * fq + r) * 32 + (fr >> 2) * 8 + (fr & 3) + 4 * (jt & 1)] = (h16)(-lt[r]);
        }
      } else {
#pragma unroll
        for (int r = 0; r < 4; ++r) {
          const int i = w * 16 + 4 * fq + r;
          ATPi[i * 64 + (((pj >> 3) ^ (i & 7)) << 3) + (pj & 7)] = (h16)0.f;
        }
      }
    }
  }
  __syncthreads();
  if (lane < 16) {
    float y[16];
#pragma unroll
    for (int i = 0; i < 16; ++i) {
      float s = (i == lane) ? 1.f : 0.f;
#pragma unroll
      for (int k = 0; k < i; ++k) s -= Ld[(w * 16 + i) * 17 + k] * y[k];
      y[i] = s;
    }
#pragma unroll
    for (int i = 0; i < 16; ++i) Dimg[w * 512 + i * 32 + (lane >> 2) * 8 + (lane & 3)] = (h16)y[i];
  }
  __syncthreads();
  f32x4 xs[4][4];
  {
    const h16* SRC = (w < 2) ? VH : KH;
    const float* scl = (w < 2) ? sBeta : sBG;
    const int cbase = (w & 1) * 64;
    h16x8 dA[4], lA[4];
#pragma unroll
    for (int b4 = 0; b4 < 4; ++b4) {
      dA[b4] = *(const h16x8*)(Dimg + b4 * 512 + fr * 32 + fq * 8);
      lA[b4] = *(const h16x8*)(Limg + b4 * 512 + fr * 32 + fq * 8);
    }
    const f32x4 z4 = {0.f, 0.f, 0.f, 0.f};
#pragma unroll
    for (int nt = 0; nt < 4; ++nt) {
      const int col = cbase + nt * 16 + fr;
      f32x4 rb[4];
#pragma unroll
      for (int b4 = 0; b4 < 4; ++b4)
#pragma unroll
        for (int r = 0; r < 4; ++r) rb[b4][r] = (float)SRC[(b4 * 16 + 4 * fq + r) * 136 + col] * scl[b4 * 16 + 4 * fq + r];
      const f32x4 x0 = MFMA(dA[0], pack8(rb[0], z4), z4);
      const f32x4 a1 = MFMA(lA[0], pack8(x0, z4), rb[1]);
      const f32x4 x1 = MFMA(dA[1], pack8(a1, z4), z4);
      const h16x8 x01 = pack8(x0, x1);
      const f32x4 a2 = MFMA(lA[1], x01, rb[2]);
      const f32x4 x2 = MFMA(dA[2], pack8(a2, z4), z4);
      f32x4 a3 = MFMA(lA[2], x01, rb[3]);
      a3 = MFMA(lA[3], pack8(x2, z4), a3);
      const f32x4 x3 = MFMA(dA[3], pack8(a3, z4), z4);
      xs[nt][0] = x0; xs[nt][1] = x1; xs[nt][2] = x2; xs[nt][3] = x3;
      if (w < 2) {
#pragma unroll
        for (int b4 = 0; b4 < 4; ++b4) {
          h16x4 o; o[0] = (h16)xs[nt][b4][0]; o[1] = (h16)xs[nt][b4][1]; o[2] = (h16)xs[nt][b4][2]; o[3] = (h16)xs[nt][b4][3];
          *(h16x4*)(UTi + (size_t)col * 64 + b4 * 16 + 4 * fq) = o;
        }
      }
    }
  }
  __syncthreads();
  if (w >= 2) {
#pragma unroll
    for (int nt = 0; nt < 4; ++nt) {
      const int pos = perm_pos((w & 1) * 64 + nt * 16 + fr);
#pragma unroll
      for (int b4 = 0; b4 < 4; ++b4)
#pragma unroll
        for (int r = 0; r < 4; ++r) VH[(b4 * 16 + 4 * fq + r) * 136 + pos] = (h16)xs[nt][b4][r];
    }
  }
  __syncthreads();
  for (int rr = 0; rr < 4; ++rr) {
    const int idx = tid + 256 * rr, row = idx >> 4, seg = idx & 15;
    *(h16x8*)(WPi + row * 128 + ((seg ^ (row & 15)) << 3)) = *(const h16x8*)(VH + row * 136 + seg * 8);
  }
  {
    const int dv = tid & 127, th = tid >> 7;
    const float gdv = p.in[I_DNG][dv];
    const h16* zp = PROJ + ((size_t)b * SEQ + c * 64 + th * 32) * LDP + 2560 + h * 128 + dv;
    h16 zv[32];
#pragma unroll
    for (int t = 0; t < 32; ++t) zv[t] = zp[(size_t)t * LDP];
#pragma unroll
    for (int t8 = 0; t8 < 4; ++t8) {
      h16x8 v;
#pragma unroll
      for (int e = 0; e < 8; ++e) v[e] = (h16)(siluf_((float)zv[t8 * 8 + e]) * gdv);
      *(h16x8*)(ZTi + (size_t)dv * 64 + th * 32 + t8 * 8) = v;
    }
  }
#pragma unroll 2
  for (int rr = 0; rr < 4; ++rr) {
    const int idx = tid + 256 * rr, t = idx >> 4, cpos = idx & 15, ks = cpos >> 2, q = cpos & 3;
    const h16x4 lo = *(const h16x4*)(QH + t * 136 + ks * 32 + 4 * q);
    const h16x4 hi = *(const h16x4*)(QH + t * 136 + ks * 32 + 16 + 4 * q);
    const float sc = sEG[t];
    h16x8 o;
#pragma unroll
    for (int e = 0; e < 4; ++e) { o[e] = (h16)((float)lo[e] * sc); o[4 + e] = (h16)((float)hi[e] * sc); }
    *(h16x8*)(QGPi + t * 128 + ((cpos ^ (t & 15)) << 3)) = o;
  }
#pragma unroll 2
  for (int rr = 0; rr < 4; ++rr) {
    const int idx = tid + 256 * rr, dk = idx >> 3, cpos = idx & 7, k2 = cpos >> 2, q = cpos & 3;
    h16x8 o;
#pragma unroll
    for (int e = 0; e < 8; ++e) {
      const int t = k2 * 32 + (e < 4 ? 4 * q + e : 16 + 4 * q + (e - 4));
      o[e] = (h16)((float)KH[t * 136 + dk] * sEL[t]);
    }
    *(h16x8*)(KDTi + dk * 64 + ((cpos ^ (dk & 7)) << 3)) = o;
  }
  const float Glast = sG[63];
  if (tid == 0) DL[item] = expf(Glast);
  __syncthreads();
}

template <int NB>
__device__ __forceinline__ void glds_copy(const h16* __restrict__ g, unsigned char* l) {
#pragma unroll
  for (int i = 0; i < NB / 4096; ++i) {
    const int off = threadIdx.x * 16 + i * 4096;
    __builtin_amdgcn_global_load_lds((const unsigned*)((const unsigned char*)g + off), (unsigned*)(l + off), 16, 0, 0);
  }
}
#define RAW_BARRIER() do { asm volatile("s_waitcnt lgkmcnt(0)" ::: "memory"); __builtin_amdgcn_s_barrier(); asm volatile("" ::: "memory"); } while (0)

__device__ void gdn_chain(const Params& p, int bh, unsigned char* smem) {
  const int tid = threadIdx.x, w = tid >> 6, lane = tid & 63, fr = lane & 15, fq = lane >> 4;
  const float* DL = (const float*)(p.ws + OFF_DL);
  const h16* WPb = (const h16*)(p.ws + OFF_WP) + (size_t)bh * 32 * 64 * 128;
  const h16* KDTb = (const h16*)(p.ws + OFF_KDT) + (size_t)bh * 32 * 128 * 64;
  h16* UTb = (h16*)(p.ws + OFF_UT) + (size_t)bh * 32 * 128 * 64;
  h16* SFb = (h16*)((unsigned char*)p.out + OUT_OFF_SF) + (size_t)bh * 32 * 128 * 128;
  f32x4 S[8][2];
#pragma unroll
  for (int i = 0; i < 8; ++i) { S[i][0] = f32x4{0.f, 0.f, 0.f, 0.f}; S[i][1] = f32x4{0.f, 0.f, 0.f, 0.f}; }
  h16x4 uR[4][2];
  const int uoff = (w * 32 + fr) * 64 + fq * 4;
  glds_copy<16384>(WPb, smem); glds_copy<16384>(KDTb, smem + 16384);
#pragma unroll
  for (int mt = 0; mt < 4; ++mt)
#pragma unroll
    for (int nt = 0; nt < 2; ++nt) uR[mt][nt] = *(const h16x4*)(UTb + uoff + nt * 1024 + mt * 16);
  float dl = DL[bh * 32];
  asm volatile("s_waitcnt vmcnt(0)" ::: "memory");
  RAW_BARRIER();
  for (int c = 0; c < 32; ++c) {
    const int cn = (c + 1 < 32) ? c + 1 : 31;
    const unsigned char* LW = smem + (c & 1) * 32768;
    const unsigned char* LK = LW + 16384;
    unsigned char* LWn = smem + ((c + 1) & 1) * 32768;
    f32x4 uf[4][2];
#pragma unroll
    for (int mt = 0; mt < 4; ++mt)
#pragma unroll
      for (int nt = 0; nt < 2; ++nt)
#pragma unroll
        for (int r = 0; r < 4; ++r) uf[mt][nt][r] = (float)uR[mt][nt][r];
    const float dlc = dl;
    asm volatile("" ::: "memory");
    h16x8 sfr[4][2];
#pragma unroll
    for (int ks = 0; ks < 4; ++ks) { sfr[ks][0] = pack8(S[2 * ks][0], S[2 * ks + 1][0]); sfr[ks][1] = pack8(S[2 * ks][1], S[2 * ks + 1][1]); }
#pragma unroll
    for (int ks = 0; ks < 4; ++ks)
#pragma unroll
      for (int nt = 0; nt < 2; ++nt)
        *(h16x8*)(SFb + ((size_t)(c * 4 + ks) * 8 + w * 2 + nt) * 512 + lane * 8) = sfr[ks][nt];
    glds_copy<16384>(WPb + (size_t)cn * 64 * 128, LWn);
    glds_copy<16384>(KDTb + (size_t)cn * 128 * 64, LWn + 16384);
#pragma unroll
    for (int mt = 0; mt < 4; ++mt)
#pragma unroll
      for (int nt = 0; nt < 2; ++nt)
        uR[mt][nt] = *(const h16x4*)(UTb + (size_t)cn * 128 * 64 + uoff + nt * 1024 + mt * 16);
    dl = DL[bh * 32 + cn];
    asm volatile("" ::: "memory");
    f32x4 vn[4][2];
#pragma unroll
    for (int mt = 0; mt < 4; ++mt) { vn[mt][0] = f32x4{0.f, 0.f, 0.f, 0.f}; vn[mt][1] = vn[mt][0]; }
#pragma unroll
    for (int ks = 0; ks < 4; ++ks)
#pragma unroll
      for (int mt = 0; mt < 4; ++mt) {
        h16x8 aw = *(const h16x8*)(LW + (mt * 16 + fr) * 256 + (((ks * 4 + fq) ^ fr) << 4));
        vn[mt][0] = MFMA(aw, sfr[ks][0], vn[mt][0]);
        vn[mt][1] = MFMA(aw, sfr[ks][1], vn[mt][1]);
      }
#pragma unroll
    for (int mt = 0; mt < 4; ++mt)
#pragma unroll
      for (int r = 0; r < 4; ++r) { vn[mt][0][r] = uf[mt][0][r] - vn[mt][0][r]; vn[mt][1][r] = uf[mt][1][r] - vn[mt][1][r]; }
    h16x8 vfr[2][2];
#pragma unroll
    for (int k2 = 0; k2 < 2; ++k2) { vfr[k2][0] = pack8(vn[2 * k2][0], vn[2 * k2 + 1][0]); vfr[k2][1] = pack8(vn[2 * k2][1], vn[2 * k2 + 1][1]); }
    if (c + 1 < 32) {
#pragma unroll
      for (int k2 = 0; k2 < 2; ++k2)
#pragma unroll
        for (int nt = 0; nt < 2; ++nt)
          *(h16x8*)(UTb + (size_t)c * 128 * 64 + ((size_t)k2 * 8 + w * 2 + nt) * 512 + lane * 8) = vfr[k2][nt];
    }
#pragma unroll
    for (int dkt = 0; dkt < 8; ++dkt) {
      f32x4 s0 = S[dkt][0], s1 = S[dkt][1];
#pragma unroll
      for (int r = 0; r < 4; ++r) { s0[r] *= dlc; s1[r] *= dlc; }
#pragma unroll
      for (int k2 = 0; k2 < 2; ++k2) {
        h16x8 ak = *(const h16x8*)(LK + (dkt * 16 + fr) * 128 + (((k2 * 4 + fq) ^ (fr & 7)) << 4));
        s0 = MFMA(ak, vfr[k2][0], s0);
        s1 = MFMA(ak, vfr[k2][1], s1);
      }
      S[dkt][0] = s0; S[dkt][1] = s1;
    }
    asm volatile("s_waitcnt vmcnt(0)" ::: "memory");
    RAW_BARRIER();
    if (c + 1 == 32) {
#pragma unroll
      for (int k2 = 0; k2 < 2; ++k2)
#pragma unroll
        for (int nt = 0; nt < 2; ++nt)
          *(h16x8*)(UTb + (size_t)c * 128 * 64 + ((size_t)k2 * 8 + w * 2 + nt) * 512 + lane * 8) = vfr[k2][nt];
    }
  }
  asm volatile("s_waitcnt vmcnt(0)" ::: "memory");
  __syncthreads();
}

__device__ void gdn_out_item(const Params& p, int item, unsigned char* smem) {
  unsigned char* LQ = smem;
  unsigned char* LA = smem + 16384;
  float* red = (float*)(smem + 24576);
  const int tid = threadIdx.x, w = tid >> 6, lane = tid & 63, fr = lane & 15, fq = lane >> 4;
  const int c = item & 31, h = (item >> 5) & 3, b = item >> 7;
  h16* MIXIN = (h16*)(p.ws + OFF_MIXIN);
  const h16* QGPi = (const h16*)(p.ws + OFF_QGP) + (size_t)item * 64 * 128;
  const h16* ATPi = (const h16*)(p.ws + OFF_ATP) + (size_t)item * 64 * 64;
  const h16* VFi = (const h16*)(p.ws + OFF_UT) + (size_t)item * 128 * 64;
  const h16* SFi = (const h16*)((unsigned char*)p.out + OUT_OFF_SF) + (size_t)item * 128 * 128;
  const h16* ZTi = (const h16*)((unsigned char*)p.out + OUT_OFF_ZT) + (size_t)item * 128 * 64;
  glds_copy<16384>(QGPi, LQ); glds_copy<8192>(ATPi, LA);
  h16x8 sfr[4][2], vfr[2][2];
#pragma unroll
  for (int ks = 0; ks < 4; ++ks)
#pragma unroll
    for (int nt = 0; nt < 2; ++nt) sfr[ks][nt] = *(const h16x8*)(SFi + ((size_t)ks * 8 + w * 2 + nt) * 512 + lane * 8);
#pragma unroll
  for (int k2 = 0; k2 < 2; ++k2)
#pragma unroll
    for (int nt = 0; nt < 2; ++nt) vfr[k2][nt] = *(const h16x8*)(VFi + ((size_t)k2 * 8 + w * 2 + nt) * 512 + lane * 8);
  h16x4 zR[4][2];
#pragma unroll
  for (int mt = 0; mt < 4; ++mt)
#pragma unroll
    for (int nt = 0; nt < 2; ++nt) zR[mt][nt] = *(const h16x4*)(ZTi + (size_t)(w * 32 + nt * 16 + fr) * 64 + mt * 16 + fq * 4);
  asm volatile("s_waitcnt vmcnt(0)" ::: "memory");
  __syncthreads();
  f32x4 o[4][2];
#pragma unroll
  for (int mt = 0; mt < 4; ++mt) {
    f32x4 o0 = {0.f, 0.f, 0.f, 0.f}, o1 = {0.f, 0.f, 0.f, 0.f};
#pragma unroll
    for (int ks = 0; ks < 4; ++ks) {
      h16x8 aq = *(const h16x8*)(LQ + (mt * 16 + fr) * 256 + (((ks * 4 + fq) ^ fr) << 4));
      o0 = MFMA(aq, sfr[ks][0], o0);
      o1 = MFMA(aq, sfr[ks][1], o1);
    }
#pragma unroll
    for (int k2 = 0; k2 < 2; ++k2) {
      h16x8 aa = *(const h16x8*)(LA + (mt * 16 + fr) * 128 + (((k2 * 4 + fq) ^ (fr & 7)) << 4));
      o0 = MFMA(aa, vfr[k2][0], o0);
      o1 = MFMA(aa, vfr[k2][1], o1);
    }
    o[mt][0] = o0; o[mt][1] = o1;
  }
#pragma unroll
  for (int mt = 0; mt < 4; ++mt)
#pragma unroll
    for (int r = 0; r < 4; ++r) {
      float s = o[mt][0][r] * o[mt][0][r] + o[mt][1][r] * o[mt][1][r];
      s = sum16(s);
      if (fr == 0) red[w * 64 + mt * 16 + 4 * fq + r] = s;
    }
  __syncthreads();
#pragma unroll
  for (int mt = 0; mt < 4; ++mt)
#pragma unroll
    for (int r = 0; r < 4; ++r) {
      const int tl = mt * 16 + 4 * fq + r;
      const float tot = red[tl] + red[64 + tl] + red[128 + tl] + red[192 + tl];
      const float rstd = rsqrtf(tot * (1.f / 128.f) + 1e-6f);
      const size_t tok = (size_t)b * SEQ + c * 64 + tl;
      h16* yp = MIXIN + tok * 1024 + 512 + h * 128 + w * 32 + fr;
      yp[0] = (h16)(o[mt][0][r] * rstd * (float)zR[mt][0][r]);
      yp[16] = (h16)(o[mt][1][r] * rstd * (float)zR[mt][1][r]);
    }
  __syncthreads();
}

#define XB_TMO      128
#define XB_XCNT(j)  (256  + 64 * (j))
#define XB_XSUB(j)  (1280 + 64 * (j))
#define XB_XGEN(j)  (2304 + 64 * (j))
#define XB_TOP      3328
#define XB_TOPGEN   3392
#define XCD_BAR_WORDS 3456
#define XB_SPIN_CAP (1u << 18)
#define LAS __attribute__((address_space(3)))

__device__ __forceinline__ unsigned xb_ld(unsigned* p)              { return __hip_atomic_load(p, __ATOMIC_RELAXED, __HIP_MEMORY_SCOPE_AGENT); }
__device__ __forceinline__ unsigned xb_add(unsigned* p, unsigned v) { return __hip_atomic_fetch_add(p, v, __ATOMIC_RELAXED, __HIP_MEMORY_SCOPE_AGENT); }
__device__ __forceinline__ unsigned xb_xcc_id() { return (unsigned)__builtin_amdgcn_s_getreg((3 << 11) | 20) & 0xFu; }
#define XB_SPIN(cond, bar) do { unsigned _sp = 0; while (cond) { __builtin_amdgcn_s_sleep(1); \
    if ((++_sp & 255u) == 0u) { if (xb_ld(&(bar)[XB_TMO])) break; if (_sp > XB_SPIN_CAP) { atomicAdd(&(bar)[XB_TMO], 1u); break; } } } } while (0)

struct XcdBarrier {
    unsigned* bar; unsigned x;
    volatile LAS unsigned* st;
};

__device__ __forceinline__ XcdBarrier xcd_barrier_post(unsigned* bar, volatile LAS unsigned* st) {
    XcdBarrier b; b.bar = bar; b.x = xb_xcc_id(); b.st = st;
    if (threadIdx.x == 0) (void)xb_add(&bar[XB_XCNT(b.x)], 1u);
    return b;
}
__device__ __forceinline__ void xcd_barrier_complete(unsigned* bar, unsigned x, unsigned& nloc, unsigned& nx) {
    const unsigned G = gridDim.x * gridDim.y * gridDim.z;
    unsigned sum, cnt, mine, sp = 0u;
    for (;;) {
        sum = 0u; cnt = 0u; mine = 0u;
#pragma unroll
        for (unsigned j = 0; j < 16; ++j) { const unsigned c = xb_ld(&bar[XB_XCNT(j)]); sum += c; cnt += (c > 0u) ? 1u : 0u; mine = (j == x) ? c : mine; }
        if (sum == G) break;
        __builtin_amdgcn_s_sleep(1);
        if ((++sp & 255u) == 0u) { if (xb_ld(&bar[XB_TMO])) break; if (sp > XB_SPIN_CAP) { atomicAdd(&bar[XB_TMO], 1u); break; } }
    }
    nloc = mine > 0u ? mine : 1u; nx = cnt > 0u ? cnt : 1u;
}

__device__ __forceinline__ void xcd_barrier(const XcdBarrier& b) {
    asm volatile("s_waitcnt vmcnt(0)" ::: "memory");
    __syncthreads();
    if (threadIdx.x == 0) {
        unsigned* bar = b.bar;
        __builtin_amdgcn_s_waitcnt(0);
        unsigned nloc = b.st[0], nx = b.st[1];
        if (nloc == 0u) { xcd_barrier_complete(bar, b.x, nloc, nx); b.st[0] = nloc; b.st[1] = nx; }
        const unsigned old = xb_add(&bar[XB_XSUB(b.x)], 1u);
        const unsigned gen = old / nloc;
        if (old + 1u == (gen + 1u) * nloc) {
            __builtin_amdgcn_fence(__ATOMIC_RELEASE, "agent");
            asm volatile("s_waitcnt vmcnt(0)" ::: "memory");
            const unsigned og = xb_add(&bar[XB_TOP], 1u);
            const unsigned tg = og / nx;
            if (og + 1u == (tg + 1u) * nx) xb_add(&bar[XB_TOPGEN], 1u);
            else XB_SPIN(xb_ld(&bar[XB_TOPGEN]) == tg, bar);
            __builtin_amdgcn_fence(__ATOMIC_ACQUIRE, "agent");
            xb_add(&bar[XB_XGEN(b.x)], 1u);
            asm volatile("s_waitcnt vmcnt(0)" ::: "memory");
        } else {
            XB_SPIN(xb_ld(&bar[XB_XGEN(b.x)]) == gen, bar);
            __builtin_amdgcn_fence(__ATOMIC_ACQUIRE, "agent");
            asm volatile("s_waitcnt vmcnt(0)" ::: "memory");
        }
    }
    __syncthreads();
}

#ifndef ONLY_PH
#define ONLY_PH -1
#endif
#define RUNPH(n) ((ONLY_PH < 0 || ONLY_PH == (n)) && p.ph_lo <= (n) && (n) <= p.ph_hi)
#define SYNCPH(n) do { if (p.ph_lo <= (n) && (n) < p.ph_hi) xcd_barrier(xb); } while (0)
__global__ void __launch_bounds__(256, 2) hymba_mega(Params p) {
  __shared__ __attribute__((aligned(16))) unsigned char smem[SMEM_BYTES];
  cg::grid_group grid = cg::this_grid();
  const int bid = blockIdx.x, nb = gridDim.x;
  if (p.ph_lo < 0) grid.sync();
  XcdBarrier xb;
  {
    volatile LAS unsigned* st = (volatile LAS unsigned*)(smem + SMEM_BYTES - 16);
    if (threadIdx.x == 0) { st[0] = 0u; st[1] = 0u; st[2] = 0u; st[3] = 0u; }
    __syncthreads();
    if (p.ph_lo < p.ph_hi) xb = xcd_barrier_post((unsigned*)(p.ws + OFF_BAR), st);
    else { xb.bar = (unsigned*)(p.ws + OFF_BAR); xb.x = 0; xb.st = st; }
  }
  {
    if (RUNPH(0)) for (int rep = 0; rep < REP0; ++rep) {
      if (rep) grid.sync();
      phase0(p, smem);
    }
    SYNCPH(0);
    if (RUNPH(1)) for (int rep = 0; rep < REP1; ++rep) {
      if (rep) grid.sync();
      const h16* A0 = (const h16*)((unsigned char*)p.out + OUT_OFF_A0);
      const h16* W = (const h16*)(p.ws + OFF_WIN);
      const int xl = bid & 7, nxb = nb >> 3;
      if (nb & 7) { for (int t = bid; t < 256 * 25; t += nb) gemm_tile<EPI_PROJ>(p, A0, 1024, W, 1024, 1024, (t / 25) * 128, (t % 25) * 128, smem); }
      else for (int u = bid >> 3; u < 800; u += nxb) {
        const int mb = u / 200, v = u % 200;
        gemm_tile<EPI_PROJ>(p, A0, 1024, W, 1024, 1024, (xl * 32 + mb * 8 + (v & 7)) * 128, (v >> 3) * 128, smem);
      }
    }
    SYNCPH(1);
    if (RUNPH(2)) for (int rep = 0; rep < REP2; ++rep) {
      if (rep) grid.sync();
      for (int it = bid; it < 512 + 2048; it += nb) {
        if (it < 2048) gdn_pre_item(p, it, smem);
        else ssm_item(p, (it - 2048) >> 5, (it - 2048) & 31, smem);
      }
    }
    SYNCPH(2);
    if (RUNPH(3)) {
      if (bid < 64) gdn_chain(p, bid, smem);
      const int xl = bid & 7;
      unsigned* ctr = (unsigned*)(p.ws + OFF_CTR) + xl * 16;
      volatile int* bc = (volatile int*)(smem + SMEM_BYTES - 4);
      const h16* YPRE = (const h16*)((unsigned char*)p.out + OUT_OFF_YPRE);
      for (;;) {
        __syncthreads();
        if (threadIdx.x == 0) *bc = (int)atomicAdd(ctr, 1u);
        __syncthreads();
        const int u = *bc;
        if (u >= 128 + 256) break;
        if (u < 128) gemm_tile<EPI_GLU>(p, YPRE, 512, (const h16*)(p.ws + OFF_WGLU), 512, 512, (xl * 32 + (u >> 2)) * 128, (u & 3) * 128, smem);
        else gemm_tile<EPI_PLE>(p, (const h16*)(p.ws + OFF_PB), 256, (const h16*)(p.ws + OFF_WPP), 256, 256, (xl * 32 + ((u - 128) >> 3)) * 128, ((u - 128) & 7) * 128, smem);
      }
    }
    SYNCPH(3);
    if (RUNPH(4)) {
      for (int it = bid; it < 2048; it += nb) gdn_out_item(p, it, smem);
    }
    SYNCPH(4);
    if (RUNPH(5)) {
      const int xl = bid & 7, nxb = nb >> 3;
      if (nb & 7) { for (int t = bid; t < 2048; t += nb) gemm_tile<EPI_OUT>(p, (const h16*)(p.ws + OFF_MIXIN), 1024, (const h16*)(p.ws + OFF_WOUT), 1024, 1024, (t >> 3) * 128, (t & 7) * 128, smem); }
      else for (int u = bid >> 3; u < 256; u += nxb)
        gemm_tile<EPI_OUT>(p, (const h16*)(p.ws + OFF_MIXIN), 1024, (const h16*)(p.ws + OFF_WOUT), 1024, 1024, (xl * 32 + (u >> 6) * 8 + (u & 7)) * 128, ((u >> 3) & 7) * 128, smem);
    }
    SYNCPH(5);
    if (RUNPH(6)) {
      const int xl = bid & 7, nxb = nb >> 3;
      if (nb & 7) { for (int t = bid; t < 2048; t += nb) gemm_tile<EPI_GATE>(p, (const h16*)(p.ws + OFF_PROJ), 1024, (const h16*)(p.ws + OFF_WGATE), 1024, 1024, (t >> 3) * 128, (t & 7) * 128, smem); }
      else for (int u = bid >> 3; u < 256; u += nxb)
        gemm_tile<EPI_GATE>(p, (const h16*)(p.ws + OFF_PROJ), 1024, (const h16*)(p.ws + OFF_WGATE), 1024, 1024, (xl * 32 + (u >> 6) * 8 + (u & 7)) * 128, ((u >> 3) & 7) * 128, smem);
    }
    SYNCPH(6);
    if (RUNPH(7)) {
      const int wid = threadIdx.x >> 6, lane = threadIdx.x & 63;
      const float* OPART = (const float*)(p.ws + OFF_OPART);
      const float4* g4 = (const float4*)p.in[I_FING];
      const h16* H2B = (const h16*)(p.ws + OFF_MIXIN);
      for (int row = bid * 4 + wid; row < T_TOK; row += nb * 4) {
        float s = (lane < 8) ? OPART[(size_t)row * 8 + lane] : 0.f;
        const h16x8 a = *(const h16x8*)(H2B + (size_t)row * 1024 + lane * 8);
        const h16x8 b = *(const h16x8*)(H2B + (size_t)row * 1024 + 512 + lane * 8);
        s = wave_sum(s);
        const float rstd = rsqrtf(s * (1.f / 1024.f) + 1e-6f);
        float4* orow = (float4*)(p.out + (size_t)row * 1024);
        const float4 g0 = g4[lane * 2], g1 = g4[lane * 2 + 1], g2 = g4[128 + lane * 2], g3 = g4[128 + lane * 2 + 1];
        float4 o0, o1, o2, o3;
        o0.x = (float)a[0] * rstd * g0.x; o0.y = (float)a[1] * rstd * g0.y; o0.z = (float)a[2] * rstd * g0.z; o0.w = (float)a[3] * rstd * g0.w;
        o1.x = (float)a[4] * rstd * g1.x; o1.y = (float)a[5] * rstd * g1.y; o1.z = (float)a[6] * rstd * g1.z; o1.w = (float)a[7] * rstd * g1.w;
        o2.x = (float)b[0] * rstd * g2.x; o2.y = (float)b[1] * rstd * g2.y; o2.z = (float)b[2] * rstd * g2.z; o2.w = (float)b[3] * rstd * g2.w;
        o3.x = (float)b[4] * rstd * g3.x; o3.y = (float)b[5] * rstd * g3.y; o3.z = (float)b[6] * rstd * g3.z; o3.w = (float)b[7] * rstd * g3.w;
        orow[lane * 2] = o0; orow[lane * 2 + 1] = o1; orow[128 + lane * 2] = o2; orow[128 + lane * 2 + 1] = o3;
      }
    }
  }
}

extern "C" void kernel_launch(void* const* d_in, const int* in_sizes, int n_in, void* d_out, int out_size, void* d_ws, size_t ws_size,
                              hipStream_t stream) {
  static int grid_blocks = 0;
  if (!grid_blocks) {
    int dev = 0, cus = 0, per_cu = 0;
    hipGetDevice(&dev);
    hipDeviceGetAttribute(&cus, hipDeviceAttributeMultiprocessorCount, dev);
    hipOccupancyMaxActiveBlocksPerMultiprocessor(&per_cu, hymba_mega, 256, 0);
    if (per_cu > 2) per_cu = 2;
    if (per_cu < 1) per_cu = 1;
    grid_blocks = cus * per_cu;
  }
  if (n_in != 23 || ws_size < WS_END || out_size != T_TOK * 1024) {
    fprintf(stderr, "kernel_launch: unexpected sizes n_in=%d ws=%zu (need %zu) out=%d\n", n_in, ws_size, (size_t)WS_END, out_size);
    return;
  }
  Params p{};
  for (int i = 0; i < 23; ++i) p.in[i] = (const float*)d_in[i];
  p.out = (float*)d_out;
  p.ws = (unsigned char*)d_ws;
  if (hipMemsetAsync((unsigned char*)d_ws + OFF_BAR, 0, 16384, stream) != hipSuccess) { fprintf(stderr, "kernel_launch: memset of control words failed\n"); return; }
#if MULTI_LAUNCH
  for (int ph = 0; ph < NPH; ++ph) {
    p.ph_lo = ph; p.ph_hi = ph;
    hipLaunchKernelGGL(hymba_mega, dim3(grid_blocks), dim3(256), 0, stream, p);
  }
#else
  p.ph_lo = 0; p.ph_hi = NPH - 1;
  void* args[] = {&p};
  hipError_t e = hipLaunchCooperativeKernel((void*)hymba_mega, dim3(grid_blocks), dim3(256), args, 0, stream);
  if (e != hipSuccess) fprintf(stderr, "cooperative launch failed: %s (grid %d)\n", hipGetErrorString(e), grid_blocks);
#endif
}
```

```cpp
#include <hip/hip_runtime.h>
#include <hip/hip_cooperative_groups.h>
#include <cstdio>
namespace cg = cooperative_groups;

#ifndef REP0
#define REP0 1
#endif
#ifndef REP1
#define REP1 1
#endif
#ifndef REP2
#define REP2 1
#endif
#ifndef REP3
#define REP3 1
#endif
#ifndef REP4
#define REP4 1
#endif
#ifndef MULTI_LAUNCH
#define MULTI_LAUNCH 0
#endif

typedef _Float16 h16;
typedef __attribute__((ext_vector_type(8))) _Float16 h16x8;
typedef __attribute__((ext_vector_type(4))) _Float16 h16x4;
typedef __attribute__((ext_vector_type(4))) float f32x4;
typedef __attribute__((ext_vector_type(2))) float v2f;

#define MFMA(a, b, c) __builtin_amdgcn_mfma_f32_16x16x32_f16((a), (b), (c), 0, 0, 0)

constexpr int T_TOK = 32768;
constexpr int SEQ = 2048;
constexpr int NPH = 8;
constexpr int LDP = 3072;
constexpr int SMEM_BYTES = 72704;

constexpr size_t SZ_WIN = (size_t)3200 * 1024 * 2;
constexpr size_t SZ_WGLU = (size_t)512 * 512 * 2;
constexpr size_t SZ_WOUT = (size_t)1024 * 1024 * 2;
constexpr size_t SZ_WPP = (size_t)1024 * 256 * 2;
constexpr size_t SZ_WGATE = (size_t)1024 * 1024 * 2;
constexpr size_t OFF_WIN = 0;
constexpr size_t OFF_WGLU = OFF_WIN + SZ_WIN;
constexpr size_t OFF_WOUT = OFF_WGLU + SZ_WGLU;
constexpr size_t OFF_WPP = OFF_WOUT + SZ_WOUT;
constexpr size_t OFF_WGATE = OFF_WPP + SZ_WPP;
constexpr size_t OFF_PB = OFF_WGATE + SZ_WGATE;
constexpr size_t OFF_PROJ = OFF_PB + (size_t)T_TOK * 256 * 2;
constexpr size_t OFF_AB = OFF_PROJ + (size_t)T_TOK * LDP * 2;
constexpr size_t OFF_KTAB = OFF_AB + (size_t)T_TOK * 8 * 4;
constexpr size_t OFF_ETAB = OFF_KTAB + (size_t)32 * 33 * 256 * 2;
constexpr size_t OFF_FTAB = OFF_ETAB + (size_t)32 * 128 * 512 * 2;
constexpr size_t OFF_ALPOW = OFF_FTAB + (size_t)32 * 512 * 128 * 2;
constexpr size_t OFF_DL = OFF_ALPOW + (size_t)32 * 64 * 2 * 4;
constexpr size_t OFF_EPART = OFF_DL + (size_t)2048 * 4;
constexpr size_t OFF_OPART = OFF_EPART + (size_t)T_TOK * 16 * 4;
constexpr size_t OFF_MIXIN = OFF_OPART + (size_t)T_TOK * 16 * 4;
constexpr size_t OFF_WP = OFF_MIXIN + (size_t)T_TOK * 1024 * 2;
constexpr size_t OFF_QGP = OFF_WP + (size_t)2048 * 64 * 128 * 2;
constexpr size_t OFF_KDT = OFF_QGP + (size_t)2048 * 64 * 128 * 2;
constexpr size_t OFF_UT = OFF_KDT + (size_t)2048 * 128 * 64 * 2;
constexpr size_t OFF_ATP = OFF_UT + (size_t)2048 * 128 * 64 * 2;
constexpr size_t OFF_EH = OFF_ATP + (size_t)2048 * 64 * 64 * 2;
constexpr size_t OFF_BAR = OFF_EH + (size_t)T_TOK * 1024 * 2;
constexpr size_t WS_END = OFF_BAR + 16384;
constexpr size_t OFF_CTR = OFF_BAR + 15360;
constexpr size_t OUT_OFF_A0 = 0;
constexpr size_t OUT_OFF_SF = 0;
constexpr size_t OUT_OFF_YPRE = (size_t)T_TOK * 1024 * 2;
constexpr size_t OUT_OFF_ZT = OUT_OFF_YPRE + (size_t)T_TOK * 512 * 2;

struct Params {
  const float* in[23];
  float* out;
  unsigned char* ws;
  int ph_lo, ph_hi;
};

enum { I_X = 0, I_P, I_NMG, I_WIN, I_ARE, I_AIM, I_BRE, I_BIM, I_CRE, I_CIM, I_D, I_LOGDT, I_WGLU, I_BGLU,
       I_CONVW, I_ALOG, I_DTB, I_DNG, I_WOUT, I_WPP, I_PLEG, I_WGATE, I_FING };

__device__ __forceinline__ float wave_sum(float v) {
#pragma unroll
  for (int o = 32; o > 0; o >>= 1) v += __shfl_xor(v, o);
  return v;
}
__device__ __forceinline__ float sum16(float v) {
  v += __shfl_xor(v, 1); v += __shfl_xor(v, 2); v += __shfl_xor(v, 4); v += __shfl_xor(v, 8);
  return v;
}
__device__ __forceinline__ float sigmoidf_(float x) { return __builtin_amdgcn_rcpf(1.f + __expf(-x)); }
__device__ __forceinline__ float siluf_(float x) { return x * __builtin_amdgcn_rcpf(1.f + __expf(-x)); }
__device__ __forceinline__ float gelu_tanh(float y) {
  float z = 0.7978845608028654f * (y + 0.044715f * y * y * y);
  return y * __builtin_amdgcn_rcpf(1.f + __expf(-2.f * z));
}
__device__ __forceinline__ h16x8 pack8(f32x4 lo, f32x4 hi) {
  h16x8 r;
  r[0] = (h16)lo[0]; r[1] = (h16)lo[1]; r[2] = (h16)lo[2]; r[3] = (h16)lo[3];
  r[4] = (h16)hi[0]; r[5] = (h16)hi[1]; r[6] = (h16)hi[2]; r[7] = (h16)hi[3];
  return r;
}
__device__ __forceinline__ int perm_pos(int n) { return (n & ~31) + (((n & 15) >> 2) << 3) + (((n >> 4) & 1) << 2) + (n & 3); }
__device__ __forceinline__ int perm_inv(int pos) {
  int q5 = pos & 31, qq = q5 >> 3, jj = q5 & 7;
  return (pos & ~31) + (jj < 4 ? 4 * qq + jj : 16 + 4 * qq + (jj - 4));
}

__device__ void transpose_w(const float* __restrict__ W, int K, int N, int Npad, h16* __restrict__ WT, int t, float* tile) {
  const int ntn = Npad / 64;
  const int kt = t / ntn, nt = t % ntn, k0 = kt * 64, n0 = nt * 64;
  const int tx = threadIdx.x & 63, ty = threadIdx.x >> 6;
  for (int r = 0; r < 16; ++r) {
    int k = ty * 16 + r, n = n0 + tx;
    tile[k * 65 + tx] = (n < N) ? W[(size_t)(k0 + k) * N + n] : 0.f;
  }
  __syncthreads();
  for (int r = 0; r < 16; ++r) {
    int n = ty * 16 + r;
    WT[(size_t)(n0 + n) * K + k0 + tx] = (h16)tile[tx * 65 + n];
  }
  __syncthreads();
}

__device__ void ssm_table_item(const Params& p, int g, int d, float* lds) {
  float2* sAp = (float2*)lds;
  float2* sW = sAp + 64;
  const int tid = threadIdx.x;
  h16* KTAB = (h16*)(p.ws + OFF_KTAB);
  h16* ETAB = (h16*)(p.ws + OFF_ETAB);
  h16* FTAB = (h16*)(p.ws + OFF_FTAB);
  float* ALPOW = (float*)(p.ws + OFF_ALPOW);
  float* sBr = lds + 256; float* sBi = sBr + 1024; float* sCr = sBi + 1024; float* sCi = sCr + 16 * 65;
  {
    const float4 vbr = ((const float4*)(p.in[I_BRE] + g * 1024))[tid], vbi = ((const float4*)(p.in[I_BIM] + g * 1024))[tid];
    const float4 vcr = ((const float4*)(p.in[I_CRE] + g * 1024))[tid], vci = ((const float4*)(p.in[I_CIM] + g * 1024))[tid];
    *(float4*)(sBr + tid * 4) = vbr; *(float4*)(sBi + tid * 4) = vbi;
    const int ch = (tid * 4) >> 6, cp = (tid * 4) & 63;
    sCr[ch * 65 + cp] = vcr.x; sCr[ch * 65 + cp + 1] = vcr.y; sCr[ch * 65 + cp + 2] = vcr.z; sCr[ch * 65 + cp + 3] = vcr.w;
    sCi[ch * 65 + cp] = vci.x; sCi[ch * 65 + cp + 1] = vci.y; sCi[ch * 65 + cp + 2] = vci.z; sCi[ch * 65 + cp + 3] = vci.w;
  }
  if (tid < 64) {
    const int pp = tid;
    float lr = p.in[I_ARE][g * 64 + pp], li = p.in[I_AIM][g * 64 + pp], dt = expf(p.in[I_LOGDT][g]);
    float mag = expf(lr * dt), ang = li * dt;
    float abr = mag * cosf(ang), abi = mag * sinf(ang);
    float nr = abr - 1.f, ni = abi, den = lr * lr + li * li;
    float cr = (nr * lr + ni * li) / den, ci = (ni * lr - nr * li) / den;
    float apr = 1.f, api = 0.f;
    for (int k = 0; k < d; ++k) { float t0 = apr * abr - api * abi; api = apr * abi + api * abr; apr = t0; }
    sAp[pp] = make_float2(apr, api);
    sW[pp] = make_float2(apr * cr - api * ci, apr * ci + api * cr);
    if (d == 32) { ALPOW[(g * 64 + pp) * 2] = apr; ALPOW[(g * 64 + pp) * 2 + 1] = api; }
  }
  __syncthreads();
  if (d < 32) {
    {
      const int h = tid >> 4, hp = tid & 15;
      float acc = 0.f;
#pragma unroll 8
      for (int pp = 0; pp < 64; ++pp) {
        float2 W = sW[pp];
        float br = sBr[pp * 16 + hp], bi = sBi[pp * 16 + hp];
        float wbr = W.x * br - W.y * bi, wbi = W.x * bi + W.y * br;
        float cr = sCr[h * 65 + pp], ci = sCi[h * 65 + pp];
        acc += cr * wbr - ci * wbi;
      }
      if (d == 0 && h == hp) acc += p.in[I_D][g * 16 + h];
      KTAB[(size_t)(g * 33 + d + 1) * 256 + h * 16 + hp] = (h16)acc;
      if (d == 0) KTAB[(size_t)(g * 33) * 256 + tid] = (h16)0.f;
    }
    {
      const int i = 31 - d;
#pragma unroll
      for (int r = 0; r < 4; ++r) {
        int idx = tid + 256 * r, pp = idx >> 4, hp = idx & 15;
        float2 W = sW[pp];
        float br = sBr[pp * 16 + hp], bi = sBi[pp * 16 + hp];
        float wbr = W.x * br - W.y * bi, wbi = W.x * bi + W.y * br;
        ETAB[((size_t)g * 128 + pp) * 512 + i * 16 + hp] = (h16)wbr;
        ETAB[((size_t)g * 128 + 64 + pp) * 512 + i * 16 + hp] = (h16)wbi;
      }
    }
  }
  if (d >= 1) {
    const int j = d - 1;
#pragma unroll
    for (int r = 0; r < 4; ++r) {
      int idx = tid + 256 * r, h = idx >> 6, pp = idx & 63;
      float2 Ap = sAp[pp];
      float cr = sCr[h * 65 + pp], ci = sCi[h * 65 + pp];
      float re = cr * Ap.x - ci * Ap.y, im = cr * Ap.y + ci * Ap.x;
      FTAB[((size_t)g * 512 + j * 16 + h) * 128 + pp] = (h16)re;
      FTAB[((size_t)g * 512 + j * 16 + h) * 128 + 64 + pp] = (h16)(-im);
    }
  }
  __syncthreads();
}

__device__ void phase0(const Params& p, unsigned char* smem) {
  const int bid = blockIdx.x, nb = gridDim.x, tid = threadIdx.x, wid = tid >> 6, lane = tid & 63;
  float* tile = (float*)smem;
  for (int t = bid; t < 1440; t += nb) {
    if (t < 800) transpose_w(p.in[I_WIN], 1024, 3080, 3200, (h16*)(p.ws + OFF_WIN), t, tile);
    else if (t < 864) transpose_w(p.in[I_WGLU], 512, 512, 512, (h16*)(p.ws + OFF_WGLU), t - 800, tile);
    else if (t < 1120) transpose_w(p.in[I_WOUT], 1024, 1024, 1024, (h16*)(p.ws + OFF_WOUT), t - 864, tile);
    else if (t < 1184) transpose_w(p.in[I_WPP], 256, 1024, 1024, (h16*)(p.ws + OFF_WPP), t - 1120, tile);
    else transpose_w(p.in[I_WGATE], 1024, 1024, 1024, (h16*)(p.ws + OFF_WGATE), t - 1184, tile);
  }
  for (int it = bid; it < 32 * 33; it += nb) ssm_table_item(p, it / 33, it % 33, (float*)smem);
  {
    h16* A0 = (h16*)((unsigned char*)p.out + OUT_OFF_A0);
    const float* x = p.in[I_X];
    const float4* g4 = (const float4*)p.in[I_NMG];
    for (int row = bid * 4 + wid; row < T_TOK; row += nb * 4) {
      const float4* xr = (const float4*)(x + (size_t)row * 1024);
      float4 v[4];
      float ss = 0.f;
#pragma unroll
      for (int i = 0; i < 4; ++i) {
        v[i] = xr[lane + i * 64];
        ss += v[i].x * v[i].x + v[i].y * v[i].y + v[i].z * v[i].z + v[i].w * v[i].w;
      }
      ss = wave_sum(ss);
      float rstd = rsqrtf(ss * (1.f / 1024.f) + 1e-6f);
#pragma unroll
      for (int i = 0; i < 4; ++i) {
        float4 g = g4[lane + i * 64];
        h16x4 o;
        o[0] = (h16)(v[i].x * rstd * g.x); o[1] = (h16)(v[i].y * rstd * g.y);
        o[2] = (h16)(v[i].z * rstd * g.z); o[3] = (h16)(v[i].w * rstd * g.w);
        *(h16x4*)(A0 + (size_t)row * 1024 + (lane + i * 64) * 4) = o;
      }
    }
  }
  {
    h16* PB = (h16*)(p.ws + OFF_PB);
    const float4* p4 = (const float4*)p.in[I_P];
    const size_t n4 = (size_t)T_TOK * 256 / 4;
    for (size_t i = (size_t)bid * 256 + tid; i < n4; i += (size_t)nb * 256) {
      float4 v = p4[i];
      h16x4 o;
      o[0] = (h16)v.x; o[1] = (h16)v.y; o[2] = (h16)v.z; o[3] = (h16)v.w;
      *(h16x4*)(PB + i * 4) = o;
    }
  }
}

enum { EPI_PROJ = 0, EPI_GLU, EPI_PLE, EPI_OUT, EPI_GATE };

template <int EPI>
__device__ __forceinline__ void gemm_tile(const Params& p, const h16* __restrict__ A, int lda, const h16* __restrict__ Bt, int ldb,
                                          int K, int brow, int bcol, unsigned char* smem) {
  const int tid = threadIdx.x, wid = tid >> 6, lane = tid & 63, wr = wid >> 1, wc = wid & 1, fr = lane & 15, fq = lane >> 4;
  f32x4 acc[4][4];
#pragma unroll
  for (int m = 0; m < 4; ++m)
#pragma unroll
    for (int n = 0; n < 4; ++n) acc[m][n] = f32x4{0.f, 0.f, 0.f, 0.f};
  const int nk = K / 64;
  const h16* ga[4]; const h16* gb[4];
#pragma unroll
  for (int i = 0; i < 4; ++i) {
    const int L = tid + 256 * i, row = L >> 3, cs = (L & 7) ^ (row & 7);
    ga[i] = A + (size_t)(brow + row) * lda + cs * 8;
    gb[i] = Bt + (size_t)(bcol + row) * ldb + cs * 8;
  }
#define GEMM_STAGE(t_, buf_) do { \
    unsigned char* sa_ = smem + (buf_) * 32768 + tid * 16; \
    _Pragma("unroll") for (int i_ = 0; i_ < 4; ++i_) { \
      __builtin_amdgcn_global_load_lds((const unsigned*)(ga[i_] + (t_) * 64), (unsigned*)(sa_ + i_ * 4096), 16, 0, 0); \
      __builtin_amdgcn_global_load_lds((const unsigned*)(gb[i_] + (t_) * 64), (unsigned*)(sa_ + 16384 + i_ * 4096), 16, 0, 0); \
    } \
  } while (0)
  GEMM_STAGE(0, 0);
  for (int t = 0; t < nk; ++t) {
    asm volatile("s_waitcnt vmcnt(0)" ::: "memory");
    __syncthreads();
    if (t + 1 < nk) GEMM_STAGE(t + 1, (t + 1) & 1);
    const unsigned char* SA = smem + (t & 1) * 32768;
    const unsigned char* SB = SA + 16384;
#pragma unroll
    for (int kk = 0; kk < 2; ++kk) {
      h16x8 af[4], bf[4];
      const int pos = ((kk * 4 + fq) ^ (fr & 7)) << 4;
#pragma unroll
      for (int m = 0; m < 4; ++m) {
        af[m] = *(const h16x8*)(SA + (wr * 64 + m * 16 + fr) * 128 + pos);
        bf[m] = *(const h16x8*)(SB + (wc * 64 + m * 16 + fr) * 128 + pos);
      }
#pragma unroll
      for (int m = 0; m < 4; ++m)
#pragma unroll
        for (int n = 0; n < 4; ++n) acc[m][n] = MFMA(af[m], bf[n], acc[m][n]);
    }
  }
#undef GEMM_STAGE
  __syncthreads();
  float* CT = (float*)smem;
#pragma unroll
  for (int m = 0; m < 4; ++m)
#pragma unroll
    for (int n = 0; n < 4; ++n)
#pragma unroll
      for (int j = 0; j < 4; ++j) CT[(wr * 64 + m * 16 + fq * 4 + j) * 132 + wc * 64 + n * 16 + fr] = acc[m][n][j];
  __syncthreads();
  const int c4 = tid & 31;
#pragma unroll 2
  for (int it = 0; it < 16; ++it) {
    const int rl = it * 8 + (tid >> 5);
    const size_t row = (size_t)brow + rl;
    const int col = bcol + c4 * 4;
    const float4 v = *(const float4*)(CT + rl * 132 + c4 * 4);
    if constexpr (EPI == EPI_PROJ) {
      if (bcol < 3072) {
        h16x4 o; o[0] = (h16)v.x; o[1] = (h16)v.y; o[2] = (h16)v.z; o[3] = (h16)v.w;
        *(h16x4*)((h16*)(p.ws + OFF_PROJ) + row * LDP + col) = o;
      } else if (c4 < 2) {
        *(float4*)((float*)(p.ws + OFF_AB) + row * 8 + c4 * 4) = v;
      }
    } else if constexpr (EPI == EPI_GLU) {
      const h16x4 y = *(const h16x4*)((const h16*)((unsigned char*)p.out + OUT_OFF_YPRE) + row * 512 + col);
      const h16x4 z = *(const h16x4*)((const h16*)(p.ws + OFF_PROJ) + row * LDP + 512 + col);
      const float4 bb = *(const float4*)(p.in[I_BGLU] + col);
      h16x4 o;
      o[0] = (h16)((float)y[0] * sigmoidf_(v.x + bb.x) * siluf_((float)z[0]));
      o[1] = (h16)((float)y[1] * sigmoidf_(v.y + bb.y) * siluf_((float)z[1]));
      o[2] = (h16)((float)y[2] * sigmoidf_(v.z + bb.z) * siluf_((float)z[2]));
      o[3] = (h16)((float)y[3] * sigmoidf_(v.w + bb.w) * siluf_((float)z[3]));
      *(h16x4*)((h16*)(p.ws + OFF_MIXIN) + row * 1024 + col) = o;
    } else if constexpr (EPI == EPI_PLE) {
      h16x4 o; o[0] = (h16)v.x; o[1] = (h16)v.y; o[2] = (h16)v.z; o[3] = (h16)v.w;
      *(h16x4*)((h16*)(p.ws + OFF_EH) + row * 1024 + col) = o;
      float s = v.x * v.x + v.y * v.y + v.z * v.z + v.w * v.w;
      s = sum16(s); s += __shfl_xor(s, 16);
      if (c4 == 0) ((float*)(p.ws + OFF_EPART))[row * 8 + (bcol >> 7)] = s;
    } else if constexpr (EPI == EPI_OUT) {
      const float4 xv = *(const float4*)(p.in[I_X] + row * 1024 + col);
      float4 hv; hv.x = xv.x + v.x; hv.y = xv.y + v.y; hv.z = xv.z + v.z; hv.w = xv.w + v.w;
      h16x4 o; o[0] = (h16)hv.x; o[1] = (h16)hv.y; o[2] = (h16)hv.z; o[3] = (h16)hv.w;
      *(h16x4*)((h16*)(p.ws + OFF_PROJ) + row * 1024 + col) = o;
    } else if constexpr (EPI == EPI_GATE) {
      const float4 e0 = *(const float4*)((const float*)(p.ws + OFF_EPART) + row * 8);
      const float4 e1 = *(const float4*)((const float*)(p.ws + OFF_EPART) + row * 8 + 4);
      const float rs = rsqrtf((e0.x + e0.y + e0.z + e0.w + e1.x + e1.y + e1.z + e1.w) * (1.f / 1024.f) + 1e-6f);
      const h16x4 eh = *(const h16x4*)((const h16*)(p.ws + OFF_EH) + row * 1024 + col);
      const float4 pg = *(const float4*)(p.in[I_PLEG] + col);
      const h16x4 hb = *(const h16x4*)((const h16*)(p.ws + OFF_PROJ) + row * 1024 + col);
      float4 hv;
      hv.x = (float)hb[0] + sigmoidf_(v.x) * ((float)eh[0] * rs * pg.x);
      hv.y = (float)hb[1] + sigmoidf_(v.y) * ((float)eh[1] * rs * pg.y);
      hv.z = (float)hb[2] + sigmoidf_(v.z) * ((float)eh[2] * rs * pg.z);
      hv.w = (float)hb[3] + sigmoidf_(v.w) * ((float)eh[3] * rs * pg.w);
      {
        h16x4 o; o[0] = (h16)hv.x; o[1] = (h16)hv.y; o[2] = (h16)hv.z; o[3] = (h16)hv.w;
        *(h16x4*)((h16*)(p.ws + OFF_MIXIN) + row * 1024 + col) = o;
      }
      float s = hv.x * hv.x + hv.y * hv.y + hv.z * hv.z + hv.w * hv.w;
      s = sum16(s); s += __shfl_xor(s, 16);
      if (c4 == 0) ((float*)(p.ws + OFF_OPART))[row * 8 + (bcol >> 7)] = s;
    }
  }
  __syncthreads();
}

__device__ void ssm_item(const Params& p, int b, int g, unsigned char* smem) {
  float* LOCAL = (float*)smem;
  h16* SPREV = (h16*)(smem + 33792);
  h16* KT = (h16*)(smem + 51200);
  unsigned char* ERING = smem + 33792;
  unsigned char* FRING = smem;
  int tid_ = threadIdx.x;
  asm volatile("" : "+v"(tid_));
  const int tid = tid_, w = tid >> 6, lane = tid & 63, fr = lane & 15, fq = lane >> 4;
  const h16* PROJ = (const h16*)(p.ws + OFF_PROJ);
  const h16* Eg = (const h16*)(p.ws + OFF_ETAB) + (size_t)g * 128 * 512;
  const h16* Kg = (const h16*)(p.ws + OFF_KTAB) + (size_t)g * 33 * 256;
  const h16* Fg = (const h16*)(p.ws + OFF_FTAB) + (size_t)g * 512 * 128;
  const float* ALPOW = (const float*)(p.ws + OFF_ALPOW);
  h16* YPRE = (h16*)((unsigned char*)p.out + OUT_OFF_YPRE);
  const int nchunk = w * 16 + fr;
  const size_t tok0 = (size_t)b * SEQ + (size_t)nchunk * 32;
  h16x8 uf[16];
#pragma unroll
  for (int ks = 0; ks < 16; ++ks) {
    const int i = 2 * ks + (fq >> 1);
    uf[ks] = *(const h16x8*)(PROJ + (tok0 + i) * LDP + g * 16 + (fq & 1) * 8);
  }
#pragma unroll
  for (int ks = 0; ks < 16; ++ks) asm volatile("" : "+v"(uf[ks]));
  const h16* esrc[2];
#pragma unroll
  for (int i = 0; i < 2; ++i) { const int L = tid + 256 * i, row = L >> 5, cp = L & 31; esrc[i] = Eg + (size_t)row * 512 + ((cp ^ row) << 3); }
#define E_STAGE(it_) do { \
    _Pragma("unroll") for (int i_ = 0; i_ < 2; ++i_) \
      __builtin_amdgcn_global_load_lds((const unsigned*)(esrc[i_] + (size_t)((it_) >> 1) * 16 * 512 + ((it_) & 1) * 256), \
                                       (unsigned*)(ERING + ((it_) & 3) * 8192 + (tid + 256 * i_) * 16), 16, 0, 0); } while (0)
  E_STAGE(0); E_STAGE(1); E_STAGE(2);
#pragma unroll 1
  for (int mt = 0; mt < 8; ++mt) {
    f32x4 acc = {0.f, 0.f, 0.f, 0.f};
#pragma unroll
    for (int hf = 0; hf < 2; ++hf) {
      const int it = mt * 2 + hf;
      if (it <= 13) asm volatile("s_waitcnt vmcnt(4)" ::: "memory");
      else if (it == 14) asm volatile("s_waitcnt vmcnt(2)" ::: "memory");
      else asm volatile("s_waitcnt vmcnt(0)" ::: "memory");
      asm volatile("s_waitcnt lgkmcnt(0)" ::: "memory");
      __builtin_amdgcn_s_barrier();
      asm volatile("" ::: "memory");
      if (it + 3 < 16) E_STAGE(it + 3);
      const unsigned char* slot = ERING + (it & 3) * 8192 + fr * 512;
#pragma unroll
      for (int ks = 0; ks < 8; ++ks) {
        h16x8 a = *(const h16x8*)(slot + (((ks * 4 + fq) ^ fr) << 4));
        acc = MFMA(a, uf[hf * 8 + ks], acc);
      }
    }
    *(f32x4*)(LOCAL + nchunk * 132 + mt * 16 + fq * 4) = acc;
  }
#undef E_STAGE
  __syncthreads();
  for (int idx = tid; idx < 33 * 256 / 8; idx += 256) *(h16x8*)(KT + idx * 8) = *(const h16x8*)(Kg + idx * 8);
  if (tid < 64) {
    const int pp = tid;
    const float ar = ALPOW[(g * 64 + pp) * 2], ai = ALPOW[(g * 64 + pp) * 2 + 1];
    float sr = 0.f, si = 0.f;
#pragma unroll 4
    for (int c = 0; c < 64; ++c) {
      SPREV[c * 136 + pp] = (h16)sr;
      SPREV[c * 136 + 64 + pp] = (h16)si;
      float lr = LOCAL[c * 132 + pp], li = LOCAL[c * 132 + 64 + pp];
      float nr = ar * sr - ai * si + lr;
      float ni = ar * si + ai * sr + li;
      sr = nr; si = ni;
    }
  }
  asm volatile("s_waitcnt vmcnt(0)" ::: "memory");
  __syncthreads();
  h16x8 sf[4];
#pragma unroll
  for (int ks = 0; ks < 4; ++ks) sf[ks] = *(const h16x8*)(SPREV + nchunk * 136 + ks * 32 + fq * 8);
  const h16* fsrc = Fg + (size_t)(tid >> 4) * 128 + (((tid & 15) ^ (tid >> 4)) << 3);
#define F_STAGE(j_) __builtin_amdgcn_global_load_lds((const unsigned*)(fsrc + (size_t)((j_) < 31 ? (j_) : 31) * 16 * 128), \
                                                     (unsigned*)(FRING + ((j_) & 7) * 4096 + tid * 16), 16, 0, 0)
  F_STAGE(0); F_STAGE(1); F_STAGE(2);
#pragma unroll 1
  for (int j = 0; j < 32; ++j) {
    if (j == 0) asm volatile("s_waitcnt vmcnt(2)" ::: "memory");
    else if (j == 1) asm volatile("s_waitcnt vmcnt(3)" ::: "memory");
    else if (j == 2) asm volatile("s_waitcnt vmcnt(4)" ::: "memory");
    else asm volatile("s_waitcnt vmcnt(5)" ::: "memory");
    asm volatile("s_waitcnt lgkmcnt(0)" ::: "memory");
    __builtin_amdgcn_s_barrier();
    asm volatile("" ::: "memory");
    F_STAGE(j + 3);
    asm volatile("" ::: "memory");
    f32x4 acc = {0.f, 0.f, 0.f, 0.f}, acc2 = {0.f, 0.f, 0.f, 0.f};
#pragma unroll
    for (int ks = 0; ks < 16; ++ks) {
      if (2 * ks <= j) {
        const int dd = j - 2 * ks - (fq >> 1) + 1;
        h16x8 a = *(const h16x8*)(KT + dd * 256 + fr * 16 + (fq & 1) * 8);
        if (ks & 1) acc2 = MFMA(a, uf[ks], acc2); else acc = MFMA(a, uf[ks], acc);
      }
    }
    const unsigned char* slot = FRING + (j & 7) * 4096 + fr * 256;
#pragma unroll
    for (int ks = 0; ks < 4; ++ks) {
      h16x8 a = *(const h16x8*)(slot + (((ks * 4 + fq) ^ fr) << 4));
      if (ks & 1) acc2 = MFMA(a, sf[ks], acc2); else acc = MFMA(a, sf[ks], acc);
    }
    h16x4 o;
    o[0] = (h16)gelu_tanh(acc[0] + acc2[0]);
    o[1] = (h16)gelu_tanh(acc[1] + acc2[1]);
    o[2] = (h16)gelu_tanh(acc[2] + acc2[2]);
    o[3] = (h16)gelu_tanh(acc[3] + acc2[3]);
    *(h16x4*)(YPRE + (tok0 + j) * 512 + g * 16 + fq * 4) = o;
    asm volatile("" ::: "memory");
  }
#undef F_STAGE
  asm volatile("s_waitcnt vmcnt(0)" ::: "memory");
  __syncthreads();
}

__device__ void gdn_pre_item(const Params& p, int item, unsigned char* smem) {
  h16* QH = (h16*)smem;
  h16* KH = (h16*)(smem + 17408);
  h16* VH = (h16*)(smem + 34816);
  float* Ld = (float*)(smem + 52224);
  h16* Limg = (h16*)(smem + 56576);
  h16* Dimg = (h16*)(smem + 60672);
  float* sG = (float*)(smem + 69632);
  float* sBeta = (float*)(smem + 69888);
  float* sEG = (float*)(smem + 70144);
  float* sBG = (float*)(smem + 70400);
  float* sEL = (float*)(smem + 70656);
  int tid_ = threadIdx.x;
  asm volatile("" : "+v"(tid_));
  const int tid = tid_, w = tid >> 6, lane = tid & 63, fr = lane & 15, fq = lane >> 4;
  const int c = item & 31, h = (item >> 5) & 3, b = item >> 7;
  const h16* PROJ = (const h16*)(p.ws + OFF_PROJ);
  const float* AB = (const float*)(p.ws + OFF_AB);
  const float* convw = p.in[I_CONVW];
  h16* WPi = (h16*)(p.ws + OFF_WP) + (size_t)item * 64 * 128;
  h16* QGPi = (h16*)(p.ws + OFF_QGP) + (size_t)item * 64 * 128;
  h16* KDTi = (h16*)(p.ws + OFF_KDT) + (size_t)item * 128 * 64;
  h16* UTi = (h16*)(p.ws + OFF_UT) + (size_t)item * 128 * 64;
  h16* ATPi = (h16*)(p.ws + OFF_ATP) + (size_t)item * 64 * 64;
  h16* ZTi = (h16*)((unsigned char*)p.out + OUT_OFF_ZT) + (size_t)item * 128 * 64;
  float* DL = (float*)(p.ws + OFF_DL);
  {
    const h16x8 z8 = {(h16)0.f, (h16)0.f, (h16)0.f, (h16)0.f, (h16)0.f, (h16)0.f, (h16)0.f, (h16)0.f};
    *(h16x8*)(Limg + tid * 8) = z8; *(h16x8*)(Limg + 2048 + tid * 8) = z8;
  }
  {
    const int ch0 = (tid & 15) * 8, t0 = (tid >> 4) * 4;
#pragma unroll 1
    for (int sec = 0; sec < 3; ++sec) {
      const int colbase = 1024 + sec * 512 + h * 128 + ch0;
      h16x8 xr[7];
#pragma unroll
      for (int i = 0; i < 7; ++i) {
        const int ts = c * 64 + t0 - 3 + i;
        h16x8 z8 = {(h16)0.f, (h16)0.f, (h16)0.f, (h16)0.f, (h16)0.f, (h16)0.f, (h16)0.f, (h16)0.f};
        xr[i] = (ts >= 0) ? *(const h16x8*)(PROJ + ((size_t)b * SEQ + ts) * LDP + colbase) : z8;
      }
      float4 wv[4][2];
#pragma unroll
      for (int jj = 0; jj < 4; ++jj) {
        wv[jj][0] = *(const float4*)(convw + jj * 1536 + sec * 512 + h * 128 + ch0);
        wv[jj][1] = *(const float4*)(convw + jj * 1536 + sec * 512 + h * 128 + ch0 + 4);
      }
      h16* dst = (sec == 0 ? QH : (sec == 1 ? KH : VH));
#pragma unroll
      for (int tt = 0; tt < 4; ++tt) {
        float a[8];
#pragma unroll
        for (int e = 0; e < 8; ++e) a[e] = 0.f;
#pragma unroll
        for (int jj = 0; jj < 4; ++jj) {
          const h16x8 xv = xr[tt + jj];
          a[0] += wv[jj][0].x * (float)xv[0]; a[1] += wv[jj][0].y * (float)xv[1]; a[2] += wv[jj][0].z * (float)xv[2]; a[3] += wv[jj][0].w * (float)xv[3];
          a[4] += wv[jj][1].x * (float)xv[4]; a[5] += wv[jj][1].y * (float)xv[5]; a[6] += wv[jj][1].z * (float)xv[6]; a[7] += wv[jj][1].w * (float)xv[7];
        }
        float ss = 0.f;
#pragma unroll
        for (int e = 0; e < 8; ++e) { a[e] = siluf_(a[e]); ss += a[e] * a[e]; }
        float scale = 1.f;
        if (sec < 2) {
          ss = sum16(ss);
          scale = rsqrtf(ss + 1e-6f) * (sec == 0 ? 0.08838834764831845f : 1.f);
        }
        h16x8 o;
#pragma unroll
        for (int e = 0; e < 8; ++e) o[e] = (h16)(a[e] * scale);
        *(h16x8*)(dst + (t0 + tt) * 136 + ch0) = o;
      }
    }
  }
  if (tid < 64) {
    const size_t tok = (size_t)b * SEQ + c * 64 + tid;
    float braw = AB[tok * 8 + h], araw = AB[tok * 8 + 4 + h];
    float beta = 1.f / (1.f + expf(-braw));
    float xx = araw + p.in[I_DTB][h];
    float sp = xx > 20.f ? xx : log1pf(expf(xx));
    float gg = -expf(p.in[I_ALOG][h]) * sp;
#pragma unroll
    for (int o = 1; o < 64; o <<= 1) {
      float v = __shfl_up(gg, o);
      if (lane >= o) gg += v;
    }
    sG[tid] = gg;
    sBeta[tid] = beta;
    const float eg = expf(gg);
    sEG[tid] = eg;
    sBG[tid] = beta * eg;
    sEL[tid] = expf(__shfl(gg, 63) - gg);
  }
  __syncthreads();
  {
    h16x8 ak[4], aq[4];
#pragma unroll
    for (int ks = 0; ks < 4; ++ks) {
      ak[ks] = *(const h16x8*)(KH + (w * 16 + fr) * 136 + ks * 32 + fq * 8);
      aq[ks] = *(const h16x8*)(QH + (w * 16 + fr) * 136 + ks * 32 + fq * 8);
    }
#pragma unroll
    for (int jt = 0; jt < 4; ++jt) {
      const int j = jt * 16 + fr;
      const int pj = perm_pos(j);
      if (jt <= w) {
        f32x4 kk = {0.f, 0.f, 0.f, 0.f}, qk = {0.f, 0.f, 0.f, 0.f};
#pragma unroll
        for (int ks = 0; ks < 4; ++ks) {
          h16x8 bk = *(const h16x8*)(KH + (jt * 16 + fr) * 136 + ks * 32 + fq * 8);
          kk = MFMA(ak[ks], bk, kk);
          qk = MFMA(aq[ks], bk, qk);
        }
        const float Gj = sG[j];
        f32x4 lt;
#pragma unroll
        for (int r = 0; r < 4; ++r) {
          const int i = w * 16 + 4 * fq + r;
          const float e = (i >= j) ? __expf(sG[i] - Gj) : 0.f;
          lt[r] = (i > j) ? sBeta[i] * kk[r] * e : 0.f;
          ATPi[i * 64 + (((pj >> 3) ^ (i & 7)) << 3) + (pj & 7)] = (h16)(qk[r] * e);
        }
        if (jt == w) {
#pragma unroll
          for (int r = 0; r < 4; ++r) Ld[(w * 16 + 4 * fq + r) * 17 + fr] = lt[r];
        } else {
          const int img = (w == 1) ? 0 : (w == 2 ? 1 : (jt < 2 ? 2 : 3));
#pragma unroll
          for (int r = 0; r < 4; ++r) Limg[img * 512 + (4 * fq + r) * 32 + (fr >> 2) * 8 + (fr & 3) + 4 * (jt & 1)] = (h16)(-lt[r]);
        }
      } else {
#pragma unroll
        for (int r = 0; r < 4; ++r) {
          const int i = w * 16 + 4 * fq + r;
          ATPi[i * 64 + (((pj >> 3) ^ (i & 7)) << 3) + (pj & 7)] = (h16)0.f;
        }
      }
    }
  }
  __syncthreads();
  if (lane < 16) {
    float y[16];
#pragma unroll
    for (int i = 0; i < 16; ++i) {
      float s = (i == lane) ? 1.f : 0.f;
#pragma unroll
      for (int k = 0; k < i; ++k) s -= Ld[(w * 16 + i) * 17 + k] * y[k];
      y[i] = s;
    }
#pragma unroll
    for (int i = 0; i < 16; ++i) Dimg[w * 512 + i * 32 + (lane >> 2) * 8 + (lane & 3)] = (h16)y[i];
  }
  __syncthreads();
  f32x4 xs[4][4];
  {
    const h16* SRC = (w < 2) ? VH : KH;
    const float* scl = (w < 2) ? sBeta : sBG;
    const int cbase = (w & 1) * 64;
    h16x8 dA[4], lA[4];
#pragma unroll
    for (int b4 = 0; b4 < 4; ++b4) {
      dA[b4] = *(const h16x8*)(Dimg + b4 * 512 + fr * 32 + fq * 8);
      lA[b4] = *(const h16x8*)(Limg + b4 * 512 + fr * 32 + fq * 8);
    }
    const f32x4 z4 = {0.f, 0.f, 0.f, 0.f};
#pragma unroll
    for (int nt = 0; nt < 4; ++nt) {
      const int col = cbase + nt * 16 + fr;
      f32x4 rb[4];
#pragma unroll
      for (int b4 = 0; b4 < 4; ++b4)
#pragma unroll
        for (int r = 0; r < 4; ++r) rb[b4][r] = (float)SRC[(b4 * 16 + 4 * fq + r) * 136 + col] * scl[b4 * 16 + 4 * fq + r];
      const f32x4 x0 = MFMA(dA[0], pack8(rb[0], z4), z4);
      const f32x4 a1 = MFMA(lA[0], pack8(x0, z4), rb[1]);
      const f32x4 x1 = MFMA(dA[1], pack8(a1, z4), z4);
      const h16x8 x01 = pack8(x0, x1);
      const f32x4 a2 = MFMA(lA[1], x01, rb[2]);
      const f32x4 x2 = MFMA(dA[2], pack8(a2, z4), z4);
      f32x4 a3 = MFMA(lA[2], x01, rb[3]);
      a3 = MFMA(lA[3], pack8(x2, z4), a3);
      const f32x4 x3 = MFMA(dA[3], pack8(a3, z4), z4);
      xs[nt][0] = x0; xs[nt][1] = x1; xs[nt][2] = x2; xs[nt][3] = x3;
      if (w < 2) {
#pragma unroll
        for (int b4 = 0; b4 < 4; ++b4) {
          h16x4 o; o[0] = (h16)xs[nt][b4][0]; o[1] = (h16)xs[nt][b4][1]; o[2] = (h16)xs[nt][b4][2]; o[3] = (h16)xs[nt][b4][3];
          *(h16x4*)(UTi + (size_t)col * 64 + b4 * 16 + 4 * fq) = o;
        }
      }
    }
  }
  __syncthreads();
  if (w >= 2) {
#pragma unroll
    for (int nt = 0; nt < 4; ++nt) {
      const int pos = perm_pos((w & 1) * 64 + nt * 16 + fr);
#pragma unroll
      for (int b4 = 0; b4 < 4; ++b4)
#pragma unroll
        for (int r = 0; r < 4; ++r) VH[(b4 * 16 + 4 * fq + r) * 136 + pos] = (h16)xs[nt][b4][r];
    }
  }
  __syncthreads();
  for (int rr = 0; rr < 4; ++rr) {
    const int idx = tid + 256 * rr, row = idx >> 4, seg = idx & 15;
    *(h16x8*)(WPi + row * 128 + ((seg ^ (row & 15)) << 3)) = *(const h16x8*)(VH + row * 136 + seg * 8);
  }
  {
    const int dv = tid & 127, th = tid >> 7;
    const float gdv = p.in[I_DNG][dv];
    const h16* zp = PROJ + ((size_t)b * SEQ + c * 64 + th * 32) * LDP + 2560 + h * 128 + dv;
    h16 zv[32];
#pragma unroll
    for (int t = 0; t < 32; ++t) zv[t] = zp[(size_t)t * LDP];
#pragma unroll
    for (int t8 = 0; t8 < 4; ++t8) {
      h16x8 v;
#pragma unroll
      for (int e = 0; e < 8; ++e) v[e] = (h16)(siluf_((float)zv[t8 * 8 + e]) * gdv);
      *(h16x8*)(ZTi + (size_t)dv * 64 + th * 32 + t8 * 8) = v;
    }
  }
#pragma unroll 2
  for (int rr = 0; rr < 4; ++rr) {
    const int idx = tid + 256 * rr, t = idx >> 4, cpos = idx & 15, ks = cpos >> 2, q = cpos & 3;
    const h16x4 lo = *(const h16x4*)(QH + t * 136 + ks * 32 + 4 * q);
    const h16x4 hi = *(const h16x4*)(QH + t * 136 + ks * 32 + 16 + 4 * q);
    const float sc = sEG[t];
    h16x8 o;
#pragma unroll
    for (int e = 0; e < 4; ++e) { o[e] = (h16)((float)lo[e] * sc); o[4 + e] = (h16)((float)hi[e] * sc); }
    *(h16x8*)(QGPi + t * 128 + ((cpos ^ (t & 15)) << 3)) = o;
  }
#pragma unroll 2
  for (int rr = 0; rr < 4; ++rr) {
    const int idx = tid + 256 * rr, dk = idx >> 3, cpos = idx & 7, k2 = cpos >> 2, q = cpos & 3;
    h16x8 o;
#pragma unroll
    for (int e = 0; e < 8; ++e) {
      const int t = k2 * 32 + (e < 4 ? 4 * q + e : 16 + 4 * q + (e - 4));
      o[e] = (h16)((float)KH[t * 136 + dk] * sEL[t]);
    }
    *(h16x8*)(KDTi + dk * 64 + ((cpos ^ (dk & 7)) << 3)) = o;
  }
  const float Glast = sG[63];
  if (tid == 0) DL[item] = expf(Glast);
  __syncthreads();
}

template <int NB>
__device__ __forceinline__ void glds_copy(const h16* __restrict__ g, unsigned char* l) {
#pragma unroll
  for (int i = 0; i < NB / 4096; ++i) {
    const int off = threadIdx.x * 16 + i * 4096;
    __builtin_amdgcn_global_load_lds((const unsigned*)((const unsigned char*)g + off), (unsigned*)(l + off), 16, 0, 0);
  }
}
#define RAW_BARRIER() do { asm volatile("s_waitcnt lgkmcnt(0)" ::: "memory"); __builtin_amdgcn_s_barrier(); asm volatile("" ::: "memory"); } while (0)

__device__ void gdn_chain(const Params& p, int bh, unsigned char* smem) {
  const int tid = threadIdx.x, w = tid >> 6, lane = tid & 63, fr = lane & 15, fq = lane >> 4;
  const float* DL = (const float*)(p.ws + OFF_DL);
  const h16* WPb = (const h16*)(p.ws + OFF_WP) + (size_t)bh * 32 * 64 * 128;
  const h16* KDTb = (const h16*)(p.ws + OFF_KDT) + (size_t)bh * 32 * 128 * 64;
  h16* UTb = (h16*)(p.ws + OFF_UT) + (size_t)bh * 32 * 128 * 64;
  h16* SFb = (h16*)((unsigned char*)p.out + OUT_OFF_SF) + (size_t)bh * 32 * 128 * 128;
  f32x4 S[8][2];
#pragma unroll
  for (int i = 0; i < 8; ++i) { S[i][0] = f32x4{0.f, 0.f, 0.f, 0.f}; S[i][1] = f32x4{0.f, 0.f, 0.f, 0.f}; }
  h16x4 uR[4][2];
  const int uoff = (w * 32 + fr) * 64 + fq * 4;
  glds_copy<16384>(WPb, smem); glds_copy<16384>(KDTb, smem + 16384);
#pragma unroll
  for (int mt = 0; mt < 4; ++mt)
#pragma unroll
    for (int nt = 0; nt < 2; ++nt) uR[mt][nt] = *(const h16x4*)(UTb + uoff + nt * 1024 + mt * 16);
  float dl = DL[bh * 32];
  asm volatile("s_waitcnt vmcnt(0)" ::: "memory");
  RAW_BARRIER();
  for (int c = 0; c < 32; ++c) {
    const int cn = (c + 1 < 32) ? c + 1 : 31;
    const unsigned char* LW = smem + (c & 1) * 32768;
    const unsigned char* LK = LW + 16384;
    unsigned char* LWn = smem + ((c + 1) & 1) * 32768;
    f32x4 uf[4][2];
#pragma unroll
    for (int mt = 0; mt < 4; ++mt)
#pragma unroll
      for (int nt = 0; nt < 2; ++nt)
#pragma unroll
        for (int r = 0; r < 4; ++r) uf[mt][nt][r] = (float)uR[mt][nt][r];
    const float dlc = dl;
    asm volatile("" ::: "memory");
    h16x8 sfr[4][2];
#pragma unroll
    for (int ks = 0; ks < 4; ++ks) { sfr[ks][0] = pack8(S[2 * ks][0], S[2 * ks + 1][0]); sfr[ks][1] = pack8(S[2 * ks][1], S[2 * ks + 1][1]); }
#pragma unroll
    for (int ks = 0; ks < 4; ++ks)
#pragma unroll
      for (int nt = 0; nt < 2; ++nt)
        *(h16x8*)(SFb + ((size_t)(c * 4 + ks) * 8 + w * 2 + nt) * 512 + lane * 8) = sfr[ks][nt];
    glds_copy<16384>(WPb + (size_t)cn * 64 * 128, LWn);
    glds_copy<16384>(KDTb + (size_t)cn * 128 * 64, LWn + 16384);
#pragma unroll
    for (int mt = 0; mt < 4; ++mt)
#pragma unroll
      for (int nt = 0; nt < 2; ++nt)
        uR[mt][nt] = *(const h16x4*)(UTb + (size_t)cn * 128 * 64 + uoff + nt * 1024 + mt * 16);
    dl = DL[bh * 32 + cn];
    asm volatile("" ::: "memory");
    f32x4 vn[4][2];
#pragma unroll
    for (int mt = 0; mt < 4; ++mt) { vn[mt][0] = f32x4{0.f, 0.f, 0.f, 0.f}; vn[mt][1] = vn[mt][0]; }
#pragma unroll
    for (int ks = 0; ks < 4; ++ks)
#pragma unroll
      for (int mt = 0; mt < 4; ++mt) {
        h16x8 aw = *(const h16x8*)(LW + (mt * 16 + fr) * 256 + (((ks * 4 + fq) ^ fr) << 4));
        vn[mt][0] = MFMA(aw, sfr[ks][0], vn[mt][0]);
        vn[mt][1] = MFMA(aw, sfr[ks][1], vn[mt][1]);
      }
#pragma unroll
    for (int mt = 0; mt < 4; ++mt)
#pragma unroll
      for (int r = 0; r < 4; ++r) { vn[mt][0][r] = uf[mt][0][r] - vn[mt][0][r]; vn[mt][1][r] = uf[mt][1][r] - vn[mt][1][r]; }
    h16x8 vfr[2][2];
#pragma unroll
    for (int k2 = 0; k2 < 2; ++k2) { vfr[k2][0] = pack8(vn[2 * k2][0], vn[2 * k2 + 1][0]); vfr[k2][1] = pack8(vn[2 * k2][1], vn[2 * k2 + 1][1]); }
    if (c + 1 < 32) {
#pragma unroll
      for (int k2 = 0; k2 < 2; ++k2)
#pragma unroll
        for (int nt = 0; nt < 2; ++nt)
          *(h16x8*)(UTb + (size_t)c * 128 * 64 + ((size_t)k2 * 8 + w * 2 + nt) * 512 + lane * 8) = vfr[k2][nt];
    }
#pragma unroll
    for (int dkt = 0; dkt < 8; ++dkt) {
      f32x4 s0 = S[dkt][0], s1 = S[dkt][1];
#pragma unroll
      for (int r = 0; r < 4; ++r) { s0[r] *= dlc; s1[r] *= dlc; }
#pragma unroll
      for (int k2 = 0; k2 < 2; ++k2) {
        h16x8 ak = *(const h16x8*)(LK + (dkt * 16 + fr) * 128 + (((k2 * 4 + fq) ^ (fr & 7)) << 4));
        s0 = MFMA(ak, vfr[k2][0], s0);
        s1 = MFMA(ak, vfr[k2][1], s1);
      }
      S[dkt][0] = s0; S[dkt][1] = s1;
    }
    asm volatile("s_waitcnt vmcnt(0)" ::: "memory");
    RAW_BARRIER();
    if (c + 1 == 32) {
#pragma unroll
      for (int k2 = 0; k2 < 2; ++k2)
#pragma unroll
        for (int nt = 0; nt < 2; ++nt)
          *(h16x8*)(UTb + (size_t)c * 128 * 64 + ((size_t)k2 * 8 + w * 2 + nt) * 512 + lane * 8) = vfr[k2][nt];
    }
  }
  asm volatile("s_waitcnt vmcnt(0)" ::: "memory");
  __syncthreads();
}

__device__ void gdn_out_item(const Params& p, int item, unsigned char* smem) {
  unsigned char* LQ = smem;
  unsigned char* LA = smem + 16384;
  float* red = (float*)(smem + 24576);
  const int tid = threadIdx.x, w = tid >> 6, lane = tid & 63, fr = lane & 15, fq = lane >> 4;
  const int c = item & 31, h = (item >> 5) & 3, b = item >> 7;
  h16* MIXIN = (h16*)(p.ws + OFF_MIXIN);
  const h16* QGPi = (const h16*)(p.ws + OFF_QGP) + (size_t)item * 64 * 128;
  const h16* ATPi = (const h16*)(p.ws + OFF_ATP) + (size_t)item * 64 * 64;
  const h16* VFi = (const h16*)(p.ws + OFF_UT) + (size_t)item * 128 * 64;
  const h16* SFi = (const h16*)((unsigned char*)p.out + OUT_OFF_SF) + (size_t)item * 128 * 128;
  const h16* ZTi = (const h16*)((unsigned char*)p.out + OUT_OFF_ZT) + (size_t)item * 128 * 64;
  glds_copy<16384>(QGPi, LQ); glds_copy<8192>(ATPi, LA);
  h16x8 sfr[4][2], vfr[2][2];
#pragma unroll
  for (int ks = 0; ks < 4; ++ks)
#pragma unroll
    for (int nt = 0; nt < 2; ++nt) sfr[ks][nt] = *(const h16x8*)(SFi + ((size_t)ks * 8 + w * 2 + nt) * 512 + lane * 8);
#pragma unroll
  for (int k2 = 0; k2 < 2; ++k2)
#pragma unroll
    for (int nt = 0; nt < 2; ++nt) vfr[k2][nt] = *(const h16x8*)(VFi + ((size_t)k2 * 8 + w * 2 + nt) * 512 + lane * 8);
  h16x4 zR[4][2];
#pragma unroll
  for (int mt = 0; mt < 4; ++mt)
#pragma unroll
    for (int nt = 0; nt < 2; ++nt) zR[mt][nt] = *(const h16x4*)(ZTi + (size_t)(w * 32 + nt * 16 + fr) * 64 + mt * 16 + fq * 4);
  asm volatile("s_waitcnt vmcnt(0)" ::: "memory");
  __syncthreads();
  f32x4 o[4][2];
#pragma unroll
  for (int mt = 0; mt < 4; ++mt) {
    f32x4 o0 = {0.f, 0.f, 0.f, 0.f}, o1 = {0.f, 0.f, 0.f, 0.f};
#pragma unroll
    for (int ks = 0; ks < 4; ++ks) {
      h16x8 aq = *(const h16x8*)(LQ + (mt * 16 + fr) * 256 + (((ks * 4 + fq) ^ fr) << 4));
      o0 = MFMA(aq, sfr[ks][0], o0);
      o1 = MFMA(aq, sfr[ks][1], o1);
    }
#pragma unroll
    for (int k2 = 0; k2 < 2; ++k2) {
      h16x8 aa = *(const h16x8*)(LA + (mt * 16 + fr) * 128 + (((k2 * 4 + fq) ^ (fr & 7)) << 4));
      o0 = MFMA(aa, vfr[k2][0], o0);
      o1 = MFMA(aa, vfr[k2][1], o1);
    }
    o[mt][0] = o0; o[mt][1] = o1;
  }
#pragma unroll
  for (int mt = 0; mt < 4; ++mt)
#pragma unroll
    for (int r = 0; r < 4; ++r) {
      float s = o[mt][0][r] * o[mt][0][r] + o[mt][1][r] * o[mt][1][r];
      s = sum16(s);
      if (fr == 0) red[w * 64 + mt * 16 + 4 * fq + r] = s;
    }
  __syncthreads();
#pragma unroll
  for (int mt = 0; mt < 4; ++mt)
#pragma unroll
    for (int r = 0; r < 4; ++r) {
      const int tl = mt * 16 + 4 * fq + r;
      const float tot = red[tl] + red[64 + tl] + red[128 + tl] + red[192 + tl];
      const float rstd = rsqrtf(tot * (1.f / 128.f) + 1e-6f);
      const size_t tok = (size_t)b * SEQ + c * 64 + tl;
      h16* yp = MIXIN + tok * 1024 + 512 + h * 128 + w * 32 + fr;
      yp[0] = (h16)(o[mt][0][r] * rstd * (float)zR[mt][0][r]);
      yp[16] = (h16)(o[mt][1][r] * rstd * (float)zR[mt][1][r]);
    }
  __syncthreads();
}

#define XB_TMO      128
#define XB_XCNT(j)  (256  + 64 * (j))
#define XB_XSUB(j)  (1280 + 64 * (j))
#define XB_XGEN(j)  (2304 + 64 * (j))
#define XB_TOP      3328
#define XB_TOPGEN   3392
#define XCD_BAR_WORDS 3456
#define XB_SPIN_CAP (1u << 18)
#define LAS __attribute__((address_space(3)))

__device__ __forceinline__ unsigned xb_ld(unsigned* p)              { return __hip_atomic_load(p, __ATOMIC_RELAXED, __HIP_MEMORY_SCOPE_AGENT); }
__device__ __forceinline__ unsigned xb_add(unsigned* p, unsigned v) { return __hip_atomic_fetch_add(p, v, __ATOMIC_RELAXED, __HIP_MEMORY_SCOPE_AGENT); }
__device__ __forceinline__ unsigned xb_xcc_id() { return (unsigned)__builtin_amdgcn_s_getreg((3 << 11) | 20) & 0xFu; }
#define XB_SPIN(cond, bar) do { unsigned _sp = 0; while (cond) { __builtin_amdgcn_s_sleep(1); \
    if ((++_sp & 255u) == 0u) { if (xb_ld(&(bar)[XB_TMO])) break; if (_sp > XB_SPIN_CAP) { atomicAdd(&(bar)[XB_TMO], 1u); break; } } } } while (0)

struct XcdBarrier {
    unsigned* bar; unsigned x;
    volatile LAS unsigned* st;
};

__device__ __forceinline__ XcdBarrier xcd_barrier_post(unsigned* bar, volatile LAS unsigned* st) {
    XcdBarrier b; b.bar = bar; b.x = xb_xcc_id(); b.st = st;
    if (threadIdx.x == 0) (void)xb_add(&bar[XB_XCNT(b.x)], 1u);
    return b;
}
__device__ __forceinline__ void xcd_barrier_complete(unsigned* bar, unsigned x, unsigned& nloc, unsigned& nx) {
    const unsigned G = gridDim.x * gridDim.y * gridDim.z;
    unsigned sum, cnt, mine, sp = 0u;
    for (;;) {
        sum = 0u; cnt = 0u; mine = 0u;
#pragma unroll
        for (unsigned j = 0; j < 16; ++j) { const unsigned c = xb_ld(&bar[XB_XCNT(j)]); sum += c; cnt += (c > 0u) ? 1u : 0u; mine = (j == x) ? c : mine; }
        if (sum == G) break;
        __builtin_amdgcn_s_sleep(1);
        if ((++sp & 255u) == 0u) { if (xb_ld(&bar[XB_TMO])) break; if (sp > XB_SPIN_CAP) { atomicAdd(&bar[XB_TMO], 1u); break; } }
    }
    nloc = mine > 0u ? mine : 1u; nx = cnt > 0u ? cnt : 1u;
}

__device__ __forceinline__ void xcd_barrier(const XcdBarrier& b) {
    asm volatile("s_waitcnt vmcnt(0)" ::: "memory");
    __syncthreads();
    if (threadIdx.x == 0) {
        unsigned* bar = b.bar;
        __builtin_amdgcn_s_waitcnt(0);
        unsigned nloc = b.st[0], nx = b.st[1];
        if (nloc == 0u) { xcd_barrier_complete(bar, b.x, nloc, nx); b.st[0] = nloc; b.st[1] = nx; }
        const unsigned old = xb_add(&bar[XB_XSUB(b.x)], 1u);
        const unsigned gen = old / nloc;
        if (old + 1u == (gen + 1u) * nloc) {
            __builtin_amdgcn_fence(__ATOMIC_RELEASE, "agent");
            asm volatile("s_waitcnt vmcnt(0)" ::: "memory");
            const unsigned og = xb_add(&bar[XB_TOP], 1u);
            const unsigned tg = og / nx;
            if (og + 1u == (tg + 1u) * nx) xb_add(&bar[XB_TOPGEN], 1u);
            else XB_SPIN(xb_ld(&bar[XB_TOPGEN]) == tg, bar);
            __builtin_amdgcn_fence(__ATOMIC_ACQUIRE, "agent");
            xb_add(&bar[XB_XGEN(b.x)], 1u);
            asm volatile("s_waitcnt vmcnt(0)" ::: "memory");
        } else {
            XB_SPIN(xb_ld(&bar[XB_XGEN(b.x)]) == gen, bar);
            __builtin_amdgcn_fence(__ATOMIC_ACQUIRE, "agent");
            asm volatile("s_waitcnt vmcnt(0)" ::: "memory");
        }
    }
    __syncthreads();
}

#ifndef ONLY_PH
#define ONLY_PH -1
#endif
#define RUNPH(n) ((ONLY_PH < 0 || ONLY_PH == (n)) && p.ph_lo <= (n) && (n) <= p.ph_hi)
#define SYNCPH(n) do { if (p.ph_lo <= (n) && (n) < p.ph_hi) xcd_barrier(xb); } while (0)
__global__ void __launch_bounds__(256, 2) hymba_mega(Params p) {
  __shared__ __attribute__((aligned(16))) unsigned char smem[SMEM_BYTES];
  cg::grid_group grid = cg::this_grid();
  const int bid = blockIdx.x, nb = gridDim.x;
  if (p.ph_lo < 0) grid.sync();
  XcdBarrier xb;
  {
    volatile LAS unsigned* st = (volatile LAS unsigned*)(smem + SMEM_BYTES - 16);
    if (threadIdx.x == 0) { st[0] = 0u; st[1] = 0u; st[2] = 0u; st[3] = 0u; }
    __syncthreads();
    if (p.ph_lo < p.ph_hi) xb = xcd_barrier_post((unsigned*)(p.ws + OFF_BAR), st);
    else { xb.bar = (unsigned*)(p.ws + OFF_BAR); xb.x = 0; xb.st = st; }
  }
  {
    if (RUNPH(0)) for (int rep = 0; rep < REP0; ++rep) {
      if (rep) grid.sync();
      phase0(p, smem);
    }
    SYNCPH(0);
    if (RUNPH(1)) for (int rep = 0; rep < REP1; ++rep) {
      if (rep) grid.sync();
      const h16* A0 = (const h16*)((unsigned char*)p.out + OUT_OFF_A0);
      const h16* W = (const h16*)(p.ws + OFF_WIN);
      const int xl = bid & 7, nxb = nb >> 3;
      if (nb & 7) { for (int t = bid; t < 256 * 25; t += nb) gemm_tile<EPI_PROJ>(p, A0, 1024, W, 1024, 1024, (t / 25) * 128, (t % 25) * 128, smem); }
      else for (int u = bid >> 3; u < 800; u += nxb) {
        const int mb = u / 200, v = u % 200;
        gemm_tile<EPI_PROJ>(p, A0, 1024, W, 1024, 1024, (xl * 32 + mb * 8 + (v & 7)) * 128, (v >> 3) * 128, smem);
      }
    }
    SYNCPH(1);
    if (RUNPH(2)) for (int rep = 0; rep < REP2; ++rep) {
      if (rep) grid.sync();
      for (int it = bid; it < 512 + 2048; it += nb) {
        if (it < 2048) gdn_pre_item(p, it, smem);
        else ssm_item(p, (it - 2048) >> 5, (it - 2048) & 31, smem);
      }
    }
    SYNCPH(2);
    if (RUNPH(3)) {
      if (bid < 64) gdn_chain(p, bid, smem);
      const int xl = bid & 7;
      unsigned* ctr = (unsigned*)(p.ws + OFF_CTR) + xl * 16;
      volatile int* bc = (volatile int*)(smem + SMEM_BYTES - 4);
      const h16* YPRE = (const h16*)((unsigned char*)p.out + OUT_OFF_YPRE);
      for (;;) {
        __syncthreads();
        if (threadIdx.x == 0) *bc = (int)atomicAdd(ctr, 1u);
        __syncthreads();
        const int u = *bc;
        if (u >= 128 + 256) break;
        if (u < 128) gemm_tile<EPI_GLU>(p, YPRE, 512, (const h16*)(p.ws + OFF_WGLU), 512, 512, (xl * 32 + (u >> 2)) * 128, (u & 3) * 128, smem);
        else gemm_tile<EPI_PLE>(p, (const h16*)(p.ws + OFF_PB), 256, (const h16*)(p.ws + OFF_WPP), 256, 256, (xl * 32 + ((u - 128) >> 3)) * 128, ((u - 128) & 7) * 128, smem);
      }
    }
    SYNCPH(3);
    if (RUNPH(4)) {
      for (int it = bid; it < 2048; it += nb) gdn_out_item(p, it, smem);
    }
    SYNCPH(4);
    if (RUNPH(5)) {
      const int xl = bid & 7, nxb = nb >> 3;
      if (nb & 7) { for (int t = bid; t < 2048; t += nb) gemm_tile<EPI_OUT>(p, (const h16*)(p.ws + OFF_MIXIN), 1024, (const h16*)(p.ws + OFF_WOUT), 1024, 1024, (t >> 3) * 128, (t & 7) * 128, smem); }
      else for (int u = bid >> 3; u < 256; u += nxb)
        gemm_tile<EPI_OUT>(p, (const h16*)(p.ws + OFF_MIXIN), 1024, (const h16*)(p.ws + OFF_WOUT), 1024, 1024, (xl * 32 + (u >> 6) * 8 + (u & 7)) * 128, ((u >> 3) & 7) * 128, smem);
    }
    SYNCPH(5);
    if (RUNPH(6)) {
      const int xl = bid & 7, nxb = nb >> 3;
      if (nb & 7) { for (int t = bid; t < 2048; t += nb) gemm_tile<EPI_GATE>(p, (const h16*)(p.ws + OFF_PROJ), 1024, (const h16*)(p.ws + OFF_WGATE), 1024, 1024, (t >> 3) * 128, (t & 7) * 128, smem); }
      else for (int u = bid >> 3; u < 256; u += nxb)
        gemm_tile<EPI_GATE>(p, (const h16*)(p.ws + OFF_PROJ), 1024, (const h16*)(p.ws + OFF_WGATE), 1024, 1024, (xl * 32 + (u >> 6) * 8 + (u & 7)) * 128, ((u >> 3) & 7) * 128, smem);
    }
    SYNCPH(6);
    if (RUNPH(7)) {
      const int wid = threadIdx.x >> 6, lane = threadIdx.x & 63;
      const float* OPART = (const float*)(p.ws + OFF_OPART);
      const float4* g4 = (const float4*)p.in[I_FING];
      const h16* H2B = (const h16*)(p.ws + OFF_MIXIN);
      for (int row = bid * 4 + wid; row < T_TOK; row += nb * 4) {
        float s = (lane < 8) ? OPART[(size_t)row * 8 + lane] : 0.f;
        const h16x8 a = *(const h16x8*)(H2B + (size_t)row * 1024 + lane * 8);
        const h16x8 b = *(const h16x8*)(H2B + (size_t)row * 1024 + 512 + lane * 8);
        s = wave_sum(s);
        const float rstd = rsqrtf(s * (1.f / 1024.f) + 1e-6f);
        float4* orow = (float4*)(p.out + (size_t)row * 1024);
        const float4 g0 = g4[lane * 2], g1 = g4[lane * 2 + 1], g2 = g4[128 + lane * 2], g3 = g4[128 + lane * 2 + 1];
        float4 o0, o1, o2, o3;
        o0.x = (float)a[0] * rstd * g0.x; o0.y = (float)a[1] * rstd * g0.y; o0.z = (float)a[2] * rstd * g0.z; o0.w = (float)a[3] * rstd * g0.w;
        o1.x = (float)a[4] * rstd * g1.x; o1.y = (float)a[5] * rstd * g1.y; o1.z = (float)a[6] * rstd * g1.z; o1.w = (float)a[7] * rstd * g1.w;
        o2.x = (float)b[0] * rstd * g2.x; o2.y = (float)b[1] * rstd * g2.y; o2.z = (float)b[2] * rstd * g2.z; o2.w = (float)b[3] * rstd * g2.w;
        o3.x = (float)b[4] * rstd * g3.x; o3.y = (float)b[5] * rstd * g3.y; o3.z = (float)b[6] * rstd * g3.z; o3.w = (float)b[7] * rstd * g3.w;
        orow[lane * 2] = o0; orow[lane * 2 + 1] = o1; orow[128 + lane * 2] = o2; orow[128 + lane * 2 + 1] = o3;
      }
    }
  }
}

extern "C" void kernel_launch(void* const* d_in, const int* in_sizes, int n_in, void* d_out, int out_size, void* d_ws, size_t ws_size,
                              hipStream_t stream) {
  static int grid_blocks = 0;
  if (!grid_blocks) {
    int dev = 0, cus = 0, per_cu = 0;
    hipGetDevice(&dev);
    hipDeviceGetAttribute(&cus, hipDeviceAttributeMultiprocessorCount, dev);
    hipOccupancyMaxActiveBlocksPerMultiprocessor(&per_cu, hymba_mega, 256, 0);
    if (per_cu > 2) per_cu = 2;
    if (per_cu < 1) per_cu = 1;
    grid_blocks = cus * per_cu;
  }
  if (n_in != 23 || ws_size < WS_END || out_size != T_TOK * 1024) {
    fprintf(stderr, "kernel_launch: unexpected sizes n_in=%d ws=%zu (need %zu) out=%d\n", n_in, ws_size, (size_t)WS_END, out_size);
    return;
  }
  Params p{};
  for (int i = 0; i < 23; ++i) p.in[i] = (const float*)d_in[i];
  p.out = (float*)d_out;
  p.ws = (unsigned char*)d_ws;
  if (hipMemsetAsync((unsigned char*)d_ws + OFF_BAR, 0, 16384, stream) != hipSuccess) { fprintf(stderr, "kernel_launch: memset of control words failed\n"); return; }
#if MULTI_LAUNCH
  for (int ph = 0; ph < NPH; ++ph) {
    p.ph_lo = ph; p.ph_hi = ph;
    hipLaunchKernelGGL(hymba_mega, dim3(grid_blocks), dim3(256), 0, stream, p);
  }
#else
  p.ph_lo = 0; p.ph_hi = NPH - 1;
  void* args[] = {&p};
  hipError_t e = hipLaunchCooperativeKernel((void*)hymba_mega, dim3(grid_blocks), dim3(256), args, 0, stream);
  if (e != hipSuccess) fprintf(stderr, "cooperative launch failed: %s (grid %d)\n", hipGetErrorString(e), grid_blocks);
#endif
}
```

```cpp
#include <hip/hip_runtime.h>
#include <hip/hip_cooperative_groups.h>
#include <cstdio>
namespace cg = cooperative_groups;

#ifndef REP0
#define REP0 1
#endif
#ifndef REP1
#define REP1 1
#endif
#ifndef REP2
#define REP2 1
#endif
#ifndef REP3
#define REP3 1
#endif
#ifndef REP4
#define REP4 1
#endif
#ifndef MULTI_LAUNCH
#define MULTI_LAUNCH 0
#endif

typedef _Float16 h16;
typedef __attribute__((ext_vector_type(8))) _Float16 h16x8;
typedef __attribute__((ext_vector_type(4))) _Float16 h16x4;
typedef __attribute__((ext_vector_type(4))) float f32x4;
typedef __attribute__((ext_vector_type(2))) float v2f;

#define MFMA(a, b, c) __builtin_amdgcn_mfma_f32_16x16x32_f16((a), (b), (c), 0, 0, 0)

constexpr int T_TOK = 32768;
constexpr int SEQ = 2048;
constexpr int NPH = 8;
constexpr int LDP = 3072;
constexpr int SMEM_BYTES = 72704;

constexpr size_t SZ_WIN = (size_t)3200 * 1024 * 2;
constexpr size_t SZ_WGLU = (size_t)512 * 512 * 2;
constexpr size_t SZ_WOUT = (size_t)1024 * 1024 * 2;
constexpr size_t SZ_WPP = (size_t)1024 * 256 * 2;
constexpr size_t SZ_WGATE = (size_t)1024 * 1024 * 2;
constexpr size_t OFF_WIN = 0;
constexpr size_t OFF_WGLU = OFF_WIN + SZ_WIN;
constexpr size_t OFF_WOUT = OFF_WGLU + SZ_WGLU;
constexpr size_t OFF_WPP = OFF_WOUT + SZ_WOUT;
constexpr size_t OFF_WGATE = OFF_WPP + SZ_WPP;
constexpr size_t OFF_PB = OFF_WGATE + SZ_WGATE;
constexpr size_t OFF_PROJ = OFF_PB + (size_t)T_TOK * 256 * 2;
constexpr size_t OFF_AB = OFF_PROJ + (size_t)T_TOK * LDP * 2;
constexpr size_t OFF_KTAB = OFF_AB + (size_t)T_TOK * 8 * 4;
constexpr size_t OFF_ETAB = OFF_KTAB + (size_t)32 * 33 * 256 * 2;
constexpr size_t OFF_FTAB = OFF_ETAB + (size_t)32 * 128 * 512 * 2;
constexpr size_t OFF_ALPOW = OFF_FTAB + (size_t)32 * 512 * 128 * 2;
constexpr size_t OFF_DL = OFF_ALPOW + (size_t)32 * 64 * 2 * 4;
constexpr size_t OFF_EPART = OFF_DL + (size_t)2048 * 4;
constexpr size_t OFF_OPART = OFF_EPART + (size_t)T_TOK * 16 * 4;
constexpr size_t OFF_MIXIN = OFF_OPART + (size_t)T_TOK * 16 * 4;
constexpr size_t OFF_WP = OFF_MIXIN + (size_t)T_TOK * 1024 * 2;
constexpr size_t OFF_QGP = OFF_WP + (size_t)2048 * 64 * 128 * 2;
constexpr size_t OFF_KDT = OFF_QGP + (size_t)2048 * 64 * 128 * 2;
constexpr size_t OFF_UT = OFF_KDT + (size_t)2048 * 128 * 64 * 2;
constexpr size_t OFF_ATP = OFF_UT + (size_t)2048 * 128 * 64 * 2;
constexpr size_t OFF_EH = OFF_ATP + (size_t)2048 * 64 * 64 * 2;
constexpr size_t OFF_BAR = OFF_EH + (size_t)T_TOK * 1024 * 2;
constexpr size_t WS_END = OFF_BAR + 16384;
constexpr size_t OFF_CTR = OFF_BAR + 15360;
constexpr size_t OUT_OFF_A0 = 0;
constexpr size_t OUT_OFF_SF = 0;
constexpr size_t OUT_OFF_YPRE = (size_t)T_TOK * 1024 * 2;
constexpr size_t OUT_OFF_ZT = OUT_OFF_YPRE + (size_t)T_TOK * 512 * 2;

struct Params {
  const float* in[23];
  float* out;
  unsigned char* ws;
  int ph_lo, ph_hi;
};

enum { I_X = 0, I_P, I_NMG, I_WIN, I_ARE, I_AIM, I_BRE, I_BIM, I_CRE, I_CIM, I_D, I_LOGDT, I_WGLU, I_BGLU,
       I_CONVW, I_ALOG, I_DTB, I_DNG, I_WOUT, I_WPP, I_PLEG, I_WGATE, I_FING };

__device__ __forceinline__ float wave_sum(float v) {
#pragma unroll
  for (int o = 32; o > 0; o >>= 1) v += __shfl_xor(v, o);
  return v;
}
__device__ __forceinline__ float sum16(float v) {
  v += __shfl_xor(v, 1); v += __shfl_xor(v, 2); v += __shfl_xor(v, 4); v += __shfl_xor(v, 8);
  return v;
}
__device__ __forceinline__ float sigmoidf_(float x) { return __builtin_amdgcn_rcpf(1.f + __expf(-x)); }
__device__ __forceinline__ float siluf_(float x) { return x * __builtin_amdgcn_rcpf(1.f + __expf(-x)); }
__device__ __forceinline__ float gelu_tanh(float y) {
  float z = 0.7978845608028654f * (y + 0.044715f * y * y * y);
  return y * __builtin_amdgcn_rcpf(1.f + __expf(-2.f * z));
}
__device__ __forceinline__ h16x8 pack8(f32x4 lo, f32x4 hi) {
  h16x8 r;
  r[0] = (h16)lo[0]; r[1] = (h16)lo[1]; r[2] = (h16)lo[2]; r[3] = (h16)lo[3];
  r[4] = (h16)hi[0]; r[5] = (h16)hi[1]; r[6] = (h16)hi[2]; r[7] = (h16)hi[3];
  return r;
}
__device__ __forceinline__ int perm_pos(int n) { return (n & ~31) + (((n & 15) >> 2) << 3) + (((n >> 4) & 1) << 2) + (n & 3); }
__device__ __forceinline__ int perm_inv(int pos) {
  int q5 = pos & 31, qq = q5 >> 3, jj = q5 & 7;
  return (pos & ~31) + (jj < 4 ? 4 * qq + jj : 16 + 4 * qq + (jj - 4));
}

__device__ void transpose_w(const float* __restrict__ W, int K, int N, int Npad, h16* __restrict__ WT, int t, float* tile) {
  const int ntn = Npad / 64;
  const int kt = t / ntn, nt = t % ntn, k0 = kt * 64, n0 = nt * 64;
  const int tx = threadIdx.x & 63, ty = threadIdx.x >> 6;
  for (int r = 0; r < 16; ++r) {
    int k = ty * 16 + r, n = n0 + tx;
    tile[k * 65 + tx] = (n < N) ? W[(size_t)(k0 + k) * N + n] : 0.f;
  }
  __syncthreads();
  for (int r = 0; r < 16; ++r) {
    int n = ty * 16 + r;
    WT[(size_t)(n0 + n) * K + k0 + tx] = (h16)tile[tx * 65 + n];
  }
  __syncthreads();
}

__device__ void ssm_table_item(const Params& p, int g, int d, float* lds) {
  float2* sAp = (float2*)lds;
  float2* sW = sAp + 64;
  const int tid = threadIdx.x;
  h16* KTAB = (h16*)(p.ws + OFF_KTAB);
  h16* ETAB = (h16*)(p.ws + OFF_ETAB);
  h16* FTAB = (h16*)(p.ws + OFF_FTAB);
  float* ALPOW = (float*)(p.ws + OFF_ALPOW);
  float* sBr = lds + 256; float* sBi = sBr + 1024; float* sCr = sBi + 1024; float* sCi = sCr + 16 * 65;
  {
    const float4 vbr = ((const float4*)(p.in[I_BRE] + g * 1024))[tid], vbi = ((const float4*)(p.in[I_BIM] + g * 1024))[tid];
    const float4 vcr = ((const float4*)(p.in[I_CRE] + g * 1024))[tid], vci = ((const float4*)(p.in[I_CIM] + g * 1024))[tid];
    *(float4*)(sBr + tid * 4) = vbr; *(float4*)(sBi + tid * 4) = vbi;
    const int ch = (tid * 4) >> 6, cp = (tid * 4) & 63;
    sCr[ch * 65 + cp] = vcr.x; sCr[ch * 65 + cp + 1] = vcr.y; sCr[ch * 65 + cp + 2] = vcr.z; sCr[ch * 65 + cp + 3] = vcr.w;
    sCi[ch * 65 + cp] = vci.x; sCi[ch * 65 + cp + 1] = vci.y; sCi[ch * 65 + cp + 2] = vci.z; sCi[ch * 65 + cp + 3] = vci.w;
  }
  if (tid < 64) {
    const int pp = tid;
    float lr = p.in[I_ARE][g * 64 + pp], li = p.in[I_AIM][g * 64 + pp], dt = expf(p.in[I_LOGDT][g]);
    float mag = expf(lr * dt), ang = li * dt;
    float abr = mag * cosf(ang), abi = mag * sinf(ang);
    float nr = abr - 1.f, ni = abi, den = lr * lr + li * li;
    float cr = (nr * lr + ni * li) / den, ci = (ni * lr - nr * li) / den;
    float apr = 1.f, api = 0.f;
    for (int k = 0; k < d; ++k) { float t0 = apr * abr - api * abi; api = apr * abi + api * abr; apr = t0; }
    sAp[pp] = make_float2(apr, api);
    sW[pp] = make_float2(apr * cr - api * ci, apr * ci + api * cr);
    if (d == 32) { ALPOW[(g * 64 + pp) * 2] = apr; ALPOW[(g * 64 + pp) * 2 + 1] = api; }
  }
  __syncthreads();
  if (d < 32) {
    {
      const int h = tid >> 4, hp = tid & 15;
      float acc = 0.f;
#pragma unroll 8
      for (int pp = 0; pp < 64; ++pp) {
        float2 W = sW[pp];
        float br = sBr[pp * 16 + hp], bi = sBi[pp * 16 + hp];
        float wbr = W.x * br - W.y * bi, wbi = W.x * bi + W.y * br;
        float cr = sCr[h * 65 + pp], ci = sCi[h * 65 + pp];
        acc += cr * wbr - ci * wbi;
      }
      if (d == 0 && h == hp) acc += p.in[I_D][g * 16 + h];
      KTAB[(size_t)(g * 33 + d + 1) * 256 + h * 16 + hp] = (h16)acc;
      if (d == 0) KTAB[(size_t)(g * 33) * 256 + tid] = (h16)0.f;
    }
    {
      const int i = 31 - d;
#pragma unroll
      for (int r = 0; r < 4; ++r) {
        int idx = tid + 256 * r, pp = idx >> 4, hp = idx & 15;
        float2 W = sW[pp];
        float br = sBr[pp * 16 + hp], bi = sBi[pp * 16 + hp];
        float wbr = W.x * br - W.y * bi, wbi = W.x * bi + W.y * br;
        ETAB[((size_t)g * 128 + pp) * 512 + i * 16 + hp] = (h16)wbr;
        ETAB[((size_t)g * 128 + 64 + pp) * 512 + i * 16 + hp] = (h16)wbi;
      }
    }
  }
  if (d >= 1) {
    const int j = d - 1;
#pragma unroll
    for (int r = 0; r < 4; ++r) {
      int idx = tid + 256 * r, h = idx >> 6, pp = idx & 63;
      float2 Ap = sAp[pp];
      float cr = sCr[h * 65 + pp], ci = sCi[h * 65 + pp];
      float re = cr * Ap.x - ci * Ap.y, im = cr * Ap.y + ci * Ap.x;
      FTAB[((size_t)g * 512 + j * 16 + h) * 128 + pp] = (h16)re;
      FTAB[((size_t)g * 512 + j * 16 + h) * 128 + 64 + pp] = (h16)(-im);
    }
  }
  __syncthreads();
}

__device__ void phase0(const Params& p, unsigned char* smem) {
  const int bid = blockIdx.x, nb = gridDim.x, tid = threadIdx.x, wid = tid >> 6, lane = tid & 63;
  float* tile = (float*)smem;
  for (int t = bid; t < 1440; t += nb) {
    if (t < 800) transpose_w(p.in[I_WIN], 1024, 3080, 3200, (h16*)(p.ws + OFF_WIN), t, tile);
    else if (t < 864) transpose_w(p.in[I_WGLU], 512, 512, 512, (h16*)(p.ws + OFF_WGLU), t - 800, tile);
    else if (t < 1120) transpose_w(p.in[I_WOUT], 1024, 1024, 1024, (h16*)(p.ws + OFF_WOUT), t - 864, tile);
    else if (t < 1184) transpose_w(p.in[I_WPP], 256, 1024, 1024, (h16*)(p.ws + OFF_WPP), t - 1120, tile);
    else transpose_w(p.in[I_WGATE], 1024, 1024, 1024, (h16*)(p.ws + OFF_WGATE), t - 1184, tile);
  }
  for (int it = bid; it < 32 * 33; it += nb) ssm_table_item(p, it / 33, it % 33, (float*)smem);
  {
    h16* A0 = (h16*)((unsigned char*)p.out + OUT_OFF_A0);
    const float* x = p.in[I_X];
    const float4* g4 = (const float4*)p.in[I_NMG];
    for (int row = bid * 4 + wid; row < T_TOK; row += nb * 4) {
      const float4* xr = (const float4*)(x + (size_t)row * 1024);
      float4 v[4];
      float ss = 0.f;
#pragma unroll
      for (int i = 0; i < 4; ++i) {
        v[i] = xr[lane + i * 64];
        ss += v[i].x * v[i].x + v[i].y * v[i].y + v[i].z * v[i].z + v[i].w * v[i].w;
      }
      ss = wave_sum(ss);
      float rstd = rsqrtf(ss * (1.f / 1024.f) + 1e-6f);
#pragma unroll
      for (int i = 0; i < 4; ++i) {
        float4 g = g4[lane + i * 64];
        h16x4 o;
        o[0] = (h16)(v[i].x * rstd * g.x); o[1] = (h16)(v[i].y * rstd * g.y);
        o[2] = (h16)(v[i].z * rstd * g.z); o[3] = (h16)(v[i].w * rstd * g.w);
        *(h16x4*)(A0 + (size_t)row * 1024 + (lane + i * 64) * 4) = o;
      }
    }
  }
  {
    h16* PB = (h16*)(p.ws + OFF_PB);
    const float4* p4 = (const float4*)p.in[I_P];
    const size_t n4 = (size_t)T_TOK * 256 / 4;
    for (size_t i = (size_t)bid * 256 + tid; i < n4; i += (size_t)nb * 256) {
      float4 v = p4[i];
      h16x4 o;
      o[0] = (h16)v.x; o[1] = (h16)v.y; o[2] = (h16)v.z; o[3] = (h16)v.w;
      *(h16x4*)(PB + i * 4) = o;
    }
  }
}

enum { EPI_PROJ = 0, EPI_GLU, EPI_PLE, EPI_OUT, EPI_GATE };

template <int EPI>
__device__ __forceinline__ void gemm_tile(const Params& p, const h16* __restrict__ A, int lda, const h16* __restrict__ Bt, int ldb,
                                          int K, int brow, int bcol, unsigned char* smem) {
  const int tid = threadIdx.x, wid = tid >> 6, lane = tid & 63, wr = wid >> 1, wc = wid & 1, fr = lane & 15, fq = lane >> 4;
  f32x4 acc[4][4];
#pragma unroll
  for (int m = 0; m < 4; ++m)
#pragma unroll
    for (int n = 0; n < 4; ++n) acc[m][n] = f32x4{0.f, 0.f, 0.f, 0.f};
  const int nk = K / 64;
  const h16* ga[4]; const h16* gb[4];
#pragma unroll
  for (int i = 0; i < 4; ++i) {
    const int L = tid + 256 * i, row = L >> 3, cs = (L & 7) ^ (row & 7);
    ga[i] = A + (size_t)(brow + row) * lda + cs * 8;
    gb[i] = Bt + (size_t)(bcol + row) * ldb + cs * 8;
  }
#define GEMM_STAGE(t_, buf_) do { \
    unsigned char* sa_ = smem + (buf_) * 32768 + tid * 16; \
    _Pragma("unroll") for (int i_ = 0; i_ < 4; ++i_) { \
      __builtin_amdgcn_global_load_lds((const unsigned*)(ga[i_] + (t_) * 64), (unsigned*)(sa_ + i_ * 4096), 16, 0, 0); \
      __builtin_amdgcn_global_load_lds((const unsigned*)(gb[i_] + (t_) * 64), (unsigned*)(sa_ + 16384 + i_ * 4096), 16, 0, 0); \
    } \
  } while (0)
  GEMM_STAGE(0, 0);
  for (int t = 0; t < nk; ++t) {
    asm volatile("s_waitcnt vmcnt(0)" ::: "memory");
    __syncthreads();
    if (t + 1 < nk) GEMM_STAGE(t + 1, (t + 1) & 1);
    const unsigned char* SA = smem + (t & 1) * 32768;
    const unsigned char* SB = SA + 16384;
#pragma unroll
    for (int kk = 0; kk < 2; ++kk) {
      h16x8 af[4], bf[4];
      const int pos = ((kk * 4 + fq) ^ (fr & 7)) << 4;
#pragma unroll
      for (int m = 0; m < 4; ++m) {
        af[m] = *(const h16x8*)(SA + (wr * 64 + m * 16 + fr) * 128 + pos);
        bf[m] = *(const h16x8*)(SB + (wc * 64 + m * 16 + fr) * 128 + pos);
      }
#pragma unroll
      for (int m = 0; m < 4; ++m)
#pragma unroll
        for (int n = 0; n < 4; ++n) acc[m][n] = MFMA(af[m], bf[n], acc[m][n]);
    }
  }
#undef GEMM_STAGE
  __syncthreads();
  float* CT = (float*)smem;
  const int c4 = tid & 31, col = bcol + c4 * 4, r0 = tid >> 5;
  float4 pre_f[16];
  h16x4 pre_a[16], pre_b[16];
  float4 cst = {0.f, 0.f, 0.f, 0.f};
  if constexpr (EPI == EPI_OUT) {
#pragma unroll
    for (int it = 0; it < 16; ++it) pre_f[it] = *(const float4*)(p.in[I_X] + ((size_t)brow + it * 8 + r0) * 1024 + col);
  } else if constexpr (EPI == EPI_GLU) {
    cst = *(const float4*)(p.in[I_BGLU] + col);
#pragma unroll
    for (int it = 0; it < 16; ++it) {
      const size_t row = (size_t)brow + it * 8 + r0;
      pre_a[it] = *(const h16x4*)((const h16*)((unsigned char*)p.out + OUT_OFF_YPRE) + row * 512 + col);
      pre_b[it] = *(const h16x4*)((const h16*)(p.ws + OFF_PROJ) + row * LDP + 512 + col);
    }
  } else if constexpr (EPI == EPI_GATE) {
    cst = *(const float4*)(p.in[I_PLEG] + col);
#pragma unroll
    for (int it = 0; it < 16; ++it) {
      const size_t row = (size_t)brow + it * 8 + r0;
      pre_a[it] = *(const h16x4*)((const h16*)(p.ws + OFF_EH) + row * 1024 + col);
      pre_b[it] = *(const h16x4*)((const h16*)(p.ws + OFF_PROJ) + row * 1024 + col);
    }
    if (tid < 128) {
      const float4 e0 = *(const float4*)((const float*)(p.ws + OFF_EPART) + ((size_t)brow + tid) * 8);
      const float4 e1 = *(const float4*)((const float*)(p.ws + OFF_EPART) + ((size_t)brow + tid) * 8 + 4);
      ((float*)(smem + 67584))[tid] = rsqrtf((e0.x + e0.y + e0.z + e0.w + e1.x + e1.y + e1.z + e1.w) * (1.f / 1024.f) + 1e-6f);
    }
  }
#pragma unroll
  for (int m = 0; m < 4; ++m)
#pragma unroll
    for (int n = 0; n < 4; ++n)
#pragma unroll
      for (int j = 0; j < 4; ++j) CT[(wr * 64 + m * 16 + fq * 4 + j) * 132 + wc * 64 + n * 16 + fr] = acc[m][n][j];
  __syncthreads();
#pragma unroll
  for (int it = 0; it < 16; ++it) {
    const int rl = it * 8 + r0;
    const size_t row = (size_t)brow + rl;
    const float4 v = *(const float4*)(CT + rl * 132 + c4 * 4);
    if constexpr (EPI == EPI_PROJ) {
      if (bcol < 3072) {
        h16x4 o; o[0] = (h16)v.x; o[1] = (h16)v.y; o[2] = (h16)v.z; o[3] = (h16)v.w;
        *(h16x4*)((h16*)(p.ws + OFF_PROJ) + row * LDP + col) = o;
      } else if (c4 < 2) {
        *(float4*)((float*)(p.ws + OFF_AB) + row * 8 + c4 * 4) = v;
      }
    } else if constexpr (EPI == EPI_GLU) {
      const h16x4 y = pre_a[it], z = pre_b[it];
      h16x4 o;
      o[0] = (h16)((float)y[0] * sigmoidf_(v.x + cst.x) * siluf_((float)z[0]));
      o[1] = (h16)((float)y[1] * sigmoidf_(v.y + cst.y) * siluf_((float)z[1]));
      o[2] = (h16)((float)y[2] * sigmoidf_(v.z + cst.z) * siluf_((float)z[2]));
      o[3] = (h16)((float)y[3] * sigmoidf_(v.w + cst.w) * siluf_((float)z[3]));
      *(h16x4*)((h16*)(p.ws + OFF_MIXIN) + row * 1024 + col) = o;
    } else if constexpr (EPI == EPI_PLE) {
      h16x4 o; o[0] = (h16)v.x; o[1] = (h16)v.y; o[2] = (h16)v.z; o[3] = (h16)v.w;
      *(h16x4*)((h16*)(p.ws + OFF_EH) + row * 1024 + col) = o;
      float s = v.x * v.x + v.y * v.y + v.z * v.z + v.w * v.w;
      s = sum16(s); s += __shfl_xor(s, 16);
      if (c4 == 0) ((float*)(p.ws + OFF_EPART))[row * 8 + (bcol >> 7)] = s;
    } else if constexpr (EPI == EPI_OUT) {
      const float4 xv = pre_f[it];
      h16x4 o; o[0] = (h16)(xv.x + v.x); o[1] = (h16)(xv.y + v.y); o[2] = (h16)(xv.z + v.z); o[3] = (h16)(xv.w + v.w);
      *(h16x4*)((h16*)(p.ws + OFF_PROJ) + row * 1024 + col) = o;
    } else if constexpr (EPI == EPI_GATE) {
      const float rs = ((const float*)(smem + 67584))[rl];
      const h16x4 eh = pre_a[it], hb = pre_b[it];
      float4 hv;
      hv.x = (float)hb[0] + sigmoidf_(v.x) * ((float)eh[0] * rs * cst.x);
      hv.y = (float)hb[1] + sigmoidf_(v.y) * ((float)eh[1] * rs * cst.y);
      hv.z = (float)hb[2] + sigmoidf_(v.z) * ((float)eh[2] * rs * cst.z);
      hv.w = (float)hb[3] + sigmoidf_(v.w) * ((float)eh[3] * rs * cst.w);
      {
        h16x4 o; o[0] = (h16)hv.x; o[1] = (h16)hv.y; o[2] = (h16)hv.z; o[3] = (h16)hv.w;
        *(h16x4*)((h16*)(p.ws + OFF_MIXIN) + row * 1024 + col) = o;
      }
      float s = hv.x * hv.x + hv.y * hv.y + hv.z * hv.z + hv.w * hv.w;
      s = sum16(s); s += __shfl_xor(s, 16);
      if (c4 == 0) ((float*)(p.ws + OFF_OPART))[row * 8 + (bcol >> 7)] = s;
    }
  }
  __syncthreads();
}

__device__ void ssm_item(const Params& p, int b, int g, unsigned char* smem) {
  float* LOCAL = (float*)smem;
  h16* SPREV = (h16*)(smem + 33792);
  h16* KT = (h16*)(smem + 51200);
  unsigned char* ERING = smem + 33792;
  unsigned char* FRING = smem;
  int tid_ = threadIdx.x;
  asm volatile("" : "+v"(tid_));
  const int tid = tid_, w = tid >> 6, lane = tid & 63, fr = lane & 15, fq = lane >> 4;
  const h16* PROJ = (const h16*)(p.ws + OFF_PROJ);
  const h16* Eg = (const h16*)(p.ws + OFF_ETAB) + (size_t)g * 128 * 512;
  const h16* Kg = (const h16*)(p.ws + OFF_KTAB) + (size_t)g * 33 * 256;
  const h16* Fg = (const h16*)(p.ws + OFF_FTAB) + (size_t)g * 512 * 128;
  const float* ALPOW = (const float*)(p.ws + OFF_ALPOW);
  h16* YPRE = (h16*)((unsigned char*)p.out + OUT_OFF_YPRE);
  const int nchunk = w * 16 + fr;
  const size_t tok0 = (size_t)b * SEQ + (size_t)nchunk * 32;
  h16x8 uf[16];
#pragma unroll
  for (int ks = 0; ks < 16; ++ks) {
    const int i = 2 * ks + (fq >> 1);
    uf[ks] = *(const h16x8*)(PROJ + (tok0 + i) * LDP + g * 16 + (fq & 1) * 8);
  }
#pragma unroll
  for (int ks = 0; ks < 16; ++ks) asm volatile("" : "+v"(uf[ks]));
  const h16* esrc[2];
#pragma unroll
  for (int i = 0; i < 2; ++i) { const int L = tid + 256 * i, row = L >> 5, cp = L & 31; esrc[i] = Eg + (size_t)row * 512 + ((cp ^ row) << 3); }
#define E_STAGE(it_) do { \
    _Pragma("unroll") for (int i_ = 0; i_ < 2; ++i_) \
      __builtin_amdgcn_global_load_lds((const unsigned*)(esrc[i_] + (size_t)((it_) >> 1) * 16 * 512 + ((it_) & 1) * 256), \
                                       (unsigned*)(ERING + ((it_) & 3) * 8192 + (tid + 256 * i_) * 16), 16, 0, 0); } while (0)
  E_STAGE(0); E_STAGE(1); E_STAGE(2);
#pragma unroll 1
  for (int mt = 0; mt < 8; ++mt) {
    f32x4 acc = {0.f, 0.f, 0.f, 0.f};
#pragma unroll
    for (int hf = 0; hf < 2; ++hf) {
      const int it = mt * 2 + hf;
      if (it <= 13) asm volatile("s_waitcnt vmcnt(4)" ::: "memory");
      else if (it == 14) asm volatile("s_waitcnt vmcnt(2)" ::: "memory");
      else asm volatile("s_waitcnt vmcnt(0)" ::: "memory");
      asm volatile("s_waitcnt lgkmcnt(0)" ::: "memory");
      __builtin_amdgcn_s_barrier();
      asm volatile("" ::: "memory");
      if (it + 3 < 16) E_STAGE(it + 3);
      const unsigned char* slot = ERING + (it & 3) * 8192 + fr * 512;
#pragma unroll
      for (int ks = 0; ks < 8; ++ks) {
        h16x8 a = *(const h16x8*)(slot + (((ks * 4 + fq) ^ fr) << 4));
        acc = MFMA(a, uf[hf * 8 + ks], acc);
      }
    }
    *(f32x4*)(LOCAL + nchunk * 132 + mt * 16 + fq * 4) = acc;
  }
#undef E_STAGE
  __syncthreads();
  for (int idx = tid; idx < 33 * 256 / 8; idx += 256) *(h16x8*)(KT + idx * 8) = *(const h16x8*)(Kg + idx * 8);
  if (tid < 64) {
    const int pp = tid;
    const float ar = ALPOW[(g * 64 + pp) * 2], ai = ALPOW[(g * 64 + pp) * 2 + 1];
    float sr = 0.f, si = 0.f;
#pragma unroll 4
    for (int c = 0; c < 64; ++c) {
      SPREV[c * 136 + pp] = (h16)sr;
      SPREV[c * 136 + 64 + pp] = (h16)si;
      float lr = LOCAL[c * 132 + pp], li = LOCAL[c * 132 + 64 + pp];
      float nr = ar * sr - ai * si + lr;
      float ni = ar * si + ai * sr + li;
      sr = nr; si = ni;
    }
  }
  asm volatile("s_waitcnt vmcnt(0)" ::: "memory");
  __syncthreads();
  h16x8 sf[4];
#pragma unroll
  for (int ks = 0; ks < 4; ++ks) sf[ks] = *(const h16x8*)(SPREV + nchunk * 136 + ks * 32 + fq * 8);
  const h16* fsrc = Fg + (size_t)(tid >> 4) * 128 + (((tid & 15) ^ (tid >> 4)) << 3);
#define F_STAGE(j_) __builtin_amdgcn_global_load_lds((const unsigned*)(fsrc + (size_t)((j_) < 31 ? (j_) : 31) * 16 * 128), \
                                                     (unsigned*)(FRING + ((j_) & 7) * 4096 + tid * 16), 16, 0, 0)
  F_STAGE(0); F_STAGE(1); F_STAGE(2);
#pragma unroll 1
  for (int j = 0; j < 32; ++j) {
    if (j == 0) asm volatile("s_waitcnt vmcnt(2)" ::: "memory");
    else if (j == 1) asm volatile("s_waitcnt vmcnt(3)" ::: "memory");
    else if (j == 2) asm volatile("s_waitcnt vmcnt(4)" ::: "memory");
    else asm volatile("s_waitcnt vmcnt(5)" ::: "memory");
    asm volatile("s_waitcnt lgkmcnt(0)" ::: "memory");
    __builtin_amdgcn_s_barrier();
    asm volatile("" ::: "memory");
    F_STAGE(j + 3);
    asm volatile("" ::: "memory");
    f32x4 acc = {0.f, 0.f, 0.f, 0.f}, acc2 = {0.f, 0.f, 0.f, 0.f};
#pragma unroll
    for (int ks = 0; ks < 16; ++ks) {
      if (2 * ks <= j) {
        const int dd = j - 2 * ks - (fq >> 1) + 1;
        h16x8 a = *(const h16x8*)(KT + dd * 256 + fr * 16 + (fq & 1) * 8);
        if (ks & 1) acc2 = MFMA(a, uf[ks], acc2); else acc = MFMA(a, uf[ks], acc);
      }
    }
    const unsigned char* slot = FRING + (j & 7) * 4096 + fr * 256;
#pragma unroll
    for (int ks = 0; ks < 4; ++ks) {
      h16x8 a = *(const h16x8*)(slot + (((ks * 4 + fq) ^ fr) << 4));
      if (ks & 1) acc2 = MFMA(a, sf[ks], acc2); else acc = MFMA(a, sf[ks], acc);
    }
    h16x4 o;
    o[0] = (h16)gelu_tanh(acc[0] + acc2[0]);
    o[1] = (h16)gelu_tanh(acc[1] + acc2[1]);
    o[2] = (h16)gelu_tanh(acc[2] + acc2[2]);
    o[3] = (h16)gelu_tanh(acc[3] + acc2[3]);
    *(h16x4*)(YPRE + (tok0 + j) * 512 + g * 16 + fq * 4) = o;
    asm volatile("" ::: "memory");
  }
#undef F_STAGE
  asm volatile("s_waitcnt vmcnt(0)" ::: "memory");
  __syncthreads();
}

__device__ void gdn_pre_item(const Params& p, int item, unsigned char* smem) {
  h16* QH = (h16*)smem;
  h16* KH = (h16*)(smem + 17408);
  h16* VH = (h16*)(smem + 34816);
  float* Ld = (float*)(smem + 52224);
  h16* Limg = (h16*)(smem + 56576);
  h16* Dimg = (h16*)(smem + 60672);
  float* sG = (float*)(smem + 69632);
  float* sBeta = (float*)(smem + 69888);
  float* sEG = (float*)(smem + 70144);
  float* sBG = (float*)(smem + 70400);
  float* sEL = (float*)(smem + 70656);
  int tid_ = threadIdx.x;
  asm volatile("" : "+v"(tid_));
  const int tid = tid_, w = tid >> 6, lane = tid & 63, fr = lane & 15, fq = lane >> 4;
  const int c = item & 31, h = (item >> 5) & 3, b = item >> 7;
  const h16* PROJ = (const h16*)(p.ws + OFF_PROJ);
  const float* AB = (const float*)(p.ws + OFF_AB);
  const float* convw = p.in[I_CONVW];
  h16* WPi = (h16*)(p.ws + OFF_WP) + (size_t)item * 64 * 128;
  h16* QGPi = (h16*)(p.ws + OFF_QGP) + (size_t)item * 64 * 128;
  h16* KDTi = (h16*)(p.ws + OFF_KDT) + (size_t)item * 128 * 64;
  h16* UTi = (h16*)(p.ws + OFF_UT) + (size_t)item * 128 * 64;
  h16* ATPi = (h16*)(p.ws + OFF_ATP) + (size_t)item * 64 * 64;
  h16* ZTi = (h16*)((unsigned char*)p.out + OUT_OFF_ZT) + (size_t)item * 128 * 64;
  float* DL = (float*)(p.ws + OFF_DL);
  {
    const h16x8 z8 = {(h16)0.f, (h16)0.f, (h16)0.f, (h16)0.f, (h16)0.f, (h16)0.f, (h16)0.f, (h16)0.f};
    *(h16x8*)(Limg + tid * 8) = z8; *(h16x8*)(Limg + 2048 + tid * 8) = z8;
  }
  {
    const int ch0 = (tid & 15) * 8, t0 = (tid >> 4) * 4;
#pragma unroll 1
    for (int sec = 0; sec < 3; ++sec) {
      const int colbase = 1024 + sec * 512 + h * 128 + ch0;
      h16x8 xr[7];
#pragma unroll
      for (int i = 0; i < 7; ++i) {
        const int ts = c * 64 + t0 - 3 + i;
        h16x8 z8 = {(h16)0.f, (h16)0.f, (h16)0.f, (h16)0.f, (h16)0.f, (h16)0.f, (h16)0.f, (h16)0.f};
        xr[i] = (ts >= 0) ? *(const h16x8*)(PROJ + ((size_t)b * SEQ + ts) * LDP + colbase) : z8;
      }
      float4 wv[4][2];
#pragma unroll
      for (int jj = 0; jj < 4; ++jj) {
        wv[jj][0] = *(const float4*)(convw + jj * 1536 + sec * 512 + h * 128 + ch0);
        wv[jj][1] = *(const float4*)(convw + jj * 1536 + sec * 512 + h * 128 + ch0 + 4);
      }
      h16* dst = (sec == 0 ? QH : (sec == 1 ? KH : VH));
#pragma unroll
      for (int tt = 0; tt < 4; ++tt) {
        float a[8];
#pragma unroll
        for (int e = 0; e < 8; ++e) a[e] = 0.f;
#pragma unroll
        for (int jj = 0; jj < 4; ++jj) {
          const h16x8 xv = xr[tt + jj];
          a[0] += wv[jj][0].x * (float)xv[0]; a[1] += wv[jj][0].y * (float)xv[1]; a[2] += wv[jj][0].z * (float)xv[2]; a[3] += wv[jj][0].w * (float)xv[3];
          a[4] += wv[jj][1].x * (float)xv[4]; a[5] += wv[jj][1].y * (float)xv[5]; a[6] += wv[jj][1].z * (float)xv[6]; a[7] += wv[jj][1].w * (float)xv[7];
        }
        float ss = 0.f;
#pragma unroll
        for (int e = 0; e < 8; ++e) { a[e] = siluf_(a[e]); ss += a[e] * a[e]; }
        float scale = 1.f;
        if (sec < 2) {
          ss = sum16(ss);
          scale = rsqrtf(ss + 1e-6f) * (sec == 0 ? 0.08838834764831845f : 1.f);
        }
        h16x8 o;
#pragma unroll
        for (int e = 0; e < 8; ++e) o[e] = (h16)(a[e] * scale);
        *(h16x8*)(dst + (t0 + tt) * 136 + ch0) = o;
      }
    }
  }
  if (tid < 64) {
    const size_t tok = (size_t)b * SEQ + c * 64 + tid;
    float braw = AB[tok * 8 + h], araw = AB[tok * 8 + 4 + h];
    float beta = 1.f / (1.f + expf(-braw));
    float xx = araw + p.in[I_DTB][h];
    float sp = xx > 20.f ? xx : log1pf(expf(xx));
    float gg = -expf(p.in[I_ALOG][h]) * sp;
#pragma unroll
    for (int o = 1; o < 64; o <<= 1) {
      float v = __shfl_up(gg, o);
      if (lane >= o) gg += v;
    }
    sG[tid] = gg;
    sBeta[tid] = beta;
    const float eg = expf(gg);
    sEG[tid] = eg;
    sBG[tid] = beta * eg;
    sEL[tid] = expf(__shfl(gg, 63) - gg);
  }
  __syncthreads();
  {
    h16x8 ak[4], aq[4];
#pragma unroll
    for (int ks = 0; ks < 4; ++ks) {
      ak[ks] = *(const h16x8*)(KH + (w * 16 + fr) * 136 + ks * 32 + fq * 8);
      aq[ks] = *(const h16x8*)(QH + (w * 16 + fr) * 136 + ks * 32 + fq * 8);
    }
#pragma unroll
    for (int jt = 0; jt < 4; ++jt) {
      const int j = jt * 16 + fr;
      const int pj = perm_pos(j);
      if (jt <= w) {
        f32x4 kk = {0.f, 0.f, 0.f, 0.f}, qk = {0.f, 0.f, 0.f, 0.f};
#pragma unroll
        for (int ks = 0; ks < 4; ++ks) {
          h16x8 bk = *(const h16x8*)(KH + (jt * 16 + fr) * 136 + ks * 32 + fq * 8);
          kk = MFMA(ak[ks], bk, kk);
          qk = MFMA(aq[ks], bk, qk);
        }
        const float Gj = sG[j];
        f32x4 lt;
#pragma unroll
        for (int r = 0; r < 4; ++r) {
          const int i = w * 16 + 4 * fq + r;
          const float e = (i >= j) ? __expf(sG[i] - Gj) : 0.f;
          lt[r] = (i > j) ? sBeta[i] * kk[r] * e : 0.f;
          ATPi[i * 64 + (((pj >> 3) ^ (i & 7)) << 3) + (pj & 7)] = (h16)(qk[r] * e);
        }
        if (jt == w) {
#pragma unroll
          for (int r = 0; r < 4; ++r) Ld[(w * 16 + 4 * fq + r) * 17 + fr] = lt[r];
        } else {
          const int img = (w == 1) ? 0 : (w == 2 ? 1 : (jt < 2 ? 2 : 3));
#pragma unroll
          for (int r = 0; r < 4; ++r) Limg[img * 512 + (4 * fq + r) * 32 + (fr >> 2) * 8 + (fr & 3) + 4 * (jt & 1)] = (h16)(-lt[r]);
        }
      } else {
#pragma unroll
        for (int r = 0; r < 4; ++r) {
          const int i = w * 16 + 4 * fq + r;
          ATPi[i * 64 + (((pj >> 3) ^ (i & 7)) << 3) + (pj & 7)] = (h16)0.f;
        }
      }
    }
  }
  __syncthreads();
  if (lane < 16) {
    float y[16];
#pragma unroll
    for (int i = 0; i < 16; ++i) {
      float s = (i == lane) ? 1.f : 0.f;
#pragma unroll
      for (int k = 0; k < i; ++k) s -= Ld[(w * 16 + i) * 17 + k] * y[k];
      y[i] = s;
    }
#pragma unroll
    for (int i = 0; i < 16; ++i) Dimg[w * 512 + i * 32 + (lane >> 2) * 8 + (lane & 3)] = (h16)y[i];
  }
  __syncthreads();
  f32x4 xs[4][4];
  {
    const h16* SRC = (w < 2) ? VH : KH;
    const float* scl = (w < 2) ? sBeta : sBG;
    const int cbase = (w & 1) * 64;
    h16x8 dA[4], lA[4];
#pragma unroll
    for (int b4 = 0; b4 < 4; ++b4) {
      dA[b4] = *(const h16x8*)(Dimg + b4 * 512 + fr * 32 + fq * 8);
      lA[b4] = *(const h16x8*)(Limg + b4 * 512 + fr * 32 + fq * 8);
    }
    const f32x4 z4 = {0.f, 0.f, 0.f, 0.f};
#pragma unroll
    for (int nt = 0; nt < 4; ++nt) {
      const int col = cbase + nt * 16 + fr;
      f32x4 rb[4];
#pragma unroll
      for (int b4 = 0; b4 < 4; ++b4)
#pragma unroll
        for (int r = 0; r < 4; ++r) rb[b4][r] = (float)SRC[(b4 * 16 + 4 * fq + r) * 136 + col] * scl[b4 * 16 + 4 * fq + r];
      const f32x4 x0 = MFMA(dA[0], pack8(rb[0], z4), z4);
      const f32x4 a1 = MFMA(lA[0], pack8(x0, z4), rb[1]);
      const f32x4 x1 = MFMA(dA[1], pack8(a1, z4), z4);
      const h16x8 x01 = pack8(x0, x1);
      const f32x4 a2 = MFMA(lA[1], x01, rb[2]);
      const f32x4 x2 = MFMA(dA[2], pack8(a2, z4), z4);
      f32x4 a3 = MFMA(lA[2], x01, rb[3]);
      a3 = MFMA(lA[3], pack8(x2, z4), a3);
      const f32x4 x3 = MFMA(dA[3], pack8(a3, z4), z4);
      xs[nt][0] = x0; xs[nt][1] = x1; xs[nt][2] = x2; xs[nt][3] = x3;
      if (w < 2) {
#pragma unroll
        for (int b4 = 0; b4 < 4; ++b4) {
          h16x4 o; o[0] = (h16)xs[nt][b4][0]; o[1] = (h16)xs[nt][b4][1]; o[2] = (h16)xs[nt][b4][2]; o[3] = (h16)xs[nt][b4][3];
          *(h16x4*)(UTi + (size_t)col * 64 + b4 * 16 + 4 * fq) = o;
        }
      }
    }
  }
  __syncthreads();
  if (w >= 2) {
#pragma unroll
    for (int nt = 0; nt < 4; ++nt) {
      const int pos = perm_pos((w & 1) * 64 + nt * 16 + fr);
#pragma unroll
      for (int b4 = 0; b4 < 4; ++b4)
#pragma unroll
        for (int r = 0; r < 4; ++r) VH[(b4 * 16 + 4 * fq + r) * 136 + pos] = (h16)xs[nt][b4][r];
    }
  }
  __syncthreads();
  for (int rr = 0; rr < 4; ++rr) {
    const int idx = tid + 256 * rr, row = idx >> 4, seg = idx & 15;
    *(h16x8*)(WPi + row * 128 + ((seg ^ (row & 15)) << 3)) = *(const h16x8*)(VH + row * 136 + seg * 8);
  }
  {
    const int dv = tid & 127, th = tid >> 7;
    const float gdv = p.in[I_DNG][dv];
    const h16* zp = PROJ + ((size_t)b * SEQ + c * 64 + th * 32) * LDP + 2560 + h * 128 + dv;
    h16 zv[32];
#pragma unroll
    for (int t = 0; t < 32; ++t) zv[t] = zp[(size_t)t * LDP];
#pragma unroll
    for (int t8 = 0; t8 < 4; ++t8) {
      h16x8 v;
#pragma unroll
      for (int e = 0; e < 8; ++e) v[e] = (h16)(siluf_((float)zv[t8 * 8 + e]) * gdv);
      *(h16x8*)(ZTi + (size_t)dv * 64 + th * 32 + t8 * 8) = v;
    }
  }
#pragma unroll 2
  for (int rr = 0; rr < 4; ++rr) {
    const int idx = tid + 256 * rr, t = idx >> 4, cpos = idx & 15, ks = cpos >> 2, q = cpos & 3;
    const h16x4 lo = *(const h16x4*)(QH + t * 136 + ks * 32 + 4 * q);
    const h16x4 hi = *(const h16x4*)(QH + t * 136 + ks * 32 + 16 + 4 * q);
    const float sc = sEG[t];
    h16x8 o;
#pragma unroll
    for (int e = 0; e < 4; ++e) { o[e] = (h16)((float)lo[e] * sc); o[4 + e] = (h16)((float)hi[e] * sc); }
    *(h16x8*)(QGPi + t * 128 + ((cpos ^ (t & 15)) << 3)) = o;
  }
#pragma unroll 2
  for (int rr = 0; rr < 4; ++rr) {
    const int idx = tid + 256 * rr, dk = idx >> 3, cpos = idx & 7, k2 = cpos >> 2, q = cpos & 3;
    h16x8 o;
#pragma unroll
    for (int e = 0; e < 8; ++e) {
      const int t = k2 * 32 + (e < 4 ? 4 * q + e : 16 + 4 * q + (e - 4));
      o[e] = (h16)((float)KH[t * 136 + dk] * sEL[t]);
    }
    *(h16x8*)(KDTi + dk * 64 + ((cpos ^ (dk & 7)) << 3)) = o;
  }
  const float Glast = sG[63];
  if (tid == 0) DL[item] = expf(Glast);
  __syncthreads();
}

template <int NB>
__device__ __forceinline__ void glds_copy(const h16* __restrict__ g, unsigned char* l) {
#pragma unroll
  for (int i = 0; i < NB / 4096; ++i) {
    const int off = threadIdx.x * 16 + i * 4096;
    __builtin_amdgcn_global_load_lds((const unsigned*)((const unsigned char*)g + off), (unsigned*)(l + off), 16, 0, 0);
  }
}
#define RAW_BARRIER() do { asm volatile("s_waitcnt lgkmcnt(0)" ::: "memory"); __builtin_amdgcn_s_barrier(); asm volatile("" ::: "memory"); } while (0)

__device__ void gdn_chain(const Params& p, int bh, unsigned char* smem) {
  const int tid = threadIdx.x, w = tid >> 6, lane = tid & 63, fr = lane & 15, fq = lane >> 4;
  const float* DL = (const float*)(p.ws + OFF_DL);
  const h16* WPb = (const h16*)(p.ws + OFF_WP) + (size_t)bh * 32 * 64 * 128;
  const h16* KDTb = (const h16*)(p.ws + OFF_KDT) + (size_t)bh * 32 * 128 * 64;
  h16* UTb = (h16*)(p.ws + OFF_UT) + (size_t)bh * 32 * 128 * 64;
  h16* SFb = (h16*)((unsigned char*)p.out + OUT_OFF_SF) + (size_t)bh * 32 * 128 * 128;
  f32x4 S[8][2];
#pragma unroll
  for (int i = 0; i < 8; ++i) { S[i][0] = f32x4{0.f, 0.f, 0.f, 0.f}; S[i][1] = f32x4{0.f, 0.f, 0.f, 0.f}; }
  h16x4 uR[4][2];
  const int uoff = (w * 32 + fr) * 64 + fq * 4;
  glds_copy<16384>(WPb, smem); glds_copy<16384>(KDTb, smem + 16384);
#pragma unroll
  for (int mt = 0; mt < 4; ++mt)
#pragma unroll
    for (int nt = 0; nt < 2; ++nt) uR[mt][nt] = *(const h16x4*)(UTb + uoff + nt * 1024 + mt * 16);
  float dl = DL[bh * 32];
  asm volatile("s_waitcnt vmcnt(0)" ::: "memory");
  RAW_BARRIER();
  for (int c = 0; c < 32; ++c) {
    const int cn = (c + 1 < 32) ? c + 1 : 31;
    const unsigned char* LW = smem + (c & 1) * 32768;
    const unsigned char* LK = LW + 16384;
    unsigned char* LWn = smem + ((c + 1) & 1) * 32768;
    f32x4 uf[4][2];
#pragma unroll
    for (int mt = 0; mt < 4; ++mt)
#pragma unroll
      for (int nt = 0; nt < 2; ++nt)
#pragma unroll
        for (int r = 0; r < 4; ++r) uf[mt][nt][r] = (float)uR[mt][nt][r];
    const float dlc = dl;
    asm volatile("" ::: "memory");
    h16x8 sfr[4][2];
#pragma unroll
    for (int ks = 0; ks < 4; ++ks) { sfr[ks][0] = pack8(S[2 * ks][0], S[2 * ks + 1][0]); sfr[ks][1] = pack8(S[2 * ks][1], S[2 * ks + 1][1]); }
#pragma unroll
    for (int ks = 0; ks < 4; ++ks)
#pragma unroll
      for (int nt = 0; nt < 2; ++nt)
        *(h16x8*)(SFb + ((size_t)(c * 4 + ks) * 8 + w * 2 + nt) * 512 + lane * 8) = sfr[ks][nt];
    glds_copy<16384>(WPb + (size_t)cn * 64 * 128, LWn);
    glds_copy<16384>(KDTb + (size_t)cn * 128 * 64, LWn + 16384);
#pragma unroll
    for (int mt = 0; mt < 4; ++mt)
#pragma unroll
      for (int nt = 0; nt < 2; ++nt)
        uR[mt][nt] = *(const h16x4*)(UTb + (size_t)cn * 128 * 64 + uoff + nt * 1024 + mt * 16);
    dl = DL[bh * 32 + cn];
    asm volatile("" ::: "memory");
    f32x4 vn[4][2];
#pragma unroll
    for (int mt = 0; mt < 4; ++mt) { vn[mt][0] = f32x4{0.f, 0.f, 0.f, 0.f}; vn[mt][1] = vn[mt][0]; }
#pragma unroll
    for (int ks = 0; ks < 4; ++ks)
#pragma unroll
      for (int mt = 0; mt < 4; ++mt) {
        h16x8 aw = *(const h16x8*)(LW + (mt * 16 + fr) * 256 + (((ks * 4 + fq) ^ fr) << 4));
        vn[mt][0] = MFMA(aw, sfr[ks][0], vn[mt][0]);
        vn[mt][1] = MFMA(aw, sfr[ks][1], vn[mt][1]);
      }
#pragma unroll
    for (int mt = 0; mt < 4; ++mt)
#pragma unroll
      for (int r = 0; r < 4; ++r) { vn[mt][0][r] = uf[mt][0][r] - vn[mt][0][r]; vn[mt][1][r] = uf[mt][1][r] - vn[mt][1][r]; }
    h16x8 vfr[2][2];
#pragma unroll
    for (int k2 = 0; k2 < 2; ++k2) { vfr[k2][0] = pack8(vn[2 * k2][0], vn[2 * k2 + 1][0]); vfr[k2][1] = pack8(vn[2 * k2][1], vn[2 * k2 + 1][1]); }
    if (c + 1 < 32) {
#pragma unroll
      for (int k2 = 0; k2 < 2; ++k2)
#pragma unroll
        for (int nt = 0; nt < 2; ++nt)
          *(h16x8*)(UTb + (size_t)c * 128 * 64 + ((size_t)k2 * 8 + w * 2 + nt) * 512 + lane * 8) = vfr[k2][nt];
    }
#pragma unroll
    for (int dkt = 0; dkt < 8; ++dkt) {
      f32x4 s0 = S[dkt][0], s1 = S[dkt][1];
#pragma unroll
      for (int r = 0; r < 4; ++r) { s0[r] *= dlc; s1[r] *= dlc; }
#pragma unroll
      for (int k2 = 0; k2 < 2; ++k2) {
        h16x8 ak = *(const h16x8*)(LK + (dkt * 16 + fr) * 128 + (((k2 * 4 + fq) ^ (fr & 7)) << 4));
        s0 = MFMA(ak, vfr[k2][0], s0);
        s1 = MFMA(ak, vfr[k2][1], s1);
      }
      S[dkt][0] = s0; S[dkt][1] = s1;
    }
    asm volatile("s_waitcnt vmcnt(0)" ::: "memory");
    RAW_BARRIER();
    if (c + 1 == 32) {
#pragma unroll
      for (int k2 = 0; k2 < 2; ++k2)
#pragma unroll
        for (int nt = 0; nt < 2; ++nt)
          *(h16x8*)(UTb + (size_t)c * 128 * 64 + ((size_t)k2 * 8 + w * 2 + nt) * 512 + lane * 8) = vfr[k2][nt];
    }
  }
  asm volatile("s_waitcnt vmcnt(0)" ::: "memory");
  __syncthreads();
}

__device__ void gdn_out_item(const Params& p, int item, unsigned char* smem) {
  unsigned char* LQ = smem;
  unsigned char* LA = smem + 16384;
  float* red = (float*)(smem + 24576);
  const int tid = threadIdx.x, w = tid >> 6, lane = tid & 63, fr = lane & 15, fq = lane >> 4;
  const int c = item & 31, h = (item >> 5) & 3, b = item >> 7;
  h16* MIXIN = (h16*)(p.ws + OFF_MIXIN);
  const h16* QGPi = (const h16*)(p.ws + OFF_QGP) + (size_t)item * 64 * 128;
  const h16* ATPi = (const h16*)(p.ws + OFF_ATP) + (size_t)item * 64 * 64;
  const h16* VFi = (const h16*)(p.ws + OFF_UT) + (size_t)item * 128 * 64;
  const h16* SFi = (const h16*)((unsigned char*)p.out + OUT_OFF_SF) + (size_t)item * 128 * 128;
  const h16* ZTi = (const h16*)((unsigned char*)p.out + OUT_OFF_ZT) + (size_t)item * 128 * 64;
  glds_copy<16384>(QGPi, LQ); glds_copy<8192>(ATPi, LA);
  h16x8 sfr[4][2], vfr[2][2];
#pragma unroll
  for (int ks = 0; ks < 4; ++ks)
#pragma unroll
    for (int nt = 0; nt < 2; ++nt) sfr[ks][nt] = *(const h16x8*)(SFi + ((size_t)ks * 8 + w * 2 + nt) * 512 + lane * 8);
#pragma unroll
  for (int k2 = 0; k2 < 2; ++k2)
#pragma unroll
    for (int nt = 0; nt < 2; ++nt) vfr[k2][nt] = *(const h16x8*)(VFi + ((size_t)k2 * 8 + w * 2 + nt) * 512 + lane * 8);
  h16x4 zR[4][2];
#pragma unroll
  for (int mt = 0; mt < 4; ++mt)
#pragma unroll
    for (int nt = 0; nt < 2; ++nt) zR[mt][nt] = *(const h16x4*)(ZTi + (size_t)(w * 32 + nt * 16 + fr) * 64 + mt * 16 + fq * 4);
  asm volatile("s_waitcnt vmcnt(0)" ::: "memory");
  __syncthreads();
  f32x4 o[4][2];
#pragma unroll
  for (int mt = 0; mt < 4; ++mt) {
    f32x4 o0 = {0.f, 0.f, 0.f, 0.f}, o1 = {0.f, 0.f, 0.f, 0.f};
#pragma unroll
    for (int ks = 0; ks < 4; ++ks) {
      h16x8 aq = *(const h16x8*)(LQ + (mt * 16 + fr) * 256 + (((ks * 4 + fq) ^ fr) << 4));
      o0 = MFMA(aq, sfr[ks][0], o0);
      o1 = MFMA(aq, sfr[ks][1], o1);
    }
#pragma unroll
    for (int k2 = 0; k2 < 2; ++k2) {
      h16x8 aa = *(const h16x8*)(LA + (mt * 16 + fr) * 128 + (((k2 * 4 + fq) ^ (fr & 7)) << 4));
      o0 = MFMA(aa, vfr[k2][0], o0);
      o1 = MFMA(aa, vfr[k2][1], o1);
    }
    o[mt][0] = o0; o[mt][1] = o1;
  }
#pragma unroll
  for (int mt = 0; mt < 4; ++mt)
#pragma unroll
    for (int r = 0; r < 4; ++r) {
      float s = o[mt][0][r] * o[mt][0][r] + o[mt][1][r] * o[mt][1][r];
      s = sum16(s);
      if (fr == 0) red[w * 64 + mt * 16 + 4 * fq + r] = s;
    }
  __syncthreads();
#pragma unroll
  for (int mt = 0; mt < 4; ++mt)
#pragma unroll
    for (int r = 0; r < 4; ++r) {
      const int tl = mt * 16 + 4 * fq + r;
      const float tot = red[tl] + red[64 + tl] + red[128 + tl] + red[192 + tl];
      const float rstd = rsqrtf(tot * (1.f / 128.f) + 1e-6f);
      const size_t tok = (size_t)b * SEQ + c * 64 + tl;
      h16* yp = MIXIN + tok * 1024 + 512 + h * 128 + w * 32 + fr;
      yp[0] = (h16)(o[mt][0][r] * rstd * (float)zR[mt][0][r]);
      yp[16] = (h16)(o[mt][1][r] * rstd * (float)zR[mt][1][r]);
    }
  __syncthreads();
}

#define XB_TMO      128
#define XB_XCNT(j)  (256  + 64 * (j))
#define XB_XSUB(j)  (1280 + 64 * (j))
#define XB_XGEN(j)  (2304 + 64 * (j))
#define XB_TOP      3328
#define XB_TOPGEN   3392
#define XCD_BAR_WORDS 3456
#define XB_SPIN_CAP (1u << 18)
#define LAS __attribute__((address_space(3)))

__device__ __forceinline__ unsigned xb_ld(unsigned* p)              { return __hip_atomic_load(p, __ATOMIC_RELAXED, __HIP_MEMORY_SCOPE_AGENT); }
__device__ __forceinline__ unsigned xb_add(unsigned* p, unsigned v) { return __hip_atomic_fetch_add(p, v, __ATOMIC_RELAXED, __HIP_MEMORY_SCOPE_AGENT); }
__device__ __forceinline__ unsigned xb_xcc_id() { return (unsigned)__builtin_amdgcn_s_getreg((3 << 11) | 20) & 0xFu; }
#define XB_SPIN(cond, bar) do { unsigned _sp = 0; while (cond) { __builtin_amdgcn_s_sleep(1); \
    if ((++_sp & 255u) == 0u) { if (xb_ld(&(bar)[XB_TMO])) break; if (_sp > XB_SPIN_CAP) { atomicAdd(&(bar)[XB_TMO], 1u); break; } } } } while (0)

struct XcdBarrier {
    unsigned* bar; unsigned x;
    volatile LAS unsigned* st;
};

__device__ __forceinline__ XcdBarrier xcd_barrier_post(unsigned* bar, volatile LAS unsigned* st) {
    XcdBarrier b; b.bar = bar; b.x = xb_xcc_id(); b.st = st;
    if (threadIdx.x == 0) (void)xb_add(&bar[XB_XCNT(b.x)], 1u);
    return b;
}
__device__ __forceinline__ void xcd_barrier_complete(unsigned* bar, unsigned x, unsigned& nloc, unsigned& nx) {
    const unsigned G = gridDim.x * gridDim.y * gridDim.z;
    unsigned sum, cnt, mine, sp = 0u;
    for (;;) {
        sum = 0u; cnt = 0u; mine = 0u;
#pragma unroll
        for (unsigned j = 0; j < 16; ++j) { const unsigned c = xb_ld(&bar[XB_XCNT(j)]); sum += c; cnt += (c > 0u) ? 1u : 0u; mine = (j == x) ? c : mine; }
        if (sum == G) break;
        __builtin_amdgcn_s_sleep(1);
        if ((++sp & 255u) == 0u) { if (xb_ld(&bar[XB_TMO])) break; if (sp > XB_SPIN_CAP) { atomicAdd(&bar[XB_TMO], 1u); break; } }
    }
    nloc = mine > 0u ? mine : 1u; nx = cnt > 0u ? cnt : 1u;
}

__device__ __forceinline__ void xcd_barrier(const XcdBarrier& b) {
    asm volatile("s_waitcnt vmcnt(0)" ::: "memory");
    __syncthreads();
    if (threadIdx.x == 0) {
        unsigned* bar = b.bar;
        __builtin_amdgcn_s_waitcnt(0);
        unsigned nloc = b.st[0], nx = b.st[1];
        if (nloc == 0u) { xcd_barrier_complete(bar, b.x, nloc, nx); b.st[0] = nloc; b.st[1] = nx; }
        const unsigned old = xb_add(&bar[XB_XSUB(b.x)], 1u);
        const unsigned gen = old / nloc;
        if (old + 1u == (gen + 1u) * nloc) {
            __builtin_amdgcn_fence(__ATOMIC_RELEASE, "agent");
            asm volatile("s_waitcnt vmcnt(0)" ::: "memory");
            const unsigned og = xb_add(&bar[XB_TOP], 1u);
            const unsigned tg = og / nx;
            if (og + 1u == (tg + 1u) * nx) xb_add(&bar[XB_TOPGEN], 1u);
            else XB_SPIN(xb_ld(&bar[XB_TOPGEN]) == tg, bar);
            __builtin_amdgcn_fence(__ATOMIC_ACQUIRE, "agent");
            xb_add(&bar[XB_XGEN(b.x)], 1u);
            asm volatile("s_waitcnt vmcnt(0)" ::: "memory");
        } else {
            XB_SPIN(xb_ld(&bar[XB_XGEN(b.x)]) == gen, bar);
            __builtin_amdgcn_fence(__ATOMIC_ACQUIRE, "agent");
            asm volatile("s_waitcnt vmcnt(0)" ::: "memory");
        }
    }
    __syncthreads();
}

#ifndef ONLY_PH
#define ONLY_PH -1
#endif
#define RUNPH(n) ((ONLY_PH < 0 || ONLY_PH == (n)) && p.ph_lo <= (n) && (n) <= p.ph_hi)
#define SYNCPH(n) do { if (p.ph_lo <= (n) && (n) < p.ph_hi) xcd_barrier(xb); } while (0)
__global__ void __launch_bounds__(256, 2) hymba_mega(Params p) {
  __shared__ __attribute__((aligned(16))) unsigned char smem[SMEM_BYTES];
  cg::grid_group grid = cg::this_grid();
  const int bid = blockIdx.x, nb = gridDim.x;
  if (p.ph_lo < 0) grid.sync();
  XcdBarrier xb;
  {
    volatile LAS unsigned* st = (volatile LAS unsigned*)(smem + SMEM_BYTES - 16);
    if (threadIdx.x == 0) { st[0] = 0u; st[1] = 0u; st[2] = 0u; st[3] = 0u; }
    __syncthreads();
    if (p.ph_lo < p.ph_hi) xb = xcd_barrier_post((unsigned*)(p.ws + OFF_BAR), st);
    else { xb.bar = (unsigned*)(p.ws + OFF_BAR); xb.x = 0; xb.st = st; }
  }
  {
    if (RUNPH(0)) for (int rep = 0; rep < REP0; ++rep) {
      if (rep) grid.sync();
      phase0(p, smem);
    }
    SYNCPH(0);
    if (RUNPH(1)) for (int rep = 0; rep < REP1; ++rep) {
      if (rep) grid.sync();
      const h16* A0 = (const h16*)((unsigned char*)p.out + OUT_OFF_A0);
      const h16* W = (const h16*)(p.ws + OFF_WIN);
      const int xl = bid & 7, nxb = nb >> 3;
      if (nb & 7) { for (int t = bid; t < 256 * 25; t += nb) gemm_tile<EPI_PROJ>(p, A0, 1024, W, 1024, 1024, (t / 25) * 128, (t % 25) * 128, smem); }
      else for (int u = bid >> 3; u < 800; u += nxb) {
        const int mb = u / 200, v = u % 200;
        gemm_tile<EPI_PROJ>(p, A0, 1024, W, 1024, 1024, (xl * 32 + mb * 8 + (v & 7)) * 128, (v >> 3) * 128, smem);
      }
    }
    SYNCPH(1);
    if (RUNPH(2)) for (int rep = 0; rep < REP2; ++rep) {
      if (rep) grid.sync();
      for (int it = bid; it < 512 + 2048; it += nb) {
        if (it < 2048) gdn_pre_item(p, it, smem);
        else ssm_item(p, (it - 2048) >> 5, (it - 2048) & 31, smem);
      }
    }
    SYNCPH(2);
    if (RUNPH(3)) {
      if (bid < 64) gdn_chain(p, bid, smem);
      const int xl = bid & 7;
      unsigned* ctr = (unsigned*)(p.ws + OFF_CTR) + xl * 16;
      volatile int* bc = (volatile int*)(smem + SMEM_BYTES - 4);
      const h16* YPRE = (const h16*)((unsigned char*)p.out + OUT_OFF_YPRE);
      for (;;) {
        __syncthreads();
        if (threadIdx.x == 0) *bc = (int)atomicAdd(ctr, 1u);
        __syncthreads();
        const int u = *bc;
        if (u >= 128 + 256) break;
        if (u < 128) gemm_tile<EPI_GLU>(p, YPRE, 512, (const h16*)(p.ws + OFF_WGLU), 512, 512, (xl * 32 + (u >> 2)) * 128, (u & 3) * 128, smem);
        else gemm_tile<EPI_PLE>(p, (const h16*)(p.ws + OFF_PB), 256, (const h16*)(p.ws + OFF_WPP), 256, 256, (xl * 32 + ((u - 128) >> 3)) * 128, ((u - 128) & 7) * 128, smem);
      }
    }
    SYNCPH(3);
    if (RUNPH(4)) {
      for (int it = bid; it < 2048; it += nb) gdn_out_item(p, it, smem);
    }
    SYNCPH(4);
    if (RUNPH(5)) {
      const int xl = bid & 7, nxb = nb >> 3;
      if (nb & 7) { for (int t = bid; t < 2048; t += nb) gemm_tile<EPI_OUT>(p, (const h16*)(p.ws + OFF_MIXIN), 1024, (const h16*)(p.ws + OFF_WOUT), 1024, 1024, (t >> 3) * 128, (t & 7) * 128, smem); }
      else for (int u = bid >> 3; u < 256; u += nxb)
        gemm_tile<EPI_OUT>(p, (const h16*)(p.ws + OFF_MIXIN), 1024, (const h16*)(p.ws + OFF_WOUT), 1024, 1024, (xl * 32 + (u >> 6) * 8 + (u & 7)) * 128, ((u >> 3) & 7) * 128, smem);
    }
    SYNCPH(5);
    if (RUNPH(6)) {
      const int xl = bid & 7, nxb = nb >> 3;
      if (nb & 7) { for (int t = bid; t < 2048; t += nb) gemm_tile<EPI_GATE>(p, (const h16*)(p.ws + OFF_PROJ), 1024, (const h16*)(p.ws + OFF_WGATE), 1024, 1024, (t >> 3) * 128, (t & 7) * 128, smem); }
      else for (int u = bid >> 3; u < 256; u += nxb)
        gemm_tile<EPI_GATE>(p, (const h16*)(p.ws + OFF_PROJ), 1024, (const h16*)(p.ws + OFF_WGATE), 1024, 1024, (xl * 32 + (u >> 6) * 8 + (u & 7)) * 128, ((u >> 3) & 7) * 128, smem);
    }
    SYNCPH(6);
    if (RUNPH(7)) {
      const int wid = threadIdx.x >> 6, lane = threadIdx.x & 63;
      const float* OPART = (const float*)(p.ws + OFF_OPART);
      const float4* g4 = (const float4*)p.in[I_FING];
      const h16* H2B = (const h16*)(p.ws + OFF_MIXIN);
      for (int row = bid * 4 + wid; row < T_TOK; row += nb * 4) {
        float s = (lane < 8) ? OPART[(size_t)row * 8 + lane] : 0.f;
        const h16x8 a = *(const h16x8*)(H2B + (size_t)row * 1024 + lane * 8);
        const h16x8 b = *(const h16x8*)(H2B + (size_t)row * 1024 + 512 + lane * 8);
        s = wave_sum(s);
        const float rstd = rsqrtf(s * (1.f / 1024.f) + 1e-6f);
        float4* orow = (float4*)(p.out + (size_t)row * 1024);
        const float4 g0 = g4[lane * 2], g1 = g4[lane * 2 + 1], g2 = g4[128 + lane * 2], g3 = g4[128 + lane * 2 + 1];
        float4 o0, o1, o2, o3;
        o0.x = (float)a[0] * rstd * g0.x; o0.y = (float)a[1] * rstd * g0.y; o0.z = (float)a[2] * rstd * g0.z; o0.w = (float)a[3] * rstd * g0.w;
        o1.x = (float)a[4] * rstd * g1.x; o1.y = (float)a[5] * rstd * g1.y; o1.z = (float)a[6] * rstd * g1.z; o1.w = (float)a[7] * rstd * g1.w;
        o2.x = (float)b[0] * rstd * g2.x; o2.y = (float)b[1] * rstd * g2.y; o2.z = (float)b[2] * rstd * g2.z; o2.w = (float)b[3] * rstd * g2.w;
        o3.x = (float)b[4] * rstd * g3.x; o3.y = (float)b[5] * rstd * g3.y; o3.z = (float)b[6] * rstd * g3.z; o3.w = (float)b[7] * rstd * g3.w;
        orow[lane * 2] = o0; orow[lane * 2 + 1] = o1; orow[128 + lane * 2] = o2; orow[128 + lane * 2 + 1] = o3;
      }
    }
  }
}

extern "C" void kernel_launch(void* const* d_in, const int* in_sizes, int n_in, void* d_out, int out_size, void* d_ws, size_t ws_size,
                              hipStream_t stream) {
  static int grid_blocks = 0;
  if (!grid_blocks) {
    int dev = 0, cus = 0, per_cu = 0;
    hipGetDevice(&dev);
    hipDeviceGetAttribute(&cus, hipDeviceAttributeMultiprocessorCount, dev);
    hipOccupancyMaxActiveBlocksPerMultiprocessor(&per_cu, hymba_mega, 256, 0);
    if (per_cu > 2) per_cu = 2;
    if (per_cu < 1) per_cu = 1;
    grid_blocks = cus * per_cu;
  }
  if (n_in != 23 || ws_size < WS_END || out_size != T_TOK * 1024) {
    fprintf(stderr, "kernel_launch: unexpected sizes n_in=%d ws=%zu (need %zu) out=%d\n", n_in, ws_size, (size_t)WS_END, out_size);
    return;
  }
  Params p{};
  for (int i = 0; i < 23; ++i) p.in[i] = (const float*)d_in[i];
  p.out = (float*)d_out;
  p.ws = (unsigned char*)d_ws;
  if (hipMemsetAsync((unsigned char*)d_ws + OFF_BAR, 0, 16384, stream) != hipSuccess) { fprintf(stderr, "kernel_launch: memset of control words failed\n"); return; }
#if MULTI_LAUNCH
  for (int ph = 0; ph < NPH; ++ph) {
    p.ph_lo = ph; p.ph_hi = ph;
    hipLaunchKernelGGL(hymba_mega, dim3(grid_blocks), dim3(256), 0, stream, p);
  }
#else
  p.ph_lo = 0; p.ph_hi = NPH - 1;
  void* args[] = {&p};
  hipError_t e = hipLaunchCooperativeKernel((void*)hymba_mega, dim3(grid_blocks), dim3(256), args, 0, stream);
  if (e != hipSuccess) fprintf(stderr, "cooperative launch failed: %s (grid %d)\n", hipGetErrorString(e), grid_blocks);
#endif
}
```

```cpp
#include <hip/hip_runtime.h>
#include <hip/hip_cooperative_groups.h>
#include <cstdio>
namespace cg = cooperative_groups;

#ifndef REP0
#define REP0 1
#endif
#ifndef REP1
#define REP1 1
#endif
#ifndef REP2
#define REP2 1
#endif
#ifndef REP3
#define REP3 1
#endif
#ifndef REP4
#define REP4 1
#endif
#ifndef MULTI_LAUNCH
#define MULTI_LAUNCH 0
#endif

typedef _Float16 h16;
typedef __attribute__((ext_vector_type(8))) _Float16 h16x8;
typedef __attribute__((ext_vector_type(4))) _Float16 h16x4;
typedef __attribute__((ext_vector_type(4))) float f32x4;
typedef __attribute__((ext_vector_type(2))) float v2f;

#define MFMA(a, b, c) __builtin_amdgcn_mfma_f32_16x16x32_f16((a), (b), (c), 0, 0, 0)

constexpr int T_TOK = 32768;
constexpr int SEQ = 2048;
constexpr int NPH = 9;
constexpr int LDP = 3072;
constexpr int SMEM_BYTES = 72704;

constexpr size_t SZ_WIN = (size_t)3200 * 1024 * 2;
constexpr size_t SZ_WGLU = (size_t)512 * 512 * 2;
constexpr size_t SZ_WOUT = (size_t)1024 * 1024 * 2;
constexpr size_t SZ_WPP = (size_t)1024 * 256 * 2;
constexpr size_t SZ_WGATE = (size_t)1024 * 1024 * 2;
constexpr size_t OFF_WIN = 0;
constexpr size_t OFF_WGLU = OFF_WIN + SZ_WIN;
constexpr size_t OFF_WOUT = OFF_WGLU + SZ_WGLU;
constexpr size_t OFF_WPP = OFF_WOUT + SZ_WOUT;
constexpr size_t OFF_WGATE = OFF_WPP + SZ_WPP;
constexpr size_t OFF_PB = OFF_WGATE + SZ_WGATE;
constexpr size_t OFF_PROJ = OFF_PB + (size_t)T_TOK * 256 * 2;
constexpr size_t OFF_AB = OFF_PROJ + (size_t)T_TOK * LDP * 2;
constexpr size_t OFF_KTAB = OFF_AB + (size_t)T_TOK * 8 * 4;
constexpr size_t OFF_ETAB = OFF_KTAB + (size_t)32 * 33 * 256 * 2;
constexpr size_t OFF_FTAB = OFF_ETAB + (size_t)32 * 128 * 512 * 2;
constexpr size_t OFF_ALPOW = OFF_FTAB + (size_t)32 * 512 * 128 * 2;
constexpr size_t OFF_DL = OFF_ALPOW + (size_t)32 * 64 * 2 * 4;
constexpr size_t OFF_EPART = OFF_DL + (size_t)2048 * 4;
constexpr size_t OFF_OPART = OFF_EPART + (size_t)T_TOK * 16 * 4;
constexpr size_t OFF_MIXIN = OFF_OPART + (size_t)T_TOK * 16 * 4;
constexpr size_t OFF_WP = OFF_MIXIN + (size_t)T_TOK * 1024 * 2;
constexpr size_t OFF_QGP = OFF_WP + (size_t)2048 * 64 * 128 * 2;
constexpr size_t OFF_KDT = OFF_QGP + (size_t)2048 * 64 * 128 * 2;
constexpr size_t OFF_UT = OFF_KDT + (size_t)2048 * 128 * 64 * 2;
constexpr size_t OFF_ATP = OFF_UT + (size_t)2048 * 128 * 64 * 2;
constexpr size_t OFF_EH = OFF_ATP + (size_t)2048 * 64 * 64 * 2;
constexpr size_t OFF_US = OFF_EH;
constexpr size_t OFF_LOCALG = OFF_EH + (size_t)32 * T_TOK * 16 * 2;
constexpr size_t OFF_BAR = OFF_EH + (size_t)T_TOK * 1024 * 2;
constexpr size_t WS_END = OFF_BAR + 16384;
constexpr size_t OFF_CTR = OFF_BAR + 15360;
constexpr size_t OUT_OFF_A0 = 0;
constexpr size_t OUT_OFF_SF = 0;
constexpr size_t OUT_OFF_YPRE = (size_t)T_TOK * 1024 * 2;
constexpr size_t OUT_OFF_ZT = OUT_OFF_YPRE + (size_t)T_TOK * 512 * 2;

struct Params {
  const float* in[23];
  float* out;
  unsigned char* ws;
  int ph_lo, ph_hi;
};

enum { I_X = 0, I_P, I_NMG, I_WIN, I_ARE, I_AIM, I_BRE, I_BIM, I_CRE, I_CIM, I_D, I_LOGDT, I_WGLU, I_BGLU,
       I_CONVW, I_ALOG, I_DTB, I_DNG, I_WOUT, I_WPP, I_PLEG, I_WGATE, I_FING };

__device__ __forceinline__ float wave_sum(float v) {
#pragma unroll
  for (int o = 32; o > 0; o >>= 1) v += __shfl_xor(v, o);
  return v;
}
__device__ __forceinline__ float sum16(float v) {
  v += __shfl_xor(v, 1); v += __shfl_xor(v, 2); v += __shfl_xor(v, 4); v += __shfl_xor(v, 8);
  return v;
}
__device__ __forceinline__ float sigmoidf_(float x) { return __builtin_amdgcn_rcpf(1.f + __expf(-x)); }
__device__ __forceinline__ float siluf_(float x) { return x * __builtin_amdgcn_rcpf(1.f + __expf(-x)); }
__device__ __forceinline__ float gelu_tanh(float y) {
  float z = 0.7978845608028654f * (y + 0.044715f * y * y * y);
  return y * __builtin_amdgcn_rcpf(1.f + __expf(-2.f * z));
}
__device__ __forceinline__ h16x8 pack8(f32x4 lo, f32x4 hi) {
  h16x8 r;
  r[0] = (h16)lo[0]; r[1] = (h16)lo[1]; r[2] = (h16)lo[2]; r[3] = (h16)lo[3];
  r[4] = (h16)hi[0]; r[5] = (h16)hi[1]; r[6] = (h16)hi[2]; r[7] = (h16)hi[3];
  return r;
}
__device__ __forceinline__ int perm_pos(int n) { return (n & ~31) + (((n & 15) >> 2) << 3) + (((n >> 4) & 1) << 2) + (n & 3); }
__device__ __forceinline__ int perm_inv(int pos) {
  int q5 = pos & 31, qq = q5 >> 3, jj = q5 & 7;
  return (pos & ~31) + (jj < 4 ? 4 * qq + jj : 16 + 4 * qq + (jj - 4));
}

__device__ void transpose_w(const float* __restrict__ W, int K, int N, int Npad, h16* __restrict__ WT, int t, float* tile) {
  const int ntn = Npad / 64;
  const int kt = t / ntn, nt = t % ntn, k0 = kt * 64, n0 = nt * 64;
  const int tx = threadIdx.x & 63, ty = threadIdx.x >> 6;
  for (int r = 0; r < 16; ++r) {
    int k = ty * 16 + r, n = n0 + tx;
    tile[k * 65 + tx] = (n < N) ? W[(size_t)(k0 + k) * N + n] : 0.f;
  }
  __syncthreads();
  for (int r = 0; r < 16; ++r) {
    int n = ty * 16 + r;
    WT[(size_t)(n0 + n) * K + k0 + tx] = (h16)tile[tx * 65 + n];
  }
  __syncthreads();
}

__device__ void ssm_table_item(const Params& p, int g, int d, float* lds) {
  float2* sAp = (float2*)lds;
  float2* sW = sAp + 64;
  const int tid = threadIdx.x;
  h16* KTAB = (h16*)(p.ws + OFF_KTAB);
  h16* ETAB = (h16*)(p.ws + OFF_ETAB);
  h16* FTAB = (h16*)(p.ws + OFF_FTAB);
  float* ALPOW = (float*)(p.ws + OFF_ALPOW);
  float* sBr = lds + 256; float* sBi = sBr + 1024; float* sCr = sBi + 1024; float* sCi = sCr + 16 * 65;
  {
    const float4 vbr = ((const float4*)(p.in[I_BRE] + g * 1024))[tid], vbi = ((const float4*)(p.in[I_BIM] + g * 1024))[tid];
    const float4 vcr = ((const float4*)(p.in[I_CRE] + g * 1024))[tid], vci = ((const float4*)(p.in[I_CIM] + g * 1024))[tid];
    *(float4*)(sBr + tid * 4) = vbr; *(float4*)(sBi + tid * 4) = vbi;
    const int ch = (tid * 4) >> 6, cp = (tid * 4) & 63;
    sCr[ch * 65 + cp] = vcr.x; sCr[ch * 65 + cp + 1] = vcr.y; sCr[ch * 65 + cp + 2] = vcr.z; sCr[ch * 65 + cp + 3] = vcr.w;
    sCi[ch * 65 + cp] = vci.x; sCi[ch * 65 + cp + 1] = vci.y; sCi[ch * 65 + cp + 2] = vci.z; sCi[ch * 65 + cp + 3] = vci.w;
  }
  if (tid < 64) {
    const int pp = tid;
    float lr = p.in[I_ARE][g * 64 + pp], li = p.in[I_AIM][g * 64 + pp], dt = expf(p.in[I_LOGDT][g]);
    float mag = expf(lr * dt), ang = li * dt;
    float abr = mag * cosf(ang), abi = mag * sinf(ang);
    float nr = abr - 1.f, ni = abi, den = lr * lr + li * li;
    float cr = (nr * lr + ni * li) / den, ci = (ni * lr - nr * li) / den;
    float apr = 1.f, api = 0.f;
    for (int k = 0; k < d; ++k) { float t0 = apr * abr - api * abi; api = apr * abi + api * abr; apr = t0; }
    sAp[pp] = make_float2(apr, api);
    sW[pp] = make_float2(apr * cr - api * ci, apr * ci + api * cr);
    if (d == 32) { ALPOW[(g * 64 + pp) * 2] = apr; ALPOW[(g * 64 + pp) * 2 + 1] = api; }
  }
  __syncthreads();
  if (d < 32) {
    {
      const int h = tid >> 4, hp = tid & 15;
      float acc = 0.f;
#pragma unroll 8
      for (int pp = 0; pp < 64; ++pp) {
        float2 W = sW[pp];
        float br = sBr[pp * 16 + hp], bi = sBi[pp * 16 + hp];
        float wbr = W.x * br - W.y * bi, wbi = W.x * bi + W.y * br;
        float cr = sCr[h * 65 + pp], ci = sCi[h * 65 + pp];
        acc += cr * wbr - ci * wbi;
      }
      if (d == 0 && h == hp) acc += p.in[I_D][g * 16 + h];
      KTAB[(size_t)(g * 33 + d + 1) * 256 + h * 16 + hp] = (h16)acc;
      if (d == 0) KTAB[(size_t)(g * 33) * 256 + tid] = (h16)0.f;
    }
    {
      const int i = 31 - d;
#pragma unroll
      for (int r = 0; r < 4; ++r) {
        int idx = tid + 256 * r, pp = idx >> 4, hp = idx & 15;
        float2 W = sW[pp];
        float br = sBr[pp * 16 + hp], bi = sBi[pp * 16 + hp];
        float wbr = W.x * br - W.y * bi, wbi = W.x * bi + W.y * br;
        ETAB[((size_t)g * 128 + pp) * 512 + i * 16 + hp] = (h16)wbr;
        ETAB[((size_t)g * 128 + 64 + pp) * 512 + i * 16 + hp] = (h16)wbi;
      }
    }
  }
  if (d >= 1) {
    const int j = d - 1;
#pragma unroll
    for (int r = 0; r < 4; ++r) {
      int idx = tid + 256 * r, h = idx >> 6, pp = idx & 63;
      float2 Ap = sAp[pp];
      float cr = sCr[h * 65 + pp], ci = sCi[h * 65 + pp];
      float re = cr * Ap.x - ci * Ap.y, im = cr * Ap.y + ci * Ap.x;
      FTAB[((size_t)g * 512 + j * 16 + h) * 128 + pp] = (h16)re;
      FTAB[((size_t)g * 512 + j * 16 + h) * 128 + 64 + pp] = (h16)(-im);
    }
  }
  __syncthreads();
}

__device__ void phase0(const Params& p, unsigned char* smem) {
  const int bid = blockIdx.x, nb = gridDim.x, tid = threadIdx.x, wid = tid >> 6, lane = tid & 63;
  float* tile = (float*)smem;
  for (int t = bid; t < 1440; t += nb) {
    if (t < 800) transpose_w(p.in[I_WIN], 1024, 3080, 3200, (h16*)(p.ws + OFF_WIN), t, tile);
    else if (t < 864) transpose_w(p.in[I_WGLU], 512, 512, 512, (h16*)(p.ws + OFF_WGLU), t - 800, tile);
    else if (t < 1120) transpose_w(p.in[I_WOUT], 1024, 1024, 1024, (h16*)(p.ws + OFF_WOUT), t - 864, tile);
    else if (t < 1184) transpose_w(p.in[I_WPP], 256, 1024, 1024, (h16*)(p.ws + OFF_WPP), t - 1120, tile);
    else transpose_w(p.in[I_WGATE], 1024, 1024, 1024, (h16*)(p.ws + OFF_WGATE), t - 1184, tile);
  }
  for (int it = bid; it < 32 * 33; it += nb) ssm_table_item(p, it / 33, it % 33, (float*)smem);
  {
    h16* A0 = (h16*)((unsigned char*)p.out + OUT_OFF_A0);
    const float* x = p.in[I_X];
    const float4* g4 = (const float4*)p.in[I_NMG];
    for (int row = bid * 4 + wid; row < T_TOK; row += nb * 4) {
      const float4* xr = (const float4*)(x + (size_t)row * 1024);
      float4 v[4];
      float ss = 0.f;
#pragma unroll
      for (int i = 0; i < 4; ++i) {
        v[i] = xr[lane + i * 64];
        ss += v[i].x * v[i].x + v[i].y * v[i].y + v[i].z * v[i].z + v[i].w * v[i].w;
      }
      ss = wave_sum(ss);
      float rstd = rsqrtf(ss * (1.f / 1024.f) + 1e-6f);
#pragma unroll
      for (int i = 0; i < 4; ++i) {
        float4 g = g4[lane + i * 64];
        h16x4 o;
        o[0] = (h16)(v[i].x * rstd * g.x); o[1] = (h16)(v[i].y * rstd * g.y);
        o[2] = (h16)(v[i].z * rstd * g.z); o[3] = (h16)(v[i].w * rstd * g.w);
        *(h16x4*)(A0 + (size_t)row * 1024 + (lane + i * 64) * 4) = o;
      }
    }
  }
  {
    h16* PB = (h16*)(p.ws + OFF_PB);
    const float4* p4 = (const float4*)p.in[I_P];
    const size_t n4 = (size_t)T_TOK * 256 / 4;
    for (size_t i = (size_t)bid * 256 + tid; i < n4; i += (size_t)nb * 256) {
      float4 v = p4[i];
      h16x4 o;
      o[0] = (h16)v.x; o[1] = (h16)v.y; o[2] = (h16)v.z; o[3] = (h16)v.w;
      *(h16x4*)(PB + i * 4) = o;
    }
  }
}

enum { EPI_PROJ = 0, EPI_GLU, EPI_PLE, EPI_OUT, EPI_GATE, EPI_LOCAL };

template <int EPI>
__device__ __forceinline__ void gemm_tile(const Params& p, const h16* __restrict__ A, int lda, const h16* __restrict__ Bt, int ldb,
                                          int K, int brow, int bcol, unsigned char* smem) {
  const int tid = threadIdx.x, wid = tid >> 6, lane = tid & 63, wr = wid >> 1, wc = wid & 1, fr = lane & 15, fq = lane >> 4;
  f32x4 acc[4][4];
#pragma unroll
  for (int m = 0; m < 4; ++m)
#pragma unroll
    for (int n = 0; n < 4; ++n) acc[m][n] = f32x4{0.f, 0.f, 0.f, 0.f};
  const int nk = K / 64;
  const h16* ga[4]; const h16* gb[4];
#pragma unroll
  for (int i = 0; i < 4; ++i) {
    const int L = tid + 256 * i, row = L >> 3, cs = (L & 7) ^ (row & 7);
    ga[i] = A + (size_t)(brow + row) * lda + cs * 8;
    gb[i] = Bt + (size_t)(bcol + row) * ldb + cs * 8;
  }
#define GEMM_STAGE(t_, buf_) do { \
    unsigned char* sa_ = smem + (buf_) * 32768 + tid * 16; \
    _Pragma("unroll") for (int i_ = 0; i_ < 4; ++i_) { \
      __builtin_amdgcn_global_load_lds((const unsigned*)(ga[i_] + (t_) * 64), (unsigned*)(sa_ + i_ * 4096), 16, 0, 0); \
      __builtin_amdgcn_global_load_lds((const unsigned*)(gb[i_] + (t_) * 64), (unsigned*)(sa_ + 16384 + i_ * 4096), 16, 0, 0); \
    } \
  } while (0)
  GEMM_STAGE(0, 0);
  for (int t = 0; t < nk; ++t) {
    asm volatile("s_waitcnt vmcnt(0)" ::: "memory");
    __syncthreads();
    if (t + 1 < nk) GEMM_STAGE(t + 1, (t + 1) & 1);
    const unsigned char* SA = smem + (t & 1) * 32768;
    const unsigned char* SB = SA + 16384;
#pragma unroll
    for (int kk = 0; kk < 2; ++kk) {
      h16x8 af[4], bf[4];
      const int pos = ((kk * 4 + fq) ^ (fr & 7)) << 4;
#pragma unroll
      for (int m = 0; m < 4; ++m) {
        af[m] = *(const h16x8*)(SA + (wr * 64 + m * 16 + fr) * 128 + pos);
        bf[m] = *(const h16x8*)(SB + (wc * 64 + m * 16 + fr) * 128 + pos);
      }
#pragma unroll
      for (int m = 0; m < 4; ++m)
#pragma unroll
        for (int n = 0; n < 4; ++n) acc[m][n] = MFMA(af[m], bf[n], acc[m][n]);
    }
  }
#undef GEMM_STAGE
  __syncthreads();
  float* CT = (float*)smem;
  const int c4 = tid & 31, col = bcol + c4 * 4, r0 = tid >> 5;
  float4 pre_f[16];
  h16x4 pre_a[16], pre_b[16];
  float4 cst = {0.f, 0.f, 0.f, 0.f};
  if constexpr (EPI == EPI_OUT) {
#pragma unroll
    for (int it = 0; it < 16; ++it) pre_f[it] = *(const float4*)(p.in[I_X] + ((size_t)brow + it * 8 + r0) * 1024 + col);
  } else if constexpr (EPI == EPI_GLU) {
    cst = *(const float4*)(p.in[I_BGLU] + col);
#pragma unroll
    for (int it = 0; it < 16; ++it) {
      const size_t row = (size_t)brow + it * 8 + r0;
      pre_a[it] = *(const h16x4*)((const h16*)((unsigned char*)p.out + OUT_OFF_YPRE) + row * 512 + col);
      pre_b[it] = *(const h16x4*)((const h16*)(p.ws + OFF_PROJ) + row * LDP + 512 + col);
    }
  } else if constexpr (EPI == EPI_GATE) {
    cst = *(const float4*)(p.in[I_PLEG] + col);
#pragma unroll
    for (int it = 0; it < 16; ++it) {
      const size_t row = (size_t)brow + it * 8 + r0;
      pre_a[it] = *(const h16x4*)((const h16*)(p.ws + OFF_EH) + row * 1024 + col);
      pre_b[it] = *(const h16x4*)((const h16*)(p.ws + OFF_PROJ) + row * 1024 + col);
    }
    if (tid < 128) {
      const float4 e0 = *(const float4*)((const float*)(p.ws + OFF_EPART) + ((size_t)brow + tid) * 8);
      const float4 e1 = *(const float4*)((const float*)(p.ws + OFF_EPART) + ((size_t)brow + tid) * 8 + 4);
      ((float*)(smem + 67584))[tid] = rsqrtf((e0.x + e0.y + e0.z + e0.w + e1.x + e1.y + e1.z + e1.w) * (1.f / 1024.f) + 1e-6f);
    }
  }
#pragma unroll
  for (int m = 0; m < 4; ++m)
#pragma unroll
    for (int n = 0; n < 4; ++n)
#pragma unroll
      for (int j = 0; j < 4; ++j) CT[(wr * 64 + m * 16 + fq * 4 + j) * 132 + wc * 64 + n * 16 + fr] = acc[m][n][j];
  __syncthreads();
#pragma unroll
  for (int it = 0; it < 16; ++it) {
    const int rl = it * 8 + r0;
    const size_t row = (size_t)brow + rl;
    const float4 v = *(const float4*)(CT + rl * 132 + c4 * 4);
    if constexpr (EPI == EPI_PROJ) {
      if (bcol < 512) {
        h16x4 o; o[0] = (h16)v.x; o[1] = (h16)v.y; o[2] = (h16)v.z; o[3] = (h16)v.w;
        *(h16x4*)((h16*)(p.ws + OFF_US) + ((size_t)(col >> 4) * T_TOK + row) * 16 + (col & 15)) = o;
      } else if (bcol < 3072) {
        h16x4 o; o[0] = (h16)v.x; o[1] = (h16)v.y; o[2] = (h16)v.z; o[3] = (h16)v.w;
        *(h16x4*)((h16*)(p.ws + OFF_PROJ) + row * LDP + col) = o;
      } else if (c4 < 2) {
        *(float4*)((float*)(p.ws + OFF_AB) + row * 8 + c4 * 4) = v;
      }
    } else if constexpr (EPI == EPI_LOCAL) {
      *(float4*)((float*)(p.ws + OFF_LOCALG) + row * 128 + col) = v;
    } else if constexpr (EPI == EPI_GLU) {
      const h16x4 y = pre_a[it], z = pre_b[it];
      h16x4 o;
      o[0] = (h16)((float)y[0] * sigmoidf_(v.x + cst.x) * siluf_((float)z[0]));
      o[1] = (h16)((float)y[1] * sigmoidf_(v.y + cst.y) * siluf_((float)z[1]));
      o[2] = (h16)((float)y[2] * sigmoidf_(v.z + cst.z) * siluf_((float)z[2]));
      o[3] = (h16)((float)y[3] * sigmoidf_(v.w + cst.w) * siluf_((float)z[3]));
      *(h16x4*)((h16*)(p.ws + OFF_MIXIN) + row * 1024 + col) = o;
    } else if constexpr (EPI == EPI_PLE) {
      h16x4 o; o[0] = (h16)v.x; o[1] = (h16)v.y; o[2] = (h16)v.z; o[3] = (h16)v.w;
      *(h16x4*)((h16*)(p.ws + OFF_EH) + row * 1024 + col) = o;
      float s = v.x * v.x + v.y * v.y + v.z * v.z + v.w * v.w;
      s = sum16(s); s += __shfl_xor(s, 16);
      if (c4 == 0) ((float*)(p.ws + OFF_EPART))[row * 8 + (bcol >> 7)] = s;
    } else if constexpr (EPI == EPI_OUT) {
      const float4 xv = pre_f[it];
      h16x4 o; o[0] = (h16)(xv.x + v.x); o[1] = (h16)(xv.y + v.y); o[2] = (h16)(xv.z + v.z); o[3] = (h16)(xv.w + v.w);
      *(h16x4*)((h16*)(p.ws + OFF_PROJ) + row * 1024 + col) = o;
    } else if constexpr (EPI == EPI_GATE) {
      const float rs = ((const float*)(smem + 67584))[rl];
      const h16x4 eh = pre_a[it], hb = pre_b[it];
      float4 hv;
      hv.x = (float)hb[0] + sigmoidf_(v.x) * ((float)eh[0] * rs * cst.x);
      hv.y = (float)hb[1] + sigmoidf_(v.y) * ((float)eh[1] * rs * cst.y);
      hv.z = (float)hb[2] + sigmoidf_(v.z) * ((float)eh[2] * rs * cst.z);
      hv.w = (float)hb[3] + sigmoidf_(v.w) * ((float)eh[3] * rs * cst.w);
      {
        h16x4 o; o[0] = (h16)hv.x; o[1] = (h16)hv.y; o[2] = (h16)hv.z; o[3] = (h16)hv.w;
        *(h16x4*)((h16*)(p.ws + OFF_MIXIN) + row * 1024 + col) = o;
      }
      float s = hv.x * hv.x + hv.y * hv.y + hv.z * hv.z + hv.w * hv.w;
      s = sum16(s); s += __shfl_xor(s, 16);
      if (c4 == 0) ((float*)(p.ws + OFF_OPART))[row * 8 + (bcol >> 7)] = s;
    }
  }
  __syncthreads();
}

__device__ void ssm_item(const Params& p, int b, int g, unsigned char* smem) {
  float* LOCAL = (float*)smem;
  h16* SPREV = (h16*)(smem + 33792);
  h16* KT = (h16*)(smem + 51200);
  unsigned char* ERING = smem + 33792;
  unsigned char* FRING = smem;
  int tid_ = threadIdx.x;
  asm volatile("" : "+v"(tid_));
  const int tid = tid_, w = tid >> 6, lane = tid & 63, fr = lane & 15, fq = lane >> 4;
  const h16* PROJ = (const h16*)(p.ws + OFF_PROJ);
  const h16* Eg = (const h16*)(p.ws + OFF_ETAB) + (size_t)g * 128 * 512;
  const h16* Kg = (const h16*)(p.ws + OFF_KTAB) + (size_t)g * 33 * 256;
  const h16* Fg = (const h16*)(p.ws + OFF_FTAB) + (size_t)g * 512 * 128;
  const float* ALPOW = (const float*)(p.ws + OFF_ALPOW);
  h16* YPRE = (h16*)((unsigned char*)p.out + OUT_OFF_YPRE);
  const int nchunk = w * 16 + fr;
  const size_t tok0 = (size_t)b * SEQ + (size_t)nchunk * 32;
  h16x8 uf[16];
#pragma unroll
  for (int ks = 0; ks < 16; ++ks) {
    const int i = 2 * ks + (fq >> 1);
    uf[ks] = *(const h16x8*)((const h16*)(p.ws + OFF_US) + ((size_t)g * T_TOK + tok0 + i) * 16 + (fq & 1) * 8);
  }
#pragma unroll
  for (int ks = 0; ks < 16; ++ks) asm volatile("" : "+v"(uf[ks]));
  {
    const float* lg = (const float*)(p.ws + OFF_LOCALG) + ((size_t)g * 1024 + (size_t)b * 64) * 128;
#pragma unroll
    for (int i = 0; i < 8; ++i) {
      const int idx = tid + 256 * i, c = idx >> 5, s4 = idx & 31;
      *(float4*)(LOCAL + c * 132 + s4 * 4) = *(const float4*)(lg + (size_t)c * 128 + s4 * 4);
    }
  }
  {
    h16x8 kt[5];
#pragma unroll
    for (int i = 0; i < 5; ++i) { const int idx = tid + 256 * i; kt[i] = *(const h16x8*)(Kg + (idx < 1056 ? idx : 1055) * 8); }
#pragma unroll
    for (int i = 0; i < 5; ++i) { const int idx = tid + 256 * i; if (idx < 1056) *(h16x8*)(KT + idx * 8) = kt[i]; }
  }
  __syncthreads();
  if (tid < 64) {
    const int pp = tid;
    const float ar = ALPOW[(g * 64 + pp) * 2], ai = ALPOW[(g * 64 + pp) * 2 + 1];
    float sr = 0.f, si = 0.f;
#pragma unroll 1
    for (int c8 = 0; c8 < 8; ++c8) {
      float lr[8], li[8];
#pragma unroll
      for (int k = 0; k < 8; ++k) { lr[k] = LOCAL[(c8 * 8 + k) * 132 + pp]; li[k] = LOCAL[(c8 * 8 + k) * 132 + 64 + pp]; }
#pragma unroll
      for (int k = 0; k < 8; ++k) {
        SPREV[(c8 * 8 + k) * 136 + pp] = (h16)sr;
        SPREV[(c8 * 8 + k) * 136 + 64 + pp] = (h16)si;
        const float nr = ar * sr - ai * si + lr[k];
        const float ni = ar * si + ai * sr + li[k];
        sr = nr; si = ni;
      }
    }
  }
  asm volatile("s_waitcnt vmcnt(0)" ::: "memory");
  __syncthreads();
  h16x8 sf[4];
#pragma unroll
  for (int ks = 0; ks < 4; ++ks) sf[ks] = *(const h16x8*)(SPREV + nchunk * 136 + ks * 32 + fq * 8);
  const h16* fsrc = Fg + (size_t)(tid >> 4) * 128 + (((tid & 15) ^ (tid >> 4)) << 3);
#define F_STAGE(j_) __builtin_amdgcn_global_load_lds((const unsigned*)(fsrc + (size_t)((j_) < 31 ? (j_) : 31) * 16 * 128), \
                                                     (unsigned*)(FRING + ((j_) & 7) * 4096 + tid * 16), 16, 0, 0)
  F_STAGE(0); F_STAGE(1); F_STAGE(2);
#pragma unroll 1
  for (int j = 0; j < 32; ++j) {
    if (j == 0) asm volatile("s_waitcnt vmcnt(2)" ::: "memory");
    else if (j == 1) asm volatile("s_waitcnt vmcnt(3)" ::: "memory");
    else if (j == 2) asm volatile("s_waitcnt vmcnt(4)" ::: "memory");
    else asm volatile("s_waitcnt vmcnt(5)" ::: "memory");
    asm volatile("s_waitcnt lgkmcnt(0)" ::: "memory");
    __builtin_amdgcn_s_barrier();
    asm volatile("" ::: "memory");
    F_STAGE(j + 3);
    asm volatile("" ::: "memory");
    f32x4 acc = {0.f, 0.f, 0.f, 0.f}, acc2 = {0.f, 0.f, 0.f, 0.f};
#pragma unroll
    for (int ks = 0; ks < 16; ++ks) {
      if (2 * ks <= j) {
        const int dd = j - 2 * ks - (fq >> 1) + 1;
        h16x8 a = *(const h16x8*)(KT + dd * 256 + fr * 16 + (fq & 1) * 8);
        if (ks & 1) acc2 = MFMA(a, uf[ks], acc2); else acc = MFMA(a, uf[ks], acc);
      }
    }
    const unsigned char* slot = FRING + (j & 7) * 4096 + fr * 256;
#pragma unroll
    for (int ks = 0; ks < 4; ++ks) {
      h16x8 a = *(const h16x8*)(slot + (((ks * 4 + fq) ^ fr) << 4));
      if (ks & 1) acc2 = MFMA(a, sf[ks], acc2); else acc = MFMA(a, sf[ks], acc);
    }
    h16x4 o;
    o[0] = (h16)gelu_tanh(acc[0] + acc2[0]);
    o[1] = (h16)gelu_tanh(acc[1] + acc2[1]);
    o[2] = (h16)gelu_tanh(acc[2] + acc2[2]);
    o[3] = (h16)gelu_tanh(acc[3] + acc2[3]);
    *(h16x4*)(YPRE + (tok0 + j) * 512 + g * 16 + fq * 4) = o;
    asm volatile("" ::: "memory");
  }
#undef F_STAGE
  asm volatile("s_waitcnt vmcnt(0)" ::: "memory");
  __syncthreads();
}

__device__ void gdn_pre_item(const Params& p, int item, unsigned char* smem) {
  h16* QH = (h16*)smem;
  h16* KH = (h16*)(smem + 17408);
  h16* VH = (h16*)(smem + 34816);
  float* Ld = (float*)(smem + 52224);
  h16* Limg = (h16*)(smem + 56576);
  h16* Dimg = (h16*)(smem + 60672);
  float* sG = (float*)(smem + 69632);
  float* sBeta = (float*)(smem + 69888);
  float* sEG = (float*)(smem + 70144);
  float* sBG = (float*)(smem + 70400);
  float* sEL = (float*)(smem + 70656);
  int tid_ = threadIdx.x;
  asm volatile("" : "+v"(tid_));
  const int tid = tid_, w = tid >> 6, lane = tid & 63, fr = lane & 15, fq = lane >> 4;
  const int c = item & 31, h = (item >> 5) & 3, b = item >> 7;
  const h16* PROJ = (const h16*)(p.ws + OFF_PROJ);
  const float* AB = (const float*)(p.ws + OFF_AB);
  const float* convw = p.in[I_CONVW];
  h16* WPi = (h16*)(p.ws + OFF_WP) + (size_t)item * 64 * 128;
  h16* QGPi = (h16*)(p.ws + OFF_QGP) + (size_t)item * 64 * 128;
  h16* KDTi = (h16*)(p.ws + OFF_KDT) + (size_t)item * 128 * 64;
  h16* UTi = (h16*)(p.ws + OFF_UT) + (size_t)item * 128 * 64;
  h16* ATPi = (h16*)(p.ws + OFF_ATP) + (size_t)item * 64 * 64;
  h16* ZTi = (h16*)((unsigned char*)p.out + OUT_OFF_ZT) + (size_t)item * 128 * 64;
  float* DL = (float*)(p.ws + OFF_DL);
  {
    const h16x8 z8 = {(h16)0.f, (h16)0.f, (h16)0.f, (h16)0.f, (h16)0.f, (h16)0.f, (h16)0.f, (h16)0.f};
    *(h16x8*)(Limg + tid * 8) = z8; *(h16x8*)(Limg + 2048 + tid * 8) = z8;
  }
  {
    const int ch0 = (tid & 15) * 8, t0 = (tid >> 4) * 4;
#pragma unroll 1
    for (int sec = 0; sec < 3; ++sec) {
      const int colbase = 1024 + sec * 512 + h * 128 + ch0;
      h16x8 xr[7];
#pragma unroll
      for (int i = 0; i < 7; ++i) {
        const int ts = c * 64 + t0 - 3 + i;
        h16x8 z8 = {(h16)0.f, (h16)0.f, (h16)0.f, (h16)0.f, (h16)0.f, (h16)0.f, (h16)0.f, (h16)0.f};
        xr[i] = (ts >= 0) ? *(const h16x8*)(PROJ + ((size_t)b * SEQ + ts) * LDP + colbase) : z8;
      }
      float4 wv[4][2];
#pragma unroll
      for (int jj = 0; jj < 4; ++jj) {
        wv[jj][0] = *(const float4*)(convw + jj * 1536 + sec * 512 + h * 128 + ch0);
        wv[jj][1] = *(const float4*)(convw + jj * 1536 + sec * 512 + h * 128 + ch0 + 4);
      }
      h16* dst = (sec == 0 ? QH : (sec == 1 ? KH : VH));
#pragma unroll
      for (int tt = 0; tt < 4; ++tt) {
        float a[8];
#pragma unroll
        for (int e = 0; e < 8; ++e) a[e] = 0.f;
#pragma unroll
        for (int jj = 0; jj < 4; ++jj) {
          const h16x8 xv = xr[tt + jj];
          a[0] += wv[jj][0].x * (float)xv[0]; a[1] += wv[jj][0].y * (float)xv[1]; a[2] += wv[jj][0].z * (float)xv[2]; a[3] += wv[jj][0].w * (float)xv[3];
          a[4] += wv[jj][1].x * (float)xv[4]; a[5] += wv[jj][1].y * (float)xv[5]; a[6] += wv[jj][1].z * (float)xv[6]; a[7] += wv[jj][1].w * (float)xv[7];
        }
        float ss = 0.f;
#pragma unroll
        for (int e = 0; e < 8; ++e) { a[e] = siluf_(a[e]); ss += a[e] * a[e]; }
        float scale = 1.f;
        if (sec < 2) {
          ss = sum16(ss);
          scale = rsqrtf(ss + 1e-6f) * (sec == 0 ? 0.08838834764831845f : 1.f);
        }
        h16x8 o;
#pragma unroll
        for (int e = 0; e < 8; ++e) o[e] = (h16)(a[e] * scale);
        *(h16x8*)(dst + (t0 + tt) * 136 + ch0) = o;
      }
    }
  }
  if (tid < 64) {
    const size_t tok = (size_t)b * SEQ + c * 64 + tid;
    float braw = AB[tok * 8 + h], araw = AB[tok * 8 + 4 + h];
    float beta = 1.f / (1.f + expf(-braw));
    float xx = araw + p.in[I_DTB][h];
    float sp = xx > 20.f ? xx : log1pf(expf(xx));
    float gg = -expf(p.in[I_ALOG][h]) * sp;
#pragma unroll
    for (int o = 1; o < 64; o <<= 1) {
      float v = __shfl_up(gg, o);
      if (lane >= o) gg += v;
    }
    sG[tid] = gg;
    sBeta[tid] = beta;
    const float eg = expf(gg);
    sEG[tid] = eg;
    sBG[tid] = beta * eg;
    sEL[tid] = expf(__shfl(gg, 63) - gg);
  }
  __syncthreads();
  {
    h16x8 ak[4], aq[4];
#pragma unroll
    for (int ks = 0; ks < 4; ++ks) {
      ak[ks] = *(const h16x8*)(KH + (w * 16 + fr) * 136 + ks * 32 + fq * 8);
      aq[ks] = *(const h16x8*)(QH + (w * 16 + fr) * 136 + ks * 32 + fq * 8);
    }
#pragma unroll
    for (int jt = 0; jt < 4; ++jt) {
      const int j = jt * 16 + fr;
      const int pj = perm_pos(j);
      if (jt <= w) {
        f32x4 kk = {0.f, 0.f, 0.f, 0.f}, qk = {0.f, 0.f, 0.f, 0.f};
#pragma unroll
        for (int ks = 0; ks < 4; ++ks) {
          h16x8 bk = *(const h16x8*)(KH + (jt * 16 + fr) * 136 + ks * 32 + fq * 8);
          kk = MFMA(ak[ks], bk, kk);
          qk = MFMA(aq[ks], bk, qk);
        }
        const float Gj = sG[j];
        f32x4 lt;
#pragma unroll
        for (int r = 0; r < 4; ++r) {
          const int i = w * 16 + 4 * fq + r;
          const float e = (i >= j) ? __expf(sG[i] - Gj) : 0.f;
          lt[r] = (i > j) ? sBeta[i] * kk[r] * e : 0.f;
          ATPi[i * 64 + (((pj >> 3) ^ (i & 7)) << 3) + (pj & 7)] = (h16)(qk[r] * e);
        }
        if (jt == w) {
#pragma unroll
          for (int r = 0; r < 4; ++r) Ld[(w * 16 + 4 * fq + r) * 17 + fr] = lt[r];
        } else {
          const int img = (w == 1) ? 0 : (w == 2 ? 1 : (jt < 2 ? 2 : 3));
#pragma unroll
          for (int r = 0; r < 4; ++r) Limg[img * 512 + (4 * fq + r) * 32 + (fr >> 2) * 8 + (fr & 3) + 4 * (jt & 1)] = (h16)(-lt[r]);
        }
      } else {
#pragma unroll
        for (int r = 0; r < 4; ++r) {
          const int i = w * 16 + 4 * fq + r;
          ATPi[i * 64 + (((pj >> 3) ^ (i & 7)) << 3) + (pj & 7)] = (h16)0.f;
        }
      }
    }
  }
  __syncthreads();
  if (lane < 16) {
    float y[16];
#pragma unroll
    for (int i = 0; i < 16; ++i) {
      float s = (i == lane) ? 1.f : 0.f;
#pragma unroll
      for (int k = 0; k < i; ++k) s -= Ld[(w * 16 + i) * 17 + k] * y[k];
      y[i] = s;
    }
#pragma unroll
    for (int i = 0; i < 16; ++i) Dimg[w * 512 + i * 32 + (lane >> 2) * 8 + (lane & 3)] = (h16)y[i];
  }
  __syncthreads();
  f32x4 xs[4][4];
  {
    const h16* SRC = (w < 2) ? VH : KH;
    const float* scl = (w < 2) ? sBeta : sBG;
    const int cbase = (w & 1) * 64;
    h16x8 dA[4], lA[4];
#pragma unroll
    for (int b4 = 0; b4 < 4; ++b4) {
      dA[b4] = *(const h16x8*)(Dimg + b4 * 512 + fr * 32 + fq * 8);
      lA[b4] = *(const h16x8*)(Limg + b4 * 512 + fr * 32 + fq * 8);
    }
    const f32x4 z4 = {0.f, 0.f, 0.f, 0.f};
#pragma unroll
    for (int nt = 0; nt < 4; ++nt) {
      const int col = cbase + nt * 16 + fr;
      f32x4 rb[4];
#pragma unroll
      for (int b4 = 0; b4 < 4; ++b4)
#pragma unroll
        for (int r = 0; r < 4; ++r) rb[b4][r] = (float)SRC[(b4 * 16 + 4 * fq + r) * 136 + col] * scl[b4 * 16 + 4 * fq + r];
      const f32x4 x0 = MFMA(dA[0], pack8(rb[0], z4), z4);
      const f32x4 a1 = MFMA(lA[0], pack8(x0, z4), rb[1]);
      const f32x4 x1 = MFMA(dA[1], pack8(a1, z4), z4);
      const h16x8 x01 = pack8(x0, x1);
      const f32x4 a2 = MFMA(lA[1], x01, rb[2]);
      const f32x4 x2 = MFMA(dA[2], pack8(a2, z4), z4);
      f32x4 a3 = MFMA(lA[2], x01, rb[3]);
      a3 = MFMA(lA[3], pack8(x2, z4), a3);
      const f32x4 x3 = MFMA(dA[3], pack8(a3, z4), z4);
      xs[nt][0] = x0; xs[nt][1] = x1; xs[nt][2] = x2; xs[nt][3] = x3;
      if (w < 2) {
#pragma unroll
        for (int b4 = 0; b4 < 4; ++b4) {
          h16x4 o; o[0] = (h16)xs[nt][b4][0]; o[1] = (h16)xs[nt][b4][1]; o[2] = (h16)xs[nt][b4][2]; o[3] = (h16)xs[nt][b4][3];
          *(h16x4*)(UTi + (size_t)col * 64 + b4 * 16 + 4 * fq) = o;
        }
      }
    }
  }
  __syncthreads();
  if (w >= 2) {
#pragma unroll
    for (int nt = 0; nt < 4; ++nt) {
      const int pos = perm_pos((w & 1) * 64 + nt * 16 + fr);
#pragma unroll
      for (int b4 = 0; b4 < 4; ++b4)
#pragma unroll
        for (int r = 0; r < 4; ++r) VH[(b4 * 16 + 4 * fq + r) * 136 + pos] = (h16)xs[nt][b4][r];
    }
  }
  __syncthreads();
  for (int rr = 0; rr < 4; ++rr) {
    const int idx = tid + 256 * rr, row = idx >> 4, seg = idx & 15;
    *(h16x8*)(WPi + row * 128 + ((seg ^ (row & 15)) << 3)) = *(const h16x8*)(VH + row * 136 + seg * 8);
  }
  {
    const int dv = tid & 127, th = tid >> 7;
    const float gdv = p.in[I_DNG][dv];
    const h16* zp = PROJ + ((size_t)b * SEQ + c * 64 + th * 32) * LDP + 2560 + h * 128 + dv;
    h16 zv[32];
#pragma unroll
    for (int t = 0; t < 32; ++t) zv[t] = zp[(size_t)t * LDP];
#pragma unroll
    for (int t8 = 0; t8 < 4; ++t8) {
      h16x8 v;
#pragma unroll
      for (int e = 0; e < 8; ++e) v[e] = (h16)(siluf_((float)zv[t8 * 8 + e]) * gdv);
      *(h16x8*)(ZTi + (size_t)dv * 64 + th * 32 + t8 * 8) = v;
    }
  }
#pragma unroll 2
  for (int rr = 0; rr < 4; ++rr) {
    const int idx = tid + 256 * rr, t = idx >> 4, cpos = idx & 15, ks = cpos >> 2, q = cpos & 3;
    const h16x4 lo = *(const h16x4*)(QH + t * 136 + ks * 32 + 4 * q);
    const h16x4 hi = *(const h16x4*)(QH + t * 136 + ks * 32 + 16 + 4 * q);
    const float sc = sEG[t];
    h16x8 o;
#pragma unroll
    for (int e = 0; e < 4; ++e) { o[e] = (h16)((float)lo[e] * sc); o[4 + e] = (h16)((float)hi[e] * sc); }
    *(h16x8*)(QGPi + t * 128 + ((cpos ^ (t & 15)) << 3)) = o;
  }
#pragma unroll 2
  for (int rr = 0; rr < 4; ++rr) {
    const int idx = tid + 256 * rr, dk = idx >> 3, cpos = idx & 7, k2 = cpos >> 2, q = cpos & 3;
    h16x8 o;
#pragma unroll
    for (int e = 0; e < 8; ++e) {
      const int t = k2 * 32 + (e < 4 ? 4 * q + e : 16 + 4 * q + (e - 4));
      o[e] = (h16)((float)KH[t * 136 + dk] * sEL[t]);
    }
    *(h16x8*)(KDTi + dk * 64 + ((cpos ^ (dk & 7)) << 3)) = o;
  }
  const float Glast = sG[63];
  if (tid == 0) DL[item] = expf(Glast);
  __syncthreads();
}

template <int NB>
__device__ __forceinline__ void glds_copy(const h16* __restrict__ g, unsigned char* l) {
#pragma unroll
  for (int i = 0; i < NB / 4096; ++i) {
    const int off = threadIdx.x * 16 + i * 4096;
    __builtin_amdgcn_global_load_lds((const unsigned*)((const unsigned char*)g + off), (unsigned*)(l + off), 16, 0, 0);
  }
}
#define RAW_BARRIER() do { asm volatile("s_waitcnt lgkmcnt(0)" ::: "memory"); __builtin_amdgcn_s_barrier(); asm volatile("" ::: "memory"); } while (0)

__device__ void gdn_chain(const Params& p, int bh, unsigned char* smem) {
  const int tid = threadIdx.x, w = tid >> 6, lane = tid & 63, fr = lane & 15, fq = lane >> 4;
  const float* DL = (const float*)(p.ws + OFF_DL);
  const h16* WPb = (const h16*)(p.ws + OFF_WP) + (size_t)bh * 32 * 64 * 128;
  const h16* KDTb = (const h16*)(p.ws + OFF_KDT) + (size_t)bh * 32 * 128 * 64;
  h16* UTb = (h16*)(p.ws + OFF_UT) + (size_t)bh * 32 * 128 * 64;
  h16* SFb = (h16*)((unsigned char*)p.out + OUT_OFF_SF) + (size_t)bh * 32 * 128 * 128;
  f32x4 S[8][2];
#pragma unroll
  for (int i = 0; i < 8; ++i) { S[i][0] = f32x4{0.f, 0.f, 0.f, 0.f}; S[i][1] = f32x4{0.f, 0.f, 0.f, 0.f}; }
  h16x4 uR[4][2];
  const int uoff = (w * 32 + fr) * 64 + fq * 4;
  glds_copy<16384>(WPb, smem); glds_copy<16384>(KDTb, smem + 16384);
#pragma unroll
  for (int mt = 0; mt < 4; ++mt)
#pragma unroll
    for (int nt = 0; nt < 2; ++nt) uR[mt][nt] = *(const h16x4*)(UTb + uoff + nt * 1024 + mt * 16);
  float dl = DL[bh * 32];
  asm volatile("s_waitcnt vmcnt(0)" ::: "memory");
  RAW_BARRIER();
  for (int c = 0; c < 32; ++c) {
    const int cn = (c + 1 < 32) ? c + 1 : 31;
    const unsigned char* LW = smem + (c & 1) * 32768;
    const unsigned char* LK = LW + 16384;
    unsigned char* LWn = smem + ((c + 1) & 1) * 32768;
    f32x4 uf[4][2];
#pragma unroll
    for (int mt = 0; mt < 4; ++mt)
#pragma unroll
      for (int nt = 0; nt < 2; ++nt)
#pragma unroll
        for (int r = 0; r < 4; ++r) uf[mt][nt][r] = (float)uR[mt][nt][r];
    const float dlc = dl;
    asm volatile("" ::: "memory");
    h16x8 sfr[4][2];
#pragma unroll
    for (int ks = 0; ks < 4; ++ks) { sfr[ks][0] = pack8(S[2 * ks][0], S[2 * ks + 1][0]); sfr[ks][1] = pack8(S[2 * ks][1], S[2 * ks + 1][1]); }
#pragma unroll
    for (int ks = 0; ks < 4; ++ks)
#pragma unroll
      for (int nt = 0; nt < 2; ++nt)
        *(h16x8*)(SFb + ((size_t)(c * 4 + ks) * 8 + w * 2 + nt) * 512 + lane * 8) = sfr[ks][nt];
    glds_copy<16384>(WPb + (size_t)cn * 64 * 128, LWn);
    glds_copy<16384>(KDTb + (size_t)cn * 128 * 64, LWn + 16384);
#pragma unroll
    for (int mt = 0; mt < 4; ++mt)
#pragma unroll
      for (int nt = 0; nt < 2; ++nt)
        uR[mt][nt] = *(const h16x4*)(UTb + (size_t)cn * 128 * 64 + uoff + nt * 1024 + mt * 16);
    dl = DL[bh * 32 + cn];
    asm volatile("" ::: "memory");
    f32x4 vn[4][2];
#pragma unroll
    for (int mt = 0; mt < 4; ++mt) { vn[mt][0] = f32x4{0.f, 0.f, 0.f, 0.f}; vn[mt][1] = vn[mt][0]; }
#pragma unroll
    for (int ks = 0; ks < 4; ++ks)
#pragma unroll
      for (int mt = 0; mt < 4; ++mt) {
        h16x8 aw = *(const h16x8*)(LW + (mt * 16 + fr) * 256 + (((ks * 4 + fq) ^ fr) << 4));
        vn[mt][0] = MFMA(aw, sfr[ks][0], vn[mt][0]);
        vn[mt][1] = MFMA(aw, sfr[ks][1], vn[mt][1]);
      }
#pragma unroll
    for (int mt = 0; mt < 4; ++mt)
#pragma unroll
      for (int r = 0; r < 4; ++r) { vn[mt][0][r] = uf[mt][0][r] - vn[mt][0][r]; vn[mt][1][r] = uf[mt][1][r] - vn[mt][1][r]; }
    h16x8 vfr[2][2];
#pragma unroll
    for (int k2 = 0; k2 < 2; ++k2) { vfr[k2][0] = pack8(vn[2 * k2][0], vn[2 * k2 + 1][0]); vfr[k2][1] = pack8(vn[2 * k2][1], vn[2 * k2 + 1][1]); }
    if (c + 1 < 32) {
#pragma unroll
      for (int k2 = 0; k2 < 2; ++k2)
#pragma unroll
        for (int nt = 0; nt < 2; ++nt)
          *(h16x8*)(UTb + (size_t)c * 128 * 64 + ((size_t)k2 * 8 + w * 2 + nt) * 512 + lane * 8) = vfr[k2][nt];
    }
#pragma unroll
    for (int dkt = 0; dkt < 8; ++dkt) {
      f32x4 s0 = S[dkt][0], s1 = S[dkt][1];
#pragma unroll
      for (int r = 0; r < 4; ++r) { s0[r] *= dlc; s1[r] *= dlc; }
#pragma unroll
      for (int k2 = 0; k2 < 2; ++k2) {
        h16x8 ak = *(const h16x8*)(LK + (dkt * 16 + fr) * 128 + (((k2 * 4 + fq) ^ (fr & 7)) << 4));
        s0 = MFMA(ak, vfr[k2][0], s0);
        s1 = MFMA(ak, vfr[k2][1], s1);
      }
      S[dkt][0] = s0; S[dkt][1] = s1;
    }
    asm volatile("s_waitcnt vmcnt(0)" ::: "memory");
    RAW_BARRIER();
    if (c + 1 == 32) {
#pragma unroll
      for (int k2 = 0; k2 < 2; ++k2)
#pragma unroll
        for (int nt = 0; nt < 2; ++nt)
          *(h16x8*)(UTb + (size_t)c * 128 * 64 + ((size_t)k2 * 8 + w * 2 + nt) * 512 + lane * 8) = vfr[k2][nt];
    }
  }
  asm volatile("s_waitcnt vmcnt(0)" ::: "memory");
  __syncthreads();
}

__device__ void gdn_out_item(const Params& p, int item, unsigned char* smem) {
  unsigned char* LQ = smem;
  unsigned char* LA = smem + 16384;
  float* red = (float*)(smem + 24576);
  const int tid = threadIdx.x, w = tid >> 6, lane = tid & 63, fr = lane & 15, fq = lane >> 4;
  const int c = item & 31, h = (item >> 5) & 3, b = item >> 7;
  h16* MIXIN = (h16*)(p.ws + OFF_MIXIN);
  const h16* QGPi = (const h16*)(p.ws + OFF_QGP) + (size_t)item * 64 * 128;
  const h16* ATPi = (const h16*)(p.ws + OFF_ATP) + (size_t)item * 64 * 64;
  const h16* VFi = (const h16*)(p.ws + OFF_UT) + (size_t)item * 128 * 64;
  const h16* SFi = (const h16*)((unsigned char*)p.out + OUT_OFF_SF) + (size_t)item * 128 * 128;
  const h16* ZTi = (const h16*)((unsigned char*)p.out + OUT_OFF_ZT) + (size_t)item * 128 * 64;
  glds_copy<16384>(QGPi, LQ); glds_copy<8192>(ATPi, LA);
  h16x8 sfr[4][2], vfr[2][2];
#pragma unroll
  for (int ks = 0; ks < 4; ++ks)
#pragma unroll
    for (int nt = 0; nt < 2; ++nt) sfr[ks][nt] = *(const h16x8*)(SFi + ((size_t)ks * 8 + w * 2 + nt) * 512 + lane * 8);
#pragma unroll
  for (int k2 = 0; k2 < 2; ++k2)
#pragma unroll
    for (int nt = 0; nt < 2; ++nt) vfr[k2][nt] = *(const h16x8*)(VFi + ((size_t)k2 * 8 + w * 2 + nt) * 512 + lane * 8);
  h16x4 zR[4][2];
#pragma unroll
  for (int mt = 0; mt < 4; ++mt)
#pragma unroll
    for (int nt = 0; nt < 2; ++nt) zR[mt][nt] = *(const h16x4*)(ZTi + (size_t)(w * 32 + nt * 16 + fr) * 64 + mt * 16 + fq * 4);
  asm volatile("s_waitcnt vmcnt(0)" ::: "memory");
  __syncthreads();
  f32x4 o[4][2];
#pragma unroll
  for (int mt = 0; mt < 4; ++mt) {
    f32x4 o0 = {0.f, 0.f, 0.f, 0.f}, o1 = {0.f, 0.f, 0.f, 0.f};
#pragma unroll
    for (int ks = 0; ks < 4; ++ks) {
      h16x8 aq = *(const h16x8*)(LQ + (mt * 16 + fr) * 256 + (((ks * 4 + fq) ^ fr) << 4));
      o0 = MFMA(aq, sfr[ks][0], o0);
      o1 = MFMA(aq, sfr[ks][1], o1);
    }
#pragma unroll
    for (int k2 = 0; k2 < 2; ++k2) {
      h16x8 aa = *(const h16x8*)(LA + (mt * 16 + fr) * 128 + (((k2 * 4 + fq) ^ (fr & 7)) << 4));
      o0 = MFMA(aa, vfr[k2][0], o0);
      o1 = MFMA(aa, vfr[k2][1], o1);
    }
    o[mt][0] = o0; o[mt][1] = o1;
  }
#pragma unroll
  for (int mt = 0; mt < 4; ++mt)
#pragma unroll
    for (int r = 0; r < 4; ++r) {
      float s = o[mt][0][r] * o[mt][0][r] + o[mt][1][r] * o[mt][1][r];
      s = sum16(s);
      if (fr == 0) red[w * 64 + mt * 16 + 4 * fq + r] = s;
    }
  __syncthreads();
#pragma unroll
  for (int mt = 0; mt < 4; ++mt)
#pragma unroll
    for (int r = 0; r < 4; ++r) {
      const int tl = mt * 16 + 4 * fq + r;
      const float tot = red[tl] + red[64 + tl] + red[128 + tl] + red[192 + tl];
      const float rstd = rsqrtf(tot * (1.f / 128.f) + 1e-6f);
      const size_t tok = (size_t)b * SEQ + c * 64 + tl;
      h16* yp = MIXIN + tok * 1024 + 512 + h * 128 + w * 32 + fr;
      yp[0] = (h16)(o[mt][0][r] * rstd * (float)zR[mt][0][r]);
      yp[16] = (h16)(o[mt][1][r] * rstd * (float)zR[mt][1][r]);
    }
  __syncthreads();
}

#define XB_TMO      128
#define XB_XCNT(j)  (256  + 64 * (j))
#define XB_XSUB(j)  (1280 + 64 * (j))
#define XB_XGEN(j)  (2304 + 64 * (j))
#define XB_TOP      3328
#define XB_TOPGEN   3392
#define XCD_BAR_WORDS 3456
#define XB_SPIN_CAP (1u << 18)
#define LAS __attribute__((address_space(3)))

__device__ __forceinline__ unsigned xb_ld(unsigned* p)              { return __hip_atomic_load(p, __ATOMIC_RELAXED, __HIP_MEMORY_SCOPE_AGENT); }
__device__ __forceinline__ unsigned xb_add(unsigned* p, unsigned v) { return __hip_atomic_fetch_add(p, v, __ATOMIC_RELAXED, __HIP_MEMORY_SCOPE_AGENT); }
__device__ __forceinline__ unsigned xb_xcc_id() { return (unsigned)__builtin_amdgcn_s_getreg((3 << 11) | 20) & 0xFu; }
#define XB_SPIN(cond, bar) do { unsigned _sp = 0; while (cond) { __builtin_amdgcn_s_sleep(1); \
    if ((++_sp & 255u) == 0u) { if (xb_ld(&(bar)[XB_TMO])) break; if (_sp > XB_SPIN_CAP) { atomicAdd(&(bar)[XB_TMO], 1u); break; } } } } while (0)

struct XcdBarrier {
    unsigned* bar; unsigned x;
    volatile LAS unsigned* st;
};

__device__ __forceinline__ XcdBarrier xcd_barrier_post(unsigned* bar, volatile LAS unsigned* st) {
    XcdBarrier b; b.bar = bar; b.x = xb_xcc_id(); b.st = st;
    if (threadIdx.x == 0) (void)xb_add(&bar[XB_XCNT(b.x)], 1u);
    return b;
}
__device__ __forceinline__ void xcd_barrier_complete(unsigned* bar, unsigned x, unsigned& nloc, unsigned& nx) {
    const unsigned G = gridDim.x * gridDim.y * gridDim.z;
    unsigned sum, cnt, mine, sp = 0u;
    for (;;) {
        sum = 0u; cnt = 0u; mine = 0u;
#pragma unroll
        for (unsigned j = 0; j < 16; ++j) { const unsigned c = xb_ld(&bar[XB_XCNT(j)]); sum += c; cnt += (c > 0u) ? 1u : 0u; mine = (j == x) ? c : mine; }
        if (sum == G) break;
        __builtin_amdgcn_s_sleep(1);
        if ((++sp & 255u) == 0u) { if (xb_ld(&bar[XB_TMO])) break; if (sp > XB_SPIN_CAP) { atomicAdd(&bar[XB_TMO], 1u); break; } }
    }
    nloc = mine > 0u ? mine : 1u; nx = cnt > 0u ? cnt : 1u;
}

__device__ __forceinline__ void xcd_barrier(const XcdBarrier& b) {
    asm volatile("s_waitcnt vmcnt(0)" ::: "memory");
    __syncthreads();
    if (threadIdx.x == 0) {
        unsigned* bar = b.bar;
        __builtin_amdgcn_s_waitcnt(0);
        unsigned nloc = b.st[0], nx = b.st[1];
        if (nloc == 0u) { xcd_barrier_complete(bar, b.x, nloc, nx); b.st[0] = nloc; b.st[1] = nx; }
        const unsigned old = xb_add(&bar[XB_XSUB(b.x)], 1u);
        const unsigned gen = old / nloc;
        if (old + 1u == (gen + 1u) * nloc) {
            __builtin_amdgcn_fence(__ATOMIC_RELEASE, "agent");
            asm volatile("s_waitcnt vmcnt(0)" ::: "memory");
            const unsigned og = xb_add(&bar[XB_TOP], 1u);
            const unsigned tg = og / nx;
            if (og + 1u == (tg + 1u) * nx) xb_add(&bar[XB_TOPGEN], 1u);
            else XB_SPIN(xb_ld(&bar[XB_TOPGEN]) == tg, bar);
            __builtin_amdgcn_fence(__ATOMIC_ACQUIRE, "agent");
            xb_add(&bar[XB_XGEN(b.x)], 1u);
            asm volatile("s_waitcnt vmcnt(0)" ::: "memory");
        } else {
            XB_SPIN(xb_ld(&bar[XB_XGEN(b.x)]) == gen, bar);
            __builtin_amdgcn_fence(__ATOMIC_ACQUIRE, "agent");
            asm volatile("s_waitcnt vmcnt(0)" ::: "memory");
        }
    }
    __syncthreads();
}

#ifndef ONLY_PH
#define ONLY_PH -1
#endif
#define RUNPH(n) ((ONLY_PH < 0 || ONLY_PH == (n)) && p.ph_lo <= (n) && (n) <= p.ph_hi)
#define SYNCPH(n) do { if (p.ph_lo <= (n) && (n) < p.ph_hi) xcd_barrier(xb); } while (0)
__global__ void __launch_bounds__(256, 2) hymba_mega(Params p) {
  __shared__ __attribute__((aligned(16))) unsigned char smem[SMEM_BYTES];
  cg::grid_group grid = cg::this_grid();
  const int bid = blockIdx.x, nb = gridDim.x;
  if (p.ph_lo < 0) grid.sync();
  XcdBarrier xb;
  {
    volatile LAS unsigned* st = (volatile LAS unsigned*)(smem + SMEM_BYTES - 16);
    if (threadIdx.x == 0) { st[0] = 0u; st[1] = 0u; st[2] = 0u; st[3] = 0u; }
    __syncthreads();
    if (p.ph_lo < p.ph_hi) xb = xcd_barrier_post((unsigned*)(p.ws + OFF_BAR), st);
    else { xb.bar = (unsigned*)(p.ws + OFF_BAR); xb.x = 0; xb.st = st; }
  }
  {
    if (RUNPH(0)) for (int rep = 0; rep < REP0; ++rep) {
      if (rep) grid.sync();
      phase0(p, smem);
    }
    SYNCPH(0);
    if (RUNPH(1)) for (int rep = 0; rep < REP1; ++rep) {
      if (rep) grid.sync();
      const h16* A0 = (const h16*)((unsigned char*)p.out + OUT_OFF_A0);
      const h16* W = (const h16*)(p.ws + OFF_WIN);
      const int xl = bid & 7, nxb = nb >> 3;
      if (nb & 7) { for (int t = bid; t < 256 * 25; t += nb) gemm_tile<EPI_PROJ>(p, A0, 1024, W, 1024, 1024, (t / 25) * 128, (t % 25) * 128, smem); }
      else for (int u = bid >> 3; u < 800; u += nxb) {
        const int mb = u / 200, v = u % 200;
        gemm_tile<EPI_PROJ>(p, A0, 1024, W, 1024, 1024, (xl * 32 + mb * 8 + (v & 7)) * 128, (v >> 3) * 128, smem);
      }
    }
    SYNCPH(1);
    if (RUNPH(2)) {
      for (int it = bid; it < 256 + 2048; it += nb) {
        if (it < 256) gemm_tile<EPI_LOCAL>(p, (const h16*)(p.ws + OFF_US), 512, (const h16*)(p.ws + OFF_ETAB) + (size_t)(it >> 3) * 128 * 512, 512, 512, it * 128, 0, smem);
        else gdn_pre_item(p, it - 256, smem);
      }
    }
    SYNCPH(2);
    if (RUNPH(3)) {
      for (int it = bid; it < 512; it += nb) ssm_item(p, it >> 5, it & 31, smem);
    }
    SYNCPH(3);
    if (RUNPH(4)) {
      if (bid < 64) gdn_chain(p, bid, smem);
      const int xl = bid & 7;
      unsigned* ctr = (unsigned*)(p.ws + OFF_CTR) + xl * 16;
      volatile int* bc = (volatile int*)(smem + SMEM_BYTES - 4);
      const h16* YPRE = (const h16*)((unsigned char*)p.out + OUT_OFF_YPRE);
      for (;;) {
        __syncthreads();
        if (threadIdx.x == 0) *bc = (int)atomicAdd(ctr, 1u);
        __syncthreads();
        const int u = *bc;
        if (u >= 128 + 256) break;
        if (u < 128) gemm_tile<EPI_GLU>(p, YPRE, 512, (const h16*)(p.ws + OFF_WGLU), 512, 512, (xl * 32 + (u >> 2)) * 128, (u & 3) * 128, smem);
        else gemm_tile<EPI_PLE>(p, (const h16*)(p.ws + OFF_PB), 256, (const h16*)(p.ws + OFF_WPP), 256, 256, (xl * 32 + ((u - 128) >> 3)) * 128, ((u - 128) & 7) * 128, smem);
      }
    }
    SYNCPH(4);
    if (RUNPH(5)) {
      for (int it = bid; it < 2048; it += nb) gdn_out_item(p, it, smem);
    }
    SYNCPH(5);
    if (RUNPH(6)) {
      const int xl = bid & 7, nxb = nb >> 3;
      if (nb & 7) { for (int t = bid; t < 2048; t += nb) gemm_tile<EPI_OUT>(p, (const h16*)(p.ws + OFF_MIXIN), 1024, (const h16*)(p.ws + OFF_WOUT), 1024, 1024, (t >> 3) * 128, (t & 7) * 128, smem); }
      else for (int u = bid >> 3; u < 256; u += nxb)
        gemm_tile<EPI_OUT>(p, (const h16*)(p.ws + OFF_MIXIN), 1024, (const h16*)(p.ws + OFF_WOUT), 1024, 1024, (xl * 32 + (u >> 6) * 8 + (u & 7)) * 128, ((u >> 3) & 7) * 128, smem);
    }
    SYNCPH(6);
    if (RUNPH(7)) {
      const int xl = bid & 7, nxb = nb >> 3;
      if (nb & 7) { for (int t = bid; t < 2048; t += nb) gemm_tile<EPI_GATE>(p, (const h16*)(p.ws + OFF_PROJ), 1024, (const h16*)(p.ws + OFF_WGATE), 1024, 1024, (t >> 3) * 128, (t & 7) * 128, smem); }
      else for (int u = bid >> 3; u < 256; u += nxb)
        gemm_tile<EPI_GATE>(p, (const h16*)(p.ws + OFF_PROJ), 1024, (const h16*)(p.ws + OFF_WGATE), 1024, 1024, (xl * 32 + (u >> 6) * 8 + (u & 7)) * 128, ((u >> 3) & 7) * 128, smem);
    }
    SYNCPH(7);
    if (RUNPH(8)) {
      const int wid = threadIdx.x >> 6, lane = threadIdx.x & 63;
      const float* OPART = (const float*)(p.ws + OFF_OPART);
      const float4* g4 = (const float4*)p.in[I_FING];
      const h16* H2B = (const h16*)(p.ws + OFF_MIXIN);
      for (int row = bid * 4 + wid; row < T_TOK; row += nb * 4) {
        float s = (lane < 8) ? OPART[(size_t)row * 8 + lane] : 0.f;
        const h16x8 a = *(const h16x8*)(H2B + (size_t)row * 1024 + lane * 8);
        const h16x8 b = *(const h16x8*)(H2B + (size_t)row * 1024 + 512 + lane * 8);
        s = wave_sum(s);
        const float rstd = rsqrtf(s * (1.f / 1024.f) + 1e-6f);
        float4* orow = (float4*)(p.out + (size_t)row * 1024);
        const float4 g0 = g4[lane * 2], g1 = g4[lane * 2 + 1], g2 = g4[128 + lane * 2], g3 = g4[128 + lane * 2 + 1];
        float4 o0, o1, o2, o3;
        o0.x = (float)a[0] * rstd * g0.x; o0.y = (float)a[1] * rstd * g0.y; o0.z = (float)a[2] * rstd * g0.z; o0.w = (float)a[3] * rstd * g0.w;
        o1.x = (float)a[4] * rstd * g1.x; o1.y = (float)a[5] * rstd * g1.y; o1.z = (float)a[6] * rstd * g1.z; o1.w = (float)a[7] * rstd * g1.w;
        o2.x = (float)b[0] * rstd * g2.x; o2.y = (float)b[1] * rstd * g2.y; o2.z = (float)b[2] * rstd * g2.z; o2.w = (float)b[3] * rstd * g2.w;
        o3.x = (float)b[4] * rstd * g3.x; o3.y = (float)b[5] * rstd * g3.y; o3.z = (float)b[6] * rstd * g3.z; o3.w = (float)b[7] * rstd * g3.w;
        orow[lane * 2] = o0; orow[lane * 2 + 1] = o1; orow[128 + lane * 2] = o2; orow[128 + lane * 2 + 1] = o3;
      }
    }
  }
}

extern "C" void kernel_launch(void* const* d_in, const int* in_sizes, int n_in, void* d_out, int out_size, void* d_ws, size_t ws_size,
                              hipStream_t stream) {
  static int grid_blocks = 0;
  if (!grid_blocks) {
    int dev = 0, cus = 0, per_cu = 0;
    hipGetDevice(&dev);
    hipDeviceGetAttribute(&cus, hipDeviceAttributeMultiprocessorCount, dev);
    hipOccupancyMaxActiveBlocksPerMultiprocessor(&per_cu, hymba_mega, 256, 0);
    if (per_cu > 2) per_cu = 2;
    if (per_cu < 1) per_cu = 1;
    grid_blocks = cus * per_cu;
  }
  if (n_in != 23 || ws_size < WS_END || out_size != T_TOK * 1024) {
    fprintf(stderr, "kernel_launch: unexpected sizes n_in=%d ws=%zu (need %zu) out=%d\n", n_in, ws_size, (size_t)WS_END, out_size);
    return;
  }
  Params p{};
  for (int i = 0; i < 23; ++i) p.in[i] = (const float*)d_in[i];
  p.out = (float*)d_out;
  p.ws = (unsigned char*)d_ws;
  if (hipMemsetAsync((unsigned char*)d_ws + OFF_BAR, 0, 16384, stream) != hipSuccess) { fprintf(stderr, "kernel_launch: memset of control words failed\n"); return; }
#if MULTI_LAUNCH
  for (int ph = 0; ph < NPH; ++ph) {
    p.ph_lo = ph; p.ph_hi = ph;
    hipLaunchKernelGGL(hymba_mega, dim3(grid_blocks), dim3(256), 0, stream, p);
  }
#else
  p.ph_lo = 0; p.ph_hi = NPH - 1;
  void* args[] = {&p};
  hipError_t e = hipLaunchCooperativeKernel((void*)hymba_mega, dim3(grid_blocks), dim3(256), args, 0, stream);
  if (e != hipSuccess) fprintf(stderr, "cooperative launch failed: %s (grid %d)\n", hipGetErrorString(e), grid_blocks);
#endif
}
```

```cpp
#include <hip/hip_runtime.h>
#include <hip/hip_cooperative_groups.h>
#include <cstdio>
namespace cg = cooperative_groups;

#ifndef REP0
#define REP0 1
#endif
#ifndef REP1
#define REP1 1
#endif
#ifndef REP2
#define REP2 1
#endif
#ifndef REP3
#define REP3 1
#endif
#ifndef REP4
#define REP4 1
#endif
#ifndef MULTI_LAUNCH
#define MULTI_LAUNCH 0
#endif

typedef _Float16 h16;
typedef __attribute__((ext_vector_type(8))) _Float16 h16x8;
typedef __attribute__((ext_vector_type(4))) _Float16 h16x4;
typedef __attribute__((ext_vector_type(4))) float f32x4;
typedef __attribute__((ext_vector_type(2))) float v2f;

#define MFMA(a, b, c) __builtin_amdgcn_mfma_f32_16x16x32_f16((a), (b), (c), 0, 0, 0)

constexpr int T_TOK = 32768;
constexpr int SEQ = 2048;
constexpr int NPH = 9;
constexpr int LDP = 3072;
constexpr int SMEM_BYTES = 72704;

constexpr size_t SZ_WIN = (size_t)3200 * 1024 * 2;
constexpr size_t SZ_WGLU = (size_t)512 * 512 * 2;
constexpr size_t SZ_WOUT = (size_t)1024 * 1024 * 2;
constexpr size_t SZ_WPP = (size_t)1024 * 256 * 2;
constexpr size_t SZ_WGATE = (size_t)1024 * 1024 * 2;
constexpr size_t OFF_WIN = 0;
constexpr size_t OFF_WGLU = OFF_WIN + SZ_WIN;
constexpr size_t OFF_WOUT = OFF_WGLU + SZ_WGLU;
constexpr size_t OFF_WPP = OFF_WOUT + SZ_WOUT;
constexpr size_t OFF_WGATE = OFF_WPP + SZ_WPP;
constexpr size_t OFF_PB = OFF_WGATE + SZ_WGATE;
constexpr size_t OFF_PROJ = OFF_PB + (size_t)T_TOK * 256 * 2;
constexpr size_t OFF_AB = OFF_PROJ + (size_t)T_TOK * LDP * 2;
constexpr size_t OFF_KTAB = OFF_AB + (size_t)T_TOK * 8 * 4;
constexpr size_t OFF_ETAB = OFF_KTAB + (size_t)32 * 33 * 256 * 2;
constexpr size_t OFF_FTAB = OFF_ETAB + (size_t)32 * 128 * 512 * 2;
constexpr size_t OFF_ALPOW = OFF_FTAB + (size_t)32 * 512 * 128 * 2;
constexpr size_t OFF_DL = OFF_ALPOW + (size_t)32 * 64 * 2 * 4;
constexpr size_t OFF_EPART = OFF_DL + (size_t)2048 * 4;
constexpr size_t OFF_OPART = OFF_EPART + (size_t)T_TOK * 16 * 4;
constexpr size_t OFF_MIXIN = OFF_OPART + (size_t)T_TOK * 16 * 4;
constexpr size_t OFF_WP = OFF_MIXIN + (size_t)T_TOK * 1024 * 2;
constexpr size_t OFF_QGP = OFF_WP + (size_t)2048 * 64 * 128 * 2;
constexpr size_t OFF_KDT = OFF_QGP + (size_t)2048 * 64 * 128 * 2;
constexpr size_t OFF_UT = OFF_KDT + (size_t)2048 * 128 * 64 * 2;
constexpr size_t OFF_ATP = OFF_UT + (size_t)2048 * 128 * 64 * 2;
constexpr size_t OFF_EH = OFF_ATP + (size_t)2048 * 64 * 64 * 2;
constexpr size_t OFF_US = OFF_EH;
constexpr size_t OFF_LOCALG = OFF_EH + (size_t)32 * T_TOK * 16 * 2;
constexpr size_t OFF_BAR = OFF_EH + (size_t)T_TOK * 1024 * 2;
constexpr size_t WS_END = OFF_BAR + 16384;
constexpr size_t OFF_CTR = OFF_BAR + 15360;
constexpr size_t OUT_OFF_A0 = 0;
constexpr size_t OUT_OFF_SF = 0;
constexpr size_t OUT_OFF_YPRE = (size_t)T_TOK * 1024 * 2;
constexpr size_t OUT_OFF_ZT = OUT_OFF_YPRE + (size_t)T_TOK * 512 * 2;

struct Params {
  const float* in[23];
  float* out;
  unsigned char* ws;
  int ph_lo, ph_hi;
};

enum { I_X = 0, I_P, I_NMG, I_WIN, I_ARE, I_AIM, I_BRE, I_BIM, I_CRE, I_CIM, I_D, I_LOGDT, I_WGLU, I_BGLU,
       I_CONVW, I_ALOG, I_DTB, I_DNG, I_WOUT, I_WPP, I_PLEG, I_WGATE, I_FING };

__device__ __forceinline__ float wave_sum(float v) {
#pragma unroll
  for (int o = 32; o > 0; o >>= 1) v += __shfl_xor(v, o);
  return v;
}
__device__ __forceinline__ float sum16(float v) {
  v += __shfl_xor(v, 1); v += __shfl_xor(v, 2); v += __shfl_xor(v, 4); v += __shfl_xor(v, 8);
  return v;
}
__device__ __forceinline__ float sigmoidf_(float x) { return __builtin_amdgcn_rcpf(1.f + __expf(-x)); }
__device__ __forceinline__ float siluf_(float x) { return x * __builtin_amdgcn_rcpf(1.f + __expf(-x)); }
__device__ __forceinline__ float gelu_tanh(float y) {
  float z = 0.7978845608028654f * (y + 0.044715f * y * y * y);
  return y * __builtin_amdgcn_rcpf(1.f + __expf(-2.f * z));
}
__device__ __forceinline__ h16x8 pack8(f32x4 lo, f32x4 hi) {
  h16x8 r;
  r[0] = (h16)lo[0]; r[1] = (h16)lo[1]; r[2] = (h16)lo[2]; r[3] = (h16)lo[3];
  r[4] = (h16)hi[0]; r[5] = (h16)hi[1]; r[6] = (h16)hi[2]; r[7] = (h16)hi[3];
  return r;
}
__device__ __forceinline__ int perm_pos(int n) { return (n & ~31) + (((n & 15) >> 2) << 3) + (((n >> 4) & 1) << 2) + (n & 3); }
__device__ __forceinline__ int perm_inv(int pos) {
  int q5 = pos & 31, qq = q5 >> 3, jj = q5 & 7;
  return (pos & ~31) + (jj < 4 ? 4 * qq + jj : 16 + 4 * qq + (jj - 4));
}

__device__ void transpose_w(const float* __restrict__ W, int K, int N, int Npad, h16* __restrict__ WT, int t, float* tile) {
  const int ntn = Npad / 64;
  const int kt = t / ntn, nt = t % ntn, k0 = kt * 64, n0 = nt * 64;
  const int tx = threadIdx.x & 63, ty = threadIdx.x >> 6;
  for (int r = 0; r < 16; ++r) {
    int k = ty * 16 + r, n = n0 + tx;
    tile[k * 65 + tx] = (n < N) ? W[(size_t)(k0 + k) * N + n] : 0.f;
  }
  __syncthreads();
  for (int r = 0; r < 16; ++r) {
    int n = ty * 16 + r;
    WT[(size_t)(n0 + n) * K + k0 + tx] = (h16)tile[tx * 65 + n];
  }
  __syncthreads();
}

__device__ void ssm_table_item(const Params& p, int g, int d, float* lds) {
  float2* sAp = (float2*)lds;
  float2* sW = sAp + 64;
  const int tid = threadIdx.x;
  h16* KTAB = (h16*)(p.ws + OFF_KTAB);
  h16* ETAB = (h16*)(p.ws + OFF_ETAB);
  h16* FTAB = (h16*)(p.ws + OFF_FTAB);
  float* ALPOW = (float*)(p.ws + OFF_ALPOW);
  float* sBr = lds + 256; float* sBi = sBr + 1024; float* sCr = sBi + 1024; float* sCi = sCr + 16 * 65;
  {
    const float4 vbr = ((const float4*)(p.in[I_BRE] + g * 1024))[tid], vbi = ((const float4*)(p.in[I_BIM] + g * 1024))[tid];
    const float4 vcr = ((const float4*)(p.in[I_CRE] + g * 1024))[tid], vci = ((const float4*)(p.in[I_CIM] + g * 1024))[tid];
    *(float4*)(sBr + tid * 4) = vbr; *(float4*)(sBi + tid * 4) = vbi;
    const int ch = (tid * 4) >> 6, cp = (tid * 4) & 63;
    sCr[ch * 65 + cp] = vcr.x; sCr[ch * 65 + cp + 1] = vcr.y; sCr[ch * 65 + cp + 2] = vcr.z; sCr[ch * 65 + cp + 3] = vcr.w;
    sCi[ch * 65 + cp] = vci.x; sCi[ch * 65 + cp + 1] = vci.y; sCi[ch * 65 + cp + 2] = vci.z; sCi[ch * 65 + cp + 3] = vci.w;
  }
  if (tid < 64) {
    const int pp = tid;
    float lr = p.in[I_ARE][g * 64 + pp], li = p.in[I_AIM][g * 64 + pp], dt = expf(p.in[I_LOGDT][g]);
    float mag = expf(lr * dt), ang = li * dt;
    float abr = mag * cosf(ang), abi = mag * sinf(ang);
    float nr = abr - 1.f, ni = abi, den = lr * lr + li * li;
    float cr = (nr * lr + ni * li) / den, ci = (ni * lr - nr * li) / den;
    float apr = 1.f, api = 0.f;
    for (int k = 0; k < d; ++k) { float t0 = apr * abr - api * abi; api = apr * abi + api * abr; apr = t0; }
    sAp[pp] = make_float2(apr, api);
    sW[pp] = make_float2(apr * cr - api * ci, apr * ci + api * cr);
    if (d == 32) { ALPOW[(g * 64 + pp) * 2] = apr; ALPOW[(g * 64 + pp) * 2 + 1] = api; }
  }
  __syncthreads();
  if (d < 32) {
    {
      const int h = tid >> 4, hp = tid & 15;
      float acc = 0.f;
#pragma unroll 8
      for (int pp = 0; pp < 64; ++pp) {
        float2 W = sW[pp];
        float br = sBr[pp * 16 + hp], bi = sBi[pp * 16 + hp];
        float wbr = W.x * br - W.y * bi, wbi = W.x * bi + W.y * br;
        float cr = sCr[h * 65 + pp], ci = sCi[h * 65 + pp];
        acc += cr * wbr - ci * wbi;
      }
      if (d == 0 && h == hp) acc += p.in[I_D][g * 16 + h];
      KTAB[(size_t)(g * 33 + d + 1) * 256 + h * 16 + hp] = (h16)acc;
      if (d == 0) KTAB[(size_t)(g * 33) * 256 + tid] = (h16)0.f;
    }
    {
      const int i = 31 - d;
#pragma unroll
      for (int r = 0; r < 4; ++r) {
        int idx = tid + 256 * r, pp = idx >> 4, hp = idx & 15;
        float2 W = sW[pp];
        float br = sBr[pp * 16 + hp], bi = sBi[pp * 16 + hp];
        float wbr = W.x * br - W.y * bi, wbi = W.x * bi + W.y * br;
        ETAB[((size_t)g * 128 + pp) * 512 + i * 16 + hp] = (h16)wbr;
        ETAB[((size_t)g * 128 + 64 + pp) * 512 + i * 16 + hp] = (h16)wbi;
      }
    }
  }
  if (d >= 1) {
    const int j = d - 1;
#pragma unroll
    for (int r = 0; r < 4; ++r) {
      int idx = tid + 256 * r, h = idx >> 6, pp = idx & 63;
      float2 Ap = sAp[pp];
      float cr = sCr[h * 65 + pp], ci = sCi[h * 65 + pp];
      float re = cr * Ap.x - ci * Ap.y, im = cr * Ap.y + ci * Ap.x;
      FTAB[((size_t)g * 512 + j * 16 + h) * 128 + pp] = (h16)re;
      FTAB[((size_t)g * 512 + j * 16 + h) * 128 + 64 + pp] = (h16)(-im);
    }
  }
  __syncthreads();
}

__device__ void phase0(const Params& p, unsigned char* smem) {
  const int bid = blockIdx.x, nb = gridDim.x, tid = threadIdx.x, wid = tid >> 6, lane = tid & 63;
  float* tile = (float*)smem;
  for (int t = bid; t < 1440; t += nb) {
    if (t < 800) transpose_w(p.in[I_WIN], 1024, 3080, 3200, (h16*)(p.ws + OFF_WIN), t, tile);
    else if (t < 864) transpose_w(p.in[I_WGLU], 512, 512, 512, (h16*)(p.ws + OFF_WGLU), t - 800, tile);
    else if (t < 1120) transpose_w(p.in[I_WOUT], 1024, 1024, 1024, (h16*)(p.ws + OFF_WOUT), t - 864, tile);
    else if (t < 1184) transpose_w(p.in[I_WPP], 256, 1024, 1024, (h16*)(p.ws + OFF_WPP), t - 1120, tile);
    else transpose_w(p.in[I_WGATE], 1024, 1024, 1024, (h16*)(p.ws + OFF_WGATE), t - 1184, tile);
  }
  for (int it = bid; it < 32 * 33; it += nb) ssm_table_item(p, it / 33, it % 33, (float*)smem);
  {
    h16* A0 = (h16*)((unsigned char*)p.out + OUT_OFF_A0);
    const float* x = p.in[I_X];
    const float4* g4 = (const float4*)p.in[I_NMG];
    for (int row = bid * 4 + wid; row < T_TOK; row += nb * 4) {
      const float4* xr = (const float4*)(x + (size_t)row * 1024);
      float4 v[4];
      float ss = 0.f;
#pragma unroll
      for (int i = 0; i < 4; ++i) {
        v[i] = xr[lane + i * 64];
        ss += v[i].x * v[i].x + v[i].y * v[i].y + v[i].z * v[i].z + v[i].w * v[i].w;
      }
      ss = wave_sum(ss);
      float rstd = rsqrtf(ss * (1.f / 1024.f) + 1e-6f);
#pragma unroll
      for (int i = 0; i < 4; ++i) {
        float4 g = g4[lane + i * 64];
        h16x4 o;
        o[0] = (h16)(v[i].x * rstd * g.x); o[1] = (h16)(v[i].y * rstd * g.y);
        o[2] = (h16)(v[i].z * rstd * g.z); o[3] = (h16)(v[i].w * rstd * g.w);
        *(h16x4*)(A0 + (size_t)row * 1024 + (lane + i * 64) * 4) = o;
      }
    }
  }
  {
    h16* PB = (h16*)(p.ws + OFF_PB);
    const float4* p4 = (const float4*)p.in[I_P];
    const size_t n4 = (size_t)T_TOK * 256 / 4;
    for (size_t i = (size_t)bid * 256 + tid; i < n4; i += (size_t)nb * 256) {
      float4 v = p4[i];
      h16x4 o;
      o[0] = (h16)v.x; o[1] = (h16)v.y; o[2] = (h16)v.z; o[3] = (h16)v.w;
      *(h16x4*)(PB + i * 4) = o;
    }
  }
}

enum { EPI_PROJ = 0, EPI_GLU, EPI_PLE, EPI_OUT, EPI_GATE, EPI_LOCAL };

template <int EPI>
__device__ __forceinline__ void gemm_tile(const Params& p, const h16* __restrict__ A, int lda, const h16* __restrict__ Bt, int ldb,
                                          int K, int brow, int bcol, unsigned char* smem) {
  const int tid = threadIdx.x, wid = tid >> 6, lane = tid & 63, wr = wid >> 1, wc = wid & 1, fr = lane & 15, fq = lane >> 4;
  f32x4 acc[4][4];
#pragma unroll
  for (int m = 0; m < 4; ++m)
#pragma unroll
    for (int n = 0; n < 4; ++n) acc[m][n] = f32x4{0.f, 0.f, 0.f, 0.f};
  const int nk = K / 64;
  const h16* ga[4]; const h16* gb[4];
#pragma unroll
  for (int i = 0; i < 4; ++i) {
    const int L = tid + 256 * i, row = L >> 3, cs = (L & 7) ^ (row & 7);
    ga[i] = A + (size_t)(brow + row) * lda + cs * 8;
    gb[i] = Bt + (size_t)(bcol + row) * ldb + cs * 8;
  }
#define GEMM_STAGE(t_, buf_) do { \
    unsigned char* sa_ = smem + (buf_) * 32768 + tid * 16; \
    _Pragma("unroll") for (int i_ = 0; i_ < 4; ++i_) { \
      __builtin_amdgcn_global_load_lds((const unsigned*)(ga[i_] + (t_) * 64), (unsigned*)(sa_ + i_ * 4096), 16, 0, 0); \
      __builtin_amdgcn_global_load_lds((const unsigned*)(gb[i_] + (t_) * 64), (unsigned*)(sa_ + 16384 + i_ * 4096), 16, 0, 0); \
    } \
  } while (0)
  GEMM_STAGE(0, 0);
  for (int t = 0; t < nk; ++t) {
    asm volatile("s_waitcnt vmcnt(0)" ::: "memory");
    __syncthreads();
    if (t + 1 < nk) GEMM_STAGE(t + 1, (t + 1) & 1);
    const unsigned char* SA = smem + (t & 1) * 32768;
    const unsigned char* SB = SA + 16384;
    h16x8 af[2][4], bf[2][4];
#pragma unroll
    for (int kk = 0; kk < 2; ++kk) {
      const int pos = ((kk * 4 + fq) ^ (fr & 7)) << 4;
#pragma unroll
      for (int m = 0; m < 4; ++m) {
        af[kk][m] = *(const h16x8*)(SA + (wr * 64 + m * 16 + fr) * 128 + pos);
        bf[kk][m] = *(const h16x8*)(SB + (wc * 64 + m * 16 + fr) * 128 + pos);
      }
    }
    __builtin_amdgcn_s_setprio(1);
#pragma unroll
    for (int kk = 0; kk < 2; ++kk)
#pragma unroll
      for (int m = 0; m < 4; ++m)
#pragma unroll
        for (int n = 0; n < 4; ++n) acc[m][n] = MFMA(af[kk][m], bf[kk][n], acc[m][n]);
    __builtin_amdgcn_s_setprio(0);
  }
#undef GEMM_STAGE
  __syncthreads();
  float* CT = (float*)smem;
  const int c4 = tid & 31, col = bcol + c4 * 4, r0 = tid >> 5;
  float4 pre_f[16];
  h16x4 pre_a[16], pre_b[16];
  float4 cst = {0.f, 0.f, 0.f, 0.f};
  if constexpr (EPI == EPI_OUT) {
#pragma unroll
    for (int it = 0; it < 16; ++it) pre_f[it] = *(const float4*)(p.in[I_X] + ((size_t)brow + it * 8 + r0) * 1024 + col);
  } else if constexpr (EPI == EPI_GLU) {
    cst = *(const float4*)(p.in[I_BGLU] + col);
#pragma unroll
    for (int it = 0; it < 16; ++it) {
      const size_t row = (size_t)brow + it * 8 + r0;
      pre_a[it] = *(const h16x4*)((const h16*)((unsigned char*)p.out + OUT_OFF_YPRE) + row * 512 + col);
      pre_b[it] = *(const h16x4*)((const h16*)(p.ws + OFF_PROJ) + row * LDP + 512 + col);
    }
  } else if constexpr (EPI == EPI_GATE) {
    cst = *(const float4*)(p.in[I_PLEG] + col);
#pragma unroll
    for (int it = 0; it < 16; ++it) {
      const size_t row = (size_t)brow + it * 8 + r0;
      pre_a[it] = *(const h16x4*)((const h16*)(p.ws + OFF_EH) + row * 1024 + col);
      pre_b[it] = *(const h16x4*)((const h16*)(p.ws + OFF_PROJ) + row * 1024 + col);
    }
    if (tid < 128) {
      const float4 e0 = *(const float4*)((const float*)(p.ws + OFF_EPART) + ((size_t)brow + tid) * 8);
      const float4 e1 = *(const float4*)((const float*)(p.ws + OFF_EPART) + ((size_t)brow + tid) * 8 + 4);
      ((float*)(smem + 67584))[tid] = rsqrtf((e0.x + e0.y + e0.z + e0.w + e1.x + e1.y + e1.z + e1.w) * (1.f / 1024.f) + 1e-6f);
    }
  }
#pragma unroll
  for (int m = 0; m < 4; ++m)
#pragma unroll
    for (int n = 0; n < 4; ++n)
#pragma unroll
      for (int j = 0; j < 4; ++j) CT[(wr * 64 + m * 16 + fq * 4 + j) * 132 + wc * 64 + n * 16 + fr] = acc[m][n][j];
  __syncthreads();
#pragma unroll
  for (int it = 0; it < 16; ++it) {
    const int rl = it * 8 + r0;
    const size_t row = (size_t)brow + rl;
    const float4 v = *(const float4*)(CT + rl * 132 + c4 * 4);
    if constexpr (EPI == EPI_PROJ) {
      if (bcol < 512) {
        h16x4 o; o[0] = (h16)v.x; o[1] = (h16)v.y; o[2] = (h16)v.z; o[3] = (h16)v.w;
        *(h16x4*)((h16*)(p.ws + OFF_US) + ((size_t)(col >> 4) * T_TOK + row) * 16 + (col & 15)) = o;
      } else if (bcol < 3072) {
        h16x4 o; o[0] = (h16)v.x; o[1] = (h16)v.y; o[2] = (h16)v.z; o[3] = (h16)v.w;
        *(h16x4*)((h16*)(p.ws + OFF_PROJ) + row * LDP + col) = o;
      } else if (c4 < 2) {
        *(float4*)((float*)(p.ws + OFF_AB) + row * 8 + c4 * 4) = v;
      }
    } else if constexpr (EPI == EPI_LOCAL) {
      *(float4*)((float*)(p.ws + OFF_LOCALG) + row * 128 + col) = v;
    } else if constexpr (EPI == EPI_GLU) {
      const h16x4 y = pre_a[it], z = pre_b[it];
      h16x4 o;
      o[0] = (h16)((float)y[0] * sigmoidf_(v.x + cst.x) * siluf_((float)z[0]));
      o[1] = (h16)((float)y[1] * sigmoidf_(v.y + cst.y) * siluf_((float)z[1]));
      o[2] = (h16)((float)y[2] * sigmoidf_(v.z + cst.z) * siluf_((float)z[2]));
      o[3] = (h16)((float)y[3] * sigmoidf_(v.w + cst.w) * siluf_((float)z[3]));
      *(h16x4*)((h16*)(p.ws + OFF_MIXIN) + row * 1024 + col) = o;
    } else if constexpr (EPI == EPI_PLE) {
      h16x4 o; o[0] = (h16)v.x; o[1] = (h16)v.y; o[2] = (h16)v.z; o[3] = (h16)v.w;
      *(h16x4*)((h16*)(p.ws + OFF_EH) + row * 1024 + col) = o;
      float s = v.x * v.x + v.y * v.y + v.z * v.z + v.w * v.w;
      s = sum16(s); s += __shfl_xor(s, 16);
      if (c4 == 0) ((float*)(p.ws + OFF_EPART))[row * 8 + (bcol >> 7)] = s;
    } else if constexpr (EPI == EPI_OUT) {
      const float4 xv = pre_f[it];
      h16x4 o; o[0] = (h16)(xv.x + v.x); o[1] = (h16)(xv.y + v.y); o[2] = (h16)(xv.z + v.z); o[3] = (h16)(xv.w + v.w);
      *(h16x4*)((h16*)(p.ws + OFF_PROJ) + row * 1024 + col) = o;
    } else if constexpr (EPI == EPI_GATE) {
      const float rs = ((const float*)(smem + 67584))[rl];
      const h16x4 eh = pre_a[it], hb = pre_b[it];
      float4 hv;
      hv.x = (float)hb[0] + sigmoidf_(v.x) * ((float)eh[0] * rs * cst.x);
      hv.y = (float)hb[1] + sigmoidf_(v.y) * ((float)eh[1] * rs * cst.y);
      hv.z = (float)hb[2] + sigmoidf_(v.z) * ((float)eh[2] * rs * cst.z);
      hv.w = (float)hb[3] + sigmoidf_(v.w) * ((float)eh[3] * rs * cst.w);
      {
        h16x4 o; o[0] = (h16)hv.x; o[1] = (h16)hv.y; o[2] = (h16)hv.z; o[3] = (h16)hv.w;
        *(h16x4*)((h16*)(p.ws + OFF_MIXIN) + row * 1024 + col) = o;
      }
      float s = hv.x * hv.x + hv.y * hv.y + hv.z * hv.z + hv.w * hv.w;
      s = sum16(s); s += __shfl_xor(s, 16);
      if (c4 == 0) ((float*)(p.ws + OFF_OPART))[row * 8 + (bcol >> 7)] = s;
    }
  }
  __syncthreads();
}

__device__ void ssm_item(const Params& p, int b, int g, unsigned char* smem) {
  float* LOCAL = (float*)smem;
  h16* SPREV = (h16*)(smem + 33792);
  h16* KT = (h16*)(smem + 51200);
  unsigned char* ERING = smem + 33792;
  unsigned char* FRING = smem;
  int tid_ = threadIdx.x;
  asm volatile("" : "+v"(tid_));
  const int tid = tid_, w = tid >> 6, lane = tid & 63, fr = lane & 15, fq = lane >> 4;
  const h16* PROJ = (const h16*)(p.ws + OFF_PROJ);
  const h16* Eg = (const h16*)(p.ws + OFF_ETAB) + (size_t)g * 128 * 512;
  const h16* Kg = (const h16*)(p.ws + OFF_KTAB) + (size_t)g * 33 * 256;
  const h16* Fg = (const h16*)(p.ws + OFF_FTAB) + (size_t)g * 512 * 128;
  const float* ALPOW = (const float*)(p.ws + OFF_ALPOW);
  h16* YPRE = (h16*)((unsigned char*)p.out + OUT_OFF_YPRE);
  const int nchunk = w * 16 + fr;
  const size_t tok0 = (size_t)b * SEQ + (size_t)nchunk * 32;
  h16x8 uf[16];
#pragma unroll
  for (int ks = 0; ks < 16; ++ks) {
    const int i = 2 * ks + (fq >> 1);
    uf[ks] = *(const h16x8*)((const h16*)(p.ws + OFF_US) + ((size_t)g * T_TOK + tok0 + i) * 16 + (fq & 1) * 8);
  }
#pragma unroll
  for (int ks = 0; ks < 16; ++ks) asm volatile("" : "+v"(uf[ks]));
  {
    const float* lg = (const float*)(p.ws + OFF_LOCALG) + ((size_t)g * 1024 + (size_t)b * 64) * 128;
#pragma unroll
    for (int i = 0; i < 8; ++i) {
      const int idx = tid + 256 * i, c = idx >> 5, s4 = idx & 31;
      *(float4*)(LOCAL + c * 132 + s4 * 4) = *(const float4*)(lg + (size_t)c * 128 + s4 * 4);
    }
  }
  {
    h16x8 kt[5];
#pragma unroll
    for (int i = 0; i < 5; ++i) { const int idx = tid + 256 * i; kt[i] = *(const h16x8*)(Kg + (idx < 1056 ? idx : 1055) * 8); }
#pragma unroll
    for (int i = 0; i < 5; ++i) { const int idx = tid + 256 * i; if (idx < 1056) *(h16x8*)(KT + idx * 8) = kt[i]; }
  }
  __syncthreads();
  if (tid < 64) {
    const int pp = tid;
    const float ar = ALPOW[(g * 64 + pp) * 2], ai = ALPOW[(g * 64 + pp) * 2 + 1];
    float sr = 0.f, si = 0.f;
#pragma unroll 1
    for (int c8 = 0; c8 < 8; ++c8) {
      float lr[8], li[8];
#pragma unroll
      for (int k = 0; k < 8; ++k) { lr[k] = LOCAL[(c8 * 8 + k) * 132 + pp]; li[k] = LOCAL[(c8 * 8 + k) * 132 + 64 + pp]; }
#pragma unroll
      for (int k = 0; k < 8; ++k) {
        SPREV[(c8 * 8 + k) * 136 + pp] = (h16)sr;
        SPREV[(c8 * 8 + k) * 136 + 64 + pp] = (h16)si;
        const float nr = ar * sr - ai * si + lr[k];
        const float ni = ar * si + ai * sr + li[k];
        sr = nr; si = ni;
      }
    }
  }
  asm volatile("s_waitcnt vmcnt(0)" ::: "memory");
  __syncthreads();
  h16x8 sf[4];
#pragma unroll
  for (int ks = 0; ks < 4; ++ks) sf[ks] = *(const h16x8*)(SPREV + nchunk * 136 + ks * 32 + fq * 8);
  const h16* fsrc = Fg + (size_t)(tid >> 4) * 128 + (((tid & 15) ^ (tid >> 4)) << 3);
#define F_STAGE(j_) __builtin_amdgcn_global_load_lds((const unsigned*)(fsrc + (size_t)((j_) < 31 ? (j_) : 31) * 16 * 128), \
                                                     (unsigned*)(FRING + ((j_) & 7) * 4096 + tid * 16), 16, 0, 0)
  F_STAGE(0); F_STAGE(1); F_STAGE(2);
#pragma unroll 1
  for (int j = 0; j < 32; ++j) {
    if (j == 0) asm volatile("s_waitcnt vmcnt(2)" ::: "memory");
    else if (j == 1) asm volatile("s_waitcnt vmcnt(3)" ::: "memory");
    else if (j == 2) asm volatile("s_waitcnt vmcnt(4)" ::: "memory");
    else asm volatile("s_waitcnt vmcnt(5)" ::: "memory");
    asm volatile("s_waitcnt lgkmcnt(0)" ::: "memory");
    __builtin_amdgcn_s_barrier();
    asm volatile("" ::: "memory");
    F_STAGE(j + 3);
    asm volatile("" ::: "memory");
    f32x4 acc = {0.f, 0.f, 0.f, 0.f}, acc2 = {0.f, 0.f, 0.f, 0.f};
#pragma unroll
    for (int ks = 0; ks < 16; ++ks) {
      if (2 * ks <= j) {
        const int dd = j - 2 * ks - (fq >> 1) + 1;
        h16x8 a = *(const h16x8*)(KT + dd * 256 + fr * 16 + (fq & 1) * 8);
        if (ks & 1) acc2 = MFMA(a, uf[ks], acc2); else acc = MFMA(a, uf[ks], acc);
      }
    }
    const unsigned char* slot = FRING + (j & 7) * 4096 + fr * 256;
#pragma unroll
    for (int ks = 0; ks < 4; ++ks) {
      h16x8 a = *(const h16x8*)(slot + (((ks * 4 + fq) ^ fr) << 4));
      if (ks & 1) acc2 = MFMA(a, sf[ks], acc2); else acc = MFMA(a, sf[ks], acc);
    }
    h16x4 o;
    o[0] = (h16)gelu_tanh(acc[0] + acc2[0]);
    o[1] = (h16)gelu_tanh(acc[1] + acc2[1]);
    o[2] = (h16)gelu_tanh(acc[2] + acc2[2]);
    o[3] = (h16)gelu_tanh(acc[3] + acc2[3]);
    *(h16x4*)(YPRE + (tok0 + j) * 512 + g * 16 + fq * 4) = o;
    asm volatile("" ::: "memory");
  }
#undef F_STAGE
  asm volatile("s_waitcnt vmcnt(0)" ::: "memory");
  __syncthreads();
}

__device__ void gdn_pre_item(const Params& p, int item, unsigned char* smem) {
  h16* QH = (h16*)smem;
  h16* KH = (h16*)(smem + 17408);
  h16* VH = (h16*)(smem + 34816);
  float* Ld = (float*)(smem + 52224);
  h16* Limg = (h16*)(smem + 56576);
  h16* Dimg = (h16*)(smem + 60672);
  float* sG = (float*)(smem + 69632);
  float* sBeta = (float*)(smem + 69888);
  float* sEG = (float*)(smem + 70144);
  float* sBG = (float*)(smem + 70400);
  float* sEL = (float*)(smem + 70656);
  int tid_ = threadIdx.x;
  asm volatile("" : "+v"(tid_));
  const int tid = tid_, w = tid >> 6, lane = tid & 63, fr = lane & 15, fq = lane >> 4;
  const int c = item & 31, h = (item >> 5) & 3, b = item >> 7;
  const h16* PROJ = (const h16*)(p.ws + OFF_PROJ);
  const float* AB = (const float*)(p.ws + OFF_AB);
  const float* convw = p.in[I_CONVW];
  h16* WPi = (h16*)(p.ws + OFF_WP) + (size_t)item * 64 * 128;
  h16* QGPi = (h16*)(p.ws + OFF_QGP) + (size_t)item * 64 * 128;
  h16* KDTi = (h16*)(p.ws + OFF_KDT) + (size_t)item * 128 * 64;
  h16* UTi = (h16*)(p.ws + OFF_UT) + (size_t)item * 128 * 64;
  h16* ATPi = (h16*)(p.ws + OFF_ATP) + (size_t)item * 64 * 64;
  h16* ZTi = (h16*)((unsigned char*)p.out + OUT_OFF_ZT) + (size_t)item * 128 * 64;
  float* DL = (float*)(p.ws + OFF_DL);
  {
    const h16x8 z8 = {(h16)0.f, (h16)0.f, (h16)0.f, (h16)0.f, (h16)0.f, (h16)0.f, (h16)0.f, (h16)0.f};
    *(h16x8*)(Limg + tid * 8) = z8; *(h16x8*)(Limg + 2048 + tid * 8) = z8;
  }
  {
    const int ch0 = (tid & 15) * 8, t0 = (tid >> 4) * 4;
#pragma unroll 1
    for (int sec = 0; sec < 3; ++sec) {
      const int colbase = 1024 + sec * 512 + h * 128 + ch0;
      h16x8 xr[7];
#pragma unroll
      for (int i = 0; i < 7; ++i) {
        const int ts = c * 64 + t0 - 3 + i;
        h16x8 z8 = {(h16)0.f, (h16)0.f, (h16)0.f, (h16)0.f, (h16)0.f, (h16)0.f, (h16)0.f, (h16)0.f};
        xr[i] = (ts >= 0) ? *(const h16x8*)(PROJ + ((size_t)b * SEQ + ts) * LDP + colbase) : z8;
      }
      float4 wv[4][2];
#pragma unroll
      for (int jj = 0; jj < 4; ++jj) {
        wv[jj][0] = *(const float4*)(convw + jj * 1536 + sec * 512 + h * 128 + ch0);
        wv[jj][1] = *(const float4*)(convw + jj * 1536 + sec * 512 + h * 128 + ch0 + 4);
      }
      h16* dst = (sec == 0 ? QH : (sec == 1 ? KH : VH));
#pragma unroll
      for (int tt = 0; tt < 4; ++tt) {
        float a[8];
#pragma unroll
        for (int e = 0; e < 8; ++e) a[e] = 0.f;
#pragma unroll
        for (int jj = 0; jj < 4; ++jj) {
          const h16x8 xv = xr[tt + jj];
          a[0] += wv[jj][0].x * (float)xv[0]; a[1] += wv[jj][0].y * (float)xv[1]; a[2] += wv[jj][0].z * (float)xv[2]; a[3] += wv[jj][0].w * (float)xv[3];
          a[4] += wv[jj][1].x * (float)xv[4]; a[5] += wv[jj][1].y * (float)xv[5]; a[6] += wv[jj][1].z * (float)xv[6]; a[7] += wv[jj][1].w * (float)xv[7];
        }
        float ss = 0.f;
#pragma unroll
        for (int e = 0; e < 8; ++e) { a[e] = siluf_(a[e]); ss += a[e] * a[e]; }
        float scale = 1.f;
        if (sec < 2) {
          ss = sum16(ss);
          scale = rsqrtf(ss + 1e-6f) * (sec == 0 ? 0.08838834764831845f : 1.f);
        }
        h16x8 o;
#pragma unroll
        for (int e = 0; e < 8; ++e) o[e] = (h16)(a[e] * scale);
        *(h16x8*)(dst + (t0 + tt) * 136 + ch0) = o;
      }
    }
  }
  if (tid < 64) {
    const size_t tok = (size_t)b * SEQ + c * 64 + tid;
    float braw = AB[tok * 8 + h], araw = AB[tok * 8 + 4 + h];
    float beta = 1.f / (1.f + expf(-braw));
    float xx = araw + p.in[I_DTB][h];
    float sp = xx > 20.f ? xx : log1pf(expf(xx));
    float gg = -expf(p.in[I_ALOG][h]) * sp;
#pragma unroll
    for (int o = 1; o < 64; o <<= 1) {
      float v = __shfl_up(gg, o);
      if (lane >= o) gg += v;
    }
    sG[tid] = gg;
    sBeta[tid] = beta;
    const float eg = expf(gg);
    sEG[tid] = eg;
    sBG[tid] = beta * eg;
    sEL[tid] = expf(__shfl(gg, 63) - gg);
  }
  __syncthreads();
  {
    h16x8 ak[4], aq[4];
#pragma unroll
    for (int ks = 0; ks < 4; ++ks) {
      ak[ks] = *(const h16x8*)(KH + (w * 16 + fr) * 136 + ks * 32 + fq * 8);
      aq[ks] = *(const h16x8*)(QH + (w * 16 + fr) * 136 + ks * 32 + fq * 8);
    }
#pragma unroll
    for (int jt = 0; jt < 4; ++jt) {
      const int j = jt * 16 + fr;
      const int pj = perm_pos(j);
      if (jt <= w) {
        f32x4 kk = {0.f, 0.f, 0.f, 0.f}, qk = {0.f, 0.f, 0.f, 0.f};
#pragma unroll
        for (int ks = 0; ks < 4; ++ks) {
          h16x8 bk = *(const h16x8*)(KH + (jt * 16 + fr) * 136 + ks * 32 + fq * 8);
          kk = MFMA(ak[ks], bk, kk);
          qk = MFMA(aq[ks], bk, qk);
        }
        const float Gj = sG[j];
        f32x4 lt;
#pragma unroll
        for (int r = 0; r < 4; ++r) {
          const int i = w * 16 + 4 * fq + r;
          const float e = (i >= j) ? __expf(sG[i] - Gj) : 0.f;
          lt[r] = (i > j) ? sBeta[i] * kk[r] * e : 0.f;
          ATPi[i * 64 + (((pj >> 3) ^ (i & 7)) << 3) + (pj & 7)] = (h16)(qk[r] * e);
        }
        if (jt == w) {
#pragma unroll
          for (int r = 0; r < 4; ++r) Ld[(w * 16 + 4 * fq + r) * 17 + fr] = lt[r];
        } else {
          const int img = (w == 1) ? 0 : (w == 2 ? 1 : (jt < 2 ? 2 : 3));
#pragma unroll
          for (int r = 0; r < 4; ++r) Limg[img * 512 + (4 * fq + r) * 32 + (fr >> 2) * 8 + (fr & 3) + 4 * (jt & 1)] = (h16)(-lt[r]);
        }
      } else {
#pragma unroll
        for (int r = 0; r < 4; ++r) {
          const int i = w * 16 + 4 * fq + r;
          ATPi[i * 64 + (((pj >> 3) ^ (i & 7)) << 3) + (pj & 7)] = (h16)0.f;
        }
      }
    }
  }
  __syncthreads();
  if (lane < 16) {
    float y[16];
#pragma unroll
    for (int i = 0; i < 16; ++i) {
      float s = (i == lane) ? 1.f : 0.f;
#pragma unroll
      for (int k = 0; k < i; ++k) s -= Ld[(w * 16 + i) * 17 + k] * y[k];
      y[i] = s;
    }
#pragma unroll
    for (int i = 0; i < 16; ++i) Dimg[w * 512 + i * 32 + (lane >> 2) * 8 + (lane & 3)] = (h16)y[i];
  }
  __syncthreads();
  f32x4 xs[4][4];
  {
    const h16* SRC = (w < 2) ? VH : KH;
    const float* scl = (w < 2) ? sBeta : sBG;
    const int cbase = (w & 1) * 64;
    h16x8 dA[4], lA[4];
#pragma unroll
    for (int b4 = 0; b4 < 4; ++b4) {
      dA[b4] = *(const h16x8*)(Dimg + b4 * 512 + fr * 32 + fq * 8);
      lA[b4] = *(const h16x8*)(Limg + b4 * 512 + fr * 32 + fq * 8);
    }
    const f32x4 z4 = {0.f, 0.f, 0.f, 0.f};
#pragma unroll
    for (int nt = 0; nt < 4; ++nt) {
      const int col = cbase + nt * 16 + fr;
      f32x4 rb[4];
#pragma unroll
      for (int b4 = 0; b4 < 4; ++b4)
#pragma unroll
        for (int r = 0; r < 4; ++r) rb[b4][r] = (float)SRC[(b4 * 16 + 4 * fq + r) * 136 + col] * scl[b4 * 16 + 4 * fq + r];
      const f32x4 x0 = MFMA(dA[0], pack8(rb[0], z4), z4);
      const f32x4 a1 = MFMA(lA[0], pack8(x0, z4), rb[1]);
      const f32x4 x1 = MFMA(dA[1], pack8(a1, z4), z4);
      const h16x8 x01 = pack8(x0, x1);
      const f32x4 a2 = MFMA(lA[1], x01, rb[2]);
      const f32x4 x2 = MFMA(dA[2], pack8(a2, z4), z4);
      f32x4 a3 = MFMA(lA[2], x01, rb[3]);
      a3 = MFMA(lA[3], pack8(x2, z4), a3);
      const f32x4 x3 = MFMA(dA[3], pack8(a3, z4), z4);
      xs[nt][0] = x0; xs[nt][1] = x1; xs[nt][2] = x2; xs[nt][3] = x3;
      if (w < 2) {
#pragma unroll
        for (int b4 = 0; b4 < 4; ++b4) {
          h16x4 o; o[0] = (h16)xs[nt][b4][0]; o[1] = (h16)xs[nt][b4][1]; o[2] = (h16)xs[nt][b4][2]; o[3] = (h16)xs[nt][b4][3];
          *(h16x4*)(UTi + (size_t)col * 64 + b4 * 16 + 4 * fq) = o;
        }
      }
    }
  }
  __syncthreads();
  if (w >= 2) {
#pragma unroll
    for (int nt = 0; nt < 4; ++nt) {
      const int pos = perm_pos((w & 1) * 64 + nt * 16 + fr);
#pragma unroll
      for (int b4 = 0; b4 < 4; ++b4)
#pragma unroll
        for (int r = 0; r < 4; ++r) VH[(b4 * 16 + 4 * fq + r) * 136 + pos] = (h16)xs[nt][b4][r];
    }
  }
  __syncthreads();
  for (int rr = 0; rr < 4; ++rr) {
    const int idx = tid + 256 * rr, row = idx >> 4, seg = idx & 15;
    *(h16x8*)(WPi + row * 128 + ((seg ^ (row & 15)) << 3)) = *(const h16x8*)(VH + row * 136 + seg * 8);
  }
  {
    const int dv = tid & 127, th = tid >> 7;
    const float gdv = p.in[I_DNG][dv];
    const h16* zp = PROJ + ((size_t)b * SEQ + c * 64 + th * 32) * LDP + 2560 + h * 128 + dv;
    h16 zv[32];
#pragma unroll
    for (int t = 0; t < 32; ++t) zv[t] = zp[(size_t)t * LDP];
#pragma unroll
    for (int t8 = 0; t8 < 4; ++t8) {
      h16x8 v;
#pragma unroll
      for (int e = 0; e < 8; ++e) v[e] = (h16)(siluf_((float)zv[t8 * 8 + e]) * gdv);
      *(h16x8*)(ZTi + (size_t)dv * 64 + th * 32 + t8 * 8) = v;
    }
  }
#pragma unroll 2
  for (int rr = 0; rr < 4; ++rr) {
    const int idx = tid + 256 * rr, t = idx >> 4, cpos = idx & 15, ks = cpos >> 2, q = cpos & 3;
    const h16x4 lo = *(const h16x4*)(QH + t * 136 + ks * 32 + 4 * q);
    const h16x4 hi = *(const h16x4*)(QH + t * 136 + ks * 32 + 16 + 4 * q);
    const float sc = sEG[t];
    h16x8 o;
#pragma unroll
    for (int e = 0; e < 4; ++e) { o[e] = (h16)((float)lo[e] * sc); o[4 + e] = (h16)((float)hi[e] * sc); }
    *(h16x8*)(QGPi + t * 128 + ((cpos ^ (t & 15)) << 3)) = o;
  }
#pragma unroll 2
  for (int rr = 0; rr < 4; ++rr) {
    const int idx = tid + 256 * rr, dk = idx >> 3, cpos = idx & 7, k2 = cpos >> 2, q = cpos & 3;
    h16x8 o;
#pragma unroll
    for (int e = 0; e < 8; ++e) {
      const int t = k2 * 32 + (e < 4 ? 4 * q + e : 16 + 4 * q + (e - 4));
      o[e] = (h16)((float)KH[t * 136 + dk] * sEL[t]);
    }
    *(h16x8*)(KDTi + dk * 64 + ((cpos ^ (dk & 7)) << 3)) = o;
  }
  const float Glast = sG[63];
  if (tid == 0) DL[item] = expf(Glast);
  __syncthreads();
}

template <int NB>
__device__ __forceinline__ void glds_copy(const h16* __restrict__ g, unsigned char* l) {
#pragma unroll
  for (int i = 0; i < NB / 4096; ++i) {
    const int off = threadIdx.x * 16 + i * 4096;
    __builtin_amdgcn_global_load_lds((const unsigned*)((const unsigned char*)g + off), (unsigned*)(l + off), 16, 0, 0);
  }
}
#define RAW_BARRIER() do { asm volatile("s_waitcnt lgkmcnt(0)" ::: "memory"); __builtin_amdgcn_s_barrier(); asm volatile("" ::: "memory"); } while (0)

__device__ void gdn_chain(const Params& p, int bh, unsigned char* smem) {
  const int tid = threadIdx.x, w = tid >> 6, lane = tid & 63, fr = lane & 15, fq = lane >> 4;
  const float* DL = (const float*)(p.ws + OFF_DL);
  const h16* WPb = (const h16*)(p.ws + OFF_WP) + (size_t)bh * 32 * 64 * 128;
  const h16* KDTb = (const h16*)(p.ws + OFF_KDT) + (size_t)bh * 32 * 128 * 64;
  h16* UTb = (h16*)(p.ws + OFF_UT) + (size_t)bh * 32 * 128 * 64;
  h16* SFb = (h16*)((unsigned char*)p.out + OUT_OFF_SF) + (size_t)bh * 32 * 128 * 128;
  f32x4 S[8][2];
#pragma unroll
  for (int i = 0; i < 8; ++i) { S[i][0] = f32x4{0.f, 0.f, 0.f, 0.f}; S[i][1] = f32x4{0.f, 0.f, 0.f, 0.f}; }
  h16x4 uR[4][2];
  const int uoff = (w * 32 + fr) * 64 + fq * 4;
  glds_copy<16384>(WPb, smem); glds_copy<16384>(KDTb, smem + 16384);
#pragma unroll
  for (int mt = 0; mt < 4; ++mt)
#pragma unroll
    for (int nt = 0; nt < 2; ++nt) uR[mt][nt] = *(const h16x4*)(UTb + uoff + nt * 1024 + mt * 16);
  float dl = DL[bh * 32];
  asm volatile("s_waitcnt vmcnt(0)" ::: "memory");
  RAW_BARRIER();
  for (int c = 0; c < 32; ++c) {
    const int cn = (c + 1 < 32) ? c + 1 : 31;
    const unsigned char* LW = smem + (c & 1) * 32768;
    const unsigned char* LK = LW + 16384;
    unsigned char* LWn = smem + ((c + 1) & 1) * 32768;
    f32x4 uf[4][2];
#pragma unroll
    for (int mt = 0; mt < 4; ++mt)
#pragma unroll
      for (int nt = 0; nt < 2; ++nt)
#pragma unroll
        for (int r = 0; r < 4; ++r) uf[mt][nt][r] = (float)uR[mt][nt][r];
    const float dlc = dl;
    asm volatile("" ::: "memory");
    h16x8 sfr[4][2];
#pragma unroll
    for (int ks = 0; ks < 4; ++ks) { sfr[ks][0] = pack8(S[2 * ks][0], S[2 * ks + 1][0]); sfr[ks][1] = pack8(S[2 * ks][1], S[2 * ks + 1][1]); }
#pragma unroll
    for (int ks = 0; ks < 4; ++ks)
#pragma unroll
      for (int nt = 0; nt < 2; ++nt)
        *(h16x8*)(SFb + ((size_t)(c * 4 + ks) * 8 + w * 2 + nt) * 512 + lane * 8) = sfr[ks][nt];
    glds_copy<16384>(WPb + (size_t)cn * 64 * 128, LWn);
    glds_copy<16384>(KDTb + (size_t)cn * 128 * 64, LWn + 16384);
#pragma unroll
    for (int mt = 0; mt < 4; ++mt)
#pragma unroll
      for (int nt = 0; nt < 2; ++nt)
        uR[mt][nt] = *(const h16x4*)(UTb + (size_t)cn * 128 * 64 + uoff + nt * 1024 + mt * 16);
    dl = DL[bh * 32 + cn];
    asm volatile("" ::: "memory");
    f32x4 vn[4][2];
#pragma unroll
    for (int mt = 0; mt < 4; ++mt) { vn[mt][0] = f32x4{0.f, 0.f, 0.f, 0.f}; vn[mt][1] = vn[mt][0]; }
#pragma unroll
    for (int ks = 0; ks < 4; ++ks)
#pragma unroll
      for (int mt = 0; mt < 4; ++mt) {
        h16x8 aw = *(const h16x8*)(LW + (mt * 16 + fr) * 256 + (((ks * 4 + fq) ^ fr) << 4));
        vn[mt][0] = MFMA(aw, sfr[ks][0], vn[mt][0]);
        vn[mt][1] = MFMA(aw, sfr[ks][1], vn[mt][1]);
      }
#pragma unroll
    for (int mt = 0; mt < 4; ++mt)
#pragma unroll
      for (int r = 0; r < 4; ++r) { vn[mt][0][r] = uf[mt][0][r] - vn[mt][0][r]; vn[mt][1][r] = uf[mt][1][r] - vn[mt][1][r]; }
    h16x8 vfr[2][2];
#pragma unroll
    for (int k2 = 0; k2 < 2; ++k2) { vfr[k2][0] = pack8(vn[2 * k2][0], vn[2 * k2 + 1][0]); vfr[k2][1] = pack8(vn[2 * k2][1], vn[2 * k2 + 1][1]); }
    if (c + 1 < 32) {
#pragma unroll
      for (int k2 = 0; k2 < 2; ++k2)
#pragma unroll
        for (int nt = 0; nt < 2; ++nt)
          *(h16x8*)(UTb + (size_t)c * 128 * 64 + ((size_t)k2 * 8 + w * 2 + nt) * 512 + lane * 8) = vfr[k2][nt];
    }
#pragma unroll
    for (int dkt = 0; dkt < 8; ++dkt) {
      f32x4 s0 = S[dkt][0], s1 = S[dkt][1];
#pragma unroll
      for (int r = 0; r < 4; ++r) { s0[r] *= dlc; s1[r] *= dlc; }
#pragma unroll
      for (int k2 = 0; k2 < 2; ++k2) {
        h16x8 ak = *(const h16x8*)(LK + (dkt * 16 + fr) * 128 + (((k2 * 4 + fq) ^ (fr & 7)) << 4));
        s0 = MFMA(ak, vfr[k2][0], s0);
        s1 = MFMA(ak, vfr[k2][1], s1);
      }
      S[dkt][0] = s0; S[dkt][1] = s1;
    }
    asm volatile("s_waitcnt vmcnt(0)" ::: "memory");
    RAW_BARRIER();
    if (c + 1 == 32) {
#pragma unroll
      for (int k2 = 0; k2 < 2; ++k2)
#pragma unroll
        for (int nt = 0; nt < 2; ++nt)
          *(h16x8*)(UTb + (size_t)c * 128 * 64 + ((size_t)k2 * 8 + w * 2 + nt) * 512 + lane * 8) = vfr[k2][nt];
    }
  }
  asm volatile("s_waitcnt vmcnt(0)" ::: "memory");
  __syncthreads();
}

__device__ void gdn_out_item(const Params& p, int item, unsigned char* smem) {
  unsigned char* LQ = smem;
  unsigned char* LA = smem + 16384;
  float* red = (float*)(smem + 24576);
  const int tid = threadIdx.x, w = tid >> 6, lane = tid & 63, fr = lane & 15, fq = lane >> 4;
  const int c = item & 31, h = (item >> 5) & 3, b = item >> 7;
  h16* MIXIN = (h16*)(p.ws + OFF_MIXIN);
  const h16* QGPi = (const h16*)(p.ws + OFF_QGP) + (size_t)item * 64 * 128;
  const h16* ATPi = (const h16*)(p.ws + OFF_ATP) + (size_t)item * 64 * 64;
  const h16* VFi = (const h16*)(p.ws + OFF_UT) + (size_t)item * 128 * 64;
  const h16* SFi = (const h16*)((unsigned char*)p.out + OUT_OFF_SF) + (size_t)item * 128 * 128;
  const h16* ZTi = (const h16*)((unsigned char*)p.out + OUT_OFF_ZT) + (size_t)item * 128 * 64;
  glds_copy<16384>(QGPi, LQ); glds_copy<8192>(ATPi, LA);
  h16x8 sfr[4][2], vfr[2][2];
#pragma unroll
  for (int ks = 0; ks < 4; ++ks)
#pragma unroll
    for (int nt = 0; nt < 2; ++nt) sfr[ks][nt] = *(const h16x8*)(SFi + ((size_t)ks * 8 + w * 2 + nt) * 512 + lane * 8);
#pragma unroll
  for (int k2 = 0; k2 < 2; ++k2)
#pragma unroll
    for (int nt = 0; nt < 2; ++nt) vfr[k2][nt] = *(const h16x8*)(VFi + ((size_t)k2 * 8 + w * 2 + nt) * 512 + lane * 8);
  h16x4 zR[4][2];
#pragma unroll
  for (int mt = 0; mt < 4; ++mt)
#pragma unroll
    for (int nt = 0; nt < 2; ++nt) zR[mt][nt] = *(const h16x4*)(ZTi + (size_t)(w * 32 + nt * 16 + fr) * 64 + mt * 16 + fq * 4);
  asm volatile("s_waitcnt vmcnt(0)" ::: "memory");
  __syncthreads();
  f32x4 o[4][2];
#pragma unroll
  for (int mt = 0; mt < 4; ++mt) {
    f32x4 o0 = {0.f, 0.f, 0.f, 0.f}, o1 = {0.f, 0.f, 0.f, 0.f};
#pragma unroll
    for (int ks = 0; ks < 4; ++ks) {
      h16x8 aq = *(const h16x8*)(LQ + (mt * 16 + fr) * 256 + (((ks * 4 + fq) ^ fr) << 4));
      o0 = MFMA(aq, sfr[ks][0], o0);
      o1 = MFMA(aq, sfr[ks][1], o1);
    }
#pragma unroll
    for (int k2 = 0; k2 < 2; ++k2) {
      h16x8 aa = *(const h16x8*)(LA + (mt * 16 + fr) * 128 + (((k2 * 4 + fq) ^ (fr & 7)) << 4));
      o0 = MFMA(aa, vfr[k2][0], o0);
      o1 = MFMA(aa, vfr[k2][1], o1);
    }
    o[mt][0] = o0; o[mt][1] = o1;
  }
#pragma unroll
  for (int mt = 0; mt < 4; ++mt)
#pragma unroll
    for (int r = 0; r < 4; ++r) {
      float s = o[mt][0][r] * o[mt][0][r] + o[mt][1][r] * o[mt][1][r];
      s = sum16(s);
      if (fr == 0) red[w * 64 + mt * 16 + 4 * fq + r] = s;
    }
  __syncthreads();
#pragma unroll
  for (int mt = 0; mt < 4; ++mt)
#pragma unroll
    for (int r = 0; r < 4; ++r) {
      const int tl = mt * 16 + 4 * fq + r;
      const float tot = red[tl] + red[64 + tl] + red[128 + tl] + red[192 + tl];
      const float rstd = rsqrtf(tot * (1.f / 128.f) + 1e-6f);
      const size_t tok = (size_t)b * SEQ + c * 64 + tl;
      h16* yp = MIXIN + tok * 1024 + 512 + h * 128 + w * 32 + fr;
      yp[0] = (h16)(o[mt][0][r] * rstd * (float)zR[mt][0][r]);
      yp[16] = (h16)(o[mt][1][r] * rstd * (float)zR[mt][1][r]);
    }
  __syncthreads();
}

#define XB_TMO      128
#define XB_XCNT(j)  (256  + 64 * (j))
#define XB_XSUB(j)  (1280 + 64 * (j))
#define XB_XGEN(j)  (2304 + 64 * (j))
#define XB_TOP      3328
#define XB_TOPGEN   3392
#define XCD_BAR_WORDS 3456
#define XB_SPIN_CAP (1u << 18)
#define LAS __attribute__((address_space(3)))

__device__ __forceinline__ unsigned xb_ld(unsigned* p)              { return __hip_atomic_load(p, __ATOMIC_RELAXED, __HIP_MEMORY_SCOPE_AGENT); }
__device__ __forceinline__ unsigned xb_add(unsigned* p, unsigned v) { return __hip_atomic_fetch_add(p, v, __ATOMIC_RELAXED, __HIP_MEMORY_SCOPE_AGENT); }
__device__ __forceinline__ unsigned xb_xcc_id() { return (unsigned)__builtin_amdgcn_s_getreg((3 << 11) | 20) & 0xFu; }
#define XB_SPIN(cond, bar) do { unsigned _sp = 0; while (cond) { __builtin_amdgcn_s_sleep(1); \
    if ((++_sp & 255u) == 0u) { if (xb_ld(&(bar)[XB_TMO])) break; if (_sp > XB_SPIN_CAP) { atomicAdd(&(bar)[XB_TMO], 1u); break; } } } } while (0)

struct XcdBarrier {
    unsigned* bar; unsigned x;
    volatile LAS unsigned* st;
};

__device__ __forceinline__ XcdBarrier xcd_barrier_post(unsigned* bar, volatile LAS unsigned* st) {
    XcdBarrier b; b.bar = bar; b.x = xb_xcc_id(); b.st = st;
    if (threadIdx.x == 0) (void)xb_add(&bar[XB_XCNT(b.x)], 1u);
    return b;
}
__device__ __forceinline__ void xcd_barrier_complete(unsigned* bar, unsigned x, unsigned& nloc, unsigned& nx) {
    const unsigned G = gridDim.x * gridDim.y * gridDim.z;
    unsigned sum, cnt, mine, sp = 0u;
    for (;;) {
        sum = 0u; cnt = 0u; mine = 0u;
#pragma unroll
        for (unsigned j = 0; j < 16; ++j) { const unsigned c = xb_ld(&bar[XB_XCNT(j)]); sum += c; cnt += (c > 0u) ? 1u : 0u; mine = (j == x) ? c : mine; }
        if (sum == G) break;
        __builtin_amdgcn_s_sleep(1);
        if ((++sp & 255u) == 0u) { if (xb_ld(&bar[XB_TMO])) break; if (sp > XB_SPIN_CAP) { atomicAdd(&bar[XB_TMO], 1u); break; } }
    }
    nloc = mine > 0u ? mine : 1u; nx = cnt > 0u ? cnt : 1u;
}

__device__ __forceinline__ void xcd_barrier(const XcdBarrier& b) {
    asm volatile("s_waitcnt vmcnt(0)" ::: "memory");
    __syncthreads();
    if (threadIdx.x == 0) {
        unsigned* bar = b.bar;
        __builtin_amdgcn_s_waitcnt(0);
        unsigned nloc = b.st[0], nx = b.st[1];
        if (nloc == 0u) { xcd_barrier_complete(bar, b.x, nloc, nx); b.st[0] = nloc; b.st[1] = nx; }
        const unsigned old = xb_add(&bar[XB_XSUB(b.x)], 1u);
        const unsigned gen = old / nloc;
        if (old + 1u == (gen + 1u) * nloc) {
            __builtin_amdgcn_fence(__ATOMIC_RELEASE, "agent");
            asm volatile("s_waitcnt vmcnt(0)" ::: "memory");
            const unsigned og = xb_add(&bar[XB_TOP], 1u);
            const unsigned tg = og / nx;
            if (og + 1u == (tg + 1u) * nx) xb_add(&bar[XB_TOPGEN], 1u);
            else XB_SPIN(xb_ld(&bar[XB_TOPGEN]) == tg, bar);
            __builtin_amdgcn_fence(__ATOMIC_ACQUIRE, "agent");
            xb_add(&bar[XB_XGEN(b.x)], 1u);
            asm volatile("s_waitcnt vmcnt(0)" ::: "memory");
        } else {
            XB_SPIN(xb_ld(&bar[XB_XGEN(b.x)]) == gen, bar);
            __builtin_amdgcn_fence(__ATOMIC_ACQUIRE, "agent");
            asm volatile("s_waitcnt vmcnt(0)" ::: "memory");
        }
    }
    __syncthreads();
}

#ifndef ONLY_PH
#define ONLY_PH -1
#endif
#define RUNPH(n) ((ONLY_PH < 0 || ONLY_PH == (n)) && p.ph_lo <= (n) && (n) <= p.ph_hi)
#define SYNCPH(n) do { if (p.ph_lo <= (n) && (n) < p.ph_hi) xcd_barrier(xb); } while (0)
__global__ void __launch_bounds__(256, 2) hymba_mega(Params p) {
  __shared__ __attribute__((aligned(16))) unsigned char smem[SMEM_BYTES];
  cg::grid_group grid = cg::this_grid();
  const int bid = blockIdx.x, nb = gridDim.x;
  if (p.ph_lo < 0) grid.sync();
  XcdBarrier xb;
  {
    volatile LAS unsigned* st = (volatile LAS unsigned*)(smem + SMEM_BYTES - 16);
    if (threadIdx.x == 0) { st[0] = 0u; st[1] = 0u; st[2] = 0u; st[3] = 0u; }
    __syncthreads();
    if (p.ph_lo < p.ph_hi) xb = xcd_barrier_post((unsigned*)(p.ws + OFF_BAR), st);
    else { xb.bar = (unsigned*)(p.ws + OFF_BAR); xb.x = 0; xb.st = st; }
  }
  {
    if (RUNPH(0)) for (int rep = 0; rep < REP0; ++rep) {
      if (rep) grid.sync();
      phase0(p, smem);
    }
    SYNCPH(0);
    if (RUNPH(1)) for (int rep = 0; rep < REP1; ++rep) {
      if (rep) grid.sync();
      const h16* A0 = (const h16*)((unsigned char*)p.out + OUT_OFF_A0);
      const h16* W = (const h16*)(p.ws + OFF_WIN);
      const int xl = bid & 7, nxb = nb >> 3;
      if (nb & 7) { for (int t = bid; t < 256 * 25; t += nb) gemm_tile<EPI_PROJ>(p, A0, 1024, W, 1024, 1024, (t / 25) * 128, (t % 25) * 128, smem); }
      else for (int u = bid >> 3; u < 800; u += nxb) {
        const int mb = u / 200, v = u % 200;
        gemm_tile<EPI_PROJ>(p, A0, 1024, W, 1024, 1024, (xl * 32 + mb * 8 + (v & 7)) * 128, (v >> 3) * 128, smem);
      }
    }
    SYNCPH(1);
    if (RUNPH(2)) {
      for (int it = bid; it < 256 + 2048; it += nb) {
        if (it < 256) gemm_tile<EPI_LOCAL>(p, (const h16*)(p.ws + OFF_US), 512, (const h16*)(p.ws + OFF_ETAB) + (size_t)(it >> 3) * 128 * 512, 512, 512, it * 128, 0, smem);
        else gdn_pre_item(p, it - 256, smem);
      }
    }
    SYNCPH(2);
    if (RUNPH(3)) {
      for (int it = bid; it < 512; it += nb) ssm_item(p, it >> 5, it & 31, smem);
    }
    SYNCPH(3);
    if (RUNPH(4)) {
      if (bid < 64) gdn_chain(p, bid, smem);
      const int xl = bid & 7;
      unsigned* ctr = (unsigned*)(p.ws + OFF_CTR) + xl * 16;
      volatile int* bc = (volatile int*)(smem + SMEM_BYTES - 4);
      const h16* YPRE = (const h16*)((unsigned char*)p.out + OUT_OFF_YPRE);
      for (;;) {
        __syncthreads();
        if (threadIdx.x == 0) *bc = (int)atomicAdd(ctr, 1u);
        __syncthreads();
        const int u = *bc;
        if (u >= 128 + 256) break;
        if (u < 128) gemm_tile<EPI_GLU>(p, YPRE, 512, (const h16*)(p.ws + OFF_WGLU), 512, 512, (xl * 32 + (u >> 2)) * 128, (u & 3) * 128, smem);
        else gemm_tile<EPI_PLE>(p, (const h16*)(p.ws + OFF_PB), 256, (const h16*)(p.ws + OFF_WPP), 256, 256, (xl * 32 + ((u - 128) >> 3)) * 128, ((u - 128) & 7) * 128, smem);
      }
    }
    SYNCPH(4);
    if (RUNPH(5)) {
      for (int it = bid; it < 2048; it += nb) gdn_out_item(p, it, smem);
    }
    SYNCPH(5);
    if (RUNPH(6)) {
      const int xl = bid & 7, nxb = nb >> 3;
      if (nb & 7) { for (int t = bid; t < 2048; t += nb) gemm_tile<EPI_OUT>(p, (const h16*)(p.ws + OFF_MIXIN), 1024, (const h16*)(p.ws + OFF_WOUT), 1024, 1024, (t >> 3) * 128, (t & 7) * 128, smem); }
      else for (int u = bid >> 3; u < 256; u += nxb)
        gemm_tile<EPI_OUT>(p, (const h16*)(p.ws + OFF_MIXIN), 1024, (const h16*)(p.ws + OFF_WOUT), 1024, 1024, (xl * 32 + (u >> 6) * 8 + (u & 7)) * 128, ((u >> 3) & 7) * 128, smem);
    }
    SYNCPH(6);
    if (RUNPH(7)) {
      const int xl = bid & 7, nxb = nb >> 3;
      if (nb & 7) { for (int t = bid; t < 2048; t += nb) gemm_tile<EPI_GATE>(p, (const h16*)(p.ws + OFF_PROJ), 1024, (const h16*)(p.ws + OFF_WGATE), 1024, 1024, (t >> 3) * 128, (t & 7) * 128, smem); }
      else for (int u = bid >> 3; u < 256; u += nxb)
        gemm_tile<EPI_GATE>(p, (const h16*)(p.ws + OFF_PROJ), 1024, (const h16*)(p.ws + OFF_WGATE), 1024, 1024, (xl * 32 + (u >> 6) * 8 + (u & 7)) * 128, ((u >> 3) & 7) * 128, smem);
    }
    SYNCPH(7);
    if (RUNPH(8)) {
      const int wid = threadIdx.x >> 6, lane = threadIdx.x & 63;
      const float* OPART = (const float*)(p.ws + OFF_OPART);
      const float4* g4 = (const float4*)p.in[I_FING];
      const h16* H2B = (const h16*)(p.ws + OFF_MIXIN);
      for (int row = bid * 4 + wid; row < T_TOK; row += nb * 4) {
        float s = (lane < 8) ? OPART[(size_t)row * 8 + lane] : 0.f;
        const h16x8 a = *(const h16x8*)(H2B + (size_t)row * 1024 + lane * 8);
        const h16x8 b = *(const h16x8*)(H2B + (size_t)row * 1024 + 512 + lane * 8);
        s = wave_sum(s);
        const float rstd = rsqrtf(s * (1.f / 1024.f) + 1e-6f);
        float4* orow = (float4*)(p.out + (size_t)row * 1024);
        const float4 g0 = g4[lane * 2], g1 = g4[lane * 2 + 1], g2 = g4[128 + lane * 2], g3 = g4[128 + lane * 2 + 1];
        float4 o0, o1, o2, o3;
        o0.x = (float)a[0] * rstd * g0.x; o0.y = (float)a[1] * rstd * g0.y; o0.z = (float)a[2] * rstd * g0.z; o0.w = (float)a[3] * rstd * g0.w;
        o1.x = (float)a[4] * rstd * g1.x; o1.y = (float)a[5] * rstd * g1.y; o1.z = (float)a[6] * rstd * g1.z; o1.w = (float)a[7] * rstd * g1.w;
        o2.x = (float)b[0] * rstd * g2.x; o2.y = (float)b[1] * rstd * g2.y; o2.z = (float)b[2] * rstd * g2.z; o2.w = (float)b[3] * rstd * g2.w;
        o3.x = (float)b[4] * rstd * g3.x; o3.y = (float)b[5] * rstd * g3.y; o3.z = (float)b[6] * rstd * g3.z; o3.w = (float)b[7] * rstd * g3.w;
        orow[lane * 2] = o0; orow[lane * 2 + 1] = o1; orow[128 + lane * 2] = o2; orow[128 + lane * 2 + 1] = o3;
      }
    }
  }
}

extern "C" void kernel_launch(void* const* d_in, const int* in_sizes, int n_in, void* d_out, int out_size, void* d_ws, size_t ws_size,
                              hipStream_t stream) {
  static int grid_blocks = 0;
  if (!grid_blocks) {
    int dev = 0, cus = 0, per_cu = 0;
    hipGetDevice(&dev);
    hipDeviceGetAttribute(&cus, hipDeviceAttributeMultiprocessorCount, dev);
    hipOccupancyMaxActiveBlocksPerMultiprocessor(&per_cu, hymba_mega, 256, 0);
    if (per_cu > 2) per_cu = 2;
    if (per_cu < 1) per_cu = 1;
    grid_blocks = cus * per_cu;
  }
  if (n_in != 23 || ws_size < WS_END || out_size != T_TOK * 1024) {
    fprintf(stderr, "kernel_launch: unexpected sizes n_in=%d ws=%zu (need %zu) out=%d\n", n_in, ws_size, (size_t)WS_END, out_size);
    return;
  }
  Params p{};
  for (int i = 0; i < 23; ++i) p.in[i] = (const float*)d_in[i];
  p.out = (float*)d_out;
  p.ws = (unsigned char*)d_ws;
  if (hipMemsetAsync((unsigned char*)d_ws + OFF_BAR, 0, 16384, stream) != hipSuccess) { fprintf(stderr, "kernel_launch: memset of control words failed\n"); return; }
#if MULTI_LAUNCH
  for (int ph = 0; ph < NPH; ++ph) {
    p.ph_lo = ph; p.ph_hi = ph;
    hipLaunchKernelGGL(hymba_mega, dim3(grid_blocks), dim3(256), 0, stream, p);
  }
#else
  p.ph_lo = 0; p.ph_hi = NPH - 1;
  void* args[] = {&p};
  hipError_t e = hipLaunchCooperativeKernel((void*)hymba_mega, dim3(grid_blocks), dim3(256), args, 0, stream);
  if (e != hipSuccess) fprintf(stderr, "cooperative launch failed: %s (grid %d)\n", hipGetErrorString(e), grid_blocks);
#endif
}
```

```cpp
#include <hip/hip_runtime.h>
#include <hip/hip_cooperative_groups.h>
#include <cstdio>
namespace cg = cooperative_groups;

#ifndef REP0
#define REP0 1
#endif
#ifndef REP1
#define REP1 1
#endif
#ifndef REP2
#define REP2 1
#endif
#ifndef REP3
#define REP3 1
#endif
#ifndef REP4
#define REP4 1
#endif
#ifndef MULTI_LAUNCH
#define MULTI_LAUNCH 0
#endif

typedef _Float16 h16;
typedef __attribute__((ext_vector_type(8))) _Float16 h16x8;
typedef __attribute__((ext_vector_type(4))) _Float16 h16x4;
typedef __attribute__((ext_vector_type(4))) float f32x4;
typedef __attribute__((ext_vector_type(2))) float v2f;

#define MFMA(a, b, c) __builtin_amdgcn_mfma_f32_16x16x32_f16((a), (b), (c), 0, 0, 0)

constexpr int T_TOK = 32768;
constexpr int SEQ = 2048;
constexpr int NPH = 9;
constexpr int LDP = 3072;
constexpr int SMEM_BYTES = 72704;

constexpr size_t SZ_WIN = (size_t)3200 * 1024 * 2;
constexpr size_t SZ_WGLU = (size_t)512 * 512 * 2;
constexpr size_t SZ_WOUT = (size_t)1024 * 1024 * 2;
constexpr size_t SZ_WPP = (size_t)1024 * 256 * 2;
constexpr size_t SZ_WGATE = (size_t)1024 * 1024 * 2;
constexpr size_t OFF_WIN = 0;
constexpr size_t OFF_WGLU = OFF_WIN + SZ_WIN;
constexpr size_t OFF_WOUT = OFF_WGLU + SZ_WGLU;
constexpr size_t OFF_WPP = OFF_WOUT + SZ_WOUT;
constexpr size_t OFF_WGATE = OFF_WPP + SZ_WPP;
constexpr size_t OFF_PB = OFF_WGATE + SZ_WGATE;
constexpr size_t OFF_PROJ = OFF_PB + (size_t)T_TOK * 256 * 2;
constexpr size_t OFF_AB = OFF_PROJ + (size_t)T_TOK * LDP * 2;
constexpr size_t OFF_KTAB = OFF_AB + (size_t)T_TOK * 8 * 4;
constexpr size_t OFF_ETAB = OFF_KTAB + (size_t)32 * 33 * 256 * 2;
constexpr size_t OFF_FTAB = OFF_ETAB + (size_t)32 * 128 * 512 * 2;
constexpr size_t OFF_ALPOW = OFF_FTAB + (size_t)32 * 512 * 128 * 2;
constexpr size_t OFF_DL = OFF_ALPOW + (size_t)32 * 64 * 2 * 4;
constexpr size_t OFF_EPART = OFF_DL + (size_t)2048 * 4;
constexpr size_t OFF_OPART = OFF_EPART + (size_t)T_TOK * 16 * 4;
constexpr size_t OFF_MIXIN = OFF_OPART + (size_t)T_TOK * 16 * 4;
constexpr size_t OFF_WP = OFF_MIXIN + (size_t)T_TOK * 1024 * 2;
constexpr size_t OFF_QGP = OFF_WP + (size_t)2048 * 64 * 128 * 2;
constexpr size_t OFF_KDT = OFF_QGP + (size_t)2048 * 64 * 128 * 2;
constexpr size_t OFF_UT = OFF_KDT + (size_t)2048 * 128 * 64 * 2;
constexpr size_t OFF_ATP = OFF_UT + (size_t)2048 * 128 * 64 * 2;
constexpr size_t OFF_EH = OFF_ATP + (size_t)2048 * 64 * 64 * 2;
constexpr size_t OFF_US = OFF_EH;
constexpr size_t OFF_LOCALG = OFF_EH + (size_t)32 * T_TOK * 16 * 2;
constexpr size_t OFF_BAR = OFF_EH + (size_t)T_TOK * 1024 * 2;
constexpr size_t WS_END = OFF_BAR + 16384;
constexpr size_t OFF_CTR = OFF_BAR + 15360;
constexpr size_t OUT_OFF_A0 = 0;
constexpr size_t OUT_OFF_SF = 0;
constexpr size_t OUT_OFF_YPRE = (size_t)T_TOK * 1024 * 2;
constexpr size_t OUT_OFF_ZT = OUT_OFF_YPRE + (size_t)T_TOK * 512 * 2;

struct Params {
  const float* in[23];
  float* out;
  unsigned char* ws;
  int ph_lo, ph_hi;
};

enum { I_X = 0, I_P, I_NMG, I_WIN, I_ARE, I_AIM, I_BRE, I_BIM, I_CRE, I_CIM, I_D, I_LOGDT, I_WGLU, I_BGLU,
       I_CONVW, I_ALOG, I_DTB, I_DNG, I_WOUT, I_WPP, I_PLEG, I_WGATE, I_FING };

__device__ __forceinline__ float wave_sum(float v) {
#pragma unroll
  for (int o = 32; o > 0; o >>= 1) v += __shfl_xor(v, o);
  return v;
}
__device__ __forceinline__ float sum16(float v) {
  v += __shfl_xor(v, 1); v += __shfl_xor(v, 2); v += __shfl_xor(v, 4); v += __shfl_xor(v, 8);
  return v;
}
__device__ __forceinline__ float sigmoidf_(float x) { return __builtin_amdgcn_rcpf(1.f + __expf(-x)); }
__device__ __forceinline__ float siluf_(float x) { return x * __builtin_amdgcn_rcpf(1.f + __expf(-x)); }
__device__ __forceinline__ float gelu_tanh(float y) {
  float z = 0.7978845608028654f * (y + 0.044715f * y * y * y);
  return y * __builtin_amdgcn_rcpf(1.f + __expf(-2.f * z));
}
__device__ __forceinline__ h16x8 pack8(f32x4 lo, f32x4 hi) {
  h16x8 r;
  r[0] = (h16)lo[0]; r[1] = (h16)lo[1]; r[2] = (h16)lo[2]; r[3] = (h16)lo[3];
  r[4] = (h16)hi[0]; r[5] = (h16)hi[1]; r[6] = (h16)hi[2]; r[7] = (h16)hi[3];
  return r;
}
__device__ __forceinline__ int perm_pos(int n) { return (n & ~31) + (((n & 15) >> 2) << 3) + (((n >> 4) & 1) << 2) + (n & 3); }
__device__ __forceinline__ int perm_inv(int pos) {
  int q5 = pos & 31, qq = q5 >> 3, jj = q5 & 7;
  return (pos & ~31) + (jj < 4 ? 4 * qq + jj : 16 + 4 * qq + (jj - 4));
}

__device__ void transpose_w(const float* __restrict__ W, int K, int N, int Npad, h16* __restrict__ WT, int t, float* tile) {
  const int ntn = Npad / 64;
  const int kt = t / ntn, nt = t % ntn, k0 = kt * 64, n0 = nt * 64;
  const int tx = threadIdx.x & 63, ty = threadIdx.x >> 6;
  for (int r = 0; r < 16; ++r) {
    int k = ty * 16 + r, n = n0 + tx;
    tile[k * 65 + tx] = (n < N) ? W[(size_t)(k0 + k) * N + n] : 0.f;
  }
  __syncthreads();
  for (int r = 0; r < 16; ++r) {
    int n = ty * 16 + r;
    WT[(size_t)(n0 + n) * K + k0 + tx] = (h16)tile[tx * 65 + n];
  }
  __syncthreads();
}

__device__ void ssm_table_item(const Params& p, int g, int d, float* lds) {
  float2* sAp = (float2*)lds;
  float2* sW = sAp + 64;
  const int tid = threadIdx.x;
  h16* KTAB = (h16*)(p.ws + OFF_KTAB);
  h16* ETAB = (h16*)(p.ws + OFF_ETAB);
  h16* FTAB = (h16*)(p.ws + OFF_FTAB);
  float* ALPOW = (float*)(p.ws + OFF_ALPOW);
  float* sBr = lds + 256; float* sBi = sBr + 1024; float* sCr = sBi + 1024; float* sCi = sCr + 16 * 65;
  {
    const float4 vbr = ((const float4*)(p.in[I_BRE] + g * 1024))[tid], vbi = ((const float4*)(p.in[I_BIM] + g * 1024))[tid];
    const float4 vcr = ((const float4*)(p.in[I_CRE] + g * 1024))[tid], vci = ((const float4*)(p.in[I_CIM] + g * 1024))[tid];
    *(float4*)(sBr + tid * 4) = vbr; *(float4*)(sBi + tid * 4) = vbi;
    const int ch = (tid * 4) >> 6, cp = (tid * 4) & 63;
    sCr[ch * 65 + cp] = vcr.x; sCr[ch * 65 + cp + 1] = vcr.y; sCr[ch * 65 + cp + 2] = vcr.z; sCr[ch * 65 + cp + 3] = vcr.w;
    sCi[ch * 65 + cp] = vci.x; sCi[ch * 65 + cp + 1] = vci.y; sCi[ch * 65 + cp + 2] = vci.z; sCi[ch * 65 + cp + 3] = vci.w;
  }
  if (tid < 64) {
    const int pp = tid;
    float lr = p.in[I_ARE][g * 64 + pp], li = p.in[I_AIM][g * 64 + pp], dt = expf(p.in[I_LOGDT][g]);
    float mag = expf(lr * dt), ang = li * dt;
    float abr = mag * cosf(ang), abi = mag * sinf(ang);
    float nr = abr - 1.f, ni = abi, den = lr * lr + li * li;
    float cr = (nr * lr + ni * li) / den, ci = (ni * lr - nr * li) / den;
    float apr = 1.f, api = 0.f;
    for (int k = 0; k < d; ++k) { float t0 = apr * abr - api * abi; api = apr * abi + api * abr; apr = t0; }
    sAp[pp] = make_float2(apr, api);
    sW[pp] = make_float2(apr * cr - api * ci, apr * ci + api * cr);
    if (d == 32) { ALPOW[(g * 64 + pp) * 2] = apr; ALPOW[(g * 64 + pp) * 2 + 1] = api; }
  }
  __syncthreads();
  if (d < 32) {
    {
      const int h = tid >> 4, hp = tid & 15;
      float acc = 0.f;
#pragma unroll 8
      for (int pp = 0; pp < 64; ++pp) {
        float2 W = sW[pp];
        float br = sBr[pp * 16 + hp], bi = sBi[pp * 16 + hp];
        float wbr = W.x * br - W.y * bi, wbi = W.x * bi + W.y * br;
        float cr = sCr[h * 65 + pp], ci = sCi[h * 65 + pp];
        acc += cr * wbr - ci * wbi;
      }
      if (d == 0 && h == hp) acc += p.in[I_D][g * 16 + h];
      KTAB[(size_t)(g * 33 + d + 1) * 256 + h * 16 + hp] = (h16)acc;
      if (d == 0) KTAB[(size_t)(g * 33) * 256 + tid] = (h16)0.f;
    }
    {
      const int i = 31 - d;
#pragma unroll
      for (int r = 0; r < 4; ++r) {
        int idx = tid + 256 * r, pp = idx >> 4, hp = idx & 15;
        float2 W = sW[pp];
        float br = sBr[pp * 16 + hp], bi = sBi[pp * 16 + hp];
        float wbr = W.x * br - W.y * bi, wbi = W.x * bi + W.y * br;
        ETAB[((size_t)g * 128 + pp) * 512 + i * 16 + hp] = (h16)wbr;
        ETAB[((size_t)g * 128 + 64 + pp) * 512 + i * 16 + hp] = (h16)wbi;
      }
    }
  }
  if (d >= 1) {
    const int j = d - 1;
#pragma unroll
    for (int r = 0; r < 4; ++r) {
      int idx = tid + 256 * r, h = idx >> 6, pp = idx & 63;
      float2 Ap = sAp[pp];
      float cr = sCr[h * 65 + pp], ci = sCi[h * 65 + pp];
      float re = cr * Ap.x - ci * Ap.y, im = cr * Ap.y + ci * Ap.x;
      FTAB[((size_t)g * 512 + j * 16 + h) * 128 + pp] = (h16)re;
      FTAB[((size_t)g * 512 + j * 16 + h) * 128 + 64 + pp] = (h16)(-im);
    }
  }
  __syncthreads();
}

__device__ void phase0(const Params& p, unsigned char* smem) {
  const int bid = blockIdx.x, nb = gridDim.x, tid = threadIdx.x, wid = tid >> 6, lane = tid & 63;
  float* tile = (float*)smem;
  for (int t = bid; t < 1440; t += nb) {
    if (t < 800) transpose_w(p.in[I_WIN], 1024, 3080, 3200, (h16*)(p.ws + OFF_WIN), t, tile);
    else if (t < 864) transpose_w(p.in[I_WGLU], 512, 512, 512, (h16*)(p.ws + OFF_WGLU), t - 800, tile);
    else if (t < 1120) transpose_w(p.in[I_WOUT], 1024, 1024, 1024, (h16*)(p.ws + OFF_WOUT), t - 864, tile);
    else if (t < 1184) transpose_w(p.in[I_WPP], 256, 1024, 1024, (h16*)(p.ws + OFF_WPP), t - 1120, tile);
    else transpose_w(p.in[I_WGATE], 1024, 1024, 1024, (h16*)(p.ws + OFF_WGATE), t - 1184, tile);
  }
  for (int it = bid; it < 32 * 33; it += nb) ssm_table_item(p, it / 33, it % 33, (float*)smem);
  {
    h16* A0 = (h16*)((unsigned char*)p.out + OUT_OFF_A0);
    const float* x = p.in[I_X];
    const float4* g4 = (const float4*)p.in[I_NMG];
    for (int row = bid * 4 + wid; row < T_TOK; row += nb * 4) {
      const float4* xr = (const float4*)(x + (size_t)row * 1024);
      float4 v[4];
      float ss = 0.f;
#pragma unroll
      for (int i = 0; i < 4; ++i) {
        v[i] = xr[lane + i * 64];
        ss += v[i].x * v[i].x + v[i].y * v[i].y + v[i].z * v[i].z + v[i].w * v[i].w;
      }
      ss = wave_sum(ss);
      float rstd = rsqrtf(ss * (1.f / 1024.f) + 1e-6f);
#pragma unroll
      for (int i = 0; i < 4; ++i) {
        float4 g = g4[lane + i * 64];
        h16x4 o;
        o[0] = (h16)(v[i].x * rstd * g.x); o[1] = (h16)(v[i].y * rstd * g.y);
        o[2] = (h16)(v[i].z * rstd * g.z); o[3] = (h16)(v[i].w * rstd * g.w);
        *(h16x4*)(A0 + (size_t)row * 1024 + (lane + i * 64) * 4) = o;
      }
    }
  }
  {
    h16* PB = (h16*)(p.ws + OFF_PB);
    const float4* p4 = (const float4*)p.in[I_P];
    const size_t n4 = (size_t)T_TOK * 256 / 4;
    for (size_t i = (size_t)bid * 256 + tid; i < n4; i += (size_t)nb * 256) {
      float4 v = p4[i];
      h16x4 o;
      o[0] = (h16)v.x; o[1] = (h16)v.y; o[2] = (h16)v.z; o[3] = (h16)v.w;
      *(h16x4*)(PB + i * 4) = o;
    }
  }
}

enum { EPI_PROJ = 0, EPI_GLU, EPI_PLE, EPI_OUT, EPI_GATE, EPI_LOCAL };

template <int EPI>
__device__ __forceinline__ void gemm_tile(const Params& p, const h16* __restrict__ A, int lda, const h16* __restrict__ Bt, int ldb,
                                          int K, int brow, int bcol, unsigned char* smem) {
  const int tid = threadIdx.x, wid = tid >> 6, lane = tid & 63, wr = wid >> 1, wc = wid & 1, fr = lane & 15, fq = lane >> 4;
  f32x4 acc[4][4];
#pragma unroll
  for (int m = 0; m < 4; ++m)
#pragma unroll
    for (int n = 0; n < 4; ++n) acc[m][n] = f32x4{0.f, 0.f, 0.f, 0.f};
  const int nk = K / 64;
  const h16* ga[4]; const h16* gb[4];
#pragma unroll
  for (int i = 0; i < 4; ++i) {
    const int L = tid + 256 * i, row = L >> 3, cs = (L & 7) ^ (row & 7);
    ga[i] = A + (size_t)(brow + row) * lda + cs * 8;
    gb[i] = Bt + (size_t)(bcol + row) * ldb + cs * 8;
  }
#define GEMM_STAGE(t_, buf_) do { \
    unsigned char* sa_ = smem + (buf_) * 32768 + tid * 16; \
    _Pragma("unroll") for (int i_ = 0; i_ < 4; ++i_) { \
      __builtin_amdgcn_global_load_lds((const unsigned*)(ga[i_] + (t_) * 64), (unsigned*)(sa_ + i_ * 4096), 16, 0, 0); \
      __builtin_amdgcn_global_load_lds((const unsigned*)(gb[i_] + (t_) * 64), (unsigned*)(sa_ + 16384 + i_ * 4096), 16, 0, 0); \
    } \
  } while (0)
  GEMM_STAGE(0, 0);
  for (int t = 0; t < nk; ++t) {
    asm volatile("s_waitcnt vmcnt(0)" ::: "memory");
    __syncthreads();
    if (t + 1 < nk) GEMM_STAGE(t + 1, (t + 1) & 1);
    const unsigned char* SA = smem + (t & 1) * 32768;
    const unsigned char* SB = SA + 16384;
    h16x8 af[2][4], bf[2][4];
#pragma unroll
    for (int kk = 0; kk < 2; ++kk) {
      const int pos = ((kk * 4 + fq) ^ (fr & 7)) << 4;
#pragma unroll
      for (int m = 0; m < 4; ++m) {
        af[kk][m] = *(const h16x8*)(SA + (wr * 64 + m * 16 + fr) * 128 + pos);
        bf[kk][m] = *(const h16x8*)(SB + (wc * 64 + m * 16 + fr) * 128 + pos);
      }
    }
    __builtin_amdgcn_s_setprio(1);
#pragma unroll
    for (int kk = 0; kk < 2; ++kk)
#pragma unroll
      for (int m = 0; m < 4; ++m)
#pragma unroll
        for (int n = 0; n < 4; ++n) acc[m][n] = MFMA(af[kk][m], bf[kk][n], acc[m][n]);
    __builtin_amdgcn_s_setprio(0);
  }
#undef GEMM_STAGE
  __syncthreads();
  float* CT = (float*)smem;
  const int c4 = tid & 31, col = bcol + c4 * 4, r0 = tid >> 5;
  float4 pre_f[16];
  h16x4 pre_a[16], pre_b[16];
  float4 cst = {0.f, 0.f, 0.f, 0.f};
  if constexpr (EPI == EPI_OUT) {
#pragma unroll
    for (int it = 0; it < 16; ++it) pre_f[it] = *(const float4*)(p.in[I_X] + ((size_t)brow + it * 8 + r0) * 1024 + col);
  } else if constexpr (EPI == EPI_GLU) {
    cst = *(const float4*)(p.in[I_BGLU] + col);
#pragma unroll
    for (int it = 0; it < 16; ++it) {
      const size_t row = (size_t)brow + it * 8 + r0;
      pre_a[it] = *(const h16x4*)((const h16*)((unsigned char*)p.out + OUT_OFF_YPRE) + row * 512 + col);
      pre_b[it] = *(const h16x4*)((const h16*)(p.ws + OFF_PROJ) + row * LDP + 512 + col);
    }
  } else if constexpr (EPI == EPI_GATE) {
    cst = *(const float4*)(p.in[I_PLEG] + col);
#pragma unroll
    for (int it = 0; it < 16; ++it) {
      const size_t row = (size_t)brow + it * 8 + r0;
      pre_a[it] = *(const h16x4*)((const h16*)(p.ws + OFF_EH) + row * 1024 + col);
      pre_b[it] = *(const h16x4*)((const h16*)(p.ws + OFF_PROJ) + row * 1024 + col);
    }
    if (tid < 128) {
      const float4 e0 = *(const float4*)((const float*)(p.ws + OFF_EPART) + ((size_t)brow + tid) * 8);
      const float4 e1 = *(const float4*)((const float*)(p.ws + OFF_EPART) + ((size_t)brow + tid) * 8 + 4);
      ((float*)(smem + 67584))[tid] = rsqrtf((e0.x + e0.y + e0.z + e0.w + e1.x + e1.y + e1.z + e1.w) * (1.f / 1024.f) + 1e-6f);
    }
  }
#pragma unroll
  for (int m = 0; m < 4; ++m)
#pragma unroll
    for (int n = 0; n < 4; ++n)
#pragma unroll
      for (int j = 0; j < 4; ++j) CT[(wr * 64 + m * 16 + fq * 4 + j) * 132 + wc * 64 + n * 16 + fr] = acc[m][n][j];
  __syncthreads();
#pragma unroll
  for (int it = 0; it < 16; ++it) {
    const int rl = it * 8 + r0;
    const size_t row = (size_t)brow + rl;
    const float4 v = *(const float4*)(CT + rl * 132 + c4 * 4);
    if constexpr (EPI == EPI_PROJ) {
      if (bcol < 512) {
        h16x4 o; o[0] = (h16)v.x; o[1] = (h16)v.y; o[2] = (h16)v.z; o[3] = (h16)v.w;
        *(h16x4*)((h16*)(p.ws + OFF_US) + ((size_t)(col >> 4) * T_TOK + row) * 16 + (col & 15)) = o;
      } else if (bcol < 3072) {
        h16x4 o; o[0] = (h16)v.x; o[1] = (h16)v.y; o[2] = (h16)v.z; o[3] = (h16)v.w;
        *(h16x4*)((h16*)(p.ws + OFF_PROJ) + row * LDP + col) = o;
      } else if (c4 < 2) {
        *(float4*)((float*)(p.ws + OFF_AB) + row * 8 + c4 * 4) = v;
      }
    } else if constexpr (EPI == EPI_LOCAL) {
      *(float4*)((float*)(p.ws + OFF_LOCALG) + row * 128 + col) = v;
    } else if constexpr (EPI == EPI_GLU) {
      const h16x4 y = pre_a[it], z = pre_b[it];
      h16x4 o;
      o[0] = (h16)((float)y[0] * sigmoidf_(v.x + cst.x) * siluf_((float)z[0]));
      o[1] = (h16)((float)y[1] * sigmoidf_(v.y + cst.y) * siluf_((float)z[1]));
      o[2] = (h16)((float)y[2] * sigmoidf_(v.z + cst.z) * siluf_((float)z[2]));
      o[3] = (h16)((float)y[3] * sigmoidf_(v.w + cst.w) * siluf_((float)z[3]));
      *(h16x4*)((h16*)(p.ws + OFF_MIXIN) + row * 1024 + col) = o;
    } else if constexpr (EPI == EPI_PLE) {
      h16x4 o; o[0] = (h16)v.x; o[1] = (h16)v.y; o[2] = (h16)v.z; o[3] = (h16)v.w;
      *(h16x4*)((h16*)(p.ws + OFF_EH) + row * 1024 + col) = o;
      float s = v.x * v.x + v.y * v.y + v.z * v.z + v.w * v.w;
      s = sum16(s); s += __shfl_xor(s, 16);
      if (c4 == 0) ((float*)(p.ws + OFF_EPART))[row * 8 + (bcol >> 7)] = s;
    } else if constexpr (EPI == EPI_OUT) {
      const float4 xv = pre_f[it];
      h16x4 o; o[0] = (h16)(xv.x + v.x); o[1] = (h16)(xv.y + v.y); o[2] = (h16)(xv.z + v.z); o[3] = (h16)(xv.w + v.w);
      *(h16x4*)((h16*)(p.ws + OFF_PROJ) + row * 1024 + col) = o;
    } else if constexpr (EPI == EPI_GATE) {
      const float rs = ((const float*)(smem + 67584))[rl];
      const h16x4 eh = pre_a[it], hb = pre_b[it];
      float4 hv;
      hv.x = (float)hb[0] + sigmoidf_(v.x) * ((float)eh[0] * rs * cst.x);
      hv.y = (float)hb[1] + sigmoidf_(v.y) * ((float)eh[1] * rs * cst.y);
      hv.z = (float)hb[2] + sigmoidf_(v.z) * ((float)eh[2] * rs * cst.z);
      hv.w = (float)hb[3] + sigmoidf_(v.w) * ((float)eh[3] * rs * cst.w);
      {
        h16x4 o; o[0] = (h16)hv.x; o[1] = (h16)hv.y; o[2] = (h16)hv.z; o[3] = (h16)hv.w;
        *(h16x4*)((h16*)(p.ws + OFF_MIXIN) + row * 1024 + col) = o;
      }
      float s = hv.x * hv.x + hv.y * hv.y + hv.z * hv.z + hv.w * hv.w;
      s = sum16(s); s += __shfl_xor(s, 16);
      if (c4 == 0) ((float*)(p.ws + OFF_OPART))[row * 8 + (bcol >> 7)] = s;
    }
  }
  __syncthreads();
}

__device__ void ssm_item(const Params& p, int b, int g, unsigned char* smem) {
  float* LOCAL = (float*)smem;
  h16* SPREV = (h16*)(smem + 33792);
  h16* KT = (h16*)(smem + 51200);
  unsigned char* ERING = smem + 33792;
  unsigned char* FRING = smem;
  int tid_ = threadIdx.x;
  asm volatile("" : "+v"(tid_));
  const int tid = tid_, w = tid >> 6, lane = tid & 63, fr = lane & 15, fq = lane >> 4;
  const h16* PROJ = (const h16*)(p.ws + OFF_PROJ);
  const h16* Eg = (const h16*)(p.ws + OFF_ETAB) + (size_t)g * 128 * 512;
  const h16* Kg = (const h16*)(p.ws + OFF_KTAB) + (size_t)g * 33 * 256;
  const h16* Fg = (const h16*)(p.ws + OFF_FTAB) + (size_t)g * 512 * 128;
  const float* ALPOW = (const float*)(p.ws + OFF_ALPOW);
  h16* YPRE = (h16*)((unsigned char*)p.out + OUT_OFF_YPRE);
  const int nchunk = w * 16 + fr;
  const size_t tok0 = (size_t)b * SEQ + (size_t)nchunk * 32;
  h16x8 uf[16];
#pragma unroll
  for (int ks = 0; ks < 16; ++ks) {
    const int i = 2 * ks + (fq >> 1);
    uf[ks] = *(const h16x8*)((const h16*)(p.ws + OFF_US) + ((size_t)g * T_TOK + tok0 + i) * 16 + (fq & 1) * 8);
  }
  {
    const float* lg = (const float*)(p.ws + OFF_LOCALG) + ((size_t)g * 1024 + (size_t)b * 64) * 128;
    float4 lv[8]; h16x8 kt[5];
#pragma unroll
    for (int i = 0; i < 8; ++i) { const int idx = tid + 256 * i; lv[i] = *(const float4*)(lg + (size_t)(idx >> 5) * 128 + (idx & 31) * 4); }
#pragma unroll
    for (int i = 0; i < 5; ++i) { const int idx = tid + 256 * i; kt[i] = *(const h16x8*)(Kg + (idx < 1056 ? idx : 1055) * 8); }
#pragma unroll
    for (int i = 0; i < 8; ++i) { const int idx = tid + 256 * i; *(float4*)(LOCAL + (idx >> 5) * 132 + (idx & 31) * 4) = lv[i]; }
#pragma unroll
    for (int i = 0; i < 5; ++i) { const int idx = tid + 256 * i; if (idx < 1056) *(h16x8*)(KT + idx * 8) = kt[i]; }
  }
#pragma unroll
  for (int ks = 0; ks < 16; ++ks) asm volatile("" : "+v"(uf[ks]));
  __syncthreads();
  if (tid < 64) {
    const int pp = tid;
    const float ar = ALPOW[(g * 64 + pp) * 2], ai = ALPOW[(g * 64 + pp) * 2 + 1];
    float sr = 0.f, si = 0.f;
#pragma unroll 1
    for (int c8 = 0; c8 < 8; ++c8) {
      float lr[8], li[8];
#pragma unroll
      for (int k = 0; k < 8; ++k) { lr[k] = LOCAL[(c8 * 8 + k) * 132 + pp]; li[k] = LOCAL[(c8 * 8 + k) * 132 + 64 + pp]; }
#pragma unroll
      for (int k = 0; k < 8; ++k) {
        SPREV[(c8 * 8 + k) * 136 + pp] = (h16)sr;
        SPREV[(c8 * 8 + k) * 136 + 64 + pp] = (h16)si;
        const float nr = ar * sr - ai * si + lr[k];
        const float ni = ar * si + ai * sr + li[k];
        sr = nr; si = ni;
      }
    }
  }
  asm volatile("s_waitcnt vmcnt(0)" ::: "memory");
  __syncthreads();
  h16x8 sf[4];
#pragma unroll
  for (int ks = 0; ks < 4; ++ks) sf[ks] = *(const h16x8*)(SPREV + nchunk * 136 + ks * 32 + fq * 8);
  const h16* fsrc = Fg + (size_t)(tid >> 4) * 128 + (((tid & 15) ^ (tid >> 4)) << 3);
#define F_STAGE(j_) __builtin_amdgcn_global_load_lds((const unsigned*)(fsrc + (size_t)((j_) < 31 ? (j_) : 31) * 16 * 128), \
                                                     (unsigned*)(FRING + ((j_) & 7) * 4096 + tid * 16), 16, 0, 0)
  F_STAGE(0); F_STAGE(1); F_STAGE(2); F_STAGE(3); F_STAGE(4); F_STAGE(5);
#pragma unroll 1
  for (int j2 = 0; j2 < 16; ++j2) {
    const int j = 2 * j2;
    if (j2 == 0) asm volatile("s_waitcnt vmcnt(4)" ::: "memory");
    else if (j2 == 1) asm volatile("s_waitcnt vmcnt(6)" ::: "memory");
    else asm volatile("s_waitcnt vmcnt(8)" ::: "memory");
    asm volatile("s_waitcnt lgkmcnt(0)" ::: "memory");
    __builtin_amdgcn_s_barrier();
    asm volatile("" ::: "memory");
    F_STAGE(j + 6); F_STAGE(j + 7);
    asm volatile("" ::: "memory");
    f32x4 acc0 = {0.f, 0.f, 0.f, 0.f}, acc1 = {0.f, 0.f, 0.f, 0.f}, bcc0 = {0.f, 0.f, 0.f, 0.f}, bcc1 = {0.f, 0.f, 0.f, 0.f};
#pragma unroll
    for (int ks = 0; ks < 16; ++ks) {
      if (2 * ks <= j) {
        const int dd = j - 2 * ks - (fq >> 1) + 1;
        h16x8 a0 = *(const h16x8*)(KT + dd * 256 + fr * 16 + (fq & 1) * 8);
        h16x8 a1 = *(const h16x8*)(KT + (dd + 1) * 256 + fr * 16 + (fq & 1) * 8);
        if (ks & 1) { acc1 = MFMA(a0, uf[ks], acc1); bcc1 = MFMA(a1, uf[ks], bcc1); }
        else { acc0 = MFMA(a0, uf[ks], acc0); bcc0 = MFMA(a1, uf[ks], bcc0); }
      }
    }
    if (j2 < 15) {
    }
    {
    }
    const unsigned char* slot0 = FRING + (j & 7) * 4096 + fr * 256;
    const unsigned char* slot1 = FRING + ((j + 1) & 7) * 4096 + fr * 256;
#pragma unroll
    for (int ks = 0; ks < 4; ++ks) {
      h16x8 a0 = *(const h16x8*)(slot0 + (((ks * 4 + fq) ^ fr) << 4));
      h16x8 a1 = *(const h16x8*)(slot1 + (((ks * 4 + fq) ^ fr) << 4));
      if (ks & 1) { acc1 = MFMA(a0, sf[ks], acc1); bcc1 = MFMA(a1, sf[ks], bcc1); }
      else { acc0 = MFMA(a0, sf[ks], acc0); bcc0 = MFMA(a1, sf[ks], bcc0); }
    }
    h16x4 o0, o1;
#pragma unroll
    for (int r = 0; r < 4; ++r) { o0[r] = (h16)gelu_tanh(acc0[r] + acc1[r]); o1[r] = (h16)gelu_tanh(bcc0[r] + bcc1[r]); }
    *(h16x4*)(YPRE + (tok0 + j) * 512 + g * 16 + fq * 4) = o0;
    *(h16x4*)(YPRE + (tok0 + j + 1) * 512 + g * 16 + fq * 4) = o1;
    asm volatile("" ::: "memory");
  }
#undef F_STAGE
  asm volatile("s_waitcnt vmcnt(0)" ::: "memory");
  __syncthreads();
}

__device__ void gdn_pre_item(const Params& p, int item, unsigned char* smem) {
  h16* QH = (h16*)smem;
  h16* KH = (h16*)(smem + 17408);
  h16* VH = (h16*)(smem + 34816);
  float* Ld = (float*)(smem + 52224);
  h16* Limg = (h16*)(smem + 56576);
  h16* Dimg = (h16*)(smem + 60672);
  float* sG = (float*)(smem + 69632);
  float* sBeta = (float*)(smem + 69888);
  float* sEG = (float*)(smem + 70144);
  float* sBG = (float*)(smem + 70400);
  float* sEL = (float*)(smem + 70656);
  int tid_ = threadIdx.x;
  asm volatile("" : "+v"(tid_));
  const int tid = tid_, w = tid >> 6, lane = tid & 63, fr = lane & 15, fq = lane >> 4;
  const int c = item & 31, h = (item >> 5) & 3, b = item >> 7;
  const h16* PROJ = (const h16*)(p.ws + OFF_PROJ);
  const float* AB = (const float*)(p.ws + OFF_AB);
  const float* convw = p.in[I_CONVW];
  h16* WPi = (h16*)(p.ws + OFF_WP) + (size_t)item * 64 * 128;
  h16* QGPi = (h16*)(p.ws + OFF_QGP) + (size_t)item * 64 * 128;
  h16* KDTi = (h16*)(p.ws + OFF_KDT) + (size_t)item * 128 * 64;
  h16* UTi = (h16*)(p.ws + OFF_UT) + (size_t)item * 128 * 64;
  h16* ATPi = (h16*)(p.ws + OFF_ATP) + (size_t)item * 64 * 64;
  h16* ZTi = (h16*)((unsigned char*)p.out + OUT_OFF_ZT) + (size_t)item * 128 * 64;
  float* DL = (float*)(p.ws + OFF_DL);
  {
    const h16x8 z8 = {(h16)0.f, (h16)0.f, (h16)0.f, (h16)0.f, (h16)0.f, (h16)0.f, (h16)0.f, (h16)0.f};
    *(h16x8*)(Limg + tid * 8) = z8; *(h16x8*)(Limg + 2048 + tid * 8) = z8;
  }
  {
    const int ch0 = (tid & 15) * 8, t0 = (tid >> 4) * 4;
#pragma unroll 1
    for (int sec = 0; sec < 3; ++sec) {
      const int colbase = 1024 + sec * 512 + h * 128 + ch0;
      h16x8 xr[7];
#pragma unroll
      for (int i = 0; i < 7; ++i) {
        const int ts = c * 64 + t0 - 3 + i;
        h16x8 z8 = {(h16)0.f, (h16)0.f, (h16)0.f, (h16)0.f, (h16)0.f, (h16)0.f, (h16)0.f, (h16)0.f};
        xr[i] = (ts >= 0) ? *(const h16x8*)(PROJ + ((size_t)b * SEQ + ts) * LDP + colbase) : z8;
      }
      float4 wv[4][2];
#pragma unroll
      for (int jj = 0; jj < 4; ++jj) {
        wv[jj][0] = *(const float4*)(convw + jj * 1536 + sec * 512 + h * 128 + ch0);
        wv[jj][1] = *(const float4*)(convw + jj * 1536 + sec * 512 + h * 128 + ch0 + 4);
      }
      h16* dst = (sec == 0 ? QH : (sec == 1 ? KH : VH));
#pragma unroll
      for (int tt = 0; tt < 4; ++tt) {
        float a[8];
#pragma unroll
        for (int e = 0; e < 8; ++e) a[e] = 0.f;
#pragma unroll
        for (int jj = 0; jj < 4; ++jj) {
          const h16x8 xv = xr[tt + jj];
          a[0] += wv[jj][0].x * (float)xv[0]; a[1] += wv[jj][0].y * (float)xv[1]; a[2] += wv[jj][0].z * (float)xv[2]; a[3] += wv[jj][0].w * (float)xv[3];
          a[4] += wv[jj][1].x * (float)xv[4]; a[5] += wv[jj][1].y * (float)xv[5]; a[6] += wv[jj][1].z * (float)xv[6]; a[7] += wv[jj][1].w * (float)xv[7];
        }
        float ss = 0.f;
#pragma unroll
        for (int e = 0; e < 8; ++e) { a[e] = siluf_(a[e]); ss += a[e] * a[e]; }
        float scale = 1.f;
        if (sec < 2) {
          ss = sum16(ss);
          scale = rsqrtf(ss + 1e-6f) * (sec == 0 ? 0.08838834764831845f : 1.f);
        }
        h16x8 o;
#pragma unroll
        for (int e = 0; e < 8; ++e) o[e] = (h16)(a[e] * scale);
        *(h16x8*)(dst + (t0 + tt) * 136 + ch0) = o;
      }
    }
  }
  if (tid < 64) {
    const size_t tok = (size_t)b * SEQ + c * 64 + tid;
    float braw = AB[tok * 8 + h], araw = AB[tok * 8 + 4 + h];
    float beta = 1.f / (1.f + expf(-braw));
    float xx = araw + p.in[I_DTB][h];
    float sp = xx > 20.f ? xx : log1pf(expf(xx));
    float gg = -expf(p.in[I_ALOG][h]) * sp;
#pragma unroll
    for (int o = 1; o < 64; o <<= 1) {
      float v = __shfl_up(gg, o);
      if (lane >= o) gg += v;
    }
    sG[tid] = gg;
    sBeta[tid] = beta;
    const float eg = expf(gg);
    sEG[tid] = eg;
    sBG[tid] = beta * eg;
    sEL[tid] = expf(__shfl(gg, 63) - gg);
  }
  __syncthreads();
  {
    h16x8 ak[4], aq[4];
#pragma unroll
    for (int ks = 0; ks < 4; ++ks) {
      ak[ks] = *(const h16x8*)(KH + (w * 16 + fr) * 136 + ks * 32 + fq * 8);
      aq[ks] = *(const h16x8*)(QH + (w * 16 + fr) * 136 + ks * 32 + fq * 8);
    }
#pragma unroll
    for (int jt = 0; jt < 4; ++jt) {
      const int j = jt * 16 + fr;
      const int pj = perm_pos(j);
      if (jt <= w) {
        f32x4 kk = {0.f, 0.f, 0.f, 0.f}, qk = {0.f, 0.f, 0.f, 0.f};
#pragma unroll
        for (int ks = 0; ks < 4; ++ks) {
          h16x8 bk = *(const h16x8*)(KH + (jt * 16 + fr) * 136 + ks * 32 + fq * 8);
          kk = MFMA(ak[ks], bk, kk);
          qk = MFMA(aq[ks], bk, qk);
        }
        const float Gj = sG[j];
        f32x4 lt;
#pragma unroll
        for (int r = 0; r < 4; ++r) {
          const int i = w * 16 + 4 * fq + r;
          const float e = (i >= j) ? __expf(sG[i] - Gj) : 0.f;
          lt[r] = (i > j) ? sBeta[i] * kk[r] * e : 0.f;
          ATPi[i * 64 + (((pj >> 3) ^ (i & 7)) << 3) + (pj & 7)] = (h16)(qk[r] * e);
        }
        if (jt == w) {
#pragma unroll
          for (int r = 0; r < 4; ++r) Ld[(w * 16 + 4 * fq + r) * 17 + fr] = lt[r];
        } else {
          const int img = (w == 1) ? 0 : (w == 2 ? 1 : (jt < 2 ? 2 : 3));
#pragma unroll
          for (int r = 0; r < 4; ++r) Limg[img * 512 + (4 * fq + r) * 32 + (fr >> 2) * 8 + (fr & 3) + 4 * (jt & 1)] = (h16)(-lt[r]);
        }
      } else {
#pragma unroll
        for (int r = 0; r < 4; ++r) {
          const int i = w * 16 + 4 * fq + r;
          ATPi[i * 64 + (((pj >> 3) ^ (i & 7)) << 3) + (pj & 7)] = (h16)0.f;
        }
      }
    }
  }
  __syncthreads();
  if (lane < 16) {
    float y[16];
#pragma unroll
    for (int i = 0; i < 16; ++i) {
      float s = (i == lane) ? 1.f : 0.f;
#pragma unroll
      for (int k = 0; k < i; ++k) s -= Ld[(w * 16 + i) * 17 + k] * y[k];
      y[i] = s;
    }
#pragma unroll
    for (int i = 0; i < 16; ++i) Dimg[w * 512 + i * 32 + (lane >> 2) * 8 + (lane & 3)] = (h16)y[i];
  }
  __syncthreads();
  f32x4 xs[4][4];
  {
    const h16* SRC = (w < 2) ? VH : KH;
    const float* scl = (w < 2) ? sBeta : sBG;
    const int cbase = (w & 1) * 64;
    h16x8 dA[4], lA[4];
#pragma unroll
    for (int b4 = 0; b4 < 4; ++b4) {
      dA[b4] = *(const h16x8*)(Dimg + b4 * 512 + fr * 32 + fq * 8);
      lA[b4] = *(const h16x8*)(Limg + b4 * 512 + fr * 32 + fq * 8);
    }
    const f32x4 z4 = {0.f, 0.f, 0.f, 0.f};
#pragma unroll
    for (int nt = 0; nt < 4; ++nt) {
      const int col = cbase + nt * 16 + fr;
      f32x4 rb[4];
#pragma unroll
      for (int b4 = 0; b4 < 4; ++b4)
#pragma unroll
        for (int r = 0; r < 4; ++r) rb[b4][r] = (float)SRC[(b4 * 16 + 4 * fq + r) * 136 + col] * scl[b4 * 16 + 4 * fq + r];
      const f32x4 x0 = MFMA(dA[0], pack8(rb[0], z4), z4);
      const f32x4 a1 = MFMA(lA[0], pack8(x0, z4), rb[1]);
      const f32x4 x1 = MFMA(dA[1], pack8(a1, z4), z4);
      const h16x8 x01 = pack8(x0, x1);
      const f32x4 a2 = MFMA(lA[1], x01, rb[2]);
      const f32x4 x2 = MFMA(dA[2], pack8(a2, z4), z4);
      f32x4 a3 = MFMA(lA[2], x01, rb[3]);
      a3 = MFMA(lA[3], pack8(x2, z4), a3);
      const f32x4 x3 = MFMA(dA[3], pack8(a3, z4), z4);
      xs[nt][0] = x0; xs[nt][1] = x1; xs[nt][2] = x2; xs[nt][3] = x3;
      if (w < 2) {
#pragma unroll
        for (int b4 = 0; b4 < 4; ++b4) {
          h16x4 o; o[0] = (h16)xs[nt][b4][0]; o[1] = (h16)xs[nt][b4][1]; o[2] = (h16)xs[nt][b4][2]; o[3] = (h16)xs[nt][b4][3];
          *(h16x4*)(UTi + (size_t)col * 64 + b4 * 16 + 4 * fq) = o;
        }
      }
    }
  }
  __syncthreads();
  if (w >= 2) {
#pragma unroll
    for (int nt = 0; nt < 4; ++nt) {
      const int pos = perm_pos((w & 1) * 64 + nt * 16 + fr);
#pragma unroll
      for (int b4 = 0; b4 < 4; ++b4)
#pragma unroll
        for (int r = 0; r < 4; ++r) VH[(b4 * 16 + 4 * fq + r) * 136 + pos] = (h16)xs[nt][b4][r];
    }
  }
  __syncthreads();
  for (int rr = 0; rr < 4; ++rr) {
    const int idx = tid + 256 * rr, row = idx >> 4, seg = idx & 15;
    *(h16x8*)(WPi + row * 128 + ((seg ^ (row & 15)) << 3)) = *(const h16x8*)(VH + row * 136 + seg * 8);
  }
  {
    const int dv = tid & 127, th = tid >> 7;
    const float gdv = p.in[I_DNG][dv];
    const h16* zp = PROJ + ((size_t)b * SEQ + c * 64 + th * 32) * LDP + 2560 + h * 128 + dv;
    h16 zv[32];
#pragma unroll
    for (int t = 0; t < 32; ++t) zv[t] = zp[(size_t)t * LDP];
#pragma unroll
    for (int t8 = 0; t8 < 4; ++t8) {
      h16x8 v;
#pragma unroll
      for (int e = 0; e < 8; ++e) v[e] = (h16)(siluf_((float)zv[t8 * 8 + e]) * gdv);
      *(h16x8*)(ZTi + (size_t)dv * 64 + th * 32 + t8 * 8) = v;
    }
  }
#pragma unroll 2
  for (int rr = 0; rr < 4; ++rr) {
    const int idx = tid + 256 * rr, t = idx >> 4, cpos = idx & 15, ks = cpos >> 2, q = cpos & 3;
    const h16x4 lo = *(const h16x4*)(QH + t * 136 + ks * 32 + 4 * q);
    const h16x4 hi = *(const h16x4*)(QH + t * 136 + ks * 32 + 16 + 4 * q);
    const float sc = sEG[t];
    h16x8 o;
#pragma unroll
    for (int e = 0; e < 4; ++e) { o[e] = (h16)((float)lo[e] * sc); o[4 + e] = (h16)((float)hi[e] * sc); }
    *(h16x8*)(QGPi + t * 128 + ((cpos ^ (t & 15)) << 3)) = o;
  }
#pragma unroll 2
  for (int rr = 0; rr < 4; ++rr) {
    const int idx = tid + 256 * rr, dk = idx >> 3, cpos = idx & 7, k2 = cpos >> 2, q = cpos & 3;
    h16x8 o;
#pragma unroll
    for (int e = 0; e < 8; ++e) {
      const int t = k2 * 32 + (e < 4 ? 4 * q + e : 16 + 4 * q + (e - 4));
      o[e] = (h16)((float)KH[t * 136 + dk] * sEL[t]);
    }
    *(h16x8*)(KDTi + dk * 64 + ((cpos ^ (dk & 7)) << 3)) = o;
  }
  const float Glast = sG[63];
  if (tid == 0) DL[item] = expf(Glast);
  __syncthreads();
}

template <int NB>
__device__ __forceinline__ void glds_copy(const h16* __restrict__ g, unsigned char* l) {
#pragma unroll
  for (int i = 0; i < NB / 4096; ++i) {
    const int off = threadIdx.x * 16 + i * 4096;
    __builtin_amdgcn_global_load_lds((const unsigned*)((const unsigned char*)g + off), (unsigned*)(l + off), 16, 0, 0);
  }
}
#define RAW_BARRIER() do { asm volatile("s_waitcnt lgkmcnt(0)" ::: "memory"); __builtin_amdgcn_s_barrier(); asm volatile("" ::: "memory"); } while (0)

__device__ void gdn_chain(const Params& p, int bh, unsigned char* smem) {
  const int tid = threadIdx.x, w = tid >> 6, lane = tid & 63, fr = lane & 15, fq = lane >> 4;
  const float* DL = (const float*)(p.ws + OFF_DL);
  const h16* WPb = (const h16*)(p.ws + OFF_WP) + (size_t)bh * 32 * 64 * 128;
  const h16* KDTb = (const h16*)(p.ws + OFF_KDT) + (size_t)bh * 32 * 128 * 64;
  h16* UTb = (h16*)(p.ws + OFF_UT) + (size_t)bh * 32 * 128 * 64;
  h16* SFb = (h16*)((unsigned char*)p.out + OUT_OFF_SF) + (size_t)bh * 32 * 128 * 128;
  f32x4 S[8][2];
#pragma unroll
  for (int i = 0; i < 8; ++i) { S[i][0] = f32x4{0.f, 0.f, 0.f, 0.f}; S[i][1] = f32x4{0.f, 0.f, 0.f, 0.f}; }
  h16x4 uR[4][2];
  const int uoff = (w * 32 + fr) * 64 + fq * 4;
  glds_copy<16384>(WPb, smem); glds_copy<16384>(KDTb, smem + 16384);
#pragma unroll
  for (int mt = 0; mt < 4; ++mt)
#pragma unroll
    for (int nt = 0; nt < 2; ++nt) uR[mt][nt] = *(const h16x4*)(UTb + uoff + nt * 1024 + mt * 16);
  float dl = DL[bh * 32];
  asm volatile("s_waitcnt vmcnt(0)" ::: "memory");
  RAW_BARRIER();
  for (int c = 0; c < 32; ++c) {
    const int cn = (c + 1 < 32) ? c + 1 : 31;
    const unsigned char* LW = smem + (c & 1) * 32768;
    const unsigned char* LK = LW + 16384;
    unsigned char* LWn = smem + ((c + 1) & 1) * 32768;
    f32x4 uf[4][2];
#pragma unroll
    for (int mt = 0; mt < 4; ++mt)
#pragma unroll
      for (int nt = 0; nt < 2; ++nt)
#pragma unroll
        for (int r = 0; r < 4; ++r) uf[mt][nt][r] = (float)uR[mt][nt][r];
    const float dlc = dl;
    asm volatile("" ::: "memory");
    h16x8 sfr[4][2];
#pragma unroll
    for (int ks = 0; ks < 4; ++ks) { sfr[ks][0] = pack8(S[2 * ks][0], S[2 * ks + 1][0]); sfr[ks][1] = pack8(S[2 * ks][1], S[2 * ks + 1][1]); }
#pragma unroll
    for (int ks = 0; ks < 4; ++ks)
#pragma unroll
      for (int nt = 0; nt < 2; ++nt)
        *(h16x8*)(SFb + ((size_t)(c * 4 + ks) * 8 + w * 2 + nt) * 512 + lane * 8) = sfr[ks][nt];
    glds_copy<16384>(WPb + (size_t)cn * 64 * 128, LWn);
    glds_copy<16384>(KDTb + (size_t)cn * 128 * 64, LWn + 16384);
#pragma unroll
    for (int mt = 0; mt < 4; ++mt)
#pragma unroll
      for (int nt = 0; nt < 2; ++nt)
        uR[mt][nt] = *(const h16x4*)(UTb + (size_t)cn * 128 * 64 + uoff + nt * 1024 + mt * 16);
    dl = DL[bh * 32 + cn];
    asm volatile("" ::: "memory");
    f32x4 vn[4][2];
#pragma unroll
    for (int mt = 0; mt < 4; ++mt) { vn[mt][0] = f32x4{0.f, 0.f, 0.f, 0.f}; vn[mt][1] = vn[mt][0]; }
#pragma unroll
    for (int ks = 0; ks < 4; ++ks)
#pragma unroll
      for (int mt = 0; mt < 4; ++mt) {
        h16x8 aw = *(const h16x8*)(LW + (mt * 16 + fr) * 256 + (((ks * 4 + fq) ^ fr) << 4));
        vn[mt][0] = MFMA(aw, sfr[ks][0], vn[mt][0]);
        vn[mt][1] = MFMA(aw, sfr[ks][1], vn[mt][1]);
      }
#pragma unroll
    for (int mt = 0; mt < 4; ++mt)
#pragma unroll
      for (int r = 0; r < 4; ++r) { vn[mt][0][r] = uf[mt][0][r] - vn[mt][0][r]; vn[mt][1][r] = uf[mt][1][r] - vn[mt][1][r]; }
    h16x8 vfr[2][2];
#pragma unroll
    for (int k2 = 0; k2 < 2; ++k2) { vfr[k2][0] = pack8(vn[2 * k2][0], vn[2 * k2 + 1][0]); vfr[k2][1] = pack8(vn[2 * k2][1], vn[2 * k2 + 1][1]); }
    if (c + 1 < 32) {
#pragma unroll
      for (int k2 = 0; k2 < 2; ++k2)
#pragma unroll
        for (int nt = 0; nt < 2; ++nt)
          *(h16x8*)(UTb + (size_t)c * 128 * 64 + ((size_t)k2 * 8 + w * 2 + nt) * 512 + lane * 8) = vfr[k2][nt];
    }
#pragma unroll
    for (int dkt = 0; dkt < 8; ++dkt) {
      f32x4 s0 = S[dkt][0], s1 = S[dkt][1];
#pragma unroll
      for (int r = 0; r < 4; ++r) { s0[r] *= dlc; s1[r] *= dlc; }
#pragma unroll
      for (int k2 = 0; k2 < 2; ++k2) {
        h16x8 ak = *(const h16x8*)(LK + (dkt * 16 + fr) * 128 + (((k2 * 4 + fq) ^ (fr & 7)) << 4));
        s0 = MFMA(ak, vfr[k2][0], s0);
        s1 = MFMA(ak, vfr[k2][1], s1);
      }
      S[dkt][0] = s0; S[dkt][1] = s1;
    }
    asm volatile("s_waitcnt vmcnt(0)" ::: "memory");
    RAW_BARRIER();
    if (c + 1 == 32) {
#pragma unroll
      for (int k2 = 0; k2 < 2; ++k2)
#pragma unroll
        for (int nt = 0; nt < 2; ++nt)
          *(h16x8*)(UTb + (size_t)c * 128 * 64 + ((size_t)k2 * 8 + w * 2 + nt) * 512 + lane * 8) = vfr[k2][nt];
    }
  }
  asm volatile("s_waitcnt vmcnt(0)" ::: "memory");
  __syncthreads();
}

__device__ void gdn_out_item(const Params& p, int item, unsigned char* smem) {
  unsigned char* LQ = smem;
  unsigned char* LA = smem + 16384;
  float* red = (float*)(smem + 24576);
  const int tid = threadIdx.x, w = tid >> 6, lane = tid & 63, fr = lane & 15, fq = lane >> 4;
  const int c = item & 31, h = (item >> 5) & 3, b = item >> 7;
  h16* MIXIN = (h16*)(p.ws + OFF_MIXIN);
  const h16* QGPi = (const h16*)(p.ws + OFF_QGP) + (size_t)item * 64 * 128;
  const h16* ATPi = (const h16*)(p.ws + OFF_ATP) + (size_t)item * 64 * 64;
  const h16* VFi = (const h16*)(p.ws + OFF_UT) + (size_t)item * 128 * 64;
  const h16* SFi = (const h16*)((unsigned char*)p.out + OUT_OFF_SF) + (size_t)item * 128 * 128;
  const h16* ZTi = (const h16*)((unsigned char*)p.out + OUT_OFF_ZT) + (size_t)item * 128 * 64;
  glds_copy<16384>(QGPi, LQ); glds_copy<8192>(ATPi, LA);
  h16x8 sfr[4][2], vfr[2][2];
#pragma unroll
  for (int ks = 0; ks < 4; ++ks)
#pragma unroll
    for (int nt = 0; nt < 2; ++nt) sfr[ks][nt] = *(const h16x8*)(SFi + ((size_t)ks * 8 + w * 2 + nt) * 512 + lane * 8);
#pragma unroll
  for (int k2 = 0; k2 < 2; ++k2)
#pragma unroll
    for (int nt = 0; nt < 2; ++nt) vfr[k2][nt] = *(const h16x8*)(VFi + ((size_t)k2 * 8 + w * 2 + nt) * 512 + lane * 8);
  h16x4 zR[4][2];
#pragma unroll
  for (int mt = 0; mt < 4; ++mt)
#pragma unroll
    for (int nt = 0; nt < 2; ++nt) zR[mt][nt] = *(const h16x4*)(ZTi + (size_t)(w * 32 + nt * 16 + fr) * 64 + mt * 16 + fq * 4);
  asm volatile("s_waitcnt vmcnt(0)" ::: "memory");
  __syncthreads();
  f32x4 o[4][2];
#pragma unroll
  for (int mt = 0; mt < 4; ++mt) {
    f32x4 o0 = {0.f, 0.f, 0.f, 0.f}, o1 = {0.f, 0.f, 0.f, 0.f};
#pragma unroll
    for (int ks = 0; ks < 4; ++ks) {
      h16x8 aq = *(const h16x8*)(LQ + (mt * 16 + fr) * 256 + (((ks * 4 + fq) ^ fr) << 4));
      o0 = MFMA(aq, sfr[ks][0], o0);
      o1 = MFMA(aq, sfr[ks][1], o1);
    }
#pragma unroll
    for (int k2 = 0; k2 < 2; ++k2) {
      h16x8 aa = *(const h16x8*)(LA + (mt * 16 + fr) * 128 + (((k2 * 4 + fq) ^ (fr & 7)) << 4));
      o0 = MFMA(aa, vfr[k2][0], o0);
      o1 = MFMA(aa, vfr[k2][1], o1);
    }
    o[mt][0] = o0; o[mt][1] = o1;
  }
#pragma unroll
  for (int mt = 0; mt < 4; ++mt)
#pragma unroll
    for (int r = 0; r < 4; ++r) {
      float s = o[mt][0][r] * o[mt][0][r] + o[mt][1][r] * o[mt][1][r];
      s = sum16(s);
      if (fr == 0) red[w * 64 + mt * 16 + 4 * fq + r] = s;
    }
  __syncthreads();
#pragma unroll
  for (int mt = 0; mt < 4; ++mt)
#pragma unroll
    for (int r = 0; r < 4; ++r) {
      const int tl = mt * 16 + 4 * fq + r;
      const float tot = red[tl] + red[64 + tl] + red[128 + tl] + red[192 + tl];
      const float rstd = rsqrtf(tot * (1.f / 128.f) + 1e-6f);
      const size_t tok = (size_t)b * SEQ + c * 64 + tl;
      h16* yp = MIXIN + tok * 1024 + 512 + h * 128 + w * 32 + fr;
      yp[0] = (h16)(o[mt][0][r] * rstd * (float)zR[mt][0][r]);
      yp[16] = (h16)(o[mt][1][r] * rstd * (float)zR[mt][1][r]);
    }
  __syncthreads();
}

#define XB_TMO      128
#define XB_XCNT(j)  (256  + 64 * (j))
#define XB_XSUB(j)  (1280 + 64 * (j))
#define XB_XGEN(j)  (2304 + 64 * (j))
#define XB_TOP      3328
#define XB_TOPGEN   3392
#define XCD_BAR_WORDS 3456
#define XB_SPIN_CAP (1u << 18)
#define LAS __attribute__((address_space(3)))

__device__ __forceinline__ unsigned xb_ld(unsigned* p)              { return __hip_atomic_load(p, __ATOMIC_RELAXED, __HIP_MEMORY_SCOPE_AGENT); }
__device__ __forceinline__ unsigned xb_add(unsigned* p, unsigned v) { return __hip_atomic_fetch_add(p, v, __ATOMIC_RELAXED, __HIP_MEMORY_SCOPE_AGENT); }
__device__ __forceinline__ unsigned xb_xcc_id() { return (unsigned)__builtin_amdgcn_s_getreg((3 << 11) | 20) & 0xFu; }
#define XB_SPIN(cond, bar) do { unsigned _sp = 0; while (cond) { __builtin_amdgcn_s_sleep(1); \
    if ((++_sp & 255u) == 0u) { if (xb_ld(&(bar)[XB_TMO])) break; if (_sp > XB_SPIN_CAP) { atomicAdd(&(bar)[XB_TMO], 1u); break; } } } } while (0)

struct XcdBarrier {
    unsigned* bar; unsigned x;
    volatile LAS unsigned* st;
};

__device__ __forceinline__ XcdBarrier xcd_barrier_post(unsigned* bar, volatile LAS unsigned* st) {
    XcdBarrier b; b.bar = bar; b.x = xb_xcc_id(); b.st = st;
    if (threadIdx.x == 0) (void)xb_add(&bar[XB_XCNT(b.x)], 1u);
    return b;
}
__device__ __forceinline__ void xcd_barrier_complete(unsigned* bar, unsigned x, unsigned& nloc, unsigned& nx) {
    const unsigned G = gridDim.x * gridDim.y * gridDim.z;
    unsigned sum, cnt, mine, sp = 0u;
    for (;;) {
        sum = 0u; cnt = 0u; mine = 0u;
#pragma unroll
        for (unsigned j = 0; j < 16; ++j) { const unsigned c = xb_ld(&bar[XB_XCNT(j)]); sum += c; cnt += (c > 0u) ? 1u : 0u; mine = (j == x) ? c : mine; }
        if (sum == G) break;
        __builtin_amdgcn_s_sleep(1);
        if ((++sp & 255u) == 0u) { if (xb_ld(&bar[XB_TMO])) break; if (sp > XB_SPIN_CAP) { atomicAdd(&bar[XB_TMO], 1u); break; } }
    }
    nloc = mine > 0u ? mine : 1u; nx = cnt > 0u ? cnt : 1u;
}

__device__ __forceinline__ void xcd_barrier(const XcdBarrier& b) {
    asm volatile("s_waitcnt vmcnt(0)" ::: "memory");
    __syncthreads();
    if (threadIdx.x == 0) {
        unsigned* bar = b.bar;
        __builtin_amdgcn_s_waitcnt(0);
        unsigned nloc = b.st[0], nx = b.st[1];
        if (nloc == 0u) { xcd_barrier_complete(bar, b.x, nloc, nx); b.st[0] = nloc; b.st[1] = nx; }
        const unsigned old = xb_add(&bar[XB_XSUB(b.x)], 1u);
        const unsigned gen = old / nloc;
        if (old + 1u == (gen + 1u) * nloc) {
            __builtin_amdgcn_fence(__ATOMIC_RELEASE, "agent");
            asm volatile("s_waitcnt vmcnt(0)" ::: "memory");
            const unsigned og = xb_add(&bar[XB_TOP], 1u);
            const unsigned tg = og / nx;
            if (og + 1u == (tg + 1u) * nx) xb_add(&bar[XB_TOPGEN], 1u);
            else XB_SPIN(xb_ld(&bar[XB_TOPGEN]) == tg, bar);
            __builtin_amdgcn_fence(__ATOMIC_ACQUIRE, "agent");
            xb_add(&bar[XB_XGEN(b.x)], 1u);
            asm volatile("s_waitcnt vmcnt(0)" ::: "memory");
        } else {
            XB_SPIN(xb_ld(&bar[XB_XGEN(b.x)]) == gen, bar);
            __builtin_amdgcn_fence(__ATOMIC_ACQUIRE, "agent");
            asm volatile("s_waitcnt vmcnt(0)" ::: "memory");
        }
    }
    __syncthreads();
}

#ifndef ONLY_PH
#define ONLY_PH -1
#endif
#define RUNPH(n) ((ONLY_PH < 0 || ONLY_PH == (n)) && p.ph_lo <= (n) && (n) <= p.ph_hi)
#define SYNCPH(n) do { if (p.ph_lo <= (n) && (n) < p.ph_hi) xcd_barrier(xb); } while (0)
__global__ void __launch_bounds__(256, 2) hymba_mega(Params p) {
  __shared__ __attribute__((aligned(16))) unsigned char smem[SMEM_BYTES];
  cg::grid_group grid = cg::this_grid();
  const int bid = blockIdx.x, nb = gridDim.x;
  if (p.ph_lo < 0) grid.sync();
  XcdBarrier xb;
  {
    volatile LAS unsigned* st = (volatile LAS unsigned*)(smem + SMEM_BYTES - 16);
    if (threadIdx.x == 0) { st[0] = 0u; st[1] = 0u; st[2] = 0u; st[3] = 0u; }
    __syncthreads();
    if (p.ph_lo < p.ph_hi) xb = xcd_barrier_post((unsigned*)(p.ws + OFF_BAR), st);
    else { xb.bar = (unsigned*)(p.ws + OFF_BAR); xb.x = 0; xb.st = st; }
  }
  {
    if (RUNPH(0)) for (int rep = 0; rep < REP0; ++rep) {
      if (rep) grid.sync();
      phase0(p, smem);
    }
    SYNCPH(0);
    if (RUNPH(1)) for (int rep = 0; rep < REP1; ++rep) {
      if (rep) grid.sync();
      const h16* A0 = (const h16*)((unsigned char*)p.out + OUT_OFF_A0);
      const h16* W = (const h16*)(p.ws + OFF_WIN);
      const int xl = bid & 7, nxb = nb >> 3;
      if (nb & 7) { for (int t = bid; t < 256 * 25; t += nb) gemm_tile<EPI_PROJ>(p, A0, 1024, W, 1024, 1024, (t / 25) * 128, (t % 25) * 128, smem); }
      else for (int u = bid >> 3; u < 800; u += nxb) {
        const int mb = u / 200, v = u % 200;
        gemm_tile<EPI_PROJ>(p, A0, 1024, W, 1024, 1024, (xl * 32 + mb * 8 + (v & 7)) * 128, (v >> 3) * 128, smem);
      }
    }
    SYNCPH(1);
    if (RUNPH(2)) {
      for (int it = bid; it < 256 + 2048; it += nb) {
        if (it < 256) gemm_tile<EPI_LOCAL>(p, (const h16*)(p.ws + OFF_US), 512, (const h16*)(p.ws + OFF_ETAB) + (size_t)(it >> 3) * 128 * 512, 512, 512, it * 128, 0, smem);
        else gdn_pre_item(p, it - 256, smem);
      }
    }
    SYNCPH(2);
    if (RUNPH(3)) {
      for (int it = bid; it < 512; it += nb) ssm_item(p, it >> 5, it & 31, smem);
    }
    SYNCPH(3);
    if (RUNPH(4)) {
      if (bid < 64) gdn_chain(p, bid, smem);
      const int xl = bid & 7;
      unsigned* ctr = (unsigned*)(p.ws + OFF_CTR) + xl * 16;
      volatile int* bc = (volatile int*)(smem + SMEM_BYTES - 4);
      const h16* YPRE = (const h16*)((unsigned char*)p.out + OUT_OFF_YPRE);
      for (;;) {
        __syncthreads();
        if (threadIdx.x == 0) *bc = (int)atomicAdd(ctr, 1u);
        __syncthreads();
        const int u = *bc;
        if (u >= 128 + 256) break;
        if (u < 128) gemm_tile<EPI_GLU>(p, YPRE, 512, (const h16*)(p.ws + OFF_WGLU), 512, 512, (xl * 32 + (u >> 2)) * 128, (u & 3) * 128, smem);
        else gemm_tile<EPI_PLE>(p, (const h16*)(p.ws + OFF_PB), 256, (const h16*)(p.ws + OFF_WPP), 256, 256, (xl * 32 + ((u - 128) >> 3)) * 128, ((u - 128) & 7) * 128, smem);
      }
    }
    SYNCPH(4);
    if (RUNPH(5)) {
      for (int it = bid; it < 2048; it += nb) gdn_out_item(p, it, smem);
    }
    SYNCPH(5);
    if (RUNPH(6)) {
      const int xl = bid & 7, nxb = nb >> 3;
      if (nb & 7) { for (int t = bid; t < 2048; t += nb) gemm_tile<EPI_OUT>(p, (const h16*)(p.ws + OFF_MIXIN), 1024, (const h16*)(p.ws + OFF_WOUT), 1024, 1024, (t >> 3) * 128, (t & 7) * 128, smem); }
      else for (int u = bid >> 3; u < 256; u += nxb)
        gemm_tile<EPI_OUT>(p, (const h16*)(p.ws + OFF_MIXIN), 1024, (const h16*)(p.ws + OFF_WOUT), 1024, 1024, (xl * 32 + (u >> 6) * 8 + (u & 7)) * 128, ((u >> 3) & 7) * 128, smem);
    }
    SYNCPH(6);
    if (RUNPH(7)) {
      const int xl = bid & 7, nxb = nb >> 3;
      if (nb & 7) { for (int t = bid; t < 2048; t += nb) gemm_tile<EPI_GATE>(p, (const h16*)(p.ws + OFF_PROJ), 1024, (const h16*)(p.ws + OFF_WGATE), 1024, 1024, (t >> 3) * 128, (t & 7) * 128, smem); }
      else for (int u = bid >> 3; u < 256; u += nxb)
        gemm_tile<EPI_GATE>(p, (const h16*)(p.ws + OFF_PROJ), 1024, (const h16*)(p.ws + OFF_WGATE), 1024, 1024, (xl * 32 + (u >> 6) * 8 + (u & 7)) * 128, ((u >> 3) & 7) * 128, smem);
    }
    SYNCPH(7);
    if (RUNPH(8)) {
      const int wid = threadIdx.x >> 6, lane = threadIdx.x & 63;
      const float* OPART = (const float*)(p.ws + OFF_OPART);
      const float4* g4 = (const float4*)p.in[I_FING];
      const h16* H2B = (const h16*)(p.ws + OFF_MIXIN);
      for (int row = bid * 4 + wid; row < T_TOK; row += nb * 4) {
        float s = (lane < 8) ? OPART[(size_t)row * 8 + lane] : 0.f;
        const h16x8 a = *(const h16x8*)(H2B + (size_t)row * 1024 + lane * 8);
        const h16x8 b = *(const h16x8*)(H2B + (size_t)row * 1024 + 512 + lane * 8);
        s = wave_sum(s);
        const float rstd = rsqrtf(s * (1.f / 1024.f) + 1e-6f);
        float4* orow = (float4*)(p.out + (size_t)row * 1024);
        const float4 g0 = g4[lane * 2], g1 = g4[lane * 2 + 1], g2 = g4[128 + lane * 2], g3 = g4[128 + lane * 2 + 1];
        float4 o0, o1, o2, o3;
        o0.x = (float)a[0] * rstd * g0.x; o0.y = (float)a[1] * rstd * g0.y; o0.z = (float)a[2] * rstd * g0.z; o0.w = (float)a[3] * rstd * g0.w;
        o1.x = (float)a[4] * rstd * g1.x; o1.y = (float)a[5] * rstd * g1.y; o1.z = (float)a[6] * rstd * g1.z; o1.w = (float)a[7] * rstd * g1.w;
        o2.x = (float)b[0] * rstd * g2.x; o2.y = (float)b[1] * rstd * g2.y; o2.z = (float)b[2] * rstd * g2.z; o2.w = (float)b[3] * rstd * g2.w;
        o3.x = (float)b[4] * rstd * g3.x; o3.y = (float)b[5] * rstd * g3.y; o3.z = (float)b[6] * rstd * g3.z; o3.w = (float)b[7] * rstd * g3.w;
        orow[lane * 2] = o0; orow[lane * 2 + 1] = o1; orow[128 + lane * 2] = o2; orow[128 + lane * 2 + 1] = o3;
      }
    }
  }
}

extern "C" void kernel_launch(void* const* d_in, const int* in_sizes, int n_in, void* d_out, int out_size, void* d_ws, size_t ws_size,
                              hipStream_t stream) {
  static int grid_blocks = 0;
  if (!grid_blocks) {
    int dev = 0, cus = 0, per_cu = 0;
    hipGetDevice(&dev);
    hipDeviceGetAttribute(&cus, hipDeviceAttributeMultiprocessorCount, dev);
    hipOccupancyMaxActiveBlocksPerMultiprocessor(&per_cu, hymba_mega, 256, 0);
    if (per_cu > 2) per_cu = 2;
    if (per_cu < 1) per_cu = 1;
    grid_blocks = cus * per_cu;
  }
  if (n_in != 23 || ws_size < WS_END || out_size != T_TOK * 1024) {
    fprintf(stderr, "kernel_launch: unexpected sizes n_in=%d ws=%zu (need %zu) out=%d\n", n_in, ws_size, (size_t)WS_END, out_size);
    return;
  }
  Params p{};
  for (int i = 0; i < 23; ++i) p.in[i] = (const float*)d_in[i];
  p.out = (float*)d_out;
  p.ws = (unsigned char*)d_ws;
  if (hipMemsetAsync((unsigned char*)d_ws + OFF_BAR, 0, 16384, stream) != hipSuccess) { fprintf(stderr, "kernel_launch: memset of control words failed\n"); return; }
#if MULTI_LAUNCH
  for (int ph = 0; ph < NPH; ++ph) {
    p.ph_lo = ph; p.ph_hi = ph;
    hipLaunchKernelGGL(hymba_mega, dim3(grid_blocks), dim3(256), 0, stream, p);
  }
#else
  p.ph_lo = 0; p.ph_hi = NPH - 1;
  void* args[] = {&p};
  hipError_t e = hipLaunchCooperativeKernel((void*)hymba_mega, dim3(grid_blocks), dim3(256), args, 0, stream);
  if (e != hipSuccess) fprintf(stderr, "cooperative launch failed: %s (grid %d)\n", hipGetErrorString(e), grid_blocks);
#endif
}
```

```cpp
#include <hip/hip_runtime.h>
#include <hip/hip_cooperative_groups.h>
#include <cstdio>
namespace cg = cooperative_groups;

#ifndef REP0
#define REP0 1
#endif
#ifndef REP1
#define REP1 1
#endif
#ifndef REP2
#define REP2 1
#endif
#ifndef REP3
#define REP3 1
#endif
#ifndef REP4
#define REP4 1
#endif
#ifndef MULTI_LAUNCH
#define MULTI_LAUNCH 0
#endif

typedef _Float16 h16;
typedef __attribute__((ext_vector_type(8))) _Float16 h16x8;
typedef __attribute__((ext_vector_type(4))) _Float16 h16x4;
typedef __attribute__((ext_vector_type(4))) float f32x4;
typedef __attribute__((ext_vector_type(2))) float v2f;

#define MFMA(a, b, c) __builtin_amdgcn_mfma_f32_16x16x32_f16((a), (b), (c), 0, 0, 0)

constexpr int T_TOK = 32768;
constexpr int SEQ = 2048;
constexpr int NPH = 9;
constexpr int LDP = 3072;
constexpr int SMEM_BYTES = 72704;

constexpr size_t SZ_WIN = (size_t)3200 * 1024 * 2;
constexpr size_t SZ_WGLU = (size_t)512 * 512 * 2;
constexpr size_t SZ_WOUT = (size_t)1024 * 1024 * 2;
constexpr size_t SZ_WPP = (size_t)1024 * 256 * 2;
constexpr size_t SZ_WGATE = (size_t)1024 * 1024 * 2;
constexpr size_t OFF_WIN = 0;
constexpr size_t OFF_WGLU = OFF_WIN + SZ_WIN;
constexpr size_t OFF_WOUT = OFF_WGLU + SZ_WGLU;
constexpr size_t OFF_WPP = OFF_WOUT + SZ_WOUT;
constexpr size_t OFF_WGATE = OFF_WPP + SZ_WPP;
constexpr size_t OFF_PB = OFF_WGATE + SZ_WGATE;
constexpr size_t OFF_PROJ = OFF_PB + (size_t)T_TOK * 256 * 2;
constexpr size_t OFF_AB = OFF_PROJ + (size_t)T_TOK * LDP * 2;
constexpr size_t OFF_KTAB = OFF_AB + (size_t)T_TOK * 8 * 4;
constexpr size_t OFF_ETAB = OFF_KTAB + (size_t)32 * 33 * 256 * 2;
constexpr size_t OFF_FTAB = OFF_ETAB + (size_t)32 * 128 * 512 * 2;
constexpr size_t OFF_ALPOW = OFF_FTAB + (size_t)32 * 512 * 128 * 2;
constexpr size_t OFF_DL = OFF_ALPOW + (size_t)32 * 64 * 2 * 4;
constexpr size_t OFF_EPART = OFF_DL + (size_t)2048 * 4;
constexpr size_t OFF_OPART = OFF_EPART + (size_t)T_TOK * 16 * 4;
constexpr size_t OFF_MIXIN = OFF_OPART + (size_t)T_TOK * 16 * 4;
constexpr size_t OFF_WP = OFF_MIXIN + (size_t)T_TOK * 1024 * 2;
constexpr size_t OFF_QGP = OFF_WP + (size_t)2048 * 64 * 128 * 2;
constexpr size_t OFF_KDT = OFF_QGP + (size_t)2048 * 64 * 128 * 2;
constexpr size_t OFF_UT = OFF_KDT + (size_t)2048 * 128 * 64 * 2;
constexpr size_t OFF_ATP = OFF_UT + (size_t)2048 * 128 * 64 * 2;
constexpr size_t OFF_EH = OFF_ATP + (size_t)2048 * 64 * 64 * 2;
constexpr size_t OFF_US = OFF_EH;
constexpr size_t OFF_LOCALG = OFF_EH + (size_t)32 * T_TOK * 16 * 2;
constexpr size_t OFF_BAR = OFF_EH + (size_t)T_TOK * 1024 * 2;
constexpr size_t WS_END = OFF_BAR + 16384;
constexpr size_t OFF_CTR = OFF_BAR + 15360;
constexpr size_t OUT_OFF_A0 = 0;
constexpr size_t OUT_OFF_SF = 0;
constexpr size_t OUT_OFF_YPRE = (size_t)T_TOK * 1024 * 2;
constexpr size_t OUT_OFF_ZT = OUT_OFF_YPRE + (size_t)T_TOK * 512 * 2;

struct Params {
  const float* in[23];
  float* out;
  unsigned char* ws;
  int ph_lo, ph_hi;
};

enum { I_X = 0, I_P, I_NMG, I_WIN, I_ARE, I_AIM, I_BRE, I_BIM, I_CRE, I_CIM, I_D, I_LOGDT, I_WGLU, I_BGLU,
       I_CONVW, I_ALOG, I_DTB, I_DNG, I_WOUT, I_WPP, I_PLEG, I_WGATE, I_FING };

__device__ __forceinline__ float wave_sum(float v) {
#pragma unroll
  for (int o = 32; o > 0; o >>= 1) v += __shfl_xor(v, o);
  return v;
}
__device__ __forceinline__ float sum16(float v) {
  v += __shfl_xor(v, 1); v += __shfl_xor(v, 2); v += __shfl_xor(v, 4); v += __shfl_xor(v, 8);
  return v;
}
__device__ __forceinline__ float sigmoidf_(float x) { return __builtin_amdgcn_rcpf(1.f + __expf(-x)); }
__device__ __forceinline__ float siluf_(float x) { return x * __builtin_amdgcn_rcpf(1.f + __expf(-x)); }
__device__ __forceinline__ float gelu_tanh(float y) {
  float z = 0.7978845608028654f * (y + 0.044715f * y * y * y);
  return y * __builtin_amdgcn_rcpf(1.f + __expf(-2.f * z));
}
__device__ __forceinline__ h16x8 pack8(f32x4 lo, f32x4 hi) {
  h16x8 r;
  r[0] = (h16)lo[0]; r[1] = (h16)lo[1]; r[2] = (h16)lo[2]; r[3] = (h16)lo[3];
  r[4] = (h16)hi[0]; r[5] = (h16)hi[1]; r[6] = (h16)hi[2]; r[7] = (h16)hi[3];
  return r;
}
__device__ __forceinline__ int perm_pos(int n) { return (n & ~31) + (((n & 15) >> 2) << 3) + (((n >> 4) & 1) << 2) + (n & 3); }
__device__ __forceinline__ int perm_inv(int pos) {
  int q5 = pos & 31, qq = q5 >> 3, jj = q5 & 7;
  return (pos & ~31) + (jj < 4 ? 4 * qq + jj : 16 + 4 * qq + (jj - 4));
}

__device__ void transpose_w(const float* __restrict__ W, int K, int N, int Npad, h16* __restrict__ WT, int t, float* tile) {
  const int ntn = Npad / 64;
  const int kt = t / ntn, nt = t % ntn, k0 = kt * 64, n0 = nt * 64;
  const int tx = threadIdx.x & 63, ty = threadIdx.x >> 6;
  for (int r = 0; r < 16; ++r) {
    int k = ty * 16 + r, n = n0 + tx;
    tile[k * 65 + tx] = (n < N) ? W[(size_t)(k0 + k) * N + n] : 0.f;
  }
  __syncthreads();
#pragma unroll
  for (int r2 = 0; r2 < 2; ++r2) {
    const int idx = threadIdx.x + 256 * r2, n = idx >> 3, kc = idx & 7;
    h16x8 o;
#pragma unroll
    for (int e = 0; e < 8; ++e) o[e] = (h16)tile[(kc * 8 + e) * 65 + n];
    *(h16x8*)(WT + (size_t)(n0 + n) * K + k0 + kc * 8) = o;
  }
  __syncthreads();
}

__device__ void ssm_table_item(const Params& p, int g, int d, float* lds) {
  float2* sAp = (float2*)lds;
  float2* sW = sAp + 64;
  const int tid = threadIdx.x;
  h16* KTAB = (h16*)(p.ws + OFF_KTAB);
  h16* ETAB = (h16*)(p.ws + OFF_ETAB);
  h16* FTAB = (h16*)(p.ws + OFF_FTAB);
  float* ALPOW = (float*)(p.ws + OFF_ALPOW);
  float* sBr = lds + 256; float* sBi = sBr + 1024; float* sCr = sBi + 1024; float* sCi = sCr + 16 * 65;
  {
    const float4 vbr = ((const float4*)(p.in[I_BRE] + g * 1024))[tid], vbi = ((const float4*)(p.in[I_BIM] + g * 1024))[tid];
    const float4 vcr = ((const float4*)(p.in[I_CRE] + g * 1024))[tid], vci = ((const float4*)(p.in[I_CIM] + g * 1024))[tid];
    *(float4*)(sBr + tid * 4) = vbr; *(float4*)(sBi + tid * 4) = vbi;
    const int ch = (tid * 4) >> 6, cp = (tid * 4) & 63;
    sCr[ch * 65 + cp] = vcr.x; sCr[ch * 65 + cp + 1] = vcr.y; sCr[ch * 65 + cp + 2] = vcr.z; sCr[ch * 65 + cp + 3] = vcr.w;
    sCi[ch * 65 + cp] = vci.x; sCi[ch * 65 + cp + 1] = vci.y; sCi[ch * 65 + cp + 2] = vci.z; sCi[ch * 65 + cp + 3] = vci.w;
  }
  if (tid < 64) {
    const int pp = tid;
    float lr = p.in[I_ARE][g * 64 + pp], li = p.in[I_AIM][g * 64 + pp], dt = expf(p.in[I_LOGDT][g]);
    float mag = expf(lr * dt), ang = li * dt;
    float abr = mag * cosf(ang), abi = mag * sinf(ang);
    float nr = abr - 1.f, ni = abi, den = lr * lr + li * li;
    float cr = (nr * lr + ni * li) / den, ci = (ni * lr - nr * li) / den;
    float apr = 1.f, api = 0.f;
    for (int k = 0; k < d; ++k) { float t0 = apr * abr - api * abi; api = apr * abi + api * abr; apr = t0; }
    sAp[pp] = make_float2(apr, api);
    sW[pp] = make_float2(apr * cr - api * ci, apr * ci + api * cr);
    if (d == 32) { ALPOW[(g * 64 + pp) * 2] = apr; ALPOW[(g * 64 + pp) * 2 + 1] = api; }
  }
  __syncthreads();
  if (d < 32) {
    {
      const int h = tid >> 4, hp = tid & 15;
      float acc = 0.f;
#pragma unroll 8
      for (int pp = 0; pp < 64; ++pp) {
        float2 W = sW[pp];
        float br = sBr[pp * 16 + hp], bi = sBi[pp * 16 + hp];
        float wbr = W.x * br - W.y * bi, wbi = W.x * bi + W.y * br;
        float cr = sCr[h * 65 + pp], ci = sCi[h * 65 + pp];
        acc += cr * wbr - ci * wbi;
      }
      if (d == 0 && h == hp) acc += p.in[I_D][g * 16 + h];
      KTAB[(size_t)(g * 33 + d + 1) * 256 + h * 16 + hp] = (h16)acc;
      if (d == 0) KTAB[(size_t)(g * 33) * 256 + tid] = (h16)0.f;
    }
    {
      const int i = 31 - d;
#pragma unroll
      for (int r = 0; r < 4; ++r) {
        int idx = tid + 256 * r, pp = idx >> 4, hp = idx & 15;
        float2 W = sW[pp];
        float br = sBr[pp * 16 + hp], bi = sBi[pp * 16 + hp];
        float wbr = W.x * br - W.y * bi, wbi = W.x * bi + W.y * br;
        ETAB[((size_t)g * 128 + pp) * 512 + i * 16 + hp] = (h16)wbr;
        ETAB[((size_t)g * 128 + 64 + pp) * 512 + i * 16 + hp] = (h16)wbi;
      }
    }
  }
  if (d >= 1) {
    const int j = d - 1;
#pragma unroll
    for (int r = 0; r < 4; ++r) {
      int idx = tid + 256 * r, h = idx >> 6, pp = idx & 63;
      float2 Ap = sAp[pp];
      float cr = sCr[h * 65 + pp], ci = sCi[h * 65 + pp];
      float re = cr * Ap.x - ci * Ap.y, im = cr * Ap.y + ci * Ap.x;
      FTAB[((size_t)g * 512 + j * 16 + h) * 128 + pp] = (h16)re;
      FTAB[((size_t)g * 512 + j * 16 + h) * 128 + 64 + pp] = (h16)(-im);
    }
  }
  __syncthreads();
}

__device__ void phase0(const Params& p, unsigned char* smem) {
  const int bid = blockIdx.x, nb = gridDim.x, tid = threadIdx.x, wid = tid >> 6, lane = tid & 63;
  float* tile = (float*)smem;
  for (int t = bid; t < 1440; t += nb) {
    if (t < 800) transpose_w(p.in[I_WIN], 1024, 3080, 3200, (h16*)(p.ws + OFF_WIN), t, tile);
    else if (t < 864) transpose_w(p.in[I_WGLU], 512, 512, 512, (h16*)(p.ws + OFF_WGLU), t - 800, tile);
    else if (t < 1120) transpose_w(p.in[I_WOUT], 1024, 1024, 1024, (h16*)(p.ws + OFF_WOUT), t - 864, tile);
    else if (t < 1184) transpose_w(p.in[I_WPP], 256, 1024, 1024, (h16*)(p.ws + OFF_WPP), t - 1120, tile);
    else transpose_w(p.in[I_WGATE], 1024, 1024, 1024, (h16*)(p.ws + OFF_WGATE), t - 1184, tile);
  }
  for (int it = bid; it < 32 * 33; it += nb) ssm_table_item(p, it / 33, it % 33, (float*)smem);
  {
    h16* A0 = (h16*)((unsigned char*)p.out + OUT_OFF_A0);
    const float* x = p.in[I_X];
    const float4* g4 = (const float4*)p.in[I_NMG];
    for (int row = bid * 4 + wid; row < T_TOK; row += nb * 4) {
      const float4* xr = (const float4*)(x + (size_t)row * 1024);
      float4 v[4];
      float ss = 0.f;
#pragma unroll
      for (int i = 0; i < 4; ++i) {
        v[i] = xr[lane + i * 64];
        ss += v[i].x * v[i].x + v[i].y * v[i].y + v[i].z * v[i].z + v[i].w * v[i].w;
      }
      ss = wave_sum(ss);
      float rstd = rsqrtf(ss * (1.f / 1024.f) + 1e-6f);
#pragma unroll
      for (int i = 0; i < 4; ++i) {
        float4 g = g4[lane + i * 64];
        h16x4 o;
        o[0] = (h16)(v[i].x * rstd * g.x); o[1] = (h16)(v[i].y * rstd * g.y);
        o[2] = (h16)(v[i].z * rstd * g.z); o[3] = (h16)(v[i].w * rstd * g.w);
        *(h16x4*)(A0 + (size_t)row * 1024 + (lane + i * 64) * 4) = o;
      }
    }
  }
  {
    h16* PB = (h16*)(p.ws + OFF_PB);
    const float4* p4 = (const float4*)p.in[I_P];
    const size_t n4 = (size_t)T_TOK * 256 / 4;
    for (size_t i = (size_t)bid * 256 + tid; i < n4; i += (size_t)nb * 256) {
      float4 v = p4[i];
      h16x4 o;
      o[0] = (h16)v.x; o[1] = (h16)v.y; o[2] = (h16)v.z; o[3] = (h16)v.w;
      *(h16x4*)(PB + i * 4) = o;
    }
  }
}

enum { EPI_PROJ = 0, EPI_GLU, EPI_PLE, EPI_OUT, EPI_GATE, EPI_LOCAL };

template <int EPI>
__device__ __forceinline__ void gemm_tile(const Params& p, const h16* __restrict__ A, int lda, const h16* __restrict__ Bt, int ldb,
                                          int K, int brow, int bcol, unsigned char* smem) {
  const int tid = threadIdx.x, wid = tid >> 6, lane = tid & 63, wr = wid >> 1, wc = wid & 1, fr = lane & 15, fq = lane >> 4;
  f32x4 acc[4][4];
#pragma unroll
  for (int m = 0; m < 4; ++m)
#pragma unroll
    for (int n = 0; n < 4; ++n) acc[m][n] = f32x4{0.f, 0.f, 0.f, 0.f};
  const int nk = K / 64;
  const h16* ga[4]; const h16* gb[4];
#pragma unroll
  for (int i = 0; i < 4; ++i) {
    const int L = tid + 256 * i, row = L >> 3, cs = (L & 7) ^ (row & 7);
    ga[i] = A + (size_t)(brow + row) * lda + cs * 8;
    gb[i] = Bt + (size_t)(bcol + row) * ldb + cs * 8;
  }
#define GEMM_STAGE(t_, buf_) do { \
    unsigned char* sa_ = smem + (buf_) * 32768 + tid * 16; \
    _Pragma("unroll") for (int i_ = 0; i_ < 4; ++i_) { \
      __builtin_amdgcn_global_load_lds((const unsigned*)(ga[i_] + (t_) * 64), (unsigned*)(sa_ + i_ * 4096), 16, 0, 0); \
      __builtin_amdgcn_global_load_lds((const unsigned*)(gb[i_] + (t_) * 64), (unsigned*)(sa_ + 16384 + i_ * 4096), 16, 0, 0); \
    } \
  } while (0)
  GEMM_STAGE(0, 0);
  for (int t = 0; t < nk; ++t) {
    asm volatile("s_waitcnt vmcnt(0)" ::: "memory");
    __syncthreads();
    if (t + 1 < nk) GEMM_STAGE(t + 1, (t + 1) & 1);
    const unsigned char* SA = smem + (t & 1) * 32768;
    const unsigned char* SB = SA + 16384;
    h16x8 af[2][4], bf[2][4];
#pragma unroll
    for (int kk = 0; kk < 2; ++kk) {
      const int pos = ((kk * 4 + fq) ^ (fr & 7)) << 4;
#pragma unroll
      for (int m = 0; m < 4; ++m) {
        af[kk][m] = *(const h16x8*)(SA + (wr * 64 + m * 16 + fr) * 128 + pos);
        bf[kk][m] = *(const h16x8*)(SB + (wc * 64 + m * 16 + fr) * 128 + pos);
      }
    }
    __builtin_amdgcn_s_setprio(1);
#pragma unroll
    for (int kk = 0; kk < 2; ++kk)
#pragma unroll
      for (int m = 0; m < 4; ++m)
#pragma unroll
        for (int n = 0; n < 4; ++n) acc[m][n] = MFMA(af[kk][m], bf[kk][n], acc[m][n]);
    __builtin_amdgcn_s_setprio(0);
  }
#undef GEMM_STAGE
  __syncthreads();
  float* CT = (float*)smem;
  const int c4 = tid & 31, col = bcol + c4 * 4, r0 = tid >> 5;
  float4 pre_f[16];
  h16x4 pre_a[16], pre_b[16];
  float4 cst = {0.f, 0.f, 0.f, 0.f};
  if constexpr (EPI == EPI_OUT) {
#pragma unroll
    for (int it = 0; it < 16; ++it) pre_f[it] = *(const float4*)(p.in[I_X] + ((size_t)brow + it * 8 + r0) * 1024 + col);
  } else if constexpr (EPI == EPI_GLU) {
    cst = *(const float4*)(p.in[I_BGLU] + col);
#pragma unroll
    for (int it = 0; it < 16; ++it) {
      const size_t row = (size_t)brow + it * 8 + r0;
      pre_a[it] = *(const h16x4*)((const h16*)((unsigned char*)p.out + OUT_OFF_YPRE) + row * 512 + col);
      pre_b[it] = *(const h16x4*)((const h16*)(p.ws + OFF_PROJ) + row * LDP + 512 + col);
    }
  } else if constexpr (EPI == EPI_GATE) {
    cst = *(const float4*)(p.in[I_PLEG] + col);
#pragma unroll
    for (int it = 0; it < 16; ++it) {
      const size_t row = (size_t)brow + it * 8 + r0;
      pre_a[it] = *(const h16x4*)((const h16*)(p.ws + OFF_EH) + row * 1024 + col);
      pre_b[it] = *(const h16x4*)((const h16*)(p.ws + OFF_PROJ) + row * 1024 + col);
    }
    if (tid < 128) {
      const float4 e0 = *(const float4*)((const float*)(p.ws + OFF_EPART) + ((size_t)brow + tid) * 8);
      const float4 e1 = *(const float4*)((const float*)(p.ws + OFF_EPART) + ((size_t)brow + tid) * 8 + 4);
      ((float*)(smem + 67584))[tid] = rsqrtf((e0.x + e0.y + e0.z + e0.w + e1.x + e1.y + e1.z + e1.w) * (1.f / 1024.f) + 1e-6f);
    }
  }
#pragma unroll
  for (int m = 0; m < 4; ++m)
#pragma unroll
    for (int n = 0; n < 4; ++n)
#pragma unroll
      for (int j = 0; j < 4; ++j) CT[(wr * 64 + m * 16 + fq * 4 + j) * 132 + wc * 64 + n * 16 + fr] = acc[m][n][j];
  __syncthreads();
#pragma unroll
  for (int it = 0; it < 16; ++it) {
    const int rl = it * 8 + r0;
    const size_t row = (size_t)brow + rl;
    const float4 v = *(const float4*)(CT + rl * 132 + c4 * 4);
    if constexpr (EPI == EPI_PROJ) {
      if (bcol < 512) {
        h16x4 o; o[0] = (h16)v.x; o[1] = (h16)v.y; o[2] = (h16)v.z; o[3] = (h16)v.w;
        *(h16x4*)((h16*)(p.ws + OFF_US) + ((size_t)(col >> 4) * T_TOK + row) * 16 + (col & 15)) = o;
      } else if (bcol < 3072) {
        h16x4 o; o[0] = (h16)v.x; o[1] = (h16)v.y; o[2] = (h16)v.z; o[3] = (h16)v.w;
        *(h16x4*)((h16*)(p.ws + OFF_PROJ) + row * LDP + col) = o;
      } else if (c4 < 2) {
        *(float4*)((float*)(p.ws + OFF_AB) + row * 8 + c4 * 4) = v;
      }
    } else if constexpr (EPI == EPI_LOCAL) {
      *(float4*)((float*)(p.ws + OFF_LOCALG) + row * 128 + col) = v;
    } else if constexpr (EPI == EPI_GLU) {
      const h16x4 y = pre_a[it], z = pre_b[it];
      h16x4 o;
      o[0] = (h16)((float)y[0] * sigmoidf_(v.x + cst.x) * siluf_((float)z[0]));
      o[1] = (h16)((float)y[1] * sigmoidf_(v.y + cst.y) * siluf_((float)z[1]));
      o[2] = (h16)((float)y[2] * sigmoidf_(v.z + cst.z) * siluf_((float)z[2]));
      o[3] = (h16)((float)y[3] * sigmoidf_(v.w + cst.w) * siluf_((float)z[3]));
      *(h16x4*)((h16*)(p.ws + OFF_MIXIN) + row * 1024 + col) = o;
    } else if constexpr (EPI == EPI_PLE) {
      h16x4 o; o[0] = (h16)v.x; o[1] = (h16)v.y; o[2] = (h16)v.z; o[3] = (h16)v.w;
      *(h16x4*)((h16*)(p.ws + OFF_EH) + row * 1024 + col) = o;
      float s = v.x * v.x + v.y * v.y + v.z * v.z + v.w * v.w;
      s = sum16(s); s += __shfl_xor(s, 16);
      if (c4 == 0) ((float*)(p.ws + OFF_EPART))[row * 8 + (bcol >> 7)] = s;
    } else if constexpr (EPI == EPI_OUT) {
      const float4 xv = pre_f[it];
      h16x4 o; o[0] = (h16)(xv.x + v.x); o[1] = (h16)(xv.y + v.y); o[2] = (h16)(xv.z + v.z); o[3] = (h16)(xv.w + v.w);
      *(h16x4*)((h16*)(p.ws + OFF_PROJ) + row * 1024 + col) = o;
    } else if constexpr (EPI == EPI_GATE) {
      const float rs = ((const float*)(smem + 67584))[rl];
      const h16x4 eh = pre_a[it], hb = pre_b[it];
      float4 hv;
      hv.x = (float)hb[0] + sigmoidf_(v.x) * ((float)eh[0] * rs * cst.x);
      hv.y = (float)hb[1] + sigmoidf_(v.y) * ((float)eh[1] * rs * cst.y);
      hv.z = (float)hb[2] + sigmoidf_(v.z) * ((float)eh[2] * rs * cst.z);
      hv.w = (float)hb[3] + sigmoidf_(v.w) * ((float)eh[3] * rs * cst.w);
      {
        h16x4 o; o[0] = (h16)hv.x; o[1] = (h16)hv.y; o[2] = (h16)hv.z; o[3] = (h16)hv.w;
        *(h16x4*)((h16*)(p.ws + OFF_MIXIN) + row * 1024 + col) = o;
      }
      float s = hv.x * hv.x + hv.y * hv.y + hv.z * hv.z + hv.w * hv.w;
      s = sum16(s); s += __shfl_xor(s, 16);
      if (c4 == 0) ((float*)(p.ws + OFF_OPART))[row * 8 + (bcol >> 7)] = s;
    }
  }
  __syncthreads();
}

__device__ void ssm_item(const Params& p, int b, int g, unsigned char* smem) {
  float* LOCAL = (float*)smem;
  h16* SPREV = (h16*)(smem + 33792);
  h16* KT = (h16*)(smem + 51200);
  unsigned char* ERING = smem + 33792;
  unsigned char* FRING = smem;
  int tid_ = threadIdx.x;
  asm volatile("" : "+v"(tid_));
  const int tid = tid_, w = tid >> 6, lane = tid & 63, fr = lane & 15, fq = lane >> 4;
  const h16* PROJ = (const h16*)(p.ws + OFF_PROJ);
  const h16* Eg = (const h16*)(p.ws + OFF_ETAB) + (size_t)g * 128 * 512;
  const h16* Kg = (const h16*)(p.ws + OFF_KTAB) + (size_t)g * 33 * 256;
  const h16* Fg = (const h16*)(p.ws + OFF_FTAB) + (size_t)g * 512 * 128;
  const float* ALPOW = (const float*)(p.ws + OFF_ALPOW);
  h16* YPRE = (h16*)((unsigned char*)p.out + OUT_OFF_YPRE);
  const int nchunk = w * 16 + fr;
  const size_t tok0 = (size_t)b * SEQ + (size_t)nchunk * 32;
  h16x8 uf[16];
#pragma unroll
  for (int ks = 0; ks < 16; ++ks) {
    const int i = 2 * ks + (fq >> 1);
    uf[ks] = *(const h16x8*)((const h16*)(p.ws + OFF_US) + ((size_t)g * T_TOK + tok0 + i) * 16 + (fq & 1) * 8);
  }
  {
    const float* lg = (const float*)(p.ws + OFF_LOCALG) + ((size_t)g * 1024 + (size_t)b * 64) * 128;
    float4 lv[8]; h16x8 kt[5];
#pragma unroll
    for (int i = 0; i < 8; ++i) { const int idx = tid + 256 * i; lv[i] = *(const float4*)(lg + (size_t)(idx >> 5) * 128 + (idx & 31) * 4); }
#pragma unroll
    for (int i = 0; i < 5; ++i) { const int idx = tid + 256 * i; kt[i] = *(const h16x8*)(Kg + (idx < 1056 ? idx : 1055) * 8); }
#pragma unroll
    for (int i = 0; i < 8; ++i) { const int idx = tid + 256 * i; *(float4*)(LOCAL + (idx >> 5) * 132 + (idx & 31) * 4) = lv[i]; }
#pragma unroll
    for (int i = 0; i < 5; ++i) { const int idx = tid + 256 * i; if (idx < 1056) *(h16x8*)(KT + idx * 8) = kt[i]; }
  }
#pragma unroll
  for (int ks = 0; ks < 16; ++ks) asm volatile("" : "+v"(uf[ks]));
  __syncthreads();
  if (tid < 64) {
    const int pp = tid;
    const float ar = ALPOW[(g * 64 + pp) * 2], ai = ALPOW[(g * 64 + pp) * 2 + 1];
    float sr = 0.f, si = 0.f;
#pragma unroll 1
    for (int c8 = 0; c8 < 8; ++c8) {
      float lr[8], li[8];
#pragma unroll
      for (int k = 0; k < 8; ++k) { lr[k] = LOCAL[(c8 * 8 + k) * 132 + pp]; li[k] = LOCAL[(c8 * 8 + k) * 132 + 64 + pp]; }
#pragma unroll
      for (int k = 0; k < 8; ++k) {
        SPREV[(c8 * 8 + k) * 136 + pp] = (h16)sr;
        SPREV[(c8 * 8 + k) * 136 + 64 + pp] = (h16)si;
        const float nr = ar * sr - ai * si + lr[k];
        const float ni = ar * si + ai * sr + li[k];
        sr = nr; si = ni;
      }
    }
  }
  asm volatile("s_waitcnt vmcnt(0)" ::: "memory");
  __syncthreads();
  h16x8 sf[4];
#pragma unroll
  for (int ks = 0; ks < 4; ++ks) sf[ks] = *(const h16x8*)(SPREV + nchunk * 136 + ks * 32 + fq * 8);
  const h16* fsrc = Fg + (size_t)(tid >> 4) * 128 + (((tid & 15) ^ (tid >> 4)) << 3);
#define F_STAGE(j_) __builtin_amdgcn_global_load_lds((const unsigned*)(fsrc + (size_t)((j_) < 31 ? (j_) : 31) * 16 * 128), \
                                                     (unsigned*)(FRING + ((j_) & 7) * 4096 + tid * 16), 16, 0, 0)
  F_STAGE(0); F_STAGE(1); F_STAGE(2); F_STAGE(3); F_STAGE(4); F_STAGE(5);
#pragma unroll 1
  for (int j2 = 0; j2 < 16; ++j2) {
    const int j = 2 * j2;
    if (j2 == 0) asm volatile("s_waitcnt vmcnt(4)" ::: "memory");
    else if (j2 == 1) asm volatile("s_waitcnt vmcnt(6)" ::: "memory");
    else asm volatile("s_waitcnt vmcnt(8)" ::: "memory");
    asm volatile("s_waitcnt lgkmcnt(0)" ::: "memory");
    __builtin_amdgcn_s_barrier();
    asm volatile("" ::: "memory");
    F_STAGE(j + 6); F_STAGE(j + 7);
    asm volatile("" ::: "memory");
    f32x4 acc0 = {0.f, 0.f, 0.f, 0.f}, acc1 = {0.f, 0.f, 0.f, 0.f}, bcc0 = {0.f, 0.f, 0.f, 0.f}, bcc1 = {0.f, 0.f, 0.f, 0.f};
#pragma unroll
    for (int ks = 0; ks < 16; ++ks) {
      if (2 * ks <= j) {
        const int dd = j - 2 * ks - (fq >> 1) + 1;
        h16x8 a0 = *(const h16x8*)(KT + dd * 256 + fr * 16 + (fq & 1) * 8);
        h16x8 a1 = *(const h16x8*)(KT + (dd + 1) * 256 + fr * 16 + (fq & 1) * 8);
        if (ks & 1) { acc1 = MFMA(a0, uf[ks], acc1); bcc1 = MFMA(a1, uf[ks], bcc1); }
        else { acc0 = MFMA(a0, uf[ks], acc0); bcc0 = MFMA(a1, uf[ks], bcc0); }
      }
    }
    if (j2 < 15) {
    }
    {
    }
    const unsigned char* slot0 = FRING + (j & 7) * 4096 + fr * 256;
    const unsigned char* slot1 = FRING + ((j + 1) & 7) * 4096 + fr * 256;
#pragma unroll
    for (int ks = 0; ks < 4; ++ks) {
      h16x8 a0 = *(const h16x8*)(slot0 + (((ks * 4 + fq) ^ fr) << 4));
      h16x8 a1 = *(const h16x8*)(slot1 + (((ks * 4 + fq) ^ fr) << 4));
      if (ks & 1) { acc1 = MFMA(a0, sf[ks], acc1); bcc1 = MFMA(a1, sf[ks], bcc1); }
      else { acc0 = MFMA(a0, sf[ks], acc0); bcc0 = MFMA(a1, sf[ks], bcc0); }
    }
    h16x4 o0, o1;
#pragma unroll
    for (int r = 0; r < 4; ++r) { o0[r] = (h16)gelu_tanh(acc0[r] + acc1[r]); o1[r] = (h16)gelu_tanh(bcc0[r] + bcc1[r]); }
    *(h16x4*)(YPRE + (tok0 + j) * 512 + g * 16 + fq * 4) = o0;
    *(h16x4*)(YPRE + (tok0 + j + 1) * 512 + g * 16 + fq * 4) = o1;
    asm volatile("" ::: "memory");
  }
#undef F_STAGE
  asm volatile("s_waitcnt vmcnt(0)" ::: "memory");
  __syncthreads();
}

__device__ void gdn_pre_item(const Params& p, int item, unsigned char* smem) {
  h16* QH = (h16*)smem;
  h16* KH = (h16*)(smem + 17408);
  h16* VH = (h16*)(smem + 34816);
  float* Ld = (float*)(smem + 52224);
  h16* Limg = (h16*)(smem + 56576);
  h16* Dimg = (h16*)(smem + 60672);
  float* sG = (float*)(smem + 69632);
  float* sBeta = (float*)(smem + 69888);
  float* sEG = (float*)(smem + 70144);
  float* sBG = (float*)(smem + 70400);
  float* sEL = (float*)(smem + 70656);
  int tid_ = threadIdx.x;
  asm volatile("" : "+v"(tid_));
  const int tid = tid_, w = tid >> 6, lane = tid & 63, fr = lane & 15, fq = lane >> 4;
  const int c = item & 31, h = (item >> 5) & 3, b = item >> 7;
  const h16* PROJ = (const h16*)(p.ws + OFF_PROJ);
  const float* AB = (const float*)(p.ws + OFF_AB);
  const float* convw = p.in[I_CONVW];
  h16* WPi = (h16*)(p.ws + OFF_WP) + (size_t)item * 64 * 128;
  h16* QGPi = (h16*)(p.ws + OFF_QGP) + (size_t)item * 64 * 128;
  h16* KDTi = (h16*)(p.ws + OFF_KDT) + (size_t)item * 128 * 64;
  h16* UTi = (h16*)(p.ws + OFF_UT) + (size_t)item * 128 * 64;
  h16* ATPi = (h16*)(p.ws + OFF_ATP) + (size_t)item * 64 * 64;
  h16* ZTi = (h16*)((unsigned char*)p.out + OUT_OFF_ZT) + (size_t)item * 128 * 64;
  float* DL = (float*)(p.ws + OFF_DL);
  {
    const h16x8 z8 = {(h16)0.f, (h16)0.f, (h16)0.f, (h16)0.f, (h16)0.f, (h16)0.f, (h16)0.f, (h16)0.f};
    *(h16x8*)(Limg + tid * 8) = z8; *(h16x8*)(Limg + 2048 + tid * 8) = z8;
  }
  {
    const int ch0 = (tid & 15) * 8, t0 = (tid >> 4) * 4;
#pragma unroll 1
    for (int sec = 0; sec < 3; ++sec) {
      const int colbase = 1024 + sec * 512 + h * 128 + ch0;
      h16x8 xr[7];
#pragma unroll
      for (int i = 0; i < 7; ++i) {
        const int ts = c * 64 + t0 - 3 + i;
        h16x8 z8 = {(h16)0.f, (h16)0.f, (h16)0.f, (h16)0.f, (h16)0.f, (h16)0.f, (h16)0.f, (h16)0.f};
        xr[i] = (ts >= 0) ? *(const h16x8*)(PROJ + ((size_t)b * SEQ + ts) * LDP + colbase) : z8;
      }
      float4 wv[4][2];
#pragma unroll
      for (int jj = 0; jj < 4; ++jj) {
        wv[jj][0] = *(const float4*)(convw + jj * 1536 + sec * 512 + h * 128 + ch0);
        wv[jj][1] = *(const float4*)(convw + jj * 1536 + sec * 512 + h * 128 + ch0 + 4);
      }
      h16* dst = (sec == 0 ? QH : (sec == 1 ? KH : VH));
#pragma unroll
      for (int tt = 0; tt < 4; ++tt) {
        float a[8];
#pragma unroll
        for (int e = 0; e < 8; ++e) a[e] = 0.f;
#pragma unroll
        for (int jj = 0; jj < 4; ++jj) {
          const h16x8 xv = xr[tt + jj];
          a[0] += wv[jj][0].x * (float)xv[0]; a[1] += wv[jj][0].y * (float)xv[1]; a[2] += wv[jj][0].z * (float)xv[2]; a[3] += wv[jj][0].w * (float)xv[3];
          a[4] += wv[jj][1].x * (float)xv[4]; a[5] += wv[jj][1].y * (float)xv[5]; a[6] += wv[jj][1].z * (float)xv[6]; a[7] += wv[jj][1].w * (float)xv[7];
        }
        float ss = 0.f;
#pragma unroll
        for (int e = 0; e < 8; ++e) { a[e] = siluf_(a[e]); ss += a[e] * a[e]; }
        float scale = 1.f;
        if (sec < 2) {
          ss = sum16(ss);
          scale = rsqrtf(ss + 1e-6f) * (sec == 0 ? 0.08838834764831845f : 1.f);
        }
        h16x8 o;
#pragma unroll
        for (int e = 0; e < 8; ++e) o[e] = (h16)(a[e] * scale);
        *(h16x8*)(dst + (t0 + tt) * 136 + ch0) = o;
      }
    }
  }
  if (tid < 64) {
    const size_t tok = (size_t)b * SEQ + c * 64 + tid;
    float braw = AB[tok * 8 + h], araw = AB[tok * 8 + 4 + h];
    float beta = 1.f / (1.f + expf(-braw));
    float xx = araw + p.in[I_DTB][h];
    float sp = xx > 20.f ? xx : log1pf(expf(xx));
    float gg = -expf(p.in[I_ALOG][h]) * sp;
#pragma unroll
    for (int o = 1; o < 64; o <<= 1) {
      float v = __shfl_up(gg, o);
      if (lane >= o) gg += v;
    }
    sG[tid] = gg;
    sBeta[tid] = beta;
    const float eg = expf(gg);
    sEG[tid] = eg;
    sBG[tid] = beta * eg;
    sEL[tid] = expf(__shfl(gg, 63) - gg);
  }
  __syncthreads();
  {
    h16x8 ak[4], aq[4];
#pragma unroll
    for (int ks = 0; ks < 4; ++ks) {
      ak[ks] = *(const h16x8*)(KH + (w * 16 + fr) * 136 + ks * 32 + fq * 8);
      aq[ks] = *(const h16x8*)(QH + (w * 16 + fr) * 136 + ks * 32 + fq * 8);
    }
#pragma unroll
    for (int jt = 0; jt < 4; ++jt) {
      const int j = jt * 16 + fr;
      const int pj = perm_pos(j);
      if (jt <= w) {
        f32x4 kk = {0.f, 0.f, 0.f, 0.f}, qk = {0.f, 0.f, 0.f, 0.f};
#pragma unroll
        for (int ks = 0; ks < 4; ++ks) {
          h16x8 bk = *(const h16x8*)(KH + (jt * 16 + fr) * 136 + ks * 32 + fq * 8);
          kk = MFMA(ak[ks], bk, kk);
          qk = MFMA(aq[ks], bk, qk);
        }
        const float Gj = sG[j];
        f32x4 lt;
#pragma unroll
        for (int r = 0; r < 4; ++r) {
          const int i = w * 16 + 4 * fq + r;
          const float e = (i >= j) ? __expf(sG[i] - Gj) : 0.f;
          lt[r] = (i > j) ? sBeta[i] * kk[r] * e : 0.f;
          ATPi[i * 64 + (((pj >> 3) ^ (i & 7)) << 3) + (pj & 7)] = (h16)(qk[r] * e);
        }
        if (jt == w) {
#pragma unroll
          for (int r = 0; r < 4; ++r) Ld[(w * 16 + 4 * fq + r) * 17 + fr] = lt[r];
        } else {
          const int img = (w == 1) ? 0 : (w == 2 ? 1 : (jt < 2 ? 2 : 3));
#pragma unroll
          for (int r = 0; r < 4; ++r) Limg[img * 512 + (4 * fq + r) * 32 + (fr >> 2) * 8 + (fr & 3) + 4 * (jt & 1)] = (h16)(-lt[r]);
        }
      } else {
#pragma unroll
        for (int r = 0; r < 4; ++r) {
          const int i = w * 16 + 4 * fq + r;
          ATPi[i * 64 + (((pj >> 3) ^ (i & 7)) << 3) + (pj & 7)] = (h16)0.f;
        }
      }
    }
  }
  __syncthreads();
  if (lane < 16) {
    float y[16];
#pragma unroll
    for (int i = 0; i < 16; ++i) {
      float s = (i == lane) ? 1.f : 0.f;
#pragma unroll
      for (int k = 0; k < i; ++k) s -= Ld[(w * 16 + i) * 17 + k] * y[k];
      y[i] = s;
    }
#pragma unroll
    for (int i = 0; i < 16; ++i) Dimg[w * 512 + i * 32 + (lane >> 2) * 8 + (lane & 3)] = (h16)y[i];
  }
  __syncthreads();
  f32x4 xs[4][4];
  {
    const h16* SRC = (w < 2) ? VH : KH;
    const float* scl = (w < 2) ? sBeta : sBG;
    const int cbase = (w & 1) * 64;
    h16x8 dA[4], lA[4];
#pragma unroll
    for (int b4 = 0; b4 < 4; ++b4) {
      dA[b4] = *(const h16x8*)(Dimg + b4 * 512 + fr * 32 + fq * 8);
      lA[b4] = *(const h16x8*)(Limg + b4 * 512 + fr * 32 + fq * 8);
    }
    const f32x4 z4 = {0.f, 0.f, 0.f, 0.f};
#pragma unroll
    for (int nt = 0; nt < 4; ++nt) {
      const int col = cbase + nt * 16 + fr;
      f32x4 rb[4];
#pragma unroll
      for (int b4 = 0; b4 < 4; ++b4)
#pragma unroll
        for (int r = 0; r < 4; ++r) rb[b4][r] = (float)SRC[(b4 * 16 + 4 * fq + r) * 136 + col] * scl[b4 * 16 + 4 * fq + r];
      const f32x4 x0 = MFMA(dA[0], pack8(rb[0], z4), z4);
      const f32x4 a1 = MFMA(lA[0], pack8(x0, z4), rb[1]);
      const f32x4 x1 = MFMA(dA[1], pack8(a1, z4), z4);
      const h16x8 x01 = pack8(x0, x1);
      const f32x4 a2 = MFMA(lA[1], x01, rb[2]);
      const f32x4 x2 = MFMA(dA[2], pack8(a2, z4), z4);
      f32x4 a3 = MFMA(lA[2], x01, rb[3]);
      a3 = MFMA(lA[3], pack8(x2, z4), a3);
      const f32x4 x3 = MFMA(dA[3], pack8(a3, z4), z4);
      xs[nt][0] = x0; xs[nt][1] = x1; xs[nt][2] = x2; xs[nt][3] = x3;
      if (w < 2) {
#pragma unroll
        for (int b4 = 0; b4 < 4; ++b4) {
          h16x4 o; o[0] = (h16)xs[nt][b4][0]; o[1] = (h16)xs[nt][b4][1]; o[2] = (h16)xs[nt][b4][2]; o[3] = (h16)xs[nt][b4][3];
          *(h16x4*)(UTi + (size_t)col * 64 + b4 * 16 + 4 * fq) = o;
        }
      }
    }
  }
  __syncthreads();
  if (w >= 2) {
#pragma unroll
    for (int nt = 0; nt < 4; ++nt) {
      const int pos = perm_pos((w & 1) * 64 + nt * 16 + fr);
#pragma unroll
      for (int b4 = 0; b4 < 4; ++b4)
#pragma unroll
        for (int r = 0; r < 4; ++r) VH[(b4 * 16 + 4 * fq + r) * 136 + pos] = (h16)xs[nt][b4][r];
    }
  }
  __syncthreads();
  for (int rr = 0; rr < 4; ++rr) {
    const int idx = tid + 256 * rr, row = idx >> 4, seg = idx & 15;
    *(h16x8*)(WPi + row * 128 + ((seg ^ (row & 15)) << 3)) = *(const h16x8*)(VH + row * 136 + seg * 8);
  }
  {
    const int dv = tid & 127, th = tid >> 7;
    const float gdv = p.in[I_DNG][dv];
    const h16* zp = PROJ + ((size_t)b * SEQ + c * 64 + th * 32) * LDP + 2560 + h * 128 + dv;
    h16 zv[32];
#pragma unroll
    for (int t = 0; t < 32; ++t) zv[t] = zp[(size_t)t * LDP];
#pragma unroll
    for (int t8 = 0; t8 < 4; ++t8) {
      h16x8 v;
#pragma unroll
      for (int e = 0; e < 8; ++e) v[e] = (h16)(siluf_((float)zv[t8 * 8 + e]) * gdv);
      *(h16x8*)(ZTi + (size_t)dv * 64 + th * 32 + t8 * 8) = v;
    }
  }
#pragma unroll 2
  for (int rr = 0; rr < 4; ++rr) {
    const int idx = tid + 256 * rr, t = idx >> 4, cpos = idx & 15, ks = cpos >> 2, q = cpos & 3;
    const h16x4 lo = *(const h16x4*)(QH + t * 136 + ks * 32 + 4 * q);
    const h16x4 hi = *(const h16x4*)(QH + t * 136 + ks * 32 + 16 + 4 * q);
    const float sc = sEG[t];
    h16x8 o;
#pragma unroll
    for (int e = 0; e < 4; ++e) { o[e] = (h16)((float)lo[e] * sc); o[4 + e] = (h16)((float)hi[e] * sc); }
    *(h16x8*)(QGPi + t * 128 + ((cpos ^ (t & 15)) << 3)) = o;
  }
#pragma unroll 2
  for (int rr = 0; rr < 4; ++rr) {
    const int idx = tid + 256 * rr, dk = idx >> 3, cpos = idx & 7, k2 = cpos >> 2, q = cpos & 3;
    h16x8 o;
#pragma unroll
    for (int e = 0; e < 8; ++e) {
      const int t = k2 * 32 + (e < 4 ? 4 * q + e : 16 + 4 * q + (e - 4));
      o[e] = (h16)((float)KH[t * 136 + dk] * sEL[t]);
    }
    *(h16x8*)(KDTi + dk * 64 + ((cpos ^ (dk & 7)) << 3)) = o;
  }
  const float Glast = sG[63];
  if (tid == 0) DL[item] = expf(Glast);
  __syncthreads();
}

template <int NB>
__device__ __forceinline__ void glds_copy(const h16* __restrict__ g, unsigned char* l) {
#pragma unroll
  for (int i = 0; i < NB / 4096; ++i) {
    const int off = threadIdx.x * 16 + i * 4096;
    __builtin_amdgcn_global_load_lds((const unsigned*)((const unsigned char*)g + off), (unsigned*)(l + off), 16, 0, 0);
  }
}
#define RAW_BARRIER() do { asm volatile("s_waitcnt lgkmcnt(0)" ::: "memory"); __builtin_amdgcn_s_barrier(); asm volatile("" ::: "memory"); } while (0)

__device__ void gdn_chain(const Params& p, int bh, unsigned char* smem) {
  const int tid = threadIdx.x, w = tid >> 6, lane = tid & 63, fr = lane & 15, fq = lane >> 4;
  const float* DL = (const float*)(p.ws + OFF_DL);
  const h16* WPb = (const h16*)(p.ws + OFF_WP) + (size_t)bh * 32 * 64 * 128;
  const h16* KDTb = (const h16*)(p.ws + OFF_KDT) + (size_t)bh * 32 * 128 * 64;
  h16* UTb = (h16*)(p.ws + OFF_UT) + (size_t)bh * 32 * 128 * 64;
  h16* SFb = (h16*)((unsigned char*)p.out + OUT_OFF_SF) + (size_t)bh * 32 * 128 * 128;
  f32x4 S[8][2];
#pragma unroll
  for (int i = 0; i < 8; ++i) { S[i][0] = f32x4{0.f, 0.f, 0.f, 0.f}; S[i][1] = f32x4{0.f, 0.f, 0.f, 0.f}; }
  h16x4 uR[4][2];
  const int uoff = (w * 32 + fr) * 64 + fq * 4;
  glds_copy<16384>(WPb, smem); glds_copy<16384>(KDTb, smem + 16384);
#pragma unroll
  for (int mt = 0; mt < 4; ++mt)
#pragma unroll
    for (int nt = 0; nt < 2; ++nt) uR[mt][nt] = *(const h16x4*)(UTb + uoff + nt * 1024 + mt * 16);
  float dl = DL[bh * 32];
  asm volatile("s_waitcnt vmcnt(0)" ::: "memory");
  RAW_BARRIER();
  for (int c = 0; c < 32; ++c) {
    const int cn = (c + 1 < 32) ? c + 1 : 31;
    const unsigned char* LW = smem + (c & 1) * 32768;
    const unsigned char* LK = LW + 16384;
    unsigned char* LWn = smem + ((c + 1) & 1) * 32768;
    f32x4 uf[4][2];
#pragma unroll
    for (int mt = 0; mt < 4; ++mt)
#pragma unroll
      for (int nt = 0; nt < 2; ++nt)
#pragma unroll
        for (int r = 0; r < 4; ++r) uf[mt][nt][r] = (float)uR[mt][nt][r];
    const float dlc = dl;
    asm volatile("" ::: "memory");
    h16x8 sfr[4][2];
#pragma unroll
    for (int ks = 0; ks < 4; ++ks) { sfr[ks][0] = pack8(S[2 * ks][0], S[2 * ks + 1][0]); sfr[ks][1] = pack8(S[2 * ks][1], S[2 * ks + 1][1]); }
#pragma unroll
    for (int ks = 0; ks < 4; ++ks)
#pragma unroll
      for (int nt = 0; nt < 2; ++nt)
        *(h16x8*)(SFb + ((size_t)(c * 4 + ks) * 8 + w * 2 + nt) * 512 + lane * 8) = sfr[ks][nt];
    glds_copy<16384>(WPb + (size_t)cn * 64 * 128, LWn);
    glds_copy<16384>(KDTb + (size_t)cn * 128 * 64, LWn + 16384);
#pragma unroll
    for (int mt = 0; mt < 4; ++mt)
#pragma unroll
      for (int nt = 0; nt < 2; ++nt)
        uR[mt][nt] = *(const h16x4*)(UTb + (size_t)cn * 128 * 64 + uoff + nt * 1024 + mt * 16);
    dl = DL[bh * 32 + cn];
    asm volatile("" ::: "memory");
    f32x4 vn[4][2];
#pragma unroll
    for (int mt = 0; mt < 4; ++mt) { vn[mt][0] = f32x4{0.f, 0.f, 0.f, 0.f}; vn[mt][1] = vn[mt][0]; }
#pragma unroll
    for (int ks = 0; ks < 4; ++ks)
#pragma unroll
      for (int mt = 0; mt < 4; ++mt) {
        h16x8 aw = *(const h16x8*)(LW + (mt * 16 + fr) * 256 + (((ks * 4 + fq) ^ fr) << 4));
        vn[mt][0] = MFMA(aw, sfr[ks][0], vn[mt][0]);
        vn[mt][1] = MFMA(aw, sfr[ks][1], vn[mt][1]);
      }
#pragma unroll
    for (int mt = 0; mt < 4; ++mt)
#pragma unroll
      for (int r = 0; r < 4; ++r) { vn[mt][0][r] = uf[mt][0][r] - vn[mt][0][r]; vn[mt][1][r] = uf[mt][1][r] - vn[mt][1][r]; }
    h16x8 vfr[2][2];
#pragma unroll
    for (int k2 = 0; k2 < 2; ++k2) { vfr[k2][0] = pack8(vn[2 * k2][0], vn[2 * k2 + 1][0]); vfr[k2][1] = pack8(vn[2 * k2][1], vn[2 * k2 + 1][1]); }
    if (c + 1 < 32) {
#pragma unroll
      for (int k2 = 0; k2 < 2; ++k2)
#pragma unroll
        for (int nt = 0; nt < 2; ++nt)
          *(h16x8*)(UTb + (size_t)c * 128 * 64 + ((size_t)k2 * 8 + w * 2 + nt) * 512 + lane * 8) = vfr[k2][nt];
    }
#pragma unroll
    for (int dkt = 0; dkt < 8; ++dkt) {
      f32x4 s0 = S[dkt][0], s1 = S[dkt][1];
#pragma unroll
      for (int r = 0; r < 4; ++r) { s0[r] *= dlc; s1[r] *= dlc; }
#pragma unroll
      for (int k2 = 0; k2 < 2; ++k2) {
        h16x8 ak = *(const h16x8*)(LK + (dkt * 16 + fr) * 128 + (((k2 * 4 + fq) ^ (fr & 7)) << 4));
        s0 = MFMA(ak, vfr[k2][0], s0);
        s1 = MFMA(ak, vfr[k2][1], s1);
      }
      S[dkt][0] = s0; S[dkt][1] = s1;
    }
    asm volatile("s_waitcnt vmcnt(0)" ::: "memory");
    RAW_BARRIER();
    if (c + 1 == 32) {
#pragma unroll
      for (int k2 = 0; k2 < 2; ++k2)
#pragma unroll
        for (int nt = 0; nt < 2; ++nt)
          *(h16x8*)(UTb + (size_t)c * 128 * 64 + ((size_t)k2 * 8 + w * 2 + nt) * 512 + lane * 8) = vfr[k2][nt];
    }
  }
  asm volatile("s_waitcnt vmcnt(0)" ::: "memory");
  __syncthreads();
}

__device__ void gdn_out_item(const Params& p, int item, unsigned char* smem) {
  unsigned char* LQ = smem;
  unsigned char* LA = smem + 16384;
  float* red = (float*)(smem + 24576);
  const int tid = threadIdx.x, w = tid >> 6, lane = tid & 63, fr = lane & 15, fq = lane >> 4;
  const int c = item & 31, h = (item >> 5) & 3, b = item >> 7;
  h16* MIXIN = (h16*)(p.ws + OFF_MIXIN);
  const h16* QGPi = (const h16*)(p.ws + OFF_QGP) + (size_t)item * 64 * 128;
  const h16* ATPi = (const h16*)(p.ws + OFF_ATP) + (size_t)item * 64 * 64;
  const h16* VFi = (const h16*)(p.ws + OFF_UT) + (size_t)item * 128 * 64;
  const h16* SFi = (const h16*)((unsigned char*)p.out + OUT_OFF_SF) + (size_t)item * 128 * 128;
  const h16* ZTi = (const h16*)((unsigned char*)p.out + OUT_OFF_ZT) + (size_t)item * 128 * 64;
  glds_copy<16384>(QGPi, LQ); glds_copy<8192>(ATPi, LA);
  h16x8 sfr[4][2], vfr[2][2];
#pragma unroll
  for (int ks = 0; ks < 4; ++ks)
#pragma unroll
    for (int nt = 0; nt < 2; ++nt) sfr[ks][nt] = *(const h16x8*)(SFi + ((size_t)ks * 8 + w * 2 + nt) * 512 + lane * 8);
#pragma unroll
  for (int k2 = 0; k2 < 2; ++k2)
#pragma unroll
    for (int nt = 0; nt < 2; ++nt) vfr[k2][nt] = *(const h16x8*)(VFi + ((size_t)k2 * 8 + w * 2 + nt) * 512 + lane * 8);
  h16x4 zR[4][2];
#pragma unroll
  for (int mt = 0; mt < 4; ++mt)
#pragma unroll
    for (int nt = 0; nt < 2; ++nt) zR[mt][nt] = *(const h16x4*)(ZTi + (size_t)(w * 32 + nt * 16 + fr) * 64 + mt * 16 + fq * 4);
  asm volatile("s_waitcnt vmcnt(0)" ::: "memory");
  __syncthreads();
  f32x4 o[4][2];
#pragma unroll
  for (int mt = 0; mt < 4; ++mt) {
    f32x4 o0 = {0.f, 0.f, 0.f, 0.f}, o1 = {0.f, 0.f, 0.f, 0.f};
#pragma unroll
    for (int ks = 0; ks < 4; ++ks) {
      h16x8 aq = *(const h16x8*)(LQ + (mt * 16 + fr) * 256 + (((ks * 4 + fq) ^ fr) << 4));
      o0 = MFMA(aq, sfr[ks][0], o0);
      o1 = MFMA(aq, sfr[ks][1], o1);
    }
#pragma unroll
    for (int k2 = 0; k2 < 2; ++k2) {
      h16x8 aa = *(const h16x8*)(LA + (mt * 16 + fr) * 128 + (((k2 * 4 + fq) ^ (fr & 7)) << 4));
      o0 = MFMA(aa, vfr[k2][0], o0);
      o1 = MFMA(aa, vfr[k2][1], o1);
    }
    o[mt][0] = o0; o[mt][1] = o1;
  }
#pragma unroll
  for (int mt = 0; mt < 4; ++mt)
#pragma unroll
    for (int r = 0; r < 4; ++r) {
      float s = o[mt][0][r] * o[mt][0][r] + o[mt][1][r] * o[mt][1][r];
      s = sum16(s);
      if (fr == 0) red[w * 64 + mt * 16 + 4 * fq + r] = s;
    }
  __syncthreads();
#pragma unroll
  for (int mt = 0; mt < 4; ++mt)
#pragma unroll
    for (int r = 0; r < 4; ++r) {
      const int tl = mt * 16 + 4 * fq + r;
      const float tot = red[tl] + red[64 + tl] + red[128 + tl] + red[192 + tl];
      const float rstd = rsqrtf(tot * (1.f / 128.f) + 1e-6f);
      const size_t tok = (size_t)b * SEQ + c * 64 + tl;
      h16* yp = MIXIN + tok * 1024 + 512 + h * 128 + w * 32 + fr;
      yp[0] = (h16)(o[mt][0][r] * rstd * (float)zR[mt][0][r]);
      yp[16] = (h16)(o[mt][1][r] * rstd * (float)zR[mt][1][r]);
    }
  __syncthreads();
}

#define XB_TMO      128
#define XB_XCNT(j)  (256  + 64 * (j))
#define XB_XSUB(j)  (1280 + 64 * (j))
#define XB_XGEN(j)  (2304 + 64 * (j))
#define XB_TOP      3328
#define XB_TOPGEN   3392
#define XCD_BAR_WORDS 3456
#define XB_SPIN_CAP (1u << 18)
#define LAS __attribute__((address_space(3)))

__device__ __forceinline__ unsigned xb_ld(unsigned* p)              { return __hip_atomic_load(p, __ATOMIC_RELAXED, __HIP_MEMORY_SCOPE_AGENT); }
__device__ __forceinline__ unsigned xb_add(unsigned* p, unsigned v) { return __hip_atomic_fetch_add(p, v, __ATOMIC_RELAXED, __HIP_MEMORY_SCOPE_AGENT); }
__device__ __forceinline__ unsigned xb_xcc_id() { return (unsigned)__builtin_amdgcn_s_getreg((3 << 11) | 20) & 0xFu; }
#define XB_SPIN(cond, bar) do { unsigned _sp = 0; while (cond) { __builtin_amdgcn_s_sleep(1); \
    if ((++_sp & 255u) == 0u) { if (xb_ld(&(bar)[XB_TMO])) break; if (_sp > XB_SPIN_CAP) { atomicAdd(&(bar)[XB_TMO], 1u); break; } } } } while (0)

struct XcdBarrier {
    unsigned* bar; unsigned x;
    volatile LAS unsigned* st;
};

__device__ __forceinline__ XcdBarrier xcd_barrier_post(unsigned* bar, volatile LAS unsigned* st) {
    XcdBarrier b; b.bar = bar; b.x = xb_xcc_id(); b.st = st;
    if (threadIdx.x == 0) (void)xb_add(&bar[XB_XCNT(b.x)], 1u);
    return b;
}
__device__ __forceinline__ void xcd_barrier_complete(unsigned* bar, unsigned x, unsigned& nloc, unsigned& nx) {
    const unsigned G = gridDim.x * gridDim.y * gridDim.z;
    unsigned sum, cnt, mine, sp = 0u;
    for (;;) {
        sum = 0u; cnt = 0u; mine = 0u;
#pragma unroll
        for (unsigned j = 0; j < 16; ++j) { const unsigned c = xb_ld(&bar[XB_XCNT(j)]); sum += c; cnt += (c > 0u) ? 1u : 0u; mine = (j == x) ? c : mine; }
        if (sum == G) break;
        __builtin_amdgcn_s_sleep(1);
        if ((++sp & 255u) == 0u) { if (xb_ld(&bar[XB_TMO])) break; if (sp > XB_SPIN_CAP) { atomicAdd(&bar[XB_TMO], 1u); break; } }
    }
    nloc = mine > 0u ? mine : 1u; nx = cnt > 0u ? cnt : 1u;
}

__device__ __forceinline__ void xcd_barrier(const XcdBarrier& b) {
    asm volatile("s_waitcnt vmcnt(0)" ::: "memory");
    __syncthreads();
    if (threadIdx.x == 0) {
        unsigned* bar = b.bar;
        __builtin_amdgcn_s_waitcnt(0);
        unsigned nloc = b.st[0], nx = b.st[1];
        if (nloc == 0u) { xcd_barrier_complete(bar, b.x, nloc, nx); b.st[0] = nloc; b.st[1] = nx; }
        const unsigned old = xb_add(&bar[XB_XSUB(b.x)], 1u);
        const unsigned gen = old / nloc;
        if (old + 1u == (gen + 1u) * nloc) {
            __builtin_amdgcn_fence(__ATOMIC_RELEASE, "agent");
            asm volatile("s_waitcnt vmcnt(0)" ::: "memory");
            const unsigned og = xb_add(&bar[XB_TOP], 1u);
            const unsigned tg = og / nx;
            if (og + 1u == (tg + 1u) * nx) xb_add(&bar[XB_TOPGEN], 1u);
            else XB_SPIN(xb_ld(&bar[XB_TOPGEN]) == tg, bar);
            __builtin_amdgcn_fence(__ATOMIC_ACQUIRE, "agent");
            xb_add(&bar[XB_XGEN(b.x)], 1u);
            asm volatile("s_waitcnt vmcnt(0)" ::: "memory");
        } else {
            XB_SPIN(xb_ld(&bar[XB_XGEN(b.x)]) == gen, bar);
            __builtin_amdgcn_fence(__ATOMIC_ACQUIRE, "agent");
            asm volatile("s_waitcnt vmcnt(0)" ::: "memory");
        }
    }
    __syncthreads();
}

#ifndef ONLY_PH
#define ONLY_PH -1
#endif
#define RUNPH(n) ((ONLY_PH < 0 || ONLY_PH == (n)) && p.ph_lo <= (n) && (n) <= p.ph_hi)
#define SYNCPH(n) do { if (p.ph_lo <= (n) && (n) < p.ph_hi) xcd_barrier(xb); } while (0)
__global__ void __launch_bounds__(256, 2) hymba_mega(Params p) {
  __shared__ __attribute__((aligned(16))) unsigned char smem[SMEM_BYTES];
  cg::grid_group grid = cg::this_grid();
  const int bid = blockIdx.x, nb = gridDim.x;
  if (p.ph_lo < 0) grid.sync();
  XcdBarrier xb;
  {
    volatile LAS unsigned* st = (volatile LAS unsigned*)(smem + SMEM_BYTES - 16);
    if (threadIdx.x == 0) { st[0] = 0u; st[1] = 0u; st[2] = 0u; st[3] = 0u; }
    __syncthreads();
    if (p.ph_lo < p.ph_hi) xb = xcd_barrier_post((unsigned*)(p.ws + OFF_BAR), st);
    else { xb.bar = (unsigned*)(p.ws + OFF_BAR); xb.x = 0; xb.st = st; }
  }
  {
    if (RUNPH(0)) for (int rep = 0; rep < REP0; ++rep) {
      if (rep) grid.sync();
      phase0(p, smem);
    }
    SYNCPH(0);
    if (RUNPH(1)) for (int rep = 0; rep < REP1; ++rep) {
      if (rep) grid.sync();
      const h16* A0 = (const h16*)((unsigned char*)p.out + OUT_OFF_A0);
      const h16* W = (const h16*)(p.ws + OFF_WIN);
      const int xl = bid & 7, nxb = nb >> 3;
      if (nb & 7) { for (int t = bid; t < 256 * 25; t += nb) gemm_tile<EPI_PROJ>(p, A0, 1024, W, 1024, 1024, (t / 25) * 128, (t % 25) * 128, smem); }
      else for (int u = bid >> 3; u < 800; u += nxb) {
        const int mb = u / 200, v = u % 200;
        gemm_tile<EPI_PROJ>(p, A0, 1024, W, 1024, 1024, (xl * 32 + mb * 8 + (v & 7)) * 128, (v >> 3) * 128, smem);
      }
    }
    SYNCPH(1);
    if (RUNPH(2)) {
      for (int it = bid; it < 256 + 2048; it += nb) {
        if (it < 256) gemm_tile<EPI_LOCAL>(p, (const h16*)(p.ws + OFF_US), 512, (const h16*)(p.ws + OFF_ETAB) + (size_t)(it >> 3) * 128 * 512, 512, 512, it * 128, 0, smem);
        else gdn_pre_item(p, it - 256, smem);
      }
    }
    SYNCPH(2);
    if (RUNPH(3)) {
      for (int it = bid; it < 512; it += nb) ssm_item(p, it >> 5, it & 31, smem);
    }
    SYNCPH(3);
    if (RUNPH(4)) {
      if (bid < 64) gdn_chain(p, bid, smem);
      const int xl = bid & 7;
      unsigned* ctr = (unsigned*)(p.ws + OFF_CTR) + xl * 16;
      volatile int* bc = (volatile int*)(smem + SMEM_BYTES - 4);
      const h16* YPRE = (const h16*)((unsigned char*)p.out + OUT_OFF_YPRE);
      for (;;) {
        __syncthreads();
        if (threadIdx.x == 0) *bc = (int)atomicAdd(ctr, 1u);
        __syncthreads();
        const int u = *bc;
        if (u >= 128 + 256) break;
        if (u < 128) gemm_tile<EPI_GLU>(p, YPRE, 512, (const h16*)(p.ws + OFF_WGLU), 512, 512, (xl * 32 + (u >> 2)) * 128, (u & 3) * 128, smem);
        else gemm_tile<EPI_PLE>(p, (const h16*)(p.ws + OFF_PB), 256, (const h16*)(p.ws + OFF_WPP), 256, 256, (xl * 32 + ((u - 128) >> 3)) * 128, ((u - 128) & 7) * 128, smem);
      }
    }
    SYNCPH(4);
    if (RUNPH(5)) {
      for (int it = bid; it < 2048; it += nb) gdn_out_item(p, it, smem);
    }
    SYNCPH(5);
    if (RUNPH(6)) {
      const int xl = bid & 7, nxb = nb >> 3;
      if (nb & 7) { for (int t = bid; t < 2048; t += nb) gemm_tile<EPI_OUT>(p, (const h16*)(p.ws + OFF_MIXIN), 1024, (const h16*)(p.ws + OFF_WOUT), 1024, 1024, (t >> 3) * 128, (t & 7) * 128, smem); }
      else for (int u = bid >> 3; u < 256; u += nxb)
        gemm_tile<EPI_OUT>(p, (const h16*)(p.ws + OFF_MIXIN), 1024, (const h16*)(p.ws + OFF_WOUT), 1024, 1024, (xl * 32 + (u >> 6) * 8 + (u & 7)) * 128, ((u >> 3) & 7) * 128, smem);
    }
    SYNCPH(6);
    if (RUNPH(7)) {
      const int xl = bid & 7, nxb = nb >> 3;
      if (nb & 7) { for (int t = bid; t < 2048; t += nb) gemm_tile<EPI_GATE>(p, (const h16*)(p.ws + OFF_PROJ), 1024, (const h16*)(p.ws + OFF_WGATE), 1024, 1024, (t >> 3) * 128, (t & 7) * 128, smem); }
      else for (int u = bid >> 3; u < 256; u += nxb)
        gemm_tile<EPI_GATE>(p, (const h16*)(p.ws + OFF_PROJ), 1024, (const h16*)(p.ws + OFF_WGATE), 1024, 1024, (xl * 32 + (u >> 6) * 8 + (u & 7)) * 128, ((u >> 3) & 7) * 128, smem);
    }
    SYNCPH(7);
    if (RUNPH(8)) {
      const int wid = threadIdx.x >> 6, lane = threadIdx.x & 63;
      const float* OPART = (const float*)(p.ws + OFF_OPART);
      const float4* g4 = (const float4*)p.in[I_FING];
      const h16* H2B = (const h16*)(p.ws + OFF_MIXIN);
      for (int row = bid * 4 + wid; row < T_TOK; row += nb * 4) {
        float s = (lane < 8) ? OPART[(size_t)row * 8 + lane] : 0.f;
        const h16x8 a = *(const h16x8*)(H2B + (size_t)row * 1024 + lane * 8);
        const h16x8 b = *(const h16x8*)(H2B + (size_t)row * 1024 + 512 + lane * 8);
        s = wave_sum(s);
        const float rstd = rsqrtf(s * (1.f / 1024.f) + 1e-6f);
        float4* orow = (float4*)(p.out + (size_t)row * 1024);
        const float4 g0 = g4[lane * 2], g1 = g4[lane * 2 + 1], g2 = g4[128 + lane * 2], g3 = g4[128 + lane * 2 + 1];
        float4 o0, o1, o2, o3;
        o0.x = (float)a[0] * rstd * g0.x; o0.y = (float)a[1] * rstd * g0.y; o0.z = (float)a[2] * rstd * g0.z; o0.w = (float)a[3] * rstd * g0.w;
        o1.x = (float)a[4] * rstd * g1.x; o1.y = (float)a[5] * rstd * g1.y; o1.z = (float)a[6] * rstd * g1.z; o1.w = (float)a[7] * rstd * g1.w;
        o2.x = (float)b[0] * rstd * g2.x; o2.y = (float)b[1] * rstd * g2.y; o2.z = (float)b[2] * rstd * g2.z; o2.w = (float)b[3] * rstd * g2.w;
        o3.x = (float)b[4] * rstd * g3.x; o3.y = (float)b[5] * rstd * g3.y; o3.z = (float)b[6] * rstd * g3.z; o3.w = (float)b[7] * rstd * g3.w;
        orow[lane * 2] = o0; orow[lane * 2 + 1] = o1; orow[128 + lane * 2] = o2; orow[128 + lane * 2 + 1] = o3;
      }
    }
  }
}

extern "C" void kernel_launch(void* const* d_in, const int* in_sizes, int n_in, void* d_out, int out_size, void* d_ws, size_t ws_size,
                              hipStream_t stream) {
  static int grid_blocks = 0;
  if (!grid_blocks) {
    int dev = 0, cus = 0, per_cu = 0;
    hipGetDevice(&dev);
    hipDeviceGetAttribute(&cus, hipDeviceAttributeMultiprocessorCount, dev);
    hipOccupancyMaxActiveBlocksPerMultiprocessor(&per_cu, hymba_mega, 256, 0);
    if (per_cu > 2) per_cu = 2;
    if (per_cu < 1) per_cu = 1;
    grid_blocks = cus * per_cu;
  }
  if (n_in != 23 || ws_size < WS_END || out_size != T_TOK * 1024) {
    fprintf(stderr, "kernel_launch: unexpected sizes n_in=%d ws=%zu (need %zu) out=%d\n", n_in, ws_size, (size_t)WS_END, out_size);
    return;
  }
  Params p{};
  for (int i = 0; i < 23; ++i) p.in[i] = (const float*)d_in[i];
  p.out = (float*)d_out;
  p.ws = (unsigned char*)d_ws;
  if (hipMemsetAsync((unsigned char*)d_ws + OFF_BAR, 0, 16384, stream) != hipSuccess) { fprintf(stderr, "kernel_launch: memset of control words failed\n"); return; }
#if MULTI_LAUNCH
  for (int ph = 0; ph < NPH; ++ph) {
    p.ph_lo = ph; p.ph_hi = ph;
    hipLaunchKernelGGL(hymba_mega, dim3(grid_blocks), dim3(256), 0, stream, p);
  }
#else
  p.ph_lo = 0; p.ph_hi = NPH - 1;
  void* args[] = {&p};
  hipError_t e = hipLaunchCooperativeKernel((void*)hymba_mega, dim3(grid_blocks), dim3(256), args, 0, stream);
  if (e != hipSuccess) fprintf(stderr, "cooperative launch failed: %s (grid %d)\n", hipGetErrorString(e), grid_blocks);
#endif
}
```
